# Optimizing an MI355X kernel written in HIP

```python
import math
import jax, jax.numpy as jnp
from jax import lax
import numpy as np

D_MODEL = 1024
BATCH = 1
SEQ = 16384
DEPTH = 4
DEC_BATCH = 4
DEC_SEQ = 4096
PAST_LEN = 128

D_HYENA = 512
HYENA_GROUPS = 8
D_HGRN = D_MODEL - D_HYENA
HGRN_HEADS = 4
HGRN_DK = D_HGRN // HGRN_HEADS
HGRN_DV = D_HGRN // HGRN_HEADS
D_IN = 3 * D_HYENA + 5 * D_HGRN
D_FF = 4 * D_MODEL
CHUNK = 64
FILTER_EMB = 33
FILTER_BANDS = (FILTER_EMB - 1) // 2
FILTER_HIDDEN = 64
DECAY_TARGET = 1e-2
FAST_DECAY_PCT = 0.3
SLOW_DECAY_PCT = 1.5
EPS = 1e-6

kernel_name = "hyena_hgrn2_parallel_encoder"

F32 = jnp.float32


def _rmsnorm(x, gain):
    xf = x.astype(F32)
    y = xf * lax.rsqrt(jnp.mean(xf * xf, axis=-1, keepdims=True) + EPS)
    return (y * gain.astype(F32)).astype(x.dtype)


def _group_rmsnorm(x, gain, n_groups):
    b, l, c = x.shape
    y = _rmsnorm(x.reshape(b, l, n_groups, c // n_groups), gain.reshape(n_groups, c // n_groups))
    return y.reshape(b, l, c)


def _dwconv3(x, w, b):
    L = x.shape[1]
    xp = jnp.pad(x, ((0, 0), (1, 1), (0, 0)))
    return xp[:, :L] * w[0] + xp[:, 1:L + 1] * w[1] + xp[:, 2:] * w[2] + b


def _hyena_filter(L, w1, b1, w2, b2, w3, b3, w4, freq):
    t = jnp.linspace(0.0, 1.0, L, dtype=F32)[:, None]
    ang = (2.0 * math.pi / L) * jnp.arange(L, dtype=F32)[:, None]
    bands = jnp.linspace(1e-4, FILTER_BANDS - 1, FILTER_BANDS, dtype=F32)[None, :]
    feats = jnp.concatenate([t, jnp.cos(bands * ang), -jnp.sin(bands * ang)], axis=-1)
    fr = freq.astype(F32)
    h = jnp.sin(fr * (feats @ w1.astype(F32) + b1.astype(F32)))
    h = jnp.sin(fr * (h @ w2.astype(F32) + b2.astype(F32)))
    h = jnp.sin(fr * (h @ w3.astype(F32) + b3.astype(F32)))
    h = h @ w4.astype(F32)
    deltas = jnp.abs(jnp.linspace(math.log(DECAY_TARGET) / SLOW_DECAY_PCT,
                                  math.log(DECAY_TARGET) / FAST_DECAY_PCT, D_HYENA, dtype=F32))
    window = jnp.exp(-t * deltas)
    h = h.reshape(L, 2, D_HYENA) * window[:, None, :]
    h_fwd, h_bwd = h[:, 0], h[:, 1]
    return jnp.concatenate([h_fwd, jnp.zeros((1, D_HYENA), F32), h_bwd[:0:-1]], axis=0)


def _hyena(u, kernel, skip):
    L = u.shape[1]
    uf = u.astype(F32)
    x0, x1, v = jnp.split(uf, 3, axis=-1)
    z = x1 * v
    Z = jnp.fft.rfft(z, n=2 * L, axis=1)
    K = jnp.fft.rfft(kernel, axis=0)
    y = jnp.fft.irfft(Z * K[None], n=2 * L, axis=1)[:, :L] + skip.astype(F32) * z
    return (x0 * y).astype(u.dtype)


def _chunk_scan(q, k, logf, v):
    B, L, H, dk = q.shape
    dv = v.shape[-1]
    n = L // CHUNK

    def to_chunks(a):
        return a.reshape(B, n, CHUNK, H, a.shape[-1]).transpose(1, 0, 3, 2, 4)

    causal = jnp.tril(jnp.ones((CHUNK, CHUNK), dtype=bool))[:, :, None]

    def step(S, xs):
        qc, kc, gc, vc = xs
        b = jnp.cumsum(gc, axis=2)
        o_inter = jnp.einsum('bhtd,bhde->bhte', qc * jnp.exp(b), S)
        rel = b[:, :, :, None, :] - b[:, :, None, :, :]
        decay = jnp.exp(jnp.where(causal, rel, -jnp.inf))
        scores = jnp.einsum('bhtd,bhsd,bhtsd->bhts', qc, kc, decay)
        o_intra = jnp.einsum('bhts,bhse->bhte', scores, vc)
        b_last = b[:, :, -1:, :]
        S_new = jnp.exp(b_last[:, :, 0, :, None]) * S + jnp.einsum(
            'bhsd,bhse->bhde', kc * jnp.exp(b_last - b), vc)
        return S_new, o_inter + o_intra

    S0 = jnp.zeros((B, H, dk, dv), F32)
    _, o = lax.scan(step, S0, (to_chunks(q), to_chunks(k), to_chunks(logf), to_chunks(v)))
    return o.transpose(1, 0, 3, 2, 4).reshape(B, L, H, dv)


def _hgrn2(hg, lb_fwd, lb_bwd, out_gain):
    B, L, _ = hg.shape
    q, f_fwd, f_bwd, i, g = jnp.split(hg.astype(F32), 5, axis=-1)
    q = jax.nn.silu(q)

    def heads(a):
        return a.reshape(B, L, HGRN_HEADS, a.shape[-1] // HGRN_HEADS)

    def log_forget(z, lb):
        lb = lb.astype(F32)
        return jnp.logaddexp(jnp.log(lb), jnp.log1p(-lb) + jax.nn.log_sigmoid(z))

    def flip(a):
        return jnp.flip(a, axis=1)

    gf = heads(log_forget(f_fwd, lb_fwd))
    gb = heads(log_forget(f_bwd, lb_bwd))
    qh, ih = heads(q), heads(i)
    o_f = _chunk_scan(qh, -jnp.expm1(gf), gf, ih)
    o_b = flip(_chunk_scan(flip(qh), flip(-jnp.expm1(gb)), flip(gb), flip(ih)))
    o = _rmsnorm(o_f + o_b, out_gain.reshape(HGRN_HEADS, HGRN_DV))
    o = o.reshape(B, L, D_HGRN) * jax.nn.silu(g)
    return o.astype(hg.dtype)


def _lower_bounds(table):
    c = jnp.cumsum(jax.nn.softmax(table.astype(F32), axis=1), axis=1)
    return c - c[:, :1]


def _trunk(x, lbs, norm_mix_pre, norm_mix_post, norm_ffn_pre, norm_ffn_post, w_in,
           hyena_conv_w, hyena_conv_b, filt_w1, filt_b1, filt_w2, filt_b2, filt_w3, filt_b3,
           filt_w4, filt_freq, hyena_skip, hyena_out_norm, hgrn_out_norm, w_out,
           ffn_w_up, ffn_conv_w, ffn_conv_b, ffn_w_down):
    L = x.shape[1]
    for l in range(DEPTH):
        h = _rmsnorm(x, norm_mix_pre[l])
        proj = h @ w_in[l]
        hy = _dwconv3(proj[..., :3 * D_HYENA], hyena_conv_w[l], hyena_conv_b[l])
        hg = proj[..., 3 * D_HYENA:]
        kernel = _hyena_filter(L, filt_w1[l], filt_b1[l], filt_w2[l], filt_b2[l], filt_w3[l],
                               filt_b3[l], filt_w4[l], filt_freq[l])
        y_hy = _group_rmsnorm(_hyena(hy, kernel, hyena_skip[l]), hyena_out_norm[l], HYENA_GROUPS)
        y_hg = _hgrn2(hg, lbs[0, l], lbs[1, l], hgrn_out_norm[l])
        mix = jnp.concatenate([y_hy, y_hg], axis=-1) @ w_out[l]
        x = x + _rmsnorm(mix, norm_mix_post[l])
        h = _rmsnorm(x, norm_ffn_pre[l])
        u = _dwconv3(h @ ffn_w_up[l], ffn_conv_w[l], ffn_conv_b[l])
        a, b = jnp.split(u, 2, axis=-1)
        ff = (jax.nn.gelu(a, approximate=True) * b) @ ffn_w_down[l]
        x = x + _rmsnorm(ff, norm_ffn_post[l])
    return x


def setup_inputs(seed: int = 0) -> dict:
    key = jax.random.key(seed)
    ks = jax.random.split(key, 32)

    def nrm(k, shape, scale):
        return jax.random.normal(k, shape, F32) * scale

    def gain(k, shape):
        return 1.0 + 0.05 * jax.random.normal(k, shape, F32)

    centre = jnp.array([0.0, 1.0, 0.0], F32)[:, None]
    return {
        "x_prompt": nrm(ks[0], (BATCH, SEQ, D_MODEL), 1.0),
        "x_sample": nrm(ks[1], (DEC_BATCH, DEC_SEQ, D_MODEL), 1.0),
        "norm_mix_pre": gain(ks[2], (DEPTH, D_MODEL)),
        "norm_mix_post": gain(ks[3], (DEPTH, D_MODEL)),
        "norm_ffn_pre": gain(ks[4], (DEPTH, D_MODEL)),
        "norm_ffn_post": gain(ks[5], (DEPTH, D_MODEL)),
        "w_in": nrm(ks[6], (DEPTH, D_MODEL, D_IN), D_MODEL ** -0.5),
        "hyena_conv_w": centre + nrm(ks[7], (DEPTH, 3, 3 * D_HYENA), 0.3),
        "hyena_conv_b": nrm(ks[8], (DEPTH, 3 * D_HYENA), 0.01),
        "filt_w1": nrm(ks[9], (DEPTH, FILTER_EMB, FILTER_HIDDEN), FILTER_EMB ** -0.5),
        "filt_b1": nrm(ks[10], (DEPTH, FILTER_HIDDEN), 0.1),
        "filt_w2": nrm(ks[11], (DEPTH, FILTER_HIDDEN, FILTER_HIDDEN), FILTER_HIDDEN ** -0.5),
        "filt_b2": nrm(ks[12], (DEPTH, FILTER_HIDDEN), 0.1),
        "filt_w3": nrm(ks[13], (DEPTH, FILTER_HIDDEN, FILTER_HIDDEN), FILTER_HIDDEN ** -0.5),
        "filt_b3": nrm(ks[14], (DEPTH, FILTER_HIDDEN), 0.1),
        "filt_w4": nrm(ks[15], (DEPTH, FILTER_HIDDEN, 2 * D_HYENA), FILTER_HIDDEN ** -0.5),
        "filt_freq": gain(ks[16], (DEPTH, FILTER_HIDDEN)),
        "hyena_skip": nrm(ks[17], (DEPTH, D_HYENA), 1.0),
        "hyena_out_norm": gain(ks[18], (DEPTH, D_HYENA)),
        "hgrn_lower_bounds": nrm(ks[19], (2, DEPTH, D_HGRN), 0.1),
        "hgrn_out_norm": gain(ks[20], (DEPTH, D_HGRN)),
        "w_out": nrm(ks[21], (DEPTH, D_MODEL, D_MODEL), D_MODEL ** -0.5),
        "ffn_w_up": nrm(ks[22], (DEPTH, D_MODEL, 2 * D_FF), D_MODEL ** -0.5),
        "ffn_conv_w": centre + nrm(ks[23], (DEPTH, 3, 2 * D_FF), 0.3),
        "ffn_conv_b": nrm(ks[24], (DEPTH, 2 * D_FF), 0.01),
        "ffn_w_down": nrm(ks[25], (DEPTH, D_FF, D_MODEL), D_FF ** -0.5),
    }


def reference(x_prompt, x_sample, norm_mix_pre, norm_mix_post, norm_ffn_pre, norm_ffn_post, w_in,
              hyena_conv_w, hyena_conv_b, filt_w1, filt_b1, filt_w2, filt_b2, filt_w3, filt_b3,
              filt_w4, filt_freq, hyena_skip, hyena_out_norm, hgrn_lower_bounds, hgrn_out_norm,
              w_out, ffn_w_up, ffn_conv_w, ffn_conv_b, ffn_w_down):
    lbs = _lower_bounds(hgrn_lower_bounds)
    y_prompt = _trunk(x_prompt, lbs, norm_mix_pre, norm_mix_post, norm_ffn_pre, norm_ffn_post,
                      w_in, hyena_conv_w, hyena_conv_b, filt_w1, filt_b1, filt_w2, filt_b2,
                      filt_w3, filt_b3, filt_w4, filt_freq, hyena_skip, hyena_out_norm,
                      hgrn_out_norm, w_out, ffn_w_up, ffn_conv_w, ffn_conv_b, ffn_w_down)
    y_sample = _trunk(x_sample, lbs, norm_mix_pre, norm_mix_post, norm_ffn_pre, norm_ffn_post,
                      w_in, hyena_conv_w, hyena_conv_b, filt_w1, filt_b1, filt_w2, filt_b2,
                      filt_w3, filt_b3, filt_w4, filt_freq, hyena_skip, hyena_out_norm,
                      hgrn_out_norm, w_out, ffn_w_up, ffn_conv_w, ffn_conv_b, ffn_w_down)
    return (y_prompt, y_sample)
```

```cpp
#include <hip/hip_runtime.h>
#include <hip/hip_cooperative_groups.h>
#include <cstdio>
#include <cstdint>
namespace cg = cooperative_groups;
__device__ __forceinline__ int tid_opaque() { int t = (int)threadIdx.x; asm volatile("" : "+v"(t)); return t; }
#define TIDX tid_opaque()
namespace pg8 {
#define PG8_LAS __attribute__((address_space(3)))
typedef unsigned short bf16_t;
typedef short bf16x8 __attribute__((ext_vector_type(8)));
typedef float f32x4 __attribute__((ext_vector_type(4)));
typedef unsigned u32x4 __attribute__((ext_vector_type(4)));
constexpr int BM = 256, BK = 64, HALF = 128, HTB = HALF * BK * 2  , STAGE_BYTES = 8 * HTB, NXCD = 8, WGM = 8;

__host__ __device__ __forceinline__ int lds_byte(int r, int c) { const int st = (r >> 4) * 2 + (c >> 5), rr = r & 15, cc = c & 31, ob = rr * 64 + cc * 2; return st * 1024 + (ob ^ (((ob >> 9) & 1) << 5)); }
__host__ __device__ __forceinline__ void stage_rc(int b, int& R, int& C) { const int st = b / 1024, sb = b % 1024, swz = sb ^ (((sb >> 9) & 1) << 5); R = (st >> 1) * 16 + swz / 64; C = (st & 1) * 32 + (swz % 64) / 2; }
__host__ __device__ __forceinline__ int perm32(int rho) { const int n = rho >> 4, i = rho & 15; return 8 * (i >> 2) + 4 * n + (i & 3); }

struct Unit { int pm, pn; };
struct Gemm { const bf16_t* A; const bf16_t* Bt; int M, N, K; };

struct StaticOrder {
    int nM, nN, nwg, G, c;
    __host__ __device__ void init(int M, int N, int G_, int c_) { nM = M / BM; nN = N / BM; nwg = nM * nN; G = G_; c = c_; }
    __host__ __device__ bool next(int i, Unit& u) const {
        const long L = (long)i * G + c; if (L >= nwg) return false;
        int wgid = (int)L; { const int q = nwg / NXCD, r = nwg % NXCD, xcd = wgid % NXCD, off = wgid / NXCD; wgid = (xcd < r ? xcd * (q + 1) : r * (q + 1) + (xcd - r) * q) + off; }
        const int nig = WGM * nN, gid = wgid / nig, fm = gid * WGM, gsz = (nM - fm) < WGM ? (nM - fm) : WGM;
        u.pm = fm + ((wgid % nig) % gsz); u.pn = (wgid % nig) / gsz; return true;
    }
    __device__ __forceinline__ void a_ready(const Unit&) const {}
    __device__ __forceinline__ void done(const Unit&) const {}
};
struct CountedOrder : StaticOrder {
    const unsigned* ready; unsigned need; unsigned* tmo;
    __device__ __forceinline__ void a_ready(const Unit& u) const {
        if (TIDX < 64) {
            const unsigned long long t0 = __builtin_amdgcn_s_memrealtime(); unsigned polls = 0;
            while ((unsigned)__builtin_amdgcn_readfirstlane(__hip_atomic_load(ready + 64 * u.pm, __ATOMIC_RELAXED, __HIP_MEMORY_SCOPE_AGENT)) < need) {
                if ((++polls & 255u) == 0u && __builtin_amdgcn_readfirstlane(__hip_atomic_load(tmo, __ATOMIC_RELAXED, __HIP_MEMORY_SCOPE_AGENT)) != 0u) break;
                if (__builtin_amdgcn_s_memrealtime() - t0 > 2000000ull) {
                    if (TIDX == 0) { unsigned expect = 0u; __hip_atomic_compare_exchange_strong(tmo + 1, &expect, 0x600u | (unsigned)(u.pm & 0xff), __ATOMIC_RELAXED, __ATOMIC_RELAXED, __HIP_MEMORY_SCOPE_AGENT); __hip_atomic_store(tmo, 1u, __ATOMIC_RELAXED, __HIP_MEMORY_SCOPE_AGENT); }
                    break; }
                __builtin_amdgcn_s_sleep(2); }
            __builtin_amdgcn_fence(__ATOMIC_ACQUIRE, "agent");
            asm volatile("s_waitcnt vmcnt(0)" ::: "memory");
        }
#if !defined(BROKEN_HOOK_NO_BARRIER)
        asm volatile("" ::: "memory"); __builtin_amdgcn_s_barrier(); asm volatile("" ::: "memory");
#endif
    }
};

__device__ __forceinline__ unsigned cvt_pk_bf16(float lo, float hi) { unsigned r; asm volatile("v_cvt_pk_bf16_f32 %0, %1, %2" : "=v"(r) : "v"(lo), "v"(hi)); return r; }
typedef float f32x2 __attribute__((ext_vector_type(2)));
__device__ __forceinline__ f32x2 gelu_pk(f32x2 v) {
    const f32x2 av = __builtin_elementwise_abs(v), d = av * 0.2316418882f + 1.0f;
    f32x2 t; t.x = __builtin_amdgcn_rcpf(d.x); t.y = __builtin_amdgcn_rcpf(d.y);
    f32x2 q = t * 0.5307027145f + (-0.7265760135f); q = q * t + 0.7107068705f; q = q * t + (-0.142248368f); q = q * t + 0.127414796f; q = q * t;
    const f32x2 s = (v * v) * (-0.72134752044f);
    f32x2 e; e.x = __builtin_amdgcn_exp2f(s.x); e.y = __builtin_amdgcn_exp2f(s.y);
    const f32x2 m = v * (q * e), r = v - m;
    f32x2 o; o.x = v.x < 0.f ? m.x : r.x; o.y = v.y < 0.f ? m.y : r.y; return o;
}

struct EpiF32 {
    static constexpr bool PERM = false, AFTER_DRAIN = false;
    float* C; int ldc; const float* bias;
    __device__ __forceinline__ void operator()(const f32x4 (&acc)[2][2][4][2], const Unit& u, int wr, int wc, int fr, int fq) const {
        const int row0 = u.pm * BM + wr * 64 + fr, col0 = u.pn * BM + wc * 32 + 4 * fq;
        f32x4 bv[2][2];
#pragma unroll
        for (int bj = 0; bj < 2; ++bj)
#pragma unroll
            for (int n = 0; n < 2; ++n) bv[bj][n] = bias ? *(const f32x4*)(bias + col0 + bj * HALF + n * 16) : (f32x4){0.f, 0.f, 0.f, 0.f};
#pragma unroll
        for (int ai = 0; ai < 2; ++ai)
#pragma unroll
            for (int m = 0; m < 4; ++m) { float* rowp = C + (size_t)(row0 + ai * HALF + m * 16) * ldc + col0;
#pragma unroll
                for (int bj = 0; bj < 2; ++bj)
#pragma unroll
                    for (int n = 0; n < 2; ++n) *(f32x4*)(rowp + bj * HALF + n * 16) = acc[ai][bj][m][n] + bv[bj][n]; }
    }
};
template <int ACT  > struct EpiBf16 {
    static constexpr bool PERM = true, AFTER_DRAIN = false;
    bf16_t* O; int ldc; const float* bias; int split_cols; size_t split_stride;
    __device__ __forceinline__ void operator()(const f32x4 (&acc)[2][2][4][2], const Unit& u, int wr, int wc, int fr, int fq) const {
        const int row0 = u.pm * BM + wr * 64 + fr; int colt = u.pn * BM; bf16_t* base = O;
        if (split_cols) { const int t = colt / split_cols; base += (size_t)t * split_stride; colt -= t * split_cols; }
        const int col0 = colt + wc * 32 + 8 * fq, bcol0 = u.pn * BM + wc * 32 + 8 * fq;
        f32x4 bv[2][2];
#pragma unroll
        for (int bj = 0; bj < 2; ++bj)
#pragma unroll
            for (int n = 0; n < 2; ++n) bv[bj][n] = bias ? *(const f32x4*)(bias + bcol0 + bj * HALF + 4 * n) : (f32x4){0.f, 0.f, 0.f, 0.f};
#pragma unroll
        for (int ai = 0; ai < 2; ++ai)
#pragma unroll
            for (int m = 0; m < 4; ++m) { bf16_t* rowp = base + (size_t)(row0 + ai * HALF + m * 16) * ldc + col0;
#pragma unroll
                for (int bj = 0; bj < 2; ++bj) { f32x4 v0 = acc[ai][bj][m][0] + bv[bj][0], v1 = acc[ai][bj][m][1] + bv[bj][1];
                    if (ACT == 1) { f32x2 a = gelu_pk((f32x2){v0[0], v0[1]}), b = gelu_pk((f32x2){v0[2], v0[3]}), c = gelu_pk((f32x2){v1[0], v1[1]}), d = gelu_pk((f32x2){v1[2], v1[3]});
                        v0 = (f32x4){a.x, a.y, b.x, b.y}; v1 = (f32x4){c.x, c.y, d.x, d.y}; }
                    if (ACT == 2) {
#pragma unroll
                        for (int j = 0; j < 4; ++j) { v0[j] = 0.5f * v0[j] * (1.0f + erff(v0[j] * 0.70710678f)); v1[j] = 0.5f * v1[j] * (1.0f + erff(v1[j] * 0.70710678f)); } }
                    u32x4 w; w.x = cvt_pk_bf16(v0[0], v0[1]); w.y = cvt_pk_bf16(v0[2], v0[3]); w.z = cvt_pk_bf16(v1[0], v1[1]); w.w = cvt_pk_bf16(v1[2], v1[3]);
                    *(u32x4*)(rowp + bj * HALF) = w; } }
    }
};
template <class Epi, class Sched, bool STAMP = false>
__device__ __forceinline__ void gemm_phase(PG8_LAS unsigned char* lds, const Gemm g, const Sched& S, const Epi& E, unsigned long long* stamps) {
    const int tid = TIDX, wid = __builtin_amdgcn_readfirstlane(tid >> 6), lane = tid & 63, wr = wid >> 2, wc = wid & 3, fr = lane & 15, fq = lane >> 4;
    const int K = g.K, nt = K / BK;
    int ts_lo = 0, ts_hi = 0, nts = 0; const unsigned long long rt_entry = STAMP ? (unsigned long long)wall_clock64() : 0ull;
#define PG8_STAMP() do { if (STAMP && wid == 0 && nts < 64) { const unsigned long long _c = (unsigned long long)clock64(); \
        ts_lo = (lane == nts) ? (int)(unsigned)_c : ts_lo; ts_hi = (lane == nts) ? (int)(unsigned)(_c >> 32) : ts_hi; ++nts; } } while (0)
    PG8_STAMP();
    unsigned voffA[2], voffB[2];
#pragma unroll
    for (int i = 0; i < 2; ++i) { int R, C; stage_rc(tid * 16 + i * 8192, R, C); const int Rb = Epi::PERM ? ((R & ~31) + perm32(R & 31)) : R;
        voffA[i] = (unsigned)(R * K + C) * 2u; voffB[i] = (unsigned)(Rb * K + C) * 2u; }
    const size_t kstep = (size_t)(BK * 2);
    const size_t hstep = (size_t)HALF * K * 2;
    const size_t tstep = 2 * hstep;
    const unsigned ldsw = (unsigned)wid * 1024u;
    const int aoff = lds_byte(wr * 64 + fr, fq * 8), boff = lds_byte(wc * 32 + fr, fq * 8);
#define PG8_SA(b, h) (((b) * 2 + (h)) * HTB)
#define PG8_SB(b, h) ((4 + (b) * 2 + (h)) * HTB)
#define PG8_STAGE(bufoff, gbase, voff) do { _Pragma("unroll") for (int _i = 0; _i < 2; ++_i) \
        __builtin_amdgcn_global_load_lds((const unsigned*)((const char*)(gbase) + (voff)[_i]), (PG8_LAS unsigned*)(lds + (bufoff) + ldsw + _i * 8192), 16, 0, 0); } while (0)
#define PG8_LDA(dst, b, h) do { _Pragma("unroll") for (int m = 0; m < 4; ++m) _Pragma("unroll") for (int k = 0; k < 2; ++k) dst[m][k] = *(const PG8_LAS bf16x8*)(lds + PG8_SA(b, h) + aoff + m * 2048 + k * 1024); } while (0)
#define PG8_LDB(dst, b, h) do { _Pragma("unroll") for (int n = 0; n < 2; ++n) _Pragma("unroll") for (int k = 0; k < 2; ++k) dst[n][k] = *(const PG8_LAS bf16x8*)(lds + PG8_SB(b, h) + boff + n * 2048 + k * 1024); } while (0)
#define PG8_MMA(ai, bj, At, Bt) do { __builtin_amdgcn_s_setprio(1); _Pragma("unroll") for (int m = 0; m < 4; ++m) _Pragma("unroll") for (int n = 0; n < 2; ++n) _Pragma("unroll") for (int k = 0; k < 2; ++k) \
        acc[ai][bj][m][n] = __builtin_amdgcn_mfma_f32_16x16x32_bf16(Bt[n][k], At[m][k], acc[ai][bj][m][n], 0, 0, 0); __builtin_amdgcn_s_setprio(0); } while (0)
#define PG8_WAIT_V(n) asm volatile("s_waitcnt vmcnt(" #n ")" ::: "memory")
#define PG8_WAIT_L(n) asm volatile("s_waitcnt lgkmcnt(" #n ")" ::: "memory")
#define PG8_BAR __builtin_amdgcn_s_barrier()
#define PG8_SCHED __builtin_amdgcn_sched_barrier(0)
    Unit cur, nxt; int ui = 0;
    if (!S.next(0, cur)) return;
    f32x4 acc[2][2][4][2];
#pragma unroll
    for (int a = 0; a < 2; ++a)
#pragma unroll
        for (int b = 0; b < 2; ++b)
#pragma unroll
            for (int m = 0; m < 4; ++m)
#pragma unroll
                for (int n = 0; n < 2; ++n) acc[a][b][m][n] = (f32x4){0.f, 0.f, 0.f, 0.f};
    bf16x8 At[4][2], B0[2][2], B1[2][2];
    const char* cA = (const char*)g.A + (size_t)cur.pm * tstep; const char* cB = (const char*)g.Bt + (size_t)cur.pn * tstep;
    S.a_ready(cur);
    PG8_STAGE(PG8_SB(0, 0), cB, voffB); PG8_STAGE(PG8_SA(0, 0), cA, voffA); PG8_STAGE(PG8_SB(0, 1), cB + hstep, voffB); PG8_STAGE(PG8_SA(0, 1), cA + hstep, voffA);
    if (wr == 1) PG8_BAR;
    PG8_WAIT_V(4); PG8_BAR;
    PG8_STAGE(PG8_SB(1, 0), cB + kstep, voffB); PG8_STAGE(PG8_SA(1, 0), cA + kstep, voffA); PG8_STAGE(PG8_SB(1, 1), cB + hstep + kstep, voffB);
    PG8_WAIT_V(6); PG8_BAR;
    PG8_STAMP();
    for (;;) {
        const bool has_next = S.next(ui + 1, nxt);
        const char* nA = has_next ? (const char*)g.A + (size_t)nxt.pm * tstep : cA; const char* nB = has_next ? (const char*)g.Bt + (size_t)nxt.pn * tstep : cB;
        for (int t = 0; t < nt; t += 2) {
            const bool last = (t == nt - 2);
            const char* a1 = cA + (size_t)(t + 1) * kstep;
            const char* a2 = last ? nA : cA + (size_t)(t + 2) * kstep; const char* b2 = last ? nB : cB + (size_t)(t + 2) * kstep;
            const char* a3 = a2 + kstep; const char* b3 = b2 + kstep;
            if (last && has_next) S.a_ready(nxt);
            PG8_LDB(B0, 0, 0); PG8_SCHED; PG8_LDA(At, 0, 0); PG8_STAGE(PG8_SA(1, 1), a1 + hstep, voffA);
            PG8_WAIT_L(8); PG8_BAR; PG8_WAIT_L(0); PG8_MMA(0, 0, At, B0); PG8_BAR; PG8_SCHED;
            PG8_LDB(B1, 0, 1); PG8_STAGE(PG8_SB(0, 0), b2, voffB);
            PG8_BAR; PG8_WAIT_L(0); PG8_MMA(0, 1, At, B1); PG8_BAR;
            PG8_LDA(At, 0, 1); PG8_STAGE(PG8_SA(0, 0), a2, voffA);
            PG8_BAR; PG8_WAIT_L(0); PG8_MMA(1, 0, At, B0); PG8_BAR; PG8_SCHED;
            PG8_STAGE(PG8_SB(0, 1), b2 + hstep, voffB);
            PG8_WAIT_V(6); PG8_BAR; PG8_MMA(1, 1, At, B1); PG8_BAR;
            PG8_LDB(B0, 1, 0); PG8_SCHED; PG8_LDA(At, 1, 0); PG8_STAGE(PG8_SA(0, 1), a2 + hstep, voffA);
            PG8_WAIT_L(8); PG8_BAR; PG8_WAIT_L(0); PG8_MMA(0, 0, At, B0); PG8_BAR; PG8_SCHED;
            PG8_LDB(B1, 1, 1); PG8_STAGE(PG8_SB(1, 0), b3, voffB);
            PG8_BAR; PG8_WAIT_L(0); PG8_MMA(0, 1, At, B1); PG8_BAR;
            PG8_LDA(At, 1, 1); PG8_STAGE(PG8_SA(1, 0), a3, voffA);
            PG8_BAR; PG8_WAIT_L(0); PG8_MMA(1, 0, At, B0); PG8_BAR; PG8_SCHED;
            PG8_STAGE(PG8_SB(1, 1), b3 + hstep, voffB);
            PG8_WAIT_V(6); PG8_BAR; PG8_MMA(1, 1, At, B1); PG8_BAR;
        }
        PG8_STAMP();
        if constexpr (!Epi::AFTER_DRAIN) { E(acc, cur, wr, wc, fr, fq); S.done(cur); }
        PG8_STAMP();
        if (!has_next) break;
#pragma unroll
        for (int a = 0; a < 2; ++a)
#pragma unroll
            for (int b = 0; b < 2; ++b)
#pragma unroll
                for (int m = 0; m < 4; ++m)
#pragma unroll
                    for (int n = 0; n < 2; ++n) acc[a][b][m][n] = (f32x4){0.f, 0.f, 0.f, 0.f};
        cur = nxt; cA = nA; cB = nB; ++ui;
    }
    PG8_WAIT_V(0);
    if (wr == 0) PG8_BAR;
    PG8_BAR;
    if constexpr (Epi::AFTER_DRAIN) { E.fused(acc, cur, wr, wc, fr, fq, lds, wid, lane); S.done(cur); }
    PG8_STAMP();
    if (STAMP && wid == 0) { stamps[lane] = lane < nts ? (((unsigned long long)(unsigned)ts_hi << 32) | (unsigned)ts_lo) : 0ull;
        if (lane == 62) stamps[62] = rt_entry; if (lane == 63) stamps[63] = (unsigned long long)wall_clock64(); }
#undef PG8_STAMP
#undef PG8_SA
#undef PG8_SB
#undef PG8_STAGE
#undef PG8_LDA
#undef PG8_LDB
#undef PG8_MMA
#undef PG8_WAIT_V
#undef PG8_WAIT_L
#undef PG8_BAR
#undef PG8_SCHED
}
}
typedef unsigned short bf16_t;
constexpr int T_TOK = 32768, DM = 1024, D_IN = 4096, D_HY = 512, D_HG = 512, DFF = 4096, NLAYER = 4;
constexpr int L_BIG = 16384, L_SML = 4096;
constexpr int APAD = 256;
constexpr size_t MiB = 1024ull * 1024ull;
constexpr size_t OFF_W = 0;
constexpr size_t OFF_W_IN = OFF_W, OFF_W_OUT = OFF_W + 8 * MiB, OFF_W_UP = OFF_W + 10 * MiB, OFF_W_DN = OFF_W + 26 * MiB;
constexpr size_t OFF_ABUF = 34 * MiB;
constexpr size_t OFF_R1 = 99 * MiB;
constexpr size_t OFF_HYRAW = OFF_R1;
constexpr size_t OFF_HG = OFF_R1 + 96 * MiB;
constexpr size_t OFF_KT = OFF_R1;
constexpr size_t OFF_ACT = OFF_R1;
constexpr size_t OFF_R2 = 355 * MiB;
constexpr size_t OFF_X0T = OFF_R2, OFF_ZT = OFF_R2 + 32 * MiB;
constexpr size_t OFF_MIX = OFF_R2;
constexpr size_t OFF_UPART = OFF_R2;
constexpr size_t OFF_R6 = 419 * MiB;
constexpr size_t OFF_OBUF = OFF_R6;
constexpr size_t OFF_KS = OFF_R6;
constexpr size_t OFF_SMALL = 483 * MiB;
constexpr size_t WS_NEED = 484 * MiB;

struct P {
    const float *x_prompt, *x_sample, *norm_mix_pre, *norm_mix_post, *norm_ffn_pre, *norm_ffn_post, *w_in, *hy_conv_w, *hy_conv_b;
    const float *f_w1, *f_b1, *f_w2, *f_b2, *f_w3, *f_b3, *f_w4, *f_freq, *hy_skip, *hy_out_norm, *lb_table, *hg_out_norm, *w_out, *w_up, *ffn_conv_w, *ffn_conv_b, *w_down;
    float* out; unsigned char* ws;
};

__device__ __forceinline__ float bf2f(bf16_t b) { return __uint_as_float(((unsigned)b) << 16); }
__device__ __forceinline__ bf16_t f2bf(float f) { unsigned u = __float_as_uint(f); u += 0x7FFFu + ((u >> 16) & 1u); return (bf16_t)(u >> 16); }
__device__ __forceinline__ unsigned pack_bf2(float lo, float hi) { return (unsigned)f2bf(lo) | ((unsigned)f2bf(hi) << 16); }
__device__ __forceinline__ bool seq_start(int t) { return t < L_BIG ? (t == 0) : ((t & (L_SML - 1)) == 0); }
__device__ __forceinline__ bool seq_end(int t) { return (t + 1 == T_TOK) || seq_start(t + 1); }
__device__ __forceinline__ const float* x_src_row(const P& p, int l, int t) {
    if (l > 0) return p.out + (size_t)t * DM;
    return t < L_BIG ? p.x_prompt + (size_t)t * DM : p.x_sample + (size_t)(t - L_BIG) * DM;
}
__device__ __forceinline__ float silu_f(float x) { return x / (1.0f + __expf(-x)); }
__device__ __forceinline__ float wave_sum(float v) {
#pragma unroll
    for (int o = 32; o >= 1; o >>= 1) v += __shfl_xor(v, o);
    return v;
}

struct EpiBf16Split {
    static constexpr bool PERM = true, AFTER_DRAIN = false;
    bf16_t* O0; int ldc0; bf16_t* O1; int ldc1; int csplit;
    __device__ __forceinline__ void operator()(const pg8::f32x4 (&acc)[2][2][4][2], const pg8::Unit& u, int wr, int wc, int fr, int fq) const {
        const int row0 = u.pm * pg8::BM + wr * 64 + fr; int colt = u.pn * pg8::BM; bf16_t* base = O0; int ldc = ldc0;
        if (colt >= csplit) { base = O1; ldc = ldc1; colt -= csplit; }
        const int col0 = colt + wc * 32 + 8 * fq;
#pragma unroll
        for (int ai = 0; ai < 2; ++ai)
#pragma unroll
            for (int m = 0; m < 4; ++m) { bf16_t* rowp = base + (size_t)(row0 + ai * pg8::HALF + m * 16) * ldc + col0;
#pragma unroll
                for (int bj = 0; bj < 2; ++bj) { const pg8::f32x4 v0 = acc[ai][bj][m][0], v1 = acc[ai][bj][m][1];
                    pg8::u32x4 w; w.x = pg8::cvt_pk_bf16(v0[0], v0[1]); w.y = pg8::cvt_pk_bf16(v0[2], v0[3]); w.z = pg8::cvt_pk_bf16(v1[0], v1[1]); w.w = pg8::cvt_pk_bf16(v1[2], v1[3]);
                    *(pg8::u32x4*)(rowp + bj * pg8::HALF) = w; } }
    }
};
template <class Epi>
__device__ __forceinline__ void run_gemm(unsigned char* lds, const bf16_t* A, const bf16_t* Bt, int M, int N, int K, const Epi& E) {
    pg8::Gemm g; g.A = A; g.Bt = Bt; g.M = M; g.N = N; g.K = K;
    pg8::StaticOrder S; S.init(M, N, (int)gridDim.x, (int)blockIdx.x);
    pg8::gemm_phase<Epi, pg8::StaticOrder, false>((PG8_LAS unsigned char*)lds, g, S, E, nullptr);
}

#define HD_INLINE __device__ __forceinline__
#define DEV_FN __device__ __forceinline__
#define LDS_F2 float2*
#define NTHR 512
#define FOR_TID for (int tid = (int)TIDX, once_ = 1; once_; once_ = 0)
#define SYNC __syncthreads()
#define BREV32(x) __brev(x)
#define CIS_REV(fr, c, s) do { const float f_ = (fr); c = __builtin_amdgcn_cosf(f_); s = __builtin_amdgcn_sinf(f_); } while (0)
HD_INLINE unsigned rev4(unsigned k, int S) {
    unsigned v = BREV32(k) >> (32 - 2 * S);
    return ((v & 0xAAAAAAAAu) >> 1) | ((v & 0x55555555u) << 1);
}
HD_INLINE float2 cmul(float2 a, float2 b) { return make_float2(a.x * b.x - a.y * b.y, a.x * b.y + a.y * b.x); }
HD_INLINE float2 cmulc(float2 a, float2 b) { return make_float2(a.x * b.x + a.y * b.y, a.y * b.x - a.x * b.y); }

DEV_FN void fft_fwd(LDS_F2 X, int S, int s0) {
    const int M = 1 << (2 * S);
    for (int s = s0; s < S; ++s) {
        const int n = M >> (2 * s), q = n >> 2;
        const float invn = 1.0f / (float)n;
        FOR_TID {
            for (int b = tid; b < (M >> 2); b += NTHR) {
                const int j = b & (q - 1), base = ((b - j) << 2) + j;
                const float2 a0 = X[base], a1 = X[base + q], a2 = X[base + 2 * q], a3 = X[base + 3 * q];
                const float2 t0 = make_float2(a0.x + a2.x, a0.y + a2.y), t1 = make_float2(a0.x - a2.x, a0.y - a2.y);
                const float2 t2 = make_float2(a1.x + a3.x, a1.y + a3.y);
                const float2 d13 = make_float2(a1.x - a3.x, a1.y - a3.y);
                const float2 t3 = make_float2(d13.y, -d13.x);
                const float2 y0 = make_float2(t0.x + t2.x, t0.y + t2.y);
                float2 y1 = make_float2(t1.x + t3.x, t1.y + t3.y);
                float2 y2 = make_float2(t0.x - t2.x, t0.y - t2.y);
                float2 y3 = make_float2(t1.x - t3.x, t1.y - t3.y);
                if (q > 1) {
                    const float fr = (float)j * invn;
                    float c1, s1, c2, s2, c3, s3;
                    CIS_REV(fr, c1, s1); CIS_REV(2.0f * fr, c2, s2); CIS_REV(3.0f * fr, c3, s3);
                    y1 = cmul(y1, make_float2(c1, -s1)); y2 = cmul(y2, make_float2(c2, -s2)); y3 = cmul(y3, make_float2(c3, -s3));
                }
                X[base] = y0; X[base + q] = y1; X[base + 2 * q] = y2; X[base + 3 * q] = y3;
            }
        }
        SYNC;
    }
}
DEV_FN void fft_inv(LDS_F2 X, int S) {
    const int M = 1 << (2 * S);
    for (int s = S - 1; s >= 0; --s) {
        const int n = M >> (2 * s), q = n >> 2;
        const float invn = 1.0f / (float)n;
        FOR_TID {
            for (int b = tid; b < (M >> 2); b += NTHR) {
                const int j = b & (q - 1), base = ((b - j) << 2) + j;
                float2 b0 = X[base], b1 = X[base + q], b2 = X[base + 2 * q], b3 = X[base + 3 * q];
                if (q > 1) {
                    const float fr = (float)j * invn;
                    float c1, s1, c2, s2, c3, s3;
                    CIS_REV(fr, c1, s1); CIS_REV(2.0f * fr, c2, s2); CIS_REV(3.0f * fr, c3, s3);
                    b1 = cmul(b1, make_float2(c1, s1)); b2 = cmul(b2, make_float2(c2, s2)); b3 = cmul(b3, make_float2(c3, s3));
                }
                const float2 t0 = make_float2(b0.x + b2.x, b0.y + b2.y), t1 = make_float2(b0.x - b2.x, b0.y - b2.y);
                const float2 t2 = make_float2(b1.x + b3.x, b1.y + b3.y);
                const float2 d13 = make_float2(b1.x - b3.x, b1.y - b3.y);
                const float2 t3 = make_float2(-d13.y, d13.x);
                X[base] = make_float2(t0.x + t2.x, t0.y + t2.y);
                X[base + q] = make_float2(t1.x + t3.x, t1.y + t3.y);
                X[base + 2 * q] = make_float2(t0.x - t2.x, t0.y - t2.y);
                X[base + 3 * q] = make_float2(t1.x - t3.x, t1.y - t3.y);
            }
        }
        SYNC;
    }
}
DEV_FN void spec_store(LDS_F2 X, int S, float2* Ks) {
    const int M = 1 << (2 * S);
    FOR_TID {
        for (int k = tid; k <= (M >> 1); k += NTHR) {
            if (k == 0) { const float2 c0 = X[0]; Ks[0] = make_float2(c0.x + c0.y, c0.x - c0.y); }
            else {
                const float2 ck = X[rev4((unsigned)k, S)], cm = X[rev4((unsigned)(M - k), S)];
                const float2 P = make_float2(0.5f * (ck.x + cm.x), 0.5f * (ck.y - cm.y));
                const float2 O = make_float2(0.5f * (ck.y + cm.y), -0.5f * (ck.x - cm.x));
                float c, s; CIS_REV((float)k / (float)(2 * M), c, s);
                const float2 Q = cmul(O, make_float2(c, -s));
                Ks[k] = make_float2(P.x + Q.x, P.y + Q.y);
                Ks[M - k] = make_float2(P.x - Q.x, -(P.y - Q.y));
            }
        }
    }
    SYNC;
}
DEV_FN void spec_mul(LDS_F2 X, int S, const float2* Ks) {
    const int M = 1 << (2 * S);
    FOR_TID {
        for (int k = tid; k <= (M >> 1); k += NTHR) {
            if (k == 0) {
                const float2 c0 = X[0], k0 = Ks[0];
                const float y0 = (c0.x + c0.y) * k0.x, ym = (c0.x - c0.y) * k0.y;
                X[0] = make_float2(0.5f * (y0 + ym), 0.5f * (y0 - ym));
            } else {
                const unsigned pk = rev4((unsigned)k, S), pm = rev4((unsigned)(M - k), S);
                const float2 ck = X[pk], cm = X[pm];
                const float2 P = make_float2(0.5f * (ck.x + cm.x), 0.5f * (ck.y - cm.y));
                const float2 O = make_float2(0.5f * (ck.y + cm.y), -0.5f * (ck.x - cm.x));
                float c, s; CIS_REV((float)k / (float)(2 * M), c, s);
                const float2 Wk = make_float2(c, -s);
                const float2 Q = cmul(O, Wk);
                const float2 xk = make_float2(P.x + Q.x, P.y + Q.y), xm = make_float2(P.x - Q.x, -(P.y - Q.y));
                const float2 yk = cmul(xk, Ks[k]), ym = cmul(xm, Ks[M - k]);
                const float2 Ye = make_float2(0.5f * (yk.x + ym.x), 0.5f * (yk.y - ym.y));
                const float2 Yd = make_float2(0.5f * (yk.x - ym.x), 0.5f * (yk.y + ym.y));
                const float2 Yo = cmulc(Yd, Wk);
                X[pk] = make_float2(Ye.x - Yo.y, Ye.y + Yo.x);
                if (k != (M >> 1)) X[pm] = make_float2(Ye.x + Yo.y, -Ye.y + Yo.x);
            }
        }
    }
    SYNC;
}
__device__ void ph_setup(const P& p) {
    const int gid = blockIdx.x * 512 + TIDX;
    if (gid < 2 * D_HG) {
        const int dir = gid / D_HG, c = gid % D_HG;
        float v[NLAYER], mx = -1e30f;
#pragma unroll
        for (int l = 0; l < NLAYER; ++l) { v[l] = p.lb_table[(size_t)(dir * NLAYER + l) * D_HG + c]; mx = fmaxf(mx, v[l]); }
        float s = 0.f;
#pragma unroll
        for (int l = 0; l < NLAYER; ++l) { v[l] = expf(v[l] - mx); s += v[l]; }
        float* lbs = (float*)(p.ws + OFF_SMALL);
        float cum = 0.f;
#pragma unroll
        for (int l = 0; l < NLAYER; ++l) { if (l > 0) cum += v[l] / s; lbs[(size_t)(dir * NLAYER + l) * D_HG + c] = cum; }
    }
}
__device__ void convert_one(const float* src, bf16_t* dst, int K, int N, float* tile  ) {
    const int tiles_n = N / 64, ntiles = (K / 64) * tiles_n, tid = TIDX;
    for (int it = blockIdx.x; it < ntiles; it += gridDim.x) {
        const int k0 = (it / tiles_n) * 64, n0 = (it % tiles_n) * 64;
#pragma unroll
        for (int i = 0; i < 8; ++i) { const int r = (tid >> 6) + 8 * i, c = tid & 63; tile[r * 65 + c] = src[(size_t)(k0 + r) * N + n0 + c]; }
        __syncthreads();
#pragma unroll
        for (int i = 0; i < 8; ++i) { const int n = (tid >> 6) + 8 * i, k = tid & 63; dst[(size_t)(n0 + n) * K + k0 + k] = f2bf(tile[k * 65 + n]); }
        __syncthreads();
    }
}
__device__ void ph_convert_w(const P& p, int l, unsigned char* lds) {
    float* tile = (float*)lds;
    convert_one(p.w_in + (size_t)l * DM * D_IN, (bf16_t*)(p.ws + OFF_W_IN), DM, D_IN, tile);
    convert_one(p.w_out + (size_t)l * DM * DM, (bf16_t*)(p.ws + OFF_W_OUT), DM, DM, tile);
    convert_one(p.w_up + (size_t)l * DM * 2 * DFF, (bf16_t*)(p.ws + OFF_W_UP), DM, 2 * DFF, tile);
    convert_one(p.w_down + (size_t)l * DFF * DM, (bf16_t*)(p.ws + OFF_W_DN), DFF, DM, tile);
}
__device__ __forceinline__ bf16_t* abuf_row(const P& p, int t) { return (bf16_t*)(p.ws + OFF_ABUF) + (size_t)(t + APAD) * DM; }
__device__ void ph_rmsnorm_in(const P& p, int l) {
    const int lane = TIDX & 63, wv = TIDX >> 6;
    const float* gain = p.norm_mix_pre + (size_t)l * DM;
    for (int t = blockIdx.x * 8 + wv; t < T_TOK; t += gridDim.x * 8) {
        const float* xr = x_src_row(p, l, t);
        float4 v[4]; float ss = 0.f;
#pragma unroll
        for (int i = 0; i < 4; ++i) { v[i] = *(const float4*)(xr + lane * 4 + 256 * i); ss += v[i].x * v[i].x + v[i].y * v[i].y + v[i].z * v[i].z + v[i].w * v[i].w; }
        ss = wave_sum(ss);
        const float r = rsqrtf(ss * (1.0f / DM) + 1e-6f);
        bf16_t* hr = abuf_row(p, t);
#pragma unroll
        for (int i = 0; i < 4; ++i) { const float4 g = *(const float4*)(gain + lane * 4 + 256 * i);
            uint2 w; w.x = pack_bf2(v[i].x * r * g.x, v[i].y * r * g.y); w.y = pack_bf2(v[i].z * r * g.z, v[i].w * r * g.w);
            *(uint2*)(hr + lane * 4 + 256 * i) = w; }
    }
}
__device__ void ph_norm_resid(const P& p, int l, int which) {
    const int lane = TIDX & 63, wv = TIDX >> 6;
    const float* gpost = (which == 0 ? p.norm_mix_post : p.norm_ffn_post) + (size_t)l * DM;
    const bool has_next = (which == 0) || (l + 1 < NLAYER);
    const float* gnext = which == 0 ? p.norm_ffn_pre + (size_t)l * DM : p.norm_mix_pre + (size_t)(has_next ? l + 1 : l) * DM;
    const bf16_t* Y = (const bf16_t*)(p.ws + OFF_MIX);
    const int lx = which == 0 ? l : 1;
    for (int t = blockIdx.x * 8 + wv; t < T_TOK; t += gridDim.x * 8) {
        const float* xr = x_src_row(p, lx, t);
        const bf16_t* yr = Y + (size_t)t * DM;
        float4 x[4], y[4]; float ss = 0.f;
#pragma unroll
        for (int i = 0; i < 4; ++i) { x[i] = *(const float4*)(xr + lane * 4 + 256 * i); const uint2 w = *(const uint2*)(yr + lane * 4 + 256 * i);
            y[i].x = __uint_as_float(w.x << 16); y[i].y = __uint_as_float(w.x & 0xffff0000u); y[i].z = __uint_as_float(w.y << 16); y[i].w = __uint_as_float(w.y & 0xffff0000u);
            ss += y[i].x * y[i].x + y[i].y * y[i].y + y[i].z * y[i].z + y[i].w * y[i].w; }
        ss = wave_sum(ss);
        const float r = rsqrtf(ss * (1.0f / DM) + 1e-6f);
        float s2 = 0.f;
#pragma unroll
        for (int i = 0; i < 4; ++i) { const float4 g = *(const float4*)(gpost + lane * 4 + 256 * i);
            x[i].x += y[i].x * r * g.x; x[i].y += y[i].y * r * g.y; x[i].z += y[i].z * r * g.z; x[i].w += y[i].w * r * g.w;
            s2 += x[i].x * x[i].x + x[i].y * x[i].y + x[i].z * x[i].z + x[i].w * x[i].w;
            *(float4*)(p.out + (size_t)t * DM + lane * 4 + 256 * i) = x[i]; }
        if (has_next) {
            s2 = wave_sum(s2);
            const float r2 = rsqrtf(s2 * (1.0f / DM) + 1e-6f);
            bf16_t* hr = abuf_row(p, t);
#pragma unroll
            for (int i = 0; i < 4; ++i) { const float4 g = *(const float4*)(gnext + lane * 4 + 256 * i);
                uint2 w; w.x = pack_bf2(x[i].x * r2 * g.x, x[i].y * r2 * g.y); w.y = pack_bf2(x[i].z * r2 * g.z, x[i].w * r2 * g.w);
                *(uint2*)(hr + lane * 4 + 256 * i) = w; }
        }
    }
}
__device__ void ph_filter(const P& p, int l, unsigned char* lds) {
    float* feats = (float*)lds;
    float* ha = feats + 16 * 33;
    float* hb = ha + 16 * 64;
    const int tid = TIDX;
    const float* w1 = p.f_w1 + (size_t)l * 33 * 64; const float* b1 = p.f_b1 + (size_t)l * 64;
    const float* w2 = p.f_w2 + (size_t)l * 64 * 64; const float* b2 = p.f_b2 + (size_t)l * 64;
    const float* w3 = p.f_w3 + (size_t)l * 64 * 64; const float* b3 = p.f_b3 + (size_t)l * 64;
    const float* w4 = p.f_w4 + (size_t)l * 64 * 1024; const float* fq = p.f_freq + (size_t)l * 64;
    float* kt = (float*)(p.ws + OFF_KT);
    const int nitems = (L_BIG + L_SML) / 16;
    for (int it = blockIdx.x; it < nitems; it += gridDim.x) {
        const bool big = it < L_BIG / 16; const int L = big ? L_BIG : L_SML; const int pos0 = (big ? it : it - L_BIG / 16) * 16;
        float* ktc = kt + (big ? 0 : (size_t)512 * 2 * L_BIG);
        for (int idx = tid; idx < 16 * 33; idx += 512) {
            const int pp = idx / 33, f = idx % 33; const int pos = pos0 + pp;
            const float tt = (float)pos / (float)(L - 1), ang = (6.283185307179586f / (float)L) * (float)pos;
            float v;
            if (f == 0) v = tt;
            else { const int bi = (f - 1) & 15; const float band = 1e-4f + (float)bi * ((15.0f - 1e-4f) / 15.0f); v = f <= 16 ? cosf(band * ang) : -sinf(band * ang); }
            feats[idx] = v;
        }
        __syncthreads();
        for (int idx = tid; idx < 16 * 64; idx += 512) { const int pp = idx >> 6, j = idx & 63; float a = b1[j];
            for (int f = 0; f < 33; ++f) a += feats[pp * 33 + f] * w1[f * 64 + j];
            ha[idx] = sinf(fq[j] * a); }
        __syncthreads();
        for (int idx = tid; idx < 16 * 64; idx += 512) { const int pp = idx >> 6, j = idx & 63; float a = b2[j];
            for (int f = 0; f < 64; ++f) a += ha[pp * 64 + f] * w2[f * 64 + j];
            hb[idx] = sinf(fq[j] * a); }
        __syncthreads();
        for (int idx = tid; idx < 16 * 64; idx += 512) { const int pp = idx >> 6, j = idx & 63; float a = b3[j];
            for (int f = 0; f < 64; ++f) a += hb[pp * 64 + f] * w3[f * 64 + j];
            ha[idx] = sinf(fq[j] * a); }
        __syncthreads();
        for (int o = tid; o < 1024; o += 512) {
            float acc[16];
#pragma unroll
            for (int pp = 0; pp < 16; ++pp) acc[pp] = 0.f;
            for (int f = 0; f < 64; ++f) { const float w = w4[f * 1024 + o];
#pragma unroll
                for (int pp = 0; pp < 16; ++pp) acc[pp] += ha[pp * 64 + f] * w; }
            const int dir = o >> 9, c = o & 511;
            const float delta = 3.0701134573253945f + (float)c * ((15.350567286626972f - 3.0701134573253945f) / 511.0f);
            float* dst = ktc + (size_t)(c * 2 + dir) * L + pos0;
#pragma unroll
            for (int pp = 0; pp < 16; ++pp) { const float tt = (float)(pos0 + pp) / (float)(L - 1); dst[pp] = acc[pp] * expf(-tt * delta); }
        }
        __syncthreads();
    }
}
__device__ void ph_hy_prep(const P& p, int l, unsigned char* lds) {
    float* tx = (float*)lds;
    float* tz = tx + 64 * 65;
    const bf16_t* hy = (const bf16_t*)(p.ws + OFF_HYRAW);
    bf16_t* x0t = (bf16_t*)(p.ws + OFF_X0T); bf16_t* zt = (bf16_t*)(p.ws + OFF_ZT);
    const float* cw = p.hy_conv_w + (size_t)l * 3 * 1536; const float* cb = p.hy_conv_b + (size_t)l * 1536;
    const int tid = TIDX, nitems = (T_TOK / 64) * 8;
    for (int it = blockIdx.x; it < nitems; it += gridDim.x) {
        const int t0 = (it >> 3) * 64, c0 = (it & 7) * 64, c = tid & 63;
        float wv[3][3], bv[3];
#pragma unroll
        for (int a = 0; a < 3; ++a) { bv[a] = cb[a * 512 + c0 + c];
#pragma unroll
            for (int k = 0; k < 3; ++k) wv[a][k] = cw[k * 1536 + a * 512 + c0 + c]; }
#pragma unroll
        for (int i = 0; i < 8; ++i) {
            const int tt = (tid >> 6) + 8 * i, t = t0 + tt;
            const bool hp = !seq_start(t), hn = !seq_end(t);
            float r[3];
#pragma unroll
            for (int a = 0; a < 3; ++a) {
                const bf16_t* col = hy + (size_t)t * 1536 + a * 512 + c0 + c;
                const float xm = hp ? bf2f(col[-1536]) : 0.f, x0 = bf2f(col[0]), xp = hn ? bf2f(col[1536]) : 0.f;
                r[a] = xm * wv[a][0] + x0 * wv[a][1] + xp * wv[a][2] + bv[a];
            }
            tx[c * 65 + tt] = r[0]; tz[c * 65 + tt] = r[1] * r[2];
        }
        __syncthreads();
#pragma unroll
        for (int i = 0; i < 8; ++i) { const int cc = (tid >> 6) + 8 * i, tt = tid & 63;
            x0t[(size_t)(c0 + cc) * T_TOK + t0 + tt] = f2bf(tx[cc * 65 + tt]); zt[(size_t)(c0 + cc) * T_TOK + t0 + tt] = f2bf(tz[cc * 65 + tt]); }
        __syncthreads();
    }
}
__device__ __forceinline__ float2 ld_f2_agent(const float2* ptr) {
    const unsigned long long w = __hip_atomic_load((const unsigned long long*)ptr, __ATOMIC_RELAXED, __HIP_MEMORY_SCOPE_AGENT);
    return make_float2(__uint_as_float((unsigned)w), __uint_as_float((unsigned)(w >> 32)));
}
DEV_FN void spec_mul_g(LDS_F2 X, int S, const float2* Ks);
__device__ void ph_hy_fft(const P& p, int l, unsigned char* lds) {
    float2* X = (float2*)lds;
    const int tid = TIDX;
    float2* Ks = (float2*)(p.ws + OFF_KS) + (size_t)blockIdx.x * L_BIG;
    const float* kt = (const float*)(p.ws + OFF_KT);
    const bf16_t* x0t = (const bf16_t*)(p.ws + OFF_X0T); bf16_t* zt = (bf16_t*)(p.ws + OFF_ZT);
    for (int job = blockIdx.x; job < 1024; job += gridDim.x) {
        const bool big = job < 512; const int c = job & 511;
        const int L = big ? L_BIG : L_SML, S = big ? 7 : 6, M = L;
        const float* hf = kt + (big ? 0 : (size_t)512 * 2 * L_BIG) + (size_t)(c * 2) * L; const float* hb = hf + L;
        for (int m = tid; m < M; m += 512) {
            const int n0 = 2 * m, n1 = 2 * m + 1;
            const float a = n0 < L ? hf[n0] : (n0 == L ? 0.f : hb[2 * L - n0]);
            const float b = n1 < L ? hf[n1] : hb[2 * L - n1];
            X[m] = make_float2(a, b);
        }
        __syncthreads();
        fft_fwd(X, S, 0);
        spec_store(X, S, Ks);
        __threadfence(); __syncthreads();
        const float skip = p.hy_skip[(size_t)l * D_HY + c];
        const int nseq = big ? 1 : 4;
        for (int sq = 0; sq < nseq; ++sq) {
            const int t0 = big ? 0 : L_BIG + sq * L_SML;
            const bf16_t* zrow = zt + (size_t)c * T_TOK + t0; const bf16_t* xrow = x0t + (size_t)c * T_TOK + t0;
            for (int m = tid; m < M; m += 512) {
                float2 v = make_float2(0.f, 0.f);
                if (m < (M >> 1)) { const unsigned w = *(const unsigned*)(zrow + 2 * m); v.x = __uint_as_float(w << 16); v.y = __uint_as_float(w & 0xffff0000u); }
                X[m] = v;
            }
            __syncthreads();
            fft_fwd(X, S, 0);
            spec_mul_g(X, S, Ks);
            fft_inv(X, S);
            const float inv = 1.0f / (float)M;
            bf16_t* orow = zt + (size_t)c * T_TOK + t0;
            for (int m = tid; m < (M >> 1); m += 512) {
                const float2 d = X[m];
                const unsigned wz = *(const unsigned*)(zrow + 2 * m), wx = *(const unsigned*)(xrow + 2 * m);
                const float z0 = __uint_as_float(wz << 16), z1 = __uint_as_float(wz & 0xffff0000u), a0 = __uint_as_float(wx << 16), a1 = __uint_as_float(wx & 0xffff0000u);
                *(unsigned*)(orow + 2 * m) = pack_bf2(a0 * (d.x * inv + skip * z0), a1 * (d.y * inv + skip * z1));
            }
            __syncthreads();
        }
    }
}
DEV_FN void spec_mul_g(LDS_F2 X, int S, const float2* Ks) {
    const int M = 1 << (2 * S);
    for (int k = TIDX; k <= (M >> 1); k += NTHR) {
        if (k == 0) {
            const float2 c0 = X[0], k0 = ld_f2_agent(Ks);
            const float y0 = (c0.x + c0.y) * k0.x, ym = (c0.x - c0.y) * k0.y;
            X[0] = make_float2(0.5f * (y0 + ym), 0.5f * (y0 - ym));
        } else {
            const unsigned pk = rev4((unsigned)k, S), pm = rev4((unsigned)(M - k), S);
            const float2 ck = X[pk], cm = X[pm];
            const float2 Pv = make_float2(0.5f * (ck.x + cm.x), 0.5f * (ck.y - cm.y));
            const float2 O = make_float2(0.5f * (ck.y + cm.y), -0.5f * (ck.x - cm.x));
            float c, s; CIS_REV((float)k / (float)(2 * M), c, s);
            const float2 Wk = make_float2(c, -s);
            const float2 Q = cmul(O, Wk);
            const float2 xk = make_float2(Pv.x + Q.x, Pv.y + Q.y), xm = make_float2(Pv.x - Q.x, -(Pv.y - Q.y));
            const float2 yk = cmul(xk, ld_f2_agent(Ks + k)), ym = cmul(xm, ld_f2_agent(Ks + (M - k)));
            const float2 Ye = make_float2(0.5f * (yk.x + ym.x), 0.5f * (yk.y - ym.y));
            const float2 Yd = make_float2(0.5f * (yk.x - ym.x), 0.5f * (yk.y + ym.y));
            const float2 Yo = cmulc(Yd, Wk);
            X[pk] = make_float2(Ye.x - Yo.y, Ye.y + Yo.x);
            if (k != (M >> 1)) X[pm] = make_float2(Ye.x + Yo.y, -Ye.y + Yo.x);
        }
    }
    __syncthreads();
}
__device__ void ph_hy_norm(const P& p, int l, unsigned char* lds) {
    float* tl = (float*)lds;
    float* red = tl + 64 * 65;
    const bf16_t* yh = (const bf16_t*)(p.ws + OFF_ZT);
    const float* gain = p.hy_out_norm + (size_t)l * D_HY;
    const int tid = TIDX, nitems = (T_TOK / 64) * 8;
    for (int it = blockIdx.x; it < nitems; it += gridDim.x) {
        const int t0 = (it >> 3) * 64, c0 = (it & 7) * 64;
#pragma unroll
        for (int i = 0; i < 8; ++i) { const int cc = (tid >> 6) + 8 * i, tt = tid & 63; tl[cc * 65 + tt] = bf2f(yh[(size_t)(c0 + cc) * T_TOK + t0 + tt]); }
        __syncthreads();
        { const int tt = tid & 63, part = tid >> 6; float s = 0.f;
#pragma unroll
          for (int j = 0; j < 8; ++j) { const float v = tl[(part * 8 + j) * 65 + tt]; s += v * v; }
          red[part * 64 + tt] = s; }
        __syncthreads();
#pragma unroll
        for (int i = 0; i < 8; ++i) { const int tt = (tid >> 6) + 8 * i, cc = tid & 63;
            float s = 0.f;
#pragma unroll
            for (int j = 0; j < 8; ++j) s += red[j * 64 + tt];
            const float r = rsqrtf(s * (1.0f / 64.0f) + 1e-6f);
            abuf_row(p, t0 + tt)[c0 + cc] = f2bf(tl[cc * 65 + tt] * r * gain[c0 + cc]); }
        __syncthreads();
    }
}
__device__ void ph_hgrn_naive(const P& p, int l, unsigned char* lds) {
    float* sq = (float*)lds;
    float* sf = sq + 2 * 16 * 128;
    const bf16_t* hg = (const bf16_t*)(p.ws + OFF_HG);
    bf16_t* obuf = (bf16_t*)(p.ws + OFF_OBUF);
    const float* lbs = (const float*)(p.ws + OFF_SMALL);
    const int tid = TIDX;
    for (int it = blockIdx.x; it < 20; it += gridDim.x) {
        const int sqi = it >> 2, h = it & 3;
        const int t0 = sqi == 0 ? 0 : L_BIG + (sqi - 1) * L_SML, L = sqi == 0 ? L_BIG : L_SML;
        const int dir = (tid >> 7) & 1, e = tid & 127;
        const bool act = tid < 256;
        const float lb = act ? lbs[(size_t)(dir * NLAYER + l) * D_HG + h * 128 + e] : 0.f;
        float S[128];
#pragma unroll
        for (int d = 0; d < 128; ++d) S[d] = 0.f;
        for (int b = 0; b < L / 16; ++b) {
            if (act) {
#pragma unroll 4
                for (int j = 0; j < 16; ++j) {
                    const int u = b * 16 + j, tok = dir ? t0 + L - 1 - u : t0 + u;
                    const bf16_t* row = hg + (size_t)tok * 2560 + h * 128 + e;
                    const float zq = bf2f(row[0]), zf = bf2f(row[dir ? 1024 : 512]);
                    sq[(dir * 16 + j) * 128 + e] = silu_f(zq);
                    sf[(dir * 16 + j) * 128 + e] = lb + (1.0f - lb) / (1.0f + __expf(-zf));
                }
            }
            __syncthreads();
            if (act) {
                for (int j = 0; j < 16; ++j) {
                    const int u = b * 16 + j, tok = dir ? t0 + L - 1 - u : t0 + u;
                    const float v = bf2f(hg[(size_t)tok * 2560 + 1536 + h * 128 + e]);
                    const float4* q4 = (const float4*)(sq + (dir * 16 + j) * 128); const float4* f4 = (const float4*)(sf + (dir * 16 + j) * 128);
                    float o = 0.f;
#pragma unroll
                    for (int d4 = 0; d4 < 32; ++d4) { const float4 q = q4[d4], f = f4[d4];
                        S[4 * d4 + 0] = f.x * S[4 * d4 + 0] + (1.0f - f.x) * v; o += S[4 * d4 + 0] * q.x;
                        S[4 * d4 + 1] = f.y * S[4 * d4 + 1] + (1.0f - f.y) * v; o += S[4 * d4 + 1] * q.y;
                        S[4 * d4 + 2] = f.z * S[4 * d4 + 2] + (1.0f - f.z) * v; o += S[4 * d4 + 2] * q.z;
                        S[4 * d4 + 3] = f.w * S[4 * d4 + 3] + (1.0f - f.w) * v; o += S[4 * d4 + 3] * q.w; }
                    obuf[((size_t)dir * T_TOK + tok) * D_HG + h * 128 + e] = f2bf(o);
                }
            }
            __syncthreads();
        }
    }
}
__device__ void ph_hg_norm(const P& p, int l) {
    const int lane = TIDX & 63, wv = TIDX >> 6;
    const bf16_t* hg = (const bf16_t*)(p.ws + OFF_HG); const bf16_t* obuf = (const bf16_t*)(p.ws + OFF_OBUF);
    const float* gain = p.hg_out_norm + (size_t)l * D_HG;
    for (int it = blockIdx.x * 8 + wv; it < T_TOK * 4; it += gridDim.x * 8) {
        const int t = it >> 2, h = it & 3, e = h * 128 + lane * 2;
        const unsigned wf = *(const unsigned*)(obuf + (size_t)t * D_HG + e), wb = *(const unsigned*)(obuf + ((size_t)T_TOK + t) * D_HG + e);
        const float o0 = __uint_as_float(wf << 16) + __uint_as_float(wb << 16), o1 = __uint_as_float(wf & 0xffff0000u) + __uint_as_float(wb & 0xffff0000u);
        const float ss = wave_sum(o0 * o0 + o1 * o1);
        const float r = rsqrtf(ss * (1.0f / 128.0f) + 1e-6f);
        const unsigned wg = *(const unsigned*)(hg + (size_t)t * 2560 + 2048 + e);
        const float g0 = silu_f(__uint_as_float(wg << 16)), g1 = silu_f(__uint_as_float(wg & 0xffff0000u));
        *(unsigned*)(abuf_row(p, t) + 512 + e) = pack_bf2(o0 * r * gain[e] * g0, o1 * r * gain[e + 1] * g1);
    }
}
__device__ __forceinline__ float gelu_tanh_f(float x) { const float y = 0.7978845608028654f * (x + 0.044715f * x * x * x); return x / (1.0f + __expf(-2.0f * y)); }
__device__ void ph_geglu_part(const P& p, int l, int r0) {
    const bf16_t* up = (const bf16_t*)(p.ws + OFF_UPART);
    bf16_t* act = (bf16_t*)(p.ws + OFF_ACT);
    const float* cw = p.ffn_conv_w + (size_t)l * 3 * 8192; const float* cb = p.ffn_conv_b + (size_t)l * 8192;
    const size_t total = (size_t)4096 * (DFF / 2);
    for (size_t idx = (size_t)blockIdx.x * 512 + TIDX; idx < total; idx += (size_t)gridDim.x * 512) {
        const int tt = (int)(idx / (DFF / 2)), j = (int)(idx % (DFF / 2)) * 2, t = r0 + tt;
        const bool hp = !seq_start(t), hn = !seq_end(t);
        const bf16_t* row = up + (size_t)(tt + 256) * 8192;
        float res[2][2];
#pragma unroll
        for (int half = 0; half < 2; ++half) {
            const int col = half * DFF + j;
            const unsigned w0 = *(const unsigned*)(row + col), wm = hp ? *(const unsigned*)(row - 8192 + col) : 0u, wp = hn ? *(const unsigned*)(row + 8192 + col) : 0u;
#pragma unroll
            for (int q = 0; q < 2; ++q) {
                const float xm = q ? __uint_as_float(wm & 0xffff0000u) : __uint_as_float(wm << 16), x0 = q ? __uint_as_float(w0 & 0xffff0000u) : __uint_as_float(w0 << 16), xp = q ? __uint_as_float(wp & 0xffff0000u) : __uint_as_float(wp << 16);
                res[half][q] = xm * cw[col + q] + x0 * cw[8192 + col + q] + xp * cw[2 * 8192 + col + q] + cb[col + q];
            }
        }
        *(unsigned*)(act + (size_t)t * DFF + j) = pack_bf2(gelu_tanh_f(res[0][0]) * res[1][0], gelu_tanh_f(res[0][1]) * res[1][1]);
    }
}
enum { PH_SETUP, PH_CONVERT, PH_RMS_IN, PH_GEMM_IN, PH_HY_PREP, PH_FILTER, PH_HGRN, PH_HG_NORM, PH_HY_FFT, PH_HY_NORM, PH_GEMM_OUT, PH_NR0, PH_GEMM_UP, PH_GEGLU, PH_GEMM_DN, PH_NR1 };
template <int PH> __device__ __forceinline__ void run_phase(const P& p, int l, int part, unsigned char* lds) {
    if constexpr (PH == PH_SETUP) ph_setup(p);
    if constexpr (PH == PH_CONVERT) ph_convert_w(p, l, lds);
    if constexpr (PH == PH_RMS_IN) ph_rmsnorm_in(p, l);
    if constexpr (PH == PH_GEMM_IN) { EpiBf16Split E; E.O0 = (bf16_t*)(p.ws + OFF_HYRAW); E.ldc0 = 1536; E.O1 = (bf16_t*)(p.ws + OFF_HG); E.ldc1 = 2560; E.csplit = 1536;
        run_gemm(lds, abuf_row(p, 0), (const bf16_t*)(p.ws + OFF_W_IN), T_TOK, D_IN, DM, E); }
    if constexpr (PH == PH_HY_PREP) ph_hy_prep(p, l, lds);
    if constexpr (PH == PH_FILTER) ph_filter(p, l, lds);
    if constexpr (PH == PH_HGRN) ph_hgrn_naive(p, l, lds);
    if constexpr (PH == PH_HG_NORM) ph_hg_norm(p, l);
    if constexpr (PH == PH_HY_FFT) ph_hy_fft(p, l, lds);
    if constexpr (PH == PH_HY_NORM) ph_hy_norm(p, l, lds);
    if constexpr (PH == PH_GEMM_OUT) { EpiBf16Split E; E.O0 = (bf16_t*)(p.ws + OFF_MIX); E.ldc0 = DM; E.O1 = E.O0; E.ldc1 = DM; E.csplit = 1 << 30;
        run_gemm(lds, abuf_row(p, 0), (const bf16_t*)(p.ws + OFF_W_OUT), T_TOK, DM, DM, E); }
    if constexpr (PH == PH_NR0) ph_norm_resid(p, l, 0);
    if constexpr (PH == PH_GEMM_UP) { EpiBf16Split E; E.O0 = (bf16_t*)(p.ws + OFF_UPART); E.ldc0 = 2 * DFF; E.O1 = E.O0; E.ldc1 = 2 * DFF; E.csplit = 1 << 30;
        run_gemm(lds, abuf_row(p, part * 4096 - 256), (const bf16_t*)(p.ws + OFF_W_UP), 4608, 2 * DFF, DM, E); }
    if constexpr (PH == PH_GEGLU) ph_geglu_part(p, l, part * 4096);
    if constexpr (PH == PH_GEMM_DN) { EpiBf16Split E; E.O0 = (bf16_t*)(p.ws + OFF_MIX); E.ldc0 = DM; E.O1 = E.O0; E.ldc1 = DM; E.csplit = 1 << 30;
        run_gemm(lds, (const bf16_t*)(p.ws + OFF_ACT), (const bf16_t*)(p.ws + OFF_W_DN), T_TOK, DM, DFF, E); }
    if constexpr (PH == PH_NR1) ph_norm_resid(p, l, 1);
}
constexpr int LDS_BYTES = 131072;
__global__ __launch_bounds__(512, 2) void mega(P p) {
    extern __shared__ __attribute__((aligned(16))) unsigned char lds[];
    cg::grid_group grid = cg::this_grid();
    run_phase<PH_SETUP>(p, 0, 0, lds);
    run_phase<PH_CONVERT>(p, 0, 0, lds);
    run_phase<PH_RMS_IN>(p, 0, 0, lds);
    grid.sync();
#pragma unroll 1
    for (int l = 0; l < NLAYER; ++l) {
        run_phase<PH_GEMM_IN>(p, l, 0, lds); grid.sync();
        run_phase<PH_HY_PREP>(p, l, 0, lds); run_phase<PH_HGRN>(p, l, 0, lds); grid.sync();
        run_phase<PH_FILTER>(p, l, 0, lds); run_phase<PH_HG_NORM>(p, l, 0, lds); grid.sync();
        run_phase<PH_HY_FFT>(p, l, 0, lds); grid.sync();
        run_phase<PH_HY_NORM>(p, l, 0, lds); grid.sync();
        run_phase<PH_GEMM_OUT>(p, l, 0, lds); grid.sync();
        run_phase<PH_NR0>(p, l, 0, lds); grid.sync();
#pragma unroll 1
        for (int part = 0; part < 8; ++part) { run_phase<PH_GEMM_UP>(p, l, part, lds); grid.sync(); run_phase<PH_GEGLU>(p, l, part, lds); grid.sync(); }
        run_phase<PH_GEMM_DN>(p, l, 0, lds); grid.sync();
        run_phase<PH_NR1>(p, l, 0, lds);
        if (l + 1 < NLAYER) { run_phase<PH_CONVERT>(p, l + 1, 0, lds); grid.sync(); }
    }
}
extern "C" void kernel_launch(void* const* d_in, const int* in_sizes, int n_in, void* d_out, int out_size, void* d_ws, size_t ws_size, hipStream_t stream) {
    if (ws_size < WS_NEED) { fprintf(stderr, "workspace too small: %zu < %zu\n", ws_size, (size_t)WS_NEED); return; }
    static int grid_blocks = 0;
    if (!grid_blocks) {
        hipFuncSetAttribute((const void*)mega, hipFuncAttributeMaxDynamicSharedMemorySize, LDS_BYTES);
        int dev = 0, cus = 0, per_cu = 0;
        hipGetDevice(&dev);
        hipDeviceGetAttribute(&cus, hipDeviceAttributeMultiprocessorCount, dev);
        hipOccupancyMaxActiveBlocksPerMultiprocessor(&per_cu, mega, 512, LDS_BYTES);
        if (per_cu > 1) per_cu = 1;
        grid_blocks = cus * per_cu;
    }
    P p{};
    p.x_prompt = (const float*)d_in[0]; p.x_sample = (const float*)d_in[1]; p.norm_mix_pre = (const float*)d_in[2]; p.norm_mix_post = (const float*)d_in[3];
    p.norm_ffn_pre = (const float*)d_in[4]; p.norm_ffn_post = (const float*)d_in[5]; p.w_in = (const float*)d_in[6]; p.hy_conv_w = (const float*)d_in[7]; p.hy_conv_b = (const float*)d_in[8];
    p.f_w1 = (const float*)d_in[9]; p.f_b1 = (const float*)d_in[10]; p.f_w2 = (const float*)d_in[11]; p.f_b2 = (const float*)d_in[12]; p.f_w3 = (const float*)d_in[13]; p.f_b3 = (const float*)d_in[14];
    p.f_w4 = (const float*)d_in[15]; p.f_freq = (const float*)d_in[16]; p.hy_skip = (const float*)d_in[17]; p.hy_out_norm = (const float*)d_in[18]; p.lb_table = (const float*)d_in[19];
    p.hg_out_norm = (const float*)d_in[20]; p.w_out = (const float*)d_in[21]; p.w_up = (const float*)d_in[22]; p.ffn_conv_w = (const float*)d_in[23]; p.ffn_conv_b = (const float*)d_in[24]; p.w_down = (const float*)d_in[25];
    p.out = (float*)d_out; p.ws = (unsigned char*)d_ws;
    void* args[] = {&p};
    hipError_t e = hipLaunchCooperativeKernel((void*)mega, dim3(grid_blocks), dim3(512), args, LDS_BYTES, stream);
    if (e != hipSuccess) fprintf(stderr, "cooperative launch failed: %s (grid %d)\n", hipGetErrorString(e), grid_blocks);
}
```

```cpp
#include <hip/hip_runtime.h>
#include <hip/hip_cooperative_groups.h>
#include <cstdio>
#include <cstdint>
namespace cg = cooperative_groups;
__device__ __forceinline__ int tid_opaque() { int t = (int)threadIdx.x; asm volatile("" : "+v"(t)); return t; }
#define TIDX tid_opaque()
namespace pg8 {
#define PG8_LAS __attribute__((address_space(3)))
typedef unsigned short bf16_t;
typedef short bf16x8 __attribute__((ext_vector_type(8)));
typedef float f32x4 __attribute__((ext_vector_type(4)));
typedef unsigned u32x4 __attribute__((ext_vector_type(4)));
constexpr int BM = 256, BK = 64, HALF = 128, HTB = HALF * BK * 2  , STAGE_BYTES = 8 * HTB, NXCD = 8, WGM = 8;

__host__ __device__ __forceinline__ int lds_byte(int r, int c) { const int st = (r >> 4) * 2 + (c >> 5), rr = r & 15, cc = c & 31, ob = rr * 64 + cc * 2; return st * 1024 + (ob ^ (((ob >> 9) & 1) << 5)); }
__host__ __device__ __forceinline__ void stage_rc(int b, int& R, int& C) { const int st = b / 1024, sb = b % 1024, swz = sb ^ (((sb >> 9) & 1) << 5); R = (st >> 1) * 16 + swz / 64; C = (st & 1) * 32 + (swz % 64) / 2; }
__host__ __device__ __forceinline__ int perm32(int rho) { const int n = rho >> 4, i = rho & 15; return 8 * (i >> 2) + 4 * n + (i & 3); }

struct Unit { int pm, pn; };
struct Gemm { const bf16_t* A; const bf16_t* Bt; int M, N, K; };

struct StaticOrder {
    int nM, nN, nwg, G, c;
    __host__ __device__ void init(int M, int N, int G_, int c_) { nM = M / BM; nN = N / BM; nwg = nM * nN; G = G_; c = c_; }
    __host__ __device__ bool next(int i, Unit& u) const {
        const long L = (long)i * G + c; if (L >= nwg) return false;
        int wgid = (int)L; { const int q = nwg / NXCD, r = nwg % NXCD, xcd = wgid % NXCD, off = wgid / NXCD; wgid = (xcd < r ? xcd * (q + 1) : r * (q + 1) + (xcd - r) * q) + off; }
        const int nig = WGM * nN, gid = wgid / nig, fm = gid * WGM, gsz = (nM - fm) < WGM ? (nM - fm) : WGM;
        u.pm = fm + ((wgid % nig) % gsz); u.pn = (wgid % nig) / gsz; return true;
    }
    __device__ __forceinline__ void a_ready(const Unit&) const {}
    __device__ __forceinline__ void done(const Unit&) const {}
};
struct CountedOrder : StaticOrder {
    const unsigned* ready; unsigned need; unsigned* tmo;
    __device__ __forceinline__ void a_ready(const Unit& u) const {
        if (TIDX < 64) {
            const unsigned long long t0 = __builtin_amdgcn_s_memrealtime(); unsigned polls = 0;
            while ((unsigned)__builtin_amdgcn_readfirstlane(__hip_atomic_load(ready + 64 * u.pm, __ATOMIC_RELAXED, __HIP_MEMORY_SCOPE_AGENT)) < need) {
                if ((++polls & 255u) == 0u && __builtin_amdgcn_readfirstlane(__hip_atomic_load(tmo, __ATOMIC_RELAXED, __HIP_MEMORY_SCOPE_AGENT)) != 0u) break;
                if (__builtin_amdgcn_s_memrealtime() - t0 > 2000000ull) {
                    if (TIDX == 0) { unsigned expect = 0u; __hip_atomic_compare_exchange_strong(tmo + 1, &expect, 0x600u | (unsigned)(u.pm & 0xff), __ATOMIC_RELAXED, __ATOMIC_RELAXED, __HIP_MEMORY_SCOPE_AGENT); __hip_atomic_store(tmo, 1u, __ATOMIC_RELAXED, __HIP_MEMORY_SCOPE_AGENT); }
                    break; }
                __builtin_amdgcn_s_sleep(2); }
            __builtin_amdgcn_fence(__ATOMIC_ACQUIRE, "agent");
            asm volatile("s_waitcnt vmcnt(0)" ::: "memory");
        }
#if !defined(BROKEN_HOOK_NO_BARRIER)
        asm volatile("" ::: "memory"); __builtin_amdgcn_s_barrier(); asm volatile("" ::: "memory");
#endif
    }
};

__device__ __forceinline__ unsigned cvt_pk_bf16(float lo, float hi) { unsigned r; asm volatile("v_cvt_pk_bf16_f32 %0, %1, %2" : "=v"(r) : "v"(lo), "v"(hi)); return r; }
typedef float f32x2 __attribute__((ext_vector_type(2)));
__device__ __forceinline__ f32x2 gelu_pk(f32x2 v) {
    const f32x2 av = __builtin_elementwise_abs(v), d = av * 0.2316418882f + 1.0f;
    f32x2 t; t.x = __builtin_amdgcn_rcpf(d.x); t.y = __builtin_amdgcn_rcpf(d.y);
    f32x2 q = t * 0.5307027145f + (-0.7265760135f); q = q * t + 0.7107068705f; q = q * t + (-0.142248368f); q = q * t + 0.127414796f; q = q * t;
    const f32x2 s = (v * v) * (-0.72134752044f);
    f32x2 e; e.x = __builtin_amdgcn_exp2f(s.x); e.y = __builtin_amdgcn_exp2f(s.y);
    const f32x2 m = v * (q * e), r = v - m;
    f32x2 o; o.x = v.x < 0.f ? m.x : r.x; o.y = v.y < 0.f ? m.y : r.y; return o;
}

struct EpiF32 {
    static constexpr bool PERM = false, AFTER_DRAIN = false;
    float* C; int ldc; const float* bias;
    __device__ __forceinline__ void operator()(const f32x4 (&acc)[2][2][4][2], const Unit& u, int wr, int wc, int fr, int fq) const {
        const int row0 = u.pm * BM + wr * 64 + fr, col0 = u.pn * BM + wc * 32 + 4 * fq;
        f32x4 bv[2][2];
#pragma unroll
        for (int bj = 0; bj < 2; ++bj)
#pragma unroll
            for (int n = 0; n < 2; ++n) bv[bj][n] = bias ? *(const f32x4*)(bias + col0 + bj * HALF + n * 16) : (f32x4){0.f, 0.f, 0.f, 0.f};
#pragma unroll
        for (int ai = 0; ai < 2; ++ai)
#pragma unroll
            for (int m = 0; m < 4; ++m) { float* rowp = C + (size_t)(row0 + ai * HALF + m * 16) * ldc + col0;
#pragma unroll
                for (int bj = 0; bj < 2; ++bj)
#pragma unroll
                    for (int n = 0; n < 2; ++n) *(f32x4*)(rowp + bj * HALF + n * 16) = acc[ai][bj][m][n] + bv[bj][n]; }
    }
};
template <int ACT  > struct EpiBf16 {
    static constexpr bool PERM = true, AFTER_DRAIN = false;
    bf16_t* O; int ldc; const float* bias; int split_cols; size_t split_stride;
    __device__ __forceinline__ void operator()(const f32x4 (&acc)[2][2][4][2], const Unit& u, int wr, int wc, int fr, int fq) const {
        const int row0 = u.pm * BM + wr * 64 + fr; int colt = u.pn * BM; bf16_t* base = O;
        if (split_cols) { const int t = colt / split_cols; base += (size_t)t * split_stride; colt -= t * split_cols; }
        const int col0 = colt + wc * 32 + 8 * fq, bcol0 = u.pn * BM + wc * 32 + 8 * fq;
        f32x4 bv[2][2];
#pragma unroll
        for (int bj = 0; bj < 2; ++bj)
#pragma unroll
            for (int n = 0; n < 2; ++n) bv[bj][n] = bias ? *(const f32x4*)(bias + bcol0 + bj * HALF + 4 * n) : (f32x4){0.f, 0.f, 0.f, 0.f};
#pragma unroll
        for (int ai = 0; ai < 2; ++ai)
#pragma unroll
            for (int m = 0; m < 4; ++m) { bf16_t* rowp = base + (size_t)(row0 + ai * HALF + m * 16) * ldc + col0;
#pragma unroll
                for (int bj = 0; bj < 2; ++bj) { f32x4 v0 = acc[ai][bj][m][0] + bv[bj][0], v1 = acc[ai][bj][m][1] + bv[bj][1];
                    if (ACT == 1) { f32x2 a = gelu_pk((f32x2){v0[0], v0[1]}), b = gelu_pk((f32x2){v0[2], v0[3]}), c = gelu_pk((f32x2){v1[0], v1[1]}), d = gelu_pk((f32x2){v1[2], v1[3]});
                        v0 = (f32x4){a.x, a.y, b.x, b.y}; v1 = (f32x4){c.x, c.y, d.x, d.y}; }
                    if (ACT == 2) {
#pragma unroll
                        for (int j = 0; j < 4; ++j) { v0[j] = 0.5f * v0[j] * (1.0f + erff(v0[j] * 0.70710678f)); v1[j] = 0.5f * v1[j] * (1.0f + erff(v1[j] * 0.70710678f)); } }
                    u32x4 w; w.x = cvt_pk_bf16(v0[0], v0[1]); w.y = cvt_pk_bf16(v0[2], v0[3]); w.z = cvt_pk_bf16(v1[0], v1[1]); w.w = cvt_pk_bf16(v1[2], v1[3]);
                    *(u32x4*)(rowp + bj * HALF) = w; } }
    }
};
template <class Epi, class Sched, bool STAMP = false>
__device__ __forceinline__ void gemm_phase(PG8_LAS unsigned char* lds, const Gemm g, const Sched& S, const Epi& E, unsigned long long* stamps) {
    const int tid = TIDX, wid = __builtin_amdgcn_readfirstlane(tid >> 6), lane = tid & 63, wr = wid >> 2, wc = wid & 3, fr = lane & 15, fq = lane >> 4;
    const int K = g.K, nt = K / BK;
    int ts_lo = 0, ts_hi = 0, nts = 0; const unsigned long long rt_entry = STAMP ? (unsigned long long)wall_clock64() : 0ull;
#define PG8_STAMP() do { if (STAMP && wid == 0 && nts < 64) { const unsigned long long _c = (unsigned long long)clock64(); \
        ts_lo = (lane == nts) ? (int)(unsigned)_c : ts_lo; ts_hi = (lane == nts) ? (int)(unsigned)(_c >> 32) : ts_hi; ++nts; } } while (0)
    PG8_STAMP();
    unsigned voffA[2], voffB[2];
#pragma unroll
    for (int i = 0; i < 2; ++i) { int R, C; stage_rc(tid * 16 + i * 8192, R, C); const int Rb = Epi::PERM ? ((R & ~31) + perm32(R & 31)) : R;
        voffA[i] = (unsigned)(R * K + C) * 2u; voffB[i] = (unsigned)(Rb * K + C) * 2u; }
    const size_t kstep = (size_t)(BK * 2);
    const size_t hstep = (size_t)HALF * K * 2;
    const size_t tstep = 2 * hstep;
    const unsigned ldsw = (unsigned)wid * 1024u;
    const int aoff = lds_byte(wr * 64 + fr, fq * 8), boff = lds_byte(wc * 32 + fr, fq * 8);
#define PG8_SA(b, h) (((b) * 2 + (h)) * HTB)
#define PG8_SB(b, h) ((4 + (b) * 2 + (h)) * HTB)
#define PG8_STAGE(bufoff, gbase, voff) do { _Pragma("unroll") for (int _i = 0; _i < 2; ++_i) \
        __builtin_amdgcn_global_load_lds((const unsigned*)((const char*)(gbase) + (voff)[_i]), (PG8_LAS unsigned*)(lds + (bufoff) + ldsw + _i * 8192), 16, 0, 0); } while (0)
#define PG8_LDA(dst, b, h) do { _Pragma("unroll") for (int m = 0; m < 4; ++m) _Pragma("unroll") for (int k = 0; k < 2; ++k) dst[m][k] = *(const PG8_LAS bf16x8*)(lds + PG8_SA(b, h) + aoff + m * 2048 + k * 1024); } while (0)
#define PG8_LDB(dst, b, h) do { _Pragma("unroll") for (int n = 0; n < 2; ++n) _Pragma("unroll") for (int k = 0; k < 2; ++k) dst[n][k] = *(const PG8_LAS bf16x8*)(lds + PG8_SB(b, h) + boff + n * 2048 + k * 1024); } while (0)
#define PG8_MMA(ai, bj, At, Bt) do { __builtin_amdgcn_s_setprio(1); _Pragma("unroll") for (int m = 0; m < 4; ++m) _Pragma("unroll") for (int n = 0; n < 2; ++n) _Pragma("unroll") for (int k = 0; k < 2; ++k) \
        acc[ai][bj][m][n] = __builtin_amdgcn_mfma_f32_16x16x32_bf16(Bt[n][k], At[m][k], acc[ai][bj][m][n], 0, 0, 0); __builtin_amdgcn_s_setprio(0); } while (0)
#define PG8_WAIT_V(n) asm volatile("s_waitcnt vmcnt(" #n ")" ::: "memory")
#define PG8_WAIT_L(n) asm volatile("s_waitcnt lgkmcnt(" #n ")" ::: "memory")
#define PG8_BAR __builtin_amdgcn_s_barrier()
#define PG8_SCHED __builtin_amdgcn_sched_barrier(0)
    Unit cur, nxt; int ui = 0;
    if (!S.next(0, cur)) return;
    f32x4 acc[2][2][4][2];
#pragma unroll
    for (int a = 0; a < 2; ++a)
#pragma unroll
        for (int b = 0; b < 2; ++b)
#pragma unroll
            for (int m = 0; m < 4; ++m)
#pragma unroll
                for (int n = 0; n < 2; ++n) acc[a][b][m][n] = (f32x4){0.f, 0.f, 0.f, 0.f};
    bf16x8 At[4][2], B0[2][2], B1[2][2];
    const char* cA = (const char*)g.A + (size_t)cur.pm * tstep; const char* cB = (const char*)g.Bt + (size_t)cur.pn * tstep;
    S.a_ready(cur);
    PG8_STAGE(PG8_SB(0, 0), cB, voffB); PG8_STAGE(PG8_SA(0, 0), cA, voffA); PG8_STAGE(PG8_SB(0, 1), cB + hstep, voffB); PG8_STAGE(PG8_SA(0, 1), cA + hstep, voffA);
    if (wr == 1) PG8_BAR;
    PG8_WAIT_V(4); PG8_BAR;
    PG8_STAGE(PG8_SB(1, 0), cB + kstep, voffB); PG8_STAGE(PG8_SA(1, 0), cA + kstep, voffA); PG8_STAGE(PG8_SB(1, 1), cB + hstep + kstep, voffB);
    PG8_WAIT_V(6); PG8_BAR;
    PG8_STAMP();
    for (;;) {
        const bool has_next = S.next(ui + 1, nxt);
        const char* nA = has_next ? (const char*)g.A + (size_t)nxt.pm * tstep : cA; const char* nB = has_next ? (const char*)g.Bt + (size_t)nxt.pn * tstep : cB;
        for (int t = 0; t < nt; t += 2) {
            const bool last = (t == nt - 2);
            const char* a1 = cA + (size_t)(t + 1) * kstep;
            const char* a2 = last ? nA : cA + (size_t)(t + 2) * kstep; const char* b2 = last ? nB : cB + (size_t)(t + 2) * kstep;
            const char* a3 = a2 + kstep; const char* b3 = b2 + kstep;
            if (last && has_next) S.a_ready(nxt);
            PG8_LDB(B0, 0, 0); PG8_SCHED; PG8_LDA(At, 0, 0); PG8_STAGE(PG8_SA(1, 1), a1 + hstep, voffA);
            PG8_WAIT_L(8); PG8_BAR; PG8_WAIT_L(0); PG8_MMA(0, 0, At, B0); PG8_BAR; PG8_SCHED;
            PG8_LDB(B1, 0, 1); PG8_STAGE(PG8_SB(0, 0), b2, voffB);
            PG8_BAR; PG8_WAIT_L(0); PG8_MMA(0, 1, At, B1); PG8_BAR;
            PG8_LDA(At, 0, 1); PG8_STAGE(PG8_SA(0, 0), a2, voffA);
            PG8_BAR; PG8_WAIT_L(0); PG8_MMA(1, 0, At, B0); PG8_BAR; PG8_SCHED;
            PG8_STAGE(PG8_SB(0, 1), b2 + hstep, voffB);
            PG8_WAIT_V(6); PG8_BAR; PG8_MMA(1, 1, At, B1); PG8_BAR;
            PG8_LDB(B0, 1, 0); PG8_SCHED; PG8_LDA(At, 1, 0); PG8_STAGE(PG8_SA(0, 1), a2 + hstep, voffA);
            PG8_WAIT_L(8); PG8_BAR; PG8_WAIT_L(0); PG8_MMA(0, 0, At, B0); PG8_BAR; PG8_SCHED;
            PG8_LDB(B1, 1, 1); PG8_STAGE(PG8_SB(1, 0), b3, voffB);
            PG8_BAR; PG8_WAIT_L(0); PG8_MMA(0, 1, At, B1); PG8_BAR;
            PG8_LDA(At, 1, 1); PG8_STAGE(PG8_SA(1, 0), a3, voffA);
            PG8_BAR; PG8_WAIT_L(0); PG8_MMA(1, 0, At, B0); PG8_BAR; PG8_SCHED;
            PG8_STAGE(PG8_SB(1, 1), b3 + hstep, voffB);
            PG8_WAIT_V(6); PG8_BAR; PG8_MMA(1, 1, At, B1); PG8_BAR;
        }
        PG8_STAMP();
        if constexpr (!Epi::AFTER_DRAIN) { E(acc, cur, wr, wc, fr, fq); S.done(cur); }
        PG8_STAMP();
        if (!has_next) break;
#pragma unroll
        for (int a = 0; a < 2; ++a)
#pragma unroll
            for (int b = 0; b < 2; ++b)
#pragma unroll
                for (int m = 0; m < 4; ++m)
#pragma unroll
                    for (int n = 0; n < 2; ++n) acc[a][b][m][n] = (f32x4){0.f, 0.f, 0.f, 0.f};
        cur = nxt; cA = nA; cB = nB; ++ui;
    }
    PG8_WAIT_V(0);
    if (wr == 0) PG8_BAR;
    PG8_BAR;
    if constexpr (Epi::AFTER_DRAIN) { E.fused(acc, cur, wr, wc, fr, fq, lds, wid, lane); S.done(cur); }
    PG8_STAMP();
    if (STAMP && wid == 0) { stamps[lane] = lane < nts ? (((unsigned long long)(unsigned)ts_hi << 32) | (unsigned)ts_lo) : 0ull;
        if (lane == 62) stamps[62] = rt_entry; if (lane == 63) stamps[63] = (unsigned long long)wall_clock64(); }
#undef PG8_STAMP
#undef PG8_SA
#undef PG8_SB
#undef PG8_STAGE
#undef PG8_LDA
#undef PG8_LDB
#undef PG8_MMA
#undef PG8_WAIT_V
#undef PG8_WAIT_L
#undef PG8_BAR
#undef PG8_SCHED
}
}
typedef unsigned short bf16_t;
constexpr int T_TOK = 32768, DM = 1024, D_IN = 4096, D_HY = 512, D_HG = 512, DFF = 4096, NLAYER = 4;
constexpr int L_BIG = 16384, L_SML = 4096;
constexpr int APAD = 256;
constexpr size_t MiB = 1024ull * 1024ull;
constexpr size_t OFF_W = 0;
constexpr size_t OFF_W_IN = OFF_W, OFF_W_OUT = OFF_W + 8 * MiB, OFF_W_UP = OFF_W + 10 * MiB, OFF_W_DN = OFF_W + 26 * MiB;
constexpr size_t OFF_ABUF = 34 * MiB;
constexpr size_t OFF_R1 = 99 * MiB;
constexpr size_t OFF_HYRAW = OFF_R1;
constexpr size_t OFF_HG = OFF_R1 + 96 * MiB;
constexpr size_t OFF_KT = OFF_R1;
constexpr size_t OFF_ACT = OFF_R1;
constexpr size_t OFF_R2 = 355 * MiB;
constexpr size_t OFF_X0T = OFF_R2, OFF_ZT = OFF_R2 + 32 * MiB;
constexpr size_t OFF_MIX = OFF_R2;
constexpr size_t OFF_UPART = OFF_R2;
constexpr size_t OFF_R6 = 419 * MiB;
constexpr size_t OFF_OBUF = OFF_R6;
constexpr size_t OFF_KS = OFF_R6;
constexpr size_t OFF_SMALL = 483 * MiB;
constexpr size_t WS_NEED = 487 * MiB;

struct P { const float* in[26]; float* out; unsigned char* ws; };
constexpr int PB_norm_mix_pre = 0;
constexpr int PB_norm_mix_post = 4096;
constexpr int PB_norm_ffn_pre = 8192;
constexpr int PB_norm_ffn_post = 12288;
constexpr int PB_hy_conv_w = 16384;
constexpr int PB_hy_conv_b = 34816;
constexpr int PB_f_w1 = 40960;
constexpr int PB_f_b1 = 49408;
constexpr int PB_f_w2 = 49664;
constexpr int PB_f_b2 = 66048;
constexpr int PB_f_w3 = 66304;
constexpr int PB_f_b3 = 82688;
constexpr int PB_f_w4 = 82944;
constexpr int PB_f_freq = 345088;
constexpr int PB_hy_skip = 345344;
constexpr int PB_hy_out_norm = 347392;
constexpr int PB_lb_table = 349440;
constexpr int PB_hg_out_norm = 353536;
constexpr int PB_ffn_conv_w = 355584;
constexpr int PB_ffn_conv_b = 453888;
constexpr int PB_TOTAL = 486656;
constexpr size_t OFF_PB = OFF_SMALL + 512 * 1024;
#define PRM(p, NAME) ((const float*)((p).ws + OFF_PB) + PB_##NAME)

__device__ __forceinline__ float bf2f(bf16_t b) { return __uint_as_float(((unsigned)b) << 16); }
__device__ __forceinline__ bf16_t f2bf(float f) { unsigned u = __float_as_uint(f); u += 0x7FFFu + ((u >> 16) & 1u); return (bf16_t)(u >> 16); }
__device__ __forceinline__ unsigned pack_bf2(float lo, float hi) { return (unsigned)f2bf(lo) | ((unsigned)f2bf(hi) << 16); }
__device__ __forceinline__ bool seq_start(int t) { return t < L_BIG ? (t == 0) : ((t & (L_SML - 1)) == 0); }
__device__ __forceinline__ bool seq_end(int t) { return (t + 1 == T_TOK) || seq_start(t + 1); }
__device__ __forceinline__ const float* x_src_row(const P& p, int l, int t) {
    if (l > 0) return p.out + (size_t)t * DM;
    return t < L_BIG ? p.in[0] + (size_t)t * DM : p.in[1] + (size_t)(t - L_BIG) * DM;
}
__device__ __forceinline__ float silu_f(float x) { return x / (1.0f + __expf(-x)); }
__device__ __forceinline__ float wave_sum(float v) {
#pragma unroll
    for (int o = 32; o >= 1; o >>= 1) v += __shfl_xor(v, o);
    return v;
}

struct EpiBf16Split {
    static constexpr bool PERM = true, AFTER_DRAIN = false;
    bf16_t* O0; int ldc0; bf16_t* O1; int ldc1; int csplit;
    __device__ __forceinline__ void operator()(const pg8::f32x4 (&acc)[2][2][4][2], const pg8::Unit& u, int wr, int wc, int fr, int fq) const {
        const int row0 = u.pm * pg8::BM + wr * 64 + fr; int colt = u.pn * pg8::BM; bf16_t* base = O0; int ldc = ldc0;
        if (colt >= csplit) { base = O1; ldc = ldc1; colt -= csplit; }
        const int col0 = colt + wc * 32 + 8 * fq;
#pragma unroll
        for (int ai = 0; ai < 2; ++ai)
#pragma unroll
            for (int m = 0; m < 4; ++m) { bf16_t* rowp = base + (size_t)(row0 + ai * pg8::HALF + m * 16) * ldc + col0;
#pragma unroll
                for (int bj = 0; bj < 2; ++bj) { const pg8::f32x4 v0 = acc[ai][bj][m][0], v1 = acc[ai][bj][m][1];
                    pg8::u32x4 w; w.x = pg8::cvt_pk_bf16(v0[0], v0[1]); w.y = pg8::cvt_pk_bf16(v0[2], v0[3]); w.z = pg8::cvt_pk_bf16(v1[0], v1[1]); w.w = pg8::cvt_pk_bf16(v1[2], v1[3]);
                    *(pg8::u32x4*)(rowp + bj * pg8::HALF) = w; } }
    }
};
template <class Epi>
__device__ __forceinline__ void run_gemm(unsigned char* lds, const bf16_t* A, const bf16_t* Bt, int M, int N, int K, const Epi& E) {
    pg8::Gemm g; g.A = A; g.Bt = Bt; g.M = M; g.N = N; g.K = K;
    pg8::StaticOrder S; S.init(M, N, (int)gridDim.x, (int)blockIdx.x);
    pg8::gemm_phase<Epi, pg8::StaticOrder, false>((PG8_LAS unsigned char*)lds, g, S, E, nullptr);
}

#define HD_INLINE __device__ __forceinline__
#define DEV_FN __device__ __forceinline__
#define LDS_F2 float2*
#define NTHR 512
#define FOR_TID for (int tid = (int)TIDX, once_ = 1; once_; once_ = 0)
#define SYNC __syncthreads()
#define BREV32(x) __brev(x)
#define CIS_REV(fr, c, s) do { const float f_ = (fr); c = __builtin_amdgcn_cosf(f_); s = __builtin_amdgcn_sinf(f_); } while (0)
HD_INLINE unsigned rev4(unsigned k, int S) {
    unsigned v = BREV32(k) >> (32 - 2 * S);
    return ((v & 0xAAAAAAAAu) >> 1) | ((v & 0x55555555u) << 1);
}
HD_INLINE float2 cmul(float2 a, float2 b) { return make_float2(a.x * b.x - a.y * b.y, a.x * b.y + a.y * b.x); }
HD_INLINE float2 cmulc(float2 a, float2 b) { return make_float2(a.x * b.x + a.y * b.y, a.y * b.x - a.x * b.y); }

DEV_FN void fft_fwd(LDS_F2 X, int S, int s0) {
    const int M = 1 << (2 * S);
    for (int s = s0; s < S; ++s) {
        const int n = M >> (2 * s), q = n >> 2;
        const float invn = 1.0f / (float)n;
        FOR_TID {
            for (int b = tid; b < (M >> 2); b += NTHR) {
                const int j = b & (q - 1), base = ((b - j) << 2) + j;
                const float2 a0 = X[base], a1 = X[base + q], a2 = X[base + 2 * q], a3 = X[base + 3 * q];
                const float2 t0 = make_float2(a0.x + a2.x, a0.y + a2.y), t1 = make_float2(a0.x - a2.x, a0.y - a2.y);
                const float2 t2 = make_float2(a1.x + a3.x, a1.y + a3.y);
                const float2 d13 = make_float2(a1.x - a3.x, a1.y - a3.y);
                const float2 t3 = make_float2(d13.y, -d13.x);
                const float2 y0 = make_float2(t0.x + t2.x, t0.y + t2.y);
                float2 y1 = make_float2(t1.x + t3.x, t1.y + t3.y);
                float2 y2 = make_float2(t0.x - t2.x, t0.y - t2.y);
                float2 y3 = make_float2(t1.x - t3.x, t1.y - t3.y);
                if (q > 1) {
                    const float fr = (float)j * invn;
                    float c1, s1, c2, s2, c3, s3;
                    CIS_REV(fr, c1, s1); CIS_REV(2.0f * fr, c2, s2); CIS_REV(3.0f * fr, c3, s3);
                    y1 = cmul(y1, make_float2(c1, -s1)); y2 = cmul(y2, make_float2(c2, -s2)); y3 = cmul(y3, make_float2(c3, -s3));
                }
                X[base] = y0; X[base + q] = y1; X[base + 2 * q] = y2; X[base + 3 * q] = y3;
            }
        }
        SYNC;
    }
}
DEV_FN void fft_inv(LDS_F2 X, int S) {
    const int M = 1 << (2 * S);
    for (int s = S - 1; s >= 0; --s) {
        const int n = M >> (2 * s), q = n >> 2;
        const float invn = 1.0f / (float)n;
        FOR_TID {
            for (int b = tid; b < (M >> 2); b += NTHR) {
                const int j = b & (q - 1), base = ((b - j) << 2) + j;
                float2 b0 = X[base], b1 = X[base + q], b2 = X[base + 2 * q], b3 = X[base + 3 * q];
                if (q > 1) {
                    const float fr = (float)j * invn;
                    float c1, s1, c2, s2, c3, s3;
                    CIS_REV(fr, c1, s1); CIS_REV(2.0f * fr, c2, s2); CIS_REV(3.0f * fr, c3, s3);
                    b1 = cmul(b1, make_float2(c1, s1)); b2 = cmul(b2, make_float2(c2, s2)); b3 = cmul(b3, make_float2(c3, s3));
                }
                const float2 t0 = make_float2(b0.x + b2.x, b0.y + b2.y), t1 = make_float2(b0.x - b2.x, b0.y - b2.y);
                const float2 t2 = make_float2(b1.x + b3.x, b1.y + b3.y);
                const float2 d13 = make_float2(b1.x - b3.x, b1.y - b3.y);
                const float2 t3 = make_float2(-d13.y, d13.x);
                X[base] = make_float2(t0.x + t2.x, t0.y + t2.y);
                X[base + q] = make_float2(t1.x + t3.x, t1.y + t3.y);
                X[base + 2 * q] = make_float2(t0.x - t2.x, t0.y - t2.y);
                X[base + 3 * q] = make_float2(t1.x - t3.x, t1.y - t3.y);
            }
        }
        SYNC;
    }
}
DEV_FN void spec_store(LDS_F2 X, int S, float2* Ks) {
    const int M = 1 << (2 * S);
    FOR_TID {
        for (int k = tid; k <= (M >> 1); k += NTHR) {
            if (k == 0) { const float2 c0 = X[0]; Ks[0] = make_float2(c0.x + c0.y, c0.x - c0.y); }
            else {
                const float2 ck = X[rev4((unsigned)k, S)], cm = X[rev4((unsigned)(M - k), S)];
                const float2 P = make_float2(0.5f * (ck.x + cm.x), 0.5f * (ck.y - cm.y));
                const float2 O = make_float2(0.5f * (ck.y + cm.y), -0.5f * (ck.x - cm.x));
                float c, s; CIS_REV((float)k / (float)(2 * M), c, s);
                const float2 Q = cmul(O, make_float2(c, -s));
                Ks[k] = make_float2(P.x + Q.x, P.y + Q.y);
                Ks[M - k] = make_float2(P.x - Q.x, -(P.y - Q.y));
            }
        }
    }
    SYNC;
}
DEV_FN void spec_mul(LDS_F2 X, int S, const float2* Ks) {
    const int M = 1 << (2 * S);
    FOR_TID {
        for (int k = tid; k <= (M >> 1); k += NTHR) {
            if (k == 0) {
                const float2 c0 = X[0], k0 = Ks[0];
                const float y0 = (c0.x + c0.y) * k0.x, ym = (c0.x - c0.y) * k0.y;
                X[0] = make_float2(0.5f * (y0 + ym), 0.5f * (y0 - ym));
            } else {
                const unsigned pk = rev4((unsigned)k, S), pm = rev4((unsigned)(M - k), S);
                const float2 ck = X[pk], cm = X[pm];
                const float2 P = make_float2(0.5f * (ck.x + cm.x), 0.5f * (ck.y - cm.y));
                const float2 O = make_float2(0.5f * (ck.y + cm.y), -0.5f * (ck.x - cm.x));
                float c, s; CIS_REV((float)k / (float)(2 * M), c, s);
                const float2 Wk = make_float2(c, -s);
                const float2 Q = cmul(O, Wk);
                const float2 xk = make_float2(P.x + Q.x, P.y + Q.y), xm = make_float2(P.x - Q.x, -(P.y - Q.y));
                const float2 yk = cmul(xk, Ks[k]), ym = cmul(xm, Ks[M - k]);
                const float2 Ye = make_float2(0.5f * (yk.x + ym.x), 0.5f * (yk.y - ym.y));
                const float2 Yd = make_float2(0.5f * (yk.x - ym.x), 0.5f * (yk.y + ym.y));
                const float2 Yo = cmulc(Yd, Wk);
                X[pk] = make_float2(Ye.x - Yo.y, Ye.y + Yo.x);
                if (k != (M >> 1)) X[pm] = make_float2(Ye.x + Yo.y, -Ye.y + Yo.x);
            }
        }
    }
    SYNC;
}
__device__ void ph_setup(const P& p) {
    const int gid = blockIdx.x * 512 + TIDX;
    if (gid < 2 * D_HG) {
        const int dir = gid / D_HG, c = gid % D_HG;
        float v[NLAYER], mx = -1e30f;
#pragma unroll
        for (int l = 0; l < NLAYER; ++l) { v[l] = p.in[19][(size_t)(dir * NLAYER + l) * D_HG + c]; mx = fmaxf(mx, v[l]); }
        float s = 0.f;
#pragma unroll
        for (int l = 0; l < NLAYER; ++l) { v[l] = expf(v[l] - mx); s += v[l]; }
        float* lbs = (float*)(p.ws + OFF_SMALL);
        float cum = 0.f;
#pragma unroll
        for (int l = 0; l < NLAYER; ++l) { if (l > 0) cum += v[l] / s; lbs[(size_t)(dir * NLAYER + l) * D_HG + c] = cum; }
    }
}
__device__ void ph_copy_params(const P& p) {
    float* pb = (float*)(p.ws + OFF_PB);
    const int g = blockIdx.x * 512 + TIDX, gs = gridDim.x * 512;
    for (int k = g; k < 4096; k += gs) pb[0 + k] = p.in[2][k];
    for (int k = g; k < 4096; k += gs) pb[4096 + k] = p.in[3][k];
    for (int k = g; k < 4096; k += gs) pb[8192 + k] = p.in[4][k];
    for (int k = g; k < 4096; k += gs) pb[12288 + k] = p.in[5][k];
    for (int k = g; k < 18432; k += gs) pb[16384 + k] = p.in[7][k];
    for (int k = g; k < 6144; k += gs) pb[34816 + k] = p.in[8][k];
    for (int k = g; k < 8448; k += gs) pb[40960 + k] = p.in[9][k];
    for (int k = g; k < 256; k += gs) pb[49408 + k] = p.in[10][k];
    for (int k = g; k < 16384; k += gs) pb[49664 + k] = p.in[11][k];
    for (int k = g; k < 256; k += gs) pb[66048 + k] = p.in[12][k];
    for (int k = g; k < 16384; k += gs) pb[66304 + k] = p.in[13][k];
    for (int k = g; k < 256; k += gs) pb[82688 + k] = p.in[14][k];
    for (int k = g; k < 262144; k += gs) pb[82944 + k] = p.in[15][k];
    for (int k = g; k < 256; k += gs) pb[345088 + k] = p.in[16][k];
    for (int k = g; k < 2048; k += gs) pb[345344 + k] = p.in[17][k];
    for (int k = g; k < 2048; k += gs) pb[347392 + k] = p.in[18][k];
    for (int k = g; k < 4096; k += gs) pb[349440 + k] = p.in[19][k];
    for (int k = g; k < 2048; k += gs) pb[353536 + k] = p.in[20][k];
    for (int k = g; k < 98304; k += gs) pb[355584 + k] = p.in[23][k];
    for (int k = g; k < 32768; k += gs) pb[453888 + k] = p.in[24][k];
}
__device__ void convert_one(const float* src, bf16_t* dst, int K, int N, float* tile  ) {
    const int tiles_n = N / 64, ntiles = (K / 64) * tiles_n, tid = TIDX;
    for (int it = blockIdx.x; it < ntiles; it += gridDim.x) {
        const int k0 = (it / tiles_n) * 64, n0 = (it % tiles_n) * 64;
#pragma unroll
        for (int i = 0; i < 8; ++i) { const int r = (tid >> 6) + 8 * i, c = tid & 63; tile[r * 65 + c] = src[(size_t)(k0 + r) * N + n0 + c]; }
        __syncthreads();
#pragma unroll
        for (int i = 0; i < 8; ++i) { const int n = (tid >> 6) + 8 * i, k = tid & 63; dst[(size_t)(n0 + n) * K + k0 + k] = f2bf(tile[k * 65 + n]); }
        __syncthreads();
    }
}
__device__ void ph_convert_w(const P& p, int l, unsigned char* lds) {
    float* tile = (float*)lds;
    convert_one(p.in[6] + (size_t)l * DM * D_IN, (bf16_t*)(p.ws + OFF_W_IN), DM, D_IN, tile);
    convert_one(p.in[21] + (size_t)l * DM * DM, (bf16_t*)(p.ws + OFF_W_OUT), DM, DM, tile);
    convert_one(p.in[22] + (size_t)l * DM * 2 * DFF, (bf16_t*)(p.ws + OFF_W_UP), DM, 2 * DFF, tile);
    convert_one(p.in[25] + (size_t)l * DFF * DM, (bf16_t*)(p.ws + OFF_W_DN), DFF, DM, tile);
}
__device__ __forceinline__ bf16_t* abuf_row(const P& p, int t) { return (bf16_t*)(p.ws + OFF_ABUF) + (size_t)(t + APAD) * DM; }
__device__ void ph_rmsnorm_in(const P& p, int l) {
    const int lane = TIDX & 63, wv = TIDX >> 6;
    const float* gain = p.in[2] + (size_t)l * DM;
    for (int t = blockIdx.x * 8 + wv; t < T_TOK; t += gridDim.x * 8) {
        const float* xr = x_src_row(p, l, t);
        float4 v[4]; float ss = 0.f;
#pragma unroll
        for (int i = 0; i < 4; ++i) { v[i] = *(const float4*)(xr + lane * 4 + 256 * i); ss += v[i].x * v[i].x + v[i].y * v[i].y + v[i].z * v[i].z + v[i].w * v[i].w; }
        ss = wave_sum(ss);
        const float r = rsqrtf(ss * (1.0f / DM) + 1e-6f);
        bf16_t* hr = abuf_row(p, t);
#pragma unroll
        for (int i = 0; i < 4; ++i) { const float4 g = *(const float4*)(gain + lane * 4 + 256 * i);
            uint2 w; w.x = pack_bf2(v[i].x * r * g.x, v[i].y * r * g.y); w.y = pack_bf2(v[i].z * r * g.z, v[i].w * r * g.w);
            *(uint2*)(hr + lane * 4 + 256 * i) = w; }
    }
}
__device__ void ph_norm_resid(const P& p, int l, int which) {
    const int lane = TIDX & 63, wv = TIDX >> 6;
    const float* gpost = (which == 0 ? PRM(p, norm_mix_post) : PRM(p, norm_ffn_post)) + (size_t)l * DM;
    const bool has_next = (which == 0) || (l + 1 < NLAYER);
    const float* gnext = which == 0 ? PRM(p, norm_ffn_pre) + (size_t)l * DM : PRM(p, norm_mix_pre) + (size_t)(has_next ? l + 1 : l) * DM;
    const bf16_t* Y = (const bf16_t*)(p.ws + OFF_MIX);
    const int lx = which == 0 ? l : 1;
    for (int t = blockIdx.x * 8 + wv; t < T_TOK; t += gridDim.x * 8) {
        const float* xr = x_src_row(p, lx, t);
        const bf16_t* yr = Y + (size_t)t * DM;
        float4 x[4], y[4]; float ss = 0.f;
#pragma unroll
        for (int i = 0; i < 4; ++i) { x[i] = *(const float4*)(xr + lane * 4 + 256 * i); const uint2 w = *(const uint2*)(yr + lane * 4 + 256 * i);
            y[i].x = __uint_as_float(w.x << 16); y[i].y = __uint_as_float(w.x & 0xffff0000u); y[i].z = __uint_as_float(w.y << 16); y[i].w = __uint_as_float(w.y & 0xffff0000u);
            ss += y[i].x * y[i].x + y[i].y * y[i].y + y[i].z * y[i].z + y[i].w * y[i].w; }
        ss = wave_sum(ss);
        const float r = rsqrtf(ss * (1.0f / DM) + 1e-6f);
        float s2 = 0.f;
#pragma unroll
        for (int i = 0; i < 4; ++i) { const float4 g = *(const float4*)(gpost + lane * 4 + 256 * i);
            x[i].x += y[i].x * r * g.x; x[i].y += y[i].y * r * g.y; x[i].z += y[i].z * r * g.z; x[i].w += y[i].w * r * g.w;
            s2 += x[i].x * x[i].x + x[i].y * x[i].y + x[i].z * x[i].z + x[i].w * x[i].w;
            *(float4*)(p.out + (size_t)t * DM + lane * 4 + 256 * i) = x[i]; }
        if (has_next) {
            s2 = wave_sum(s2);
            const float r2 = rsqrtf(s2 * (1.0f / DM) + 1e-6f);
            bf16_t* hr = abuf_row(p, t);
#pragma unroll
            for (int i = 0; i < 4; ++i) { const float4 g = *(const float4*)(gnext + lane * 4 + 256 * i);
                uint2 w; w.x = pack_bf2(x[i].x * r2 * g.x, x[i].y * r2 * g.y); w.y = pack_bf2(x[i].z * r2 * g.z, x[i].w * r2 * g.w);
                *(uint2*)(hr + lane * 4 + 256 * i) = w; }
        }
    }
}
__device__ void ph_filter(const P& p, int l, unsigned char* lds) {
    float* feats = (float*)lds;
    float* ha = feats + 16 * 33;
    float* hb = ha + 16 * 64;
    const int tid = TIDX;
    const float* w1 = PRM(p, f_w1) + (size_t)l * 33 * 64; const float* b1 = PRM(p, f_b1) + (size_t)l * 64;
    const float* w2 = PRM(p, f_w2) + (size_t)l * 64 * 64; const float* b2 = PRM(p, f_b2) + (size_t)l * 64;
    const float* w3 = PRM(p, f_w3) + (size_t)l * 64 * 64; const float* b3 = PRM(p, f_b3) + (size_t)l * 64;
    const float* w4 = PRM(p, f_w4) + (size_t)l * 64 * 1024; const float* fq = PRM(p, f_freq) + (size_t)l * 64;
    float* kt = (float*)(p.ws + OFF_KT);
    const int nitems = (L_BIG + L_SML) / 16;
    for (int it = blockIdx.x; it < nitems; it += gridDim.x) {
        const bool big = it < L_BIG / 16; const int L = big ? L_BIG : L_SML; const int pos0 = (big ? it : it - L_BIG / 16) * 16;
        float* ktc = kt + (big ? 0 : (size_t)512 * 2 * L_BIG);
        for (int idx = tid; idx < 16 * 33; idx += 512) {
            const int pp = idx / 33, f = idx % 33; const int pos = pos0 + pp;
            const float tt = (float)pos / (float)(L - 1), ang = (6.283185307179586f / (float)L) * (float)pos;
            float v;
            if (f == 0) v = tt;
            else { const int bi = (f - 1) & 15; const float band = 1e-4f + (float)bi * ((15.0f - 1e-4f) / 15.0f); v = f <= 16 ? cosf(band * ang) : -sinf(band * ang); }
            feats[idx] = v;
        }
        __syncthreads();
        for (int idx = tid; idx < 16 * 64; idx += 512) { const int pp = idx >> 6, j = idx & 63; float a = b1[j];
            for (int f = 0; f < 33; ++f) a += feats[pp * 33 + f] * w1[f * 64 + j];
            ha[idx] = sinf(fq[j] * a); }
        __syncthreads();
        for (int idx = tid; idx < 16 * 64; idx += 512) { const int pp = idx >> 6, j = idx & 63; float a = b2[j];
            for (int f = 0; f < 64; ++f) a += ha[pp * 64 + f] * w2[f * 64 + j];
            hb[idx] = sinf(fq[j] * a); }
        __syncthreads();
        for (int idx = tid; idx < 16 * 64; idx += 512) { const int pp = idx >> 6, j = idx & 63; float a = b3[j];
            for (int f = 0; f < 64; ++f) a += hb[pp * 64 + f] * w3[f * 64 + j];
            ha[idx] = sinf(fq[j] * a); }
        __syncthreads();
        for (int o = tid; o < 1024; o += 512) {
            float acc[16];
#pragma unroll
            for (int pp = 0; pp < 16; ++pp) acc[pp] = 0.f;
            for (int f = 0; f < 64; ++f) { const float w = w4[f * 1024 + o];
#pragma unroll
                for (int pp = 0; pp < 16; ++pp) acc[pp] += ha[pp * 64 + f] * w; }
            const int dir = o >> 9, c = o & 511;
            const float delta = 3.0701134573253945f + (float)c * ((15.350567286626972f - 3.0701134573253945f) / 511.0f);
            float* dst = ktc + (size_t)(c * 2 + dir) * L + pos0;
#pragma unroll
            for (int pp = 0; pp < 16; ++pp) { const float tt = (float)(pos0 + pp) / (float)(L - 1); dst[pp] = acc[pp] * expf(-tt * delta); }
        }
        __syncthreads();
    }
}
__device__ void ph_hy_prep(const P& p, int l, unsigned char* lds) {
    float* tx = (float*)lds;
    float* tz = tx + 64 * 65;
    const bf16_t* hy = (const bf16_t*)(p.ws + OFF_HYRAW);
    bf16_t* x0t = (bf16_t*)(p.ws + OFF_X0T); bf16_t* zt = (bf16_t*)(p.ws + OFF_ZT);
    const float* cw = PRM(p, hy_conv_w) + (size_t)l * 3 * 1536; const float* cb = PRM(p, hy_conv_b) + (size_t)l * 1536;
    const int tid = TIDX, nitems = (T_TOK / 64) * 8;
    for (int it = blockIdx.x; it < nitems; it += gridDim.x) {
        const int t0 = (it >> 3) * 64, c0 = (it & 7) * 64, c = tid & 63;
        float wv[3][3], bv[3];
#pragma unroll
        for (int a = 0; a < 3; ++a) { bv[a] = cb[a * 512 + c0 + c];
#pragma unroll
            for (int k = 0; k < 3; ++k) wv[a][k] = cw[k * 1536 + a * 512 + c0 + c]; }
#pragma unroll
        for (int i = 0; i < 8; ++i) {
            const int tt = (tid >> 6) + 8 * i, t = t0 + tt;
            const bool hp = !seq_start(t), hn = !seq_end(t);
            float r[3];
#pragma unroll
            for (int a = 0; a < 3; ++a) {
                const bf16_t* col = hy + (size_t)t * 1536 + a * 512 + c0 + c;
                const float xm = hp ? bf2f(col[-1536]) : 0.f, x0 = bf2f(col[0]), xp = hn ? bf2f(col[1536]) : 0.f;
                r[a] = xm * wv[a][0] + x0 * wv[a][1] + xp * wv[a][2] + bv[a];
            }
            tx[c * 65 + tt] = r[0]; tz[c * 65 + tt] = r[1] * r[2];
        }
        __syncthreads();
#pragma unroll
        for (int i = 0; i < 8; ++i) { const int cc = (tid >> 6) + 8 * i, tt = tid & 63;
            x0t[(size_t)(c0 + cc) * T_TOK + t0 + tt] = f2bf(tx[cc * 65 + tt]); zt[(size_t)(c0 + cc) * T_TOK + t0 + tt] = f2bf(tz[cc * 65 + tt]); }
        __syncthreads();
    }
}
__device__ __forceinline__ float2 ld_f2_agent(const float2* ptr) {
    const unsigned long long w = __hip_atomic_load((const unsigned long long*)ptr, __ATOMIC_RELAXED, __HIP_MEMORY_SCOPE_AGENT);
    return make_float2(__uint_as_float((unsigned)w), __uint_as_float((unsigned)(w >> 32)));
}
DEV_FN void spec_mul_g(LDS_F2 X, int S, const float2* Ks);
__device__ void ph_hy_fft(const P& p, int l, unsigned char* lds) {
    float2* X = (float2*)lds;
    const int tid = TIDX;
    float2* Ks = (float2*)(p.ws + OFF_KS) + (size_t)blockIdx.x * L_BIG;
    const float* kt = (const float*)(p.ws + OFF_KT);
    const bf16_t* x0t = (const bf16_t*)(p.ws + OFF_X0T); bf16_t* zt = (bf16_t*)(p.ws + OFF_ZT);
    for (int job = blockIdx.x; job < 1024; job += gridDim.x) {
        const bool big = job < 512; const int c = job & 511;
        const int L = big ? L_BIG : L_SML, S = big ? 7 : 6, M = L;
        const float* hf = kt + (big ? 0 : (size_t)512 * 2 * L_BIG) + (size_t)(c * 2) * L; const float* hb = hf + L;
        for (int m = tid; m < M; m += 512) {
            const int n0 = 2 * m, n1 = 2 * m + 1;
            const float a = n0 < L ? hf[n0] : (n0 == L ? 0.f : hb[2 * L - n0]);
            const float b = n1 < L ? hf[n1] : hb[2 * L - n1];
            X[m] = make_float2(a, b);
        }
        __syncthreads();
        fft_fwd(X, S, 0);
        spec_store(X, S, Ks);
        __threadfence(); __syncthreads();
        const float skip = PRM(p, hy_skip)[(size_t)l * D_HY + c];
        const int nseq = big ? 1 : 4;
        for (int sq = 0; sq < nseq; ++sq) {
            const int t0 = big ? 0 : L_BIG + sq * L_SML;
            const bf16_t* zrow = zt + (size_t)c * T_TOK + t0; const bf16_t* xrow = x0t + (size_t)c * T_TOK + t0;
            for (int m = tid; m < M; m += 512) {
                float2 v = make_float2(0.f, 0.f);
                if (m < (M >> 1)) { const unsigned w = *(const unsigned*)(zrow + 2 * m); v.x = __uint_as_float(w << 16); v.y = __uint_as_float(w & 0xffff0000u); }
                X[m] = v;
            }
            __syncthreads();
            fft_fwd(X, S, 0);
            spec_mul_g(X, S, Ks);
            fft_inv(X, S);
            const float inv = 1.0f / (float)M;
            bf16_t* orow = zt + (size_t)c * T_TOK + t0;
            for (int m = tid; m < (M >> 1); m += 512) {
                const float2 d = X[m];
                const unsigned wz = *(const unsigned*)(zrow + 2 * m), wx = *(const unsigned*)(xrow + 2 * m);
                const float z0 = __uint_as_float(wz << 16), z1 = __uint_as_float(wz & 0xffff0000u), a0 = __uint_as_float(wx << 16), a1 = __uint_as_float(wx & 0xffff0000u);
                *(unsigned*)(orow + 2 * m) = pack_bf2(a0 * (d.x * inv + skip * z0), a1 * (d.y * inv + skip * z1));
            }
            __syncthreads();
        }
    }
}
DEV_FN void spec_mul_g(LDS_F2 X, int S, const float2* Ks) {
    const int M = 1 << (2 * S);
    for (int k = TIDX; k <= (M >> 1); k += NTHR) {
        if (k == 0) {
            const float2 c0 = X[0], k0 = ld_f2_agent(Ks);
            const float y0 = (c0.x + c0.y) * k0.x, ym = (c0.x - c0.y) * k0.y;
            X[0] = make_float2(0.5f * (y0 + ym), 0.5f * (y0 - ym));
        } else {
            const unsigned pk = rev4((unsigned)k, S), pm = rev4((unsigned)(M - k), S);
            const float2 ck = X[pk], cm = X[pm];
            const float2 Pv = make_float2(0.5f * (ck.x + cm.x), 0.5f * (ck.y - cm.y));
            const float2 O = make_float2(0.5f * (ck.y + cm.y), -0.5f * (ck.x - cm.x));
            float c, s; CIS_REV((float)k / (float)(2 * M), c, s);
            const float2 Wk = make_float2(c, -s);
            const float2 Q = cmul(O, Wk);
            const float2 xk = make_float2(Pv.x + Q.x, Pv.y + Q.y), xm = make_float2(Pv.x - Q.x, -(Pv.y - Q.y));
            const float2 yk = cmul(xk, ld_f2_agent(Ks + k)), ym = cmul(xm, ld_f2_agent(Ks + (M - k)));
            const float2 Ye = make_float2(0.5f * (yk.x + ym.x), 0.5f * (yk.y - ym.y));
            const float2 Yd = make_float2(0.5f * (yk.x - ym.x), 0.5f * (yk.y + ym.y));
            const float2 Yo = cmulc(Yd, Wk);
            X[pk] = make_float2(Ye.x - Yo.y, Ye.y + Yo.x);
            if (k != (M >> 1)) X[pm] = make_float2(Ye.x + Yo.y, -Ye.y + Yo.x);
        }
    }
    __syncthreads();
}
__device__ void ph_hy_norm(const P& p, int l, unsigned char* lds) {
    float* tl = (float*)lds;
    float* red = tl + 64 * 65;
    const bf16_t* yh = (const bf16_t*)(p.ws + OFF_ZT);
    const float* gain = PRM(p, hy_out_norm) + (size_t)l * D_HY;
    const int tid = TIDX, nitems = (T_TOK / 64) * 8;
    for (int it = blockIdx.x; it < nitems; it += gridDim.x) {
        const int t0 = (it >> 3) * 64, c0 = (it & 7) * 64;
#pragma unroll
        for (int i = 0; i < 8; ++i) { const int cc = (tid >> 6) + 8 * i, tt = tid & 63; tl[cc * 65 + tt] = bf2f(yh[(size_t)(c0 + cc) * T_TOK + t0 + tt]); }
        __syncthreads();
        { const int tt = tid & 63, part = tid >> 6; float s = 0.f;
#pragma unroll
          for (int j = 0; j < 8; ++j) { const float v = tl[(part * 8 + j) * 65 + tt]; s += v * v; }
          red[part * 64 + tt] = s; }
        __syncthreads();
#pragma unroll
        for (int i = 0; i < 8; ++i) { const int tt = (tid >> 6) + 8 * i, cc = tid & 63;
            float s = 0.f;
#pragma unroll
            for (int j = 0; j < 8; ++j) s += red[j * 64 + tt];
            const float r = rsqrtf(s * (1.0f / 64.0f) + 1e-6f);
            abuf_row(p, t0 + tt)[c0 + cc] = f2bf(tl[cc * 65 + tt] * r * gain[c0 + cc]); }
        __syncthreads();
    }
}
__device__ void ph_hgrn_naive(const P& p, int l, unsigned char* lds) {
    float* sq = (float*)lds;
    float* sf = sq + 2 * 16 * 128;
    const bf16_t* hg = (const bf16_t*)(p.ws + OFF_HG);
    bf16_t* obuf = (bf16_t*)(p.ws + OFF_OBUF);
    const float* lbs = (const float*)(p.ws + OFF_SMALL);
    const int tid = TIDX;
    for (int it = blockIdx.x; it < 20; it += gridDim.x) {
        const int sqi = it >> 2, h = it & 3;
        const int t0 = sqi == 0 ? 0 : L_BIG + (sqi - 1) * L_SML, L = sqi == 0 ? L_BIG : L_SML;
        const int dir = (tid >> 7) & 1, e = tid & 127;
        const bool act = tid < 256;
        const float lb = act ? lbs[(size_t)(dir * NLAYER + l) * D_HG + h * 128 + e] : 0.f;
        float S[128];
#pragma unroll
        for (int d = 0; d < 128; ++d) S[d] = 0.f;
        for (int b = 0; b < L / 16; ++b) {
            if (act) {
#pragma unroll 4
                for (int j = 0; j < 16; ++j) {
                    const int u = b * 16 + j, tok = dir ? t0 + L - 1 - u : t0 + u;
                    const bf16_t* row = hg + (size_t)tok * 2560 + h * 128 + e;
                    const float zq = bf2f(row[0]), zf = bf2f(row[dir ? 1024 : 512]);
                    sq[(dir * 16 + j) * 128 + e] = silu_f(zq);
                    sf[(dir * 16 + j) * 128 + e] = lb + (1.0f - lb) / (1.0f + __expf(-zf));
                }
            }
            __syncthreads();
            if (act) {
                for (int j = 0; j < 16; ++j) {
                    const int u = b * 16 + j, tok = dir ? t0 + L - 1 - u : t0 + u;
                    const float v = bf2f(hg[(size_t)tok * 2560 + 1536 + h * 128 + e]);
                    const float4* q4 = (const float4*)(sq + (dir * 16 + j) * 128); const float4* f4 = (const float4*)(sf + (dir * 16 + j) * 128);
                    float o = 0.f;
#pragma unroll
                    for (int d4 = 0; d4 < 32; ++d4) { const float4 q = q4[d4], f = f4[d4];
                        S[4 * d4 + 0] = f.x * S[4 * d4 + 0] + (1.0f - f.x) * v; o += S[4 * d4 + 0] * q.x;
                        S[4 * d4 + 1] = f.y * S[4 * d4 + 1] + (1.0f - f.y) * v; o += S[4 * d4 + 1] * q.y;
                        S[4 * d4 + 2] = f.z * S[4 * d4 + 2] + (1.0f - f.z) * v; o += S[4 * d4 + 2] * q.z;
                        S[4 * d4 + 3] = f.w * S[4 * d4 + 3] + (1.0f - f.w) * v; o += S[4 * d4 + 3] * q.w; }
                    obuf[((size_t)dir * T_TOK + tok) * D_HG + h * 128 + e] = f2bf(o);
                }
            }
            __syncthreads();
        }
    }
}
__device__ void ph_hg_norm(const P& p, int l) {
    const int lane = TIDX & 63, wv = TIDX >> 6;
    const bf16_t* hg = (const bf16_t*)(p.ws + OFF_HG); const bf16_t* obuf = (const bf16_t*)(p.ws + OFF_OBUF);
    const float* gain = PRM(p, hg_out_norm) + (size_t)l * D_HG;
    for (int it = blockIdx.x * 8 + wv; it < T_TOK * 4; it += gridDim.x * 8) {
        const int t = it >> 2, h = it & 3, e = h * 128 + lane * 2;
        const unsigned wf = *(const unsigned*)(obuf + (size_t)t * D_HG + e), wb = *(const unsigned*)(obuf + ((size_t)T_TOK + t) * D_HG + e);
        const float o0 = __uint_as_float(wf << 16) + __uint_as_float(wb << 16), o1 = __uint_as_float(wf & 0xffff0000u) + __uint_as_float(wb & 0xffff0000u);
        const float ss = wave_sum(o0 * o0 + o1 * o1);
        const float r = rsqrtf(ss * (1.0f / 128.0f) + 1e-6f);
        const unsigned wg = *(const unsigned*)(hg + (size_t)t * 2560 + 2048 + e);
        const float g0 = silu_f(__uint_as_float(wg << 16)), g1 = silu_f(__uint_as_float(wg & 0xffff0000u));
        *(unsigned*)(abuf_row(p, t) + 512 + e) = pack_bf2(o0 * r * gain[e] * g0, o1 * r * gain[e + 1] * g1);
    }
}
__device__ __forceinline__ float gelu_tanh_f(float x) { const float y = 0.7978845608028654f * (x + 0.044715f * x * x * x); return x / (1.0f + __expf(-2.0f * y)); }
__device__ void ph_geglu_part(const P& p, int l, int r0) {
    const bf16_t* up = (const bf16_t*)(p.ws + OFF_UPART);
    bf16_t* act = (bf16_t*)(p.ws + OFF_ACT);
    const float* cw = PRM(p, ffn_conv_w) + (size_t)l * 3 * 8192; const float* cb = PRM(p, ffn_conv_b) + (size_t)l * 8192;
    const size_t total = (size_t)4096 * (DFF / 2);
    for (size_t idx = (size_t)blockIdx.x * 512 + TIDX; idx < total; idx += (size_t)gridDim.x * 512) {
        const int tt = (int)(idx / (DFF / 2)), j = (int)(idx % (DFF / 2)) * 2, t = r0 + tt;
        const bool hp = !seq_start(t), hn = !seq_end(t);
        const bf16_t* row = up + (size_t)(tt + 256) * 8192;
        float res[2][2];
#pragma unroll
        for (int half = 0; half < 2; ++half) {
            const int col = half * DFF + j;
            const unsigned w0 = *(const unsigned*)(row + col), wm = hp ? *(const unsigned*)(row - 8192 + col) : 0u, wp = hn ? *(const unsigned*)(row + 8192 + col) : 0u;
#pragma unroll
            for (int q = 0; q < 2; ++q) {
                const float xm = q ? __uint_as_float(wm & 0xffff0000u) : __uint_as_float(wm << 16), x0 = q ? __uint_as_float(w0 & 0xffff0000u) : __uint_as_float(w0 << 16), xp = q ? __uint_as_float(wp & 0xffff0000u) : __uint_as_float(wp << 16);
                res[half][q] = xm * cw[col + q] + x0 * cw[8192 + col + q] + xp * cw[2 * 8192 + col + q] + cb[col + q];
            }
        }
        *(unsigned*)(act + (size_t)t * DFF + j) = pack_bf2(gelu_tanh_f(res[0][0]) * res[1][0], gelu_tanh_f(res[0][1]) * res[1][1]);
    }
}
typedef short hbf16x8 __attribute__((ext_vector_type(8)));
typedef float hf32x16 __attribute__((ext_vector_type(16)));
constexpr int HSC = 512, HNCH = HSC / 64, HNSC = T_TOK / HSC;
constexpr int QS = 136, KS_ = 72;
constexpr int HL_QH = 0, HL_KH = HL_QH + 64 * QS * 2, HL_QT = HL_KH + 64 * QS * 2, HL_KT = HL_QT + 64 * QS * 2, HL_VT = HL_KT + 128 * KS_ * 2, HL_ST = HL_VT + 128 * KS_ * 2,
              HL_PM = HL_ST + 128 * QS * 2, HL_TOT = HL_PM + 64 * KS_ * 2, HL_EB = HL_TOT + 4 * 128 * 4, HL_END = HL_EB + 128 * 4;
constexpr int HL_OF = HL_QH, OFS = 132;
static_assert(64 * OFS * 4 <= 2 * 64 * QS * 2, "O tile must fit over Qh|Kh");
constexpr size_t OFF_HST = OFF_R6 + 32 * MiB;
constexpr size_t OFF_HAT = OFF_SMALL + 64 * 1024;

__device__ __forceinline__ hf32x16 mfma32(hbf16x8 a, hbf16x8 b, hf32x16 c) { return __builtin_amdgcn_mfma_f32_32x32x16_bf16(a, b, c, 0, 0, 0); }
__device__ __forceinline__ hbf16x8 lds_frag(const unsigned char* base, int row, int stride_el, int col_el) { return *(const hbf16x8*)(base + ((size_t)row * stride_el + col_el) * 2); }

typedef unsigned hu32x4 __attribute__((ext_vector_type(4)));
struct HgPre { hu32x4 f0, f1, v0, v1, q0, q1; };
template <bool FULL>
__device__ __forceinline__ void hg_fetch(const bf16_t* hg, HgPre& pre, int tokbase, int dirsign, int h, int dir) {
    const int tid = TIDX;
    { const int u = tid >> 4, seg = tid & 15;
      const bf16_t* row = hg + (size_t)(tokbase + dirsign * u) * 2560 + h * 128 + seg * 8;
      pre.f0 = *(const hu32x4*)(row + 512 + 512 * dir); pre.v0 = *(const hu32x4*)(row + 1536); if (FULL) pre.q0 = *(const hu32x4*)(row);
      const bf16_t* row1 = row + (size_t)dirsign * 32 * 2560;
      pre.f1 = *(const hu32x4*)(row1 + 512 + 512 * dir); pre.v1 = *(const hu32x4*)(row1 + 1536); if (FULL) pre.q1 = *(const hu32x4*)(row1); }
}
template <bool FULL>
__device__ __forceinline__ void hg_prep(unsigned char* lds, const HgPre& pre, float lb, float& Bsum_out) {
    const int tid = TIDX, d = tid & 127, qt = tid >> 7;
    float* tot = (float*)(lds + HL_TOT); float* eB = (float*)(lds + HL_EB);
    { const int u = tid >> 4, seg = tid & 15;
      *(hu32x4*)(lds + HL_KH + ((size_t)u * QS + seg * 8) * 2) = pre.f0; *(hu32x4*)(lds + HL_KH + ((size_t)(u + 32) * QS + seg * 8) * 2) = pre.f1;
      *(hu32x4*)(lds + HL_QH + ((size_t)u * QS + seg * 8) * 2) = pre.v0; *(hu32x4*)(lds + HL_QH + ((size_t)(u + 32) * QS + seg * 8) * 2) = pre.v1;
      if (FULL) { *(hu32x4*)(lds + HL_QT + ((size_t)u * QS + seg * 8) * 2) = pre.q0; *(hu32x4*)(lds + HL_QT + ((size_t)(u + 32) * QS + seg * 8) * 2) = pre.q1; } }
    __syncthreads();
    float run = 0.f;
#pragma unroll 4
    for (int j = 0; j < 16; ++j) {
        const int u = qt * 16 + j;
        float z = bf2f(*(const bf16_t*)(lds + HL_KH + ((size_t)u * QS + d) * 2));
        z = fmaxf(z, -60.0f);
        const float f = lb + (1.0f - lb) / (1.0f + __expf(-z));
        run += __logf(f);
    }
    tot[qt * 128 + d] = run;
    __syncthreads();
    const float t0 = tot[d], t1 = tot[128 + d], t2 = tot[256 + d], t3 = tot[384 + d];
    const float off = qt == 0 ? 0.f : (qt == 1 ? t0 : (qt == 2 ? t0 + t1 : t0 + t1 + t2));
    const float r = t0 + t1, B = t0 + t1 + t2 + t3;
    const float eBr = __expf(B - r);
    if (qt == 0) eB[d] = __expf(B);
    Bsum_out = B;
    float b = off;
#pragma unroll 2
    for (int jj = 0; jj < 8; ++jj) {
        unsigned pkt = 0, pvt = 0;
#pragma unroll
        for (int q2 = 0; q2 < 2; ++q2) {
            const int u = qt * 16 + jj * 2 + q2;
            float z = bf2f(*(const bf16_t*)(lds + HL_KH + ((size_t)u * QS + d) * 2));
            z = fmaxf(z, -60.0f);
            const float f = lb + (1.0f - lb) / (1.0f + __expf(-z));
            b += __logf(f);
            const float kh = (1.0f - f) * __expf(r - b);
            const bf16_t vraw = *(const bf16_t*)(lds + HL_QH + ((size_t)u * QS + d) * 2);
            pkt |= (unsigned)f2bf(kh * eBr) << (16 * q2); pvt |= (unsigned)vraw << (16 * q2);
            if (FULL) {
                const float q = silu_f(bf2f(*(const bf16_t*)(lds + HL_QT + ((size_t)u * QS + d) * 2)));
                const float E = __expf(b);
                *(bf16_t*)(lds + HL_QT + ((size_t)u * QS + d) * 2) = f2bf(q * E);
                *(bf16_t*)(lds + HL_QH + ((size_t)u * QS + d) * 2) = f2bf(q * __expf(b - r));
                *(bf16_t*)(lds + HL_KH + ((size_t)u * QS + d) * 2) = f2bf(kh);
            }
        }
        *(unsigned*)(lds + HL_KT + ((size_t)d * KS_ + qt * 16 + jj * 2) * 2) = pkt;
        *(unsigned*)(lds + HL_VT + ((size_t)d * KS_ + qt * 16 + jj * 2) * 2) = pvt;
    }
    __syncthreads();
}
__device__ __forceinline__ void hg_state_update(unsigned char* lds, hf32x16 (&S)[2], int w, int lane) {
    const int en = w & 3, r = lane & 31, hh = lane >> 5;
    const float* eB = (const float*)(lds + HL_EB);
#pragma unroll
    for (int i = 0; i < 2; ++i) {
        const int dm = (w >> 2) * 2 + i;
#pragma unroll
        for (int g = 0; g < 4; ++g) { const float4 sc = *(const float4*)(eB + 32 * dm + 8 * g + 4 * hh);
            S[i][4 * g + 0] *= sc.x; S[i][4 * g + 1] *= sc.y; S[i][4 * g + 2] *= sc.z; S[i][4 * g + 3] *= sc.w; }
#pragma unroll
        for (int ks = 0; ks < 4; ++ks) {
            const hbf16x8 a = lds_frag(lds + HL_KT, 32 * dm + r, KS_, 16 * ks + 8 * hh);
            const hbf16x8 b = lds_frag(lds + HL_VT, 32 * en + r, KS_, 16 * ks + 8 * hh);
            S[i] = mfma32(a, b, S[i]);
        }
    }
}
__device__ __forceinline__ int hg_unit_base(int sc) { return sc * HSC; }
__device__ void ph_hg_pass1(const P& p, int l, unsigned char* lds) {
    const bf16_t* hg = (const bf16_t*)(p.ws + OFF_HG);
    const float* lbs = (const float*)(p.ws + OFF_SMALL);
    float* ust = (float*)(p.ws + OFF_HST); float* atot = (float*)(p.ws + OFF_HAT);
    const int tid = TIDX, w = tid >> 6, lane = tid & 63;
    for (int unit = blockIdx.x; unit < HNSC * 8; unit += gridDim.x) {
        const int sc = unit >> 3, h = (unit >> 1) & 3, dir = unit & 1;
        const float lb = lbs[(size_t)(dir * NLAYER + l) * D_HG + h * 128 + (tid & 127)];
        hf32x16 S[2];
#pragma unroll
        for (int i = 0; i < 2; ++i)
#pragma unroll
            for (int k = 0; k < 16; ++k) S[i][k] = 0.f;
        float Btot = 0.f;
        const int dsg = dir ? -1 : 1, tb0 = dir ? hg_unit_base(sc) + HSC - 1 : hg_unit_base(sc);
        HgPre pre;
        hg_fetch<false>(hg, pre, tb0, dsg, h, dir);
        for (int ci = 0; ci < HNCH; ++ci) {
            float B;
            hg_prep<false>(lds, pre, lb, B);
            if (ci + 1 < HNCH) hg_fetch<false>(hg, pre, tb0 + dsg * (ci + 1) * 64, dsg, h, dir);
            Btot += B;
            hg_state_update(lds, S, w, lane);
            __syncthreads();
        }
        float* U = ust + (size_t)unit * 16384;
        int r = lane & 31, hh = lane >> 5; asm volatile("" : "+v"(r), "+v"(hh));
        const int en = w & 3;
#pragma unroll
        for (int i = 0; i < 2; ++i) { const int dm = (w >> 2) * 2 + i;
#pragma unroll
            for (int k = 0; k < 16; ++k) U[(32 * dm + (k & 3) + 8 * (k >> 2) + 4 * hh) * 128 + 32 * en + r] = S[i][k]; }
        if (tid < 128) atot[(size_t)unit * 128 + tid] = __expf(Btot);
    }
}
__device__ void ph_hg_pass2(const P& p) {
    float* ust = (float*)(p.ws + OFF_HST); const float* atot = (const float*)(p.ws + OFF_HAT);
    const int total = 5 * 8 * 16384;
    for (int idx = blockIdx.x * 512 + TIDX; idx < total; idx += gridDim.x * 512) {
        const int el = idx & 16383, hd = (idx >> 14) & 7, sq = idx >> 17;
        const int sc0 = sq == 0 ? 0 : 32 + 8 * (sq - 1), nsc = sq == 0 ? 32 : 8, dir = hd & 1, d = el >> 7;
        float carry = 0.f;
        for (int j = 0; j < nsc; ++j) {
            const int sc = dir ? sc0 + nsc - 1 - j : sc0 + j;
            const size_t unit = (size_t)sc * 8 + hd;
            const float u = ust[unit * 16384 + el], a = atot[unit * 128 + d];
            ust[unit * 16384 + el] = carry;
            carry = a * carry + u;
        }
    }
}
__device__ void ph_hg_pass3(const P& p, int l, unsigned char* lds) {
    const bf16_t* hg = (const bf16_t*)(p.ws + OFF_HG);
    const float* lbs = (const float*)(p.ws + OFF_SMALL);
    const float* ust = (const float*)(p.ws + OFF_HST);
    const float* gain = PRM(p, hg_out_norm) + (size_t)l * D_HG;
    const int tid = TIDX, w = tid >> 6, lane = tid & 63, r = lane & 31, hh = lane >> 5;
    for (int unit = blockIdx.x; unit < HNSC * 4; unit += gridDim.x) {
        const int sc = unit >> 2, h = unit & 3;
        for (int dir = 0; dir < 2; ++dir) {
            const float lb = lbs[(size_t)(dir * NLAYER + l) * D_HG + h * 128 + (tid & 127)];
            const float* S0 = ust + ((size_t)sc * 8 + h * 2 + dir) * 16384;
            hf32x16 S[2];
            { const int en = w & 3;
              int r_ = r, hh_ = hh; asm volatile("" : "+v"(r_), "+v"(hh_));
              const float* S0l = S0 + (4 * hh_) * 128 + 32 * en + r_;
#pragma unroll
              for (int i = 0; i < 2; ++i) { const int dm = (w >> 2) * 2 + i;
#pragma unroll
                  for (int k = 0; k < 16; ++k) S[i][k] = S0l[(32 * dm + (k & 3) + 8 * (k >> 2)) * 128];
#pragma unroll
                  for (int g = 0; g < 4; ++g) { uint2 wv; wv.x = pack_bf2(S[i][4 * g], S[i][4 * g + 1]); wv.y = pack_bf2(S[i][4 * g + 2], S[i][4 * g + 3]);
                      *(uint2*)(lds + HL_ST + ((size_t)(32 * en + r) * QS + 32 * dm + 8 * g + 4 * hh) * 2) = wv; } } }
            const int dsg = dir ? -1 : 1, tb0 = dir ? hg_unit_base(sc) + HSC - 1 : hg_unit_base(sc);
            HgPre pre;
            hg_fetch<true>(hg, pre, tb0, dsg, h, dir);
            for (int ci = 0; ci < HNCH; ++ci) {
                const int tokbase = tb0 + dsg * ci * 64;
                float Bdummy;
                hg_prep<true>(lds, pre, lb, Bdummy);
                if (ci + 1 < HNCH) hg_fetch<true>(hg, pre, tb0 + dsg * (ci + 1) * 64, dsg, h, dir);
                if (w < 4) {
                    const int tm = (w == 0 || w == 3) ? 0 : 1, sn = (w == 2 || w == 3) ? 1 : 0;
                    hf32x16 acc;
#pragma unroll
                    for (int k = 0; k < 16; ++k) acc[k] = 0.f;
                    if (w < 3) {
#pragma unroll
                        for (int ks = 0; ks < 8; ++ks) acc = mfma32(lds_frag(lds + HL_QH, 32 * tm + r, QS, 16 * ks + 8 * hh), lds_frag(lds + HL_KH, 32 * sn + r, QS, 16 * ks + 8 * hh), acc);
                    }
                    const int s_ = 32 * sn + r;
#pragma unroll
                    for (int k = 0; k < 16; ++k) { const int t_ = 32 * tm + (k & 3) + 8 * (k >> 2) + 4 * hh;
                        const float v = (w < 3 && s_ <= t_) ? acc[k] : 0.f;
                        *(bf16_t*)(lds + HL_PM + ((size_t)t_ * KS_ + s_) * 2) = f2bf(v); }
                }
                __syncthreads();
                hf32x16 o;
                { const int tm = w >> 2, en = w & 3;
#pragma unroll
                  for (int k = 0; k < 16; ++k) o[k] = 0.f;
#pragma unroll
                  for (int ks = 0; ks < 4; ++ks) o = mfma32(lds_frag(lds + HL_PM, 32 * tm + r, KS_, 16 * ks + 8 * hh), lds_frag(lds + HL_VT, 32 * en + r, KS_, 16 * ks + 8 * hh), o);
#pragma unroll
                  for (int ks = 0; ks < 8; ++ks) o = mfma32(lds_frag(lds + HL_QT, 32 * tm + r, QS, 16 * ks + 8 * hh), lds_frag(lds + HL_ST, 32 * en + r, QS, 16 * ks + 8 * hh), o);
                }
                __syncthreads();
                { const int tm = w >> 2, en = w & 3; float* Of = (float*)(lds + HL_OF);
#pragma unroll
                  for (int k = 0; k < 16; ++k) Of[(size_t)(32 * tm + (k & 3) + 8 * (k >> 2) + 4 * hh) * OFS + 32 * en + r] = o[k]; }
                hg_state_update(lds, S, w, lane);
                { const int en = w & 3;
#pragma unroll
                  for (int i = 0; i < 2; ++i) { const int dm = (w >> 2) * 2 + i;
#pragma unroll
                      for (int g = 0; g < 4; ++g) { uint2 wv; wv.x = pack_bf2(S[i][4 * g], S[i][4 * g + 1]); wv.y = pack_bf2(S[i][4 * g + 2], S[i][4 * g + 3]);
                          *(uint2*)(lds + HL_ST + ((size_t)(32 * en + r) * QS + 32 * dm + 8 * g + 4 * hh) * 2) = wv; } } }
                __syncthreads();
                { const int u = tid >> 3, e0 = (tid & 7) * 16, tok = tokbase + dsg * u;
                  const float* Of = (const float*)(lds + HL_OF) + (size_t)u * OFS + e0;
                  bf16_t* dst = abuf_row(p, tok) + 512 + h * 128 + e0;
                  float v[16];
#pragma unroll
                  for (int j = 0; j < 4; ++j) { const float4 t4 = *(const float4*)(Of + 4 * j); v[4 * j] = t4.x; v[4 * j + 1] = t4.y; v[4 * j + 2] = t4.z; v[4 * j + 3] = t4.w; }
                  if (dir == 0) {
                      uint4 w0, w1;
                      w0.x = pack_bf2(v[0], v[1]); w0.y = pack_bf2(v[2], v[3]); w0.z = pack_bf2(v[4], v[5]); w0.w = pack_bf2(v[6], v[7]);
                      w1.x = pack_bf2(v[8], v[9]); w1.y = pack_bf2(v[10], v[11]); w1.z = pack_bf2(v[12], v[13]); w1.w = pack_bf2(v[14], v[15]);
                      ((uint4*)dst)[0] = w0; ((uint4*)dst)[1] = w1;
                  } else {
                      const uint4 f0 = ((const uint4*)dst)[0], f1 = ((const uint4*)dst)[1];
                      const unsigned fw[8] = {f0.x, f0.y, f0.z, f0.w, f1.x, f1.y, f1.z, f1.w};
                      float ss = 0.f;
#pragma unroll
                      for (int j = 0; j < 8; ++j) { v[2 * j] += __uint_as_float(fw[j] << 16); v[2 * j + 1] += __uint_as_float(fw[j] & 0xffff0000u); ss += v[2 * j] * v[2 * j] + v[2 * j + 1] * v[2 * j + 1]; }
                      ss += __shfl_xor(ss, 1); ss += __shfl_xor(ss, 2); ss += __shfl_xor(ss, 4);
                      const float rn = rsqrtf(ss * (1.0f / 128.0f) + 1e-6f);
                      const bf16_t* gp = hg + (size_t)tok * 2560 + 2048 + h * 128 + e0;
                      const uint4 g0 = ((const uint4*)gp)[0], g1 = ((const uint4*)gp)[1];
                      const unsigned gw[8] = {g0.x, g0.y, g0.z, g0.w, g1.x, g1.y, g1.z, g1.w};
                      unsigned ow[8];
#pragma unroll
                      for (int j = 0; j < 8; ++j) { const float ga = silu_f(__uint_as_float(gw[j] << 16)), gb = silu_f(__uint_as_float(gw[j] & 0xffff0000u));
                          ow[j] = pack_bf2(v[2 * j] * rn * gain[h * 128 + e0 + 2 * j] * ga, v[2 * j + 1] * rn * gain[h * 128 + e0 + 2 * j + 1] * gb); }
                      ((uint4*)dst)[0] = make_uint4(ow[0], ow[1], ow[2], ow[3]); ((uint4*)dst)[1] = make_uint4(ow[4], ow[5], ow[6], ow[7]);
                  }
                }
                __syncthreads();
            }
        }
    }
}
enum { PH_SETUP, PH_CONVERT, PH_RMS_IN, PH_GEMM_IN, PH_HY_PREP, PH_FILTER, PH_HGRN, PH_HG_NORM, PH_HY_FFT, PH_HY_NORM, PH_GEMM_OUT, PH_NR0, PH_GEMM_UP, PH_GEGLU, PH_GEMM_DN, PH_NR1, PH_HG_P1, PH_HG_P2, PH_HG_P3 };
template <int PH> __device__ __forceinline__ void run_phase(const P& p_in, int l, int part, unsigned char* lds) {
    P p = p_in; asm volatile("" : "+s"(p.ws), "+s"(p.out));
    if constexpr (PH == PH_SETUP) { ph_setup(p); ph_copy_params(p); }
    if constexpr (PH == PH_CONVERT) ph_convert_w(p, l, lds);
    if constexpr (PH == PH_RMS_IN) ph_rmsnorm_in(p, l);
    if constexpr (PH == PH_GEMM_IN) { EpiBf16Split E; E.O0 = (bf16_t*)(p.ws + OFF_HYRAW); E.ldc0 = 1536; E.O1 = (bf16_t*)(p.ws + OFF_HG); E.ldc1 = 2560; E.csplit = 1536;
        run_gemm(lds, abuf_row(p, 0), (const bf16_t*)(p.ws + OFF_W_IN), T_TOK, D_IN, DM, E); }
    if constexpr (PH == PH_HY_PREP) ph_hy_prep(p, l, lds);
    if constexpr (PH == PH_FILTER) ph_filter(p, l, lds);
    if constexpr (PH == PH_HGRN) ph_hgrn_naive(p, l, lds);
    if constexpr (PH == PH_HG_NORM) ph_hg_norm(p, l);
    if constexpr (PH == PH_HY_FFT) ph_hy_fft(p, l, lds);
    if constexpr (PH == PH_HY_NORM) ph_hy_norm(p, l, lds);
    if constexpr (PH == PH_GEMM_OUT) { EpiBf16Split E; E.O0 = (bf16_t*)(p.ws + OFF_MIX); E.ldc0 = DM; E.O1 = E.O0; E.ldc1 = DM; E.csplit = 1 << 30;
        run_gemm(lds, abuf_row(p, 0), (const bf16_t*)(p.ws + OFF_W_OUT), T_TOK, DM, DM, E); }
    if constexpr (PH == PH_NR0) ph_norm_resid(p, l, 0);
    if constexpr (PH == PH_GEMM_UP) { EpiBf16Split E; E.O0 = (bf16_t*)(p.ws + OFF_UPART); E.ldc0 = 2 * DFF; E.O1 = E.O0; E.ldc1 = 2 * DFF; E.csplit = 1 << 30;
        run_gemm(lds, abuf_row(p, part * 4096 - 256), (const bf16_t*)(p.ws + OFF_W_UP), 4608, 2 * DFF, DM, E); }
    if constexpr (PH == PH_GEGLU) ph_geglu_part(p, l, part * 4096);
    if constexpr (PH == PH_GEMM_DN) { EpiBf16Split E; E.O0 = (bf16_t*)(p.ws + OFF_MIX); E.ldc0 = DM; E.O1 = E.O0; E.ldc1 = DM; E.csplit = 1 << 30;
        run_gemm(lds, (const bf16_t*)(p.ws + OFF_ACT), (const bf16_t*)(p.ws + OFF_W_DN), T_TOK, DM, DFF, E); }
    if constexpr (PH == PH_NR1) ph_norm_resid(p, l, 1);
    if constexpr (PH == PH_HG_P1) ph_hg_pass1(p, l, lds);
    if constexpr (PH == PH_HG_P2) ph_hg_pass2(p);
    if constexpr (PH == PH_HG_P3) ph_hg_pass3(p, l, lds);
}
constexpr int LDS_BYTES = 139264;
__global__ __launch_bounds__(512, 2) void mega(P p) {
    extern __shared__ __attribute__((aligned(16))) unsigned char lds[];
    cg::grid_group grid = cg::this_grid();
    run_phase<PH_SETUP>(p, 0, 0, lds);
    run_phase<PH_CONVERT>(p, 0, 0, lds);
    run_phase<PH_RMS_IN>(p, 0, 0, lds);
    grid.sync();
#pragma unroll 1
    for (int l = 0; l < NLAYER; ++l) {
        run_phase<PH_GEMM_IN>(p, l, 0, lds); grid.sync();
        run_phase<PH_HY_PREP>(p, l, 0, lds); run_phase<PH_HG_P1>(p, l, 0, lds); grid.sync();
        run_phase<PH_FILTER>(p, l, 0, lds); run_phase<PH_HG_P2>(p, l, 0, lds); grid.sync();
        run_phase<PH_HG_P3>(p, l, 0, lds); run_phase<PH_HY_FFT>(p, l, 0, lds); grid.sync();
        run_phase<PH_HY_NORM>(p, l, 0, lds); grid.sync();
        run_phase<PH_GEMM_OUT>(p, l, 0, lds); grid.sync();
        run_phase<PH_NR0>(p, l, 0, lds); grid.sync();
#pragma unroll 1
        for (int part = 0; part < 8; ++part) { run_phase<PH_GEMM_UP>(p, l, part, lds); grid.sync(); run_phase<PH_GEGLU>(p, l, part, lds); grid.sync(); }
        run_phase<PH_GEMM_DN>(p, l, 0, lds); grid.sync();
        run_phase<PH_NR1>(p, l, 0, lds);
        if (l + 1 < NLAYER) { run_phase<PH_CONVERT>(p, l + 1, 0, lds); grid.sync(); }
    }
}
extern "C" void kernel_launch(void* const* d_in, const int* in_sizes, int n_in, void* d_out, int out_size, void* d_ws, size_t ws_size, hipStream_t stream) {
    if (ws_size < WS_NEED) { fprintf(stderr, "workspace too small: %zu < %zu\n", ws_size, (size_t)WS_NEED); return; }
    static int grid_blocks = 0;
    if (!grid_blocks) {
        hipFuncSetAttribute((const void*)mega, hipFuncAttributeMaxDynamicSharedMemorySize, LDS_BYTES);
        int dev = 0, cus = 0, per_cu = 0;
        hipGetDevice(&dev);
        hipDeviceGetAttribute(&cus, hipDeviceAttributeMultiprocessorCount, dev);
        hipOccupancyMaxActiveBlocksPerMultiprocessor(&per_cu, mega, 512, LDS_BYTES);
        if (per_cu > 1) per_cu = 1;
        grid_blocks = cus * per_cu;
    }
    P p{};
    for (int i = 0; i < 26; ++i) p.in[i] = (const float*)d_in[i];
    p.out = (float*)d_out; p.ws = (unsigned char*)d_ws;
    void* args[] = {&p};
    hipError_t e = hipLaunchCooperativeKernel((void*)mega, dim3(grid_blocks), dim3(512), args, LDS_BYTES, stream);
    if (e != hipSuccess) fprintf(stderr, "cooperative launch failed: %s (grid %d)\n", hipGetErrorString(e), grid_blocks);
}
```

```cpp
#include <hip/hip_runtime.h>
#include <hip/hip_cooperative_groups.h>
#include <cstdio>
#include <cstdint>
namespace cg = cooperative_groups;
__device__ __forceinline__ int tid_opaque() { int t = (int)threadIdx.x; asm volatile("" : "+v"(t)); return t; }
#define TIDX tid_opaque()
namespace pg8 {
#define PG8_LAS __attribute__((address_space(3)))
typedef unsigned short bf16_t;
typedef short bf16x8 __attribute__((ext_vector_type(8)));
typedef float f32x4 __attribute__((ext_vector_type(4)));
typedef unsigned u32x4 __attribute__((ext_vector_type(4)));
constexpr int BM = 256, BK = 64, HALF = 128, HTB = HALF * BK * 2  , STAGE_BYTES = 8 * HTB, NXCD = 8, WGM = 8;

__host__ __device__ __forceinline__ int lds_byte(int r, int c) { const int st = (r >> 4) * 2 + (c >> 5), rr = r & 15, cc = c & 31, ob = rr * 64 + cc * 2; return st * 1024 + (ob ^ (((ob >> 9) & 1) << 5)); }
__host__ __device__ __forceinline__ void stage_rc(int b, int& R, int& C) { const int st = b / 1024, sb = b % 1024, swz = sb ^ (((sb >> 9) & 1) << 5); R = (st >> 1) * 16 + swz / 64; C = (st & 1) * 32 + (swz % 64) / 2; }
__host__ __device__ __forceinline__ int perm32(int rho) { const int n = rho >> 4, i = rho & 15; return 8 * (i >> 2) + 4 * n + (i & 3); }

struct Unit { int pm, pn; };
struct Gemm { const bf16_t* A; const bf16_t* Bt; int M, N, K; int ovl; };

struct StaticOrder {
    int nM, nN, nwg, G, c;
    __host__ __device__ void init(int M, int N, int G_, int c_) { nM = M / BM; nN = N / BM; nwg = nM * nN; G = G_; c = c_; }
    __host__ __device__ bool next(int i, Unit& u) const {
        const long L = (long)i * G + c; if (L >= nwg) return false;
        int wgid = (int)L; { const int q = nwg / NXCD, r = nwg % NXCD, xcd = wgid % NXCD, off = wgid / NXCD; wgid = (xcd < r ? xcd * (q + 1) : r * (q + 1) + (xcd - r) * q) + off; }
        const int nig = WGM * nN, gid = wgid / nig, fm = gid * WGM, gsz = (nM - fm) < WGM ? (nM - fm) : WGM;
        u.pm = fm + ((wgid % nig) % gsz); u.pn = (wgid % nig) / gsz; return true;
    }
    __device__ __forceinline__ void a_ready(const Unit&) const {}
    __device__ __forceinline__ void done(const Unit&) const {}
};
struct CountedOrder : StaticOrder {
    const unsigned* ready; unsigned need; unsigned* tmo;
    __device__ __forceinline__ void a_ready(const Unit& u) const {
        if (TIDX < 64) {
            const unsigned long long t0 = __builtin_amdgcn_s_memrealtime(); unsigned polls = 0;
            while ((unsigned)__builtin_amdgcn_readfirstlane(__hip_atomic_load(ready + 64 * u.pm, __ATOMIC_RELAXED, __HIP_MEMORY_SCOPE_AGENT)) < need) {
                if ((++polls & 255u) == 0u && __builtin_amdgcn_readfirstlane(__hip_atomic_load(tmo, __ATOMIC_RELAXED, __HIP_MEMORY_SCOPE_AGENT)) != 0u) break;
                if (__builtin_amdgcn_s_memrealtime() - t0 > 2000000ull) {
                    if (TIDX == 0) { unsigned expect = 0u; __hip_atomic_compare_exchange_strong(tmo + 1, &expect, 0x600u | (unsigned)(u.pm & 0xff), __ATOMIC_RELAXED, __ATOMIC_RELAXED, __HIP_MEMORY_SCOPE_AGENT); __hip_atomic_store(tmo, 1u, __ATOMIC_RELAXED, __HIP_MEMORY_SCOPE_AGENT); }
                    break; }
                __builtin_amdgcn_s_sleep(2); }
            __builtin_amdgcn_fence(__ATOMIC_ACQUIRE, "agent");
            asm volatile("s_waitcnt vmcnt(0)" ::: "memory");
        }
#if !defined(BROKEN_HOOK_NO_BARRIER)
        asm volatile("" ::: "memory"); __builtin_amdgcn_s_barrier(); asm volatile("" ::: "memory");
#endif
    }
};

__device__ __forceinline__ unsigned cvt_pk_bf16(float lo, float hi) { unsigned r; asm volatile("v_cvt_pk_bf16_f32 %0, %1, %2" : "=v"(r) : "v"(lo), "v"(hi)); return r; }
typedef float f32x2 __attribute__((ext_vector_type(2)));
__device__ __forceinline__ f32x2 gelu_pk(f32x2 v) {
    const f32x2 av = __builtin_elementwise_abs(v), d = av * 0.2316418882f + 1.0f;
    f32x2 t; t.x = __builtin_amdgcn_rcpf(d.x); t.y = __builtin_amdgcn_rcpf(d.y);
    f32x2 q = t * 0.5307027145f + (-0.7265760135f); q = q * t + 0.7107068705f; q = q * t + (-0.142248368f); q = q * t + 0.127414796f; q = q * t;
    const f32x2 s = (v * v) * (-0.72134752044f);
    f32x2 e; e.x = __builtin_amdgcn_exp2f(s.x); e.y = __builtin_amdgcn_exp2f(s.y);
    const f32x2 m = v * (q * e), r = v - m;
    f32x2 o; o.x = v.x < 0.f ? m.x : r.x; o.y = v.y < 0.f ? m.y : r.y; return o;
}

struct EpiF32 {
    static constexpr bool PERM = false, AFTER_DRAIN = false;
    float* C; int ldc; const float* bias;
    __device__ __forceinline__ void operator()(const f32x4 (&acc)[2][2][4][2], const Unit& u, int wr, int wc, int fr, int fq) const {
        const int row0 = u.pm * BM + wr * 64 + fr, col0 = u.pn * BM + wc * 32 + 4 * fq;
        f32x4 bv[2][2];
#pragma unroll
        for (int bj = 0; bj < 2; ++bj)
#pragma unroll
            for (int n = 0; n < 2; ++n) bv[bj][n] = bias ? *(const f32x4*)(bias + col0 + bj * HALF + n * 16) : (f32x4){0.f, 0.f, 0.f, 0.f};
#pragma unroll
        for (int ai = 0; ai < 2; ++ai)
#pragma unroll
            for (int m = 0; m < 4; ++m) { float* rowp = C + (size_t)(row0 + ai * HALF + m * 16) * ldc + col0;
#pragma unroll
                for (int bj = 0; bj < 2; ++bj)
#pragma unroll
                    for (int n = 0; n < 2; ++n) *(f32x4*)(rowp + bj * HALF + n * 16) = acc[ai][bj][m][n] + bv[bj][n]; }
    }
};
template <int ACT  > struct EpiBf16 {
    static constexpr bool PERM = true, AFTER_DRAIN = false;
    bf16_t* O; int ldc; const float* bias; int split_cols; size_t split_stride;
    __device__ __forceinline__ void operator()(const f32x4 (&acc)[2][2][4][2], const Unit& u, int wr, int wc, int fr, int fq) const {
        const int row0 = u.pm * BM + wr * 64 + fr; int colt = u.pn * BM; bf16_t* base = O;
        if (split_cols) { const int t = colt / split_cols; base += (size_t)t * split_stride; colt -= t * split_cols; }
        const int col0 = colt + wc * 32 + 8 * fq, bcol0 = u.pn * BM + wc * 32 + 8 * fq;
        f32x4 bv[2][2];
#pragma unroll
        for (int bj = 0; bj < 2; ++bj)
#pragma unroll
            for (int n = 0; n < 2; ++n) bv[bj][n] = bias ? *(const f32x4*)(bias + bcol0 + bj * HALF + 4 * n) : (f32x4){0.f, 0.f, 0.f, 0.f};
#pragma unroll
        for (int ai = 0; ai < 2; ++ai)
#pragma unroll
            for (int m = 0; m < 4; ++m) { bf16_t* rowp = base + (size_t)(row0 + ai * HALF + m * 16) * ldc + col0;
#pragma unroll
                for (int bj = 0; bj < 2; ++bj) { f32x4 v0 = acc[ai][bj][m][0] + bv[bj][0], v1 = acc[ai][bj][m][1] + bv[bj][1];
                    if (ACT == 1) { f32x2 a = gelu_pk((f32x2){v0[0], v0[1]}), b = gelu_pk((f32x2){v0[2], v0[3]}), c = gelu_pk((f32x2){v1[0], v1[1]}), d = gelu_pk((f32x2){v1[2], v1[3]});
                        v0 = (f32x4){a.x, a.y, b.x, b.y}; v1 = (f32x4){c.x, c.y, d.x, d.y}; }
                    if (ACT == 2) {
#pragma unroll
                        for (int j = 0; j < 4; ++j) { v0[j] = 0.5f * v0[j] * (1.0f + erff(v0[j] * 0.70710678f)); v1[j] = 0.5f * v1[j] * (1.0f + erff(v1[j] * 0.70710678f)); } }
                    u32x4 w; w.x = cvt_pk_bf16(v0[0], v0[1]); w.y = cvt_pk_bf16(v0[2], v0[3]); w.z = cvt_pk_bf16(v1[0], v1[1]); w.w = cvt_pk_bf16(v1[2], v1[3]);
                    *(u32x4*)(rowp + bj * HALF) = w; } }
    }
};
template <class Epi, class Sched, bool STAMP = false>
__device__ __forceinline__ void gemm_phase(PG8_LAS unsigned char* lds, const Gemm g, const Sched& S, const Epi& E, unsigned long long* stamps) {
    const int tid = TIDX, wid = __builtin_amdgcn_readfirstlane(tid >> 6), lane = tid & 63, wr = wid >> 2, wc = wid & 3, fr = lane & 15, fq = lane >> 4;
    const int K = g.K, nt = K / BK;
    int ts_lo = 0, ts_hi = 0, nts = 0; const unsigned long long rt_entry = STAMP ? (unsigned long long)wall_clock64() : 0ull;
#define PG8_STAMP() do { if (STAMP && wid == 0 && nts < 64) { const unsigned long long _c = (unsigned long long)clock64(); \
        ts_lo = (lane == nts) ? (int)(unsigned)_c : ts_lo; ts_hi = (lane == nts) ? (int)(unsigned)(_c >> 32) : ts_hi; ++nts; } } while (0)
    PG8_STAMP();
    unsigned voffA[2], voffB[2];
#pragma unroll
    for (int i = 0; i < 2; ++i) { int R, C; stage_rc(tid * 16 + i * 8192, R, C); const int Rb = Epi::PERM ? ((R & ~31) + perm32(R & 31)) : R;
        const int Ra = g.ovl ? R - 2 * (R >> 6) : R; voffA[i] = (unsigned)(Ra * K + C) * 2u; voffB[i] = (unsigned)(Rb * K + C) * 2u; }
    const size_t kstep = (size_t)(BK * 2);
    const size_t hstep = (size_t)HALF * K * 2;
    const size_t tstep = 2 * hstep;
    const size_t hstepA = g.ovl ? (size_t)124 * K * 2 : hstep, tstepA = g.ovl ? (size_t)248 * K * 2 : tstep;
    const unsigned ldsw = (unsigned)wid * 1024u;
    const int aoff = lds_byte(wr * 64 + fr, fq * 8), boff = lds_byte(wc * 32 + fr, fq * 8);
#define PG8_SA(b, h) (((b) * 2 + (h)) * HTB)
#define PG8_SB(b, h) ((4 + (b) * 2 + (h)) * HTB)
#define PG8_STAGE(bufoff, gbase, voff) do { _Pragma("unroll") for (int _i = 0; _i < 2; ++_i) \
        __builtin_amdgcn_global_load_lds((const unsigned*)((const char*)(gbase) + (voff)[_i]), (PG8_LAS unsigned*)(lds + (bufoff) + ldsw + _i * 8192), 16, 0, 0); } while (0)
#define PG8_LDA(dst, b, h) do { _Pragma("unroll") for (int m = 0; m < 4; ++m) _Pragma("unroll") for (int k = 0; k < 2; ++k) dst[m][k] = *(const PG8_LAS bf16x8*)(lds + PG8_SA(b, h) + aoff + m * 2048 + k * 1024); } while (0)
#define PG8_LDB(dst, b, h) do { _Pragma("unroll") for (int n = 0; n < 2; ++n) _Pragma("unroll") for (int k = 0; k < 2; ++k) dst[n][k] = *(const PG8_LAS bf16x8*)(lds + PG8_SB(b, h) + boff + n * 2048 + k * 1024); } while (0)
#define PG8_MMA(ai, bj, At, Bt) do { __builtin_amdgcn_s_setprio(1); _Pragma("unroll") for (int m = 0; m < 4; ++m) _Pragma("unroll") for (int n = 0; n < 2; ++n) _Pragma("unroll") for (int k = 0; k < 2; ++k) \
        acc[ai][bj][m][n] = __builtin_amdgcn_mfma_f32_16x16x32_bf16(Bt[n][k], At[m][k], acc[ai][bj][m][n], 0, 0, 0); __builtin_amdgcn_s_setprio(0); } while (0)
#define PG8_WAIT_V(n) asm volatile("s_waitcnt vmcnt(" #n ")" ::: "memory")
#define PG8_WAIT_L(n) asm volatile("s_waitcnt lgkmcnt(" #n ")" ::: "memory")
#define PG8_BAR __builtin_amdgcn_s_barrier()
#define PG8_SCHED __builtin_amdgcn_sched_barrier(0)
    Unit cur, nxt; int ui = 0;
    if (!S.next(0, cur)) return;
    f32x4 acc[2][2][4][2];
#pragma unroll
    for (int a = 0; a < 2; ++a)
#pragma unroll
        for (int b = 0; b < 2; ++b)
#pragma unroll
            for (int m = 0; m < 4; ++m)
#pragma unroll
                for (int n = 0; n < 2; ++n) acc[a][b][m][n] = (f32x4){0.f, 0.f, 0.f, 0.f};
    bf16x8 At[4][2], B0[2][2], B1[2][2];
    const char* cA = (const char*)g.A + (size_t)cur.pm * tstepA; const char* cB = (const char*)g.Bt + (size_t)cur.pn * tstep;
    S.a_ready(cur);
    PG8_STAGE(PG8_SB(0, 0), cB, voffB); PG8_STAGE(PG8_SA(0, 0), cA, voffA); PG8_STAGE(PG8_SB(0, 1), cB + hstep, voffB); PG8_STAGE(PG8_SA(0, 1), cA + hstepA, voffA);
    if (wr == 1) PG8_BAR;
    PG8_WAIT_V(4); PG8_BAR;
    PG8_STAGE(PG8_SB(1, 0), cB + kstep, voffB); PG8_STAGE(PG8_SA(1, 0), cA + kstep, voffA); PG8_STAGE(PG8_SB(1, 1), cB + hstep + kstep, voffB);
    PG8_WAIT_V(6); PG8_BAR;
    PG8_STAMP();
    for (;;) {
        const bool has_next = S.next(ui + 1, nxt);
        const char* nA = has_next ? (const char*)g.A + (size_t)nxt.pm * tstepA : cA; const char* nB = has_next ? (const char*)g.Bt + (size_t)nxt.pn * tstep : cB;
        for (int t = 0; t < nt; t += 2) {
            const bool last = (t == nt - 2);
            const char* a1 = cA + (size_t)(t + 1) * kstep;
            const char* a2 = last ? nA : cA + (size_t)(t + 2) * kstep; const char* b2 = last ? nB : cB + (size_t)(t + 2) * kstep;
            const char* a3 = a2 + kstep; const char* b3 = b2 + kstep;
            if (last && has_next) S.a_ready(nxt);
            PG8_LDB(B0, 0, 0); PG8_SCHED; PG8_LDA(At, 0, 0); PG8_STAGE(PG8_SA(1, 1), a1 + hstepA, voffA);
            PG8_WAIT_L(8); PG8_BAR; PG8_WAIT_L(0); PG8_MMA(0, 0, At, B0); PG8_BAR; PG8_SCHED;
            PG8_LDB(B1, 0, 1); PG8_STAGE(PG8_SB(0, 0), b2, voffB);
            PG8_BAR; PG8_WAIT_L(0); PG8_MMA(0, 1, At, B1); PG8_BAR;
            PG8_LDA(At, 0, 1); PG8_STAGE(PG8_SA(0, 0), a2, voffA);
            PG8_BAR; PG8_WAIT_L(0); PG8_MMA(1, 0, At, B0); PG8_BAR; PG8_SCHED;
            PG8_STAGE(PG8_SB(0, 1), b2 + hstep, voffB);
            PG8_WAIT_V(6); PG8_BAR; PG8_MMA(1, 1, At, B1); PG8_BAR;
            PG8_LDB(B0, 1, 0); PG8_SCHED; PG8_LDA(At, 1, 0); PG8_STAGE(PG8_SA(0, 1), a2 + hstepA, voffA);
            PG8_WAIT_L(8); PG8_BAR; PG8_WAIT_L(0); PG8_MMA(0, 0, At, B0); PG8_BAR; PG8_SCHED;
            PG8_LDB(B1, 1, 1); PG8_STAGE(PG8_SB(1, 0), b3, voffB);
            PG8_BAR; PG8_WAIT_L(0); PG8_MMA(0, 1, At, B1); PG8_BAR;
            PG8_LDA(At, 1, 1); PG8_STAGE(PG8_SA(1, 0), a3, voffA);
            PG8_BAR; PG8_WAIT_L(0); PG8_MMA(1, 0, At, B0); PG8_BAR; PG8_SCHED;
            PG8_STAGE(PG8_SB(1, 1), b3 + hstep, voffB);
            PG8_WAIT_V(6); PG8_BAR; PG8_MMA(1, 1, At, B1); PG8_BAR;
        }
        PG8_STAMP();
        if constexpr (!Epi::AFTER_DRAIN) { E(acc, cur, wr, wc, fr, fq); S.done(cur); }
        PG8_STAMP();
        if (!has_next) break;
#pragma unroll
        for (int a = 0; a < 2; ++a)
#pragma unroll
            for (int b = 0; b < 2; ++b)
#pragma unroll
                for (int m = 0; m < 4; ++m)
#pragma unroll
                    for (int n = 0; n < 2; ++n) acc[a][b][m][n] = (f32x4){0.f, 0.f, 0.f, 0.f};
        cur = nxt; cA = nA; cB = nB; ++ui;
    }
    PG8_WAIT_V(0);
    if (wr == 0) PG8_BAR;
    PG8_BAR;
    if constexpr (Epi::AFTER_DRAIN) { E.fused(acc, cur, wr, wc, fr, fq, lds, wid, lane); S.done(cur); }
    PG8_STAMP();
    if (STAMP && wid == 0) { stamps[lane] = lane < nts ? (((unsigned long long)(unsigned)ts_hi << 32) | (unsigned)ts_lo) : 0ull;
        if (lane == 62) stamps[62] = rt_entry; if (lane == 63) stamps[63] = (unsigned long long)wall_clock64(); }
#undef PG8_STAMP
#undef PG8_SA
#undef PG8_SB
#undef PG8_STAGE
#undef PG8_LDA
#undef PG8_LDB
#undef PG8_MMA
#undef PG8_WAIT_V
#undef PG8_WAIT_L
#undef PG8_BAR
#undef PG8_SCHED
}
}
typedef unsigned short bf16_t;
constexpr int T_TOK = 32768, DM = 1024, D_IN = 4096, D_HY = 512, D_HG = 512, DFF = 4096, NLAYER = 4;
constexpr int L_BIG = 16384, L_SML = 4096;
constexpr int APAD = 256;
constexpr size_t MiB = 1024ull * 1024ull;
constexpr size_t OFF_W = 0;
constexpr size_t OFF_W_IN = OFF_W, OFF_W_OUT = OFF_W + 8 * MiB, OFF_W_UP = OFF_W + 10 * MiB, OFF_W_DN = OFF_W + 26 * MiB;
constexpr size_t OFF_ABUF = 34 * MiB;
constexpr size_t OFF_R1 = 99 * MiB;
constexpr size_t OFF_HYRAW = OFF_R1;
constexpr size_t OFF_HG = OFF_R1 + 96 * MiB;
constexpr size_t OFF_KT = OFF_R1;
constexpr size_t OFF_ACT = OFF_R1;
constexpr size_t OFF_R2 = 355 * MiB;
constexpr size_t OFF_X0T = OFF_R2, OFF_ZT = OFF_R2 + 32 * MiB;
constexpr size_t OFF_MIX = OFF_R2;
constexpr size_t OFF_UPART = OFF_R2;
constexpr size_t OFF_R6 = 419 * MiB;
constexpr size_t OFF_OBUF = OFF_R6;
constexpr size_t OFF_KS = OFF_R6;
constexpr size_t OFF_SMALL = 483 * MiB;
constexpr size_t WS_NEED = 487 * MiB;

struct P { const float* in[26]; float* out; unsigned char* ws; };
constexpr int PB_norm_mix_pre = 0;
constexpr int PB_norm_mix_post = 4096;
constexpr int PB_norm_ffn_pre = 8192;
constexpr int PB_norm_ffn_post = 12288;
constexpr int PB_hy_conv_w = 16384;
constexpr int PB_hy_conv_b = 34816;
constexpr int PB_f_w1 = 40960;
constexpr int PB_f_b1 = 49408;
constexpr int PB_f_w2 = 49664;
constexpr int PB_f_b2 = 66048;
constexpr int PB_f_w3 = 66304;
constexpr int PB_f_b3 = 82688;
constexpr int PB_f_w4 = 82944;
constexpr int PB_f_freq = 345088;
constexpr int PB_hy_skip = 345344;
constexpr int PB_hy_out_norm = 347392;
constexpr int PB_lb_table = 349440;
constexpr int PB_hg_out_norm = 353536;
constexpr int PB_ffn_conv_w = 355584;
constexpr int PB_ffn_conv_b = 453888;
constexpr int PB_TOTAL = 486656;
constexpr size_t OFF_PB = OFF_SMALL + 512 * 1024;
#define PRM(p, NAME) ((const float*)((p).ws + OFF_PB) + PB_##NAME)

__device__ __forceinline__ float bf2f(bf16_t b) { return __uint_as_float(((unsigned)b) << 16); }
__device__ __forceinline__ bf16_t f2bf(float f) { unsigned u = __float_as_uint(f); u += 0x7FFFu + ((u >> 16) & 1u); return (bf16_t)(u >> 16); }
__device__ __forceinline__ unsigned pack_bf2(float lo, float hi) { return (unsigned)f2bf(lo) | ((unsigned)f2bf(hi) << 16); }
__device__ __forceinline__ bool seq_start(int t) { return t < L_BIG ? (t == 0) : ((t & (L_SML - 1)) == 0); }
__device__ __forceinline__ bool seq_end(int t) { return (t + 1 == T_TOK) || seq_start(t + 1); }
__device__ __forceinline__ const float* x_src_row(const P& p, int l, int t) {
    if (l > 0) return p.out + (size_t)t * DM;
    return t < L_BIG ? p.in[0] + (size_t)t * DM : p.in[1] + (size_t)(t - L_BIG) * DM;
}
__device__ __forceinline__ float silu_f(float x) { return x / (1.0f + __expf(-x)); }
__device__ __forceinline__ float wave_sum(float v) {
#pragma unroll
    for (int o = 32; o >= 1; o >>= 1) v += __shfl_xor(v, o);
    return v;
}

struct EpiBf16Split {
    static constexpr bool PERM = true, AFTER_DRAIN = false, OVL = false;
    bf16_t* O0; int ldc0; bf16_t* O1; int ldc1; int csplit;
    __device__ __forceinline__ void operator()(const pg8::f32x4 (&acc)[2][2][4][2], const pg8::Unit& u, int wr, int wc, int fr, int fq) const {
        const int row0 = u.pm * pg8::BM + wr * 64 + fr; int colt = u.pn * pg8::BM; bf16_t* base = O0; int ldc = ldc0;
        if (colt >= csplit) { base = O1; ldc = ldc1; colt -= csplit; }
        const int col0 = colt + wc * 32 + 8 * fq;
#pragma unroll
        for (int ai = 0; ai < 2; ++ai)
#pragma unroll
            for (int m = 0; m < 4; ++m) { bf16_t* rowp = base + (size_t)(row0 + ai * pg8::HALF + m * 16) * ldc + col0;
#pragma unroll
                for (int bj = 0; bj < 2; ++bj) { const pg8::f32x4 v0 = acc[ai][bj][m][0], v1 = acc[ai][bj][m][1];
                    pg8::u32x4 w; w.x = pg8::cvt_pk_bf16(v0[0], v0[1]); w.y = pg8::cvt_pk_bf16(v0[2], v0[3]); w.z = pg8::cvt_pk_bf16(v1[0], v1[1]); w.w = pg8::cvt_pk_bf16(v1[2], v1[3]);
                    *(pg8::u32x4*)(rowp + bj * pg8::HALF) = w; } }
    }
};
__device__ __forceinline__ float dpp_ror1(float v) { return __int_as_float(__builtin_amdgcn_update_dpp(0, __float_as_int(v), 0x121, 0xF, 0xF, false)); }
__device__ __forceinline__ float dpp_ror15(float v) { return __int_as_float(__builtin_amdgcn_update_dpp(0, __float_as_int(v), 0x12F, 0xF, 0xF, false)); }
__device__ __forceinline__ float gelu_tanh_e(float x) { const float y = 1.5957691216057308f * (x + 0.044715f * x * x * x); return x * __builtin_amdgcn_rcpf(1.0f + __expf(-y)); }
struct EpiGeglu {
    static constexpr bool PERM = true, AFTER_DRAIN = false, OVL = true;
    bf16_t* act; const float* cw; const float* cb;
    __device__ __forceinline__ void operator()(const pg8::f32x4 (&acc)[2][2][4][2], const pg8::Unit& u, int wr, int wc, int fr, int fq) const {
        const int j0 = u.pn * 128 + wc * 32 + 8 * fq;
        unsigned mprev = 0, mnext = 0, mst = 0;
#pragma unroll
        for (int ai = 0; ai < 2; ++ai)
#pragma unroll
            for (int m = 0; m < 4; ++m) { const int q = 16 * m + fr, tok = u.pm * 248 + 124 * ai + 62 * wr + q - 1, b = ai * 4 + m;
                const bool st = q >= 1 && q <= 62 && tok < T_TOK;
                if (st) { mst |= 1u << b; if (!seq_start(tok)) mprev |= 1u << b; if (!seq_end(tok)) mnext |= 1u << b; } }
#pragma unroll
        for (int n = 0; n < 2; ++n) {
            const int jc = j0 + 4 * n;
            const pg8::f32x4 wa0 = *(const pg8::f32x4*)(cw + jc), wa1 = *(const pg8::f32x4*)(cw + 8192 + jc), wa2 = *(const pg8::f32x4*)(cw + 16384 + jc), ba = *(const pg8::f32x4*)(cb + jc);
            const pg8::f32x4 wb0 = *(const pg8::f32x4*)(cw + 4096 + jc), wb1 = *(const pg8::f32x4*)(cw + 8192 + 4096 + jc), wb2 = *(const pg8::f32x4*)(cw + 16384 + 4096 + jc), bb = *(const pg8::f32x4*)(cb + 4096 + jc);
#pragma unroll
            for (int ai = 0; ai < 2; ++ai) {
                pg8::f32x4 pa_prev, pb_prev, na_cur, nb_cur;
#pragma unroll
                for (int i = 0; i < 4; ++i) { na_cur[i] = dpp_ror15(acc[ai][0][0][n][i]); nb_cur[i] = dpp_ror15(acc[ai][1][0][n][i]); pa_prev[i] = 0.f; pb_prev[i] = 0.f; }
#pragma unroll
                for (int m = 0; m < 4; ++m) {
                    const int b = ai * 4 + m, q = 16 * m + fr, tok = u.pm * 248 + 124 * ai + 62 * wr + q - 1;
                    const bool hp = (mprev >> b) & 1u, hn = (mnext >> b) & 1u;
                    pg8::f32x4 pa_cur, pb_cur, na_next, nb_next;
#pragma unroll
                    for (int i = 0; i < 4; ++i) { pa_cur[i] = dpp_ror1(acc[ai][0][m][n][i]); pb_cur[i] = dpp_ror1(acc[ai][1][m][n][i]);
                        na_next[i] = m < 3 ? dpp_ror15(acc[ai][0][m < 3 ? m + 1 : 3][n][i]) : 0.f; nb_next[i] = m < 3 ? dpp_ror15(acc[ai][1][m < 3 ? m + 1 : 3][n][i]) : 0.f; }
                    const pg8::f32x4 xpa = (fr == 0) ? pa_prev : pa_cur, xna = (fr == 15) ? na_next : na_cur;
                    const pg8::f32x4 xpb = (fr == 0) ? pb_prev : pb_cur, xnb = (fr == 15) ? nb_next : nb_cur;
                    const pg8::f32x4 xa = acc[ai][0][m][n], xb = acc[ai][1][m][n];
                    float o[4];
#pragma unroll
                    for (int i = 0; i < 4; ++i) {
                        const float ya = (hp ? xpa[i] * wa0[i] : 0.f) + xa[i] * wa1[i] + (hn ? xna[i] * wa2[i] : 0.f) + ba[i];
                        const float yb = (hp ? xpb[i] * wb0[i] : 0.f) + xb[i] * wb1[i] + (hn ? xnb[i] * wb2[i] : 0.f) + bb[i];
                        o[i] = gelu_tanh_e(ya) * yb;
                    }
                    if ((mst >> b) & 1u) { uint2 w; w.x = pg8::cvt_pk_bf16(o[0], o[1]); w.y = pg8::cvt_pk_bf16(o[2], o[3]); *(uint2*)(act + (size_t)tok * DFF + jc) = w; }
                    pa_prev = pa_cur; pb_prev = pb_cur; na_cur = na_next; nb_cur = nb_next;
                }
            }
        }
    }
};
template <class Epi>
__device__ __forceinline__ void run_gemm(unsigned char* lds, const bf16_t* A, const bf16_t* Bt, int M, int N, int K, const Epi& E) {
    pg8::Gemm g; g.A = A; g.Bt = Bt; g.M = M; g.N = N; g.K = K; g.ovl = Epi::OVL ? 1 : 0;
    pg8::StaticOrder S; S.init(M, N, (int)gridDim.x, (int)blockIdx.x);
    pg8::gemm_phase<Epi, pg8::StaticOrder, false>((PG8_LAS unsigned char*)lds, g, S, E, nullptr);
}

#define HD_INLINE __device__ __forceinline__
#define DEV_FN __device__ __forceinline__
#define LDS_F2 float2*
#define NTHR 512
#define FOR_TID for (int tid = (int)TIDX, once_ = 1; once_; once_ = 0)
#define SYNC __syncthreads()
#define BREV32(x) __brev(x)
#define CIS_REV(fr, c, s) do { const float f_ = (fr); c = __builtin_amdgcn_cosf(f_); s = __builtin_amdgcn_sinf(f_); } while (0)
HD_INLINE unsigned rev4(unsigned k, int S) {
    unsigned v = BREV32(k) >> (32 - 2 * S);
    return ((v & 0xAAAAAAAAu) >> 1) | ((v & 0x55555555u) << 1);
}
HD_INLINE float2 cmul(float2 a, float2 b) { return make_float2(a.x * b.x - a.y * b.y, a.x * b.y + a.y * b.x); }
HD_INLINE float2 cmulc(float2 a, float2 b) { return make_float2(a.x * b.x + a.y * b.y, a.y * b.x - a.x * b.y); }

DEV_FN void fft_fwd(LDS_F2 X, int S, int s0) {
    const int M = 1 << (2 * S);
    for (int s = s0; s < S; ++s) {
        const int n = M >> (2 * s), q = n >> 2;
        const float invn = 1.0f / (float)n;
        FOR_TID {
            for (int b = tid; b < (M >> 2); b += NTHR) {
                const int j = b & (q - 1), base = ((b - j) << 2) + j;
                const float2 a0 = X[base], a1 = X[base + q], a2 = X[base + 2 * q], a3 = X[base + 3 * q];
                const float2 t0 = make_float2(a0.x + a2.x, a0.y + a2.y), t1 = make_float2(a0.x - a2.x, a0.y - a2.y);
                const float2 t2 = make_float2(a1.x + a3.x, a1.y + a3.y);
                const float2 d13 = make_float2(a1.x - a3.x, a1.y - a3.y);
                const float2 t3 = make_float2(d13.y, -d13.x);
                const float2 y0 = make_float2(t0.x + t2.x, t0.y + t2.y);
                float2 y1 = make_float2(t1.x + t3.x, t1.y + t3.y);
                float2 y2 = make_float2(t0.x - t2.x, t0.y - t2.y);
                float2 y3 = make_float2(t1.x - t3.x, t1.y - t3.y);
                if (q > 1) {
                    const float fr = (float)j * invn;
                    float c1, s1, c2, s2, c3, s3;
                    CIS_REV(fr, c1, s1); CIS_REV(2.0f * fr, c2, s2); CIS_REV(3.0f * fr, c3, s3);
                    y1 = cmul(y1, make_float2(c1, -s1)); y2 = cmul(y2, make_float2(c2, -s2)); y3 = cmul(y3, make_float2(c3, -s3));
                }
                X[base] = y0; X[base + q] = y1; X[base + 2 * q] = y2; X[base + 3 * q] = y3;
            }
        }
        SYNC;
    }
}
DEV_FN void fft_inv(LDS_F2 X, int S) {
    const int M = 1 << (2 * S);
    for (int s = S - 1; s >= 0; --s) {
        const int n = M >> (2 * s), q = n >> 2;
        const float invn = 1.0f / (float)n;
        FOR_TID {
            for (int b = tid; b < (M >> 2); b += NTHR) {
                const int j = b & (q - 1), base = ((b - j) << 2) + j;
                float2 b0 = X[base], b1 = X[base + q], b2 = X[base + 2 * q], b3 = X[base + 3 * q];
                if (q > 1) {
                    const float fr = (float)j * invn;
                    float c1, s1, c2, s2, c3, s3;
                    CIS_REV(fr, c1, s1); CIS_REV(2.0f * fr, c2, s2); CIS_REV(3.0f * fr, c3, s3);
                    b1 = cmul(b1, make_float2(c1, s1)); b2 = cmul(b2, make_float2(c2, s2)); b3 = cmul(b3, make_float2(c3, s3));
                }
                const float2 t0 = make_float2(b0.x + b2.x, b0.y + b2.y), t1 = make_float2(b0.x - b2.x, b0.y - b2.y);
                const float2 t2 = make_float2(b1.x + b3.x, b1.y + b3.y);
                const float2 d13 = make_float2(b1.x - b3.x, b1.y - b3.y);
                const float2 t3 = make_float2(-d13.y, d13.x);
                X[base] = make_float2(t0.x + t2.x, t0.y + t2.y);
                X[base + q] = make_float2(t1.x + t3.x, t1.y + t3.y);
                X[base + 2 * q] = make_float2(t0.x - t2.x, t0.y - t2.y);
                X[base + 3 * q] = make_float2(t1.x - t3.x, t1.y - t3.y);
            }
        }
        SYNC;
    }
}
DEV_FN void spec_store(LDS_F2 X, int S, float2* Ks) {
    const int M = 1 << (2 * S);
    FOR_TID {
        for (int k = tid; k <= (M >> 1); k += NTHR) {
            if (k == 0) { const float2 c0 = X[0]; Ks[0] = make_float2(c0.x + c0.y, c0.x - c0.y); }
            else {
                const float2 ck = X[rev4((unsigned)k, S)], cm = X[rev4((unsigned)(M - k), S)];
                const float2 P = make_float2(0.5f * (ck.x + cm.x), 0.5f * (ck.y - cm.y));
                const float2 O = make_float2(0.5f * (ck.y + cm.y), -0.5f * (ck.x - cm.x));
                float c, s; CIS_REV((float)k / (float)(2 * M), c, s);
                const float2 Q = cmul(O, make_float2(c, -s));
                Ks[k] = make_float2(P.x + Q.x, P.y + Q.y);
                Ks[M - k] = make_float2(P.x - Q.x, -(P.y - Q.y));
            }
        }
    }
    SYNC;
}
DEV_FN void spec_mul(LDS_F2 X, int S, const float2* Ks) {
    const int M = 1 << (2 * S);
    FOR_TID {
        for (int k = tid; k <= (M >> 1); k += NTHR) {
            if (k == 0) {
                const float2 c0 = X[0], k0 = Ks[0];
                const float y0 = (c0.x + c0.y) * k0.x, ym = (c0.x - c0.y) * k0.y;
                X[0] = make_float2(0.5f * (y0 + ym), 0.5f * (y0 - ym));
            } else {
                const unsigned pk = rev4((unsigned)k, S), pm = rev4((unsigned)(M - k), S);
                const float2 ck = X[pk], cm = X[pm];
                const float2 P = make_float2(0.5f * (ck.x + cm.x), 0.5f * (ck.y - cm.y));
                const float2 O = make_float2(0.5f * (ck.y + cm.y), -0.5f * (ck.x - cm.x));
                float c, s; CIS_REV((float)k / (float)(2 * M), c, s);
                const float2 Wk = make_float2(c, -s);
                const float2 Q = cmul(O, Wk);
                const float2 xk = make_float2(P.x + Q.x, P.y + Q.y), xm = make_float2(P.x - Q.x, -(P.y - Q.y));
                const float2 yk = cmul(xk, Ks[k]), ym = cmul(xm, Ks[M - k]);
                const float2 Ye = make_float2(0.5f * (yk.x + ym.x), 0.5f * (yk.y - ym.y));
                const float2 Yd = make_float2(0.5f * (yk.x - ym.x), 0.5f * (yk.y + ym.y));
                const float2 Yo = cmulc(Yd, Wk);
                X[pk] = make_float2(Ye.x - Yo.y, Ye.y + Yo.x);
                if (k != (M >> 1)) X[pm] = make_float2(Ye.x + Yo.y, -Ye.y + Yo.x);
            }
        }
    }
    SYNC;
}
__device__ void ph_setup(const P& p) {
    const int gid = blockIdx.x * 512 + TIDX;
    if (gid < 2 * D_HG) {
        const int dir = gid / D_HG, c = gid % D_HG;
        float v[NLAYER], mx = -1e30f;
#pragma unroll
        for (int l = 0; l < NLAYER; ++l) { v[l] = p.in[19][(size_t)(dir * NLAYER + l) * D_HG + c]; mx = fmaxf(mx, v[l]); }
        float s = 0.f;
#pragma unroll
        for (int l = 0; l < NLAYER; ++l) { v[l] = expf(v[l] - mx); s += v[l]; }
        float* lbs = (float*)(p.ws + OFF_SMALL);
        float cum = 0.f;
#pragma unroll
        for (int l = 0; l < NLAYER; ++l) { if (l > 0) cum += v[l] / s; lbs[(size_t)(dir * NLAYER + l) * D_HG + c] = cum; }
    }
}
__device__ void ph_copy_params(const P& p) {
    float* pb = (float*)(p.ws + OFF_PB);
    const int g = blockIdx.x * 512 + TIDX, gs = gridDim.x * 512;
    for (int k = g; k < 4096; k += gs) pb[0 + k] = p.in[2][k];
    for (int k = g; k < 4096; k += gs) pb[4096 + k] = p.in[3][k];
    for (int k = g; k < 4096; k += gs) pb[8192 + k] = p.in[4][k];
    for (int k = g; k < 4096; k += gs) pb[12288 + k] = p.in[5][k];
    for (int k = g; k < 18432; k += gs) pb[16384 + k] = p.in[7][k];
    for (int k = g; k < 6144; k += gs) pb[34816 + k] = p.in[8][k];
    for (int k = g; k < 8448; k += gs) pb[40960 + k] = p.in[9][k];
    for (int k = g; k < 256; k += gs) pb[49408 + k] = p.in[10][k];
    for (int k = g; k < 16384; k += gs) pb[49664 + k] = p.in[11][k];
    for (int k = g; k < 256; k += gs) pb[66048 + k] = p.in[12][k];
    for (int k = g; k < 16384; k += gs) pb[66304 + k] = p.in[13][k];
    for (int k = g; k < 256; k += gs) pb[82688 + k] = p.in[14][k];
    for (int k = g; k < 262144; k += gs) pb[82944 + k] = p.in[15][k];
    for (int k = g; k < 256; k += gs) pb[345088 + k] = p.in[16][k];
    for (int k = g; k < 2048; k += gs) pb[345344 + k] = p.in[17][k];
    for (int k = g; k < 2048; k += gs) pb[347392 + k] = p.in[18][k];
    for (int k = g; k < 4096; k += gs) pb[349440 + k] = p.in[19][k];
    for (int k = g; k < 2048; k += gs) pb[353536 + k] = p.in[20][k];
    for (int k = g; k < 98304; k += gs) pb[355584 + k] = p.in[23][k];
    for (int k = g; k < 32768; k += gs) pb[453888 + k] = p.in[24][k];
}
__device__ void convert_one(const float* src, bf16_t* dst, int K, int N, float* tile  , bool geglu_perm = false) {
    const int tiles_n = N / 64, ntiles = (K / 64) * tiles_n, tid = TIDX;
    for (int it = blockIdx.x; it < ntiles; it += gridDim.x) {
        const int k0 = (it / tiles_n) * 64, n0 = (it % tiles_n) * 64;
#pragma unroll
        for (int i = 0; i < 8; ++i) { const int r = (tid >> 6) + 8 * i, c = tid & 63; tile[r * 65 + c] = src[(size_t)(k0 + r) * N + n0 + c]; }
        __syncthreads();
#pragma unroll
        for (int i = 0; i < 8; ++i) { const int n = (tid >> 6) + 8 * i, k = tid & 63; int nr = n0 + n;
            if (geglu_perm) nr = nr < DFF ? (nr >> 7) * 256 + (nr & 127) : ((nr - DFF) >> 7) * 256 + 128 + ((nr - DFF) & 127);
            dst[(size_t)nr * K + k0 + k] = f2bf(tile[k * 65 + n]); }
        __syncthreads();
    }
}
__device__ void ph_convert_w(const P& p, int l, unsigned char* lds) {
    float* tile = (float*)lds;
    convert_one(p.in[6] + (size_t)l * DM * D_IN, (bf16_t*)(p.ws + OFF_W_IN), DM, D_IN, tile);
    convert_one(p.in[21] + (size_t)l * DM * DM, (bf16_t*)(p.ws + OFF_W_OUT), DM, DM, tile);
    convert_one(p.in[22] + (size_t)l * DM * 2 * DFF, (bf16_t*)(p.ws + OFF_W_UP), DM, 2 * DFF, tile, true);
    convert_one(p.in[25] + (size_t)l * DFF * DM, (bf16_t*)(p.ws + OFF_W_DN), DFF, DM, tile);
}
__device__ __forceinline__ bf16_t* abuf_row(const P& p, int t) { return (bf16_t*)(p.ws + OFF_ABUF) + (size_t)(t + APAD) * DM; }
__device__ void ph_rmsnorm_in(const P& p, int l) {
    const int lane = TIDX & 63, wv = TIDX >> 6;
    const float* gain = p.in[2] + (size_t)l * DM;
    for (int t = blockIdx.x * 8 + wv; t < T_TOK; t += gridDim.x * 8) {
        const float* xr = x_src_row(p, l, t);
        float4 v[4]; float ss = 0.f;
#pragma unroll
        for (int i = 0; i < 4; ++i) { v[i] = *(const float4*)(xr + lane * 4 + 256 * i); ss += v[i].x * v[i].x + v[i].y * v[i].y + v[i].z * v[i].z + v[i].w * v[i].w; }
        ss = wave_sum(ss);
        const float r = rsqrtf(ss * (1.0f / DM) + 1e-6f);
        bf16_t* hr = abuf_row(p, t);
#pragma unroll
        for (int i = 0; i < 4; ++i) { const float4 g = *(const float4*)(gain + lane * 4 + 256 * i);
            uint2 w; w.x = pack_bf2(v[i].x * r * g.x, v[i].y * r * g.y); w.y = pack_bf2(v[i].z * r * g.z, v[i].w * r * g.w);
            *(uint2*)(hr + lane * 4 + 256 * i) = w; }
    }
}
__device__ void ph_norm_resid(const P& p, int l, int which) {
    const int lane = TIDX & 63, wv = TIDX >> 6;
    const float* gpost = (which == 0 ? PRM(p, norm_mix_post) : PRM(p, norm_ffn_post)) + (size_t)l * DM;
    const bool has_next = (which == 0) || (l + 1 < NLAYER);
    const float* gnext = which == 0 ? PRM(p, norm_ffn_pre) + (size_t)l * DM : PRM(p, norm_mix_pre) + (size_t)(has_next ? l + 1 : l) * DM;
    const bf16_t* Y = (const bf16_t*)(p.ws + OFF_MIX);
    const int lx = which == 0 ? l : 1;
    for (int t = blockIdx.x * 8 + wv; t < T_TOK; t += gridDim.x * 8) {
        const float* xr = x_src_row(p, lx, t);
        const bf16_t* yr = Y + (size_t)t * DM;
        float4 x[4], y[4]; float ss = 0.f;
#pragma unroll
        for (int i = 0; i < 4; ++i) { x[i] = *(const float4*)(xr + lane * 4 + 256 * i); const uint2 w = *(const uint2*)(yr + lane * 4 + 256 * i);
            y[i].x = __uint_as_float(w.x << 16); y[i].y = __uint_as_float(w.x & 0xffff0000u); y[i].z = __uint_as_float(w.y << 16); y[i].w = __uint_as_float(w.y & 0xffff0000u);
            ss += y[i].x * y[i].x + y[i].y * y[i].y + y[i].z * y[i].z + y[i].w * y[i].w; }
        ss = wave_sum(ss);
        const float r = rsqrtf(ss * (1.0f / DM) + 1e-6f);
        float s2 = 0.f;
#pragma unroll
        for (int i = 0; i < 4; ++i) { const float4 g = *(const float4*)(gpost + lane * 4 + 256 * i);
            x[i].x += y[i].x * r * g.x; x[i].y += y[i].y * r * g.y; x[i].z += y[i].z * r * g.z; x[i].w += y[i].w * r * g.w;
            s2 += x[i].x * x[i].x + x[i].y * x[i].y + x[i].z * x[i].z + x[i].w * x[i].w;
            *(float4*)(p.out + (size_t)t * DM + lane * 4 + 256 * i) = x[i]; }
        if (has_next) {
            s2 = wave_sum(s2);
            const float r2 = rsqrtf(s2 * (1.0f / DM) + 1e-6f);
            bf16_t* hr = abuf_row(p, t);
#pragma unroll
            for (int i = 0; i < 4; ++i) { const float4 g = *(const float4*)(gnext + lane * 4 + 256 * i);
                uint2 w; w.x = pack_bf2(x[i].x * r2 * g.x, x[i].y * r2 * g.y); w.y = pack_bf2(x[i].z * r2 * g.z, x[i].w * r2 * g.w);
                *(uint2*)(hr + lane * 4 + 256 * i) = w; }
        }
    }
}
__device__ void ph_filter(const P& p, int l, unsigned char* lds) {
    float* feats = (float*)lds;
    float* ha = feats + 16 * 33;
    float* hb = ha + 16 * 64;
    const int tid = TIDX;
    const float* w1 = PRM(p, f_w1) + (size_t)l * 33 * 64; const float* b1 = PRM(p, f_b1) + (size_t)l * 64;
    const float* w2 = PRM(p, f_w2) + (size_t)l * 64 * 64; const float* b2 = PRM(p, f_b2) + (size_t)l * 64;
    const float* w3 = PRM(p, f_w3) + (size_t)l * 64 * 64; const float* b3 = PRM(p, f_b3) + (size_t)l * 64;
    const float* w4 = PRM(p, f_w4) + (size_t)l * 64 * 1024; const float* fq = PRM(p, f_freq) + (size_t)l * 64;
    float* kt = (float*)(p.ws + OFF_KT);
    const int nitems = (L_BIG + L_SML) / 16;
    for (int it = blockIdx.x; it < nitems; it += gridDim.x) {
        const bool big = it < L_BIG / 16; const int L = big ? L_BIG : L_SML; const int pos0 = (big ? it : it - L_BIG / 16) * 16;
        float* ktc = kt + (big ? 0 : (size_t)512 * 2 * L_BIG);
        for (int idx = tid; idx < 16 * 33; idx += 512) {
            const int pp = idx / 33, f = idx % 33; const int pos = pos0 + pp;
            const float tt = (float)pos / (float)(L - 1), ang = (6.283185307179586f / (float)L) * (float)pos;
            float v;
            if (f == 0) v = tt;
            else { const int bi = (f - 1) & 15; const float band = 1e-4f + (float)bi * ((15.0f - 1e-4f) / 15.0f); v = f <= 16 ? cosf(band * ang) : -sinf(band * ang); }
            feats[idx] = v;
        }
        __syncthreads();
        for (int idx = tid; idx < 16 * 64; idx += 512) { const int pp = idx >> 6, j = idx & 63; float a = b1[j];
            for (int f = 0; f < 33; ++f) a += feats[pp * 33 + f] * w1[f * 64 + j];
            ha[idx] = sinf(fq[j] * a); }
        __syncthreads();
        for (int idx = tid; idx < 16 * 64; idx += 512) { const int pp = idx >> 6, j = idx & 63; float a = b2[j];
            for (int f = 0; f < 64; ++f) a += ha[pp * 64 + f] * w2[f * 64 + j];
            hb[idx] = sinf(fq[j] * a); }
        __syncthreads();
        for (int idx = tid; idx < 16 * 64; idx += 512) { const int pp = idx >> 6, j = idx & 63; float a = b3[j];
            for (int f = 0; f < 64; ++f) a += hb[pp * 64 + f] * w3[f * 64 + j];
            ha[idx] = sinf(fq[j] * a); }
        __syncthreads();
        for (int o = tid; o < 1024; o += 512) {
            float acc[16];
#pragma unroll
            for (int pp = 0; pp < 16; ++pp) acc[pp] = 0.f;
            for (int f = 0; f < 64; ++f) { const float w = w4[f * 1024 + o];
#pragma unroll
                for (int pp = 0; pp < 16; ++pp) acc[pp] += ha[pp * 64 + f] * w; }
            const int dir = o >> 9, c = o & 511;
            const float delta = 3.0701134573253945f + (float)c * ((15.350567286626972f - 3.0701134573253945f) / 511.0f);
            float* dst = ktc + (size_t)(c * 2 + dir) * L + pos0;
#pragma unroll
            for (int pp = 0; pp < 16; ++pp) { const float tt = (float)(pos0 + pp) / (float)(L - 1); dst[pp] = acc[pp] * expf(-tt * delta); }
        }
        __syncthreads();
    }
}
__device__ void ph_hy_prep(const P& p, int l, unsigned char* lds) {
    float* tx = (float*)lds;
    float* tz = tx + 64 * 65;
    const bf16_t* hy = (const bf16_t*)(p.ws + OFF_HYRAW);
    bf16_t* x0t = (bf16_t*)(p.ws + OFF_X0T); bf16_t* zt = (bf16_t*)(p.ws + OFF_ZT);
    const float* cw = PRM(p, hy_conv_w) + (size_t)l * 3 * 1536; const float* cb = PRM(p, hy_conv_b) + (size_t)l * 1536;
    const int tid = TIDX, nitems = (T_TOK / 64) * 8;
    for (int it = blockIdx.x; it < nitems; it += gridDim.x) {
        const int t0 = (it >> 3) * 64, c0 = (it & 7) * 64, c = tid & 63;
        float wv[3][3], bv[3];
#pragma unroll
        for (int a = 0; a < 3; ++a) { bv[a] = cb[a * 512 + c0 + c];
#pragma unroll
            for (int k = 0; k < 3; ++k) wv[a][k] = cw[k * 1536 + a * 512 + c0 + c]; }
#pragma unroll
        for (int i = 0; i < 8; ++i) {
            const int tt = (tid >> 6) + 8 * i, t = t0 + tt;
            const bool hp = !seq_start(t), hn = !seq_end(t);
            float r[3];
#pragma unroll
            for (int a = 0; a < 3; ++a) {
                const bf16_t* col = hy + (size_t)t * 1536 + a * 512 + c0 + c;
                const float xm = hp ? bf2f(col[-1536]) : 0.f, x0 = bf2f(col[0]), xp = hn ? bf2f(col[1536]) : 0.f;
                r[a] = xm * wv[a][0] + x0 * wv[a][1] + xp * wv[a][2] + bv[a];
            }
            tx[c * 65 + tt] = r[0]; tz[c * 65 + tt] = r[1] * r[2];
        }
        __syncthreads();
#pragma unroll
        for (int i = 0; i < 8; ++i) { const int cc = (tid >> 6) + 8 * i, tt = tid & 63;
            x0t[(size_t)(c0 + cc) * T_TOK + t0 + tt] = f2bf(tx[cc * 65 + tt]); zt[(size_t)(c0 + cc) * T_TOK + t0 + tt] = f2bf(tz[cc * 65 + tt]); }
        __syncthreads();
    }
}
__device__ __forceinline__ float2 ld_f2_agent(const float2* ptr) {
    const unsigned long long w = __hip_atomic_load((const unsigned long long*)ptr, __ATOMIC_RELAXED, __HIP_MEMORY_SCOPE_AGENT);
    return make_float2(__uint_as_float((unsigned)w), __uint_as_float((unsigned)(w >> 32)));
}
DEV_FN void spec_mul_g(LDS_F2 X, int S, const float2* Ks);
__device__ void ph_hy_fft(const P& p, int l, unsigned char* lds) {
    float2* X = (float2*)lds;
    const int tid = TIDX;
    float2* Ks = (float2*)(p.ws + OFF_KS) + (size_t)blockIdx.x * L_BIG;
    const float* kt = (const float*)(p.ws + OFF_KT);
    const bf16_t* x0t = (const bf16_t*)(p.ws + OFF_X0T); bf16_t* zt = (bf16_t*)(p.ws + OFF_ZT);
    for (int job = blockIdx.x; job < 1024; job += gridDim.x) {
        const bool big = job < 512; const int c = job & 511;
        const int L = big ? L_BIG : L_SML, S = big ? 7 : 6, M = L;
        const float* hf = kt + (big ? 0 : (size_t)512 * 2 * L_BIG) + (size_t)(c * 2) * L; const float* hb = hf + L;
        for (int m = tid; m < M; m += 512) {
            const int n0 = 2 * m, n1 = 2 * m + 1;
            const float a = n0 < L ? hf[n0] : (n0 == L ? 0.f : hb[2 * L - n0]);
            const float b = n1 < L ? hf[n1] : hb[2 * L - n1];
            X[m] = make_float2(a, b);
        }
        __syncthreads();
        fft_fwd(X, S, 0);
        spec_store(X, S, Ks);
        __threadfence(); __syncthreads();
        const float skip = PRM(p, hy_skip)[(size_t)l * D_HY + c];
        const int nseq = big ? 1 : 4;
        for (int sq = 0; sq < nseq; ++sq) {
            const int t0 = big ? 0 : L_BIG + sq * L_SML;
            const bf16_t* zrow = zt + (size_t)c * T_TOK + t0; const bf16_t* xrow = x0t + (size_t)c * T_TOK + t0;
            for (int m = tid; m < M; m += 512) {
                float2 v = make_float2(0.f, 0.f);
                if (m < (M >> 1)) { const unsigned w = *(const unsigned*)(zrow + 2 * m); v.x = __uint_as_float(w << 16); v.y = __uint_as_float(w & 0xffff0000u); }
                X[m] = v;
            }
            __syncthreads();
            fft_fwd(X, S, 0);
            spec_mul_g(X, S, Ks);
            fft_inv(X, S);
            const float inv = 1.0f / (float)M;
            bf16_t* orow = zt + (size_t)c * T_TOK + t0;
            for (int m = tid; m < (M >> 1); m += 512) {
                const float2 d = X[m];
                const unsigned wz = *(const unsigned*)(zrow + 2 * m), wx = *(const unsigned*)(xrow + 2 * m);
                const float z0 = __uint_as_float(wz << 16), z1 = __uint_as_float(wz & 0xffff0000u), a0 = __uint_as_float(wx << 16), a1 = __uint_as_float(wx & 0xffff0000u);
                *(unsigned*)(orow + 2 * m) = pack_bf2(a0 * (d.x * inv + skip * z0), a1 * (d.y * inv + skip * z1));
            }
            __syncthreads();
        }
    }
}
DEV_FN void spec_mul_g(LDS_F2 X, int S, const float2* Ks) {
    const int M = 1 << (2 * S);
    for (int k = TIDX; k <= (M >> 1); k += NTHR) {
        if (k == 0) {
            const float2 c0 = X[0], k0 = ld_f2_agent(Ks);
            const float y0 = (c0.x + c0.y) * k0.x, ym = (c0.x - c0.y) * k0.y;
            X[0] = make_float2(0.5f * (y0 + ym), 0.5f * (y0 - ym));
        } else {
            const unsigned pk = rev4((unsigned)k, S), pm = rev4((unsigned)(M - k), S);
            const float2 ck = X[pk], cm = X[pm];
            const float2 Pv = make_float2(0.5f * (ck.x + cm.x), 0.5f * (ck.y - cm.y));
            const float2 O = make_float2(0.5f * (ck.y + cm.y), -0.5f * (ck.x - cm.x));
            float c, s; CIS_REV((float)k / (float)(2 * M), c, s);
            const float2 Wk = make_float2(c, -s);
            const float2 Q = cmul(O, Wk);
            const float2 xk = make_float2(Pv.x + Q.x, Pv.y + Q.y), xm = make_float2(Pv.x - Q.x, -(Pv.y - Q.y));
            const float2 yk = cmul(xk, ld_f2_agent(Ks + k)), ym = cmul(xm, ld_f2_agent(Ks + (M - k)));
            const float2 Ye = make_float2(0.5f * (yk.x + ym.x), 0.5f * (yk.y - ym.y));
            const float2 Yd = make_float2(0.5f * (yk.x - ym.x), 0.5f * (yk.y + ym.y));
            const float2 Yo = cmulc(Yd, Wk);
            X[pk] = make_float2(Ye.x - Yo.y, Ye.y + Yo.x);
            if (k != (M >> 1)) X[pm] = make_float2(Ye.x + Yo.y, -Ye.y + Yo.x);
        }
    }
    __syncthreads();
}
__device__ void ph_hy_norm(const P& p, int l, unsigned char* lds) {
    float* tl = (float*)lds;
    float* red = tl + 64 * 65;
    const bf16_t* yh = (const bf16_t*)(p.ws + OFF_ZT);
    const float* gain = PRM(p, hy_out_norm) + (size_t)l * D_HY;
    const int tid = TIDX, nitems = (T_TOK / 64) * 8;
    for (int it = blockIdx.x; it < nitems; it += gridDim.x) {
        const int t0 = (it >> 3) * 64, c0 = (it & 7) * 64;
#pragma unroll
        for (int i = 0; i < 8; ++i) { const int cc = (tid >> 6) + 8 * i, tt = tid & 63; tl[cc * 65 + tt] = bf2f(yh[(size_t)(c0 + cc) * T_TOK + t0 + tt]); }
        __syncthreads();
        { const int tt = tid & 63, part = tid >> 6; float s = 0.f;
#pragma unroll
          for (int j = 0; j < 8; ++j) { const float v = tl[(part * 8 + j) * 65 + tt]; s += v * v; }
          red[part * 64 + tt] = s; }
        __syncthreads();
#pragma unroll
        for (int i = 0; i < 8; ++i) { const int tt = (tid >> 6) + 8 * i, cc = tid & 63;
            float s = 0.f;
#pragma unroll
            for (int j = 0; j < 8; ++j) s += red[j * 64 + tt];
            const float r = rsqrtf(s * (1.0f / 64.0f) + 1e-6f);
            abuf_row(p, t0 + tt)[c0 + cc] = f2bf(tl[cc * 65 + tt] * r * gain[c0 + cc]); }
        __syncthreads();
    }
}
__device__ void ph_hgrn_naive(const P& p, int l, unsigned char* lds) {
    float* sq = (float*)lds;
    float* sf = sq + 2 * 16 * 128;
    const bf16_t* hg = (const bf16_t*)(p.ws + OFF_HG);
    bf16_t* obuf = (bf16_t*)(p.ws + OFF_OBUF);
    const float* lbs = (const float*)(p.ws + OFF_SMALL);
    const int tid = TIDX;
    for (int it = blockIdx.x; it < 20; it += gridDim.x) {
        const int sqi = it >> 2, h = it & 3;
        const int t0 = sqi == 0 ? 0 : L_BIG + (sqi - 1) * L_SML, L = sqi == 0 ? L_BIG : L_SML;
        const int dir = (tid >> 7) & 1, e = tid & 127;
        const bool act = tid < 256;
        const float lb = act ? lbs[(size_t)(dir * NLAYER + l) * D_HG + h * 128 + e] : 0.f;
        float S[128];
#pragma unroll
        for (int d = 0; d < 128; ++d) S[d] = 0.f;
        for (int b = 0; b < L / 16; ++b) {
            if (act) {
#pragma unroll 4
                for (int j = 0; j < 16; ++j) {
                    const int u = b * 16 + j, tok = dir ? t0 + L - 1 - u : t0 + u;
                    const bf16_t* row = hg + (size_t)tok * 2560 + h * 128 + e;
                    const float zq = bf2f(row[0]), zf = bf2f(row[dir ? 1024 : 512]);
                    sq[(dir * 16 + j) * 128 + e] = silu_f(zq);
                    sf[(dir * 16 + j) * 128 + e] = lb + (1.0f - lb) / (1.0f + __expf(-zf));
                }
            }
            __syncthreads();
            if (act) {
                for (int j = 0; j < 16; ++j) {
                    const int u = b * 16 + j, tok = dir ? t0 + L - 1 - u : t0 + u;
                    const float v = bf2f(hg[(size_t)tok * 2560 + 1536 + h * 128 + e]);
                    const float4* q4 = (const float4*)(sq + (dir * 16 + j) * 128); const float4* f4 = (const float4*)(sf + (dir * 16 + j) * 128);
                    float o = 0.f;
#pragma unroll
                    for (int d4 = 0; d4 < 32; ++d4) { const float4 q = q4[d4], f = f4[d4];
                        S[4 * d4 + 0] = f.x * S[4 * d4 + 0] + (1.0f - f.x) * v; o += S[4 * d4 + 0] * q.x;
                        S[4 * d4 + 1] = f.y * S[4 * d4 + 1] + (1.0f - f.y) * v; o += S[4 * d4 + 1] * q.y;
                        S[4 * d4 + 2] = f.z * S[4 * d4 + 2] + (1.0f - f.z) * v; o += S[4 * d4 + 2] * q.z;
                        S[4 * d4 + 3] = f.w * S[4 * d4 + 3] + (1.0f - f.w) * v; o += S[4 * d4 + 3] * q.w; }
                    obuf[((size_t)dir * T_TOK + tok) * D_HG + h * 128 + e] = f2bf(o);
                }
            }
            __syncthreads();
        }
    }
}
__device__ void ph_hg_norm(const P& p, int l) {
    const int lane = TIDX & 63, wv = TIDX >> 6;
    const bf16_t* hg = (const bf16_t*)(p.ws + OFF_HG); const bf16_t* obuf = (const bf16_t*)(p.ws + OFF_OBUF);
    const float* gain = PRM(p, hg_out_norm) + (size_t)l * D_HG;
    for (int it = blockIdx.x * 8 + wv; it < T_TOK * 4; it += gridDim.x * 8) {
        const int t = it >> 2, h = it & 3, e = h * 128 + lane * 2;
        const unsigned wf = *(const unsigned*)(obuf + (size_t)t * D_HG + e), wb = *(const unsigned*)(obuf + ((size_t)T_TOK + t) * D_HG + e);
        const float o0 = __uint_as_float(wf << 16) + __uint_as_float(wb << 16), o1 = __uint_as_float(wf & 0xffff0000u) + __uint_as_float(wb & 0xffff0000u);
        const float ss = wave_sum(o0 * o0 + o1 * o1);
        const float r = rsqrtf(ss * (1.0f / 128.0f) + 1e-6f);
        const unsigned wg = *(const unsigned*)(hg + (size_t)t * 2560 + 2048 + e);
        const float g0 = silu_f(__uint_as_float(wg << 16)), g1 = silu_f(__uint_as_float(wg & 0xffff0000u));
        *(unsigned*)(abuf_row(p, t) + 512 + e) = pack_bf2(o0 * r * gain[e] * g0, o1 * r * gain[e + 1] * g1);
    }
}
__device__ __forceinline__ float gelu_tanh_f(float x) { const float y = 0.7978845608028654f * (x + 0.044715f * x * x * x); return x / (1.0f + __expf(-2.0f * y)); }
__device__ void ph_geglu_part(const P& p, int l, int r0) {
    const bf16_t* up = (const bf16_t*)(p.ws + OFF_UPART);
    bf16_t* act = (bf16_t*)(p.ws + OFF_ACT);
    const float* cw = PRM(p, ffn_conv_w) + (size_t)l * 3 * 8192; const float* cb = PRM(p, ffn_conv_b) + (size_t)l * 8192;
    const size_t total = (size_t)4096 * (DFF / 2);
    for (size_t idx = (size_t)blockIdx.x * 512 + TIDX; idx < total; idx += (size_t)gridDim.x * 512) {
        const int tt = (int)(idx / (DFF / 2)), j = (int)(idx % (DFF / 2)) * 2, t = r0 + tt;
        const bool hp = !seq_start(t), hn = !seq_end(t);
        const bf16_t* row = up + (size_t)(tt + 256) * 8192;
        float res[2][2];
#pragma unroll
        for (int half = 0; half < 2; ++half) {
            const int col = half * DFF + j;
            const unsigned w0 = *(const unsigned*)(row + col), wm = hp ? *(const unsigned*)(row - 8192 + col) : 0u, wp = hn ? *(const unsigned*)(row + 8192 + col) : 0u;
#pragma unroll
            for (int q = 0; q < 2; ++q) {
                const float xm = q ? __uint_as_float(wm & 0xffff0000u) : __uint_as_float(wm << 16), x0 = q ? __uint_as_float(w0 & 0xffff0000u) : __uint_as_float(w0 << 16), xp = q ? __uint_as_float(wp & 0xffff0000u) : __uint_as_float(wp << 16);
                res[half][q] = xm * cw[col + q] + x0 * cw[8192 + col + q] + xp * cw[2 * 8192 + col + q] + cb[col + q];
            }
        }
        *(unsigned*)(act + (size_t)t * DFF + j) = pack_bf2(gelu_tanh_f(res[0][0]) * res[1][0], gelu_tanh_f(res[0][1]) * res[1][1]);
    }
}
typedef short hbf16x8 __attribute__((ext_vector_type(8)));
typedef float hf32x16 __attribute__((ext_vector_type(16)));
constexpr int HSC = 512, HNCH = HSC / 64, HNSC = T_TOK / HSC;
constexpr int QS = 136, KS_ = 72;
constexpr int HL_QH = 0, HL_KH = HL_QH + 64 * QS * 2, HL_QT = HL_KH + 64 * QS * 2, HL_KT = HL_QT + 64 * QS * 2, HL_VT = HL_KT + 128 * KS_ * 2, HL_ST = HL_VT + 128 * KS_ * 2,
              HL_PM = HL_ST + 128 * QS * 2, HL_TOT = HL_PM + 64 * KS_ * 2, HL_EB = HL_TOT + 4 * 128 * 4, HL_END = HL_EB + 128 * 4;
constexpr int HL_OF = HL_QH, OFS = 132;
static_assert(64 * OFS * 4 <= 2 * 64 * QS * 2, "O tile must fit over Qh|Kh");
constexpr size_t OFF_HST = OFF_R6 + 32 * MiB;
constexpr size_t OFF_HAT = OFF_SMALL + 64 * 1024;

__device__ __forceinline__ hf32x16 mfma32(hbf16x8 a, hbf16x8 b, hf32x16 c) { return __builtin_amdgcn_mfma_f32_32x32x16_bf16(a, b, c, 0, 0, 0); }
__device__ __forceinline__ hbf16x8 lds_frag(const unsigned char* base, int row, int stride_el, int col_el) { return *(const hbf16x8*)(base + ((size_t)row * stride_el + col_el) * 2); }

typedef unsigned hu32x4 __attribute__((ext_vector_type(4)));
struct HgPre { hu32x4 f0, f1, v0, v1, q0, q1; };
template <bool FULL>
__device__ __forceinline__ void hg_fetch(const bf16_t* hg, HgPre& pre, int tokbase, int dirsign, int h, int dir) {
    const int tid = TIDX;
    { const int u = tid >> 4, seg = tid & 15;
      const bf16_t* row = hg + (size_t)(tokbase + dirsign * u) * 2560 + h * 128 + seg * 8;
      pre.f0 = *(const hu32x4*)(row + 512 + 512 * dir); pre.v0 = *(const hu32x4*)(row + 1536); if (FULL) pre.q0 = *(const hu32x4*)(row);
      const bf16_t* row1 = row + (size_t)dirsign * 32 * 2560;
      pre.f1 = *(const hu32x4*)(row1 + 512 + 512 * dir); pre.v1 = *(const hu32x4*)(row1 + 1536); if (FULL) pre.q1 = *(const hu32x4*)(row1); }
}
template <bool FULL>
__device__ __forceinline__ void hg_prep(unsigned char* lds, const HgPre& pre, float lb, float& Bsum_out) {
    const int tid = TIDX, d = tid & 127, qt = tid >> 7;
    float* tot = (float*)(lds + HL_TOT); float* eB = (float*)(lds + HL_EB);
    { const int u = tid >> 4, seg = tid & 15;
      *(hu32x4*)(lds + HL_KH + ((size_t)u * QS + seg * 8) * 2) = pre.f0; *(hu32x4*)(lds + HL_KH + ((size_t)(u + 32) * QS + seg * 8) * 2) = pre.f1;
      *(hu32x4*)(lds + HL_QH + ((size_t)u * QS + seg * 8) * 2) = pre.v0; *(hu32x4*)(lds + HL_QH + ((size_t)(u + 32) * QS + seg * 8) * 2) = pre.v1;
      if (FULL) { *(hu32x4*)(lds + HL_QT + ((size_t)u * QS + seg * 8) * 2) = pre.q0; *(hu32x4*)(lds + HL_QT + ((size_t)(u + 32) * QS + seg * 8) * 2) = pre.q1; } }
    __syncthreads();
    float run = 0.f;
#pragma unroll 4
    for (int j = 0; j < 16; ++j) {
        const int u = qt * 16 + j;
        float z = bf2f(*(const bf16_t*)(lds + HL_KH + ((size_t)u * QS + d) * 2));
        z = fmaxf(z, -60.0f);
        const float f = lb + (1.0f - lb) / (1.0f + __expf(-z));
        run += __logf(f);
    }
    tot[qt * 128 + d] = run;
    __syncthreads();
    const float t0 = tot[d], t1 = tot[128 + d], t2 = tot[256 + d], t3 = tot[384 + d];
    const float off = qt == 0 ? 0.f : (qt == 1 ? t0 : (qt == 2 ? t0 + t1 : t0 + t1 + t2));
    const float r = t0 + t1, B = t0 + t1 + t2 + t3;
    const float eBr = __expf(B - r);
    if (qt == 0) eB[d] = __expf(B);
    Bsum_out = B;
    float b = off;
#pragma unroll 2
    for (int jj = 0; jj < 8; ++jj) {
        unsigned pkt = 0, pvt = 0;
#pragma unroll
        for (int q2 = 0; q2 < 2; ++q2) {
            const int u = qt * 16 + jj * 2 + q2;
            float z = bf2f(*(const bf16_t*)(lds + HL_KH + ((size_t)u * QS + d) * 2));
            z = fmaxf(z, -60.0f);
            const float f = lb + (1.0f - lb) / (1.0f + __expf(-z));
            b += __logf(f);
            const float kh = (1.0f - f) * __expf(r - b);
            const bf16_t vraw = *(const bf16_t*)(lds + HL_QH + ((size_t)u * QS + d) * 2);
            pkt |= (unsigned)f2bf(kh * eBr) << (16 * q2); pvt |= (unsigned)vraw << (16 * q2);
            if (FULL) {
                const float q = silu_f(bf2f(*(const bf16_t*)(lds + HL_QT + ((size_t)u * QS + d) * 2)));
                const float E = __expf(b);
                *(bf16_t*)(lds + HL_QT + ((size_t)u * QS + d) * 2) = f2bf(q * E);
                *(bf16_t*)(lds + HL_QH + ((size_t)u * QS + d) * 2) = f2bf(q * __expf(b - r));
                *(bf16_t*)(lds + HL_KH + ((size_t)u * QS + d) * 2) = f2bf(kh);
            }
        }
        *(unsigned*)(lds + HL_KT + ((size_t)d * KS_ + qt * 16 + jj * 2) * 2) = pkt;
        *(unsigned*)(lds + HL_VT + ((size_t)d * KS_ + qt * 16 + jj * 2) * 2) = pvt;
    }
    __syncthreads();
}
__device__ __forceinline__ void hg_state_update(unsigned char* lds, hf32x16 (&S)[2], int w, int lane) {
    const int en = w & 3, r = lane & 31, hh = lane >> 5;
    const float* eB = (const float*)(lds + HL_EB);
#pragma unroll
    for (int i = 0; i < 2; ++i) {
        const int dm = (w >> 2) * 2 + i;
#pragma unroll
        for (int g = 0; g < 4; ++g) { const float4 sc = *(const float4*)(eB + 32 * dm + 8 * g + 4 * hh);
            S[i][4 * g + 0] *= sc.x; S[i][4 * g + 1] *= sc.y; S[i][4 * g + 2] *= sc.z; S[i][4 * g + 3] *= sc.w; }
#pragma unroll
        for (int ks = 0; ks < 4; ++ks) {
            const hbf16x8 a = lds_frag(lds + HL_KT, 32 * dm + r, KS_, 16 * ks + 8 * hh);
            const hbf16x8 b = lds_frag(lds + HL_VT, 32 * en + r, KS_, 16 * ks + 8 * hh);
            S[i] = mfma32(a, b, S[i]);
        }
    }
}
__device__ __forceinline__ int hg_unit_base(int sc) { return sc * HSC; }
__device__ void ph_hg_pass1(const P& p, int l, unsigned char* lds) {
    const bf16_t* hg = (const bf16_t*)(p.ws + OFF_HG);
    const float* lbs = (const float*)(p.ws + OFF_SMALL);
    float* ust = (float*)(p.ws + OFF_HST); float* atot = (float*)(p.ws + OFF_HAT);
    const int tid = TIDX, w = tid >> 6, lane = tid & 63;
    for (int unit = blockIdx.x; unit < HNSC * 8; unit += gridDim.x) {
        const int sc = unit >> 3, h = (unit >> 1) & 3, dir = unit & 1;
        const float lb = lbs[(size_t)(dir * NLAYER + l) * D_HG + h * 128 + (tid & 127)];
        hf32x16 S[2];
#pragma unroll
        for (int i = 0; i < 2; ++i)
#pragma unroll
            for (int k = 0; k < 16; ++k) S[i][k] = 0.f;
        float Btot = 0.f;
        const int dsg = dir ? -1 : 1, tb0 = dir ? hg_unit_base(sc) + HSC - 1 : hg_unit_base(sc);
        HgPre pre;
        hg_fetch<false>(hg, pre, tb0, dsg, h, dir);
        for (int ci = 0; ci < HNCH; ++ci) {
            float B;
            hg_prep<false>(lds, pre, lb, B);
            if (ci + 1 < HNCH) hg_fetch<false>(hg, pre, tb0 + dsg * (ci + 1) * 64, dsg, h, dir);
            Btot += B;
            hg_state_update(lds, S, w, lane);
            __syncthreads();
        }
        float* U = ust + (size_t)unit * 16384;
        int r = lane & 31, hh = lane >> 5; asm volatile("" : "+v"(r), "+v"(hh));
        const int en = w & 3;
#pragma unroll
        for (int i = 0; i < 2; ++i) { const int dm = (w >> 2) * 2 + i;
#pragma unroll
            for (int k = 0; k < 16; ++k) U[(32 * dm + (k & 3) + 8 * (k >> 2) + 4 * hh) * 128 + 32 * en + r] = S[i][k]; }
        if (tid < 128) atot[(size_t)unit * 128 + tid] = __expf(Btot);
    }
}
__device__ void ph_hg_pass2(const P& p) {
    float* ust = (float*)(p.ws + OFF_HST); const float* atot = (const float*)(p.ws + OFF_HAT);
    const int total = 5 * 8 * 16384;
    for (int idx = blockIdx.x * 512 + TIDX; idx < total; idx += gridDim.x * 512) {
        const int el = idx & 16383, hd = (idx >> 14) & 7, sq = idx >> 17;
        const int sc0 = sq == 0 ? 0 : 32 + 8 * (sq - 1), nsc = sq == 0 ? 32 : 8, dir = hd & 1, d = el >> 7;
        float carry = 0.f;
        for (int j = 0; j < nsc; ++j) {
            const int sc = dir ? sc0 + nsc - 1 - j : sc0 + j;
            const size_t unit = (size_t)sc * 8 + hd;
            const float u = ust[unit * 16384 + el], a = atot[unit * 128 + d];
            ust[unit * 16384 + el] = carry;
            carry = a * carry + u;
        }
    }
}
__device__ void ph_hg_pass3(const P& p, int l, unsigned char* lds) {
    const bf16_t* hg = (const bf16_t*)(p.ws + OFF_HG);
    const float* lbs = (const float*)(p.ws + OFF_SMALL);
    const float* ust = (const float*)(p.ws + OFF_HST);
    const float* gain = PRM(p, hg_out_norm) + (size_t)l * D_HG;
    const int tid = TIDX, w = tid >> 6, lane = tid & 63, r = lane & 31, hh = lane >> 5;
    for (int unit = blockIdx.x; unit < HNSC * 4; unit += gridDim.x) {
        const int sc = unit >> 2, h = unit & 3;
        for (int dir = 0; dir < 2; ++dir) {
            const float lb = lbs[(size_t)(dir * NLAYER + l) * D_HG + h * 128 + (tid & 127)];
            const float* S0 = ust + ((size_t)sc * 8 + h * 2 + dir) * 16384;
            hf32x16 S[2];
            { const int en = w & 3;
              int r_ = r, hh_ = hh; asm volatile("" : "+v"(r_), "+v"(hh_));
              const float* S0l = S0 + (4 * hh_) * 128 + 32 * en + r_;
#pragma unroll
              for (int i = 0; i < 2; ++i) { const int dm = (w >> 2) * 2 + i;
#pragma unroll
                  for (int k = 0; k < 16; ++k) S[i][k] = S0l[(32 * dm + (k & 3) + 8 * (k >> 2)) * 128];
#pragma unroll
                  for (int g = 0; g < 4; ++g) { uint2 wv; wv.x = pack_bf2(S[i][4 * g], S[i][4 * g + 1]); wv.y = pack_bf2(S[i][4 * g + 2], S[i][4 * g + 3]);
                      *(uint2*)(lds + HL_ST + ((size_t)(32 * en + r) * QS + 32 * dm + 8 * g + 4 * hh) * 2) = wv; } } }
            const int dsg = dir ? -1 : 1, tb0 = dir ? hg_unit_base(sc) + HSC - 1 : hg_unit_base(sc);
            HgPre pre;
            hg_fetch<true>(hg, pre, tb0, dsg, h, dir);
            for (int ci = 0; ci < HNCH; ++ci) {
                const int tokbase = tb0 + dsg * ci * 64;
                float Bdummy;
                hg_prep<true>(lds, pre, lb, Bdummy);
                if (ci + 1 < HNCH) hg_fetch<true>(hg, pre, tb0 + dsg * (ci + 1) * 64, dsg, h, dir);
                if (w < 4) {
                    const int tm = (w == 0 || w == 3) ? 0 : 1, sn = (w == 2 || w == 3) ? 1 : 0;
                    hf32x16 acc;
#pragma unroll
                    for (int k = 0; k < 16; ++k) acc[k] = 0.f;
                    if (w < 3) {
#pragma unroll
                        for (int ks = 0; ks < 8; ++ks) acc = mfma32(lds_frag(lds + HL_QH, 32 * tm + r, QS, 16 * ks + 8 * hh), lds_frag(lds + HL_KH, 32 * sn + r, QS, 16 * ks + 8 * hh), acc);
                    }
                    const int s_ = 32 * sn + r;
#pragma unroll
                    for (int k = 0; k < 16; ++k) { const int t_ = 32 * tm + (k & 3) + 8 * (k >> 2) + 4 * hh;
                        const float v = (w < 3 && s_ <= t_) ? acc[k] : 0.f;
                        *(bf16_t*)(lds + HL_PM + ((size_t)t_ * KS_ + s_) * 2) = f2bf(v); }
                }
                __syncthreads();
                hf32x16 o;
                { const int tm = w >> 2, en = w & 3;
#pragma unroll
                  for (int k = 0; k < 16; ++k) o[k] = 0.f;
#pragma unroll
                  for (int ks = 0; ks < 4; ++ks) o = mfma32(lds_frag(lds + HL_PM, 32 * tm + r, KS_, 16 * ks + 8 * hh), lds_frag(lds + HL_VT, 32 * en + r, KS_, 16 * ks + 8 * hh), o);
#pragma unroll
                  for (int ks = 0; ks < 8; ++ks) o = mfma32(lds_frag(lds + HL_QT, 32 * tm + r, QS, 16 * ks + 8 * hh), lds_frag(lds + HL_ST, 32 * en + r, QS, 16 * ks + 8 * hh), o);
                }
                __syncthreads();
                { const int tm = w >> 2, en = w & 3; float* Of = (float*)(lds + HL_OF);
#pragma unroll
                  for (int k = 0; k < 16; ++k) Of[(size_t)(32 * tm + (k & 3) + 8 * (k >> 2) + 4 * hh) * OFS + 32 * en + r] = o[k]; }
                hg_state_update(lds, S, w, lane);
                { const int en = w & 3;
#pragma unroll
                  for (int i = 0; i < 2; ++i) { const int dm = (w >> 2) * 2 + i;
#pragma unroll
                      for (int g = 0; g < 4; ++g) { uint2 wv; wv.x = pack_bf2(S[i][4 * g], S[i][4 * g + 1]); wv.y = pack_bf2(S[i][4 * g + 2], S[i][4 * g + 3]);
                          *(uint2*)(lds + HL_ST + ((size_t)(32 * en + r) * QS + 32 * dm + 8 * g + 4 * hh) * 2) = wv; } } }
                __syncthreads();
                { const int u = tid >> 3, e0 = (tid & 7) * 16, tok = tokbase + dsg * u;
                  const float* Of = (const float*)(lds + HL_OF) + (size_t)u * OFS + e0;
                  bf16_t* dst = abuf_row(p, tok) + 512 + h * 128 + e0;
                  float v[16];
#pragma unroll
                  for (int j = 0; j < 4; ++j) { const float4 t4 = *(const float4*)(Of + 4 * j); v[4 * j] = t4.x; v[4 * j + 1] = t4.y; v[4 * j + 2] = t4.z; v[4 * j + 3] = t4.w; }
                  if (dir == 0) {
                      uint4 w0, w1;
                      w0.x = pack_bf2(v[0], v[1]); w0.y = pack_bf2(v[2], v[3]); w0.z = pack_bf2(v[4], v[5]); w0.w = pack_bf2(v[6], v[7]);
                      w1.x = pack_bf2(v[8], v[9]); w1.y = pack_bf2(v[10], v[11]); w1.z = pack_bf2(v[12], v[13]); w1.w = pack_bf2(v[14], v[15]);
                      ((uint4*)dst)[0] = w0; ((uint4*)dst)[1] = w1;
                  } else {
                      const uint4 f0 = ((const uint4*)dst)[0], f1 = ((const uint4*)dst)[1];
                      const unsigned fw[8] = {f0.x, f0.y, f0.z, f0.w, f1.x, f1.y, f1.z, f1.w};
                      float ss = 0.f;
#pragma unroll
                      for (int j = 0; j < 8; ++j) { v[2 * j] += __uint_as_float(fw[j] << 16); v[2 * j + 1] += __uint_as_float(fw[j] & 0xffff0000u); ss += v[2 * j] * v[2 * j] + v[2 * j + 1] * v[2 * j + 1]; }
                      ss += __shfl_xor(ss, 1); ss += __shfl_xor(ss, 2); ss += __shfl_xor(ss, 4);
                      const float rn = rsqrtf(ss * (1.0f / 128.0f) + 1e-6f);
                      const bf16_t* gp = hg + (size_t)tok * 2560 + 2048 + h * 128 + e0;
                      const uint4 g0 = ((const uint4*)gp)[0], g1 = ((const uint4*)gp)[1];
                      const unsigned gw[8] = {g0.x, g0.y, g0.z, g0.w, g1.x, g1.y, g1.z, g1.w};
                      unsigned ow[8];
#pragma unroll
                      for (int j = 0; j < 8; ++j) { const float ga = silu_f(__uint_as_float(gw[j] << 16)), gb = silu_f(__uint_as_float(gw[j] & 0xffff0000u));
                          ow[j] = pack_bf2(v[2 * j] * rn * gain[h * 128 + e0 + 2 * j] * ga, v[2 * j + 1] * rn * gain[h * 128 + e0 + 2 * j + 1] * gb); }
                      ((uint4*)dst)[0] = make_uint4(ow[0], ow[1], ow[2], ow[3]); ((uint4*)dst)[1] = make_uint4(ow[4], ow[5], ow[6], ow[7]);
                  }
                }
                __syncthreads();
            }
        }
    }
}
enum { PH_SETUP, PH_CONVERT, PH_RMS_IN, PH_GEMM_IN, PH_HY_PREP, PH_FILTER, PH_HGRN, PH_HG_NORM, PH_HY_FFT, PH_HY_NORM, PH_GEMM_OUT, PH_NR0, PH_GEMM_UP, PH_GEGLU, PH_GEMM_DN, PH_NR1, PH_HG_P1, PH_HG_P2, PH_HG_P3 };
template <int PH> __device__ __forceinline__ void run_phase(const P& p_in, int l, int part, unsigned char* lds) {
    P p = p_in; asm volatile("" : "+s"(p.ws), "+s"(p.out));
    if constexpr (PH == PH_SETUP) { ph_setup(p); ph_copy_params(p); }
    if constexpr (PH == PH_CONVERT) ph_convert_w(p, l, lds);
    if constexpr (PH == PH_RMS_IN) ph_rmsnorm_in(p, l);
    if constexpr (PH == PH_GEMM_IN) { EpiBf16Split E; E.O0 = (bf16_t*)(p.ws + OFF_HYRAW); E.ldc0 = 1536; E.O1 = (bf16_t*)(p.ws + OFF_HG); E.ldc1 = 2560; E.csplit = 1536;
        run_gemm(lds, abuf_row(p, 0), (const bf16_t*)(p.ws + OFF_W_IN), T_TOK, D_IN, DM, E); }
    if constexpr (PH == PH_HY_PREP) ph_hy_prep(p, l, lds);
    if constexpr (PH == PH_FILTER) ph_filter(p, l, lds);
    if constexpr (PH == PH_HGRN) ph_hgrn_naive(p, l, lds);
    if constexpr (PH == PH_HG_NORM) ph_hg_norm(p, l);
    if constexpr (PH == PH_HY_FFT) ph_hy_fft(p, l, lds);
    if constexpr (PH == PH_HY_NORM) ph_hy_norm(p, l, lds);
    if constexpr (PH == PH_GEMM_OUT) { EpiBf16Split E; E.O0 = (bf16_t*)(p.ws + OFF_MIX); E.ldc0 = DM; E.O1 = E.O0; E.ldc1 = DM; E.csplit = 1 << 30;
        run_gemm(lds, abuf_row(p, 0), (const bf16_t*)(p.ws + OFF_W_OUT), T_TOK, DM, DM, E); }
    if constexpr (PH == PH_NR0) ph_norm_resid(p, l, 0);
    if constexpr (PH == PH_GEMM_UP) { EpiGeglu E; E.act = (bf16_t*)(p.ws + OFF_ACT); E.cw = PRM(p, ffn_conv_w) + (size_t)l * 3 * 8192; E.cb = PRM(p, ffn_conv_b) + (size_t)l * 8192;
        run_gemm(lds, abuf_row(p, -1), (const bf16_t*)(p.ws + OFF_W_UP), 133 * 256, 2 * DFF, DM, E); }
    if constexpr (PH == PH_GEMM_DN) { EpiBf16Split E; E.O0 = (bf16_t*)(p.ws + OFF_MIX); E.ldc0 = DM; E.O1 = E.O0; E.ldc1 = DM; E.csplit = 1 << 30;
        run_gemm(lds, (const bf16_t*)(p.ws + OFF_ACT), (const bf16_t*)(p.ws + OFF_W_DN), T_TOK, DM, DFF, E); }
    if constexpr (PH == PH_NR1) ph_norm_resid(p, l, 1);
    if constexpr (PH == PH_HG_P1) ph_hg_pass1(p, l, lds);
    if constexpr (PH == PH_HG_P2) ph_hg_pass2(p);
    if constexpr (PH == PH_HG_P3) ph_hg_pass3(p, l, lds);
}
constexpr int LDS_BYTES = 139264;
__global__ __launch_bounds__(512, 2) void mega(P p) {
    extern __shared__ __attribute__((aligned(16))) unsigned char lds[];
    cg::grid_group grid = cg::this_grid();
    run_phase<PH_SETUP>(p, 0, 0, lds);
    run_phase<PH_CONVERT>(p, 0, 0, lds);
    run_phase<PH_RMS_IN>(p, 0, 0, lds);
    grid.sync();
#pragma unroll 1
    for (int l = 0; l < NLAYER; ++l) {
        run_phase<PH_GEMM_IN>(p, l, 0, lds); grid.sync();
        run_phase<PH_HY_PREP>(p, l, 0, lds); run_phase<PH_HG_P1>(p, l, 0, lds); grid.sync();
        run_phase<PH_FILTER>(p, l, 0, lds); run_phase<PH_HG_P2>(p, l, 0, lds); grid.sync();
        run_phase<PH_HG_P3>(p, l, 0, lds); run_phase<PH_HY_FFT>(p, l, 0, lds); grid.sync();
        run_phase<PH_HY_NORM>(p, l, 0, lds); grid.sync();
        run_phase<PH_GEMM_OUT>(p, l, 0, lds); grid.sync();
        run_phase<PH_NR0>(p, l, 0, lds); grid.sync();
        run_phase<PH_GEMM_UP>(p, l, 0, lds); grid.sync();
        run_phase<PH_GEMM_DN>(p, l, 0, lds); grid.sync();
        run_phase<PH_NR1>(p, l, 0, lds);
        if (l + 1 < NLAYER) { run_phase<PH_CONVERT>(p, l + 1, 0, lds); grid.sync(); }
    }
}
extern "C" void kernel_launch(void* const* d_in, const int* in_sizes, int n_in, void* d_out, int out_size, void* d_ws, size_t ws_size, hipStream_t stream) {
    if (ws_size < WS_NEED) { fprintf(stderr, "workspace too small: %zu < %zu\n", ws_size, (size_t)WS_NEED); return; }
    static int grid_blocks = 0;
    if (!grid_blocks) {
        hipFuncSetAttribute((const void*)mega, hipFuncAttributeMaxDynamicSharedMemorySize, LDS_BYTES);
        int dev = 0, cus = 0, per_cu = 0;
        hipGetDevice(&dev);
        hipDeviceGetAttribute(&cus, hipDeviceAttributeMultiprocessorCount, dev);
        hipOccupancyMaxActiveBlocksPerMultiprocessor(&per_cu, mega, 512, LDS_BYTES);
        if (per_cu > 1) per_cu = 1;
        grid_blocks = cus * per_cu;
    }
    P p{};
    for (int i = 0; i < 26; ++i) p.in[i] = (const float*)d_in[i];
    p.out = (float*)d_out; p.ws = (unsigned char*)d_ws;
    void* args[] = {&p};
    hipError_t e = hipLaunchCooperativeKernel((void*)mega, dim3(grid_blocks), dim3(512), args, LDS_BYTES, stream);
    if (e != hipSuccess) fprintf(stderr, "cooperative launch failed: %s (grid %d)\n", hipGetErrorString(e), grid_blocks);
}
```

```cpp
#include <hip/hip_runtime.h>
#include <hip/hip_cooperative_groups.h>
#include <cstdio>
#include <cstdint>
namespace cg = cooperative_groups;
__device__ __forceinline__ int tid_opaque() { int t = (int)threadIdx.x; asm volatile("" : "+v"(t)); return t; }
#define TIDX tid_opaque()
#define LAS __attribute__((address_space(3)))
typedef float cf2 __attribute__((ext_vector_type(2)));
typedef float nf4 __attribute__((ext_vector_type(4)));
typedef unsigned nu2 __attribute__((ext_vector_type(2)));
typedef unsigned nu4 __attribute__((ext_vector_type(4)));
namespace pg8 {
#define PG8_LAS __attribute__((address_space(3)))
typedef unsigned short bf16_t;
typedef short bf16x8 __attribute__((ext_vector_type(8)));
typedef float f32x4 __attribute__((ext_vector_type(4)));
typedef unsigned u32x4 __attribute__((ext_vector_type(4)));
constexpr int BM = 256, BK = 64, HALF = 128, HTB = HALF * BK * 2  , STAGE_BYTES = 8 * HTB, NXCD = 8, WGM = 8;

__host__ __device__ __forceinline__ int lds_byte(int r, int c) { const int st = (r >> 4) * 2 + (c >> 5), rr = r & 15, cc = c & 31, ob = rr * 64 + cc * 2; return st * 1024 + (ob ^ (((ob >> 9) & 1) << 5)); }
__host__ __device__ __forceinline__ void stage_rc(int b, int& R, int& C) { const int st = b / 1024, sb = b % 1024, swz = sb ^ (((sb >> 9) & 1) << 5); R = (st >> 1) * 16 + swz / 64; C = (st & 1) * 32 + (swz % 64) / 2; }
__host__ __device__ __forceinline__ int perm32(int rho) { const int n = rho >> 4, i = rho & 15; return 8 * (i >> 2) + 4 * n + (i & 3); }

struct Unit { int pm, pn; };
struct Gemm { const bf16_t* A; const bf16_t* Bt; int M, N, K; int ovl; };

struct StaticOrder {
    int nM, nN, nwg, G, c;
    __host__ __device__ void init(int M, int N, int G_, int c_) { nM = M / BM; nN = N / BM; nwg = nM * nN; G = G_; c = c_; }
    __host__ __device__ bool next(int i, Unit& u) const {
        const long L = (long)i * G + c; if (L >= nwg) return false;
        int wgid = (int)L; { const int q = nwg / NXCD, r = nwg % NXCD, xcd = wgid % NXCD, off = wgid / NXCD; wgid = (xcd < r ? xcd * (q + 1) : r * (q + 1) + (xcd - r) * q) + off; }
        const int nig = WGM * nN, gid = wgid / nig, fm = gid * WGM, gsz = (nM - fm) < WGM ? (nM - fm) : WGM;
        u.pm = fm + ((wgid % nig) % gsz); u.pn = (wgid % nig) / gsz; return true;
    }
    __device__ __forceinline__ void a_ready(const Unit&) const {}
    __device__ __forceinline__ void done(const Unit&) const {}
};
struct CountedOrder : StaticOrder {
    const unsigned* ready; unsigned need; unsigned* tmo;
    __device__ __forceinline__ void a_ready(const Unit& u) const {
        if (TIDX < 64) {
            const unsigned long long t0 = __builtin_amdgcn_s_memrealtime(); unsigned polls = 0;
            while ((unsigned)__builtin_amdgcn_readfirstlane(__hip_atomic_load(ready + 64 * u.pm, __ATOMIC_RELAXED, __HIP_MEMORY_SCOPE_AGENT)) < need) {
                if ((++polls & 255u) == 0u && __builtin_amdgcn_readfirstlane(__hip_atomic_load(tmo, __ATOMIC_RELAXED, __HIP_MEMORY_SCOPE_AGENT)) != 0u) break;
                if (__builtin_amdgcn_s_memrealtime() - t0 > 2000000ull) {
                    if (TIDX == 0) { unsigned expect = 0u; __hip_atomic_compare_exchange_strong(tmo + 1, &expect, 0x600u | (unsigned)(u.pm & 0xff), __ATOMIC_RELAXED, __ATOMIC_RELAXED, __HIP_MEMORY_SCOPE_AGENT); __hip_atomic_store(tmo, 1u, __ATOMIC_RELAXED, __HIP_MEMORY_SCOPE_AGENT); }
                    break; }
                __builtin_amdgcn_s_sleep(2); }
            __builtin_amdgcn_fence(__ATOMIC_ACQUIRE, "agent");
            asm volatile("s_waitcnt vmcnt(0)" ::: "memory");
        }
#if !defined(BROKEN_HOOK_NO_BARRIER)
        asm volatile("" ::: "memory"); __builtin_amdgcn_s_barrier(); asm volatile("" ::: "memory");
#endif
    }
};

__device__ __forceinline__ unsigned cvt_pk_bf16(float lo, float hi) { unsigned r; asm volatile("v_cvt_pk_bf16_f32 %0, %1, %2" : "=v"(r) : "v"(lo), "v"(hi)); return r; }
typedef float f32x2 __attribute__((ext_vector_type(2)));
__device__ __forceinline__ f32x2 gelu_pk(f32x2 v) {
    const f32x2 av = __builtin_elementwise_abs(v), d = av * 0.2316418882f + 1.0f;
    f32x2 t; t.x = __builtin_amdgcn_rcpf(d.x); t.y = __builtin_amdgcn_rcpf(d.y);
    f32x2 q = t * 0.5307027145f + (-0.7265760135f); q = q * t + 0.7107068705f; q = q * t + (-0.142248368f); q = q * t + 0.127414796f; q = q * t;
    const f32x2 s = (v * v) * (-0.72134752044f);
    f32x2 e; e.x = __builtin_amdgcn_exp2f(s.x); e.y = __builtin_amdgcn_exp2f(s.y);
    const f32x2 m = v * (q * e), r = v - m;
    f32x2 o; o.x = v.x < 0.f ? m.x : r.x; o.y = v.y < 0.f ? m.y : r.y; return o;
}

struct EpiF32 {
    static constexpr bool PERM = false, AFTER_DRAIN = false;
    float* C; int ldc; const float* bias;
    __device__ __forceinline__ void operator()(const f32x4 (&acc)[2][2][4][2], const Unit& u, int wr, int wc, int fr, int fq) const {
        const int row0 = u.pm * BM + wr * 64 + fr, col0 = u.pn * BM + wc * 32 + 4 * fq;
        f32x4 bv[2][2];
#pragma unroll
        for (int bj = 0; bj < 2; ++bj)
#pragma unroll
            for (int n = 0; n < 2; ++n) bv[bj][n] = bias ? *(const f32x4*)(bias + col0 + bj * HALF + n * 16) : (f32x4){0.f, 0.f, 0.f, 0.f};
#pragma unroll
        for (int ai = 0; ai < 2; ++ai)
#pragma unroll
            for (int m = 0; m < 4; ++m) { float* rowp = C + (size_t)(row0 + ai * HALF + m * 16) * ldc + col0;
#pragma unroll
                for (int bj = 0; bj < 2; ++bj)
#pragma unroll
                    for (int n = 0; n < 2; ++n) *(f32x4*)(rowp + bj * HALF + n * 16) = acc[ai][bj][m][n] + bv[bj][n]; }
    }
};
template <int ACT  > struct EpiBf16 {
    static constexpr bool PERM = true, AFTER_DRAIN = false;
    bf16_t* O; int ldc; const float* bias; int split_cols; size_t split_stride;
    __device__ __forceinline__ void operator()(const f32x4 (&acc)[2][2][4][2], const Unit& u, int wr, int wc, int fr, int fq) const {
        const int row0 = u.pm * BM + wr * 64 + fr; int colt = u.pn * BM; bf16_t* base = O;
        if (split_cols) { const int t = colt / split_cols; base += (size_t)t * split_stride; colt -= t * split_cols; }
        const int col0 = colt + wc * 32 + 8 * fq, bcol0 = u.pn * BM + wc * 32 + 8 * fq;
        f32x4 bv[2][2];
#pragma unroll
        for (int bj = 0; bj < 2; ++bj)
#pragma unroll
            for (int n = 0; n < 2; ++n) bv[bj][n] = bias ? *(const f32x4*)(bias + bcol0 + bj * HALF + 4 * n) : (f32x4){0.f, 0.f, 0.f, 0.f};
#pragma unroll
        for (int ai = 0; ai < 2; ++ai)
#pragma unroll
            for (int m = 0; m < 4; ++m) { bf16_t* rowp = base + (size_t)(row0 + ai * HALF + m * 16) * ldc + col0;
#pragma unroll
                for (int bj = 0; bj < 2; ++bj) { f32x4 v0 = acc[ai][bj][m][0] + bv[bj][0], v1 = acc[ai][bj][m][1] + bv[bj][1];
                    if (ACT == 1) { f32x2 a = gelu_pk((f32x2){v0[0], v0[1]}), b = gelu_pk((f32x2){v0[2], v0[3]}), c = gelu_pk((f32x2){v1[0], v1[1]}), d = gelu_pk((f32x2){v1[2], v1[3]});
                        v0 = (f32x4){a.x, a.y, b.x, b.y}; v1 = (f32x4){c.x, c.y, d.x, d.y}; }
                    if (ACT == 2) {
#pragma unroll
                        for (int j = 0; j < 4; ++j) { v0[j] = 0.5f * v0[j] * (1.0f + erff(v0[j] * 0.70710678f)); v1[j] = 0.5f * v1[j] * (1.0f + erff(v1[j] * 0.70710678f)); } }
                    u32x4 w; w.x = cvt_pk_bf16(v0[0], v0[1]); w.y = cvt_pk_bf16(v0[2], v0[3]); w.z = cvt_pk_bf16(v1[0], v1[1]); w.w = cvt_pk_bf16(v1[2], v1[3]);
                    *(u32x4*)(rowp + bj * HALF) = w; } }
    }
};
template <class Epi, class Sched, bool STAMP = false>
__device__ __forceinline__ void gemm_phase(PG8_LAS unsigned char* lds, const Gemm g, const Sched& S, const Epi& E, unsigned long long* stamps) {
    const int tid = TIDX, wid = __builtin_amdgcn_readfirstlane(tid >> 6), lane = tid & 63, wr = wid >> 2, wc = wid & 3, fr = lane & 15, fq = lane >> 4;
    const int K = g.K, nt = K / BK;
    int ts_lo = 0, ts_hi = 0, nts = 0; const unsigned long long rt_entry = STAMP ? (unsigned long long)wall_clock64() : 0ull;
#define PG8_STAMP() do { if (STAMP && wid == 0 && nts < 64) { const unsigned long long _c = (unsigned long long)clock64(); \
        ts_lo = (lane == nts) ? (int)(unsigned)_c : ts_lo; ts_hi = (lane == nts) ? (int)(unsigned)(_c >> 32) : ts_hi; ++nts; } } while (0)
    PG8_STAMP();
    unsigned voffA[2], voffB[2];
#pragma unroll
    for (int i = 0; i < 2; ++i) { int R, C; stage_rc(tid * 16 + i * 8192, R, C); const int Rb = Epi::PERM ? ((R & ~31) + perm32(R & 31)) : R;
        const int Ra = g.ovl ? R - 2 * (R >> 6) : R; voffA[i] = (unsigned)(Ra * K + C) * 2u; voffB[i] = (unsigned)(Rb * K + C) * 2u; }
    const size_t kstep = (size_t)(BK * 2);
    const size_t hstep = (size_t)HALF * K * 2;
    const size_t tstep = 2 * hstep;
    const size_t hstepA = g.ovl ? (size_t)124 * K * 2 : hstep, tstepA = g.ovl ? (size_t)248 * K * 2 : tstep;
    const unsigned ldsw = (unsigned)wid * 1024u;
    const int aoff = lds_byte(wr * 64 + fr, fq * 8), boff = lds_byte(wc * 32 + fr, fq * 8);
#define PG8_SA(b, h) (((b) * 2 + (h)) * HTB)
#define PG8_SB(b, h) ((4 + (b) * 2 + (h)) * HTB)
#define PG8_STAGE(bufoff, gbase, voff) do { _Pragma("unroll") for (int _i = 0; _i < 2; ++_i) \
        __builtin_amdgcn_global_load_lds((const unsigned*)((const char*)(gbase) + (voff)[_i]), (PG8_LAS unsigned*)(lds + (bufoff) + ldsw + _i * 8192), 16, 0, 0); } while (0)
#define PG8_LDA(dst, b, h) do { _Pragma("unroll") for (int m = 0; m < 4; ++m) _Pragma("unroll") for (int k = 0; k < 2; ++k) dst[m][k] = *(const PG8_LAS bf16x8*)(lds + PG8_SA(b, h) + aoff + m * 2048 + k * 1024); } while (0)
#define PG8_LDB(dst, b, h) do { _Pragma("unroll") for (int n = 0; n < 2; ++n) _Pragma("unroll") for (int k = 0; k < 2; ++k) dst[n][k] = *(const PG8_LAS bf16x8*)(lds + PG8_SB(b, h) + boff + n * 2048 + k * 1024); } while (0)
#define PG8_MMA(ai, bj, At, Bt) do { __builtin_amdgcn_s_setprio(1); _Pragma("unroll") for (int m = 0; m < 4; ++m) _Pragma("unroll") for (int n = 0; n < 2; ++n) _Pragma("unroll") for (int k = 0; k < 2; ++k) \
        acc[ai][bj][m][n] = __builtin_amdgcn_mfma_f32_16x16x32_bf16(Bt[n][k], At[m][k], acc[ai][bj][m][n], 0, 0, 0); __builtin_amdgcn_s_setprio(0); } while (0)
#define PG8_WAIT_V(n) asm volatile("s_waitcnt vmcnt(" #n ")" ::: "memory")
#define PG8_WAIT_L(n) asm volatile("s_waitcnt lgkmcnt(" #n ")" ::: "memory")
#define PG8_BAR __builtin_amdgcn_s_barrier()
#define PG8_SCHED __builtin_amdgcn_sched_barrier(0)
    Unit cur, nxt; int ui = 0;
    if (!S.next(0, cur)) return;
    f32x4 acc[2][2][4][2];
#pragma unroll
    for (int a = 0; a < 2; ++a)
#pragma unroll
        for (int b = 0; b < 2; ++b)
#pragma unroll
            for (int m = 0; m < 4; ++m)
#pragma unroll
                for (int n = 0; n < 2; ++n) acc[a][b][m][n] = (f32x4){0.f, 0.f, 0.f, 0.f};
    bf16x8 At[4][2], B0[2][2], B1[2][2];
    const char* cA = (const char*)g.A + (size_t)cur.pm * tstepA; const char* cB = (const char*)g.Bt + (size_t)cur.pn * tstep;
    S.a_ready(cur);
    PG8_STAGE(PG8_SB(0, 0), cB, voffB); PG8_STAGE(PG8_SA(0, 0), cA, voffA); PG8_STAGE(PG8_SB(0, 1), cB + hstep, voffB); PG8_STAGE(PG8_SA(0, 1), cA + hstepA, voffA);
    if (wr == 1) PG8_BAR;
    PG8_WAIT_V(4); PG8_BAR;
    PG8_STAGE(PG8_SB(1, 0), cB + kstep, voffB); PG8_STAGE(PG8_SA(1, 0), cA + kstep, voffA); PG8_STAGE(PG8_SB(1, 1), cB + hstep + kstep, voffB);
    PG8_WAIT_V(6); PG8_BAR;
    PG8_STAMP();
    for (;;) {
        const bool has_next = S.next(ui + 1, nxt);
        const char* nA = has_next ? (const char*)g.A + (size_t)nxt.pm * tstepA : cA; const char* nB = has_next ? (const char*)g.Bt + (size_t)nxt.pn * tstep : cB;
        for (int t = 0; t < nt; t += 2) {
            const bool last = (t == nt - 2);
            const char* a1 = cA + (size_t)(t + 1) * kstep;
            const char* a2 = last ? nA : cA + (size_t)(t + 2) * kstep; const char* b2 = last ? nB : cB + (size_t)(t + 2) * kstep;
            const char* a3 = a2 + kstep; const char* b3 = b2 + kstep;
            if (last && has_next) S.a_ready(nxt);
            PG8_LDB(B0, 0, 0); PG8_SCHED; PG8_LDA(At, 0, 0); PG8_STAGE(PG8_SA(1, 1), a1 + hstepA, voffA);
            PG8_WAIT_L(8); PG8_BAR; PG8_WAIT_L(0); PG8_MMA(0, 0, At, B0); PG8_BAR; PG8_SCHED;
            PG8_LDB(B1, 0, 1); PG8_STAGE(PG8_SB(0, 0), b2, voffB);
            PG8_BAR; PG8_WAIT_L(0); PG8_MMA(0, 1, At, B1); PG8_BAR;
            PG8_LDA(At, 0, 1); PG8_STAGE(PG8_SA(0, 0), a2, voffA);
            PG8_BAR; PG8_WAIT_L(0); PG8_MMA(1, 0, At, B0); PG8_BAR; PG8_SCHED;
            PG8_STAGE(PG8_SB(0, 1), b2 + hstep, voffB);
            PG8_WAIT_V(6); PG8_BAR; PG8_MMA(1, 1, At, B1); PG8_BAR;
            PG8_LDB(B0, 1, 0); PG8_SCHED; PG8_LDA(At, 1, 0); PG8_STAGE(PG8_SA(0, 1), a2 + hstepA, voffA);
            PG8_WAIT_L(8); PG8_BAR; PG8_WAIT_L(0); PG8_MMA(0, 0, At, B0); PG8_BAR; PG8_SCHED;
            PG8_LDB(B1, 1, 1); PG8_STAGE(PG8_SB(1, 0), b3, voffB);
            PG8_BAR; PG8_WAIT_L(0); PG8_MMA(0, 1, At, B1); PG8_BAR;
            PG8_LDA(At, 1, 1); PG8_STAGE(PG8_SA(1, 0), a3, voffA);
            PG8_BAR; PG8_WAIT_L(0); PG8_MMA(1, 0, At, B0); PG8_BAR; PG8_SCHED;
            PG8_STAGE(PG8_SB(1, 1), b3 + hstep, voffB);
            PG8_WAIT_V(6); PG8_BAR; PG8_MMA(1, 1, At, B1); PG8_BAR;
        }
        PG8_STAMP();
        if constexpr (!Epi::AFTER_DRAIN) { E(acc, cur, wr, wc, fr, fq); S.done(cur); }
        PG8_STAMP();
        if (!has_next) break;
#pragma unroll
        for (int a = 0; a < 2; ++a)
#pragma unroll
            for (int b = 0; b < 2; ++b)
#pragma unroll
                for (int m = 0; m < 4; ++m)
#pragma unroll
                    for (int n = 0; n < 2; ++n) acc[a][b][m][n] = (f32x4){0.f, 0.f, 0.f, 0.f};
        cur = nxt; cA = nA; cB = nB; ++ui;
    }
    PG8_WAIT_V(0);
    if (wr == 0) PG8_BAR;
    PG8_BAR;
    if constexpr (Epi::AFTER_DRAIN) { E.fused(acc, cur, wr, wc, fr, fq, lds, wid, lane); S.done(cur); }
    PG8_STAMP();
    if (STAMP && wid == 0) { stamps[lane] = lane < nts ? (((unsigned long long)(unsigned)ts_hi << 32) | (unsigned)ts_lo) : 0ull;
        if (lane == 62) stamps[62] = rt_entry; if (lane == 63) stamps[63] = (unsigned long long)wall_clock64(); }
#undef PG8_STAMP
#undef PG8_SA
#undef PG8_SB
#undef PG8_STAGE
#undef PG8_LDA
#undef PG8_LDB
#undef PG8_MMA
#undef PG8_WAIT_V
#undef PG8_WAIT_L
#undef PG8_BAR
#undef PG8_SCHED
}
}
typedef unsigned short bf16_t;
constexpr int T_TOK = 32768, DM = 1024, D_IN = 4096, D_HY = 512, D_HG = 512, DFF = 4096, NLAYER = 4;
constexpr int L_BIG = 16384, L_SML = 4096;
constexpr int APAD = 256;
constexpr size_t MiB = 1024ull * 1024ull;
constexpr size_t OFF_W = 0;
constexpr size_t OFF_W_IN = OFF_W, OFF_W_OUT = OFF_W + 8 * MiB, OFF_W_UP = OFF_W + 10 * MiB, OFF_W_DN = OFF_W + 26 * MiB;
constexpr size_t OFF_ABUF = 34 * MiB;
constexpr size_t OFF_R1 = 99 * MiB;
constexpr size_t OFF_HYRAW = OFF_R1;
constexpr size_t OFF_HG = OFF_R1 + 96 * MiB;
constexpr size_t OFF_KT = OFF_R1;
constexpr size_t OFF_ACT = OFF_R1;
constexpr size_t OFF_R2 = 355 * MiB;
constexpr size_t OFF_X0T = OFF_R2, OFF_ZT = OFF_R2 + 32 * MiB;
constexpr size_t OFF_MIX = OFF_R2;
constexpr size_t OFF_UPART = OFF_R2;
constexpr size_t OFF_R6 = 419 * MiB;
constexpr size_t OFF_OBUF = OFF_R6;
constexpr size_t OFF_KS = OFF_R6;
constexpr size_t OFF_SMALL = 483 * MiB;
constexpr size_t WS_NEED = 487 * MiB;

struct P { const float* in[26]; float* out; unsigned char* ws; };
constexpr int PB_norm_mix_pre = 0;
constexpr int PB_norm_mix_post = 4096;
constexpr int PB_norm_ffn_pre = 8192;
constexpr int PB_norm_ffn_post = 12288;
constexpr int PB_hy_conv_w = 16384;
constexpr int PB_hy_conv_b = 34816;
constexpr int PB_f_w1 = 40960;
constexpr int PB_f_b1 = 49408;
constexpr int PB_f_w2 = 49664;
constexpr int PB_f_b2 = 66048;
constexpr int PB_f_w3 = 66304;
constexpr int PB_f_b3 = 82688;
constexpr int PB_f_w4 = 82944;
constexpr int PB_f_freq = 345088;
constexpr int PB_hy_skip = 345344;
constexpr int PB_hy_out_norm = 347392;
constexpr int PB_lb_table = 349440;
constexpr int PB_hg_out_norm = 353536;
constexpr int PB_ffn_conv_w = 355584;
constexpr int PB_ffn_conv_b = 453888;
constexpr int PB_TOTAL = 486656;
constexpr size_t OFF_PB = OFF_SMALL + 512 * 1024;
#define PRM(p, NAME) ((const float*)((p).ws + OFF_PB) + PB_##NAME)

__device__ __forceinline__ float bf2f(bf16_t b) { return __uint_as_float(((unsigned)b) << 16); }
__device__ __forceinline__ bf16_t f2bf(float f) { unsigned u = __float_as_uint(f); u += 0x7FFFu + ((u >> 16) & 1u); return (bf16_t)(u >> 16); }
__device__ __forceinline__ unsigned pack_bf2(float lo, float hi) { return (unsigned)f2bf(lo) | ((unsigned)f2bf(hi) << 16); }
__device__ __forceinline__ bool seq_start(int t) { return t < L_BIG ? (t == 0) : ((t & (L_SML - 1)) == 0); }
__device__ __forceinline__ bool seq_end(int t) { return (t + 1 == T_TOK) || seq_start(t + 1); }
__device__ __forceinline__ const float* x_src_row(const P& p, int l, int t) {
    if (l > 0) return p.out + (size_t)t * DM;
    return t < L_BIG ? p.in[0] + (size_t)t * DM : p.in[1] + (size_t)(t - L_BIG) * DM;
}
__device__ __forceinline__ float silu_f(float x) { return x / (1.0f + __expf(-x)); }
__device__ __forceinline__ float wave_sum(float v) {
#pragma unroll
    for (int o = 32; o >= 1; o >>= 1) v += __shfl_xor(v, o);
    return v;
}

struct EpiBf16Split {
    static constexpr bool PERM = true, AFTER_DRAIN = false, OVL = false;
    bf16_t* O0; int ldc0; bf16_t* O1; int ldc1; int csplit;
    __device__ __forceinline__ void operator()(const pg8::f32x4 (&acc)[2][2][4][2], const pg8::Unit& u, int wr, int wc, int fr, int fq) const {
        const int row0 = u.pm * pg8::BM + wr * 64 + fr; int colt = u.pn * pg8::BM; bf16_t* base = O0; int ldc = ldc0;
        if (colt >= csplit) { base = O1; ldc = ldc1; colt -= csplit; }
        const int col0 = colt + wc * 32 + 8 * fq;
#pragma unroll
        for (int ai = 0; ai < 2; ++ai)
#pragma unroll
            for (int m = 0; m < 4; ++m) { bf16_t* rowp = base + (size_t)(row0 + ai * pg8::HALF + m * 16) * ldc + col0;
#pragma unroll
                for (int bj = 0; bj < 2; ++bj) { const pg8::f32x4 v0 = acc[ai][bj][m][0], v1 = acc[ai][bj][m][1];
                    pg8::u32x4 w; w.x = pg8::cvt_pk_bf16(v0[0], v0[1]); w.y = pg8::cvt_pk_bf16(v0[2], v0[3]); w.z = pg8::cvt_pk_bf16(v1[0], v1[1]); w.w = pg8::cvt_pk_bf16(v1[2], v1[3]);
                    *(pg8::u32x4*)(rowp + bj * pg8::HALF) = w; } }
    }
};
__device__ __forceinline__ float dpp_ror1(float v) { return __int_as_float(__builtin_amdgcn_update_dpp(0, __float_as_int(v), 0x121, 0xF, 0xF, false)); }
__device__ __forceinline__ float dpp_ror15(float v) { return __int_as_float(__builtin_amdgcn_update_dpp(0, __float_as_int(v), 0x12F, 0xF, 0xF, false)); }
__device__ __forceinline__ float gelu_tanh_e(float x) { const float y = 1.5957691216057308f * (x + 0.044715f * x * x * x); return x * __builtin_amdgcn_rcpf(1.0f + __expf(-y)); }
struct EpiGeglu {
    static constexpr bool PERM = true, AFTER_DRAIN = false, OVL = true;
    bf16_t* act; const float* cw; const float* cb;
    __device__ __forceinline__ void operator()(const pg8::f32x4 (&acc)[2][2][4][2], const pg8::Unit& u, int wr, int wc, int fr, int fq) const {
        const int j0 = u.pn * 128 + wc * 32 + 8 * fq;
        unsigned mprev = 0, mnext = 0, mst = 0;
#pragma unroll
        for (int ai = 0; ai < 2; ++ai)
#pragma unroll
            for (int m = 0; m < 4; ++m) { const int q = 16 * m + fr, tok = u.pm * 248 + 124 * ai + 62 * wr + q - 1, b = ai * 4 + m;
                const bool st = q >= 1 && q <= 62 && tok < T_TOK;
                if (st) { mst |= 1u << b; if (!seq_start(tok)) mprev |= 1u << b; if (!seq_end(tok)) mnext |= 1u << b; } }
#pragma unroll
        for (int n = 0; n < 2; ++n) {
            const int jc = j0 + 4 * n;
            const pg8::f32x4 wa0 = *(const pg8::f32x4*)(cw + jc), wa1 = *(const pg8::f32x4*)(cw + 8192 + jc), wa2 = *(const pg8::f32x4*)(cw + 16384 + jc), ba = *(const pg8::f32x4*)(cb + jc);
            const pg8::f32x4 wb0 = *(const pg8::f32x4*)(cw + 4096 + jc), wb1 = *(const pg8::f32x4*)(cw + 8192 + 4096 + jc), wb2 = *(const pg8::f32x4*)(cw + 16384 + 4096 + jc), bb = *(const pg8::f32x4*)(cb + 4096 + jc);
#pragma unroll
            for (int ai = 0; ai < 2; ++ai) {
                pg8::f32x4 pa_prev, pb_prev, na_cur, nb_cur;
#pragma unroll
                for (int i = 0; i < 4; ++i) { na_cur[i] = dpp_ror15(acc[ai][0][0][n][i]); nb_cur[i] = dpp_ror15(acc[ai][1][0][n][i]); pa_prev[i] = 0.f; pb_prev[i] = 0.f; }
#pragma unroll
                for (int m = 0; m < 4; ++m) {
                    const int b = ai * 4 + m, q = 16 * m + fr, tok = u.pm * 248 + 124 * ai + 62 * wr + q - 1;
                    const bool hp = (mprev >> b) & 1u, hn = (mnext >> b) & 1u;
                    pg8::f32x4 pa_cur, pb_cur, na_next, nb_next;
#pragma unroll
                    for (int i = 0; i < 4; ++i) { pa_cur[i] = dpp_ror1(acc[ai][0][m][n][i]); pb_cur[i] = dpp_ror1(acc[ai][1][m][n][i]);
                        na_next[i] = m < 3 ? dpp_ror15(acc[ai][0][m < 3 ? m + 1 : 3][n][i]) : 0.f; nb_next[i] = m < 3 ? dpp_ror15(acc[ai][1][m < 3 ? m + 1 : 3][n][i]) : 0.f; }
                    const pg8::f32x4 xpa = (fr == 0) ? pa_prev : pa_cur, xna = (fr == 15) ? na_next : na_cur;
                    const pg8::f32x4 xpb = (fr == 0) ? pb_prev : pb_cur, xnb = (fr == 15) ? nb_next : nb_cur;
                    const pg8::f32x4 xa = acc[ai][0][m][n], xb = acc[ai][1][m][n];
                    float o[4];
#pragma unroll
                    for (int i = 0; i < 4; ++i) {
                        const float ya = (hp ? xpa[i] * wa0[i] : 0.f) + xa[i] * wa1[i] + (hn ? xna[i] * wa2[i] : 0.f) + ba[i];
                        const float yb = (hp ? xpb[i] * wb0[i] : 0.f) + xb[i] * wb1[i] + (hn ? xnb[i] * wb2[i] : 0.f) + bb[i];
                        o[i] = gelu_tanh_e(ya) * yb;
                    }
                    if ((mst >> b) & 1u) { uint2 w; w.x = pg8::cvt_pk_bf16(o[0], o[1]); w.y = pg8::cvt_pk_bf16(o[2], o[3]); *(uint2*)(act + (size_t)tok * DFF + jc) = w; }
                    pa_prev = pa_cur; pb_prev = pb_cur; na_cur = na_next; nb_cur = nb_next;
                }
            }
        }
    }
};
template <class Epi>
__device__ __forceinline__ void run_gemm(LAS unsigned char* lds, const bf16_t* A, const bf16_t* Bt, int M, int N, int K, const Epi& E) {
    pg8::Gemm g; g.A = A; g.Bt = Bt; g.M = M; g.N = N; g.K = K; g.ovl = Epi::OVL ? 1 : 0;
    pg8::StaticOrder S; S.init(M, N, (int)gridDim.x, (int)blockIdx.x);
    pg8::gemm_phase<Epi, pg8::StaticOrder, false>((PG8_LAS unsigned char*)lds, g, S, E, nullptr);
}

#define HD_INLINE __device__ __forceinline__
#define DEV_FN __device__ __forceinline__
#define LDS_F2 LAS cf2*
#define NTHR 512
#define FOR_TID for (int tid = (int)TIDX, once_ = 1; once_; once_ = 0)
#define SYNC __syncthreads()
#define BREV32(x) __brev(x)
#define CIS_REV(fr, c, s) do { const float f_ = (fr); c = __builtin_amdgcn_cosf(f_); s = __builtin_amdgcn_sinf(f_); } while (0)
HD_INLINE unsigned rev4(unsigned k, int S) {
    unsigned v = BREV32(k) >> (32 - 2 * S);
    return ((v & 0xAAAAAAAAu) >> 1) | ((v & 0x55555555u) << 1);
}
HD_INLINE cf2 mkf2(float a, float b) { cf2 r; r.x = a; r.y = b; return r; }
HD_INLINE cf2 cmul(cf2 a, cf2 b) { return mkf2(a.x * b.x - a.y * b.y, a.x * b.y + a.y * b.x); }
HD_INLINE cf2 cmulc(cf2 a, cf2 b) { return mkf2(a.x * b.x + a.y * b.y, a.y * b.x - a.x * b.y); }

DEV_FN void fft_fwd(LDS_F2 X, int S, int s0) {
    const int M = 1 << (2 * S);
    for (int s = s0; s < S; ++s) {
        const int n = M >> (2 * s), q = n >> 2;
        const float invn = 1.0f / (float)n;
        FOR_TID {
            for (int b = tid; b < (M >> 2); b += NTHR) {
                const int j = b & (q - 1), base = ((b - j) << 2) + j;
                const cf2 a0 = X[base], a1 = X[base + q], a2 = X[base + 2 * q], a3 = X[base + 3 * q];
                const cf2 t0 = mkf2(a0.x + a2.x, a0.y + a2.y), t1 = mkf2(a0.x - a2.x, a0.y - a2.y);
                const cf2 t2 = mkf2(a1.x + a3.x, a1.y + a3.y);
                const cf2 d13 = mkf2(a1.x - a3.x, a1.y - a3.y);
                const cf2 t3 = mkf2(d13.y, -d13.x);
                const cf2 y0 = mkf2(t0.x + t2.x, t0.y + t2.y);
                cf2 y1 = mkf2(t1.x + t3.x, t1.y + t3.y);
                cf2 y2 = mkf2(t0.x - t2.x, t0.y - t2.y);
                cf2 y3 = mkf2(t1.x - t3.x, t1.y - t3.y);
                if (q > 1) {
                    const float fr = (float)j * invn;
                    float c1, s1, c2, s2, c3, s3;
                    CIS_REV(fr, c1, s1); CIS_REV(2.0f * fr, c2, s2); CIS_REV(3.0f * fr, c3, s3);
                    y1 = cmul(y1, mkf2(c1, -s1)); y2 = cmul(y2, mkf2(c2, -s2)); y3 = cmul(y3, mkf2(c3, -s3));
                }
                X[base] = y0; X[base + q] = y1; X[base + 2 * q] = y2; X[base + 3 * q] = y3;
            }
        }
        SYNC;
    }
}
DEV_FN void fft_inv(LDS_F2 X, int S) {
    const int M = 1 << (2 * S);
    for (int s = S - 1; s >= 0; --s) {
        const int n = M >> (2 * s), q = n >> 2;
        const float invn = 1.0f / (float)n;
        FOR_TID {
            for (int b = tid; b < (M >> 2); b += NTHR) {
                const int j = b & (q - 1), base = ((b - j) << 2) + j;
                cf2 b0 = X[base], b1 = X[base + q], b2 = X[base + 2 * q], b3 = X[base + 3 * q];
                if (q > 1) {
                    const float fr = (float)j * invn;
                    float c1, s1, c2, s2, c3, s3;
                    CIS_REV(fr, c1, s1); CIS_REV(2.0f * fr, c2, s2); CIS_REV(3.0f * fr, c3, s3);
                    b1 = cmul(b1, mkf2(c1, s1)); b2 = cmul(b2, mkf2(c2, s2)); b3 = cmul(b3, mkf2(c3, s3));
                }
                const cf2 t0 = mkf2(b0.x + b2.x, b0.y + b2.y), t1 = mkf2(b0.x - b2.x, b0.y - b2.y);
                const cf2 t2 = mkf2(b1.x + b3.x, b1.y + b3.y);
                const cf2 d13 = mkf2(b1.x - b3.x, b1.y - b3.y);
                const cf2 t3 = mkf2(-d13.y, d13.x);
                X[base] = mkf2(t0.x + t2.x, t0.y + t2.y);
                X[base + q] = mkf2(t1.x + t3.x, t1.y + t3.y);
                X[base + 2 * q] = mkf2(t0.x - t2.x, t0.y - t2.y);
                X[base + 3 * q] = mkf2(t1.x - t3.x, t1.y - t3.y);
            }
        }
        SYNC;
    }
}
DEV_FN void spec_store(LDS_F2 X, int S, cf2* Ks) {
    const int M = 1 << (2 * S);
    FOR_TID {
        for (int k = tid; k <= (M >> 1); k += NTHR) {
            if (k == 0) { const cf2 c0 = X[0]; Ks[0] = mkf2(c0.x + c0.y, c0.x - c0.y); }
            else {
                const cf2 ck = X[rev4((unsigned)k, S)], cm = X[rev4((unsigned)(M - k), S)];
                const cf2 P = mkf2(0.5f * (ck.x + cm.x), 0.5f * (ck.y - cm.y));
                const cf2 O = mkf2(0.5f * (ck.y + cm.y), -0.5f * (ck.x - cm.x));
                float c, s; CIS_REV((float)k / (float)(2 * M), c, s);
                const cf2 Q = cmul(O, mkf2(c, -s));
                Ks[k] = mkf2(P.x + Q.x, P.y + Q.y);
                Ks[M - k] = mkf2(P.x - Q.x, -(P.y - Q.y));
            }
        }
    }
    SYNC;
}
DEV_FN void spec_mul(LDS_F2 X, int S, const cf2* Ks) {
    const int M = 1 << (2 * S);
    FOR_TID {
        for (int k = tid; k <= (M >> 1); k += NTHR) {
            if (k == 0) {
                const cf2 c0 = X[0], k0 = Ks[0];
                const float y0 = (c0.x + c0.y) * k0.x, ym = (c0.x - c0.y) * k0.y;
                X[0] = mkf2(0.5f * (y0 + ym), 0.5f * (y0 - ym));
            } else {
                const unsigned pk = rev4((unsigned)k, S), pm = rev4((unsigned)(M - k), S);
                const cf2 ck = X[pk], cm = X[pm];
                const cf2 P = mkf2(0.5f * (ck.x + cm.x), 0.5f * (ck.y - cm.y));
                const cf2 O = mkf2(0.5f * (ck.y + cm.y), -0.5f * (ck.x - cm.x));
                float c, s; CIS_REV((float)k / (float)(2 * M), c, s);
                const cf2 Wk = mkf2(c, -s);
                const cf2 Q = cmul(O, Wk);
                const cf2 xk = mkf2(P.x + Q.x, P.y + Q.y), xm = mkf2(P.x - Q.x, -(P.y - Q.y));
                const cf2 yk = cmul(xk, Ks[k]), ym = cmul(xm, Ks[M - k]);
                const cf2 Ye = mkf2(0.5f * (yk.x + ym.x), 0.5f * (yk.y - ym.y));
                const cf2 Yd = mkf2(0.5f * (yk.x - ym.x), 0.5f * (yk.y + ym.y));
                const cf2 Yo = cmulc(Yd, Wk);
                X[pk] = mkf2(Ye.x - Yo.y, Ye.y + Yo.x);
                if (k != (M >> 1)) X[pm] = mkf2(Ye.x + Yo.y, -Ye.y + Yo.x);
            }
        }
    }
    SYNC;
}
__device__ void ph_setup(const P& p) {
    const int gid = blockIdx.x * 512 + TIDX;
    if (gid < 2 * D_HG) {
        const int dir = gid / D_HG, c = gid % D_HG;
        float v[NLAYER], mx = -1e30f;
#pragma unroll
        for (int l = 0; l < NLAYER; ++l) { v[l] = p.in[19][(size_t)(dir * NLAYER + l) * D_HG + c]; mx = fmaxf(mx, v[l]); }
        float s = 0.f;
#pragma unroll
        for (int l = 0; l < NLAYER; ++l) { v[l] = expf(v[l] - mx); s += v[l]; }
        float* lbs = (float*)(p.ws + OFF_SMALL);
        float cum = 0.f;
#pragma unroll
        for (int l = 0; l < NLAYER; ++l) { if (l > 0) cum += v[l] / s; lbs[(size_t)(dir * NLAYER + l) * D_HG + c] = cum; }
    }
}
__device__ void ph_copy_params(const P& p) {
    float* pb = (float*)(p.ws + OFF_PB);
    const int g = blockIdx.x * 512 + TIDX, gs = gridDim.x * 512;
    for (int k = g; k < 4096; k += gs) pb[0 + k] = p.in[2][k];
    for (int k = g; k < 4096; k += gs) pb[4096 + k] = p.in[3][k];
    for (int k = g; k < 4096; k += gs) pb[8192 + k] = p.in[4][k];
    for (int k = g; k < 4096; k += gs) pb[12288 + k] = p.in[5][k];
    for (int k = g; k < 18432; k += gs) pb[16384 + k] = p.in[7][k];
    for (int k = g; k < 6144; k += gs) pb[34816 + k] = p.in[8][k];
    for (int k = g; k < 8448; k += gs) pb[40960 + k] = p.in[9][k];
    for (int k = g; k < 256; k += gs) pb[49408 + k] = p.in[10][k];
    for (int k = g; k < 16384; k += gs) pb[49664 + k] = p.in[11][k];
    for (int k = g; k < 256; k += gs) pb[66048 + k] = p.in[12][k];
    for (int k = g; k < 16384; k += gs) pb[66304 + k] = p.in[13][k];
    for (int k = g; k < 256; k += gs) pb[82688 + k] = p.in[14][k];
    for (int k = g; k < 262144; k += gs) pb[82944 + k] = p.in[15][k];
    for (int k = g; k < 256; k += gs) pb[345088 + k] = p.in[16][k];
    for (int k = g; k < 2048; k += gs) pb[345344 + k] = p.in[17][k];
    for (int k = g; k < 2048; k += gs) pb[347392 + k] = p.in[18][k];
    for (int k = g; k < 4096; k += gs) pb[349440 + k] = p.in[19][k];
    for (int k = g; k < 2048; k += gs) pb[353536 + k] = p.in[20][k];
    for (int k = g; k < 98304; k += gs) pb[355584 + k] = p.in[23][k];
    for (int k = g; k < 32768; k += gs) pb[453888 + k] = p.in[24][k];
}
__device__ void convert_one(const float* src, bf16_t* dst, int K, int N, LAS float* tile  , bool geglu_perm = false) {
    const int tiles_n = N / 64, ntiles = (K / 64) * tiles_n, tid = TIDX;
    for (int it = blockIdx.x; it < ntiles; it += gridDim.x) {
        const int k0 = (it / tiles_n) * 64, n0 = (it % tiles_n) * 64;
#pragma unroll
        for (int i = 0; i < 8; ++i) { const int r = (tid >> 6) + 8 * i, c = tid & 63; tile[r * 65 + c] = src[(size_t)(k0 + r) * N + n0 + c]; }
        __syncthreads();
#pragma unroll
        for (int i = 0; i < 8; ++i) { const int n = (tid >> 6) + 8 * i, k = tid & 63; int nr = n0 + n;
            if (geglu_perm) nr = nr < DFF ? (nr >> 7) * 256 + (nr & 127) : ((nr - DFF) >> 7) * 256 + 128 + ((nr - DFF) & 127);
            dst[(size_t)nr * K + k0 + k] = f2bf(tile[k * 65 + n]); }
        __syncthreads();
    }
}
__device__ void ph_convert_w(const P& p, int l, LAS unsigned char* lds) {
    LAS float* tile = (LAS float*)lds;
    convert_one(p.in[6] + (size_t)l * DM * D_IN, (bf16_t*)(p.ws + OFF_W_IN), DM, D_IN, tile);
    convert_one(p.in[21] + (size_t)l * DM * DM, (bf16_t*)(p.ws + OFF_W_OUT), DM, DM, tile);
    convert_one(p.in[22] + (size_t)l * DM * 2 * DFF, (bf16_t*)(p.ws + OFF_W_UP), DM, 2 * DFF, tile, true);
    convert_one(p.in[25] + (size_t)l * DFF * DM, (bf16_t*)(p.ws + OFF_W_DN), DFF, DM, tile);
}
__device__ __forceinline__ bf16_t* abuf_row(const P& p, int t) { return (bf16_t*)(p.ws + OFF_ABUF) + (size_t)(t + APAD) * DM; }
__device__ void ph_rmsnorm_in(const P& p, int l) {
    const int lane = TIDX & 63, wv = TIDX >> 6;
    const float* gain = p.in[2] + (size_t)l * DM;
    for (int t = blockIdx.x * 8 + wv; t < T_TOK; t += gridDim.x * 8) {
        const float* xr = x_src_row(p, l, t);
        float4 v[4]; float ss = 0.f;
#pragma unroll
        for (int i = 0; i < 4; ++i) { v[i] = *(const float4*)(xr + lane * 4 + 256 * i); ss += v[i].x * v[i].x + v[i].y * v[i].y + v[i].z * v[i].z + v[i].w * v[i].w; }
        ss = wave_sum(ss);
        const float r = rsqrtf(ss * (1.0f / DM) + 1e-6f);
        bf16_t* hr = abuf_row(p, t);
#pragma unroll
        for (int i = 0; i < 4; ++i) { const float4 g = *(const float4*)(gain + lane * 4 + 256 * i);
            uint2 w; w.x = pack_bf2(v[i].x * r * g.x, v[i].y * r * g.y); w.y = pack_bf2(v[i].z * r * g.z, v[i].w * r * g.w);
            *(uint2*)(hr + lane * 4 + 256 * i) = w; }
    }
}
__device__ void ph_norm_resid(const P& p, int l, int which) {
    const int lane = TIDX & 63, wv = TIDX >> 6;
    const float* gpost = (which == 0 ? PRM(p, norm_mix_post) : PRM(p, norm_ffn_post)) + (size_t)l * DM;
    const bool has_next = (which == 0) || (l + 1 < NLAYER);
    const float* gnext = which == 0 ? PRM(p, norm_ffn_pre) + (size_t)l * DM : PRM(p, norm_mix_pre) + (size_t)(has_next ? l + 1 : l) * DM;
    const bf16_t* Y = (const bf16_t*)(p.ws + OFF_MIX);
    const int lx = which == 0 ? l : 1;
    for (int t = blockIdx.x * 8 + wv; t < T_TOK; t += gridDim.x * 8) {
        const float* xr = x_src_row(p, lx, t);
        const bf16_t* yr = Y + (size_t)t * DM;
        float4 x[4], y[4]; float ss = 0.f;
#pragma unroll
        for (int i = 0; i < 4; ++i) { x[i] = *(const float4*)(xr + lane * 4 + 256 * i); const uint2 w = *(const uint2*)(yr + lane * 4 + 256 * i);
            y[i].x = __uint_as_float(w.x << 16); y[i].y = __uint_as_float(w.x & 0xffff0000u); y[i].z = __uint_as_float(w.y << 16); y[i].w = __uint_as_float(w.y & 0xffff0000u);
            ss += y[i].x * y[i].x + y[i].y * y[i].y + y[i].z * y[i].z + y[i].w * y[i].w; }
        ss = wave_sum(ss);
        const float r = rsqrtf(ss * (1.0f / DM) + 1e-6f);
        float s2 = 0.f;
#pragma unroll
        for (int i = 0; i < 4; ++i) { const float4 g = *(const float4*)(gpost + lane * 4 + 256 * i);
            x[i].x += y[i].x * r * g.x; x[i].y += y[i].y * r * g.y; x[i].z += y[i].z * r * g.z; x[i].w += y[i].w * r * g.w;
            s2 += x[i].x * x[i].x + x[i].y * x[i].y + x[i].z * x[i].z + x[i].w * x[i].w;
            *(float4*)(p.out + (size_t)t * DM + lane * 4 + 256 * i) = x[i]; }
        if (has_next) {
            s2 = wave_sum(s2);
            const float r2 = rsqrtf(s2 * (1.0f / DM) + 1e-6f);
            bf16_t* hr = abuf_row(p, t);
#pragma unroll
            for (int i = 0; i < 4; ++i) { const float4 g = *(const float4*)(gnext + lane * 4 + 256 * i);
                uint2 w; w.x = pack_bf2(x[i].x * r2 * g.x, x[i].y * r2 * g.y); w.y = pack_bf2(x[i].z * r2 * g.z, x[i].w * r2 * g.w);
                *(uint2*)(hr + lane * 4 + 256 * i) = w; }
        }
    }
}
__device__ void ph_filter(const P& p, int l, LAS unsigned char* lds) {
    LAS float* feats = (LAS float*)lds;
    LAS float* ha = feats + 16 * 36;
    LAS float* hb = ha + 16 * 64;
    LAS float* w1s = hb + 16 * 64;
    LAS float* w2s = w1s + 33 * 64;
    LAS float* w3s = w2s + 64 * 64;
    const int tid = TIDX;
    const float* w1 = PRM(p, f_w1) + (size_t)l * 33 * 64; const float* b1 = PRM(p, f_b1) + (size_t)l * 64;
    const float* w2 = PRM(p, f_w2) + (size_t)l * 64 * 64; const float* b2 = PRM(p, f_b2) + (size_t)l * 64;
    const float* w3 = PRM(p, f_w3) + (size_t)l * 64 * 64; const float* b3 = PRM(p, f_b3) + (size_t)l * 64;
    const float* w4 = PRM(p, f_w4) + (size_t)l * 64 * 1024; const float* fq = PRM(p, f_freq) + (size_t)l * 64;
    float* kt = (float*)(p.ws + OFF_KT);
    for (int i = tid; i < 33 * 64; i += 512) w1s[i] = w1[i];
    for (int i = tid; i < 64 * 64; i += 512) { w2s[i] = w2[i]; w3s[i] = w3[i]; }
    const int j = tid & 63;
    const float fqj = fq[j], b1j = b1[j], b2j = b2[j], b3j = b3[j];
    __syncthreads();
    const int nitems = (L_BIG + L_SML) / 16;
    for (int it = blockIdx.x; it < nitems; it += gridDim.x) {
        const bool big = it < L_BIG / 16; const int L = big ? L_BIG : L_SML; const int pos0 = (big ? it : it - L_BIG / 16) * 16;
        float* ktc = kt + (big ? 0 : (size_t)512 * 2 * L_BIG);
        for (int idx = tid; idx < 16 * 33; idx += 512) {
            const int pp = idx / 33, f = idx % 33; const int pos = pos0 + pp;
            const float tt = (float)pos / (float)(L - 1), ang = (6.283185307179586f / (float)L) * (float)pos;
            float v;
            if (f == 0) v = tt;
            else { const int bi = (f - 1) & 15; const float band = 1e-4f + (float)bi * ((15.0f - 1e-4f) / 15.0f); v = f <= 16 ? cosf(band * ang) : -sinf(band * ang); }
            feats[pp * 36 + f] = v;
        }
        __syncthreads();
#pragma unroll
        for (int h2 = 0; h2 < 2; ++h2) { const int pp = (tid >> 6) + 8 * h2; float a = b1j;
            for (int f = 0; f < 33; ++f) a += feats[pp * 36 + f] * w1s[f * 64 + j];
            ha[pp * 64 + j] = __sinf(fqj * a); }
        __syncthreads();
#pragma unroll
        for (int h2 = 0; h2 < 2; ++h2) { const int pp = (tid >> 6) + 8 * h2; float a = b2j;
#pragma unroll 4
            for (int f4 = 0; f4 < 16; ++f4) { const nf4 hv = *(const LAS nf4*)(ha + pp * 64 + 4 * f4);
                a += hv.x * w2s[(4 * f4) * 64 + j] + hv.y * w2s[(4 * f4 + 1) * 64 + j] + hv.z * w2s[(4 * f4 + 2) * 64 + j] + hv.w * w2s[(4 * f4 + 3) * 64 + j]; }
            hb[pp * 64 + j] = __sinf(fqj * a); }
        __syncthreads();
#pragma unroll
        for (int h2 = 0; h2 < 2; ++h2) { const int pp = (tid >> 6) + 8 * h2; float a = b3j;
#pragma unroll 4
            for (int f4 = 0; f4 < 16; ++f4) { const nf4 hv = *(const LAS nf4*)(hb + pp * 64 + 4 * f4);
                a += hv.x * w3s[(4 * f4) * 64 + j] + hv.y * w3s[(4 * f4 + 1) * 64 + j] + hv.z * w3s[(4 * f4 + 2) * 64 + j] + hv.w * w3s[(4 * f4 + 3) * 64 + j]; }
            ha[pp * 64 + j] = __sinf(fqj * a); }
        __syncthreads();
        {
            float acc0[16], acc1[16];
#pragma unroll
            for (int pp = 0; pp < 16; ++pp) { acc0[pp] = 0.f; acc1[pp] = 0.f; }
            const float* w4p = w4 + 2 * tid;
#pragma unroll 2
            for (int f4 = 0; f4 < 16; ++f4) {
                const cf2 wa = *(const cf2*)(w4p + (4 * f4) * 1024), wb = *(const cf2*)(w4p + (4 * f4 + 1) * 1024), wc = *(const cf2*)(w4p + (4 * f4 + 2) * 1024), wd = *(const cf2*)(w4p + (4 * f4 + 3) * 1024);
#pragma unroll
                for (int pp = 0; pp < 16; ++pp) { const nf4 hv = *(const LAS nf4*)(ha + pp * 64 + 4 * f4);
                    acc0[pp] += hv.x * wa.x + hv.y * wb.x + hv.z * wc.x + hv.w * wd.x;
                    acc1[pp] += hv.x * wa.y + hv.y * wb.y + hv.z * wc.y + hv.w * wd.y; }
            }
            const int o = 2 * tid, dir = o >> 9, c = o & 511;
            const float dstep = (15.350567286626972f - 3.0701134573253945f) / 511.0f;
            const float d0 = 3.0701134573253945f + (float)c * dstep, d1 = d0 + dstep;
            float* dst0 = ktc + (size_t)(c * 2 + dir) * L + pos0; float* dst1 = dst0 + 2 * (size_t)L;
            const float invl = 1.0f / (float)(L - 1);
#pragma unroll
            for (int g = 0; g < 4; ++g) { nf4 v0, v1;
#pragma unroll
                for (int i = 0; i < 4; ++i) { const float tt = (float)(pos0 + 4 * g + i) * invl; v0[i] = acc0[4 * g + i] * __expf(-tt * d0); v1[i] = acc1[4 * g + i] * __expf(-tt * d1); }
                *(nf4*)(dst0 + 4 * g) = v0; *(nf4*)(dst1 + 4 * g) = v1; }
        }
        __syncthreads();
    }
}
__device__ void ph_hy_prep(const P& p, int l, LAS unsigned char* lds) {
    LAS float* tx = (LAS float*)lds;
    LAS float* tz = tx + 64 * 65;
    const bf16_t* hy = (const bf16_t*)(p.ws + OFF_HYRAW);
    bf16_t* x0t = (bf16_t*)(p.ws + OFF_X0T); bf16_t* zt = (bf16_t*)(p.ws + OFF_ZT);
    const float* cw = PRM(p, hy_conv_w) + (size_t)l * 3 * 1536; const float* cb = PRM(p, hy_conv_b) + (size_t)l * 1536;
    const int tid = TIDX, nitems = (T_TOK / 64) * 8;
    for (int it = blockIdx.x; it < nitems; it += gridDim.x) {
        const int t0 = (it >> 3) * 64, c0 = (it & 7) * 64, c = tid & 63;
        float wv[3][3], bv[3];
#pragma unroll
        for (int a = 0; a < 3; ++a) { bv[a] = cb[a * 512 + c0 + c];
#pragma unroll
            for (int k = 0; k < 3; ++k) wv[a][k] = cw[k * 1536 + a * 512 + c0 + c]; }
#pragma unroll
        for (int i = 0; i < 8; ++i) {
            const int tt = (tid >> 6) + 8 * i, t = t0 + tt;
            const bool hp = !seq_start(t), hn = !seq_end(t);
            float r[3];
#pragma unroll
            for (int a = 0; a < 3; ++a) {
                const bf16_t* col = hy + (size_t)t * 1536 + a * 512 + c0 + c;
                const float xm = hp ? bf2f(col[-1536]) : 0.f, x0 = bf2f(col[0]), xp = hn ? bf2f(col[1536]) : 0.f;
                r[a] = xm * wv[a][0] + x0 * wv[a][1] + xp * wv[a][2] + bv[a];
            }
            tx[c * 65 + tt] = r[0]; tz[c * 65 + tt] = r[1] * r[2];
        }
        __syncthreads();
#pragma unroll
        for (int i = 0; i < 8; ++i) { const int cc = (tid >> 6) + 8 * i, tt = tid & 63;
            x0t[(size_t)(c0 + cc) * T_TOK + t0 + tt] = f2bf(tx[cc * 65 + tt]); zt[(size_t)(c0 + cc) * T_TOK + t0 + tt] = f2bf(tz[cc * 65 + tt]); }
        __syncthreads();
    }
}
__device__ __forceinline__ cf2 ld_f2_agent(const cf2* ptr) {
    const unsigned long long w = __hip_atomic_load((const unsigned long long*)ptr, __ATOMIC_RELAXED, __HIP_MEMORY_SCOPE_AGENT);
    return mkf2(__uint_as_float((unsigned)w), __uint_as_float((unsigned)(w >> 32)));
}
DEV_FN void spec_mul_g(LDS_F2 X, int S, const cf2* Ks);
__device__ void ph_hy_fft(const P& p, int l, LAS unsigned char* lds) {
    LAS cf2* X = (LAS cf2*)lds;
    const int tid = TIDX;
    cf2* Ks = (cf2*)(p.ws + OFF_KS) + (size_t)blockIdx.x * L_BIG;
    const float* kt = (const float*)(p.ws + OFF_KT);
    const bf16_t* x0t = (const bf16_t*)(p.ws + OFF_X0T); bf16_t* zt = (bf16_t*)(p.ws + OFF_ZT);
    for (int job = blockIdx.x; job < 1024; job += gridDim.x) {
        const bool big = job < 512; const int c = job & 511;
        const int L = big ? L_BIG : L_SML, S = big ? 7 : 6, M = L;
        const float* hf = kt + (big ? 0 : (size_t)512 * 2 * L_BIG) + (size_t)(c * 2) * L; const float* hb = hf + L;
        for (int m = tid; m < M; m += 512) {
            const int n0 = 2 * m, n1 = 2 * m + 1;
            const float a = n0 < L ? hf[n0] : (n0 == L ? 0.f : hb[2 * L - n0]);
            const float b = n1 < L ? hf[n1] : hb[2 * L - n1];
            X[m] = mkf2(a, b);
        }
        __syncthreads();
        fft_fwd(X, S, 0);
        spec_store(X, S, Ks);
        __threadfence(); __syncthreads();
        const float skip = PRM(p, hy_skip)[(size_t)l * D_HY + c];
        const int nseq = big ? 1 : 4;
        for (int sq = 0; sq < nseq; ++sq) {
            const int t0 = big ? 0 : L_BIG + sq * L_SML;
            const bf16_t* zrow = zt + (size_t)c * T_TOK + t0; const bf16_t* xrow = x0t + (size_t)c * T_TOK + t0;
            for (int m = tid; m < M; m += 512) {
                cf2 v = mkf2(0.f, 0.f);
                if (m < (M >> 1)) { const unsigned w = *(const unsigned*)(zrow + 2 * m); v.x = __uint_as_float(w << 16); v.y = __uint_as_float(w & 0xffff0000u); }
                X[m] = v;
            }
            __syncthreads();
            fft_fwd(X, S, 0);
            spec_mul_g(X, S, Ks);
            fft_inv(X, S);
            const float inv = 1.0f / (float)M;
            bf16_t* orow = zt + (size_t)c * T_TOK + t0;
            for (int m = tid; m < (M >> 1); m += 512) {
                const cf2 d = X[m];
                const unsigned wz = *(const unsigned*)(zrow + 2 * m), wx = *(const unsigned*)(xrow + 2 * m);
                const float z0 = __uint_as_float(wz << 16), z1 = __uint_as_float(wz & 0xffff0000u), a0 = __uint_as_float(wx << 16), a1 = __uint_as_float(wx & 0xffff0000u);
                *(unsigned*)(orow + 2 * m) = pack_bf2(a0 * (d.x * inv + skip * z0), a1 * (d.y * inv + skip * z1));
            }
            __syncthreads();
        }
    }
}
DEV_FN void spec_mul_g(LDS_F2 X, int S, const cf2* Ks) {
    const int M = 1 << (2 * S);
    for (int k = TIDX; k <= (M >> 1); k += NTHR) {
        if (k == 0) {
            const cf2 c0 = X[0], k0 = ld_f2_agent(Ks);
            const float y0 = (c0.x + c0.y) * k0.x, ym = (c0.x - c0.y) * k0.y;
            X[0] = mkf2(0.5f * (y0 + ym), 0.5f * (y0 - ym));
        } else {
            const unsigned pk = rev4((unsigned)k, S), pm = rev4((unsigned)(M - k), S);
            const cf2 ck = X[pk], cm = X[pm];
            const cf2 Pv = mkf2(0.5f * (ck.x + cm.x), 0.5f * (ck.y - cm.y));
            const cf2 O = mkf2(0.5f * (ck.y + cm.y), -0.5f * (ck.x - cm.x));
            float c, s; CIS_REV((float)k / (float)(2 * M), c, s);
            const cf2 Wk = mkf2(c, -s);
            const cf2 Q = cmul(O, Wk);
            const cf2 xk = mkf2(Pv.x + Q.x, Pv.y + Q.y), xm = mkf2(Pv.x - Q.x, -(Pv.y - Q.y));
            const cf2 yk = cmul(xk, ld_f2_agent(Ks + k)), ym = cmul(xm, ld_f2_agent(Ks + (M - k)));
            const cf2 Ye = mkf2(0.5f * (yk.x + ym.x), 0.5f * (yk.y - ym.y));
            const cf2 Yd = mkf2(0.5f * (yk.x - ym.x), 0.5f * (yk.y + ym.y));
            const cf2 Yo = cmulc(Yd, Wk);
            X[pk] = mkf2(Ye.x - Yo.y, Ye.y + Yo.x);
            if (k != (M >> 1)) X[pm] = mkf2(Ye.x + Yo.y, -Ye.y + Yo.x);
        }
    }
    __syncthreads();
}
__device__ void ph_hy_norm(const P& p, int l, LAS unsigned char* lds) {
    LAS float* tl = (LAS float*)lds;
    LAS float* red = tl + 64 * 65;
    const bf16_t* yh = (const bf16_t*)(p.ws + OFF_ZT);
    const float* gain = PRM(p, hy_out_norm) + (size_t)l * D_HY;
    const int tid = TIDX, nitems = (T_TOK / 64) * 8;
    for (int it = blockIdx.x; it < nitems; it += gridDim.x) {
        const int t0 = (it >> 3) * 64, c0 = (it & 7) * 64;
#pragma unroll
        for (int i = 0; i < 8; ++i) { const int cc = (tid >> 6) + 8 * i, tt = tid & 63; tl[cc * 65 + tt] = bf2f(yh[(size_t)(c0 + cc) * T_TOK + t0 + tt]); }
        __syncthreads();
        { const int tt = tid & 63, part = tid >> 6; float s = 0.f;
#pragma unroll
          for (int j = 0; j < 8; ++j) { const float v = tl[(part * 8 + j) * 65 + tt]; s += v * v; }
          red[part * 64 + tt] = s; }
        __syncthreads();
#pragma unroll
        for (int i = 0; i < 8; ++i) { const int tt = (tid >> 6) + 8 * i, cc = tid & 63;
            float s = 0.f;
#pragma unroll
            for (int j = 0; j < 8; ++j) s += red[j * 64 + tt];
            const float r = rsqrtf(s * (1.0f / 64.0f) + 1e-6f);
            abuf_row(p, t0 + tt)[c0 + cc] = f2bf(tl[cc * 65 + tt] * r * gain[c0 + cc]); }
        __syncthreads();
    }
}
typedef short hbf16x8 __attribute__((ext_vector_type(8)));
typedef float hf32x16 __attribute__((ext_vector_type(16)));
constexpr int HSC = 512, HNCH = HSC / 64, HNSC = T_TOK / HSC;
constexpr int QS = 136, KS_ = 72;
constexpr int HL_QH = 0, HL_KH = HL_QH + 64 * QS * 2, HL_QT = HL_KH + 64 * QS * 2, HL_KT = HL_QT + 64 * QS * 2, HL_VT = HL_KT + 128 * KS_ * 2, HL_ST = HL_VT + 128 * KS_ * 2,
              HL_PM = HL_ST + 128 * QS * 2, HL_TOT = HL_PM + 64 * KS_ * 2, HL_EB = HL_TOT + 4 * 128 * 4, HL_END = HL_EB + 128 * 4;
constexpr int HL_OF = HL_QH, OFS = 132;
static_assert(64 * OFS * 4 <= 2 * 64 * QS * 2, "O tile must fit over Qh|Kh");
constexpr size_t OFF_HST = OFF_R6 + 32 * MiB;
constexpr size_t OFF_HAT = OFF_SMALL + 64 * 1024;

__device__ __forceinline__ hf32x16 mfma32(hbf16x8 a, hbf16x8 b, hf32x16 c) { return __builtin_amdgcn_mfma_f32_32x32x16_bf16(a, b, c, 0, 0, 0); }
__device__ __forceinline__ hbf16x8 lds_frag(const LAS unsigned char* base, int row, int stride_el, int col_el) { return *(const LAS hbf16x8*)(base + ((size_t)row * stride_el + col_el) * 2); }

typedef unsigned hu32x4 __attribute__((ext_vector_type(4)));
struct HgPre { hu32x4 f0, f1, v0, v1, q0, q1; };
template <bool FULL>
__device__ __forceinline__ void hg_fetch(const bf16_t* hg, HgPre& pre, int tokbase, int dirsign, int h, int dir) {
    const int tid = TIDX;
    { const int u = tid >> 4, seg = tid & 15;
      const bf16_t* row = hg + (size_t)(tokbase + dirsign * u) * 2560 + h * 128 + seg * 8;
      pre.f0 = *(const hu32x4*)(row + 512 + 512 * dir); pre.v0 = *(const hu32x4*)(row + 1536); if (FULL) pre.q0 = *(const hu32x4*)(row);
      const bf16_t* row1 = row + (size_t)dirsign * 32 * 2560;
      pre.f1 = *(const hu32x4*)(row1 + 512 + 512 * dir); pre.v1 = *(const hu32x4*)(row1 + 1536); if (FULL) pre.q1 = *(const hu32x4*)(row1); }
}
template <bool FULL>
__device__ __forceinline__ void hg_prep(LAS unsigned char* lds, const HgPre& pre, float lb, float& Bsum_out) {
    const int tid = TIDX, d = tid & 127, qt = tid >> 7;
    LAS float* tot = (LAS float*)(lds + HL_TOT); LAS float* eB = (LAS float*)(lds + HL_EB);
    { const int u = tid >> 4, seg = tid & 15;
      *(LAS hu32x4*)(lds + HL_KH + ((size_t)u * QS + seg * 8) * 2) = pre.f0; *(LAS hu32x4*)(lds + HL_KH + ((size_t)(u + 32) * QS + seg * 8) * 2) = pre.f1;
      *(LAS hu32x4*)(lds + HL_QH + ((size_t)u * QS + seg * 8) * 2) = pre.v0; *(LAS hu32x4*)(lds + HL_QH + ((size_t)(u + 32) * QS + seg * 8) * 2) = pre.v1;
      if (FULL) { *(LAS hu32x4*)(lds + HL_QT + ((size_t)u * QS + seg * 8) * 2) = pre.q0; *(LAS hu32x4*)(lds + HL_QT + ((size_t)(u + 32) * QS + seg * 8) * 2) = pre.q1; } }
    __syncthreads();
    float run = 0.f;
#pragma unroll 4
    for (int j = 0; j < 16; ++j) {
        const int u = qt * 16 + j;
        float z = bf2f(*(const LAS bf16_t*)(lds + HL_KH + ((size_t)u * QS + d) * 2));
        z = fmaxf(z, -60.0f);
        const float f = lb + (1.0f - lb) / (1.0f + __expf(-z));
        run += __logf(f);
    }
    tot[qt * 128 + d] = run;
    __syncthreads();
    const float t0 = tot[d], t1 = tot[128 + d], t2 = tot[256 + d], t3 = tot[384 + d];
    const float off = qt == 0 ? 0.f : (qt == 1 ? t0 : (qt == 2 ? t0 + t1 : t0 + t1 + t2));
    const float r = t0 + t1, B = t0 + t1 + t2 + t3;
    const float eBr = __expf(B - r);
    if (qt == 0) eB[d] = __expf(B);
    Bsum_out = B;
    float b = off;
#pragma unroll 2
    for (int jj = 0; jj < 8; ++jj) {
        unsigned pkt = 0, pvt = 0;
#pragma unroll
        for (int q2 = 0; q2 < 2; ++q2) {
            const int u = qt * 16 + jj * 2 + q2;
            float z = bf2f(*(const LAS bf16_t*)(lds + HL_KH + ((size_t)u * QS + d) * 2));
            z = fmaxf(z, -60.0f);
            const float f = lb + (1.0f - lb) / (1.0f + __expf(-z));
            b += __logf(f);
            const float kh = (1.0f - f) * __expf(r - b);
            const bf16_t vraw = *(const LAS bf16_t*)(lds + HL_QH + ((size_t)u * QS + d) * 2);
            pkt |= (unsigned)f2bf(kh * eBr) << (16 * q2); pvt |= (unsigned)vraw << (16 * q2);
            if (FULL) {
                const float q = silu_f(bf2f(*(const LAS bf16_t*)(lds + HL_QT + ((size_t)u * QS + d) * 2)));
                const float E = __expf(b);
                *(LAS bf16_t*)(lds + HL_QT + ((size_t)u * QS + d) * 2) = f2bf(q * E);
                *(LAS bf16_t*)(lds + HL_QH + ((size_t)u * QS + d) * 2) = f2bf(q * __expf(b - r));
                *(LAS bf16_t*)(lds + HL_KH + ((size_t)u * QS + d) * 2) = f2bf(kh);
            }
        }
        *(LAS unsigned*)(lds + HL_KT + ((size_t)d * KS_ + qt * 16 + jj * 2) * 2) = pkt;
        *(LAS unsigned*)(lds + HL_VT + ((size_t)d * KS_ + qt * 16 + jj * 2) * 2) = pvt;
    }
    __syncthreads();
}
__device__ __forceinline__ void hg_state_update(LAS unsigned char* lds, hf32x16 (&S)[2], int w, int lane) {
    const int en = w & 3, r = lane & 31, hh = lane >> 5;
    const LAS float* eB = (const LAS float*)(lds + HL_EB);
#pragma unroll
    for (int i = 0; i < 2; ++i) {
        const int dm = (w >> 2) * 2 + i;
#pragma unroll
        for (int g = 0; g < 4; ++g) { const nf4 sc = *(const LAS nf4*)(eB + 32 * dm + 8 * g + 4 * hh);
            S[i][4 * g + 0] *= sc.x; S[i][4 * g + 1] *= sc.y; S[i][4 * g + 2] *= sc.z; S[i][4 * g + 3] *= sc.w; }
#pragma unroll
        for (int ks = 0; ks < 4; ++ks) {
            const hbf16x8 a = lds_frag(lds + HL_KT, 32 * dm + r, KS_, 16 * ks + 8 * hh);
            const hbf16x8 b = lds_frag(lds + HL_VT, 32 * en + r, KS_, 16 * ks + 8 * hh);
            S[i] = mfma32(a, b, S[i]);
        }
    }
}
__device__ __forceinline__ int hg_unit_base(int sc) { return sc * HSC; }
__device__ void ph_hg_pass1(const P& p, int l, LAS unsigned char* lds) {
    const bf16_t* hg = (const bf16_t*)(p.ws + OFF_HG);
    const float* lbs = (const float*)(p.ws + OFF_SMALL);
    float* ust = (float*)(p.ws + OFF_HST); float* atot = (float*)(p.ws + OFF_HAT);
    const int tid = TIDX, w = tid >> 6, lane = tid & 63;
    for (int unit = blockIdx.x; unit < HNSC * 8; unit += gridDim.x) {
        const int sc = unit >> 3, h = (unit >> 1) & 3, dir = unit & 1;
        const float lb = lbs[(size_t)(dir * NLAYER + l) * D_HG + h * 128 + (tid & 127)];
        hf32x16 S[2];
#pragma unroll
        for (int i = 0; i < 2; ++i)
#pragma unroll
            for (int k = 0; k < 16; ++k) S[i][k] = 0.f;
        float Btot = 0.f;
        const int dsg = dir ? -1 : 1, tb0 = dir ? hg_unit_base(sc) + HSC - 1 : hg_unit_base(sc);
        HgPre pre;
        hg_fetch<false>(hg, pre, tb0, dsg, h, dir);
        for (int ci = 0; ci < HNCH; ++ci) {
            float B;
            hg_prep<false>(lds, pre, lb, B);
            if (ci + 1 < HNCH) hg_fetch<false>(hg, pre, tb0 + dsg * (ci + 1) * 64, dsg, h, dir);
            Btot += B;
            hg_state_update(lds, S, w, lane);
            __syncthreads();
        }
        float* U = ust + (size_t)unit * 16384;
        int r = lane & 31, hh = lane >> 5; asm volatile("" : "+v"(r), "+v"(hh));
        const int en = w & 3;
#pragma unroll
        for (int i = 0; i < 2; ++i) { const int dm = (w >> 2) * 2 + i;
#pragma unroll
            for (int k = 0; k < 16; ++k) U[(32 * dm + (k & 3) + 8 * (k >> 2) + 4 * hh) * 128 + 32 * en + r] = S[i][k]; }
        if (tid < 128) atot[(size_t)unit * 128 + tid] = __expf(Btot);
    }
}
__device__ void ph_hg_pass2(const P& p) {
    float* ust = (float*)(p.ws + OFF_HST); const float* atot = (const float*)(p.ws + OFF_HAT);
    const int total = 5 * 8 * 16384;
    for (int idx = blockIdx.x * 512 + TIDX; idx < total; idx += gridDim.x * 512) {
        const int el = idx & 16383, hd = (idx >> 14) & 7, sq = idx >> 17;
        const int sc0 = sq == 0 ? 0 : 32 + 8 * (sq - 1), nsc = sq == 0 ? 32 : 8, dir = hd & 1, d = el >> 7;
        float carry = 0.f;
        for (int j = 0; j < nsc; ++j) {
            const int sc = dir ? sc0 + nsc - 1 - j : sc0 + j;
            const size_t unit = (size_t)sc * 8 + hd;
            const float u = ust[unit * 16384 + el], a = atot[unit * 128 + d];
            ust[unit * 16384 + el] = carry;
            carry = a * carry + u;
        }
    }
}
__device__ void ph_hg_pass3(const P& p, int l, LAS unsigned char* lds) {
    const bf16_t* hg = (const bf16_t*)(p.ws + OFF_HG);
    const float* lbs = (const float*)(p.ws + OFF_SMALL);
    const float* ust = (const float*)(p.ws + OFF_HST);
    const float* gain = PRM(p, hg_out_norm) + (size_t)l * D_HG;
    const int tid = TIDX, w = tid >> 6, lane = tid & 63, r = lane & 31, hh = lane >> 5;
    for (int unit = blockIdx.x; unit < HNSC * 4; unit += gridDim.x) {
        const int sc = unit >> 2, h = unit & 3;
        for (int dir = 0; dir < 2; ++dir) {
            const float lb = lbs[(size_t)(dir * NLAYER + l) * D_HG + h * 128 + (tid & 127)];
            const float* S0 = ust + ((size_t)sc * 8 + h * 2 + dir) * 16384;
            hf32x16 S[2];
            { const int en = w & 3;
              int r_ = r, hh_ = hh; asm volatile("" : "+v"(r_), "+v"(hh_));
              const float* S0l = S0 + (4 * hh_) * 128 + 32 * en + r_;
#pragma unroll
              for (int i = 0; i < 2; ++i) { const int dm = (w >> 2) * 2 + i;
#pragma unroll
                  for (int k = 0; k < 16; ++k) S[i][k] = S0l[(32 * dm + (k & 3) + 8 * (k >> 2)) * 128];
#pragma unroll
                  for (int g = 0; g < 4; ++g) { nu2 wv; wv.x = pack_bf2(S[i][4 * g], S[i][4 * g + 1]); wv.y = pack_bf2(S[i][4 * g + 2], S[i][4 * g + 3]);
                      *(LAS nu2*)(lds + HL_ST + ((size_t)(32 * en + r) * QS + 32 * dm + 8 * g + 4 * hh) * 2) = wv; } } }
            const int dsg = dir ? -1 : 1, tb0 = dir ? hg_unit_base(sc) + HSC - 1 : hg_unit_base(sc);
            HgPre pre;
            hg_fetch<true>(hg, pre, tb0, dsg, h, dir);
            for (int ci = 0; ci < HNCH; ++ci) {
                const int tokbase = tb0 + dsg * ci * 64;
                float Bdummy;
                hg_prep<true>(lds, pre, lb, Bdummy);
                if (ci + 1 < HNCH) hg_fetch<true>(hg, pre, tb0 + dsg * (ci + 1) * 64, dsg, h, dir);
                if (w < 4) {
                    const int tm = (w == 0 || w == 3) ? 0 : 1, sn = (w == 2 || w == 3) ? 1 : 0;
                    hf32x16 acc;
#pragma unroll
                    for (int k = 0; k < 16; ++k) acc[k] = 0.f;
                    if (w < 3) {
#pragma unroll
                        for (int ks = 0; ks < 8; ++ks) acc = mfma32(lds_frag(lds + HL_QH, 32 * tm + r, QS, 16 * ks + 8 * hh), lds_frag(lds + HL_KH, 32 * sn + r, QS, 16 * ks + 8 * hh), acc);
                    }
                    const int s_ = 32 * sn + r;
#pragma unroll
                    for (int k = 0; k < 16; ++k) { const int t_ = 32 * tm + (k & 3) + 8 * (k >> 2) + 4 * hh;
                        const float v = (w < 3 && s_ <= t_) ? acc[k] : 0.f;
                        *(LAS bf16_t*)(lds + HL_PM + ((size_t)t_ * KS_ + s_) * 2) = f2bf(v); }
                }
                __syncthreads();
                hf32x16 o;
                { const int tm = w >> 2, en = w & 3;
#pragma unroll
                  for (int k = 0; k < 16; ++k) o[k] = 0.f;
#pragma unroll
                  for (int ks = 0; ks < 4; ++ks) o = mfma32(lds_frag(lds + HL_PM, 32 * tm + r, KS_, 16 * ks + 8 * hh), lds_frag(lds + HL_VT, 32 * en + r, KS_, 16 * ks + 8 * hh), o);
#pragma unroll
                  for (int ks = 0; ks < 8; ++ks) o = mfma32(lds_frag(lds + HL_QT, 32 * tm + r, QS, 16 * ks + 8 * hh), lds_frag(lds + HL_ST, 32 * en + r, QS, 16 * ks + 8 * hh), o);
                }
                __syncthreads();
                { const int tm = w >> 2, en = w & 3; LAS float* Of = (LAS float*)(lds + HL_OF);
#pragma unroll
                  for (int k = 0; k < 16; ++k) Of[(size_t)(32 * tm + (k & 3) + 8 * (k >> 2) + 4 * hh) * OFS + 32 * en + r] = o[k]; }
                hg_state_update(lds, S, w, lane);
                { const int en = w & 3;
#pragma unroll
                  for (int i = 0; i < 2; ++i) { const int dm = (w >> 2) * 2 + i;
#pragma unroll
                      for (int g = 0; g < 4; ++g) { nu2 wv; wv.x = pack_bf2(S[i][4 * g], S[i][4 * g + 1]); wv.y = pack_bf2(S[i][4 * g + 2], S[i][4 * g + 3]);
                          *(LAS nu2*)(lds + HL_ST + ((size_t)(32 * en + r) * QS + 32 * dm + 8 * g + 4 * hh) * 2) = wv; } } }
                __syncthreads();
                { const int u = tid >> 3, e0 = (tid & 7) * 16, tok = tokbase + dsg * u;
                  const LAS float* Of = (const LAS float*)(lds + HL_OF) + (size_t)u * OFS + e0;
                  bf16_t* dst = abuf_row(p, tok) + 512 + h * 128 + e0;
                  float v[16];
#pragma unroll
                  for (int j = 0; j < 4; ++j) { const nf4 t4 = *(const LAS nf4*)(Of + 4 * j); v[4 * j] = t4.x; v[4 * j + 1] = t4.y; v[4 * j + 2] = t4.z; v[4 * j + 3] = t4.w; }
                  if (dir == 0) {
                      uint4 w0, w1;
                      w0.x = pack_bf2(v[0], v[1]); w0.y = pack_bf2(v[2], v[3]); w0.z = pack_bf2(v[4], v[5]); w0.w = pack_bf2(v[6], v[7]);
                      w1.x = pack_bf2(v[8], v[9]); w1.y = pack_bf2(v[10], v[11]); w1.z = pack_bf2(v[12], v[13]); w1.w = pack_bf2(v[14], v[15]);
                      ((uint4*)dst)[0] = w0; ((uint4*)dst)[1] = w1;
                  } else {
                      const uint4 f0 = ((const uint4*)dst)[0], f1 = ((const uint4*)dst)[1];
                      const unsigned fw[8] = {f0.x, f0.y, f0.z, f0.w, f1.x, f1.y, f1.z, f1.w};
                      float ss = 0.f;
#pragma unroll
                      for (int j = 0; j < 8; ++j) { v[2 * j] += __uint_as_float(fw[j] << 16); v[2 * j + 1] += __uint_as_float(fw[j] & 0xffff0000u); ss += v[2 * j] * v[2 * j] + v[2 * j + 1] * v[2 * j + 1]; }
                      ss += __shfl_xor(ss, 1); ss += __shfl_xor(ss, 2); ss += __shfl_xor(ss, 4);
                      const float rn = rsqrtf(ss * (1.0f / 128.0f) + 1e-6f);
                      const bf16_t* gp = hg + (size_t)tok * 2560 + 2048 + h * 128 + e0;
                      const uint4 g0 = ((const uint4*)gp)[0], g1 = ((const uint4*)gp)[1];
                      const unsigned gw[8] = {g0.x, g0.y, g0.z, g0.w, g1.x, g1.y, g1.z, g1.w};
                      unsigned ow[8];
#pragma unroll
                      for (int j = 0; j < 8; ++j) { const float ga = silu_f(__uint_as_float(gw[j] << 16)), gb = silu_f(__uint_as_float(gw[j] & 0xffff0000u));
                          ow[j] = pack_bf2(v[2 * j] * rn * gain[h * 128 + e0 + 2 * j] * ga, v[2 * j + 1] * rn * gain[h * 128 + e0 + 2 * j + 1] * gb); }
                      ((uint4*)dst)[0] = make_uint4(ow[0], ow[1], ow[2], ow[3]); ((uint4*)dst)[1] = make_uint4(ow[4], ow[5], ow[6], ow[7]);
                  }
                }
                __syncthreads();
            }
        }
    }
}
enum { PH_SETUP, PH_CONVERT, PH_RMS_IN, PH_GEMM_IN, PH_HY_PREP, PH_FILTER, PH_HGRN, PH_HG_NORM, PH_HY_FFT, PH_HY_NORM, PH_GEMM_OUT, PH_NR0, PH_GEMM_UP, PH_GEGLU, PH_GEMM_DN, PH_NR1, PH_HG_P1, PH_HG_P2, PH_HG_P3 };
template <int PH> __device__ __forceinline__ void run_phase(const P& p_in, int l, int part, LAS unsigned char* lds) {
    P p = p_in; asm volatile("" : "+s"(p.ws), "+s"(p.out));
    p.ws = (unsigned char*)(__attribute__((address_space(1))) unsigned char*)p.ws; p.out = (float*)(__attribute__((address_space(1))) float*)p.out;
    if constexpr (PH == PH_SETUP) { ph_setup(p); ph_copy_params(p); }
    if constexpr (PH == PH_CONVERT) ph_convert_w(p, l, lds);
    if constexpr (PH == PH_RMS_IN) ph_rmsnorm_in(p, l);
    if constexpr (PH == PH_GEMM_IN) { EpiBf16Split E; E.O0 = (bf16_t*)(p.ws + OFF_HYRAW); E.ldc0 = 1536; E.O1 = (bf16_t*)(p.ws + OFF_HG); E.ldc1 = 2560; E.csplit = 1536;
        run_gemm(lds, abuf_row(p, 0), (const bf16_t*)(p.ws + OFF_W_IN), T_TOK, D_IN, DM, E); }
    if constexpr (PH == PH_HY_PREP) ph_hy_prep(p, l, lds);
    if constexpr (PH == PH_FILTER) ph_filter(p, l, lds);
    if constexpr (PH == PH_HY_FFT) ph_hy_fft(p, l, lds);
    if constexpr (PH == PH_HY_NORM) ph_hy_norm(p, l, lds);
    if constexpr (PH == PH_GEMM_OUT) { EpiBf16Split E; E.O0 = (bf16_t*)(p.ws + OFF_MIX); E.ldc0 = DM; E.O1 = E.O0; E.ldc1 = DM; E.csplit = 1 << 30;
        run_gemm(lds, abuf_row(p, 0), (const bf16_t*)(p.ws + OFF_W_OUT), T_TOK, DM, DM, E); }
    if constexpr (PH == PH_NR0) ph_norm_resid(p, l, 0);
    if constexpr (PH == PH_GEMM_UP) { EpiGeglu E; E.act = (bf16_t*)(p.ws + OFF_ACT); E.cw = PRM(p, ffn_conv_w) + (size_t)l * 3 * 8192; E.cb = PRM(p, ffn_conv_b) + (size_t)l * 8192;
        run_gemm(lds, abuf_row(p, -1), (const bf16_t*)(p.ws + OFF_W_UP), 133 * 256, 2 * DFF, DM, E); }
    if constexpr (PH == PH_GEMM_DN) { EpiBf16Split E; E.O0 = (bf16_t*)(p.ws + OFF_MIX); E.ldc0 = DM; E.O1 = E.O0; E.ldc1 = DM; E.csplit = 1 << 30;
        run_gemm(lds, (const bf16_t*)(p.ws + OFF_ACT), (const bf16_t*)(p.ws + OFF_W_DN), T_TOK, DM, DFF, E); }
    if constexpr (PH == PH_NR1) ph_norm_resid(p, l, 1);
    if constexpr (PH == PH_HG_P1) ph_hg_pass1(p, l, lds);
    if constexpr (PH == PH_HG_P2) ph_hg_pass2(p);
    if constexpr (PH == PH_HG_P3) ph_hg_pass3(p, l, lds);
}
constexpr int LDS_BYTES = 139264;
__global__ __launch_bounds__(512, 2) void mega(P p) {
    extern __shared__ __attribute__((aligned(16))) unsigned char lds_g[];
    LAS unsigned char* lds = (LAS unsigned char*)lds_g;
    cg::grid_group grid = cg::this_grid();
    run_phase<PH_SETUP>(p, 0, 0, lds);
    run_phase<PH_CONVERT>(p, 0, 0, lds);
    run_phase<PH_RMS_IN>(p, 0, 0, lds);
    grid.sync();
#pragma unroll 1
    for (int l = 0; l < NLAYER; ++l) {
        run_phase<PH_GEMM_IN>(p, l, 0, lds); grid.sync();
        run_phase<PH_HY_PREP>(p, l, 0, lds); run_phase<PH_HG_P1>(p, l, 0, lds); grid.sync();
        run_phase<PH_FILTER>(p, l, 0, lds); run_phase<PH_HG_P2>(p, l, 0, lds); grid.sync();
        run_phase<PH_HG_P3>(p, l, 0, lds); run_phase<PH_HY_FFT>(p, l, 0, lds); grid.sync();
        run_phase<PH_HY_NORM>(p, l, 0, lds); grid.sync();
        run_phase<PH_GEMM_OUT>(p, l, 0, lds); grid.sync();
        run_phase<PH_NR0>(p, l, 0, lds); grid.sync();
        run_phase<PH_GEMM_UP>(p, l, 0, lds); grid.sync();
        run_phase<PH_GEMM_DN>(p, l, 0, lds); grid.sync();
        run_phase<PH_NR1>(p, l, 0, lds);
        if (l + 1 < NLAYER) { run_phase<PH_CONVERT>(p, l + 1, 0, lds); grid.sync(); }
    }
}
extern "C" void kernel_launch(void* const* d_in, const int* in_sizes, int n_in, void* d_out, int out_size, void* d_ws, size_t ws_size, hipStream_t stream) {
    if (ws_size < WS_NEED) { fprintf(stderr, "workspace too small: %zu < %zu\n", ws_size, (size_t)WS_NEED); return; }
    static int grid_blocks = 0;
    if (!grid_blocks) {
        hipFuncSetAttribute((const void*)mega, hipFuncAttributeMaxDynamicSharedMemorySize, LDS_BYTES);
        int dev = 0, cus = 0, per_cu = 0;
        hipGetDevice(&dev);
        hipDeviceGetAttribute(&cus, hipDeviceAttributeMultiprocessorCount, dev);
        hipOccupancyMaxActiveBlocksPerMultiprocessor(&per_cu, mega, 512, LDS_BYTES);
        if (per_cu > 1) per_cu = 1;
        grid_blocks = cus * per_cu;
    }
    P p{};
    for (int i = 0; i < 26; ++i) p.in[i] = (const float*)d_in[i];
    p.out = (float*)d_out; p.ws = (unsigned char*)d_ws;
    void* args[] = {&p};
    hipError_t e = hipLaunchCooperativeKernel((void*)mega, dim3(grid_blocks), dim3(512), args, LDS_BYTES, stream);
    if (e != hipSuccess) fprintf(stderr, "cooperative launch failed: %s (grid %d)\n", hipGetErrorString(e), grid_blocks);
}
```

```cpp
#include <hip/hip_runtime.h>
#include <hip/hip_cooperative_groups.h>
#include <cstdio>
#include <cstdint>
namespace cg = cooperative_groups;
__device__ __forceinline__ int tid_opaque() { int t = (int)threadIdx.x; asm volatile("" : "+v"(t)); return t; }
#define TIDX tid_opaque()
#define LAS __attribute__((address_space(3)))
typedef float cf2 __attribute__((ext_vector_type(2)));
typedef float nf4 __attribute__((ext_vector_type(4)));
typedef unsigned nu2 __attribute__((ext_vector_type(2)));
typedef unsigned nu4 __attribute__((ext_vector_type(4)));
namespace pg8 {
#define PG8_LAS __attribute__((address_space(3)))
typedef unsigned short bf16_t;
typedef short bf16x8 __attribute__((ext_vector_type(8)));
typedef float f32x4 __attribute__((ext_vector_type(4)));
typedef unsigned u32x4 __attribute__((ext_vector_type(4)));
constexpr int BM = 256, BK = 64, HALF = 128, HTB = HALF * BK * 2  , STAGE_BYTES = 8 * HTB, NXCD = 8, WGM = 8;

__host__ __device__ __forceinline__ int lds_byte(int r, int c) { const int st = (r >> 4) * 2 + (c >> 5), rr = r & 15, cc = c & 31, ob = rr * 64 + cc * 2; return st * 1024 + (ob ^ (((ob >> 9) & 1) << 5)); }
__host__ __device__ __forceinline__ void stage_rc(int b, int& R, int& C) { const int st = b / 1024, sb = b % 1024, swz = sb ^ (((sb >> 9) & 1) << 5); R = (st >> 1) * 16 + swz / 64; C = (st & 1) * 32 + (swz % 64) / 2; }
__host__ __device__ __forceinline__ int perm32(int rho) { const int n = rho >> 4, i = rho & 15; return 8 * (i >> 2) + 4 * n + (i & 3); }

struct Unit { int pm, pn; };
struct Gemm { const bf16_t* A; const bf16_t* Bt; int M, N, K; int ovl; };

struct StaticOrder {
    int nM, nN, nwg, G, c;
    __host__ __device__ void init(int M, int N, int G_, int c_) { nM = M / BM; nN = N / BM; nwg = nM * nN; G = G_; c = c_; }
    __host__ __device__ bool next(int i, Unit& u) const {
        const long L = (long)i * G + c; if (L >= nwg) return false;
        int wgid = (int)L; { const int q = nwg / NXCD, r = nwg % NXCD, xcd = wgid % NXCD, off = wgid / NXCD; wgid = (xcd < r ? xcd * (q + 1) : r * (q + 1) + (xcd - r) * q) + off; }
        const int nig = WGM * nN, gid = wgid / nig, fm = gid * WGM, gsz = (nM - fm) < WGM ? (nM - fm) : WGM;
        u.pm = fm + ((wgid % nig) % gsz); u.pn = (wgid % nig) / gsz; return true;
    }
    __device__ __forceinline__ void a_ready(const Unit&) const {}
    __device__ __forceinline__ void done(const Unit&) const {}
};
struct CountedOrder : StaticOrder {
    const unsigned* ready; unsigned need; unsigned* tmo;
    __device__ __forceinline__ void a_ready(const Unit& u) const {
        if (TIDX < 64) {
            const unsigned long long t0 = __builtin_amdgcn_s_memrealtime(); unsigned polls = 0;
            while ((unsigned)__builtin_amdgcn_readfirstlane(__hip_atomic_load(ready + 64 * u.pm, __ATOMIC_RELAXED, __HIP_MEMORY_SCOPE_AGENT)) < need) {
                if ((++polls & 255u) == 0u && __builtin_amdgcn_readfirstlane(__hip_atomic_load(tmo, __ATOMIC_RELAXED, __HIP_MEMORY_SCOPE_AGENT)) != 0u) break;
                if (__builtin_amdgcn_s_memrealtime() - t0 > 2000000ull) {
                    if (TIDX == 0) { unsigned expect = 0u; __hip_atomic_compare_exchange_strong(tmo + 1, &expect, 0x600u | (unsigned)(u.pm & 0xff), __ATOMIC_RELAXED, __ATOMIC_RELAXED, __HIP_MEMORY_SCOPE_AGENT); __hip_atomic_store(tmo, 1u, __ATOMIC_RELAXED, __HIP_MEMORY_SCOPE_AGENT); }
                    break; }
                __builtin_amdgcn_s_sleep(2); }
            __builtin_amdgcn_fence(__ATOMIC_ACQUIRE, "agent");
            asm volatile("s_waitcnt vmcnt(0)" ::: "memory");
        }
#if !defined(BROKEN_HOOK_NO_BARRIER)
        asm volatile("" ::: "memory"); __builtin_amdgcn_s_barrier(); asm volatile("" ::: "memory");
#endif
    }
};

__device__ __forceinline__ unsigned cvt_pk_bf16(float lo, float hi) { unsigned r; asm volatile("v_cvt_pk_bf16_f32 %0, %1, %2" : "=v"(r) : "v"(lo), "v"(hi)); return r; }
typedef float f32x2 __attribute__((ext_vector_type(2)));
__device__ __forceinline__ f32x2 gelu_pk(f32x2 v) {
    const f32x2 av = __builtin_elementwise_abs(v), d = av * 0.2316418882f + 1.0f;
    f32x2 t; t.x = __builtin_amdgcn_rcpf(d.x); t.y = __builtin_amdgcn_rcpf(d.y);
    f32x2 q = t * 0.5307027145f + (-0.7265760135f); q = q * t + 0.7107068705f; q = q * t + (-0.142248368f); q = q * t + 0.127414796f; q = q * t;
    const f32x2 s = (v * v) * (-0.72134752044f);
    f32x2 e; e.x = __builtin_amdgcn_exp2f(s.x); e.y = __builtin_amdgcn_exp2f(s.y);
    const f32x2 m = v * (q * e), r = v - m;
    f32x2 o; o.x = v.x < 0.f ? m.x : r.x; o.y = v.y < 0.f ? m.y : r.y; return o;
}

struct EpiF32 {
    static constexpr bool PERM = false, AFTER_DRAIN = false;
    float* C; int ldc; const float* bias;
    __device__ __forceinline__ void operator()(const f32x4 (&acc)[2][2][4][2], const Unit& u, int wr, int wc, int fr, int fq) const {
        const int row0 = u.pm * BM + wr * 64 + fr, col0 = u.pn * BM + wc * 32 + 4 * fq;
        f32x4 bv[2][2];
#pragma unroll
        for (int bj = 0; bj < 2; ++bj)
#pragma unroll
            for (int n = 0; n < 2; ++n) bv[bj][n] = bias ? *(const f32x4*)(bias + col0 + bj * HALF + n * 16) : (f32x4){0.f, 0.f, 0.f, 0.f};
#pragma unroll
        for (int ai = 0; ai < 2; ++ai)
#pragma unroll
            for (int m = 0; m < 4; ++m) { float* rowp = C + (size_t)(row0 + ai * HALF + m * 16) * ldc + col0;
#pragma unroll
                for (int bj = 0; bj < 2; ++bj)
#pragma unroll
                    for (int n = 0; n < 2; ++n) *(f32x4*)(rowp + bj * HALF + n * 16) = acc[ai][bj][m][n] + bv[bj][n]; }
    }
};
template <int ACT  > struct EpiBf16 {
    static constexpr bool PERM = true, AFTER_DRAIN = false;
    bf16_t* O; int ldc; const float* bias; int split_cols; size_t split_stride;
    __device__ __forceinline__ void operator()(const f32x4 (&acc)[2][2][4][2], const Unit& u, int wr, int wc, int fr, int fq) const {
        const int row0 = u.pm * BM + wr * 64 + fr; int colt = u.pn * BM; bf16_t* base = O;
        if (split_cols) { const int t = colt / split_cols; base += (size_t)t * split_stride; colt -= t * split_cols; }
        const int col0 = colt + wc * 32 + 8 * fq, bcol0 = u.pn * BM + wc * 32 + 8 * fq;
        f32x4 bv[2][2];
#pragma unroll
        for (int bj = 0; bj < 2; ++bj)
#pragma unroll
            for (int n = 0; n < 2; ++n) bv[bj][n] = bias ? *(const f32x4*)(bias + bcol0 + bj * HALF + 4 * n) : (f32x4){0.f, 0.f, 0.f, 0.f};
#pragma unroll
        for (int ai = 0; ai < 2; ++ai)
#pragma unroll
            for (int m = 0; m < 4; ++m) { bf16_t* rowp = base + (size_t)(row0 + ai * HALF + m * 16) * ldc + col0;
#pragma unroll
                for (int bj = 0; bj < 2; ++bj) { f32x4 v0 = acc[ai][bj][m][0] + bv[bj][0], v1 = acc[ai][bj][m][1] + bv[bj][1];
                    if (ACT == 1) { f32x2 a = gelu_pk((f32x2){v0[0], v0[1]}), b = gelu_pk((f32x2){v0[2], v0[3]}), c = gelu_pk((f32x2){v1[0], v1[1]}), d = gelu_pk((f32x2){v1[2], v1[3]});
                        v0 = (f32x4){a.x, a.y, b.x, b.y}; v1 = (f32x4){c.x, c.y, d.x, d.y}; }
                    if (ACT == 2) {
#pragma unroll
                        for (int j = 0; j < 4; ++j) { v0[j] = 0.5f * v0[j] * (1.0f + erff(v0[j] * 0.70710678f)); v1[j] = 0.5f * v1[j] * (1.0f + erff(v1[j] * 0.70710678f)); } }
                    u32x4 w; w.x = cvt_pk_bf16(v0[0], v0[1]); w.y = cvt_pk_bf16(v0[2], v0[3]); w.z = cvt_pk_bf16(v1[0], v1[1]); w.w = cvt_pk_bf16(v1[2], v1[3]);
                    *(u32x4*)(rowp + bj * HALF) = w; } }
    }
};
template <class Epi, class Sched, bool STAMP = false>
__device__ __forceinline__ void gemm_phase(PG8_LAS unsigned char* lds, const Gemm g, const Sched& S, const Epi& E, unsigned long long* stamps) {
    const int tid = TIDX, wid = __builtin_amdgcn_readfirstlane(tid >> 6), lane = tid & 63, wr = wid >> 2, wc = wid & 3, fr = lane & 15, fq = lane >> 4;
    const int K = g.K, nt = K / BK;
    int ts_lo = 0, ts_hi = 0, nts = 0; const unsigned long long rt_entry = STAMP ? (unsigned long long)wall_clock64() : 0ull;
#define PG8_STAMP() do { if (STAMP && wid == 0 && nts < 64) { const unsigned long long _c = (unsigned long long)clock64(); \
        ts_lo = (lane == nts) ? (int)(unsigned)_c : ts_lo; ts_hi = (lane == nts) ? (int)(unsigned)(_c >> 32) : ts_hi; ++nts; } } while (0)
    PG8_STAMP();
    unsigned voffA[2], voffB[2];
#pragma unroll
    for (int i = 0; i < 2; ++i) { int R, C; stage_rc(tid * 16 + i * 8192, R, C); const int Rb = Epi::PERM ? ((R & ~31) + perm32(R & 31)) : R;
        const int Ra = g.ovl ? R - 2 * (R >> 6) : R; voffA[i] = (unsigned)(Ra * K + C) * 2u; voffB[i] = (unsigned)(Rb * K + C) * 2u; }
    const size_t kstep = (size_t)(BK * 2);
    const size_t hstep = (size_t)HALF * K * 2;
    const size_t tstep = 2 * hstep;
    const size_t hstepA = g.ovl ? (size_t)124 * K * 2 : hstep, tstepA = g.ovl ? (size_t)248 * K * 2 : tstep;
    const unsigned ldsw = (unsigned)wid * 1024u;
    const int aoff = lds_byte(wr * 64 + fr, fq * 8), boff = lds_byte(wc * 32 + fr, fq * 8);
#define PG8_SA(b, h) (((b) * 2 + (h)) * HTB)
#define PG8_SB(b, h) ((4 + (b) * 2 + (h)) * HTB)
#define PG8_STAGE(bufoff, gbase, voff) do { _Pragma("unroll") for (int _i = 0; _i < 2; ++_i) \
        __builtin_amdgcn_global_load_lds((const unsigned*)((const char*)(gbase) + (voff)[_i]), (PG8_LAS unsigned*)(lds + (bufoff) + ldsw + _i * 8192), 16, 0, 0); } while (0)
#define PG8_LDA(dst, b, h) do { _Pragma("unroll") for (int m = 0; m < 4; ++m) _Pragma("unroll") for (int k = 0; k < 2; ++k) dst[m][k] = *(const PG8_LAS bf16x8*)(lds + PG8_SA(b, h) + aoff + m * 2048 + k * 1024); } while (0)
#define PG8_LDB(dst, b, h) do { _Pragma("unroll") for (int n = 0; n < 2; ++n) _Pragma("unroll") for (int k = 0; k < 2; ++k) dst[n][k] = *(const PG8_LAS bf16x8*)(lds + PG8_SB(b, h) + boff + n * 2048 + k * 1024); } while (0)
#define PG8_MMA(ai, bj, At, Bt) do { __builtin_amdgcn_s_setprio(1); _Pragma("unroll") for (int m = 0; m < 4; ++m) _Pragma("unroll") for (int n = 0; n < 2; ++n) _Pragma("unroll") for (int k = 0; k < 2; ++k) \
        acc[ai][bj][m][n] = __builtin_amdgcn_mfma_f32_16x16x32_bf16(Bt[n][k], At[m][k], acc[ai][bj][m][n], 0, 0, 0); __builtin_amdgcn_s_setprio(0); } while (0)
#define PG8_WAIT_V(n) asm volatile("s_waitcnt vmcnt(" #n ")" ::: "memory")
#define PG8_WAIT_L(n) asm volatile("s_waitcnt lgkmcnt(" #n ")" ::: "memory")
#define PG8_BAR __builtin_amdgcn_s_barrier()
#define PG8_SCHED __builtin_amdgcn_sched_barrier(0)
    Unit cur, nxt; int ui = 0;
    if (!S.next(0, cur)) return;
    f32x4 acc[2][2][4][2];
#pragma unroll
    for (int a = 0; a < 2; ++a)
#pragma unroll
        for (int b = 0; b < 2; ++b)
#pragma unroll
            for (int m = 0; m < 4; ++m)
#pragma unroll
                for (int n = 0; n < 2; ++n) acc[a][b][m][n] = (f32x4){0.f, 0.f, 0.f, 0.f};
    bf16x8 At[4][2], B0[2][2], B1[2][2];
    const char* cA = (const char*)g.A + (size_t)cur.pm * tstepA; const char* cB = (const char*)g.Bt + (size_t)cur.pn * tstep;
    S.a_ready(cur);
    PG8_STAGE(PG8_SB(0, 0), cB, voffB); PG8_STAGE(PG8_SA(0, 0), cA, voffA); PG8_STAGE(PG8_SB(0, 1), cB + hstep, voffB); PG8_STAGE(PG8_SA(0, 1), cA + hstepA, voffA);
    if (wr == 1) PG8_BAR;
    PG8_WAIT_V(4); PG8_BAR;
    PG8_STAGE(PG8_SB(1, 0), cB + kstep, voffB); PG8_STAGE(PG8_SA(1, 0), cA + kstep, voffA); PG8_STAGE(PG8_SB(1, 1), cB + hstep + kstep, voffB);
    PG8_WAIT_V(6); PG8_BAR;
    PG8_STAMP();
    for (;;) {
        const bool has_next = S.next(ui + 1, nxt);
        const char* nA = has_next ? (const char*)g.A + (size_t)nxt.pm * tstepA : cA; const char* nB = has_next ? (const char*)g.Bt + (size_t)nxt.pn * tstep : cB;
        for (int t = 0; t < nt; t += 2) {
            const bool last = (t == nt - 2);
            const char* a1 = cA + (size_t)(t + 1) * kstep;
            const char* a2 = last ? nA : cA + (size_t)(t + 2) * kstep; const char* b2 = last ? nB : cB + (size_t)(t + 2) * kstep;
            const char* a3 = a2 + kstep; const char* b3 = b2 + kstep;
            if (last && has_next) S.a_ready(nxt);
            PG8_LDB(B0, 0, 0); PG8_SCHED; PG8_LDA(At, 0, 0); PG8_STAGE(PG8_SA(1, 1), a1 + hstepA, voffA);
            PG8_WAIT_L(8); PG8_BAR; PG8_WAIT_L(0); PG8_MMA(0, 0, At, B0); PG8_BAR; PG8_SCHED;
            PG8_LDB(B1, 0, 1); PG8_STAGE(PG8_SB(0, 0), b2, voffB);
            PG8_BAR; PG8_WAIT_L(0); PG8_MMA(0, 1, At, B1); PG8_BAR;
            PG8_LDA(At, 0, 1); PG8_STAGE(PG8_SA(0, 0), a2, voffA);
            PG8_BAR; PG8_WAIT_L(0); PG8_MMA(1, 0, At, B0); PG8_BAR; PG8_SCHED;
            PG8_STAGE(PG8_SB(0, 1), b2 + hstep, voffB);
            PG8_WAIT_V(6); PG8_BAR; PG8_MMA(1, 1, At, B1); PG8_BAR;
            PG8_LDB(B0, 1, 0); PG8_SCHED; PG8_LDA(At, 1, 0); PG8_STAGE(PG8_SA(0, 1), a2 + hstepA, voffA);
            PG8_WAIT_L(8); PG8_BAR; PG8_WAIT_L(0); PG8_MMA(0, 0, At, B0); PG8_BAR; PG8_SCHED;
            PG8_LDB(B1, 1, 1); PG8_STAGE(PG8_SB(1, 0), b3, voffB);
            PG8_BAR; PG8_WAIT_L(0); PG8_MMA(0, 1, At, B1); PG8_BAR;
            PG8_LDA(At, 1, 1); PG8_STAGE(PG8_SA(1, 0), a3, voffA);
            PG8_BAR; PG8_WAIT_L(0); PG8_MMA(1, 0, At, B0); PG8_BAR; PG8_SCHED;
            PG8_STAGE(PG8_SB(1, 1), b3 + hstep, voffB);
            PG8_WAIT_V(6); PG8_BAR; PG8_MMA(1, 1, At, B1); PG8_BAR;
        }
        PG8_STAMP();
        if constexpr (!Epi::AFTER_DRAIN) { E(acc, cur, wr, wc, fr, fq); S.done(cur); }
        PG8_STAMP();
        if (!has_next) break;
#pragma unroll
        for (int a = 0; a < 2; ++a)
#pragma unroll
            for (int b = 0; b < 2; ++b)
#pragma unroll
                for (int m = 0; m < 4; ++m)
#pragma unroll
                    for (int n = 0; n < 2; ++n) acc[a][b][m][n] = (f32x4){0.f, 0.f, 0.f, 0.f};
        cur = nxt; cA = nA; cB = nB; ++ui;
    }
    PG8_WAIT_V(0);
    if (wr == 0) PG8_BAR;
    PG8_BAR;
    if constexpr (Epi::AFTER_DRAIN) { E.fused(acc, cur, wr, wc, fr, fq, lds, wid, lane); S.done(cur); }
    PG8_STAMP();
    if (STAMP && wid == 0) { stamps[lane] = lane < nts ? (((unsigned long long)(unsigned)ts_hi << 32) | (unsigned)ts_lo) : 0ull;
        if (lane == 62) stamps[62] = rt_entry; if (lane == 63) stamps[63] = (unsigned long long)wall_clock64(); }
#undef PG8_STAMP
#undef PG8_SA
#undef PG8_SB
#undef PG8_STAGE
#undef PG8_LDA
#undef PG8_LDB
#undef PG8_MMA
#undef PG8_WAIT_V
#undef PG8_WAIT_L
#undef PG8_BAR
#undef PG8_SCHED
}
}
typedef unsigned short bf16_t;
constexpr int T_TOK = 32768, DM = 1024, D_IN = 4096, D_HY = 512, D_HG = 512, DFF = 4096, NLAYER = 4;
constexpr int L_BIG = 16384, L_SML = 4096;
constexpr int APAD = 256;
constexpr size_t MiB = 1024ull * 1024ull;
constexpr size_t OFF_W = 0;
constexpr size_t OFF_W_IN = OFF_W, OFF_W_OUT = OFF_W + 8 * MiB, OFF_W_UP = OFF_W + 10 * MiB, OFF_W_DN = OFF_W + 26 * MiB;
constexpr size_t OFF_ABUF = 34 * MiB;
constexpr size_t OFF_R1 = 99 * MiB;
constexpr size_t OFF_HYRAW = OFF_R1;
constexpr size_t OFF_HG = OFF_R1 + 96 * MiB;
constexpr size_t OFF_KT = OFF_R1;
constexpr size_t OFF_ACT = OFF_R1;
constexpr size_t OFF_R2 = 355 * MiB;
constexpr size_t OFF_X0T = OFF_R2, OFF_ZT = OFF_R2 + 32 * MiB;
constexpr size_t OFF_MIX = OFF_R2;
constexpr size_t OFF_UPART = OFF_R2;
constexpr size_t OFF_R6 = 419 * MiB;
constexpr size_t OFF_OBUF = OFF_R6;
constexpr size_t OFF_KS = OFF_R6;
constexpr size_t OFF_SMALL = 483 * MiB;
constexpr size_t OFF_BAR = OFF_SMALL + 4 * MiB;
constexpr size_t WS_NEED = 488 * MiB;

struct P { const float* in[26]; float* out; unsigned char* ws; };
constexpr int PB_norm_mix_pre = 0;
constexpr int PB_norm_mix_post = 4096;
constexpr int PB_norm_ffn_pre = 8192;
constexpr int PB_norm_ffn_post = 12288;
constexpr int PB_hy_conv_w = 16384;
constexpr int PB_hy_conv_b = 34816;
constexpr int PB_f_w1 = 40960;
constexpr int PB_f_b1 = 49408;
constexpr int PB_f_w2 = 49664;
constexpr int PB_f_b2 = 66048;
constexpr int PB_f_w3 = 66304;
constexpr int PB_f_b3 = 82688;
constexpr int PB_f_w4 = 82944;
constexpr int PB_f_freq = 345088;
constexpr int PB_hy_skip = 345344;
constexpr int PB_hy_out_norm = 347392;
constexpr int PB_lb_table = 349440;
constexpr int PB_hg_out_norm = 353536;
constexpr int PB_ffn_conv_w = 355584;
constexpr int PB_ffn_conv_b = 453888;
constexpr int PB_TOTAL = 486656;
constexpr size_t OFF_PB = OFF_SMALL + 512 * 1024;
#define PRM(p, NAME) ((const float*)((p).ws + OFF_PB) + PB_##NAME)

__device__ __forceinline__ float bf2f(bf16_t b) { return __uint_as_float(((unsigned)b) << 16); }
__device__ __forceinline__ bf16_t f2bf(float f) { unsigned u = __float_as_uint(f); u += 0x7FFFu + ((u >> 16) & 1u); return (bf16_t)(u >> 16); }
__device__ __forceinline__ unsigned pack_bf2(float lo, float hi) { return (unsigned)f2bf(lo) | ((unsigned)f2bf(hi) << 16); }
__device__ __forceinline__ bool seq_start(int t) { return t < L_BIG ? (t == 0) : ((t & (L_SML - 1)) == 0); }
__device__ __forceinline__ bool seq_end(int t) { return (t + 1 == T_TOK) || seq_start(t + 1); }
__device__ __forceinline__ const float* x_src_row(const P& p, int l, int t) {
    if (l > 0) return p.out + (size_t)t * DM;
    return t < L_BIG ? p.in[0] + (size_t)t * DM : p.in[1] + (size_t)(t - L_BIG) * DM;
}
__device__ __forceinline__ float silu_f(float x) { return x / (1.0f + __expf(-x)); }
__device__ __forceinline__ float wave_sum(float v) {
#pragma unroll
    for (int o = 32; o >= 1; o >>= 1) v += __shfl_xor(v, o);
    return v;
}

struct EpiBf16Split {
    static constexpr bool PERM = true, AFTER_DRAIN = false, OVL = false;
    bf16_t* O0; int ldc0; bf16_t* O1; int ldc1; int csplit;
    __device__ __forceinline__ void operator()(const pg8::f32x4 (&acc)[2][2][4][2], const pg8::Unit& u, int wr, int wc, int fr, int fq) const {
        const int row0 = u.pm * pg8::BM + wr * 64 + fr; int colt = u.pn * pg8::BM; bf16_t* base = O0; int ldc = ldc0;
        if (colt >= csplit) { base = O1; ldc = ldc1; colt -= csplit; }
        const int col0 = colt + wc * 32 + 8 * fq;
#pragma unroll
        for (int ai = 0; ai < 2; ++ai)
#pragma unroll
            for (int m = 0; m < 4; ++m) { bf16_t* rowp = base + (size_t)(row0 + ai * pg8::HALF + m * 16) * ldc + col0;
#pragma unroll
                for (int bj = 0; bj < 2; ++bj) { const pg8::f32x4 v0 = acc[ai][bj][m][0], v1 = acc[ai][bj][m][1];
                    pg8::u32x4 w; w.x = pg8::cvt_pk_bf16(v0[0], v0[1]); w.y = pg8::cvt_pk_bf16(v0[2], v0[3]); w.z = pg8::cvt_pk_bf16(v1[0], v1[1]); w.w = pg8::cvt_pk_bf16(v1[2], v1[3]);
                    *(pg8::u32x4*)(rowp + bj * pg8::HALF) = w; } }
    }
};
__device__ __forceinline__ float dpp_ror1(float v) { return __int_as_float(__builtin_amdgcn_update_dpp(0, __float_as_int(v), 0x121, 0xF, 0xF, false)); }
__device__ __forceinline__ float dpp_ror15(float v) { return __int_as_float(__builtin_amdgcn_update_dpp(0, __float_as_int(v), 0x12F, 0xF, 0xF, false)); }
__device__ __forceinline__ float gelu_tanh_e(float x) { const float y = 1.5957691216057308f * (x + 0.044715f * x * x * x); return x * __builtin_amdgcn_rcpf(1.0f + __expf(-y)); }
struct EpiGeglu {
    static constexpr bool PERM = true, AFTER_DRAIN = false, OVL = true;
    bf16_t* act; const float* cw; const float* cb;
    __device__ __forceinline__ void operator()(const pg8::f32x4 (&acc)[2][2][4][2], const pg8::Unit& u, int wr, int wc, int fr, int fq) const {
        const int j0 = u.pn * 128 + wc * 32 + 8 * fq;
        unsigned mprev = 0, mnext = 0, mst = 0;
#pragma unroll
        for (int ai = 0; ai < 2; ++ai)
#pragma unroll
            for (int m = 0; m < 4; ++m) { const int q = 16 * m + fr, tok = u.pm * 248 + 124 * ai + 62 * wr + q - 1, b = ai * 4 + m;
                const bool st = q >= 1 && q <= 62 && tok < T_TOK;
                if (st) { mst |= 1u << b; if (!seq_start(tok)) mprev |= 1u << b; if (!seq_end(tok)) mnext |= 1u << b; } }
#pragma unroll
        for (int n = 0; n < 2; ++n) {
            const int jc = j0 + 4 * n;
            const pg8::f32x4 wa0 = *(const pg8::f32x4*)(cw + jc), wa1 = *(const pg8::f32x4*)(cw + 8192 + jc), wa2 = *(const pg8::f32x4*)(cw + 16384 + jc), ba = *(const pg8::f32x4*)(cb + jc);
            const pg8::f32x4 wb0 = *(const pg8::f32x4*)(cw + 4096 + jc), wb1 = *(const pg8::f32x4*)(cw + 8192 + 4096 + jc), wb2 = *(const pg8::f32x4*)(cw + 16384 + 4096 + jc), bb = *(const pg8::f32x4*)(cb + 4096 + jc);
#pragma unroll
            for (int ai = 0; ai < 2; ++ai) {
                pg8::f32x4 pa_prev, pb_prev, na_cur, nb_cur;
#pragma unroll
                for (int i = 0; i < 4; ++i) { na_cur[i] = dpp_ror15(acc[ai][0][0][n][i]); nb_cur[i] = dpp_ror15(acc[ai][1][0][n][i]); pa_prev[i] = 0.f; pb_prev[i] = 0.f; }
#pragma unroll
                for (int m = 0; m < 4; ++m) {
                    const int b = ai * 4 + m, q = 16 * m + fr, tok = u.pm * 248 + 124 * ai + 62 * wr + q - 1;
                    const bool hp = (mprev >> b) & 1u, hn = (mnext >> b) & 1u;
                    pg8::f32x4 pa_cur, pb_cur, na_next, nb_next;
#pragma unroll
                    for (int i = 0; i < 4; ++i) { pa_cur[i] = dpp_ror1(acc[ai][0][m][n][i]); pb_cur[i] = dpp_ror1(acc[ai][1][m][n][i]);
                        na_next[i] = m < 3 ? dpp_ror15(acc[ai][0][m < 3 ? m + 1 : 3][n][i]) : 0.f; nb_next[i] = m < 3 ? dpp_ror15(acc[ai][1][m < 3 ? m + 1 : 3][n][i]) : 0.f; }
                    const pg8::f32x4 xpa = (fr == 0) ? pa_prev : pa_cur, xna = (fr == 15) ? na_next : na_cur;
                    const pg8::f32x4 xpb = (fr == 0) ? pb_prev : pb_cur, xnb = (fr == 15) ? nb_next : nb_cur;
                    const pg8::f32x4 xa = acc[ai][0][m][n], xb = acc[ai][1][m][n];
                    float o[4];
#pragma unroll
                    for (int i = 0; i < 4; ++i) {
                        const float ya = (hp ? xpa[i] * wa0[i] : 0.f) + xa[i] * wa1[i] + (hn ? xna[i] * wa2[i] : 0.f) + ba[i];
                        const float yb = (hp ? xpb[i] * wb0[i] : 0.f) + xb[i] * wb1[i] + (hn ? xnb[i] * wb2[i] : 0.f) + bb[i];
                        o[i] = gelu_tanh_e(ya) * yb;
                    }
                    if ((mst >> b) & 1u) { uint2 w; w.x = pg8::cvt_pk_bf16(o[0], o[1]); w.y = pg8::cvt_pk_bf16(o[2], o[3]); *(uint2*)(act + (size_t)tok * DFF + jc) = w; }
                    pa_prev = pa_cur; pb_prev = pb_cur; na_cur = na_next; nb_cur = nb_next;
                }
            }
        }
    }
};
template <class Epi>
__device__ __forceinline__ void run_gemm(LAS unsigned char* lds, const bf16_t* A, const bf16_t* Bt, int M, int N, int K, const Epi& E) {
    pg8::Gemm g; g.A = A; g.Bt = Bt; g.M = M; g.N = N; g.K = K; g.ovl = Epi::OVL ? 1 : 0;
    pg8::StaticOrder S; S.init(M, N, (int)gridDim.x, (int)blockIdx.x);
    pg8::gemm_phase<Epi, pg8::StaticOrder, false>((PG8_LAS unsigned char*)lds, g, S, E, nullptr);
}

#define HD_INLINE __device__ __forceinline__
#define DEV_FN __device__ __forceinline__
#define LDS_F2 LAS cf2*
#define NTHR 512
#define FOR_TID for (int tid = (int)TIDX, once_ = 1; once_; once_ = 0)
#define SYNC __syncthreads()
#define BREV32(x) __brev(x)
#define CIS_REV(fr, c, s) do { const float f_ = (fr); c = __builtin_amdgcn_cosf(f_); s = __builtin_amdgcn_sinf(f_); } while (0)
HD_INLINE unsigned rev4(unsigned k, int S) {
    unsigned v = BREV32(k) >> (32 - 2 * S);
    return ((v & 0xAAAAAAAAu) >> 1) | ((v & 0x55555555u) << 1);
}
HD_INLINE cf2 mkf2(float a, float b) { cf2 r; r.x = a; r.y = b; return r; }
HD_INLINE cf2 cmul(cf2 a, cf2 b) { return mkf2(a.x * b.x - a.y * b.y, a.x * b.y + a.y * b.x); }
HD_INLINE cf2 cmulc(cf2 a, cf2 b) { return mkf2(a.x * b.x + a.y * b.y, a.y * b.x - a.x * b.y); }

DEV_FN void fft_fwd(LDS_F2 X, int S, int s0) {
    const int M = 1 << (2 * S);
    for (int s = s0; s < S; ++s) {
        const int n = M >> (2 * s), q = n >> 2;
        const float invn = 1.0f / (float)n;
        FOR_TID {
            for (int b = tid; b < (M >> 2); b += NTHR) {
                const int j = b & (q - 1), base = ((b - j) << 2) + j;
                const cf2 a0 = X[base], a1 = X[base + q], a2 = X[base + 2 * q], a3 = X[base + 3 * q];
                const cf2 t0 = mkf2(a0.x + a2.x, a0.y + a2.y), t1 = mkf2(a0.x - a2.x, a0.y - a2.y);
                const cf2 t2 = mkf2(a1.x + a3.x, a1.y + a3.y);
                const cf2 d13 = mkf2(a1.x - a3.x, a1.y - a3.y);
                const cf2 t3 = mkf2(d13.y, -d13.x);
                const cf2 y0 = mkf2(t0.x + t2.x, t0.y + t2.y);
                cf2 y1 = mkf2(t1.x + t3.x, t1.y + t3.y);
                cf2 y2 = mkf2(t0.x - t2.x, t0.y - t2.y);
                cf2 y3 = mkf2(t1.x - t3.x, t1.y - t3.y);
                if (q > 1) {
                    const float fr = (float)j * invn;
                    float c1, s1, c2, s2, c3, s3;
                    CIS_REV(fr, c1, s1); CIS_REV(2.0f * fr, c2, s2); CIS_REV(3.0f * fr, c3, s3);
                    y1 = cmul(y1, mkf2(c1, -s1)); y2 = cmul(y2, mkf2(c2, -s2)); y3 = cmul(y3, mkf2(c3, -s3));
                }
                X[base] = y0; X[base + q] = y1; X[base + 2 * q] = y2; X[base + 3 * q] = y3;
            }
        }
        SYNC;
    }
}
DEV_FN void fft_inv(LDS_F2 X, int S) {
    const int M = 1 << (2 * S);
    for (int s = S - 1; s >= 0; --s) {
        const int n = M >> (2 * s), q = n >> 2;
        const float invn = 1.0f / (float)n;
        FOR_TID {
            for (int b = tid; b < (M >> 2); b += NTHR) {
                const int j = b & (q - 1), base = ((b - j) << 2) + j;
                cf2 b0 = X[base], b1 = X[base + q], b2 = X[base + 2 * q], b3 = X[base + 3 * q];
                if (q > 1) {
                    const float fr = (float)j * invn;
                    float c1, s1, c2, s2, c3, s3;
                    CIS_REV(fr, c1, s1); CIS_REV(2.0f * fr, c2, s2); CIS_REV(3.0f * fr, c3, s3);
                    b1 = cmul(b1, mkf2(c1, s1)); b2 = cmul(b2, mkf2(c2, s2)); b3 = cmul(b3, mkf2(c3, s3));
                }
                const cf2 t0 = mkf2(b0.x + b2.x, b0.y + b2.y), t1 = mkf2(b0.x - b2.x, b0.y - b2.y);
                const cf2 t2 = mkf2(b1.x + b3.x, b1.y + b3.y);
                const cf2 d13 = mkf2(b1.x - b3.x, b1.y - b3.y);
                const cf2 t3 = mkf2(-d13.y, d13.x);
                X[base] = mkf2(t0.x + t2.x, t0.y + t2.y);
                X[base + q] = mkf2(t1.x + t3.x, t1.y + t3.y);
                X[base + 2 * q] = mkf2(t0.x - t2.x, t0.y - t2.y);
                X[base + 3 * q] = mkf2(t1.x - t3.x, t1.y - t3.y);
            }
        }
        SYNC;
    }
}
DEV_FN void spec_store(LDS_F2 X, int S, cf2* Ks) {
    const int M = 1 << (2 * S);
    FOR_TID {
        for (int k = tid; k <= (M >> 1); k += NTHR) {
            if (k == 0) { const cf2 c0 = X[0]; Ks[0] = mkf2(c0.x + c0.y, c0.x - c0.y); }
            else {
                const cf2 ck = X[rev4((unsigned)k, S)], cm = X[rev4((unsigned)(M - k), S)];
                const cf2 P = mkf2(0.5f * (ck.x + cm.x), 0.5f * (ck.y - cm.y));
                const cf2 O = mkf2(0.5f * (ck.y + cm.y), -0.5f * (ck.x - cm.x));
                float c, s; CIS_REV((float)k / (float)(2 * M), c, s);
                const cf2 Q = cmul(O, mkf2(c, -s));
                Ks[k] = mkf2(P.x + Q.x, P.y + Q.y);
                Ks[M - k] = mkf2(P.x - Q.x, -(P.y - Q.y));
            }
        }
    }
    SYNC;
}
DEV_FN void spec_mul(LDS_F2 X, int S, const cf2* Ks) {
    const int M = 1 << (2 * S);
    FOR_TID {
        for (int k = tid; k <= (M >> 1); k += NTHR) {
            if (k == 0) {
                const cf2 c0 = X[0], k0 = Ks[0];
                const float y0 = (c0.x + c0.y) * k0.x, ym = (c0.x - c0.y) * k0.y;
                X[0] = mkf2(0.5f * (y0 + ym), 0.5f * (y0 - ym));
            } else {
                const unsigned pk = rev4((unsigned)k, S), pm = rev4((unsigned)(M - k), S);
                const cf2 ck = X[pk], cm = X[pm];
                const cf2 P = mkf2(0.5f * (ck.x + cm.x), 0.5f * (ck.y - cm.y));
                const cf2 O = mkf2(0.5f * (ck.y + cm.y), -0.5f * (ck.x - cm.x));
                float c, s; CIS_REV((float)k / (float)(2 * M), c, s);
                const cf2 Wk = mkf2(c, -s);
                const cf2 Q = cmul(O, Wk);
                const cf2 xk = mkf2(P.x + Q.x, P.y + Q.y), xm = mkf2(P.x - Q.x, -(P.y - Q.y));
                const cf2 yk = cmul(xk, Ks[k]), ym = cmul(xm, Ks[M - k]);
                const cf2 Ye = mkf2(0.5f * (yk.x + ym.x), 0.5f * (yk.y - ym.y));
                const cf2 Yd = mkf2(0.5f * (yk.x - ym.x), 0.5f * (yk.y + ym.y));
                const cf2 Yo = cmulc(Yd, Wk);
                X[pk] = mkf2(Ye.x - Yo.y, Ye.y + Yo.x);
                if (k != (M >> 1)) X[pm] = mkf2(Ye.x + Yo.y, -Ye.y + Yo.x);
            }
        }
    }
    SYNC;
}
__device__ void ph_setup(const P& p) {
    const int gid = blockIdx.x * 512 + TIDX;
    if (gid < 2 * D_HG) {
        const int dir = gid / D_HG, c = gid % D_HG;
        float v[NLAYER], mx = -1e30f;
#pragma unroll
        for (int l = 0; l < NLAYER; ++l) { v[l] = p.in[19][(size_t)(dir * NLAYER + l) * D_HG + c]; mx = fmaxf(mx, v[l]); }
        float s = 0.f;
#pragma unroll
        for (int l = 0; l < NLAYER; ++l) { v[l] = expf(v[l] - mx); s += v[l]; }
        float* lbs = (float*)(p.ws + OFF_SMALL);
        float cum = 0.f;
#pragma unroll
        for (int l = 0; l < NLAYER; ++l) { if (l > 0) cum += v[l] / s; lbs[(size_t)(dir * NLAYER + l) * D_HG + c] = cum; }
    }
}
__device__ void ph_copy_params(const P& p) {
    float* pb = (float*)(p.ws + OFF_PB);
    const int g = blockIdx.x * 512 + TIDX, gs = gridDim.x * 512;
    for (int k = g; k < 4096; k += gs) pb[0 + k] = p.in[2][k];
    for (int k = g; k < 4096; k += gs) pb[4096 + k] = p.in[3][k];
    for (int k = g; k < 4096; k += gs) pb[8192 + k] = p.in[4][k];
    for (int k = g; k < 4096; k += gs) pb[12288 + k] = p.in[5][k];
    for (int k = g; k < 18432; k += gs) pb[16384 + k] = p.in[7][k];
    for (int k = g; k < 6144; k += gs) pb[34816 + k] = p.in[8][k];
    for (int k = g; k < 8448; k += gs) pb[40960 + k] = p.in[9][k];
    for (int k = g; k < 256; k += gs) pb[49408 + k] = p.in[10][k];
    for (int k = g; k < 16384; k += gs) pb[49664 + k] = p.in[11][k];
    for (int k = g; k < 256; k += gs) pb[66048 + k] = p.in[12][k];
    for (int k = g; k < 16384; k += gs) pb[66304 + k] = p.in[13][k];
    for (int k = g; k < 256; k += gs) pb[82688 + k] = p.in[14][k];
    for (int k = g; k < 262144; k += gs) pb[82944 + k] = p.in[15][k];
    for (int k = g; k < 256; k += gs) pb[345088 + k] = p.in[16][k];
    for (int k = g; k < 2048; k += gs) pb[345344 + k] = p.in[17][k];
    for (int k = g; k < 2048; k += gs) pb[347392 + k] = p.in[18][k];
    for (int k = g; k < 4096; k += gs) pb[349440 + k] = p.in[19][k];
    for (int k = g; k < 2048; k += gs) pb[353536 + k] = p.in[20][k];
    for (int k = g; k < 98304; k += gs) pb[355584 + k] = p.in[23][k];
    for (int k = g; k < 32768; k += gs) pb[453888 + k] = p.in[24][k];
}
__device__ void convert_one(const float* src, bf16_t* dst, int K, int N, LAS float* tile  , bool geglu_perm = false) {
    const int tiles_n = N / 64, ntiles = (K / 64) * tiles_n, tid = TIDX;
    for (int it = blockIdx.x; it < ntiles; it += gridDim.x) {
        const int k0 = (it / tiles_n) * 64, n0 = (it % tiles_n) * 64;
#pragma unroll
        for (int i = 0; i < 8; ++i) { const int r = (tid >> 6) + 8 * i, c = tid & 63; tile[r * 65 + c] = src[(size_t)(k0 + r) * N + n0 + c]; }
        __syncthreads();
#pragma unroll
        for (int i = 0; i < 8; ++i) { const int n = (tid >> 6) + 8 * i, k = tid & 63; int nr = n0 + n;
            if (geglu_perm) nr = nr < DFF ? (nr >> 7) * 256 + (nr & 127) : ((nr - DFF) >> 7) * 256 + 128 + ((nr - DFF) & 127);
            dst[(size_t)nr * K + k0 + k] = f2bf(tile[k * 65 + n]); }
        __syncthreads();
    }
}
__device__ void ph_convert_w(const P& p, int l, LAS unsigned char* lds) {
    LAS float* tile = (LAS float*)lds;
    convert_one(p.in[6] + (size_t)l * DM * D_IN, (bf16_t*)(p.ws + OFF_W_IN), DM, D_IN, tile);
    convert_one(p.in[21] + (size_t)l * DM * DM, (bf16_t*)(p.ws + OFF_W_OUT), DM, DM, tile);
    convert_one(p.in[22] + (size_t)l * DM * 2 * DFF, (bf16_t*)(p.ws + OFF_W_UP), DM, 2 * DFF, tile, true);
    convert_one(p.in[25] + (size_t)l * DFF * DM, (bf16_t*)(p.ws + OFF_W_DN), DFF, DM, tile);
}
__device__ __forceinline__ bf16_t* abuf_row(const P& p, int t) { return (bf16_t*)(p.ws + OFF_ABUF) + (size_t)(t + APAD) * DM; }
__device__ void ph_rmsnorm_in(const P& p, int l) {
    const int lane = TIDX & 63, wv = TIDX >> 6;
    const float* gain = p.in[2] + (size_t)l * DM;
    for (int t = blockIdx.x * 8 + wv; t < T_TOK; t += gridDim.x * 8) {
        const float* xr = x_src_row(p, l, t);
        float4 v[4]; float ss = 0.f;
#pragma unroll
        for (int i = 0; i < 4; ++i) { v[i] = *(const float4*)(xr + lane * 4 + 256 * i); ss += v[i].x * v[i].x + v[i].y * v[i].y + v[i].z * v[i].z + v[i].w * v[i].w; }
        ss = wave_sum(ss);
        const float r = rsqrtf(ss * (1.0f / DM) + 1e-6f);
        bf16_t* hr = abuf_row(p, t);
#pragma unroll
        for (int i = 0; i < 4; ++i) { const float4 g = *(const float4*)(gain + lane * 4 + 256 * i);
            uint2 w; w.x = pack_bf2(v[i].x * r * g.x, v[i].y * r * g.y); w.y = pack_bf2(v[i].z * r * g.z, v[i].w * r * g.w);
            *(uint2*)(hr + lane * 4 + 256 * i) = w; }
    }
}
__device__ void ph_norm_resid(const P& p, int l, int which) {
    const int lane = TIDX & 63, wv = TIDX >> 6;
    const float* gpost = (which == 0 ? PRM(p, norm_mix_post) : PRM(p, norm_ffn_post)) + (size_t)l * DM;
    const bool has_next = (which == 0) || (l + 1 < NLAYER);
    const float* gnext = which == 0 ? PRM(p, norm_ffn_pre) + (size_t)l * DM : PRM(p, norm_mix_pre) + (size_t)(has_next ? l + 1 : l) * DM;
    const bf16_t* Y = (const bf16_t*)(p.ws + OFF_MIX);
    const int lx = which == 0 ? l : 1;
    for (int t = blockIdx.x * 8 + wv; t < T_TOK; t += gridDim.x * 8) {
        const float* xr = x_src_row(p, lx, t);
        const bf16_t* yr = Y + (size_t)t * DM;
        float4 x[4], y[4]; float ss = 0.f;
#pragma unroll
        for (int i = 0; i < 4; ++i) { x[i] = *(const float4*)(xr + lane * 4 + 256 * i); const uint2 w = *(const uint2*)(yr + lane * 4 + 256 * i);
            y[i].x = __uint_as_float(w.x << 16); y[i].y = __uint_as_float(w.x & 0xffff0000u); y[i].z = __uint_as_float(w.y << 16); y[i].w = __uint_as_float(w.y & 0xffff0000u);
            ss += y[i].x * y[i].x + y[i].y * y[i].y + y[i].z * y[i].z + y[i].w * y[i].w; }
        ss = wave_sum(ss);
        const float r = rsqrtf(ss * (1.0f / DM) + 1e-6f);
        float s2 = 0.f;
#pragma unroll
        for (int i = 0; i < 4; ++i) { const float4 g = *(const float4*)(gpost + lane * 4 + 256 * i);
            x[i].x += y[i].x * r * g.x; x[i].y += y[i].y * r * g.y; x[i].z += y[i].z * r * g.z; x[i].w += y[i].w * r * g.w;
            s2 += x[i].x * x[i].x + x[i].y * x[i].y + x[i].z * x[i].z + x[i].w * x[i].w;
            *(float4*)(p.out + (size_t)t * DM + lane * 4 + 256 * i) = x[i]; }
        if (has_next) {
            s2 = wave_sum(s2);
            const float r2 = rsqrtf(s2 * (1.0f / DM) + 1e-6f);
            bf16_t* hr = abuf_row(p, t);
#pragma unroll
            for (int i = 0; i < 4; ++i) { const float4 g = *(const float4*)(gnext + lane * 4 + 256 * i);
                uint2 w; w.x = pack_bf2(x[i].x * r2 * g.x, x[i].y * r2 * g.y); w.y = pack_bf2(x[i].z * r2 * g.z, x[i].w * r2 * g.w);
                *(uint2*)(hr + lane * 4 + 256 * i) = w; }
        }
    }
}
__device__ void ph_filter(const P& p, int l, LAS unsigned char* lds) {
    LAS float* feats = (LAS float*)lds;
    LAS float* ha = feats + 16 * 36;
    LAS float* hb = ha + 16 * 64;
    LAS float* w1s = hb + 16 * 64;
    LAS float* w2s = w1s + 33 * 64;
    LAS float* w3s = w2s + 64 * 64;
    const int tid = TIDX;
    const float* w1 = PRM(p, f_w1) + (size_t)l * 33 * 64; const float* b1 = PRM(p, f_b1) + (size_t)l * 64;
    const float* w2 = PRM(p, f_w2) + (size_t)l * 64 * 64; const float* b2 = PRM(p, f_b2) + (size_t)l * 64;
    const float* w3 = PRM(p, f_w3) + (size_t)l * 64 * 64; const float* b3 = PRM(p, f_b3) + (size_t)l * 64;
    const float* w4 = PRM(p, f_w4) + (size_t)l * 64 * 1024; const float* fq = PRM(p, f_freq) + (size_t)l * 64;
    float* kt = (float*)(p.ws + OFF_KT);
    for (int i = tid; i < 33 * 64; i += 512) w1s[i] = w1[i];
    for (int i = tid; i < 64 * 64; i += 512) { w2s[i] = w2[i]; w3s[i] = w3[i]; }
    const int j = tid & 63;
    const float fqj = fq[j], b1j = b1[j], b2j = b2[j], b3j = b3[j];
    __syncthreads();
    const int nitems = (L_BIG + L_SML) / 16;
    for (int it = blockIdx.x; it < nitems; it += gridDim.x) {
        const bool big = it < L_BIG / 16; const int L = big ? L_BIG : L_SML; const int pos0 = (big ? it : it - L_BIG / 16) * 16;
        float* ktc = kt + (big ? 0 : (size_t)512 * 2 * L_BIG);
        for (int idx = tid; idx < 16 * 33; idx += 512) {
            const int pp = idx / 33, f = idx % 33; const int pos = pos0 + pp;
            const float tt = (float)pos / (float)(L - 1), ang = (6.283185307179586f / (float)L) * (float)pos;
            float v;
            if (f == 0) v = tt;
            else { const int bi = (f - 1) & 15; const float band = 1e-4f + (float)bi * ((15.0f - 1e-4f) / 15.0f); v = f <= 16 ? cosf(band * ang) : -sinf(band * ang); }
            feats[pp * 36 + f] = v;
        }
        __syncthreads();
#pragma unroll
        for (int h2 = 0; h2 < 2; ++h2) { const int pp = (tid >> 6) + 8 * h2; float a = b1j;
            for (int f = 0; f < 33; ++f) a += feats[pp * 36 + f] * w1s[f * 64 + j];
            ha[pp * 64 + j] = __sinf(fqj * a); }
        __syncthreads();
#pragma unroll
        for (int h2 = 0; h2 < 2; ++h2) { const int pp = (tid >> 6) + 8 * h2; float a = b2j;
#pragma unroll 4
            for (int f4 = 0; f4 < 16; ++f4) { const nf4 hv = *(const LAS nf4*)(ha + pp * 64 + 4 * f4);
                a += hv.x * w2s[(4 * f4) * 64 + j] + hv.y * w2s[(4 * f4 + 1) * 64 + j] + hv.z * w2s[(4 * f4 + 2) * 64 + j] + hv.w * w2s[(4 * f4 + 3) * 64 + j]; }
            hb[pp * 64 + j] = __sinf(fqj * a); }
        __syncthreads();
#pragma unroll
        for (int h2 = 0; h2 < 2; ++h2) { const int pp = (tid >> 6) + 8 * h2; float a = b3j;
#pragma unroll 4
            for (int f4 = 0; f4 < 16; ++f4) { const nf4 hv = *(const LAS nf4*)(hb + pp * 64 + 4 * f4);
                a += hv.x * w3s[(4 * f4) * 64 + j] + hv.y * w3s[(4 * f4 + 1) * 64 + j] + hv.z * w3s[(4 * f4 + 2) * 64 + j] + hv.w * w3s[(4 * f4 + 3) * 64 + j]; }
            ha[pp * 64 + j] = __sinf(fqj * a); }
        __syncthreads();
        {
            float acc0[16], acc1[16];
#pragma unroll
            for (int pp = 0; pp < 16; ++pp) { acc0[pp] = 0.f; acc1[pp] = 0.f; }
            const float* w4p = w4 + 2 * tid;
#pragma unroll 2
            for (int f4 = 0; f4 < 16; ++f4) {
                const cf2 wa = *(const cf2*)(w4p + (4 * f4) * 1024), wb = *(const cf2*)(w4p + (4 * f4 + 1) * 1024), wc = *(const cf2*)(w4p + (4 * f4 + 2) * 1024), wd = *(const cf2*)(w4p + (4 * f4 + 3) * 1024);
#pragma unroll
                for (int pp = 0; pp < 16; ++pp) { const nf4 hv = *(const LAS nf4*)(ha + pp * 64 + 4 * f4);
                    acc0[pp] += hv.x * wa.x + hv.y * wb.x + hv.z * wc.x + hv.w * wd.x;
                    acc1[pp] += hv.x * wa.y + hv.y * wb.y + hv.z * wc.y + hv.w * wd.y; }
            }
            const int o = 2 * tid, dir = o >> 9, c = o & 511;
            const float dstep = (15.350567286626972f - 3.0701134573253945f) / 511.0f;
            const float d0 = 3.0701134573253945f + (float)c * dstep, d1 = d0 + dstep;
            float* dst0 = ktc + (size_t)(c * 2 + dir) * L + pos0; float* dst1 = dst0 + 2 * (size_t)L;
            const float invl = 1.0f / (float)(L - 1);
#pragma unroll
            for (int g = 0; g < 4; ++g) { nf4 v0, v1;
#pragma unroll
                for (int i = 0; i < 4; ++i) { const float tt = (float)(pos0 + 4 * g + i) * invl; v0[i] = acc0[4 * g + i] * __expf(-tt * d0); v1[i] = acc1[4 * g + i] * __expf(-tt * d1); }
                *(nf4*)(dst0 + 4 * g) = v0; *(nf4*)(dst1 + 4 * g) = v1; }
        }
        __syncthreads();
    }
}
__device__ void ph_hy_prep(const P& p, int l, LAS unsigned char* lds) {
    LAS float* tx = (LAS float*)lds;
    LAS float* tz = tx + 64 * 65;
    const bf16_t* hy = (const bf16_t*)(p.ws + OFF_HYRAW);
    bf16_t* x0t = (bf16_t*)(p.ws + OFF_X0T); bf16_t* zt = (bf16_t*)(p.ws + OFF_ZT);
    const float* cw = PRM(p, hy_conv_w) + (size_t)l * 3 * 1536; const float* cb = PRM(p, hy_conv_b) + (size_t)l * 1536;
    const int tid = TIDX, nitems = (T_TOK / 64) * 8;
    for (int it = blockIdx.x; it < nitems; it += gridDim.x) {
        const int t0 = (it >> 3) * 64, c0 = (it & 7) * 64, c = tid & 63;
        float wv[3][3], bv[3];
#pragma unroll
        for (int a = 0; a < 3; ++a) { bv[a] = cb[a * 512 + c0 + c];
#pragma unroll
            for (int k = 0; k < 3; ++k) wv[a][k] = cw[k * 1536 + a * 512 + c0 + c]; }
#pragma unroll
        for (int i = 0; i < 8; ++i) {
            const int tt = (tid >> 6) + 8 * i, t = t0 + tt;
            const bool hp = !seq_start(t), hn = !seq_end(t);
            float r[3];
#pragma unroll
            for (int a = 0; a < 3; ++a) {
                const bf16_t* col = hy + (size_t)t * 1536 + a * 512 + c0 + c;
                const float xm = hp ? bf2f(col[-1536]) : 0.f, x0 = bf2f(col[0]), xp = hn ? bf2f(col[1536]) : 0.f;
                r[a] = xm * wv[a][0] + x0 * wv[a][1] + xp * wv[a][2] + bv[a];
            }
            tx[c * 65 + tt] = r[0]; tz[c * 65 + tt] = r[1] * r[2];
        }
        __syncthreads();
#pragma unroll
        for (int i = 0; i < 8; ++i) { const int cc = (tid >> 6) + 8 * i, tt = tid & 63;
            x0t[(size_t)(c0 + cc) * T_TOK + t0 + tt] = f2bf(tx[cc * 65 + tt]); zt[(size_t)(c0 + cc) * T_TOK + t0 + tt] = f2bf(tz[cc * 65 + tt]); }
        __syncthreads();
    }
}
__device__ __forceinline__ cf2 ld_f2_agent(const cf2* ptr) {
    const unsigned long long w = __hip_atomic_load((const unsigned long long*)ptr, __ATOMIC_RELAXED, __HIP_MEMORY_SCOPE_AGENT);
    return mkf2(__uint_as_float((unsigned)w), __uint_as_float((unsigned)(w >> 32)));
}
DEV_FN void spec_mul_g(LDS_F2 X, int S, const cf2* Ks);
__device__ void ph_hy_fft(const P& p, int l, LAS unsigned char* lds) {
    LAS cf2* X = (LAS cf2*)lds;
    const int tid = TIDX;
    cf2* Ks = (cf2*)(p.ws + OFF_KS) + (size_t)blockIdx.x * L_BIG;
    const float* kt = (const float*)(p.ws + OFF_KT);
    const bf16_t* x0t = (const bf16_t*)(p.ws + OFF_X0T); bf16_t* zt = (bf16_t*)(p.ws + OFF_ZT);
    for (int job = blockIdx.x; job < 1024; job += gridDim.x) {
        const bool big = job < 512; const int c = job & 511;
        const int L = big ? L_BIG : L_SML, S = big ? 7 : 6, M = L;
        const float* hf = kt + (big ? 0 : (size_t)512 * 2 * L_BIG) + (size_t)(c * 2) * L; const float* hb = hf + L;
        for (int m = tid; m < M; m += 512) {
            const int n0 = 2 * m, n1 = 2 * m + 1;
            const float a = n0 < L ? hf[n0] : (n0 == L ? 0.f : hb[2 * L - n0]);
            const float b = n1 < L ? hf[n1] : hb[2 * L - n1];
            X[m] = mkf2(a, b);
        }
        __syncthreads();
        fft_fwd(X, S, 0);
        spec_store(X, S, Ks);
        __threadfence(); __syncthreads();
        const float skip = PRM(p, hy_skip)[(size_t)l * D_HY + c];
        const int nseq = big ? 1 : 4;
        for (int sq = 0; sq < nseq; ++sq) {
            const int t0 = big ? 0 : L_BIG + sq * L_SML;
            const bf16_t* zrow = zt + (size_t)c * T_TOK + t0; const bf16_t* xrow = x0t + (size_t)c * T_TOK + t0;
            for (int m = tid; m < M; m += 512) {
                cf2 v = mkf2(0.f, 0.f);
                if (m < (M >> 1)) { const unsigned w = *(const unsigned*)(zrow + 2 * m); v.x = __uint_as_float(w << 16); v.y = __uint_as_float(w & 0xffff0000u); }
                X[m] = v;
            }
            __syncthreads();
            fft_fwd(X, S, 0);
            spec_mul_g(X, S, Ks);
            fft_inv(X, S);
            const float inv = 1.0f / (float)M;
            bf16_t* orow = zt + (size_t)c * T_TOK + t0;
            for (int m = tid; m < (M >> 1); m += 512) {
                const cf2 d = X[m];
                const unsigned wz = *(const unsigned*)(zrow + 2 * m), wx = *(const unsigned*)(xrow + 2 * m);
                const float z0 = __uint_as_float(wz << 16), z1 = __uint_as_float(wz & 0xffff0000u), a0 = __uint_as_float(wx << 16), a1 = __uint_as_float(wx & 0xffff0000u);
                *(unsigned*)(orow + 2 * m) = pack_bf2(a0 * (d.x * inv + skip * z0), a1 * (d.y * inv + skip * z1));
            }
            __syncthreads();
        }
    }
}
DEV_FN void spec_mul_g(LDS_F2 X, int S, const cf2* Ks) {
    const int M = 1 << (2 * S);
    for (int k = TIDX; k <= (M >> 1); k += NTHR) {
        if (k == 0) {
            const cf2 c0 = X[0], k0 = ld_f2_agent(Ks);
            const float y0 = (c0.x + c0.y) * k0.x, ym = (c0.x - c0.y) * k0.y;
            X[0] = mkf2(0.5f * (y0 + ym), 0.5f * (y0 - ym));
        } else {
            const unsigned pk = rev4((unsigned)k, S), pm = rev4((unsigned)(M - k), S);
            const cf2 ck = X[pk], cm = X[pm];
            const cf2 Pv = mkf2(0.5f * (ck.x + cm.x), 0.5f * (ck.y - cm.y));
            const cf2 O = mkf2(0.5f * (ck.y + cm.y), -0.5f * (ck.x - cm.x));
            float c, s; CIS_REV((float)k / (float)(2 * M), c, s);
            const cf2 Wk = mkf2(c, -s);
            const cf2 Q = cmul(O, Wk);
            const cf2 xk = mkf2(Pv.x + Q.x, Pv.y + Q.y), xm = mkf2(Pv.x - Q.x, -(Pv.y - Q.y));
            const cf2 yk = cmul(xk, ld_f2_agent(Ks + k)), ym = cmul(xm, ld_f2_agent(Ks + (M - k)));
            const cf2 Ye = mkf2(0.5f * (yk.x + ym.x), 0.5f * (yk.y - ym.y));
            const cf2 Yd = mkf2(0.5f * (yk.x - ym.x), 0.5f * (yk.y + ym.y));
            const cf2 Yo = cmulc(Yd, Wk);
            X[pk] = mkf2(Ye.x - Yo.y, Ye.y + Yo.x);
            if (k != (M >> 1)) X[pm] = mkf2(Ye.x + Yo.y, -Ye.y + Yo.x);
        }
    }
    __syncthreads();
}
__device__ void ph_hy_norm(const P& p, int l, LAS unsigned char* lds) {
    LAS float* tl = (LAS float*)lds;
    LAS float* red = tl + 64 * 65;
    const bf16_t* yh = (const bf16_t*)(p.ws + OFF_ZT);
    const float* gain = PRM(p, hy_out_norm) + (size_t)l * D_HY;
    const int tid = TIDX, nitems = (T_TOK / 64) * 8;
    for (int it = blockIdx.x; it < nitems; it += gridDim.x) {
        const int t0 = (it >> 3) * 64, c0 = (it & 7) * 64;
#pragma unroll
        for (int i = 0; i < 8; ++i) { const int cc = (tid >> 6) + 8 * i, tt = tid & 63; tl[cc * 65 + tt] = bf2f(yh[(size_t)(c0 + cc) * T_TOK + t0 + tt]); }
        __syncthreads();
        { const int tt = tid & 63, part = tid >> 6; float s = 0.f;
#pragma unroll
          for (int j = 0; j < 8; ++j) { const float v = tl[(part * 8 + j) * 65 + tt]; s += v * v; }
          red[part * 64 + tt] = s; }
        __syncthreads();
#pragma unroll
        for (int i = 0; i < 8; ++i) { const int tt = (tid >> 6) + 8 * i, cc = tid & 63;
            float s = 0.f;
#pragma unroll
            for (int j = 0; j < 8; ++j) s += red[j * 64 + tt];
            const float r = rsqrtf(s * (1.0f / 64.0f) + 1e-6f);
            abuf_row(p, t0 + tt)[c0 + cc] = f2bf(tl[cc * 65 + tt] * r * gain[c0 + cc]); }
        __syncthreads();
    }
}
typedef short hbf16x8 __attribute__((ext_vector_type(8)));
typedef float hf32x16 __attribute__((ext_vector_type(16)));
constexpr int HSC = 512, HNCH = HSC / 64, HNSC = T_TOK / HSC;
constexpr int QS = 136, KS_ = 72;
constexpr int HL_QH = 0, HL_KH = HL_QH + 64 * QS * 2, HL_QT = HL_KH + 64 * QS * 2, HL_KT = HL_QT + 64 * QS * 2, HL_VT = HL_KT + 128 * KS_ * 2, HL_ST = HL_VT + 128 * KS_ * 2,
              HL_PM = HL_ST + 128 * QS * 2, HL_TOT = HL_PM + 64 * KS_ * 2, HL_EB = HL_TOT + 4 * 128 * 4, HL_END = HL_EB + 128 * 4;
constexpr int HL_OF = HL_QH, OFS = 132;
static_assert(64 * OFS * 4 <= 2 * 64 * QS * 2, "O tile must fit over Qh|Kh");
constexpr size_t OFF_HST = OFF_R6 + 32 * MiB;
constexpr size_t OFF_HAT = OFF_SMALL + 64 * 1024;

__device__ __forceinline__ hf32x16 mfma32(hbf16x8 a, hbf16x8 b, hf32x16 c) { return __builtin_amdgcn_mfma_f32_32x32x16_bf16(a, b, c, 0, 0, 0); }
__device__ __forceinline__ hbf16x8 lds_frag(const LAS unsigned char* base, int row, int stride_el, int col_el) { return *(const LAS hbf16x8*)(base + ((size_t)row * stride_el + col_el) * 2); }

typedef unsigned hu32x4 __attribute__((ext_vector_type(4)));
struct HgPre { hu32x4 f0, f1, v0, v1, q0, q1; };
template <bool FULL>
__device__ __forceinline__ void hg_fetch(const bf16_t* hg, HgPre& pre, int tokbase, int dirsign, int h, int dir) {
    const int tid = TIDX;
    { const int u = tid >> 4, seg = tid & 15;
      const bf16_t* row = hg + (size_t)(tokbase + dirsign * u) * 2560 + h * 128 + seg * 8;
      pre.f0 = *(const hu32x4*)(row + 512 + 512 * dir); pre.v0 = *(const hu32x4*)(row + 1536); if (FULL) pre.q0 = *(const hu32x4*)(row);
      const bf16_t* row1 = row + (size_t)dirsign * 32 * 2560;
      pre.f1 = *(const hu32x4*)(row1 + 512 + 512 * dir); pre.v1 = *(const hu32x4*)(row1 + 1536); if (FULL) pre.q1 = *(const hu32x4*)(row1); }
}
template <bool FULL>
__device__ __forceinline__ void hg_prep(LAS unsigned char* lds, const HgPre& pre, float lb, float& Bsum_out) {
    const int tid = TIDX, d = tid & 127, qt = tid >> 7;
    LAS float* tot = (LAS float*)(lds + HL_TOT); LAS float* eB = (LAS float*)(lds + HL_EB);
    { const int u = tid >> 4, seg = tid & 15;
      *(LAS hu32x4*)(lds + HL_KH + ((size_t)u * QS + seg * 8) * 2) = pre.f0; *(LAS hu32x4*)(lds + HL_KH + ((size_t)(u + 32) * QS + seg * 8) * 2) = pre.f1;
      *(LAS hu32x4*)(lds + HL_QH + ((size_t)u * QS + seg * 8) * 2) = pre.v0; *(LAS hu32x4*)(lds + HL_QH + ((size_t)(u + 32) * QS + seg * 8) * 2) = pre.v1;
      if (FULL) { *(LAS hu32x4*)(lds + HL_QT + ((size_t)u * QS + seg * 8) * 2) = pre.q0; *(LAS hu32x4*)(lds + HL_QT + ((size_t)(u + 32) * QS + seg * 8) * 2) = pre.q1; } }
    __syncthreads();
    float run = 0.f;
#pragma unroll 4
    for (int j = 0; j < 16; ++j) {
        const int u = qt * 16 + j;
        float z = bf2f(*(const LAS bf16_t*)(lds + HL_KH + ((size_t)u * QS + d) * 2));
        z = fmaxf(z, -60.0f);
        const float f = lb + (1.0f - lb) / (1.0f + __expf(-z));
        run += __logf(f);
    }
    tot[qt * 128 + d] = run;
    __syncthreads();
    const float t0 = tot[d], t1 = tot[128 + d], t2 = tot[256 + d], t3 = tot[384 + d];
    const float off = qt == 0 ? 0.f : (qt == 1 ? t0 : (qt == 2 ? t0 + t1 : t0 + t1 + t2));
    const float r = t0 + t1, B = t0 + t1 + t2 + t3;
    const float eBr = __expf(B - r);
    if (qt == 0) eB[d] = __expf(B);
    Bsum_out = B;
    float b = off;
#pragma unroll 2
    for (int jj = 0; jj < 8; ++jj) {
        unsigned pkt = 0, pvt = 0;
#pragma unroll
        for (int q2 = 0; q2 < 2; ++q2) {
            const int u = qt * 16 + jj * 2 + q2;
            float z = bf2f(*(const LAS bf16_t*)(lds + HL_KH + ((size_t)u * QS + d) * 2));
            z = fmaxf(z, -60.0f);
            const float f = lb + (1.0f - lb) / (1.0f + __expf(-z));
            b += __logf(f);
            const float kh = (1.0f - f) * __expf(r - b);
            const bf16_t vraw = *(const LAS bf16_t*)(lds + HL_QH + ((size_t)u * QS + d) * 2);
            pkt |= (unsigned)f2bf(kh * eBr) << (16 * q2); pvt |= (unsigned)vraw << (16 * q2);
            if (FULL) {
                const float q = silu_f(bf2f(*(const LAS bf16_t*)(lds + HL_QT + ((size_t)u * QS + d) * 2)));
                const float E = __expf(b);
                *(LAS bf16_t*)(lds + HL_QT + ((size_t)u * QS + d) * 2) = f2bf(q * E);
                *(LAS bf16_t*)(lds + HL_QH + ((size_t)u * QS + d) * 2) = f2bf(q * __expf(b - r));
                *(LAS bf16_t*)(lds + HL_KH + ((size_t)u * QS + d) * 2) = f2bf(kh);
            }
        }
        *(LAS unsigned*)(lds + HL_KT + ((size_t)d * KS_ + qt * 16 + jj * 2) * 2) = pkt;
        *(LAS unsigned*)(lds + HL_VT + ((size_t)d * KS_ + qt * 16 + jj * 2) * 2) = pvt;
    }
    __syncthreads();
}
__device__ __forceinline__ void hg_state_update(LAS unsigned char* lds, hf32x16 (&S)[2], int w, int lane) {
    const int en = w & 3, r = lane & 31, hh = lane >> 5;
    const LAS float* eB = (const LAS float*)(lds + HL_EB);
#pragma unroll
    for (int i = 0; i < 2; ++i) {
        const int dm = (w >> 2) * 2 + i;
#pragma unroll
        for (int g = 0; g < 4; ++g) { const nf4 sc = *(const LAS nf4*)(eB + 32 * dm + 8 * g + 4 * hh);
            S[i][4 * g + 0] *= sc.x; S[i][4 * g + 1] *= sc.y; S[i][4 * g + 2] *= sc.z; S[i][4 * g + 3] *= sc.w; }
#pragma unroll
        for (int ks = 0; ks < 4; ++ks) {
            const hbf16x8 a = lds_frag(lds + HL_KT, 32 * dm + r, KS_, 16 * ks + 8 * hh);
            const hbf16x8 b = lds_frag(lds + HL_VT, 32 * en + r, KS_, 16 * ks + 8 * hh);
            S[i] = mfma32(a, b, S[i]);
        }
    }
}
__device__ __forceinline__ int hg_unit_base(int sc) { return sc * HSC; }
__device__ void ph_hg_pass1(const P& p, int l, LAS unsigned char* lds) {
    const bf16_t* hg = (const bf16_t*)(p.ws + OFF_HG);
    const float* lbs = (const float*)(p.ws + OFF_SMALL);
    float* ust = (float*)(p.ws + OFF_HST); float* atot = (float*)(p.ws + OFF_HAT);
    const int tid = TIDX, w = tid >> 6, lane = tid & 63;
    for (int unit = blockIdx.x; unit < HNSC * 8; unit += gridDim.x) {
        const int sc = unit >> 3, h = (unit >> 1) & 3, dir = unit & 1;
        const float lb = lbs[(size_t)(dir * NLAYER + l) * D_HG + h * 128 + (tid & 127)];
        hf32x16 S[2];
#pragma unroll
        for (int i = 0; i < 2; ++i)
#pragma unroll
            for (int k = 0; k < 16; ++k) S[i][k] = 0.f;
        float Btot = 0.f;
        const int dsg = dir ? -1 : 1, tb0 = dir ? hg_unit_base(sc) + HSC - 1 : hg_unit_base(sc);
        HgPre pre;
        hg_fetch<false>(hg, pre, tb0, dsg, h, dir);
        for (int ci = 0; ci < HNCH; ++ci) {
            float B;
            hg_prep<false>(lds, pre, lb, B);
            if (ci + 1 < HNCH) hg_fetch<false>(hg, pre, tb0 + dsg * (ci + 1) * 64, dsg, h, dir);
            Btot += B;
            hg_state_update(lds, S, w, lane);
            __syncthreads();
        }
        float* U = ust + (size_t)unit * 16384;
        int r = lane & 31, hh = lane >> 5; asm volatile("" : "+v"(r), "+v"(hh));
        const int en = w & 3;
#pragma unroll
        for (int i = 0; i < 2; ++i) { const int dm = (w >> 2) * 2 + i;
#pragma unroll
            for (int k = 0; k < 16; ++k) U[(32 * dm + (k & 3) + 8 * (k >> 2) + 4 * hh) * 128 + 32 * en + r] = S[i][k]; }
        if (tid < 128) atot[(size_t)unit * 128 + tid] = __expf(Btot);
    }
}
__device__ void ph_hg_pass2(const P& p) {
    float* ust = (float*)(p.ws + OFF_HST); const float* atot = (const float*)(p.ws + OFF_HAT);
    const int total = 5 * 8 * 16384;
    for (int idx = blockIdx.x * 512 + TIDX; idx < total; idx += gridDim.x * 512) {
        const int el = idx & 16383, hd = (idx >> 14) & 7, sq = idx >> 17;
        const int sc0 = sq == 0 ? 0 : 32 + 8 * (sq - 1), nsc = sq == 0 ? 32 : 8, dir = hd & 1, d = el >> 7;
        float carry = 0.f;
        for (int j = 0; j < nsc; ++j) {
            const int sc = dir ? sc0 + nsc - 1 - j : sc0 + j;
            const size_t unit = (size_t)sc * 8 + hd;
            const float u = ust[unit * 16384 + el], a = atot[unit * 128 + d];
            ust[unit * 16384 + el] = carry;
            carry = a * carry + u;
        }
    }
}
__device__ void ph_hg_pass3(const P& p, int l, LAS unsigned char* lds) {
    const bf16_t* hg = (const bf16_t*)(p.ws + OFF_HG);
    const float* lbs = (const float*)(p.ws + OFF_SMALL);
    const float* ust = (const float*)(p.ws + OFF_HST);
    const float* gain = PRM(p, hg_out_norm) + (size_t)l * D_HG;
    const int tid = TIDX, w = tid >> 6, lane = tid & 63, r = lane & 31, hh = lane >> 5;
    for (int unit = blockIdx.x; unit < HNSC * 4; unit += gridDim.x) {
        const int sc = unit >> 2, h = unit & 3;
        for (int dir = 0; dir < 2; ++dir) {
            const float lb = lbs[(size_t)(dir * NLAYER + l) * D_HG + h * 128 + (tid & 127)];
            const float* S0 = ust + ((size_t)sc * 8 + h * 2 + dir) * 16384;
            hf32x16 S[2];
            { const int en = w & 3;
              int r_ = r, hh_ = hh; asm volatile("" : "+v"(r_), "+v"(hh_));
              const float* S0l = S0 + (4 * hh_) * 128 + 32 * en + r_;
#pragma unroll
              for (int i = 0; i < 2; ++i) { const int dm = (w >> 2) * 2 + i;
#pragma unroll
                  for (int k = 0; k < 16; ++k) S[i][k] = S0l[(32 * dm + (k & 3) + 8 * (k >> 2)) * 128];
#pragma unroll
                  for (int g = 0; g < 4; ++g) { nu2 wv; wv.x = pack_bf2(S[i][4 * g], S[i][4 * g + 1]); wv.y = pack_bf2(S[i][4 * g + 2], S[i][4 * g + 3]);
                      *(LAS nu2*)(lds + HL_ST + ((size_t)(32 * en + r) * QS + 32 * dm + 8 * g + 4 * hh) * 2) = wv; } } }
            const int dsg = dir ? -1 : 1, tb0 = dir ? hg_unit_base(sc) + HSC - 1 : hg_unit_base(sc);
            HgPre pre;
            hg_fetch<true>(hg, pre, tb0, dsg, h, dir);
            for (int ci = 0; ci < HNCH; ++ci) {
                const int tokbase = tb0 + dsg * ci * 64;
                float Bdummy;
                hg_prep<true>(lds, pre, lb, Bdummy);
                if (ci + 1 < HNCH) hg_fetch<true>(hg, pre, tb0 + dsg * (ci + 1) * 64, dsg, h, dir);
                if (w < 4) {
                    const int tm = (w == 0 || w == 3) ? 0 : 1, sn = (w == 2 || w == 3) ? 1 : 0;
                    hf32x16 acc;
#pragma unroll
                    for (int k = 0; k < 16; ++k) acc[k] = 0.f;
                    if (w < 3) {
#pragma unroll
                        for (int ks = 0; ks < 8; ++ks) acc = mfma32(lds_frag(lds + HL_QH, 32 * tm + r, QS, 16 * ks + 8 * hh), lds_frag(lds + HL_KH, 32 * sn + r, QS, 16 * ks + 8 * hh), acc);
                    }
                    const int s_ = 32 * sn + r;
#pragma unroll
                    for (int k = 0; k < 16; ++k) { const int t_ = 32 * tm + (k & 3) + 8 * (k >> 2) + 4 * hh;
                        const float v = (w < 3 && s_ <= t_) ? acc[k] : 0.f;
                        *(LAS bf16_t*)(lds + HL_PM + ((size_t)t_ * KS_ + s_) * 2) = f2bf(v); }
                }
                __syncthreads();
                hf32x16 o;
                { const int tm = w >> 2, en = w & 3;
#pragma unroll
                  for (int k = 0; k < 16; ++k) o[k] = 0.f;
#pragma unroll
                  for (int ks = 0; ks < 4; ++ks) o = mfma32(lds_frag(lds + HL_PM, 32 * tm + r, KS_, 16 * ks + 8 * hh), lds_frag(lds + HL_VT, 32 * en + r, KS_, 16 * ks + 8 * hh), o);
#pragma unroll
                  for (int ks = 0; ks < 8; ++ks) o = mfma32(lds_frag(lds + HL_QT, 32 * tm + r, QS, 16 * ks + 8 * hh), lds_frag(lds + HL_ST, 32 * en + r, QS, 16 * ks + 8 * hh), o);
                }
                __syncthreads();
                { const int tm = w >> 2, en = w & 3; LAS float* Of = (LAS float*)(lds + HL_OF);
#pragma unroll
                  for (int k = 0; k < 16; ++k) Of[(size_t)(32 * tm + (k & 3) + 8 * (k >> 2) + 4 * hh) * OFS + 32 * en + r] = o[k]; }
                hg_state_update(lds, S, w, lane);
                { const int en = w & 3;
#pragma unroll
                  for (int i = 0; i < 2; ++i) { const int dm = (w >> 2) * 2 + i;
#pragma unroll
                      for (int g = 0; g < 4; ++g) { nu2 wv; wv.x = pack_bf2(S[i][4 * g], S[i][4 * g + 1]); wv.y = pack_bf2(S[i][4 * g + 2], S[i][4 * g + 3]);
                          *(LAS nu2*)(lds + HL_ST + ((size_t)(32 * en + r) * QS + 32 * dm + 8 * g + 4 * hh) * 2) = wv; } } }
                __syncthreads();
                { const int u = tid >> 3, e0 = (tid & 7) * 16, tok = tokbase + dsg * u;
                  const LAS float* Of = (const LAS float*)(lds + HL_OF) + (size_t)u * OFS + e0;
                  bf16_t* dst = abuf_row(p, tok) + 512 + h * 128 + e0;
                  float v[16];
#pragma unroll
                  for (int j = 0; j < 4; ++j) { const nf4 t4 = *(const LAS nf4*)(Of + 4 * j); v[4 * j] = t4.x; v[4 * j + 1] = t4.y; v[4 * j + 2] = t4.z; v[4 * j + 3] = t4.w; }
                  if (dir == 0) {
                      uint4 w0, w1;
                      w0.x = pack_bf2(v[0], v[1]); w0.y = pack_bf2(v[2], v[3]); w0.z = pack_bf2(v[4], v[5]); w0.w = pack_bf2(v[6], v[7]);
                      w1.x = pack_bf2(v[8], v[9]); w1.y = pack_bf2(v[10], v[11]); w1.z = pack_bf2(v[12], v[13]); w1.w = pack_bf2(v[14], v[15]);
                      ((uint4*)dst)[0] = w0; ((uint4*)dst)[1] = w1;
                  } else {
                      const uint4 f0 = ((const uint4*)dst)[0], f1 = ((const uint4*)dst)[1];
                      const unsigned fw[8] = {f0.x, f0.y, f0.z, f0.w, f1.x, f1.y, f1.z, f1.w};
                      float ss = 0.f;
#pragma unroll
                      for (int j = 0; j < 8; ++j) { v[2 * j] += __uint_as_float(fw[j] << 16); v[2 * j + 1] += __uint_as_float(fw[j] & 0xffff0000u); ss += v[2 * j] * v[2 * j] + v[2 * j + 1] * v[2 * j + 1]; }
                      ss += __shfl_xor(ss, 1); ss += __shfl_xor(ss, 2); ss += __shfl_xor(ss, 4);
                      const float rn = rsqrtf(ss * (1.0f / 128.0f) + 1e-6f);
                      const bf16_t* gp = hg + (size_t)tok * 2560 + 2048 + h * 128 + e0;
                      const uint4 g0 = ((const uint4*)gp)[0], g1 = ((const uint4*)gp)[1];
                      const unsigned gw[8] = {g0.x, g0.y, g0.z, g0.w, g1.x, g1.y, g1.z, g1.w};
                      unsigned ow[8];
#pragma unroll
                      for (int j = 0; j < 8; ++j) { const float ga = silu_f(__uint_as_float(gw[j] << 16)), gb = silu_f(__uint_as_float(gw[j] & 0xffff0000u));
                          ow[j] = pack_bf2(v[2 * j] * rn * gain[h * 128 + e0 + 2 * j] * ga, v[2 * j + 1] * rn * gain[h * 128 + e0 + 2 * j + 1] * gb); }
                      ((uint4*)dst)[0] = make_uint4(ow[0], ow[1], ow[2], ow[3]); ((uint4*)dst)[1] = make_uint4(ow[4], ow[5], ow[6], ow[7]);
                  }
                }
                __syncthreads();
            }
        }
    }
}
#define XB_TMO      128
#define XB_XCNT(j)  (256  + 64 * (j))
#define XB_XSUB(j)  (1280 + 64 * (j))
#define XB_XGEN(j)  (2304 + 64 * (j))
#define XB_TOP      3328
#define XB_TOPGEN   3392
#define XCD_BAR_WORDS 3456
#define XB_SPIN_CAP (1u << 18)

__device__ __forceinline__ unsigned xb_ld(unsigned* p)              { return __hip_atomic_load(p, __ATOMIC_RELAXED, __HIP_MEMORY_SCOPE_AGENT); }
__device__ __forceinline__ unsigned xb_add(unsigned* p, unsigned v) { return __hip_atomic_fetch_add(p, v, __ATOMIC_RELAXED, __HIP_MEMORY_SCOPE_AGENT); }
__device__ __forceinline__ unsigned xb_xcc_id() { return (unsigned)__builtin_amdgcn_s_getreg((3 << 11) | 20) & 0xFu; }
#define XB_SPIN(cond, bar) do { unsigned _sp = 0; while (cond) { __builtin_amdgcn_s_sleep(1); \
    if ((++_sp & 255u) == 0u) { if (xb_ld(&(bar)[XB_TMO])) break; if (_sp > XB_SPIN_CAP) { atomicAdd(&(bar)[XB_TMO], 1u); break; } } } } while (0)

struct XcdBarrier {
    unsigned* bar; unsigned x;
    volatile LAS unsigned* st;
};

__device__ __forceinline__ XcdBarrier xcd_barrier_post(unsigned* bar, volatile LAS unsigned* st) {
    XcdBarrier b; b.bar = bar; b.x = xb_xcc_id(); b.st = st;
    if (TIDX == 0) (void)xb_add(&bar[XB_XCNT(b.x)], 1u);
    return b;
}
__device__ __forceinline__ void xcd_barrier_complete(unsigned* bar, unsigned x, unsigned& nloc, unsigned& nx) {
    const unsigned G = gridDim.x * gridDim.y * gridDim.z;
    unsigned sum, cnt, mine, sp = 0u;
    for (;;) {
        sum = 0u; cnt = 0u; mine = 0u;
#pragma unroll
        for (unsigned j = 0; j < 16; ++j) { const unsigned c = xb_ld(&bar[XB_XCNT(j)]); sum += c; cnt += (c > 0u) ? 1u : 0u; mine = (j == x) ? c : mine; }
        if (sum == G) break;
        __builtin_amdgcn_s_sleep(1);
        if ((++sp & 255u) == 0u) { if (xb_ld(&bar[XB_TMO])) break; if (sp > XB_SPIN_CAP) { atomicAdd(&bar[XB_TMO], 1u); break; } }
    }
    nloc = mine > 0u ? mine : 1u; nx = cnt > 0u ? cnt : 1u;
}

__device__ __forceinline__ void xcd_barrier(const XcdBarrier& b) {
    asm volatile("s_waitcnt vmcnt(0)" ::: "memory");
    __syncthreads();
    if (TIDX == 0) {
        unsigned* bar = b.bar;
        __builtin_amdgcn_s_waitcnt(0);
        unsigned nloc = b.st[0], nx = b.st[1];
        if (nloc == 0u) { xcd_barrier_complete(bar, b.x, nloc, nx); b.st[0] = nloc; b.st[1] = nx; }
        const unsigned old = xb_add(&bar[XB_XSUB(b.x)], 1u);
        const unsigned gen = old / nloc;
        if (old + 1u == (gen + 1u) * nloc) {
            __builtin_amdgcn_fence(__ATOMIC_RELEASE, "agent");
            asm volatile("s_waitcnt vmcnt(0)" ::: "memory");
            const unsigned og = xb_add(&bar[XB_TOP], 1u);
            const unsigned tg = og / nx;
            if (og + 1u == (tg + 1u) * nx) xb_add(&bar[XB_TOPGEN], 1u);
            else XB_SPIN(xb_ld(&bar[XB_TOPGEN]) == tg, bar);
            __builtin_amdgcn_fence(__ATOMIC_ACQUIRE, "agent");
            xb_add(&bar[XB_XGEN(b.x)], 1u);
            asm volatile("s_waitcnt vmcnt(0)" ::: "memory");
        } else {
            XB_SPIN(xb_ld(&bar[XB_XGEN(b.x)]) == gen, bar);
            __builtin_amdgcn_fence(__ATOMIC_ACQUIRE, "agent");
            asm volatile("s_waitcnt vmcnt(0)" ::: "memory");
        }
    }
    __syncthreads();
}

enum { PH_SETUP, PH_CONVERT, PH_RMS_IN, PH_GEMM_IN, PH_HY_PREP, PH_FILTER, PH_HGRN, PH_HG_NORM, PH_HY_FFT, PH_HY_NORM, PH_GEMM_OUT, PH_NR0, PH_GEMM_UP, PH_GEGLU, PH_GEMM_DN, PH_NR1, PH_HG_P1, PH_HG_P2, PH_HG_P3 };
template <int PH> __device__ __forceinline__ void run_phase(const P& p_in, int l, int part, LAS unsigned char* lds) {
    P p = p_in; asm volatile("" : "+s"(p.ws), "+s"(p.out));
    p.ws = (unsigned char*)(__attribute__((address_space(1))) unsigned char*)p.ws; p.out = (float*)(__attribute__((address_space(1))) float*)p.out;
    if constexpr (PH == PH_SETUP) { ph_setup(p); ph_copy_params(p); }
    if constexpr (PH == PH_CONVERT) ph_convert_w(p, l, lds);
    if constexpr (PH == PH_RMS_IN) ph_rmsnorm_in(p, l);
    if constexpr (PH == PH_GEMM_IN) { EpiBf16Split E; E.O0 = (bf16_t*)(p.ws + OFF_HYRAW); E.ldc0 = 1536; E.O1 = (bf16_t*)(p.ws + OFF_HG); E.ldc1 = 2560; E.csplit = 1536;
        run_gemm(lds, abuf_row(p, 0), (const bf16_t*)(p.ws + OFF_W_IN), T_TOK, D_IN, DM, E); }
    if constexpr (PH == PH_HY_PREP) ph_hy_prep(p, l, lds);
    if constexpr (PH == PH_FILTER) ph_filter(p, l, lds);
    if constexpr (PH == PH_HY_FFT) ph_hy_fft(p, l, lds);
    if constexpr (PH == PH_HY_NORM) ph_hy_norm(p, l, lds);
    if constexpr (PH == PH_GEMM_OUT) { EpiBf16Split E; E.O0 = (bf16_t*)(p.ws + OFF_MIX); E.ldc0 = DM; E.O1 = E.O0; E.ldc1 = DM; E.csplit = 1 << 30;
        run_gemm(lds, abuf_row(p, 0), (const bf16_t*)(p.ws + OFF_W_OUT), T_TOK, DM, DM, E); }
    if constexpr (PH == PH_NR0) ph_norm_resid(p, l, 0);
    if constexpr (PH == PH_GEMM_UP) { EpiGeglu E; E.act = (bf16_t*)(p.ws + OFF_ACT); E.cw = PRM(p, ffn_conv_w) + (size_t)l * 3 * 8192; E.cb = PRM(p, ffn_conv_b) + (size_t)l * 8192;
        run_gemm(lds, abuf_row(p, -1), (const bf16_t*)(p.ws + OFF_W_UP), 133 * 256, 2 * DFF, DM, E); }
    if constexpr (PH == PH_GEMM_DN) { EpiBf16Split E; E.O0 = (bf16_t*)(p.ws + OFF_MIX); E.ldc0 = DM; E.O1 = E.O0; E.ldc1 = DM; E.csplit = 1 << 30;
        run_gemm(lds, (const bf16_t*)(p.ws + OFF_ACT), (const bf16_t*)(p.ws + OFF_W_DN), T_TOK, DM, DFF, E); }
    if constexpr (PH == PH_NR1) ph_norm_resid(p, l, 1);
    if constexpr (PH == PH_HG_P1) ph_hg_pass1(p, l, lds);
    if constexpr (PH == PH_HG_P2) ph_hg_pass2(p);
    if constexpr (PH == PH_HG_P3) ph_hg_pass3(p, l, lds);
}
constexpr int LDS_BYTES = 139264;
__global__ __launch_bounds__(512, 2) void mega(P p) {
    extern __shared__ __attribute__((aligned(16))) unsigned char lds_g[];
    LAS unsigned char* lds = (LAS unsigned char*)lds_g;
    cg::grid_group grid = cg::this_grid();
    volatile LAS unsigned* xst = (volatile LAS unsigned*)(lds + LDS_BYTES - 16);
    if (TIDX == 0) { xst[0] = 0u; xst[1] = 0u; }
    __syncthreads();
    const XcdBarrier xb = xcd_barrier_post((unsigned*)(p.ws + OFF_BAR), xst);
    run_phase<PH_SETUP>(p, 0, 0, lds);
    run_phase<PH_CONVERT>(p, 0, 0, lds);
    run_phase<PH_RMS_IN>(p, 0, 0, lds);
    grid.sync();
#pragma unroll 1
    for (int l = 0; l < NLAYER; ++l) {
        run_phase<PH_GEMM_IN>(p, l, 0, lds); xcd_barrier(xb);
        run_phase<PH_HY_PREP>(p, l, 0, lds); run_phase<PH_HG_P1>(p, l, 0, lds); xcd_barrier(xb);
        run_phase<PH_FILTER>(p, l, 0, lds); run_phase<PH_HG_P2>(p, l, 0, lds); xcd_barrier(xb);
        run_phase<PH_HG_P3>(p, l, 0, lds); run_phase<PH_HY_FFT>(p, l, 0, lds); xcd_barrier(xb);
        run_phase<PH_HY_NORM>(p, l, 0, lds); xcd_barrier(xb);
        run_phase<PH_GEMM_OUT>(p, l, 0, lds); xcd_barrier(xb);
        run_phase<PH_NR0>(p, l, 0, lds); xcd_barrier(xb);
        run_phase<PH_GEMM_UP>(p, l, 0, lds); xcd_barrier(xb);
        run_phase<PH_GEMM_DN>(p, l, 0, lds); xcd_barrier(xb);
        run_phase<PH_NR1>(p, l, 0, lds);
        if (l + 1 < NLAYER) { run_phase<PH_CONVERT>(p, l + 1, 0, lds); xcd_barrier(xb); }
    }
}
extern "C" void kernel_launch(void* const* d_in, const int* in_sizes, int n_in, void* d_out, int out_size, void* d_ws, size_t ws_size, hipStream_t stream) {
    if (ws_size < WS_NEED) { fprintf(stderr, "workspace too small: %zu < %zu\n", ws_size, (size_t)WS_NEED); return; }
    static int grid_blocks = 0;
    if (!grid_blocks) {
        hipFuncSetAttribute((const void*)mega, hipFuncAttributeMaxDynamicSharedMemorySize, LDS_BYTES);
        int dev = 0, cus = 0, per_cu = 0;
        hipGetDevice(&dev);
        hipDeviceGetAttribute(&cus, hipDeviceAttributeMultiprocessorCount, dev);
        hipOccupancyMaxActiveBlocksPerMultiprocessor(&per_cu, mega, 512, LDS_BYTES);
        if (per_cu > 1) per_cu = 1;
        grid_blocks = cus * per_cu;
    }
    P p{};
    for (int i = 0; i < 26; ++i) p.in[i] = (const float*)d_in[i];
    p.out = (float*)d_out; p.ws = (unsigned char*)d_ws;
    hipMemsetAsync((unsigned char*)d_ws + OFF_BAR, 0, XCD_BAR_WORDS * 4, stream);
    void* args[] = {&p};
    hipError_t e = hipLaunchCooperativeKernel((void*)mega, dim3(grid_blocks), dim3(512), args, LDS_BYTES, stream);
    if (e != hipSuccess) fprintf(stderr, "cooperative launch failed: %s (grid %d)\n", hipGetErrorString(e), grid_blocks);
}
```

```cpp
#include <hip/hip_runtime.h>
#include <hip/hip_cooperative_groups.h>
#include <cstdio>
#include <cstdint>
namespace cg = cooperative_groups;
__device__ __forceinline__ int tid_opaque() { int t = (int)threadIdx.x; asm volatile("" : "+v"(t)); return t; }
#define TIDX tid_opaque()
#define LAS __attribute__((address_space(3)))
typedef float cf2 __attribute__((ext_vector_type(2)));
typedef float nf4 __attribute__((ext_vector_type(4)));
typedef unsigned nu2 __attribute__((ext_vector_type(2)));
typedef unsigned nu4 __attribute__((ext_vector_type(4)));
namespace pg8 {
#define PG8_LAS __attribute__((address_space(3)))
typedef unsigned short bf16_t;
typedef short bf16x8 __attribute__((ext_vector_type(8)));
typedef float f32x4 __attribute__((ext_vector_type(4)));
typedef unsigned u32x4 __attribute__((ext_vector_type(4)));
constexpr int BM = 256, BK = 64, HALF = 128, HTB = HALF * BK * 2  , STAGE_BYTES = 8 * HTB, NXCD = 8, WGM = 8;

__host__ __device__ __forceinline__ int lds_byte(int r, int c) { const int st = (r >> 4) * 2 + (c >> 5), rr = r & 15, cc = c & 31, ob = rr * 64 + cc * 2; return st * 1024 + (ob ^ (((ob >> 9) & 1) << 5)); }
__host__ __device__ __forceinline__ void stage_rc(int b, int& R, int& C) { const int st = b / 1024, sb = b % 1024, swz = sb ^ (((sb >> 9) & 1) << 5); R = (st >> 1) * 16 + swz / 64; C = (st & 1) * 32 + (swz % 64) / 2; }
__host__ __device__ __forceinline__ int perm32(int rho) { const int n = rho >> 4, i = rho & 15; return 8 * (i >> 2) + 4 * n + (i & 3); }

struct Unit { int pm, pn; };
struct Gemm { const bf16_t* A; const bf16_t* Bt; int M, N, K; int ovl; };

struct StaticOrder {
    int nM, nN, nwg, G, c;
    __host__ __device__ void init(int M, int N, int G_, int c_) { nM = M / BM; nN = N / BM; nwg = nM * nN; G = G_; c = c_; }
    __host__ __device__ bool next(int i, Unit& u) const {
        const long L = (long)i * G + c; if (L >= nwg) return false;
        int wgid = (int)L; { const int q = nwg / NXCD, r = nwg % NXCD, xcd = wgid % NXCD, off = wgid / NXCD; wgid = (xcd < r ? xcd * (q + 1) : r * (q + 1) + (xcd - r) * q) + off; }
        const int nig = WGM * nN, gid = wgid / nig, fm = gid * WGM, gsz = (nM - fm) < WGM ? (nM - fm) : WGM;
        u.pm = fm + ((wgid % nig) % gsz); u.pn = (wgid % nig) / gsz; return true;
    }
    __device__ __forceinline__ void a_ready(const Unit&) const {}
    __device__ __forceinline__ void done(const Unit&) const {}
};
struct CountedOrder : StaticOrder {
    const unsigned* ready; unsigned need; unsigned* tmo;
    __device__ __forceinline__ void a_ready(const Unit& u) const {
        if (TIDX < 64) {
            const unsigned long long t0 = __builtin_amdgcn_s_memrealtime(); unsigned polls = 0;
            while ((unsigned)__builtin_amdgcn_readfirstlane(__hip_atomic_load(ready + 64 * u.pm, __ATOMIC_RELAXED, __HIP_MEMORY_SCOPE_AGENT)) < need) {
                if ((++polls & 255u) == 0u && __builtin_amdgcn_readfirstlane(__hip_atomic_load(tmo, __ATOMIC_RELAXED, __HIP_MEMORY_SCOPE_AGENT)) != 0u) break;
                if (__builtin_amdgcn_s_memrealtime() - t0 > 2000000ull) {
                    if (TIDX == 0) { unsigned expect = 0u; __hip_atomic_compare_exchange_strong(tmo + 1, &expect, 0x600u | (unsigned)(u.pm & 0xff), __ATOMIC_RELAXED, __ATOMIC_RELAXED, __HIP_MEMORY_SCOPE_AGENT); __hip_atomic_store(tmo, 1u, __ATOMIC_RELAXED, __HIP_MEMORY_SCOPE_AGENT); }
                    break; }
                __builtin_amdgcn_s_sleep(2); }
            __builtin_amdgcn_fence(__ATOMIC_ACQUIRE, "agent");
            asm volatile("s_waitcnt vmcnt(0)" ::: "memory");
        }
#if !defined(BROKEN_HOOK_NO_BARRIER)
        asm volatile("" ::: "memory"); __builtin_amdgcn_s_barrier(); asm volatile("" ::: "memory");
#endif
    }
};

__device__ __forceinline__ unsigned cvt_pk_bf16(float lo, float hi) { unsigned r; asm volatile("v_cvt_pk_bf16_f32 %0, %1, %2" : "=v"(r) : "v"(lo), "v"(hi)); return r; }
typedef float f32x2 __attribute__((ext_vector_type(2)));
__device__ __forceinline__ f32x2 gelu_pk(f32x2 v) {
    const f32x2 av = __builtin_elementwise_abs(v), d = av * 0.2316418882f + 1.0f;
    f32x2 t; t.x = __builtin_amdgcn_rcpf(d.x); t.y = __builtin_amdgcn_rcpf(d.y);
    f32x2 q = t * 0.5307027145f + (-0.7265760135f); q = q * t + 0.7107068705f; q = q * t + (-0.142248368f); q = q * t + 0.127414796f; q = q * t;
    const f32x2 s = (v * v) * (-0.72134752044f);
    f32x2 e; e.x = __builtin_amdgcn_exp2f(s.x); e.y = __builtin_amdgcn_exp2f(s.y);
    const f32x2 m = v * (q * e), r = v - m;
    f32x2 o; o.x = v.x < 0.f ? m.x : r.x; o.y = v.y < 0.f ? m.y : r.y; return o;
}

struct EpiF32 {
    static constexpr bool PERM = false, AFTER_DRAIN = false;
    float* C; int ldc; const float* bias;
    __device__ __forceinline__ void operator()(const f32x4 (&acc)[2][2][4][2], const Unit& u, int wr, int wc, int fr, int fq) const {
        const int row0 = u.pm * BM + wr * 64 + fr, col0 = u.pn * BM + wc * 32 + 4 * fq;
        f32x4 bv[2][2];
#pragma unroll
        for (int bj = 0; bj < 2; ++bj)
#pragma unroll
            for (int n = 0; n < 2; ++n) bv[bj][n] = bias ? *(const f32x4*)(bias + col0 + bj * HALF + n * 16) : (f32x4){0.f, 0.f, 0.f, 0.f};
#pragma unroll
        for (int ai = 0; ai < 2; ++ai)
#pragma unroll
            for (int m = 0; m < 4; ++m) { float* rowp = C + (size_t)(row0 + ai * HALF + m * 16) * ldc + col0;
#pragma unroll
                for (int bj = 0; bj < 2; ++bj)
#pragma unroll
                    for (int n = 0; n < 2; ++n) *(f32x4*)(rowp + bj * HALF + n * 16) = acc[ai][bj][m][n] + bv[bj][n]; }
    }
};
template <int ACT  > struct EpiBf16 {
    static constexpr bool PERM = true, AFTER_DRAIN = false;
    bf16_t* O; int ldc; const float* bias; int split_cols; size_t split_stride;
    __device__ __forceinline__ void operator()(const f32x4 (&acc)[2][2][4][2], const Unit& u, int wr, int wc, int fr, int fq) const {
        const int row0 = u.pm * BM + wr * 64 + fr; int colt = u.pn * BM; bf16_t* base = O;
        if (split_cols) { const int t = colt / split_cols; base += (size_t)t * split_stride; colt -= t * split_cols; }
        const int col0 = colt + wc * 32 + 8 * fq, bcol0 = u.pn * BM + wc * 32 + 8 * fq;
        f32x4 bv[2][2];
#pragma unroll
        for (int bj = 0; bj < 2; ++bj)
#pragma unroll
            for (int n = 0; n < 2; ++n) bv[bj][n] = bias ? *(const f32x4*)(bias + bcol0 + bj * HALF + 4 * n) : (f32x4){0.f, 0.f, 0.f, 0.f};
#pragma unroll
        for (int ai = 0; ai < 2; ++ai)
#pragma unroll
            for (int m = 0; m < 4; ++m) { bf16_t* rowp = base + (size_t)(row0 + ai * HALF + m * 16) * ldc + col0;
#pragma unroll
                for (int bj = 0; bj < 2; ++bj) { f32x4 v0 = acc[ai][bj][m][0] + bv[bj][0], v1 = acc[ai][bj][m][1] + bv[bj][1];
                    if (ACT == 1) { f32x2 a = gelu_pk((f32x2){v0[0], v0[1]}), b = gelu_pk((f32x2){v0[2], v0[3]}), c = gelu_pk((f32x2){v1[0], v1[1]}), d = gelu_pk((f32x2){v1[2], v1[3]});
                        v0 = (f32x4){a.x, a.y, b.x, b.y}; v1 = (f32x4){c.x, c.y, d.x, d.y}; }
                    if (ACT == 2) {
#pragma unroll
                        for (int j = 0; j < 4; ++j) { v0[j] = 0.5f * v0[j] * (1.0f + erff(v0[j] * 0.70710678f)); v1[j] = 0.5f * v1[j] * (1.0f + erff(v1[j] * 0.70710678f)); } }
                    u32x4 w; w.x = cvt_pk_bf16(v0[0], v0[1]); w.y = cvt_pk_bf16(v0[2], v0[3]); w.z = cvt_pk_bf16(v1[0], v1[1]); w.w = cvt_pk_bf16(v1[2], v1[3]);
                    *(u32x4*)(rowp + bj * HALF) = w; } }
    }
};
template <class Epi, class Sched, bool STAMP = false>
__device__ __forceinline__ void gemm_phase(PG8_LAS unsigned char* lds, const Gemm g, const Sched& S, const Epi& E, unsigned long long* stamps) {
    const int tid = TIDX, wid = __builtin_amdgcn_readfirstlane(tid >> 6), lane = tid & 63, wr = wid >> 2, wc = wid & 3, fr = lane & 15, fq = lane >> 4;
    const int K = g.K, nt = K / BK;
    int ts_lo = 0, ts_hi = 0, nts = 0; const unsigned long long rt_entry = STAMP ? (unsigned long long)wall_clock64() : 0ull;
#define PG8_STAMP() do { if (STAMP && wid == 0 && nts < 64) { const unsigned long long _c = (unsigned long long)clock64(); \
        ts_lo = (lane == nts) ? (int)(unsigned)_c : ts_lo; ts_hi = (lane == nts) ? (int)(unsigned)(_c >> 32) : ts_hi; ++nts; } } while (0)
    PG8_STAMP();
    unsigned voffA[2], voffB[2];
#pragma unroll
    for (int i = 0; i < 2; ++i) { int R, C; stage_rc(tid * 16 + i * 8192, R, C); const int Rb = Epi::PERM ? ((R & ~31) + perm32(R & 31)) : R;
        const int Ra = g.ovl ? R - 2 * (R >> 6) : R; voffA[i] = (unsigned)(Ra * K + C) * 2u; voffB[i] = (unsigned)(Rb * K + C) * 2u; }
    const size_t kstep = (size_t)(BK * 2);
    const size_t hstep = (size_t)HALF * K * 2;
    const size_t tstep = 2 * hstep;
    const size_t hstepA = g.ovl ? (size_t)124 * K * 2 : hstep, tstepA = g.ovl ? (size_t)248 * K * 2 : tstep;
    const unsigned ldsw = (unsigned)wid * 1024u;
    const int aoff = lds_byte(wr * 64 + fr, fq * 8), boff = lds_byte(wc * 32 + fr, fq * 8);
#define PG8_SA(b, h) (((b) * 2 + (h)) * HTB)
#define PG8_SB(b, h) ((4 + (b) * 2 + (h)) * HTB)
#define PG8_STAGE(bufoff, gbase, voff) do { _Pragma("unroll") for (int _i = 0; _i < 2; ++_i) \
        __builtin_amdgcn_global_load_lds((const unsigned*)((const char*)(gbase) + (voff)[_i]), (PG8_LAS unsigned*)(lds + (bufoff) + ldsw + _i * 8192), 16, 0, 0); } while (0)
#define PG8_LDA(dst, b, h) do { _Pragma("unroll") for (int m = 0; m < 4; ++m) _Pragma("unroll") for (int k = 0; k < 2; ++k) dst[m][k] = *(const PG8_LAS bf16x8*)(lds + PG8_SA(b, h) + aoff + m * 2048 + k * 1024); } while (0)
#define PG8_LDB(dst, b, h) do { _Pragma("unroll") for (int n = 0; n < 2; ++n) _Pragma("unroll") for (int k = 0; k < 2; ++k) dst[n][k] = *(const PG8_LAS bf16x8*)(lds + PG8_SB(b, h) + boff + n * 2048 + k * 1024); } while (0)
#define PG8_MMA(ai, bj, At, Bt) do { __builtin_amdgcn_s_setprio(1); _Pragma("unroll") for (int m = 0; m < 4; ++m) _Pragma("unroll") for (int n = 0; n < 2; ++n) _Pragma("unroll") for (int k = 0; k < 2; ++k) \
        acc[ai][bj][m][n] = __builtin_amdgcn_mfma_f32_16x16x32_bf16(Bt[n][k], At[m][k], acc[ai][bj][m][n], 0, 0, 0); __builtin_amdgcn_s_setprio(0); } while (0)
#define PG8_WAIT_V(n) asm volatile("s_waitcnt vmcnt(" #n ")" ::: "memory")
#define PG8_WAIT_L(n) asm volatile("s_waitcnt lgkmcnt(" #n ")" ::: "memory")
#define PG8_BAR __builtin_amdgcn_s_barrier()
#define PG8_SCHED __builtin_amdgcn_sched_barrier(0)
    Unit cur, nxt; int ui = 0;
    if (!S.next(0, cur)) return;
    f32x4 acc[2][2][4][2];
#pragma unroll
    for (int a = 0; a < 2; ++a)
#pragma unroll
        for (int b = 0; b < 2; ++b)
#pragma unroll
            for (int m = 0; m < 4; ++m)
#pragma unroll
                for (int n = 0; n < 2; ++n) acc[a][b][m][n] = (f32x4){0.f, 0.f, 0.f, 0.f};
    bf16x8 At[4][2], B0[2][2], B1[2][2];
    const char* cA = (const char*)g.A + (size_t)cur.pm * tstepA; const char* cB = (const char*)g.Bt + (size_t)cur.pn * tstep;
    S.a_ready(cur);
    PG8_STAGE(PG8_SB(0, 0), cB, voffB); PG8_STAGE(PG8_SA(0, 0), cA, voffA); PG8_STAGE(PG8_SB(0, 1), cB + hstep, voffB); PG8_STAGE(PG8_SA(0, 1), cA + hstepA, voffA);
    if (wr == 1) PG8_BAR;
    PG8_WAIT_V(4); PG8_BAR;
    PG8_STAGE(PG8_SB(1, 0), cB + kstep, voffB); PG8_STAGE(PG8_SA(1, 0), cA + kstep, voffA); PG8_STAGE(PG8_SB(1, 1), cB + hstep + kstep, voffB);
    PG8_WAIT_V(6); PG8_BAR;
    PG8_STAMP();
    for (;;) {
        const bool has_next = S.next(ui + 1, nxt);
        const char* nA = has_next ? (const char*)g.A + (size_t)nxt.pm * tstepA : cA; const char* nB = has_next ? (const char*)g.Bt + (size_t)nxt.pn * tstep : cB;
        for (int t = 0; t < nt; t += 2) {
            const bool last = (t == nt - 2);
            const char* a1 = cA + (size_t)(t + 1) * kstep;
            const char* a2 = last ? nA : cA + (size_t)(t + 2) * kstep; const char* b2 = last ? nB : cB + (size_t)(t + 2) * kstep;
            const char* a3 = a2 + kstep; const char* b3 = b2 + kstep;
            if (last && has_next) S.a_ready(nxt);
            PG8_LDB(B0, 0, 0); PG8_SCHED; PG8_LDA(At, 0, 0); PG8_STAGE(PG8_SA(1, 1), a1 + hstepA, voffA);
            PG8_WAIT_L(8); PG8_BAR; PG8_WAIT_L(0); PG8_MMA(0, 0, At, B0); PG8_BAR; PG8_SCHED;
            PG8_LDB(B1, 0, 1); PG8_STAGE(PG8_SB(0, 0), b2, voffB);
            PG8_BAR; PG8_WAIT_L(0); PG8_MMA(0, 1, At, B1); PG8_BAR;
            PG8_LDA(At, 0, 1); PG8_STAGE(PG8_SA(0, 0), a2, voffA);
            PG8_BAR; PG8_WAIT_L(0); PG8_MMA(1, 0, At, B0); PG8_BAR; PG8_SCHED;
            PG8_STAGE(PG8_SB(0, 1), b2 + hstep, voffB);
            PG8_WAIT_V(6); PG8_BAR; PG8_MMA(1, 1, At, B1); PG8_BAR;
            PG8_LDB(B0, 1, 0); PG8_SCHED; PG8_LDA(At, 1, 0); PG8_STAGE(PG8_SA(0, 1), a2 + hstepA, voffA);
            PG8_WAIT_L(8); PG8_BAR; PG8_WAIT_L(0); PG8_MMA(0, 0, At, B0); PG8_BAR; PG8_SCHED;
            PG8_LDB(B1, 1, 1); PG8_STAGE(PG8_SB(1, 0), b3, voffB);
            PG8_BAR; PG8_WAIT_L(0); PG8_MMA(0, 1, At, B1); PG8_BAR;
            PG8_LDA(At, 1, 1); PG8_STAGE(PG8_SA(1, 0), a3, voffA);
            PG8_BAR; PG8_WAIT_L(0); PG8_MMA(1, 0, At, B0); PG8_BAR; PG8_SCHED;
            PG8_STAGE(PG8_SB(1, 1), b3 + hstep, voffB);
            PG8_WAIT_V(6); PG8_BAR; PG8_MMA(1, 1, At, B1); PG8_BAR;
        }
        PG8_STAMP();
        if constexpr (!Epi::AFTER_DRAIN) { E(acc, cur, wr, wc, fr, fq); S.done(cur); }
        PG8_STAMP();
        if (!has_next) break;
#pragma unroll
        for (int a = 0; a < 2; ++a)
#pragma unroll
            for (int b = 0; b < 2; ++b)
#pragma unroll
                for (int m = 0; m < 4; ++m)
#pragma unroll
                    for (int n = 0; n < 2; ++n) acc[a][b][m][n] = (f32x4){0.f, 0.f, 0.f, 0.f};
        cur = nxt; cA = nA; cB = nB; ++ui;
    }
    PG8_WAIT_V(0);
    if (wr == 0) PG8_BAR;
    PG8_BAR;
    if constexpr (Epi::AFTER_DRAIN) { E.fused(acc, cur, wr, wc, fr, fq, lds, wid, lane); S.done(cur); }
    PG8_STAMP();
    if (STAMP && wid == 0) { stamps[lane] = lane < nts ? (((unsigned long long)(unsigned)ts_hi << 32) | (unsigned)ts_lo) : 0ull;
        if (lane == 62) stamps[62] = rt_entry; if (lane == 63) stamps[63] = (unsigned long long)wall_clock64(); }
#undef PG8_STAMP
#undef PG8_SA
#undef PG8_SB
#undef PG8_STAGE
#undef PG8_LDA
#undef PG8_LDB
#undef PG8_MMA
#undef PG8_WAIT_V
#undef PG8_WAIT_L
#undef PG8_BAR
#undef PG8_SCHED
}
}
typedef unsigned short bf16_t;
constexpr int T_TOK = 32768, DM = 1024, D_IN = 4096, D_HY = 512, D_HG = 512, DFF = 4096, NLAYER = 4;
constexpr int L_BIG = 16384, L_SML = 4096;
constexpr int APAD = 256;
constexpr size_t MiB = 1024ull * 1024ull;
constexpr size_t OFF_W = 0;
constexpr size_t OFF_W_IN = OFF_W, OFF_W_OUT = OFF_W + 8 * MiB, OFF_W_UP = OFF_W + 10 * MiB, OFF_W_DN = OFF_W + 26 * MiB;
constexpr size_t OFF_ABUF = 34 * MiB;
constexpr size_t OFF_R1 = 99 * MiB;
constexpr size_t OFF_HYRAW = OFF_R1;
constexpr size_t OFF_HG = OFF_R1 + 96 * MiB;
constexpr size_t OFF_KT = OFF_R1;
constexpr size_t OFF_ACT = OFF_R1;
constexpr size_t OFF_R2 = 355 * MiB;
constexpr size_t OFF_X0T = OFF_R2, OFF_ZT = OFF_R2 + 32 * MiB;
constexpr size_t OFF_MIX = OFF_R2;
constexpr size_t OFF_UPART = OFF_R2;
constexpr size_t OFF_R6 = 419 * MiB;
constexpr size_t OFF_OBUF = OFF_R6;
constexpr size_t OFF_KS = OFF_R6;
constexpr size_t OFF_SMALL = 483 * MiB;
constexpr size_t OFF_BAR = OFF_SMALL + 4 * MiB;
constexpr size_t WS_NEED = 488 * MiB;

struct P { const float* in[26]; float* out; unsigned char* ws; };
constexpr int PB_norm_mix_pre = 0;
constexpr int PB_norm_mix_post = 4096;
constexpr int PB_norm_ffn_pre = 8192;
constexpr int PB_norm_ffn_post = 12288;
constexpr int PB_hy_conv_w = 16384;
constexpr int PB_hy_conv_b = 34816;
constexpr int PB_f_w1 = 40960;
constexpr int PB_f_b1 = 49408;
constexpr int PB_f_w2 = 49664;
constexpr int PB_f_b2 = 66048;
constexpr int PB_f_w3 = 66304;
constexpr int PB_f_b3 = 82688;
constexpr int PB_f_w4 = 82944;
constexpr int PB_f_freq = 345088;
constexpr int PB_hy_skip = 345344;
constexpr int PB_hy_out_norm = 347392;
constexpr int PB_lb_table = 349440;
constexpr int PB_hg_out_norm = 353536;
constexpr int PB_ffn_conv_w = 355584;
constexpr int PB_ffn_conv_b = 453888;
constexpr int PB_TOTAL = 486656;
constexpr size_t OFF_PB = OFF_SMALL + 512 * 1024;
#define PRM(p, NAME) ((const float*)((p).ws + OFF_PB) + PB_##NAME)

__device__ __forceinline__ float bf2f(bf16_t b) { return __uint_as_float(((unsigned)b) << 16); }
__device__ __forceinline__ bf16_t f2bf(float f) { unsigned u = __float_as_uint(f); u += 0x7FFFu + ((u >> 16) & 1u); return (bf16_t)(u >> 16); }
__device__ __forceinline__ unsigned pack_bf2(float lo, float hi) { return (unsigned)f2bf(lo) | ((unsigned)f2bf(hi) << 16); }
__device__ __forceinline__ bool seq_start(int t) { return t < L_BIG ? (t == 0) : ((t & (L_SML - 1)) == 0); }
__device__ __forceinline__ bool seq_end(int t) { return (t + 1 == T_TOK) || seq_start(t + 1); }
__device__ __forceinline__ const float* x_src_row(const P& p, int l, int t) {
    if (l > 0) return p.out + (size_t)t * DM;
    return t < L_BIG ? p.in[0] + (size_t)t * DM : p.in[1] + (size_t)(t - L_BIG) * DM;
}
__device__ __forceinline__ float silu_f(float x) { return x / (1.0f + __expf(-x)); }
__device__ __forceinline__ float wave_sum(float v) {
#pragma unroll
    for (int o = 32; o >= 1; o >>= 1) v += __shfl_xor(v, o);
    return v;
}

struct EpiBf16Split {
    static constexpr bool PERM = true, AFTER_DRAIN = false, OVL = false;
    bf16_t* O0; int ldc0; bf16_t* O1; int ldc1; int csplit;
    __device__ __forceinline__ void operator()(const pg8::f32x4 (&acc)[2][2][4][2], const pg8::Unit& u, int wr, int wc, int fr, int fq) const {
        const int row0 = u.pm * pg8::BM + wr * 64 + fr; int colt = u.pn * pg8::BM; bf16_t* base = O0; int ldc = ldc0;
        if (colt >= csplit) { base = O1; ldc = ldc1; colt -= csplit; }
        const int col0 = colt + wc * 32 + 8 * fq;
#pragma unroll
        for (int ai = 0; ai < 2; ++ai)
#pragma unroll
            for (int m = 0; m < 4; ++m) { bf16_t* rowp = base + (size_t)(row0 + ai * pg8::HALF + m * 16) * ldc + col0;
#pragma unroll
                for (int bj = 0; bj < 2; ++bj) { const pg8::f32x4 v0 = acc[ai][bj][m][0], v1 = acc[ai][bj][m][1];
                    pg8::u32x4 w; w.x = pg8::cvt_pk_bf16(v0[0], v0[1]); w.y = pg8::cvt_pk_bf16(v0[2], v0[3]); w.z = pg8::cvt_pk_bf16(v1[0], v1[1]); w.w = pg8::cvt_pk_bf16(v1[2], v1[3]);
                    *(pg8::u32x4*)(rowp + bj * pg8::HALF) = w; } }
    }
};
__device__ __forceinline__ float dpp_ror1(float v) { return __int_as_float(__builtin_amdgcn_update_dpp(0, __float_as_int(v), 0x121, 0xF, 0xF, false)); }
__device__ __forceinline__ float dpp_ror15(float v) { return __int_as_float(__builtin_amdgcn_update_dpp(0, __float_as_int(v), 0x12F, 0xF, 0xF, false)); }
__device__ __forceinline__ float gelu_tanh_e(float x) { const float y = 1.5957691216057308f * (x + 0.044715f * x * x * x); return x * __builtin_amdgcn_rcpf(1.0f + __expf(-y)); }
struct EpiGeglu {
    static constexpr bool PERM = true, AFTER_DRAIN = false, OVL = true;
    bf16_t* act; const float* cw; const float* cb;
    __device__ __forceinline__ void operator()(const pg8::f32x4 (&acc)[2][2][4][2], const pg8::Unit& u, int wr, int wc, int fr, int fq) const {
        const int j0 = u.pn * 128 + wc * 32 + 8 * fq;
        unsigned mprev = 0, mnext = 0, mst = 0;
#pragma unroll
        for (int ai = 0; ai < 2; ++ai)
#pragma unroll
            for (int m = 0; m < 4; ++m) { const int q = 16 * m + fr, tok = u.pm * 248 + 124 * ai + 62 * wr + q - 1, b = ai * 4 + m;
                const bool st = q >= 1 && q <= 62 && tok < T_TOK;
                if (st) { mst |= 1u << b; if (!seq_start(tok)) mprev |= 1u << b; if (!seq_end(tok)) mnext |= 1u << b; } }
#pragma unroll
        for (int n = 0; n < 2; ++n) {
            const int jc = j0 + 4 * n;
            const pg8::f32x4 wa0 = *(const pg8::f32x4*)(cw + jc), wa1 = *(const pg8::f32x4*)(cw + 8192 + jc), wa2 = *(const pg8::f32x4*)(cw + 16384 + jc), ba = *(const pg8::f32x4*)(cb + jc);
            const pg8::f32x4 wb0 = *(const pg8::f32x4*)(cw + 4096 + jc), wb1 = *(const pg8::f32x4*)(cw + 8192 + 4096 + jc), wb2 = *(const pg8::f32x4*)(cw + 16384 + 4096 + jc), bb = *(const pg8::f32x4*)(cb + 4096 + jc);
#pragma unroll
            for (int ai = 0; ai < 2; ++ai) {
                pg8::f32x4 pa_prev, pb_prev, na_cur, nb_cur;
#pragma unroll
                for (int i = 0; i < 4; ++i) { na_cur[i] = dpp_ror15(acc[ai][0][0][n][i]); nb_cur[i] = dpp_ror15(acc[ai][1][0][n][i]); pa_prev[i] = 0.f; pb_prev[i] = 0.f; }
#pragma unroll
                for (int m = 0; m < 4; ++m) {
                    const int b = ai * 4 + m, q = 16 * m + fr, tok = u.pm * 248 + 124 * ai + 62 * wr + q - 1;
                    const bool hp = (mprev >> b) & 1u, hn = (mnext >> b) & 1u;
                    pg8::f32x4 pa_cur, pb_cur, na_next, nb_next;
#pragma unroll
                    for (int i = 0; i < 4; ++i) { pa_cur[i] = dpp_ror1(acc[ai][0][m][n][i]); pb_cur[i] = dpp_ror1(acc[ai][1][m][n][i]);
                        na_next[i] = m < 3 ? dpp_ror15(acc[ai][0][m < 3 ? m + 1 : 3][n][i]) : 0.f; nb_next[i] = m < 3 ? dpp_ror15(acc[ai][1][m < 3 ? m + 1 : 3][n][i]) : 0.f; }
                    const pg8::f32x4 xpa = (fr == 0) ? pa_prev : pa_cur, xna = (fr == 15) ? na_next : na_cur;
                    const pg8::f32x4 xpb = (fr == 0) ? pb_prev : pb_cur, xnb = (fr == 15) ? nb_next : nb_cur;
                    const pg8::f32x4 xa = acc[ai][0][m][n], xb = acc[ai][1][m][n];
                    float o[4];
#pragma unroll
                    for (int i = 0; i < 4; ++i) {
                        const float ya = (hp ? xpa[i] * wa0[i] : 0.f) + xa[i] * wa1[i] + (hn ? xna[i] * wa2[i] : 0.f) + ba[i];
                        const float yb = (hp ? xpb[i] * wb0[i] : 0.f) + xb[i] * wb1[i] + (hn ? xnb[i] * wb2[i] : 0.f) + bb[i];
                        o[i] = gelu_tanh_e(ya) * yb;
                    }
                    if ((mst >> b) & 1u) { uint2 w; w.x = pg8::cvt_pk_bf16(o[0], o[1]); w.y = pg8::cvt_pk_bf16(o[2], o[3]); *(uint2*)(act + (size_t)tok * DFF + jc) = w; }
                    pa_prev = pa_cur; pb_prev = pb_cur; na_cur = na_next; nb_cur = nb_next;
                }
            }
        }
    }
};
template <class Epi>
__device__ __forceinline__ void run_gemm(LAS unsigned char* lds, const bf16_t* A, const bf16_t* Bt, int M, int N, int K, const Epi& E) {
    pg8::Gemm g; g.A = A; g.Bt = Bt; g.M = M; g.N = N; g.K = K; g.ovl = Epi::OVL ? 1 : 0;
    int gx = (int)gridDim.x, bx = (int)blockIdx.x; asm volatile("" : "+s"(gx), "+s"(bx));
    pg8::StaticOrder S; S.init(M, N, gx, bx);
    pg8::gemm_phase<Epi, pg8::StaticOrder, false>((PG8_LAS unsigned char*)lds, g, S, E, nullptr);
}

#define HD_INLINE __device__ __forceinline__
#define DEV_FN __device__ __forceinline__
#define LDS_F2 LAS cf2*
#define NTHR 512
#define FOR_TID for (int tid = (int)TIDX, once_ = 1; once_; once_ = 0)
#define SYNC __syncthreads()
#define BREV32(x) __brev(x)
#define CIS_REV(fr, c, s) do { const float f_ = (fr); c = __builtin_amdgcn_cosf(f_); s = __builtin_amdgcn_sinf(f_); } while (0)
HD_INLINE unsigned rev4(unsigned k, int S) {
    unsigned v = BREV32(k) >> (32 - 2 * S);
    return ((v & 0xAAAAAAAAu) >> 1) | ((v & 0x55555555u) << 1);
}
HD_INLINE cf2 mkf2(float a, float b) { cf2 r; r.x = a; r.y = b; return r; }
HD_INLINE cf2 cmul(cf2 a, cf2 b) { return mkf2(a.x * b.x - a.y * b.y, a.x * b.y + a.y * b.x); }
HD_INLINE cf2 cmulc(cf2 a, cf2 b) { return mkf2(a.x * b.x + a.y * b.y, a.y * b.x - a.x * b.y); }

DEV_FN void fft_fwd(LDS_F2 X, int S, int s0) {
    const int M = 1 << (2 * S);
    for (int s = s0; s < S; ++s) {
        const int n = M >> (2 * s), q = n >> 2;
        const float invn = 1.0f / (float)n;
        FOR_TID {
            for (int b = tid; b < (M >> 2); b += NTHR) {
                const int j = b & (q - 1), base = ((b - j) << 2) + j;
                const cf2 a0 = X[base], a1 = X[base + q], a2 = X[base + 2 * q], a3 = X[base + 3 * q];
                const cf2 t0 = mkf2(a0.x + a2.x, a0.y + a2.y), t1 = mkf2(a0.x - a2.x, a0.y - a2.y);
                const cf2 t2 = mkf2(a1.x + a3.x, a1.y + a3.y);
                const cf2 d13 = mkf2(a1.x - a3.x, a1.y - a3.y);
                const cf2 t3 = mkf2(d13.y, -d13.x);
                const cf2 y0 = mkf2(t0.x + t2.x, t0.y + t2.y);
                cf2 y1 = mkf2(t1.x + t3.x, t1.y + t3.y);
                cf2 y2 = mkf2(t0.x - t2.x, t0.y - t2.y);
                cf2 y3 = mkf2(t1.x - t3.x, t1.y - t3.y);
                if (q > 1) {
                    const float fr = (float)j * invn;
                    float c1, s1, c2, s2, c3, s3;
                    CIS_REV(fr, c1, s1); CIS_REV(2.0f * fr, c2, s2); CIS_REV(3.0f * fr, c3, s3);
                    y1 = cmul(y1, mkf2(c1, -s1)); y2 = cmul(y2, mkf2(c2, -s2)); y3 = cmul(y3, mkf2(c3, -s3));
                }
                X[base] = y0; X[base + q] = y1; X[base + 2 * q] = y2; X[base + 3 * q] = y3;
            }
        }
        SYNC;
    }
}
DEV_FN void fft_inv(LDS_F2 X, int S) {
    const int M = 1 << (2 * S);
    for (int s = S - 1; s >= 0; --s) {
        const int n = M >> (2 * s), q = n >> 2;
        const float invn = 1.0f / (float)n;
        FOR_TID {
            for (int b = tid; b < (M >> 2); b += NTHR) {
                const int j = b & (q - 1), base = ((b - j) << 2) + j;
                cf2 b0 = X[base], b1 = X[base + q], b2 = X[base + 2 * q], b3 = X[base + 3 * q];
                if (q > 1) {
                    const float fr = (float)j * invn;
                    float c1, s1, c2, s2, c3, s3;
                    CIS_REV(fr, c1, s1); CIS_REV(2.0f * fr, c2, s2); CIS_REV(3.0f * fr, c3, s3);
                    b1 = cmul(b1, mkf2(c1, s1)); b2 = cmul(b2, mkf2(c2, s2)); b3 = cmul(b3, mkf2(c3, s3));
                }
                const cf2 t0 = mkf2(b0.x + b2.x, b0.y + b2.y), t1 = mkf2(b0.x - b2.x, b0.y - b2.y);
                const cf2 t2 = mkf2(b1.x + b3.x, b1.y + b3.y);
                const cf2 d13 = mkf2(b1.x - b3.x, b1.y - b3.y);
                const cf2 t3 = mkf2(-d13.y, d13.x);
                X[base] = mkf2(t0.x + t2.x, t0.y + t2.y);
                X[base + q] = mkf2(t1.x + t3.x, t1.y + t3.y);
                X[base + 2 * q] = mkf2(t0.x - t2.x, t0.y - t2.y);
                X[base + 3 * q] = mkf2(t1.x - t3.x, t1.y - t3.y);
            }
        }
        SYNC;
    }
}
DEV_FN void spec_store(LDS_F2 X, int S, cf2* Ks) {
    const int M = 1 << (2 * S);
    FOR_TID {
        for (int k = tid; k <= (M >> 1); k += NTHR) {
            if (k == 0) { const cf2 c0 = X[0]; Ks[0] = mkf2(c0.x + c0.y, c0.x - c0.y); }
            else {
                const cf2 ck = X[rev4((unsigned)k, S)], cm = X[rev4((unsigned)(M - k), S)];
                const cf2 P = mkf2(0.5f * (ck.x + cm.x), 0.5f * (ck.y - cm.y));
                const cf2 O = mkf2(0.5f * (ck.y + cm.y), -0.5f * (ck.x - cm.x));
                float c, s; CIS_REV((float)k / (float)(2 * M), c, s);
                const cf2 Q = cmul(O, mkf2(c, -s));
                Ks[k] = mkf2(P.x + Q.x, P.y + Q.y);
                Ks[M - k] = mkf2(P.x - Q.x, -(P.y - Q.y));
            }
        }
    }
    SYNC;
}
DEV_FN void spec_mul(LDS_F2 X, int S, const cf2* Ks) {
    const int M = 1 << (2 * S);
    FOR_TID {
        for (int k = tid; k <= (M >> 1); k += NTHR) {
            if (k == 0) {
                const cf2 c0 = X[0], k0 = Ks[0];
                const float y0 = (c0.x + c0.y) * k0.x, ym = (c0.x - c0.y) * k0.y;
                X[0] = mkf2(0.5f * (y0 + ym), 0.5f * (y0 - ym));
            } else {
                const unsigned pk = rev4((unsigned)k, S), pm = rev4((unsigned)(M - k), S);
                const cf2 ck = X[pk], cm = X[pm];
                const cf2 P = mkf2(0.5f * (ck.x + cm.x), 0.5f * (ck.y - cm.y));
                const cf2 O = mkf2(0.5f * (ck.y + cm.y), -0.5f * (ck.x - cm.x));
                float c, s; CIS_REV((float)k / (float)(2 * M), c, s);
                const cf2 Wk = mkf2(c, -s);
                const cf2 Q = cmul(O, Wk);
                const cf2 xk = mkf2(P.x + Q.x, P.y + Q.y), xm = mkf2(P.x - Q.x, -(P.y - Q.y));
                const cf2 yk = cmul(xk, Ks[k]), ym = cmul(xm, Ks[M - k]);
                const cf2 Ye = mkf2(0.5f * (yk.x + ym.x), 0.5f * (yk.y - ym.y));
                const cf2 Yd = mkf2(0.5f * (yk.x - ym.x), 0.5f * (yk.y + ym.y));
                const cf2 Yo = cmulc(Yd, Wk);
                X[pk] = mkf2(Ye.x - Yo.y, Ye.y + Yo.x);
                if (k != (M >> 1)) X[pm] = mkf2(Ye.x + Yo.y, -Ye.y + Yo.x);
            }
        }
    }
    SYNC;
}
__device__ void ph_setup(const P& p) {
    const int gid = blockIdx.x * 512 + TIDX;
    if (gid < 2 * D_HG) {
        const int dir = gid / D_HG, c = gid % D_HG;
        float v[NLAYER], mx = -1e30f;
#pragma unroll
        for (int l = 0; l < NLAYER; ++l) { v[l] = p.in[19][(size_t)(dir * NLAYER + l) * D_HG + c]; mx = fmaxf(mx, v[l]); }
        float s = 0.f;
#pragma unroll
        for (int l = 0; l < NLAYER; ++l) { v[l] = expf(v[l] - mx); s += v[l]; }
        float* lbs = (float*)(p.ws + OFF_SMALL);
        float cum = 0.f;
#pragma unroll
        for (int l = 0; l < NLAYER; ++l) { if (l > 0) cum += v[l] / s; lbs[(size_t)(dir * NLAYER + l) * D_HG + c] = cum; }
    }
}
__device__ void ph_copy_params(const P& p) {
    float* pb = (float*)(p.ws + OFF_PB);
    const int g = blockIdx.x * 512 + TIDX, gs = gridDim.x * 512;
    for (int k = g; k < 4096; k += gs) pb[0 + k] = p.in[2][k];
    for (int k = g; k < 4096; k += gs) pb[4096 + k] = p.in[3][k];
    for (int k = g; k < 4096; k += gs) pb[8192 + k] = p.in[4][k];
    for (int k = g; k < 4096; k += gs) pb[12288 + k] = p.in[5][k];
    for (int k = g; k < 18432; k += gs) pb[16384 + k] = p.in[7][k];
    for (int k = g; k < 6144; k += gs) pb[34816 + k] = p.in[8][k];
    for (int k = g; k < 8448; k += gs) pb[40960 + k] = p.in[9][k];
    for (int k = g; k < 256; k += gs) pb[49408 + k] = p.in[10][k];
    for (int k = g; k < 16384; k += gs) pb[49664 + k] = p.in[11][k];
    for (int k = g; k < 256; k += gs) pb[66048 + k] = p.in[12][k];
    for (int k = g; k < 16384; k += gs) pb[66304 + k] = p.in[13][k];
    for (int k = g; k < 256; k += gs) pb[82688 + k] = p.in[14][k];
    for (int k = g; k < 262144; k += gs) pb[82944 + k] = p.in[15][k];
    for (int k = g; k < 256; k += gs) pb[345088 + k] = p.in[16][k];
    for (int k = g; k < 2048; k += gs) pb[345344 + k] = p.in[17][k];
    for (int k = g; k < 2048; k += gs) pb[347392 + k] = p.in[18][k];
    for (int k = g; k < 4096; k += gs) pb[349440 + k] = p.in[19][k];
    for (int k = g; k < 2048; k += gs) pb[353536 + k] = p.in[20][k];
    for (int k = g; k < 98304; k += gs) pb[355584 + k] = p.in[23][k];
    for (int k = g; k < 32768; k += gs) pb[453888 + k] = p.in[24][k];
}
__device__ void convert_one(const float* src, bf16_t* dst, int K, int N, LAS float* tile  , bool geglu_perm = false) {
    const int tiles_n = N / 64, ntiles = (K / 64) * tiles_n, tid = TIDX;
    for (int it = blockIdx.x; it < ntiles; it += gridDim.x) {
        const int k0 = (it / tiles_n) * 64, n0 = (it % tiles_n) * 64;
#pragma unroll
        for (int i = 0; i < 8; ++i) { const int r = (tid >> 6) + 8 * i, c = tid & 63; tile[r * 65 + c] = src[(size_t)(k0 + r) * N + n0 + c]; }
        __syncthreads();
#pragma unroll
        for (int i = 0; i < 8; ++i) { const int n = (tid >> 6) + 8 * i, k = tid & 63; int nr = n0 + n;
            if (geglu_perm) nr = nr < DFF ? (nr >> 7) * 256 + (nr & 127) : ((nr - DFF) >> 7) * 256 + 128 + ((nr - DFF) & 127);
            dst[(size_t)nr * K + k0 + k] = f2bf(tile[k * 65 + n]); }
        __syncthreads();
    }
}
__device__ void ph_convert_w(const P& p, int l, LAS unsigned char* lds) {
    LAS float* tile = (LAS float*)lds;
    convert_one(p.in[6] + (size_t)l * DM * D_IN, (bf16_t*)(p.ws + OFF_W_IN), DM, D_IN, tile);
    convert_one(p.in[21] + (size_t)l * DM * DM, (bf16_t*)(p.ws + OFF_W_OUT), DM, DM, tile);
    convert_one(p.in[22] + (size_t)l * DM * 2 * DFF, (bf16_t*)(p.ws + OFF_W_UP), DM, 2 * DFF, tile, true);
    convert_one(p.in[25] + (size_t)l * DFF * DM, (bf16_t*)(p.ws + OFF_W_DN), DFF, DM, tile);
}
__device__ __forceinline__ bf16_t* abuf_row(const P& p, int t) { return (bf16_t*)(p.ws + OFF_ABUF) + (size_t)(t + APAD) * DM; }
__device__ void ph_rmsnorm_in(const P& p, int l) {
    const int lane = TIDX & 63, wv = TIDX >> 6;
    const float* gain = p.in[2] + (size_t)l * DM;
    for (int t = blockIdx.x * 8 + wv; t < T_TOK; t += gridDim.x * 8) {
        const float* xr = x_src_row(p, l, t);
        float4 v[4]; float ss = 0.f;
#pragma unroll
        for (int i = 0; i < 4; ++i) { v[i] = *(const float4*)(xr + lane * 4 + 256 * i); ss += v[i].x * v[i].x + v[i].y * v[i].y + v[i].z * v[i].z + v[i].w * v[i].w; }
        ss = wave_sum(ss);
        const float r = rsqrtf(ss * (1.0f / DM) + 1e-6f);
        bf16_t* hr = abuf_row(p, t);
#pragma unroll
        for (int i = 0; i < 4; ++i) { const float4 g = *(const float4*)(gain + lane * 4 + 256 * i);
            uint2 w; w.x = pack_bf2(v[i].x * r * g.x, v[i].y * r * g.y); w.y = pack_bf2(v[i].z * r * g.z, v[i].w * r * g.w);
            *(uint2*)(hr + lane * 4 + 256 * i) = w; }
    }
}
__device__ void ph_norm_resid(const P& p, int l, int which) {
    const int lane = TIDX & 63, wv = TIDX >> 6;
    const float* gpost = (which == 0 ? PRM(p, norm_mix_post) : PRM(p, norm_ffn_post)) + (size_t)l * DM;
    const bool has_next = (which == 0) || (l + 1 < NLAYER);
    const float* gnext = which == 0 ? PRM(p, norm_ffn_pre) + (size_t)l * DM : PRM(p, norm_mix_pre) + (size_t)(has_next ? l + 1 : l) * DM;
    const bf16_t* Y = (const bf16_t*)(p.ws + OFF_MIX);
    const int lx = which == 0 ? l : 1;
    for (int t = blockIdx.x * 8 + wv; t < T_TOK; t += gridDim.x * 8) {
        const float* xr = x_src_row(p, lx, t);
        const bf16_t* yr = Y + (size_t)t * DM;
        float4 x[4], y[4]; float ss = 0.f;
#pragma unroll
        for (int i = 0; i < 4; ++i) { x[i] = *(const float4*)(xr + lane * 4 + 256 * i); const uint2 w = *(const uint2*)(yr + lane * 4 + 256 * i);
            y[i].x = __uint_as_float(w.x << 16); y[i].y = __uint_as_float(w.x & 0xffff0000u); y[i].z = __uint_as_float(w.y << 16); y[i].w = __uint_as_float(w.y & 0xffff0000u);
            ss += y[i].x * y[i].x + y[i].y * y[i].y + y[i].z * y[i].z + y[i].w * y[i].w; }
        ss = wave_sum(ss);
        const float r = rsqrtf(ss * (1.0f / DM) + 1e-6f);
        float s2 = 0.f;
#pragma unroll
        for (int i = 0; i < 4; ++i) { const float4 g = *(const float4*)(gpost + lane * 4 + 256 * i);
            x[i].x += y[i].x * r * g.x; x[i].y += y[i].y * r * g.y; x[i].z += y[i].z * r * g.z; x[i].w += y[i].w * r * g.w;
            s2 += x[i].x * x[i].x + x[i].y * x[i].y + x[i].z * x[i].z + x[i].w * x[i].w;
            *(float4*)(p.out + (size_t)t * DM + lane * 4 + 256 * i) = x[i]; }
        if (has_next) {
            s2 = wave_sum(s2);
            const float r2 = rsqrtf(s2 * (1.0f / DM) + 1e-6f);
            bf16_t* hr = abuf_row(p, t);
#pragma unroll
            for (int i = 0; i < 4; ++i) { const float4 g = *(const float4*)(gnext + lane * 4 + 256 * i);
                uint2 w; w.x = pack_bf2(x[i].x * r2 * g.x, x[i].y * r2 * g.y); w.y = pack_bf2(x[i].z * r2 * g.z, x[i].w * r2 * g.w);
                *(uint2*)(hr + lane * 4 + 256 * i) = w; }
        }
    }
}
__device__ void ph_filter(const P& p, int l, LAS unsigned char* lds) {
    LAS float* feats = (LAS float*)lds;
    LAS float* ha = feats + 16 * 36;
    LAS float* hb = ha + 16 * 64;
    LAS float* w1s = hb + 16 * 64;
    LAS float* w2s = w1s + 33 * 64;
    LAS float* w3s = w2s + 64 * 64;
    const int tid = TIDX;
    const float* w1 = PRM(p, f_w1) + (size_t)l * 33 * 64; const float* b1 = PRM(p, f_b1) + (size_t)l * 64;
    const float* w2 = PRM(p, f_w2) + (size_t)l * 64 * 64; const float* b2 = PRM(p, f_b2) + (size_t)l * 64;
    const float* w3 = PRM(p, f_w3) + (size_t)l * 64 * 64; const float* b3 = PRM(p, f_b3) + (size_t)l * 64;
    const float* w4 = PRM(p, f_w4) + (size_t)l * 64 * 1024; const float* fq = PRM(p, f_freq) + (size_t)l * 64;
    float* kt = (float*)(p.ws + OFF_KT);
    for (int i = tid; i < 33 * 64; i += 512) w1s[i] = w1[i];
    for (int i = tid; i < 64 * 64; i += 512) { w2s[i] = w2[i]; w3s[i] = w3[i]; }
    const int j = tid & 63;
    const float fqj = fq[j], b1j = b1[j], b2j = b2[j], b3j = b3[j];
    __syncthreads();
    const int nitems = (L_BIG + L_SML) / 16;
    for (int it = blockIdx.x; it < nitems; it += gridDim.x) {
        const bool big = it < L_BIG / 16; const int L = big ? L_BIG : L_SML; const int pos0 = (big ? it : it - L_BIG / 16) * 16;
        float* ktc = kt + (big ? 0 : (size_t)512 * 2 * L_BIG);
        for (int idx = tid; idx < 16 * 33; idx += 512) {
            const int pp = idx / 33, f = idx % 33; const int pos = pos0 + pp;
            const float tt = (float)pos / (float)(L - 1), ang = (6.283185307179586f / (float)L) * (float)pos;
            float v;
            if (f == 0) v = tt;
            else { const int bi = (f - 1) & 15; const float band = 1e-4f + (float)bi * ((15.0f - 1e-4f) / 15.0f); v = f <= 16 ? cosf(band * ang) : -sinf(band * ang); }
            feats[pp * 36 + f] = v;
        }
        __syncthreads();
#pragma unroll
        for (int h2 = 0; h2 < 2; ++h2) { const int pp = (tid >> 6) + 8 * h2; float a = b1j;
            for (int f = 0; f < 33; ++f) a += feats[pp * 36 + f] * w1s[f * 64 + j];
            ha[pp * 64 + j] = __sinf(fqj * a); }
        __syncthreads();
#pragma unroll
        for (int h2 = 0; h2 < 2; ++h2) { const int pp = (tid >> 6) + 8 * h2; float a = b2j;
#pragma unroll 4
            for (int f4 = 0; f4 < 16; ++f4) { const nf4 hv = *(const LAS nf4*)(ha + pp * 64 + 4 * f4);
                a += hv.x * w2s[(4 * f4) * 64 + j] + hv.y * w2s[(4 * f4 + 1) * 64 + j] + hv.z * w2s[(4 * f4 + 2) * 64 + j] + hv.w * w2s[(4 * f4 + 3) * 64 + j]; }
            hb[pp * 64 + j] = __sinf(fqj * a); }
        __syncthreads();
#pragma unroll
        for (int h2 = 0; h2 < 2; ++h2) { const int pp = (tid >> 6) + 8 * h2; float a = b3j;
#pragma unroll 4
            for (int f4 = 0; f4 < 16; ++f4) { const nf4 hv = *(const LAS nf4*)(hb + pp * 64 + 4 * f4);
                a += hv.x * w3s[(4 * f4) * 64 + j] + hv.y * w3s[(4 * f4 + 1) * 64 + j] + hv.z * w3s[(4 * f4 + 2) * 64 + j] + hv.w * w3s[(4 * f4 + 3) * 64 + j]; }
            ha[pp * 64 + j] = __sinf(fqj * a); }
        __syncthreads();
        {
            float acc0[16], acc1[16];
#pragma unroll
            for (int pp = 0; pp < 16; ++pp) { acc0[pp] = 0.f; acc1[pp] = 0.f; }
            const float* w4p = w4 + 2 * tid;
#pragma unroll 2
            for (int f4 = 0; f4 < 16; ++f4) {
                const cf2 wa = *(const cf2*)(w4p + (4 * f4) * 1024), wb = *(const cf2*)(w4p + (4 * f4 + 1) * 1024), wc = *(const cf2*)(w4p + (4 * f4 + 2) * 1024), wd = *(const cf2*)(w4p + (4 * f4 + 3) * 1024);
#pragma unroll
                for (int pp = 0; pp < 16; ++pp) { const nf4 hv = *(const LAS nf4*)(ha + pp * 64 + 4 * f4);
                    acc0[pp] += hv.x * wa.x + hv.y * wb.x + hv.z * wc.x + hv.w * wd.x;
                    acc1[pp] += hv.x * wa.y + hv.y * wb.y + hv.z * wc.y + hv.w * wd.y; }
            }
            const int o = 2 * tid, dir = o >> 9, c = o & 511;
            const float dstep = (15.350567286626972f - 3.0701134573253945f) / 511.0f;
            const float d0 = 3.0701134573253945f + (float)c * dstep, d1 = d0 + dstep;
            float* dst0 = ktc + (size_t)(c * 2 + dir) * L + pos0; float* dst1 = dst0 + 2 * (size_t)L;
            const float invl = 1.0f / (float)(L - 1);
#pragma unroll
            for (int g = 0; g < 4; ++g) { nf4 v0, v1;
#pragma unroll
                for (int i = 0; i < 4; ++i) { const float tt = (float)(pos0 + 4 * g + i) * invl; v0[i] = acc0[4 * g + i] * __expf(-tt * d0); v1[i] = acc1[4 * g + i] * __expf(-tt * d1); }
                *(nf4*)(dst0 + 4 * g) = v0; *(nf4*)(dst1 + 4 * g) = v1; }
        }
        __syncthreads();
    }
}
__device__ void ph_hy_prep(const P& p, int l, LAS unsigned char* lds) {
    constexpr int RS = 3 * 128 + 8;
    LAS bf16_t* raw = (LAS bf16_t*)lds;
    LAS bf16_t* ox = (LAS bf16_t*)(lds + 52224);
    LAS bf16_t* oz = ox + 128 * 72;
    const bf16_t* hy = (const bf16_t*)(p.ws + OFF_HYRAW);
    bf16_t* x0t = (bf16_t*)(p.ws + OFF_X0T); bf16_t* zt = (bf16_t*)(p.ws + OFF_ZT);
    const float* cw = PRM(p, hy_conv_w) + (size_t)l * 3 * 1536; const float* cb = PRM(p, hy_conv_b) + (size_t)l * 1536;
    const int tid = TIDX, nitems = (T_TOK / 64) * 4;
    for (int it = blockIdx.x; it < nitems; it += gridDim.x) {
        const int t0 = (it >> 2) * 64, c0 = (it & 3) * 128;
        for (int idx = tid; idx < 66 * 48; idx += 512) {
            const int row = idx / 48, rem = idx - row * 48, a = rem >> 4, pc = rem & 15;
            int t = t0 - 1 + row; t = t < 0 ? 0 : (t >= T_TOK ? T_TOK - 1 : t);
            *(LAS nu4*)(raw + row * RS + a * 128 + pc * 8) = *(const nu4*)(hy + (size_t)t * 1536 + a * 512 + c0 + pc * 8);
        }
        __syncthreads();
        {
            const int c = tid & 127, tq = tid >> 7;
            float wv[3][3], bv[3];
#pragma unroll
            for (int a = 0; a < 3; ++a) { bv[a] = cb[a * 512 + c0 + c];
#pragma unroll
                for (int k = 0; k < 3; ++k) wv[a][k] = cw[k * 1536 + a * 512 + c0 + c]; }
            float xm[3], xc[3];
#pragma unroll
            for (int a = 0; a < 3; ++a) { xm[a] = bf2f(raw[(tq * 16) * RS + a * 128 + c]); xc[a] = bf2f(raw[(tq * 16 + 1) * RS + a * 128 + c]); }
            unsigned px = 0, pz = 0;
#pragma unroll
            for (int j = 0; j < 16; ++j) {
                const int tt = tq * 16 + j, t = t0 + tt;
                const bool hp = !seq_start(t), hn = !seq_end(t);
                float r[3];
#pragma unroll
                for (int a = 0; a < 3; ++a) { const float xp = bf2f(raw[(tt + 2) * RS + a * 128 + c]);
                    r[a] = (hp ? xm[a] * wv[a][0] : 0.f) + xc[a] * wv[a][1] + (hn ? xp * wv[a][2] : 0.f) + bv[a];
                    xm[a] = xc[a]; xc[a] = xp; }
                const unsigned bx = f2bf(r[0]), bz = f2bf(r[1] * r[2]);
                if (j & 1) { px |= bx << 16; pz |= bz << 16;
                    *(LAS unsigned*)(ox + c * 72 + tt - 1) = px; *(LAS unsigned*)(oz + c * 72 + tt - 1) = pz; }
                else { px = bx; pz = bz; }
            }
        }
        __syncthreads();
        for (int idx = tid; idx < 128 * 16; idx += 512) {
            const int c = idx >> 4, rem = idx & 15, arr = rem >> 3, pc = rem & 7;
            const nu4 v = *(const LAS nu4*)((arr ? oz : ox) + c * 72 + pc * 8);
            *(nu4*)((arr ? zt : x0t) + (size_t)(c0 + c) * T_TOK + t0 + pc * 8) = v;
        }
        __syncthreads();
    }
}
__device__ __forceinline__ cf2 ld_f2_agent(const cf2* ptr) {
    const unsigned long long w = __hip_atomic_load((const unsigned long long*)ptr, __ATOMIC_RELAXED, __HIP_MEMORY_SCOPE_AGENT);
    return mkf2(__uint_as_float((unsigned)w), __uint_as_float((unsigned)(w >> 32)));
}
DEV_FN void spec_mul_g(LDS_F2 X, int S, const cf2* Ks);
__device__ void ph_hy_fft(const P& p, int l, LAS unsigned char* lds) {
    LAS cf2* X = (LAS cf2*)lds;
    const int tid = TIDX;
    cf2* Ks = (cf2*)(p.ws + OFF_KS) + (size_t)blockIdx.x * L_BIG;
    const float* kt = (const float*)(p.ws + OFF_KT);
    const bf16_t* x0t = (const bf16_t*)(p.ws + OFF_X0T); bf16_t* zt = (bf16_t*)(p.ws + OFF_ZT);
    for (int job = blockIdx.x; job < 1024; job += gridDim.x) {
        const bool big = job < 512; const int c = job & 511;
        const int L = big ? L_BIG : L_SML, S = big ? 7 : 6, M = L;
        const float* hf = kt + (big ? 0 : (size_t)512 * 2 * L_BIG) + (size_t)(c * 2) * L; const float* hb = hf + L;
        for (int m = tid; m < M; m += 512) {
            const int n0 = 2 * m, n1 = 2 * m + 1;
            const float a = n0 < L ? hf[n0] : (n0 == L ? 0.f : hb[2 * L - n0]);
            const float b = n1 < L ? hf[n1] : hb[2 * L - n1];
            X[m] = mkf2(a, b);
        }
        __syncthreads();
        fft_fwd(X, S, 0);
        spec_store(X, S, Ks);
        __threadfence(); __syncthreads();
        const float skip = PRM(p, hy_skip)[(size_t)l * D_HY + c];
        const int nseq = big ? 1 : 4;
        for (int sq = 0; sq < nseq; ++sq) {
            const int t0 = big ? 0 : L_BIG + sq * L_SML;
            const bf16_t* zrow = zt + (size_t)c * T_TOK + t0; const bf16_t* xrow = x0t + (size_t)c * T_TOK + t0;
            for (int m = tid; m < M; m += 512) {
                cf2 v = mkf2(0.f, 0.f);
                if (m < (M >> 1)) { const unsigned w = *(const unsigned*)(zrow + 2 * m); v.x = __uint_as_float(w << 16); v.y = __uint_as_float(w & 0xffff0000u); }
                X[m] = v;
            }
            __syncthreads();
            fft_fwd(X, S, 0);
            spec_mul_g(X, S, Ks);
            fft_inv(X, S);
            const float inv = 1.0f / (float)M;
            bf16_t* orow = zt + (size_t)c * T_TOK + t0;
            for (int m = tid; m < (M >> 1); m += 512) {
                const cf2 d = X[m];
                const unsigned wz = *(const unsigned*)(zrow + 2 * m), wx = *(const unsigned*)(xrow + 2 * m);
                const float z0 = __uint_as_float(wz << 16), z1 = __uint_as_float(wz & 0xffff0000u), a0 = __uint_as_float(wx << 16), a1 = __uint_as_float(wx & 0xffff0000u);
                *(unsigned*)(orow + 2 * m) = pack_bf2(a0 * (d.x * inv + skip * z0), a1 * (d.y * inv + skip * z1));
            }
            __syncthreads();
        }
    }
}
DEV_FN void spec_mul_g(LDS_F2 X, int S, const cf2* Ks) {
    const int M = 1 << (2 * S);
    for (int k = TIDX; k <= (M >> 1); k += NTHR) {
        if (k == 0) {
            const cf2 c0 = X[0], k0 = ld_f2_agent(Ks);
            const float y0 = (c0.x + c0.y) * k0.x, ym = (c0.x - c0.y) * k0.y;
            X[0] = mkf2(0.5f * (y0 + ym), 0.5f * (y0 - ym));
        } else {
            const unsigned pk = rev4((unsigned)k, S), pm = rev4((unsigned)(M - k), S);
            const cf2 ck = X[pk], cm = X[pm];
            const cf2 Pv = mkf2(0.5f * (ck.x + cm.x), 0.5f * (ck.y - cm.y));
            const cf2 O = mkf2(0.5f * (ck.y + cm.y), -0.5f * (ck.x - cm.x));
            float c, s; CIS_REV((float)k / (float)(2 * M), c, s);
            const cf2 Wk = mkf2(c, -s);
            const cf2 Q = cmul(O, Wk);
            const cf2 xk = mkf2(Pv.x + Q.x, Pv.y + Q.y), xm = mkf2(Pv.x - Q.x, -(Pv.y - Q.y));
            const cf2 yk = cmul(xk, ld_f2_agent(Ks + k)), ym = cmul(xm, ld_f2_agent(Ks + (M - k)));
            const cf2 Ye = mkf2(0.5f * (yk.x + ym.x), 0.5f * (yk.y - ym.y));
            const cf2 Yd = mkf2(0.5f * (yk.x - ym.x), 0.5f * (yk.y + ym.y));
            const cf2 Yo = cmulc(Yd, Wk);
            X[pk] = mkf2(Ye.x - Yo.y, Ye.y + Yo.x);
            if (k != (M >> 1)) X[pm] = mkf2(Ye.x + Yo.y, -Ye.y + Yo.x);
        }
    }
    __syncthreads();
}
__device__ void ph_hy_norm(const P& p, int l, LAS unsigned char* lds) {
    LAS bf16_t* tl = (LAS bf16_t*)lds;
    LAS float* red = (LAS float*)(lds + 9216);
    const bf16_t* yh = (const bf16_t*)(p.ws + OFF_ZT);
    const float* gain = PRM(p, hy_out_norm) + (size_t)l * D_HY;
    const int tid = TIDX, nitems = (T_TOK / 64) * 8;
    for (int it = blockIdx.x; it < nitems; it += gridDim.x) {
        const int t0 = (it >> 3) * 64, c0 = (it & 7) * 64;
        { const int cc = tid >> 3, pc = tid & 7;
          *(LAS nu4*)(tl + cc * 72 + pc * 8) = *(const nu4*)(yh + (size_t)(c0 + cc) * T_TOK + t0 + pc * 8); }
        __syncthreads();
        { const int tt = tid & 63, part = tid >> 6; float s = 0.f;
#pragma unroll
          for (int j = 0; j < 8; ++j) { const float v = bf2f(tl[(part * 8 + j) * 72 + tt]); s += v * v; }
          red[part * 64 + tt] = s; }
        __syncthreads();
        { const int tt = tid >> 3, pc = tid & 7;
          float s = 0.f;
#pragma unroll
          for (int j = 0; j < 8; ++j) s += red[j * 64 + tt];
          const float r = rsqrtf(s * (1.0f / 64.0f) + 1e-6f);
          unsigned w[4];
#pragma unroll
          for (int j = 0; j < 4; ++j) { const int ca = pc * 8 + 2 * j;
              w[j] = pack_bf2(bf2f(tl[ca * 72 + tt]) * r * gain[c0 + ca], bf2f(tl[(ca + 1) * 72 + tt]) * r * gain[c0 + ca + 1]); }
          nu4 o; o.x = w[0]; o.y = w[1]; o.z = w[2]; o.w = w[3];
          *(nu4*)(abuf_row(p, t0 + tt) + c0 + pc * 8) = o; }
        __syncthreads();
    }
}
typedef short hbf16x8 __attribute__((ext_vector_type(8)));
typedef float hf32x16 __attribute__((ext_vector_type(16)));
constexpr int HSC = 512, HNCH = HSC / 64, HNSC = T_TOK / HSC;
constexpr int QS = 136, KS_ = 72;
constexpr int HL_QH = 0, HL_KH = HL_QH + 64 * QS * 2, HL_QT = HL_KH + 64 * QS * 2, HL_KT = HL_QT + 64 * QS * 2, HL_VT = HL_KT + 128 * KS_ * 2, HL_ST = HL_VT + 128 * KS_ * 2,
              HL_PM = HL_ST + 128 * QS * 2, HL_TOT = HL_PM + 64 * KS_ * 2, HL_EB = HL_TOT + 4 * 128 * 4, HL_END = HL_EB + 128 * 4;
constexpr int HL_OF = HL_QH, OFS = 132;
static_assert(64 * OFS * 4 <= 2 * 64 * QS * 2, "O tile must fit over Qh|Kh");
constexpr size_t OFF_HST = OFF_R6 + 32 * MiB;
constexpr size_t OFF_HAT = OFF_SMALL + 64 * 1024;

__device__ __forceinline__ hf32x16 mfma32(hbf16x8 a, hbf16x8 b, hf32x16 c) { return __builtin_amdgcn_mfma_f32_32x32x16_bf16(a, b, c, 0, 0, 0); }
__device__ __forceinline__ hbf16x8 lds_frag(const LAS unsigned char* base, int row, int stride_el, int col_el) { return *(const LAS hbf16x8*)(base + ((size_t)row * stride_el + col_el) * 2); }

typedef unsigned hu32x4 __attribute__((ext_vector_type(4)));
struct HgPre { hu32x4 f0, f1, v0, v1, q0, q1; };
template <bool FULL>
__device__ __forceinline__ void hg_fetch(const bf16_t* hg, HgPre& pre, int tokbase, int dirsign, int h, int dir) {
    const int tid = TIDX;
    { const int u = tid >> 4, seg = tid & 15;
      const bf16_t* row = hg + (size_t)(tokbase + dirsign * u) * 2560 + h * 128 + seg * 8;
      pre.f0 = *(const hu32x4*)(row + 512 + 512 * dir); pre.v0 = *(const hu32x4*)(row + 1536); if (FULL) pre.q0 = *(const hu32x4*)(row);
      const bf16_t* row1 = row + (size_t)dirsign * 32 * 2560;
      pre.f1 = *(const hu32x4*)(row1 + 512 + 512 * dir); pre.v1 = *(const hu32x4*)(row1 + 1536); if (FULL) pre.q1 = *(const hu32x4*)(row1); }
}
template <bool FULL>
__device__ __forceinline__ void hg_prep(LAS unsigned char* lds, const HgPre& pre, float lb, float& Bsum_out) {
    const int tid = TIDX, d = tid & 127, qt = tid >> 7;
    LAS float* tot = (LAS float*)(lds + HL_TOT); LAS float* eB = (LAS float*)(lds + HL_EB);
    { const int u = tid >> 4, seg = tid & 15;
      *(LAS hu32x4*)(lds + HL_KH + ((size_t)u * QS + seg * 8) * 2) = pre.f0; *(LAS hu32x4*)(lds + HL_KH + ((size_t)(u + 32) * QS + seg * 8) * 2) = pre.f1;
      *(LAS hu32x4*)(lds + HL_QH + ((size_t)u * QS + seg * 8) * 2) = pre.v0; *(LAS hu32x4*)(lds + HL_QH + ((size_t)(u + 32) * QS + seg * 8) * 2) = pre.v1;
      if (FULL) { *(LAS hu32x4*)(lds + HL_QT + ((size_t)u * QS + seg * 8) * 2) = pre.q0; *(LAS hu32x4*)(lds + HL_QT + ((size_t)(u + 32) * QS + seg * 8) * 2) = pre.q1; } }
    __syncthreads();
    float c[16];
    float run = 0.f;
    const float oml = 1.0f - lb;
#pragma unroll
    for (int j = 0; j < 16; ++j) {
        const int u = qt * 16 + j;
        float z = bf2f(*(const LAS bf16_t*)(lds + HL_KH + ((size_t)u * QS + d) * 2));
        z = fmaxf(z, -60.0f);
        const float f = lb + oml * __builtin_amdgcn_rcpf(1.0f + __expf(-z));
        *(LAS bf16_t*)(lds + HL_KH + ((size_t)u * QS + d) * 2) = f2bf(1.0f - f);
        run += __logf(f);
        c[j] = run;
    }
    tot[qt * 128 + d] = run;
    __syncthreads();
    const float t0 = tot[d], t1 = tot[128 + d], t2 = tot[256 + d], t3 = tot[384 + d];
    const float off = qt == 0 ? 0.f : (qt == 1 ? t0 : (qt == 2 ? t0 + t1 : t0 + t1 + t2));
    const float r = t0 + t1, B = t0 + t1 + t2 + t3;
    const float eBr = __expf(B - r), eR = __expf(r);
    if (qt == 0) eB[d] = __expf(B);
    Bsum_out = B;
#pragma unroll
    for (int jj = 0; jj < 8; ++jj) {
        unsigned pkt = 0, pvt = 0;
#pragma unroll
        for (int q2 = 0; q2 < 2; ++q2) {
            const int j = jj * 2 + q2, u = qt * 16 + j;
            const float rb = r - (off + c[j]);
            const float kh = bf2f(*(const LAS bf16_t*)(lds + HL_KH + ((size_t)u * QS + d) * 2)) * __expf(rb);
            const bf16_t vraw = *(const LAS bf16_t*)(lds + HL_QH + ((size_t)u * QS + d) * 2);
            pkt |= (unsigned)f2bf(kh * eBr) << (16 * q2); pvt |= (unsigned)vraw << (16 * q2);
            if (FULL) {
                const float zq = bf2f(*(const LAS bf16_t*)(lds + HL_QT + ((size_t)u * QS + d) * 2));
                const float q = zq * __builtin_amdgcn_rcpf(1.0f + __expf(-zq));
                const float qh = q * __expf(-rb);
                *(LAS bf16_t*)(lds + HL_QT + ((size_t)u * QS + d) * 2) = f2bf(qh * eR);
                *(LAS bf16_t*)(lds + HL_QH + ((size_t)u * QS + d) * 2) = f2bf(qh);
                *(LAS bf16_t*)(lds + HL_KH + ((size_t)u * QS + d) * 2) = f2bf(kh);
            }
        }
        *(LAS unsigned*)(lds + HL_KT + ((size_t)d * KS_ + qt * 16 + jj * 2) * 2) = pkt;
        *(LAS unsigned*)(lds + HL_VT + ((size_t)d * KS_ + qt * 16 + jj * 2) * 2) = pvt;
    }
    __syncthreads();
}
__device__ __forceinline__ void hg_state_update(LAS unsigned char* lds, hf32x16 (&S)[2], int w, int lane) {
    const int en = w & 3, r = lane & 31, hh = lane >> 5;
    const LAS float* eB = (const LAS float*)(lds + HL_EB);
#pragma unroll
    for (int i = 0; i < 2; ++i) {
        const int dm = (w >> 2) * 2 + i;
#pragma unroll
        for (int g = 0; g < 4; ++g) { const nf4 sc = *(const LAS nf4*)(eB + 32 * dm + 8 * g + 4 * hh);
            S[i][4 * g + 0] *= sc.x; S[i][4 * g + 1] *= sc.y; S[i][4 * g + 2] *= sc.z; S[i][4 * g + 3] *= sc.w; }
#pragma unroll
        for (int ks = 0; ks < 4; ++ks) {
            const hbf16x8 a = lds_frag(lds + HL_KT, 32 * dm + r, KS_, 16 * ks + 8 * hh);
            const hbf16x8 b = lds_frag(lds + HL_VT, 32 * en + r, KS_, 16 * ks + 8 * hh);
            S[i] = mfma32(a, b, S[i]);
        }
    }
}
__device__ __forceinline__ int hg_unit_base(int sc) { return sc * HSC; }
__device__ void ph_hg_pass1(const P& p, int l, LAS unsigned char* lds) {
    const bf16_t* hg = (const bf16_t*)(p.ws + OFF_HG);
    const float* lbs = (const float*)(p.ws + OFF_SMALL);
    float* ust = (float*)(p.ws + OFF_HST); float* atot = (float*)(p.ws + OFF_HAT);
    const int tid = TIDX, w = tid >> 6, lane = tid & 63;
    for (int unit = blockIdx.x; unit < HNSC * 8; unit += gridDim.x) {
        const int sc = unit >> 3, h = (unit >> 1) & 3, dir = unit & 1;
        const float lb = lbs[(size_t)(dir * NLAYER + l) * D_HG + h * 128 + (tid & 127)];
        hf32x16 S[2];
#pragma unroll
        for (int i = 0; i < 2; ++i)
#pragma unroll
            for (int k = 0; k < 16; ++k) S[i][k] = 0.f;
        float Btot = 0.f;
        const int dsg = dir ? -1 : 1, tb0 = dir ? hg_unit_base(sc) + HSC - 1 : hg_unit_base(sc);
        HgPre pre;
        hg_fetch<false>(hg, pre, tb0, dsg, h, dir);
        for (int ci = 0; ci < HNCH; ++ci) {
            float B;
            hg_prep<false>(lds, pre, lb, B);
            if (ci + 1 < HNCH) hg_fetch<false>(hg, pre, tb0 + dsg * (ci + 1) * 64, dsg, h, dir);
            Btot += B;
            hg_state_update(lds, S, w, lane);
            __syncthreads();
        }
        float* U = ust + (size_t)unit * 16384;
        int r = lane & 31, hh = lane >> 5; asm volatile("" : "+v"(r), "+v"(hh));
        const int en = w & 3;
#pragma unroll
        for (int i = 0; i < 2; ++i) { const int dm = (w >> 2) * 2 + i;
#pragma unroll
            for (int k = 0; k < 16; ++k) U[(32 * dm + (k & 3) + 8 * (k >> 2) + 4 * hh) * 128 + 32 * en + r] = S[i][k]; }
        if (tid < 128) atot[(size_t)unit * 128 + tid] = __expf(Btot);
    }
}
__device__ void ph_hg_pass2(const P& p) {
    float* ust = (float*)(p.ws + OFF_HST); const float* atot = (const float*)(p.ws + OFF_HAT);
    const int total = 5 * 8 * 16384;
    for (int idx = blockIdx.x * 512 + TIDX; idx < total; idx += gridDim.x * 512) {
        const int el = idx & 16383, hd = (idx >> 14) & 7, sq = idx >> 17;
        const int sc0 = sq == 0 ? 0 : 32 + 8 * (sq - 1), nsc = sq == 0 ? 32 : 8, dir = hd & 1, d = el >> 7;
        float carry = 0.f;
        for (int j = 0; j < nsc; ++j) {
            const int sc = dir ? sc0 + nsc - 1 - j : sc0 + j;
            const size_t unit = (size_t)sc * 8 + hd;
            const float u = ust[unit * 16384 + el], a = atot[unit * 128 + d];
            ust[unit * 16384 + el] = carry;
            carry = a * carry + u;
        }
    }
}
__device__ void ph_hg_pass3(const P& p, int l, LAS unsigned char* lds) {
    const bf16_t* hg = (const bf16_t*)(p.ws + OFF_HG);
    const float* lbs = (const float*)(p.ws + OFF_SMALL);
    const float* ust = (const float*)(p.ws + OFF_HST);
    const float* gain = PRM(p, hg_out_norm) + (size_t)l * D_HG;
    const int tid = TIDX, w = tid >> 6, lane = tid & 63, r = lane & 31, hh = lane >> 5;
    for (int unit = blockIdx.x; unit < HNSC * 4; unit += gridDim.x) {
        const int sc = unit >> 2, h = unit & 3;
        for (int dir = 0; dir < 2; ++dir) {
            const float lb = lbs[(size_t)(dir * NLAYER + l) * D_HG + h * 128 + (tid & 127)];
            const float* S0 = ust + ((size_t)sc * 8 + h * 2 + dir) * 16384;
            hf32x16 S[2];
            { const int en = w & 3;
              int r_ = r, hh_ = hh; asm volatile("" : "+v"(r_), "+v"(hh_));
              const float* S0l = S0 + (4 * hh_) * 128 + 32 * en + r_;
#pragma unroll
              for (int i = 0; i < 2; ++i) { const int dm = (w >> 2) * 2 + i;
#pragma unroll
                  for (int k = 0; k < 16; ++k) S[i][k] = S0l[(32 * dm + (k & 3) + 8 * (k >> 2)) * 128];
#pragma unroll
                  for (int g = 0; g < 4; ++g) { nu2 wv; wv.x = pack_bf2(S[i][4 * g], S[i][4 * g + 1]); wv.y = pack_bf2(S[i][4 * g + 2], S[i][4 * g + 3]);
                      *(LAS nu2*)(lds + HL_ST + ((size_t)(32 * en + r) * QS + 32 * dm + 8 * g + 4 * hh) * 2) = wv; } } }
            const int dsg = dir ? -1 : 1, tb0 = dir ? hg_unit_base(sc) + HSC - 1 : hg_unit_base(sc);
            HgPre pre;
            hg_fetch<true>(hg, pre, tb0, dsg, h, dir);
            for (int ci = 0; ci < HNCH; ++ci) {
                const int tokbase = tb0 + dsg * ci * 64;
                float Bdummy;
                hg_prep<true>(lds, pre, lb, Bdummy);
                if (ci + 1 < HNCH) hg_fetch<true>(hg, pre, tb0 + dsg * (ci + 1) * 64, dsg, h, dir);
                if (w < 4) {
                    const int tm = (w == 0 || w == 3) ? 0 : 1, sn = (w == 2 || w == 3) ? 1 : 0;
                    hf32x16 acc;
#pragma unroll
                    for (int k = 0; k < 16; ++k) acc[k] = 0.f;
                    if (w < 3) {
#pragma unroll
                        for (int ks = 0; ks < 8; ++ks) acc = mfma32(lds_frag(lds + HL_QH, 32 * tm + r, QS, 16 * ks + 8 * hh), lds_frag(lds + HL_KH, 32 * sn + r, QS, 16 * ks + 8 * hh), acc);
                    }
                    const int s_ = 32 * sn + r;
#pragma unroll
                    for (int k = 0; k < 16; ++k) { const int t_ = 32 * tm + (k & 3) + 8 * (k >> 2) + 4 * hh;
                        const float v = (w < 3 && s_ <= t_) ? acc[k] : 0.f;
                        *(LAS bf16_t*)(lds + HL_PM + ((size_t)t_ * KS_ + s_) * 2) = f2bf(v); }
                }
                __syncthreads();
                hf32x16 o;
                { const int tm = w >> 2, en = w & 3;
#pragma unroll
                  for (int k = 0; k < 16; ++k) o[k] = 0.f;
#pragma unroll
                  for (int ks = 0; ks < 4; ++ks) o = mfma32(lds_frag(lds + HL_PM, 32 * tm + r, KS_, 16 * ks + 8 * hh), lds_frag(lds + HL_VT, 32 * en + r, KS_, 16 * ks + 8 * hh), o);
#pragma unroll
                  for (int ks = 0; ks < 8; ++ks) o = mfma32(lds_frag(lds + HL_QT, 32 * tm + r, QS, 16 * ks + 8 * hh), lds_frag(lds + HL_ST, 32 * en + r, QS, 16 * ks + 8 * hh), o);
                }
                __syncthreads();
                { const int tm = w >> 2, en = w & 3; LAS float* Of = (LAS float*)(lds + HL_OF);
#pragma unroll
                  for (int k = 0; k < 16; ++k) Of[(size_t)(32 * tm + (k & 3) + 8 * (k >> 2) + 4 * hh) * OFS + 32 * en + r] = o[k]; }
                hg_state_update(lds, S, w, lane);
                { const int en = w & 3;
#pragma unroll
                  for (int i = 0; i < 2; ++i) { const int dm = (w >> 2) * 2 + i;
#pragma unroll
                      for (int g = 0; g < 4; ++g) { nu2 wv; wv.x = pack_bf2(S[i][4 * g], S[i][4 * g + 1]); wv.y = pack_bf2(S[i][4 * g + 2], S[i][4 * g + 3]);
                          *(LAS nu2*)(lds + HL_ST + ((size_t)(32 * en + r) * QS + 32 * dm + 8 * g + 4 * hh) * 2) = wv; } } }
                __syncthreads();
                { const int u = tid >> 3, e0 = (tid & 7) * 16, tok = tokbase + dsg * u;
                  const LAS float* Of = (const LAS float*)(lds + HL_OF) + (size_t)u * OFS + e0;
                  bf16_t* dst = abuf_row(p, tok) + 512 + h * 128 + e0;
                  float v[16];
#pragma unroll
                  for (int j = 0; j < 4; ++j) { const nf4 t4 = *(const LAS nf4*)(Of + 4 * j); v[4 * j] = t4.x; v[4 * j + 1] = t4.y; v[4 * j + 2] = t4.z; v[4 * j + 3] = t4.w; }
                  if (dir == 0) {
                      uint4 w0, w1;
                      w0.x = pack_bf2(v[0], v[1]); w0.y = pack_bf2(v[2], v[3]); w0.z = pack_bf2(v[4], v[5]); w0.w = pack_bf2(v[6], v[7]);
                      w1.x = pack_bf2(v[8], v[9]); w1.y = pack_bf2(v[10], v[11]); w1.z = pack_bf2(v[12], v[13]); w1.w = pack_bf2(v[14], v[15]);
                      ((uint4*)dst)[0] = w0; ((uint4*)dst)[1] = w1;
                  } else {
                      const uint4 f0 = ((const uint4*)dst)[0], f1 = ((const uint4*)dst)[1];
                      const unsigned fw[8] = {f0.x, f0.y, f0.z, f0.w, f1.x, f1.y, f1.z, f1.w};
                      float ss = 0.f;
#pragma unroll
                      for (int j = 0; j < 8; ++j) { v[2 * j] += __uint_as_float(fw[j] << 16); v[2 * j + 1] += __uint_as_float(fw[j] & 0xffff0000u); ss += v[2 * j] * v[2 * j] + v[2 * j + 1] * v[2 * j + 1]; }
                      ss += __shfl_xor(ss, 1); ss += __shfl_xor(ss, 2); ss += __shfl_xor(ss, 4);
                      const float rn = rsqrtf(ss * (1.0f / 128.0f) + 1e-6f);
                      const bf16_t* gp = hg + (size_t)tok * 2560 + 2048 + h * 128 + e0;
                      const uint4 g0 = ((const uint4*)gp)[0], g1 = ((const uint4*)gp)[1];
                      const unsigned gw[8] = {g0.x, g0.y, g0.z, g0.w, g1.x, g1.y, g1.z, g1.w};
                      unsigned ow[8];
#pragma unroll
                      for (int j = 0; j < 8; ++j) { const float ga = silu_f(__uint_as_float(gw[j] << 16)), gb = silu_f(__uint_as_float(gw[j] & 0xffff0000u));
                          ow[j] = pack_bf2(v[2 * j] * rn * gain[h * 128 + e0 + 2 * j] * ga, v[2 * j + 1] * rn * gain[h * 128 + e0 + 2 * j + 1] * gb); }
                      ((uint4*)dst)[0] = make_uint4(ow[0], ow[1], ow[2], ow[3]); ((uint4*)dst)[1] = make_uint4(ow[4], ow[5], ow[6], ow[7]);
                  }
                }
                __syncthreads();
            }
        }
    }
}
#define XB_TMO      128
#define XB_XCNT(j)  (256  + 64 * (j))
#define XB_XSUB(j)  (1280 + 64 * (j))
#define XB_XGEN(j)  (2304 + 64 * (j))
#define XB_TOP      3328
#define XB_TOPGEN   3392
#define XCD_BAR_WORDS 3456
#define XB_SPIN_CAP (1u << 18)

__device__ __forceinline__ unsigned xb_ld(unsigned* p)              { return __hip_atomic_load(p, __ATOMIC_RELAXED, __HIP_MEMORY_SCOPE_AGENT); }
__device__ __forceinline__ unsigned xb_add(unsigned* p, unsigned v) { return __hip_atomic_fetch_add(p, v, __ATOMIC_RELAXED, __HIP_MEMORY_SCOPE_AGENT); }
__device__ __forceinline__ unsigned xb_xcc_id() { return (unsigned)__builtin_amdgcn_s_getreg((3 << 11) | 20) & 0xFu; }
#define XB_SPIN(cond, bar) do { unsigned _sp = 0; while (cond) { __builtin_amdgcn_s_sleep(1); \
    if ((++_sp & 255u) == 0u) { if (xb_ld(&(bar)[XB_TMO])) break; if (_sp > XB_SPIN_CAP) { atomicAdd(&(bar)[XB_TMO], 1u); break; } } } } while (0)

struct XcdBarrier {
    unsigned* bar; unsigned x;
    volatile LAS unsigned* st;
};

__device__ __forceinline__ XcdBarrier xcd_barrier_post(unsigned* bar, volatile LAS unsigned* st) {
    XcdBarrier b; b.bar = bar; b.x = xb_xcc_id(); b.st = st;
    if (TIDX == 0) (void)xb_add(&bar[XB_XCNT(b.x)], 1u);
    return b;
}
__device__ __forceinline__ void xcd_barrier_complete(unsigned* bar, unsigned x, unsigned& nloc, unsigned& nx) {
    const unsigned G = gridDim.x * gridDim.y * gridDim.z;
    unsigned sum, cnt, mine, sp = 0u;
    for (;;) {
        sum = 0u; cnt = 0u; mine = 0u;
#pragma unroll
        for (unsigned j = 0; j < 16; ++j) { const unsigned c = xb_ld(&bar[XB_XCNT(j)]); sum += c; cnt += (c > 0u) ? 1u : 0u; mine = (j == x) ? c : mine; }
        if (sum == G) break;
        __builtin_amdgcn_s_sleep(1);
        if ((++sp & 255u) == 0u) { if (xb_ld(&bar[XB_TMO])) break; if (sp > XB_SPIN_CAP) { atomicAdd(&bar[XB_TMO], 1u); break; } }
    }
    nloc = mine > 0u ? mine : 1u; nx = cnt > 0u ? cnt : 1u;
}

__device__ __forceinline__ void xcd_barrier(const XcdBarrier& b) {
    asm volatile("s_waitcnt vmcnt(0)" ::: "memory");
    __syncthreads();
    if (TIDX == 0) {
        unsigned* bar = b.bar;
        __builtin_amdgcn_s_waitcnt(0);
        unsigned nloc = b.st[0], nx = b.st[1];
        if (nloc == 0u) { xcd_barrier_complete(bar, b.x, nloc, nx); b.st[0] = nloc; b.st[1] = nx; }
        const unsigned old = xb_add(&bar[XB_XSUB(b.x)], 1u);
        const unsigned gen = old / nloc;
        if (old + 1u == (gen + 1u) * nloc) {
            __builtin_amdgcn_fence(__ATOMIC_RELEASE, "agent");
            asm volatile("s_waitcnt vmcnt(0)" ::: "memory");
            const unsigned og = xb_add(&bar[XB_TOP], 1u);
            const unsigned tg = og / nx;
            if (og + 1u == (tg + 1u) * nx) xb_add(&bar[XB_TOPGEN], 1u);
            else XB_SPIN(xb_ld(&bar[XB_TOPGEN]) == tg, bar);
            __builtin_amdgcn_fence(__ATOMIC_ACQUIRE, "agent");
            xb_add(&bar[XB_XGEN(b.x)], 1u);
            asm volatile("s_waitcnt vmcnt(0)" ::: "memory");
        } else {
            XB_SPIN(xb_ld(&bar[XB_XGEN(b.x)]) == gen, bar);
            __builtin_amdgcn_fence(__ATOMIC_ACQUIRE, "agent");
            asm volatile("s_waitcnt vmcnt(0)" ::: "memory");
        }
    }
    __syncthreads();
}

enum { PH_SETUP, PH_CONVERT, PH_RMS_IN, PH_GEMM_IN, PH_HY_PREP, PH_FILTER, PH_HGRN, PH_HG_NORM, PH_HY_FFT, PH_HY_NORM, PH_GEMM_OUT, PH_NR0, PH_GEMM_UP, PH_GEGLU, PH_GEMM_DN, PH_NR1, PH_HG_P1, PH_HG_P2, PH_HG_P3 };
template <int PH> __device__ __forceinline__ void run_phase(const P& p_in, int l, int part, LAS unsigned char* lds) {
    P p = p_in; asm volatile("" : "+s"(p.ws), "+s"(p.out));
    p.ws = (unsigned char*)(__attribute__((address_space(1))) unsigned char*)p.ws; p.out = (float*)(__attribute__((address_space(1))) float*)p.out;
    if constexpr (PH == PH_SETUP) { ph_setup(p); ph_copy_params(p); }
    if constexpr (PH == PH_CONVERT) ph_convert_w(p, l, lds);
    if constexpr (PH == PH_RMS_IN) ph_rmsnorm_in(p, l);
    if constexpr (PH == PH_GEMM_IN) { EpiBf16Split E; E.O0 = (bf16_t*)(p.ws + OFF_HYRAW); E.ldc0 = 1536; E.O1 = (bf16_t*)(p.ws + OFF_HG); E.ldc1 = 2560; E.csplit = 1536;
        run_gemm(lds, abuf_row(p, 0), (const bf16_t*)(p.ws + OFF_W_IN), T_TOK, D_IN, DM, E); }
    if constexpr (PH == PH_HY_PREP) ph_hy_prep(p, l, lds);
    if constexpr (PH == PH_FILTER) ph_filter(p, l, lds);
    if constexpr (PH == PH_HY_FFT) ph_hy_fft(p, l, lds);
    if constexpr (PH == PH_HY_NORM) ph_hy_norm(p, l, lds);
    if constexpr (PH == PH_GEMM_OUT) { EpiBf16Split E; E.O0 = (bf16_t*)(p.ws + OFF_MIX); E.ldc0 = DM; E.O1 = E.O0; E.ldc1 = DM; E.csplit = 1 << 30;
        run_gemm(lds, abuf_row(p, 0), (const bf16_t*)(p.ws + OFF_W_OUT), T_TOK, DM, DM, E); }
    if constexpr (PH == PH_NR0) ph_norm_resid(p, l, 0);
    if constexpr (PH == PH_GEMM_UP) { EpiGeglu E; E.act = (bf16_t*)(p.ws + OFF_ACT); E.cw = PRM(p, ffn_conv_w) + (size_t)l * 3 * 8192; E.cb = PRM(p, ffn_conv_b) + (size_t)l * 8192;
        run_gemm(lds, abuf_row(p, -1), (const bf16_t*)(p.ws + OFF_W_UP), 133 * 256, 2 * DFF, DM, E); }
    if constexpr (PH == PH_GEMM_DN) { EpiBf16Split E; E.O0 = (bf16_t*)(p.ws + OFF_MIX); E.ldc0 = DM; E.O1 = E.O0; E.ldc1 = DM; E.csplit = 1 << 30;
        run_gemm(lds, (const bf16_t*)(p.ws + OFF_ACT), (const bf16_t*)(p.ws + OFF_W_DN), T_TOK, DM, DFF, E); }
    if constexpr (PH == PH_NR1) ph_norm_resid(p, l, 1);
    if constexpr (PH == PH_HG_P1) ph_hg_pass1(p, l, lds);
    if constexpr (PH == PH_HG_P2) ph_hg_pass2(p);
    if constexpr (PH == PH_HG_P3) ph_hg_pass3(p, l, lds);
}
constexpr int LDS_BYTES = 139264;
__global__ __launch_bounds__(512, 2) void mega(P p) {
    extern __shared__ __attribute__((aligned(16))) unsigned char lds_g[];
    LAS unsigned char* lds = (LAS unsigned char*)lds_g;
    cg::grid_group grid = cg::this_grid();
    volatile LAS unsigned* xst = (volatile LAS unsigned*)(lds + LDS_BYTES - 16);
    if (TIDX == 0) { xst[0] = 0u; xst[1] = 0u; }
    __syncthreads();
    const XcdBarrier xb = xcd_barrier_post((unsigned*)(p.ws + OFF_BAR), xst);
    run_phase<PH_SETUP>(p, 0, 0, lds);
    run_phase<PH_CONVERT>(p, 0, 0, lds);
    run_phase<PH_RMS_IN>(p, 0, 0, lds);
    grid.sync();
#pragma unroll 1
    for (int l = 0; l < NLAYER; ++l) {
        run_phase<PH_GEMM_IN>(p, l, 0, lds); xcd_barrier(xb);
        run_phase<PH_HY_PREP>(p, l, 0, lds); run_phase<PH_HG_P1>(p, l, 0, lds); xcd_barrier(xb);
        run_phase<PH_FILTER>(p, l, 0, lds); run_phase<PH_HG_P2>(p, l, 0, lds); xcd_barrier(xb);
        run_phase<PH_HG_P3>(p, l, 0, lds); run_phase<PH_HY_FFT>(p, l, 0, lds); xcd_barrier(xb);
        run_phase<PH_HY_NORM>(p, l, 0, lds); xcd_barrier(xb);
        run_phase<PH_GEMM_OUT>(p, l, 0, lds); xcd_barrier(xb);
        run_phase<PH_NR0>(p, l, 0, lds); xcd_barrier(xb);
        run_phase<PH_GEMM_UP>(p, l, 0, lds); xcd_barrier(xb);
        run_phase<PH_GEMM_DN>(p, l, 0, lds); xcd_barrier(xb);
        run_phase<PH_NR1>(p, l, 0, lds);
        if (l + 1 < NLAYER) { run_phase<PH_CONVERT>(p, l + 1, 0, lds); xcd_barrier(xb); }
    }
}
extern "C" void kernel_launch(void* const* d_in, const int* in_sizes, int n_in, void* d_out, int out_size, void* d_ws, size_t ws_size, hipStream_t stream) {
    if (ws_size < WS_NEED) { fprintf(stderr, "workspace too small: %zu < %zu\n", ws_size, (size_t)WS_NEED); return; }
    static int grid_blocks = 0;
    if (!grid_blocks) {
        hipFuncSetAttribute((const void*)mega, hipFuncAttributeMaxDynamicSharedMemorySize, LDS_BYTES);
        int dev = 0, cus = 0, per_cu = 0;
        hipGetDevice(&dev);
        hipDeviceGetAttribute(&cus, hipDeviceAttributeMultiprocessorCount, dev);
        hipOccupancyMaxActiveBlocksPerMultiprocessor(&per_cu, mega, 512, LDS_BYTES);
        if (per_cu > 1) per_cu = 1;
        grid_blocks = cus * per_cu;
    }
    P p{};
    for (int i = 0; i < 26; ++i) p.in[i] = (const float*)d_in[i];
    p.out = (float*)d_out; p.ws = (unsigned char*)d_ws;
    hipMemsetAsync((unsigned char*)d_ws + OFF_BAR, 0, XCD_BAR_WORDS * 4, stream);
    void* args[] = {&p};
    hipError_t e = hipLaunchCooperativeKernel((void*)mega, dim3(grid_blocks), dim3(512), args, LDS_BYTES, stream);
    if (e != hipSuccess) fprintf(stderr, "cooperative launch failed: %s (grid %d)\n", hipGetErrorString(e), grid_blocks);
}
```

```cpp
#include <hip/hip_runtime.h>
#include <hip/hip_cooperative_groups.h>
#include <cstdio>
#include <cstdint>
namespace cg = cooperative_groups;
__device__ __forceinline__ int tid_opaque() { int t = (int)threadIdx.x; asm volatile("" : "+v"(t)); return t; }
#define TIDX tid_opaque()
#define LAS __attribute__((address_space(3)))
typedef float cf2 __attribute__((ext_vector_type(2)));
typedef float nf4 __attribute__((ext_vector_type(4)));
typedef unsigned nu2 __attribute__((ext_vector_type(2)));
typedef unsigned nu4 __attribute__((ext_vector_type(4)));
namespace pg8 {
#define PG8_LAS __attribute__((address_space(3)))
typedef unsigned short bf16_t;
typedef short bf16x8 __attribute__((ext_vector_type(8)));
typedef float f32x4 __attribute__((ext_vector_type(4)));
typedef unsigned u32x4 __attribute__((ext_vector_type(4)));
constexpr int BM = 256, BK = 64, HALF = 128, HTB = HALF * BK * 2  , STAGE_BYTES = 8 * HTB, NXCD = 8, WGM = 8;

__host__ __device__ __forceinline__ int lds_byte(int r, int c) { const int st = (r >> 4) * 2 + (c >> 5), rr = r & 15, cc = c & 31, ob = rr * 64 + cc * 2; return st * 1024 + (ob ^ (((ob >> 9) & 1) << 5)); }
__host__ __device__ __forceinline__ void stage_rc(int b, int& R, int& C) { const int st = b / 1024, sb = b % 1024, swz = sb ^ (((sb >> 9) & 1) << 5); R = (st >> 1) * 16 + swz / 64; C = (st & 1) * 32 + (swz % 64) / 2; }
__host__ __device__ __forceinline__ int perm32(int rho) { const int n = rho >> 4, i = rho & 15; return 8 * (i >> 2) + 4 * n + (i & 3); }

struct Unit { int pm, pn; };
struct Gemm { const bf16_t* A; const bf16_t* Bt; int M, N, K; int ovl; };

struct StaticOrder {
    int nM, nN, nwg, G, c;
    __host__ __device__ void init(int M, int N, int G_, int c_) { nM = M / BM; nN = N / BM; nwg = nM * nN; G = G_; c = c_; }
    __host__ __device__ bool next(int i, Unit& u) const {
        const long L = (long)i * G + c; if (L >= nwg) return false;
        int wgid = (int)L; { const int q = nwg / NXCD, r = nwg % NXCD, xcd = wgid % NXCD, off = wgid / NXCD; wgid = (xcd < r ? xcd * (q + 1) : r * (q + 1) + (xcd - r) * q) + off; }
        const int nig = WGM * nN, gid = wgid / nig, fm = gid * WGM, gsz = (nM - fm) < WGM ? (nM - fm) : WGM;
        u.pm = fm + ((wgid % nig) % gsz); u.pn = (wgid % nig) / gsz; return true;
    }
    __device__ __forceinline__ void a_ready(const Unit&) const {}
    __device__ __forceinline__ void done(const Unit&) const {}
};
struct CountedOrder : StaticOrder {
    const unsigned* ready; unsigned need; unsigned* tmo;
    __device__ __forceinline__ void a_ready(const Unit& u) const {
        if (TIDX < 64) {
            const unsigned long long t0 = __builtin_amdgcn_s_memrealtime(); unsigned polls = 0;
            while ((unsigned)__builtin_amdgcn_readfirstlane(__hip_atomic_load(ready + 64 * u.pm, __ATOMIC_RELAXED, __HIP_MEMORY_SCOPE_AGENT)) < need) {
                if ((++polls & 255u) == 0u && __builtin_amdgcn_readfirstlane(__hip_atomic_load(tmo, __ATOMIC_RELAXED, __HIP_MEMORY_SCOPE_AGENT)) != 0u) break;
                if (__builtin_amdgcn_s_memrealtime() - t0 > 2000000ull) {
                    if (TIDX == 0) { unsigned expect = 0u; __hip_atomic_compare_exchange_strong(tmo + 1, &expect, 0x600u | (unsigned)(u.pm & 0xff), __ATOMIC_RELAXED, __ATOMIC_RELAXED, __HIP_MEMORY_SCOPE_AGENT); __hip_atomic_store(tmo, 1u, __ATOMIC_RELAXED, __HIP_MEMORY_SCOPE_AGENT); }
                    break; }
                __builtin_amdgcn_s_sleep(2); }
            __builtin_amdgcn_fence(__ATOMIC_ACQUIRE, "agent");
            asm volatile("s_waitcnt vmcnt(0)" ::: "memory");
        }
#if !defined(BROKEN_HOOK_NO_BARRIER)
        asm volatile("" ::: "memory"); __builtin_amdgcn_s_barrier(); asm volatile("" ::: "memory");
#endif
    }
};

__device__ __forceinline__ unsigned cvt_pk_bf16(float lo, float hi) { unsigned r; asm volatile("v_cvt_pk_bf16_f32 %0, %1, %2" : "=v"(r) : "v"(lo), "v"(hi)); return r; }
typedef float f32x2 __attribute__((ext_vector_type(2)));
__device__ __forceinline__ f32x2 gelu_pk(f32x2 v) {
    const f32x2 av = __builtin_elementwise_abs(v), d = av * 0.2316418882f + 1.0f;
    f32x2 t; t.x = __builtin_amdgcn_rcpf(d.x); t.y = __builtin_amdgcn_rcpf(d.y);
    f32x2 q = t * 0.5307027145f + (-0.7265760135f); q = q * t + 0.7107068705f; q = q * t + (-0.142248368f); q = q * t + 0.127414796f; q = q * t;
    const f32x2 s = (v * v) * (-0.72134752044f);
    f32x2 e; e.x = __builtin_amdgcn_exp2f(s.x); e.y = __builtin_amdgcn_exp2f(s.y);
    const f32x2 m = v * (q * e), r = v - m;
    f32x2 o; o.x = v.x < 0.f ? m.x : r.x; o.y = v.y < 0.f ? m.y : r.y; return o;
}

struct EpiF32 {
    static constexpr bool PERM = false, AFTER_DRAIN = false;
    float* C; int ldc; const float* bias;
    __device__ __forceinline__ void operator()(const f32x4 (&acc)[2][2][4][2], const Unit& u, int wr, int wc, int fr, int fq) const {
        const int row0 = u.pm * BM + wr * 64 + fr, col0 = u.pn * BM + wc * 32 + 4 * fq;
        f32x4 bv[2][2];
#pragma unroll
        for (int bj = 0; bj < 2; ++bj)
#pragma unroll
            for (int n = 0; n < 2; ++n) bv[bj][n] = bias ? *(const f32x4*)(bias + col0 + bj * HALF + n * 16) : (f32x4){0.f, 0.f, 0.f, 0.f};
#pragma unroll
        for (int ai = 0; ai < 2; ++ai)
#pragma unroll
            for (int m = 0; m < 4; ++m) { float* rowp = C + (size_t)(row0 + ai * HALF + m * 16) * ldc + col0;
#pragma unroll
                for (int bj = 0; bj < 2; ++bj)
#pragma unroll
                    for (int n = 0; n < 2; ++n) *(f32x4*)(rowp + bj * HALF + n * 16) = acc[ai][bj][m][n] + bv[bj][n]; }
    }
};
template <int ACT  > struct EpiBf16 {
    static constexpr bool PERM = true, AFTER_DRAIN = false;
    bf16_t* O; int ldc; const float* bias; int split_cols; size_t split_stride;
    __device__ __forceinline__ void operator()(const f32x4 (&acc)[2][2][4][2], const Unit& u, int wr, int wc, int fr, int fq) const {
        const int row0 = u.pm * BM + wr * 64 + fr; int colt = u.pn * BM; bf16_t* base = O;
        if (split_cols) { const int t = colt / split_cols; base += (size_t)t * split_stride; colt -= t * split_cols; }
        const int col0 = colt + wc * 32 + 8 * fq, bcol0 = u.pn * BM + wc * 32 + 8 * fq;
        f32x4 bv[2][2];
#pragma unroll
        for (int bj = 0; bj < 2; ++bj)
#pragma unroll
            for (int n = 0; n < 2; ++n) bv[bj][n] = bias ? *(const f32x4*)(bias + bcol0 + bj * HALF + 4 * n) : (f32x4){0.f, 0.f, 0.f, 0.f};
#pragma unroll
        for (int ai = 0; ai < 2; ++ai)
#pragma unroll
            for (int m = 0; m < 4; ++m) { bf16_t* rowp = base + (size_t)(row0 + ai * HALF + m * 16) * ldc + col0;
#pragma unroll
                for (int bj = 0; bj < 2; ++bj) { f32x4 v0 = acc[ai][bj][m][0] + bv[bj][0], v1 = acc[ai][bj][m][1] + bv[bj][1];
                    if (ACT == 1) { f32x2 a = gelu_pk((f32x2){v0[0], v0[1]}), b = gelu_pk((f32x2){v0[2], v0[3]}), c = gelu_pk((f32x2){v1[0], v1[1]}), d = gelu_pk((f32x2){v1[2], v1[3]});
                        v0 = (f32x4){a.x, a.y, b.x, b.y}; v1 = (f32x4){c.x, c.y, d.x, d.y}; }
                    if (ACT == 2) {
#pragma unroll
                        for (int j = 0; j < 4; ++j) { v0[j] = 0.5f * v0[j] * (1.0f + erff(v0[j] * 0.70710678f)); v1[j] = 0.5f * v1[j] * (1.0f + erff(v1[j] * 0.70710678f)); } }
                    u32x4 w; w.x = cvt_pk_bf16(v0[0], v0[1]); w.y = cvt_pk_bf16(v0[2], v0[3]); w.z = cvt_pk_bf16(v1[0], v1[1]); w.w = cvt_pk_bf16(v1[2], v1[3]);
                    *(u32x4*)(rowp + bj * HALF) = w; } }
    }
};
template <class Epi, class Sched, bool STAMP = false>
__device__ __forceinline__ void gemm_phase(PG8_LAS unsigned char* lds, const Gemm g, const Sched& S, const Epi& E, unsigned long long* stamps) {
    const int tid = TIDX, wid = __builtin_amdgcn_readfirstlane(tid >> 6), lane = tid & 63, wr = wid >> 2, wc = wid & 3, fr = lane & 15, fq = lane >> 4;
    const int K = g.K, nt = K / BK;
    int ts_lo = 0, ts_hi = 0, nts = 0; const unsigned long long rt_entry = STAMP ? (unsigned long long)wall_clock64() : 0ull;
#define PG8_STAMP() do { if (STAMP && wid == 0 && nts < 64) { const unsigned long long _c = (unsigned long long)clock64(); \
        ts_lo = (lane == nts) ? (int)(unsigned)_c : ts_lo; ts_hi = (lane == nts) ? (int)(unsigned)(_c >> 32) : ts_hi; ++nts; } } while (0)
    PG8_STAMP();
    unsigned voffA[2], voffB[2];
#pragma unroll
    for (int i = 0; i < 2; ++i) { int R, C; stage_rc(tid * 16 + i * 8192, R, C); const int Rb = Epi::PERM ? ((R & ~31) + perm32(R & 31)) : R;
        const int Ra = g.ovl ? R - 2 * (R >> 6) : R; voffA[i] = (unsigned)(Ra * K + C) * 2u; voffB[i] = (unsigned)(Rb * K + C) * 2u; }
    const size_t kstep = (size_t)(BK * 2);
    const size_t hstep = (size_t)HALF * K * 2;
    const size_t tstep = 2 * hstep;
    const size_t hstepA = g.ovl ? (size_t)124 * K * 2 : hstep, tstepA = g.ovl ? (size_t)248 * K * 2 : tstep;
    const unsigned ldsw = (unsigned)wid * 1024u;
    const int aoff = lds_byte(wr * 64 + fr, fq * 8), boff = lds_byte(wc * 32 + fr, fq * 8);
#define PG8_SA(b, h) (((b) * 2 + (h)) * HTB)
#define PG8_SB(b, h) ((4 + (b) * 2 + (h)) * HTB)
#define PG8_STAGE(bufoff, gbase, voff) do { _Pragma("unroll") for (int _i = 0; _i < 2; ++_i) \
        __builtin_amdgcn_global_load_lds((const unsigned*)((const char*)(gbase) + (voff)[_i]), (PG8_LAS unsigned*)(lds + (bufoff) + ldsw + _i * 8192), 16, 0, 0); } while (0)
#define PG8_LDA(dst, b, h) do { _Pragma("unroll") for (int m = 0; m < 4; ++m) _Pragma("unroll") for (int k = 0; k < 2; ++k) dst[m][k] = *(const PG8_LAS bf16x8*)(lds + PG8_SA(b, h) + aoff + m * 2048 + k * 1024); } while (0)
#define PG8_LDB(dst, b, h) do { _Pragma("unroll") for (int n = 0; n < 2; ++n) _Pragma("unroll") for (int k = 0; k < 2; ++k) dst[n][k] = *(const PG8_LAS bf16x8*)(lds + PG8_SB(b, h) + boff + n * 2048 + k * 1024); } while (0)
#define PG8_MMA(ai, bj, At, Bt) do { __builtin_amdgcn_s_setprio(1); _Pragma("unroll") for (int m = 0; m < 4; ++m) _Pragma("unroll") for (int n = 0; n < 2; ++n) _Pragma("unroll") for (int k = 0; k < 2; ++k) \
        acc[ai][bj][m][n] = __builtin_amdgcn_mfma_f32_16x16x32_bf16(Bt[n][k], At[m][k], acc[ai][bj][m][n], 0, 0, 0); __builtin_amdgcn_s_setprio(0); } while (0)
#define PG8_WAIT_V(n) asm volatile("s_waitcnt vmcnt(" #n ")" ::: "memory")
#define PG8_WAIT_L(n) asm volatile("s_waitcnt lgkmcnt(" #n ")" ::: "memory")
#define PG8_BAR __builtin_amdgcn_s_barrier()
#define PG8_SCHED __builtin_amdgcn_sched_barrier(0)
    Unit cur, nxt; int ui = 0;
    if (!S.next(0, cur)) return;
    f32x4 acc[2][2][4][2];
#pragma unroll
    for (int a = 0; a < 2; ++a)
#pragma unroll
        for (int b = 0; b < 2; ++b)
#pragma unroll
            for (int m = 0; m < 4; ++m)
#pragma unroll
                for (int n = 0; n < 2; ++n) acc[a][b][m][n] = (f32x4){0.f, 0.f, 0.f, 0.f};
    bf16x8 At[4][2], B0[2][2], B1[2][2];
    const char* cA = (const char*)g.A + (size_t)cur.pm * tstepA; const char* cB = (const char*)g.Bt + (size_t)cur.pn * tstep;
    S.a_ready(cur);
    PG8_STAGE(PG8_SB(0, 0), cB, voffB); PG8_STAGE(PG8_SA(0, 0), cA, voffA); PG8_STAGE(PG8_SB(0, 1), cB + hstep, voffB); PG8_STAGE(PG8_SA(0, 1), cA + hstepA, voffA);
    if (wr == 1) PG8_BAR;
    PG8_WAIT_V(4); PG8_BAR;
    PG8_STAGE(PG8_SB(1, 0), cB + kstep, voffB); PG8_STAGE(PG8_SA(1, 0), cA + kstep, voffA); PG8_STAGE(PG8_SB(1, 1), cB + hstep + kstep, voffB);
    PG8_WAIT_V(6); PG8_BAR;
    PG8_STAMP();
    for (;;) {
        const bool has_next = S.next(ui + 1, nxt);
        const char* nA = has_next ? (const char*)g.A + (size_t)nxt.pm * tstepA : cA; const char* nB = has_next ? (const char*)g.Bt + (size_t)nxt.pn * tstep : cB;
        for (int t = 0; t < nt; t += 2) {
            const bool last = (t == nt - 2);
            const char* a1 = cA + (size_t)(t + 1) * kstep;
            const char* a2 = last ? nA : cA + (size_t)(t + 2) * kstep; const char* b2 = last ? nB : cB + (size_t)(t + 2) * kstep;
            const char* a3 = a2 + kstep; const char* b3 = b2 + kstep;
            if (last && has_next) S.a_ready(nxt);
            PG8_LDB(B0, 0, 0); PG8_SCHED; PG8_LDA(At, 0, 0); PG8_STAGE(PG8_SA(1, 1), a1 + hstepA, voffA);
            PG8_WAIT_L(8); PG8_BAR; PG8_WAIT_L(0); PG8_MMA(0, 0, At, B0); PG8_BAR; PG8_SCHED;
            PG8_LDB(B1, 0, 1); PG8_STAGE(PG8_SB(0, 0), b2, voffB);
            PG8_BAR; PG8_WAIT_L(0); PG8_MMA(0, 1, At, B1); PG8_BAR;
            PG8_LDA(At, 0, 1); PG8_STAGE(PG8_SA(0, 0), a2, voffA);
            PG8_BAR; PG8_WAIT_L(0); PG8_MMA(1, 0, At, B0); PG8_BAR; PG8_SCHED;
            PG8_STAGE(PG8_SB(0, 1), b2 + hstep, voffB);
            PG8_WAIT_V(6); PG8_BAR; PG8_MMA(1, 1, At, B1); PG8_BAR;
            PG8_LDB(B0, 1, 0); PG8_SCHED; PG8_LDA(At, 1, 0); PG8_STAGE(PG8_SA(0, 1), a2 + hstepA, voffA);
            PG8_WAIT_L(8); PG8_BAR; PG8_WAIT_L(0); PG8_MMA(0, 0, At, B0); PG8_BAR; PG8_SCHED;
            PG8_LDB(B1, 1, 1); PG8_STAGE(PG8_SB(1, 0), b3, voffB);
            PG8_BAR; PG8_WAIT_L(0); PG8_MMA(0, 1, At, B1); PG8_BAR;
            PG8_LDA(At, 1, 1); PG8_STAGE(PG8_SA(1, 0), a3, voffA);
            PG8_BAR; PG8_WAIT_L(0); PG8_MMA(1, 0, At, B0); PG8_BAR; PG8_SCHED;
            PG8_STAGE(PG8_SB(1, 1), b3 + hstep, voffB);
            PG8_WAIT_V(6); PG8_BAR; PG8_MMA(1, 1, At, B1); PG8_BAR;
        }
        PG8_STAMP();
        if constexpr (!Epi::AFTER_DRAIN) { E(acc, cur, wr, wc, fr, fq); S.done(cur); }
        PG8_STAMP();
        if (!has_next) break;
#pragma unroll
        for (int a = 0; a < 2; ++a)
#pragma unroll
            for (int b = 0; b < 2; ++b)
#pragma unroll
                for (int m = 0; m < 4; ++m)
#pragma unroll
                    for (int n = 0; n < 2; ++n) acc[a][b][m][n] = (f32x4){0.f, 0.f, 0.f, 0.f};
        cur = nxt; cA = nA; cB = nB; ++ui;
    }
    PG8_WAIT_V(0);
    if (wr == 0) PG8_BAR;
    PG8_BAR;
    if constexpr (Epi::AFTER_DRAIN) { E.fused(acc, cur, wr, wc, fr, fq, lds, wid, lane); S.done(cur); }
    PG8_STAMP();
    if (STAMP && wid == 0) { stamps[lane] = lane < nts ? (((unsigned long long)(unsigned)ts_hi << 32) | (unsigned)ts_lo) : 0ull;
        if (lane == 62) stamps[62] = rt_entry; if (lane == 63) stamps[63] = (unsigned long long)wall_clock64(); }
#undef PG8_STAMP
#undef PG8_SA
#undef PG8_SB
#undef PG8_STAGE
#undef PG8_LDA
#undef PG8_LDB
#undef PG8_MMA
#undef PG8_WAIT_V
#undef PG8_WAIT_L
#undef PG8_BAR
#undef PG8_SCHED
}
}
typedef unsigned short bf16_t;
constexpr int T_TOK = 32768, DM = 1024, D_IN = 4096, D_HY = 512, D_HG = 512, DFF = 4096, NLAYER = 4;
constexpr int L_BIG = 16384, L_SML = 4096;
constexpr int APAD = 256;
constexpr size_t MiB = 1024ull * 1024ull;
constexpr size_t OFF_W = 0;
constexpr size_t OFF_W_IN = OFF_W, OFF_W_OUT = OFF_W + 8 * MiB, OFF_W_UP = OFF_W + 10 * MiB, OFF_W_DN = OFF_W + 26 * MiB;
constexpr size_t OFF_ABUF = 34 * MiB;
constexpr size_t OFF_R1 = 99 * MiB;
constexpr size_t OFF_HYRAW = OFF_R1;
constexpr size_t OFF_HG = OFF_R1 + 96 * MiB;
constexpr size_t OFF_KT = OFF_R1;
constexpr size_t OFF_ACT = OFF_R1;
constexpr size_t OFF_R2 = 355 * MiB;
constexpr size_t OFF_X0T = OFF_R2, OFF_ZT = OFF_R2 + 32 * MiB;
constexpr size_t OFF_MIX = OFF_R2;
constexpr size_t OFF_UPART = OFF_R2;
constexpr size_t OFF_R6 = 419 * MiB;
constexpr size_t OFF_OBUF = OFF_R6;
constexpr size_t OFF_KS = OFF_R6;
constexpr size_t OFF_SMALL = 483 * MiB;
constexpr size_t OFF_BAR = OFF_SMALL + 4 * MiB;
constexpr size_t WS_NEED = 488 * MiB;

struct P { const float* in[26]; float* out; unsigned char* ws; };
constexpr int PB_norm_mix_pre = 0;
constexpr int PB_norm_mix_post = 4096;
constexpr int PB_norm_ffn_pre = 8192;
constexpr int PB_norm_ffn_post = 12288;
constexpr int PB_hy_conv_w = 16384;
constexpr int PB_hy_conv_b = 34816;
constexpr int PB_f_w1 = 40960;
constexpr int PB_f_b1 = 49408;
constexpr int PB_f_w2 = 49664;
constexpr int PB_f_b2 = 66048;
constexpr int PB_f_w3 = 66304;
constexpr int PB_f_b3 = 82688;
constexpr int PB_f_w4 = 82944;
constexpr int PB_f_freq = 345088;
constexpr int PB_hy_skip = 345344;
constexpr int PB_hy_out_norm = 347392;
constexpr int PB_lb_table = 349440;
constexpr int PB_hg_out_norm = 353536;
constexpr int PB_ffn_conv_w = 355584;
constexpr int PB_ffn_conv_b = 453888;
constexpr int PB_TOTAL = 486656;
constexpr size_t OFF_PB = OFF_SMALL + 512 * 1024;
#define PRM(p, NAME) ((const float*)((p).ws + OFF_PB) + PB_##NAME)

__device__ __forceinline__ float bf2f(bf16_t b) { return __uint_as_float(((unsigned)b) << 16); }
__device__ __forceinline__ bf16_t f2bf(float f) { unsigned u = __float_as_uint(f); u += 0x7FFFu + ((u >> 16) & 1u); return (bf16_t)(u >> 16); }
__device__ __forceinline__ unsigned pack_bf2(float lo, float hi) { return (unsigned)f2bf(lo) | ((unsigned)f2bf(hi) << 16); }
__device__ __forceinline__ bool seq_start(int t) { return t < L_BIG ? (t == 0) : ((t & (L_SML - 1)) == 0); }
__device__ __forceinline__ bool seq_end(int t) { return (t + 1 == T_TOK) || seq_start(t + 1); }
__device__ __forceinline__ const float* x_src_row(const P& p, int l, int t) {
    if (l > 0) return p.out + (size_t)t * DM;
    return t < L_BIG ? p.in[0] + (size_t)t * DM : p.in[1] + (size_t)(t - L_BIG) * DM;
}
__device__ __forceinline__ float silu_f(float x) { return x / (1.0f + __expf(-x)); }
__device__ __forceinline__ float wave_sum(float v) {
#pragma unroll
    for (int o = 32; o >= 1; o >>= 1) v += __shfl_xor(v, o);
    return v;
}

struct EpiBf16Split {
    static constexpr bool PERM = true, AFTER_DRAIN = false, OVL = false;
    bf16_t* O0; int ldc0; bf16_t* O1; int ldc1; int csplit;
    __device__ __forceinline__ void operator()(const pg8::f32x4 (&acc)[2][2][4][2], const pg8::Unit& u, int wr, int wc, int fr, int fq) const {
        const int row0 = u.pm * pg8::BM + wr * 64 + fr; int colt = u.pn * pg8::BM; bf16_t* base = O0; int ldc = ldc0;
        if (colt >= csplit) { base = O1; ldc = ldc1; colt -= csplit; }
        const int col0 = colt + wc * 32 + 8 * fq;
#pragma unroll
        for (int ai = 0; ai < 2; ++ai)
#pragma unroll
            for (int m = 0; m < 4; ++m) { bf16_t* rowp = base + (size_t)(row0 + ai * pg8::HALF + m * 16) * ldc + col0;
#pragma unroll
                for (int bj = 0; bj < 2; ++bj) { const pg8::f32x4 v0 = acc[ai][bj][m][0], v1 = acc[ai][bj][m][1];
                    pg8::u32x4 w; w.x = pg8::cvt_pk_bf16(v0[0], v0[1]); w.y = pg8::cvt_pk_bf16(v0[2], v0[3]); w.z = pg8::cvt_pk_bf16(v1[0], v1[1]); w.w = pg8::cvt_pk_bf16(v1[2], v1[3]);
                    *(pg8::u32x4*)(rowp + bj * pg8::HALF) = w; } }
    }
};
__device__ __forceinline__ float dpp_ror1(float v) { return __int_as_float(__builtin_amdgcn_update_dpp(0, __float_as_int(v), 0x121, 0xF, 0xF, false)); }
__device__ __forceinline__ float dpp_ror15(float v) { return __int_as_float(__builtin_amdgcn_update_dpp(0, __float_as_int(v), 0x12F, 0xF, 0xF, false)); }
__device__ __forceinline__ float gelu_tanh_e(float x) { const float y = 1.5957691216057308f * (x + 0.044715f * x * x * x); return x * __builtin_amdgcn_rcpf(1.0f + __expf(-y)); }
struct EpiGeglu {
    static constexpr bool PERM = true, AFTER_DRAIN = false, OVL = true;
    bf16_t* act; const float* cw; const float* cb;
    __device__ __forceinline__ void operator()(const pg8::f32x4 (&acc)[2][2][4][2], const pg8::Unit& u, int wr, int wc, int fr, int fq) const {
        const int j0 = u.pn * 128 + wc * 32 + 8 * fq;
        unsigned mprev = 0, mnext = 0, mst = 0;
#pragma unroll
        for (int ai = 0; ai < 2; ++ai)
#pragma unroll
            for (int m = 0; m < 4; ++m) { const int q = 16 * m + fr, tok = u.pm * 248 + 124 * ai + 62 * wr + q - 1, b = ai * 4 + m;
                const bool st = q >= 1 && q <= 62 && tok < T_TOK;
                if (st) { mst |= 1u << b; if (!seq_start(tok)) mprev |= 1u << b; if (!seq_end(tok)) mnext |= 1u << b; } }
#pragma unroll
        for (int n = 0; n < 2; ++n) {
            const int jc = j0 + 4 * n;
            const pg8::f32x4 wa0 = *(const pg8::f32x4*)(cw + jc), wa1 = *(const pg8::f32x4*)(cw + 8192 + jc), wa2 = *(const pg8::f32x4*)(cw + 16384 + jc), ba = *(const pg8::f32x4*)(cb + jc);
            const pg8::f32x4 wb0 = *(const pg8::f32x4*)(cw + 4096 + jc), wb1 = *(const pg8::f32x4*)(cw + 8192 + 4096 + jc), wb2 = *(const pg8::f32x4*)(cw + 16384 + 4096 + jc), bb = *(const pg8::f32x4*)(cb + 4096 + jc);
#pragma unroll
            for (int ai = 0; ai < 2; ++ai) {
                pg8::f32x4 pa_prev, pb_prev, na_cur, nb_cur;
#pragma unroll
                for (int i = 0; i < 4; ++i) { na_cur[i] = dpp_ror15(acc[ai][0][0][n][i]); nb_cur[i] = dpp_ror15(acc[ai][1][0][n][i]); pa_prev[i] = 0.f; pb_prev[i] = 0.f; }
#pragma unroll
                for (int m = 0; m < 4; ++m) {
                    const int b = ai * 4 + m, q = 16 * m + fr, tok = u.pm * 248 + 124 * ai + 62 * wr + q - 1;
                    const bool hp = (mprev >> b) & 1u, hn = (mnext >> b) & 1u;
                    pg8::f32x4 pa_cur, pb_cur, na_next, nb_next;
#pragma unroll
                    for (int i = 0; i < 4; ++i) { pa_cur[i] = dpp_ror1(acc[ai][0][m][n][i]); pb_cur[i] = dpp_ror1(acc[ai][1][m][n][i]);
                        na_next[i] = m < 3 ? dpp_ror15(acc[ai][0][m < 3 ? m + 1 : 3][n][i]) : 0.f; nb_next[i] = m < 3 ? dpp_ror15(acc[ai][1][m < 3 ? m + 1 : 3][n][i]) : 0.f; }
                    const pg8::f32x4 xpa = (fr == 0) ? pa_prev : pa_cur, xna = (fr == 15) ? na_next : na_cur;
                    const pg8::f32x4 xpb = (fr == 0) ? pb_prev : pb_cur, xnb = (fr == 15) ? nb_next : nb_cur;
                    const pg8::f32x4 xa = acc[ai][0][m][n], xb = acc[ai][1][m][n];
                    float o[4];
#pragma unroll
                    for (int i = 0; i < 4; ++i) {
                        const float ya = (hp ? xpa[i] * wa0[i] : 0.f) + xa[i] * wa1[i] + (hn ? xna[i] * wa2[i] : 0.f) + ba[i];
                        const float yb = (hp ? xpb[i] * wb0[i] : 0.f) + xb[i] * wb1[i] + (hn ? xnb[i] * wb2[i] : 0.f) + bb[i];
                        o[i] = gelu_tanh_e(ya) * yb;
                    }
                    if ((mst >> b) & 1u) { uint2 w; w.x = pg8::cvt_pk_bf16(o[0], o[1]); w.y = pg8::cvt_pk_bf16(o[2], o[3]); *(uint2*)(act + (size_t)tok * DFF + jc) = w; }
                    pa_prev = pa_cur; pb_prev = pb_cur; na_cur = na_next; nb_cur = nb_next;
                }
            }
        }
    }
};
template <class Epi>
__device__ __forceinline__ void run_gemm(LAS unsigned char* lds, const bf16_t* A, const bf16_t* Bt, int M, int N, int K, const Epi& E) {
    pg8::Gemm g; g.A = A; g.Bt = Bt; g.M = M; g.N = N; g.K = K; g.ovl = Epi::OVL ? 1 : 0;
    int gx = (int)gridDim.x, bx = (int)blockIdx.x; asm volatile("" : "+s"(gx), "+s"(bx));
    pg8::StaticOrder S; S.init(M, N, gx, bx);
    pg8::gemm_phase<Epi, pg8::StaticOrder, false>((PG8_LAS unsigned char*)lds, g, S, E, nullptr);
}

#define HD_INLINE __device__ __forceinline__
#define DEV_FN __device__ __forceinline__
#define LDS_F2 LAS cf2*
#define NTHR 512
#define PADI(i) ((i) + ((i) >> 5))
#define FOR_TID for (int tid = (int)TIDX, once_ = 1; once_; once_ = 0)
#define SYNC __syncthreads()
#define BREV32(x) __brev(x)
#define CIS_REV(fr, c, s) do { const float f_ = (fr); c = __builtin_amdgcn_cosf(f_); s = __builtin_amdgcn_sinf(f_); } while (0)
HD_INLINE unsigned rev4(unsigned k, int S) {
    unsigned v = BREV32(k) >> (32 - 2 * S);
    return ((v & 0xAAAAAAAAu) >> 1) | ((v & 0x55555555u) << 1);
}
HD_INLINE cf2 mkf2(float a, float b) { cf2 r; r.x = a; r.y = b; return r; }
HD_INLINE cf2 cmul(cf2 a, cf2 b) { return mkf2(a.x * b.x - a.y * b.y, a.x * b.y + a.y * b.x); }
HD_INLINE cf2 cmulc(cf2 a, cf2 b) { return mkf2(a.x * b.x + a.y * b.y, a.y * b.x - a.x * b.y); }

DEV_FN void fft_fwd(LDS_F2 X, int S, int s0) {
    const int M = 1 << (2 * S);
    for (int s = s0; s < S; ++s) {
        const int n = M >> (2 * s), q = n >> 2;
        const float invn = 1.0f / (float)n;
        FOR_TID {
#pragma unroll 4
            for (int b = tid; b < (M >> 2); b += NTHR) {
                const int j = b & (q - 1), base = ((b - j) << 2) + j;
                const cf2 a0 = X[PADI(base)], a1 = X[PADI(base + q)], a2 = X[PADI(base + 2 * q)], a3 = X[PADI(base + 3 * q)];
                const cf2 t0 = mkf2(a0.x + a2.x, a0.y + a2.y), t1 = mkf2(a0.x - a2.x, a0.y - a2.y);
                const cf2 t2 = mkf2(a1.x + a3.x, a1.y + a3.y);
                const cf2 d13 = mkf2(a1.x - a3.x, a1.y - a3.y);
                const cf2 t3 = mkf2(d13.y, -d13.x);
                const cf2 y0 = mkf2(t0.x + t2.x, t0.y + t2.y);
                cf2 y1 = mkf2(t1.x + t3.x, t1.y + t3.y);
                cf2 y2 = mkf2(t0.x - t2.x, t0.y - t2.y);
                cf2 y3 = mkf2(t1.x - t3.x, t1.y - t3.y);
                if (q > 1) {
                    const float fr = (float)j * invn;
                    float c1, s1; CIS_REV(fr, c1, s1);
                    const cf2 w1 = mkf2(c1, -s1), w2 = cmul(w1, w1), w3 = cmul(w2, w1);
                    y1 = cmul(y1, w1); y2 = cmul(y2, w2); y3 = cmul(y3, w3);
                }
                X[PADI(base)] = y0; X[PADI(base + q)] = y1; X[PADI(base + 2 * q)] = y2; X[PADI(base + 3 * q)] = y3;
            }
        }
        SYNC;
    }
}
DEV_FN void fft_inv(LDS_F2 X, int S) {
    const int M = 1 << (2 * S);
    for (int s = S - 1; s >= 0; --s) {
        const int n = M >> (2 * s), q = n >> 2;
        const float invn = 1.0f / (float)n;
        FOR_TID {
#pragma unroll 4
            for (int b = tid; b < (M >> 2); b += NTHR) {
                const int j = b & (q - 1), base = ((b - j) << 2) + j;
                cf2 b0 = X[PADI(base)], b1 = X[PADI(base + q)], b2 = X[PADI(base + 2 * q)], b3 = X[PADI(base + 3 * q)];
                if (q > 1) {
                    const float fr = (float)j * invn;
                    float c1, s1; CIS_REV(fr, c1, s1);
                    const cf2 w1 = mkf2(c1, s1), w2 = cmul(w1, w1), w3 = cmul(w2, w1);
                    b1 = cmul(b1, w1); b2 = cmul(b2, w2); b3 = cmul(b3, w3);
                }
                const cf2 t0 = mkf2(b0.x + b2.x, b0.y + b2.y), t1 = mkf2(b0.x - b2.x, b0.y - b2.y);
                const cf2 t2 = mkf2(b1.x + b3.x, b1.y + b3.y);
                const cf2 d13 = mkf2(b1.x - b3.x, b1.y - b3.y);
                const cf2 t3 = mkf2(-d13.y, d13.x);
                X[PADI(base)] = mkf2(t0.x + t2.x, t0.y + t2.y);
                X[PADI(base + q)] = mkf2(t1.x + t3.x, t1.y + t3.y);
                X[PADI(base + 2 * q)] = mkf2(t0.x - t2.x, t0.y - t2.y);
                X[PADI(base + 3 * q)] = mkf2(t1.x - t3.x, t1.y - t3.y);
            }
        }
        SYNC;
    }
}
DEV_FN void spec_store(LDS_F2 X, int S, cf2* Ks) {
    const int M = 1 << (2 * S);
    FOR_TID {
        for (int k = tid; k <= (M >> 1); k += NTHR) {
            if (k == 0) { const cf2 c0 = X[PADI(0)]; Ks[0] = mkf2(c0.x + c0.y, c0.x - c0.y); }
            else {
                const cf2 ck = X[PADI(rev4((unsigned)k, S))], cm = X[PADI(rev4((unsigned)(M - k), S))];
                const cf2 P = mkf2(0.5f * (ck.x + cm.x), 0.5f * (ck.y - cm.y));
                const cf2 O = mkf2(0.5f * (ck.y + cm.y), -0.5f * (ck.x - cm.x));
                float c, s; CIS_REV((float)k / (float)(2 * M), c, s);
                const cf2 Q = cmul(O, mkf2(c, -s));
                Ks[k] = mkf2(P.x + Q.x, P.y + Q.y);
                Ks[M - k] = mkf2(P.x - Q.x, -(P.y - Q.y));
            }
        }
    }
    SYNC;
}
DEV_FN void spec_mul(LDS_F2 X, int S, const cf2* Ks) {
    const int M = 1 << (2 * S);
    FOR_TID {
        for (int k = tid; k <= (M >> 1); k += NTHR) {
            if (k == 0) {
                const cf2 c0 = X[PADI(0)], k0 = Ks[0];
                const float y0 = (c0.x + c0.y) * k0.x, ym = (c0.x - c0.y) * k0.y;
                X[PADI(0)] = mkf2(0.5f * (y0 + ym), 0.5f * (y0 - ym));
            } else {
                const unsigned pk = rev4((unsigned)k, S), pm = rev4((unsigned)(M - k), S);
                const cf2 ck = X[PADI(pk)], cm = X[PADI(pm)];
                const cf2 P = mkf2(0.5f * (ck.x + cm.x), 0.5f * (ck.y - cm.y));
                const cf2 O = mkf2(0.5f * (ck.y + cm.y), -0.5f * (ck.x - cm.x));
                float c, s; CIS_REV((float)k / (float)(2 * M), c, s);
                const cf2 Wk = mkf2(c, -s);
                const cf2 Q = cmul(O, Wk);
                const cf2 xk = mkf2(P.x + Q.x, P.y + Q.y), xm = mkf2(P.x - Q.x, -(P.y - Q.y));
                const cf2 yk = cmul(xk, Ks[k]), ym = cmul(xm, Ks[M - k]);
                const cf2 Ye = mkf2(0.5f * (yk.x + ym.x), 0.5f * (yk.y - ym.y));
                const cf2 Yd = mkf2(0.5f * (yk.x - ym.x), 0.5f * (yk.y + ym.y));
                const cf2 Yo = cmulc(Yd, Wk);
                X[PADI(pk)] = mkf2(Ye.x - Yo.y, Ye.y + Yo.x);
                if (k != (M >> 1)) X[PADI(pm)] = mkf2(Ye.x + Yo.y, -Ye.y + Yo.x);
            }
        }
    }
    SYNC;
}
__device__ void ph_setup(const P& p) {
    const int gid = blockIdx.x * 512 + TIDX;
    if (gid < 2 * D_HG) {
        const int dir = gid / D_HG, c = gid % D_HG;
        float v[NLAYER], mx = -1e30f;
#pragma unroll
        for (int l = 0; l < NLAYER; ++l) { v[l] = p.in[19][(size_t)(dir * NLAYER + l) * D_HG + c]; mx = fmaxf(mx, v[l]); }
        float s = 0.f;
#pragma unroll
        for (int l = 0; l < NLAYER; ++l) { v[l] = expf(v[l] - mx); s += v[l]; }
        float* lbs = (float*)(p.ws + OFF_SMALL);
        float cum = 0.f;
#pragma unroll
        for (int l = 0; l < NLAYER; ++l) { if (l > 0) cum += v[l] / s; lbs[(size_t)(dir * NLAYER + l) * D_HG + c] = cum; }
    }
}
__device__ void ph_copy_params(const P& p) {
    float* pb = (float*)(p.ws + OFF_PB);
    const int g = blockIdx.x * 512 + TIDX, gs = gridDim.x * 512;
    for (int k = g; k < 4096; k += gs) pb[0 + k] = p.in[2][k];
    for (int k = g; k < 4096; k += gs) pb[4096 + k] = p.in[3][k];
    for (int k = g; k < 4096; k += gs) pb[8192 + k] = p.in[4][k];
    for (int k = g; k < 4096; k += gs) pb[12288 + k] = p.in[5][k];
    for (int k = g; k < 18432; k += gs) pb[16384 + k] = p.in[7][k];
    for (int k = g; k < 6144; k += gs) pb[34816 + k] = p.in[8][k];
    for (int k = g; k < 8448; k += gs) pb[40960 + k] = p.in[9][k];
    for (int k = g; k < 256; k += gs) pb[49408 + k] = p.in[10][k];
    for (int k = g; k < 16384; k += gs) pb[49664 + k] = p.in[11][k];
    for (int k = g; k < 256; k += gs) pb[66048 + k] = p.in[12][k];
    for (int k = g; k < 16384; k += gs) pb[66304 + k] = p.in[13][k];
    for (int k = g; k < 256; k += gs) pb[82688 + k] = p.in[14][k];
    for (int k = g; k < 262144; k += gs) pb[82944 + k] = p.in[15][k];
    for (int k = g; k < 256; k += gs) pb[345088 + k] = p.in[16][k];
    for (int k = g; k < 2048; k += gs) pb[345344 + k] = p.in[17][k];
    for (int k = g; k < 2048; k += gs) pb[347392 + k] = p.in[18][k];
    for (int k = g; k < 4096; k += gs) pb[349440 + k] = p.in[19][k];
    for (int k = g; k < 2048; k += gs) pb[353536 + k] = p.in[20][k];
    for (int k = g; k < 98304; k += gs) pb[355584 + k] = p.in[23][k];
    for (int k = g; k < 32768; k += gs) pb[453888 + k] = p.in[24][k];
}
__device__ void convert_one(const float* src, bf16_t* dst, int K, int N, LAS float* tile  , bool geglu_perm = false) {
    const int tiles_n = N / 64, ntiles = (K / 64) * tiles_n, tid = TIDX;
    for (int it = blockIdx.x; it < ntiles; it += gridDim.x) {
        const int k0 = (it / tiles_n) * 64, n0 = (it % tiles_n) * 64;
#pragma unroll
        for (int i = 0; i < 8; ++i) { const int r = (tid >> 6) + 8 * i, c = tid & 63; tile[r * 65 + c] = src[(size_t)(k0 + r) * N + n0 + c]; }
        __syncthreads();
#pragma unroll
        for (int i = 0; i < 8; ++i) { const int n = (tid >> 6) + 8 * i, k = tid & 63; int nr = n0 + n;
            if (geglu_perm) nr = nr < DFF ? (nr >> 7) * 256 + (nr & 127) : ((nr - DFF) >> 7) * 256 + 128 + ((nr - DFF) & 127);
            dst[(size_t)nr * K + k0 + k] = f2bf(tile[k * 65 + n]); }
        __syncthreads();
    }
}
__device__ void ph_convert_w(const P& p, int l, LAS unsigned char* lds) {
    LAS float* tile = (LAS float*)lds;
    convert_one(p.in[6] + (size_t)l * DM * D_IN, (bf16_t*)(p.ws + OFF_W_IN), DM, D_IN, tile);
    convert_one(p.in[21] + (size_t)l * DM * DM, (bf16_t*)(p.ws + OFF_W_OUT), DM, DM, tile);
    convert_one(p.in[22] + (size_t)l * DM * 2 * DFF, (bf16_t*)(p.ws + OFF_W_UP), DM, 2 * DFF, tile, true);
    convert_one(p.in[25] + (size_t)l * DFF * DM, (bf16_t*)(p.ws + OFF_W_DN), DFF, DM, tile);
}
__device__ __forceinline__ bf16_t* abuf_row(const P& p, int t) { return (bf16_t*)(p.ws + OFF_ABUF) + (size_t)(t + APAD) * DM; }
__device__ void ph_rmsnorm_in(const P& p, int l) {
    const int lane = TIDX & 63, wv = TIDX >> 6;
    const float* gain = p.in[2] + (size_t)l * DM;
    for (int t = blockIdx.x * 8 + wv; t < T_TOK; t += gridDim.x * 8) {
        const float* xr = x_src_row(p, l, t);
        float4 v[4]; float ss = 0.f;
#pragma unroll
        for (int i = 0; i < 4; ++i) { v[i] = *(const float4*)(xr + lane * 4 + 256 * i); ss += v[i].x * v[i].x + v[i].y * v[i].y + v[i].z * v[i].z + v[i].w * v[i].w; }
        ss = wave_sum(ss);
        const float r = rsqrtf(ss * (1.0f / DM) + 1e-6f);
        bf16_t* hr = abuf_row(p, t);
#pragma unroll
        for (int i = 0; i < 4; ++i) { const float4 g = *(const float4*)(gain + lane * 4 + 256 * i);
            uint2 w; w.x = pack_bf2(v[i].x * r * g.x, v[i].y * r * g.y); w.y = pack_bf2(v[i].z * r * g.z, v[i].w * r * g.w);
            *(uint2*)(hr + lane * 4 + 256 * i) = w; }
    }
}
__device__ void ph_norm_resid(const P& p, int l, int which) {
    const int lane = TIDX & 63, wv = TIDX >> 6;
    const float* gpost = (which == 0 ? PRM(p, norm_mix_post) : PRM(p, norm_ffn_post)) + (size_t)l * DM;
    const bool has_next = (which == 0) || (l + 1 < NLAYER);
    const float* gnext = which == 0 ? PRM(p, norm_ffn_pre) + (size_t)l * DM : PRM(p, norm_mix_pre) + (size_t)(has_next ? l + 1 : l) * DM;
    const bf16_t* Y = (const bf16_t*)(p.ws + OFF_MIX);
    const int lx = which == 0 ? l : 1;
    for (int t = blockIdx.x * 8 + wv; t < T_TOK; t += gridDim.x * 8) {
        const float* xr = x_src_row(p, lx, t);
        const bf16_t* yr = Y + (size_t)t * DM;
        float4 x[4], y[4]; float ss = 0.f;
#pragma unroll
        for (int i = 0; i < 4; ++i) { x[i] = *(const float4*)(xr + lane * 4 + 256 * i); const uint2 w = *(const uint2*)(yr + lane * 4 + 256 * i);
            y[i].x = __uint_as_float(w.x << 16); y[i].y = __uint_as_float(w.x & 0xffff0000u); y[i].z = __uint_as_float(w.y << 16); y[i].w = __uint_as_float(w.y & 0xffff0000u);
            ss += y[i].x * y[i].x + y[i].y * y[i].y + y[i].z * y[i].z + y[i].w * y[i].w; }
        ss = wave_sum(ss);
        const float r = rsqrtf(ss * (1.0f / DM) + 1e-6f);
        float s2 = 0.f;
#pragma unroll
        for (int i = 0; i < 4; ++i) { const float4 g = *(const float4*)(gpost + lane * 4 + 256 * i);
            x[i].x += y[i].x * r * g.x; x[i].y += y[i].y * r * g.y; x[i].z += y[i].z * r * g.z; x[i].w += y[i].w * r * g.w;
            s2 += x[i].x * x[i].x + x[i].y * x[i].y + x[i].z * x[i].z + x[i].w * x[i].w;
            *(float4*)(p.out + (size_t)t * DM + lane * 4 + 256 * i) = x[i]; }
        if (has_next) {
            s2 = wave_sum(s2);
            const float r2 = rsqrtf(s2 * (1.0f / DM) + 1e-6f);
            bf16_t* hr = abuf_row(p, t);
#pragma unroll
            for (int i = 0; i < 4; ++i) { const float4 g = *(const float4*)(gnext + lane * 4 + 256 * i);
                uint2 w; w.x = pack_bf2(x[i].x * r2 * g.x, x[i].y * r2 * g.y); w.y = pack_bf2(x[i].z * r2 * g.z, x[i].w * r2 * g.w);
                *(uint2*)(hr + lane * 4 + 256 * i) = w; }
        }
    }
}
__device__ void ph_filter(const P& p, int l, LAS unsigned char* lds) {
    LAS float* feats = (LAS float*)lds;
    LAS float* ha = feats + 16 * 36;
    LAS float* hb = ha + 16 * 64;
    LAS float* w1s = hb + 16 * 64;
    LAS float* w2s = w1s + 33 * 64;
    LAS float* w3s = w2s + 64 * 64;
    const int tid = TIDX;
    const float* w1 = PRM(p, f_w1) + (size_t)l * 33 * 64; const float* b1 = PRM(p, f_b1) + (size_t)l * 64;
    const float* w2 = PRM(p, f_w2) + (size_t)l * 64 * 64; const float* b2 = PRM(p, f_b2) + (size_t)l * 64;
    const float* w3 = PRM(p, f_w3) + (size_t)l * 64 * 64; const float* b3 = PRM(p, f_b3) + (size_t)l * 64;
    const float* w4 = PRM(p, f_w4) + (size_t)l * 64 * 1024; const float* fq = PRM(p, f_freq) + (size_t)l * 64;
    float* kt = (float*)(p.ws + OFF_KT);
    for (int i = tid; i < 33 * 64; i += 512) w1s[i] = w1[i];
    for (int i = tid; i < 64 * 64; i += 512) { w2s[i] = w2[i]; w3s[i] = w3[i]; }
    const int j = tid & 63;
    const float fqj = fq[j], b1j = b1[j], b2j = b2[j], b3j = b3[j];
    __syncthreads();
    const int nitems = (L_BIG + L_SML) / 16;
    for (int it = blockIdx.x; it < nitems; it += gridDim.x) {
        const bool big = it < L_BIG / 16; const int L = big ? L_BIG : L_SML; const int pos0 = (big ? it : it - L_BIG / 16) * 16;
        float* ktc = kt + (big ? 0 : (size_t)512 * 2 * L_BIG);
        for (int idx = tid; idx < 16 * 33; idx += 512) {
            const int pp = idx / 33, f = idx % 33; const int pos = pos0 + pp;
            const float tt = (float)pos / (float)(L - 1), ang = (6.283185307179586f / (float)L) * (float)pos;
            float v;
            if (f == 0) v = tt;
            else { const int bi = (f - 1) & 15; const float band = 1e-4f + (float)bi * ((15.0f - 1e-4f) / 15.0f); v = f <= 16 ? cosf(band * ang) : -sinf(band * ang); }
            feats[pp * 36 + f] = v;
        }
        __syncthreads();
#pragma unroll
        for (int h2 = 0; h2 < 2; ++h2) { const int pp = (tid >> 6) + 8 * h2; float a = b1j;
            for (int f = 0; f < 33; ++f) a += feats[pp * 36 + f] * w1s[f * 64 + j];
            ha[pp * 64 + j] = __sinf(fqj * a); }
        __syncthreads();
#pragma unroll
        for (int h2 = 0; h2 < 2; ++h2) { const int pp = (tid >> 6) + 8 * h2; float a = b2j;
#pragma unroll 4
            for (int f4 = 0; f4 < 16; ++f4) { const nf4 hv = *(const LAS nf4*)(ha + pp * 64 + 4 * f4);
                a += hv.x * w2s[(4 * f4) * 64 + j] + hv.y * w2s[(4 * f4 + 1) * 64 + j] + hv.z * w2s[(4 * f4 + 2) * 64 + j] + hv.w * w2s[(4 * f4 + 3) * 64 + j]; }
            hb[pp * 64 + j] = __sinf(fqj * a); }
        __syncthreads();
#pragma unroll
        for (int h2 = 0; h2 < 2; ++h2) { const int pp = (tid >> 6) + 8 * h2; float a = b3j;
#pragma unroll 4
            for (int f4 = 0; f4 < 16; ++f4) { const nf4 hv = *(const LAS nf4*)(hb + pp * 64 + 4 * f4);
                a += hv.x * w3s[(4 * f4) * 64 + j] + hv.y * w3s[(4 * f4 + 1) * 64 + j] + hv.z * w3s[(4 * f4 + 2) * 64 + j] + hv.w * w3s[(4 * f4 + 3) * 64 + j]; }
            ha[pp * 64 + j] = __sinf(fqj * a); }
        __syncthreads();
        {
            float acc0[16], acc1[16];
#pragma unroll
            for (int pp = 0; pp < 16; ++pp) { acc0[pp] = 0.f; acc1[pp] = 0.f; }
            const float* w4p = w4 + 2 * tid;
#pragma unroll 2
            for (int f4 = 0; f4 < 16; ++f4) {
                const cf2 wa = *(const cf2*)(w4p + (4 * f4) * 1024), wb = *(const cf2*)(w4p + (4 * f4 + 1) * 1024), wc = *(const cf2*)(w4p + (4 * f4 + 2) * 1024), wd = *(const cf2*)(w4p + (4 * f4 + 3) * 1024);
#pragma unroll
                for (int pp = 0; pp < 16; ++pp) { const nf4 hv = *(const LAS nf4*)(ha + pp * 64 + 4 * f4);
                    acc0[pp] += hv.x * wa.x + hv.y * wb.x + hv.z * wc.x + hv.w * wd.x;
                    acc1[pp] += hv.x * wa.y + hv.y * wb.y + hv.z * wc.y + hv.w * wd.y; }
            }
            const int o = 2 * tid, dir = o >> 9, c = o & 511;
            const float dstep = (15.350567286626972f - 3.0701134573253945f) / 511.0f;
            const float d0 = 3.0701134573253945f + (float)c * dstep, d1 = d0 + dstep;
            float* dst0 = ktc + (size_t)(c * 2 + dir) * L + pos0; float* dst1 = dst0 + 2 * (size_t)L;
            const float invl = 1.0f / (float)(L - 1);
#pragma unroll
            for (int g = 0; g < 4; ++g) { nf4 v0, v1;
#pragma unroll
                for (int i = 0; i < 4; ++i) { const float tt = (float)(pos0 + 4 * g + i) * invl; v0[i] = acc0[4 * g + i] * __expf(-tt * d0); v1[i] = acc1[4 * g + i] * __expf(-tt * d1); }
                *(nf4*)(dst0 + 4 * g) = v0; *(nf4*)(dst1 + 4 * g) = v1; }
        }
        __syncthreads();
    }
}
__device__ void ph_hy_prep(const P& p, int l, LAS unsigned char* lds) {
    constexpr int RS = 3 * 128 + 8;
    LAS bf16_t* raw = (LAS bf16_t*)lds;
    LAS bf16_t* ox = (LAS bf16_t*)(lds + 52224);
    LAS bf16_t* oz = ox + 128 * 72;
    const bf16_t* hy = (const bf16_t*)(p.ws + OFF_HYRAW);
    bf16_t* x0t = (bf16_t*)(p.ws + OFF_X0T); bf16_t* zt = (bf16_t*)(p.ws + OFF_ZT);
    const float* cw = PRM(p, hy_conv_w) + (size_t)l * 3 * 1536; const float* cb = PRM(p, hy_conv_b) + (size_t)l * 1536;
    const int tid = TIDX, nitems = (T_TOK / 64) * 4;
    for (int it = blockIdx.x; it < nitems; it += gridDim.x) {
        const int t0 = (it >> 2) * 64, c0 = (it & 3) * 128;
        for (int idx = tid; idx < 66 * 48; idx += 512) {
            const int row = idx / 48, rem = idx - row * 48, a = rem >> 4, pc = rem & 15;
            int t = t0 - 1 + row; t = t < 0 ? 0 : (t >= T_TOK ? T_TOK - 1 : t);
            *(LAS nu4*)(raw + row * RS + a * 128 + pc * 8) = *(const nu4*)(hy + (size_t)t * 1536 + a * 512 + c0 + pc * 8);
        }
        __syncthreads();
        {
            const int c = tid & 127, tq = tid >> 7;
            float wv[3][3], bv[3];
#pragma unroll
            for (int a = 0; a < 3; ++a) { bv[a] = cb[a * 512 + c0 + c];
#pragma unroll
                for (int k = 0; k < 3; ++k) wv[a][k] = cw[k * 1536 + a * 512 + c0 + c]; }
            float xm[3], xc[3];
#pragma unroll
            for (int a = 0; a < 3; ++a) { xm[a] = bf2f(raw[(tq * 16) * RS + a * 128 + c]); xc[a] = bf2f(raw[(tq * 16 + 1) * RS + a * 128 + c]); }
            unsigned px = 0, pz = 0;
#pragma unroll
            for (int j = 0; j < 16; ++j) {
                const int tt = tq * 16 + j, t = t0 + tt;
                const bool hp = !seq_start(t), hn = !seq_end(t);
                float r[3];
#pragma unroll
                for (int a = 0; a < 3; ++a) { const float xp = bf2f(raw[(tt + 2) * RS + a * 128 + c]);
                    r[a] = (hp ? xm[a] * wv[a][0] : 0.f) + xc[a] * wv[a][1] + (hn ? xp * wv[a][2] : 0.f) + bv[a];
                    xm[a] = xc[a]; xc[a] = xp; }
                const unsigned bx = f2bf(r[0]), bz = f2bf(r[1] * r[2]);
                if (j & 1) { px |= bx << 16; pz |= bz << 16;
                    *(LAS unsigned*)(ox + c * 72 + tt - 1) = px; *(LAS unsigned*)(oz + c * 72 + tt - 1) = pz; }
                else { px = bx; pz = bz; }
            }
        }
        __syncthreads();
        for (int idx = tid; idx < 128 * 16; idx += 512) {
            const int c = idx >> 4, rem = idx & 15, arr = rem >> 3, pc = rem & 7;
            const nu4 v = *(const LAS nu4*)((arr ? oz : ox) + c * 72 + pc * 8);
            *(nu4*)((arr ? zt : x0t) + (size_t)(c0 + c) * T_TOK + t0 + pc * 8) = v;
        }
        __syncthreads();
    }
}
__device__ __forceinline__ cf2 ld_f2_agent(const cf2* ptr) {
    const unsigned long long w = __hip_atomic_load((const unsigned long long*)ptr, __ATOMIC_RELAXED, __HIP_MEMORY_SCOPE_AGENT);
    return mkf2(__uint_as_float((unsigned)w), __uint_as_float((unsigned)(w >> 32)));
}
DEV_FN void spec_mul_g(LDS_F2 X, int S, const cf2* Ks);
template <int S>
__device__ __forceinline__ void hy_fft_job(const P& p, int l, LAS cf2* X, cf2* Ks, int c, bool big) {
    const int tid = TIDX;
    constexpr int M = 1 << (2 * S), L = M;
    const float* kt = (const float*)(p.ws + OFF_KT);
    const bf16_t* x0t = (const bf16_t*)(p.ws + OFF_X0T); bf16_t* zt = (bf16_t*)(p.ws + OFF_ZT);
    const float* hf = kt + (big ? 0 : (size_t)512 * 2 * L_BIG) + (size_t)(c * 2) * L; const float* hb = hf + L;
#pragma unroll 4
    for (int m = tid; m < M; m += 512) {
        const int n0 = 2 * m, n1 = 2 * m + 1;
        const float a = n0 < L ? hf[n0] : (n0 == L ? 0.f : hb[2 * L - n0]);
        const float b = n1 < L ? hf[n1] : hb[2 * L - n1];
        X[PADI(m)] = mkf2(a, b);
    }
    __syncthreads();
    fft_fwd(X, S, 0);
    spec_store(X, S, Ks);
    __builtin_amdgcn_fence(__ATOMIC_ACQUIRE, "agent");
    asm volatile("s_waitcnt vmcnt(0)" ::: "memory");
    __syncthreads();
    const float skip = PRM(p, hy_skip)[(size_t)l * D_HY + c];
    const int nseq = big ? 1 : 4;
    for (int sq = 0; sq < nseq; ++sq) {
        const int t0 = big ? 0 : L_BIG + sq * L_SML;
        const bf16_t* zrow = zt + (size_t)c * T_TOK + t0; const bf16_t* xrow = x0t + (size_t)c * T_TOK + t0;
#pragma unroll 4
        for (int m = tid; m < M; m += 512) {
            cf2 v = mkf2(0.f, 0.f);
            if (m < (M >> 1)) { const unsigned w = *(const unsigned*)(zrow + 2 * m); v.x = __uint_as_float(w << 16); v.y = __uint_as_float(w & 0xffff0000u); }
            X[PADI(m)] = v;
        }
        __syncthreads();
        fft_fwd(X, S, 0);
        spec_mul_g(X, S, Ks);
        fft_inv(X, S);
        const float inv = 1.0f / (float)M;
        bf16_t* orow = zt + (size_t)c * T_TOK + t0;
#pragma unroll 4
        for (int m = tid; m < (M >> 1); m += 512) {
            const cf2 d = X[PADI(m)];
            const unsigned wz = *(const unsigned*)(zrow + 2 * m), wx = *(const unsigned*)(xrow + 2 * m);
            const float z0 = __uint_as_float(wz << 16), z1 = __uint_as_float(wz & 0xffff0000u), a0 = __uint_as_float(wx << 16), a1 = __uint_as_float(wx & 0xffff0000u);
            *(unsigned*)(orow + 2 * m) = pack_bf2(a0 * (d.x * inv + skip * z0), a1 * (d.y * inv + skip * z1));
        }
        __syncthreads();
    }
}
__device__ void ph_hy_fft(const P& p, int l, LAS unsigned char* lds) {
    LAS cf2* X = (LAS cf2*)lds;
    cf2* Ks = (cf2*)(p.ws + OFF_KS) + (size_t)blockIdx.x * L_BIG;
    for (int job = blockIdx.x; job < 1024; job += gridDim.x) {
        const bool big = job < 512; const int c = job & 511;
        if (big) hy_fft_job<7>(p, l, X, Ks, c, true); else hy_fft_job<6>(p, l, X, Ks, c, false);
    }
}
DEV_FN void spec_mul_g(LDS_F2 X, int S, const cf2* Ks) {
    const int M = 1 << (2 * S);
#pragma unroll 4
    for (int k = TIDX; k <= (M >> 1); k += NTHR) {
        if (k == 0) {
            const cf2 c0 = X[PADI(0)], k0 = Ks[0];
            const float y0 = (c0.x + c0.y) * k0.x, ym = (c0.x - c0.y) * k0.y;
            X[PADI(0)] = mkf2(0.5f * (y0 + ym), 0.5f * (y0 - ym));
        } else {
            const unsigned pk = rev4((unsigned)k, S), pm = rev4((unsigned)(M - k), S);
            const cf2 ck = X[PADI(pk)], cm = X[PADI(pm)];
            const cf2 Pv = mkf2(0.5f * (ck.x + cm.x), 0.5f * (ck.y - cm.y));
            const cf2 O = mkf2(0.5f * (ck.y + cm.y), -0.5f * (ck.x - cm.x));
            float c, s; CIS_REV((float)k / (float)(2 * M), c, s);
            const cf2 Wk = mkf2(c, -s);
            const cf2 Q = cmul(O, Wk);
            const cf2 xk = mkf2(Pv.x + Q.x, Pv.y + Q.y), xm = mkf2(Pv.x - Q.x, -(Pv.y - Q.y));
            const cf2 yk = cmul(xk, Ks[k]), ym = cmul(xm, Ks[M - k]);
            const cf2 Ye = mkf2(0.5f * (yk.x + ym.x), 0.5f * (yk.y - ym.y));
            const cf2 Yd = mkf2(0.5f * (yk.x - ym.x), 0.5f * (yk.y + ym.y));
            const cf2 Yo = cmulc(Yd, Wk);
            X[PADI(pk)] = mkf2(Ye.x - Yo.y, Ye.y + Yo.x);
            if (k != (M >> 1)) X[PADI(pm)] = mkf2(Ye.x + Yo.y, -Ye.y + Yo.x);
        }
    }
    __syncthreads();
}
__device__ void ph_hy_norm(const P& p, int l, LAS unsigned char* lds) {
    LAS bf16_t* tl = (LAS bf16_t*)lds;
    LAS float* red = (LAS float*)(lds + 9216);
    const bf16_t* yh = (const bf16_t*)(p.ws + OFF_ZT);
    const float* gain = PRM(p, hy_out_norm) + (size_t)l * D_HY;
    const int tid = TIDX, nitems = (T_TOK / 64) * 8;
    for (int it = blockIdx.x; it < nitems; it += gridDim.x) {
        const int t0 = (it >> 3) * 64, c0 = (it & 7) * 64;
        { const int cc = tid >> 3, pc = tid & 7;
          *(LAS nu4*)(tl + cc * 72 + pc * 8) = *(const nu4*)(yh + (size_t)(c0 + cc) * T_TOK + t0 + pc * 8); }
        __syncthreads();
        { const int tt = tid & 63, part = tid >> 6; float s = 0.f;
#pragma unroll
          for (int j = 0; j < 8; ++j) { const float v = bf2f(tl[(part * 8 + j) * 72 + tt]); s += v * v; }
          red[part * 64 + tt] = s; }
        __syncthreads();
        { const int tt = tid >> 3, pc = tid & 7;
          float s = 0.f;
#pragma unroll
          for (int j = 0; j < 8; ++j) s += red[j * 64 + tt];
          const float r = rsqrtf(s * (1.0f / 64.0f) + 1e-6f);
          unsigned w[4];
#pragma unroll
          for (int j = 0; j < 4; ++j) { const int ca = pc * 8 + 2 * j;
              w[j] = pack_bf2(bf2f(tl[ca * 72 + tt]) * r * gain[c0 + ca], bf2f(tl[(ca + 1) * 72 + tt]) * r * gain[c0 + ca + 1]); }
          nu4 o; o.x = w[0]; o.y = w[1]; o.z = w[2]; o.w = w[3];
          *(nu4*)(abuf_row(p, t0 + tt) + c0 + pc * 8) = o; }
        __syncthreads();
    }
}
typedef short hbf16x8 __attribute__((ext_vector_type(8)));
typedef float hf32x16 __attribute__((ext_vector_type(16)));
constexpr int HSC = 512, HNCH = HSC / 64, HNSC = T_TOK / HSC;
constexpr int QS = 136, KS_ = 72;
constexpr int HL_QH = 0, HL_KH = HL_QH + 64 * QS * 2, HL_QT = HL_KH + 64 * QS * 2, HL_KT = HL_QT + 64 * QS * 2, HL_VT = HL_KT + 128 * KS_ * 2, HL_ST = HL_VT + 128 * KS_ * 2,
              HL_PM = HL_ST + 128 * QS * 2, HL_TOT = HL_PM + 64 * KS_ * 2, HL_EB = HL_TOT + 4 * 128 * 4, HL_END = HL_EB + 128 * 4;
constexpr int HL_OF = HL_QH, OFS = 132;
static_assert(64 * OFS * 4 <= 2 * 64 * QS * 2, "O tile must fit over Qh|Kh");
constexpr size_t OFF_HST = OFF_R6 + 32 * MiB;
constexpr size_t OFF_HAT = OFF_SMALL + 64 * 1024;

__device__ __forceinline__ hf32x16 mfma32(hbf16x8 a, hbf16x8 b, hf32x16 c) { return __builtin_amdgcn_mfma_f32_32x32x16_bf16(a, b, c, 0, 0, 0); }
__device__ __forceinline__ hbf16x8 lds_frag(const LAS unsigned char* base, int row, int stride_el, int col_el) { return *(const LAS hbf16x8*)(base + ((size_t)row * stride_el + col_el) * 2); }

typedef unsigned hu32x4 __attribute__((ext_vector_type(4)));
struct HgPre { hu32x4 f0, f1, v0, v1, q0, q1; };
template <bool FULL>
__device__ __forceinline__ void hg_fetch(const bf16_t* hg, HgPre& pre, int tokbase, int dirsign, int h, int dir) {
    const int tid = TIDX;
    { const int u = tid >> 4, seg = tid & 15;
      const bf16_t* row = hg + (size_t)(tokbase + dirsign * u) * 2560 + h * 128 + seg * 8;
      pre.f0 = *(const hu32x4*)(row + 512 + 512 * dir); pre.v0 = *(const hu32x4*)(row + 1536); if (FULL) pre.q0 = *(const hu32x4*)(row);
      const bf16_t* row1 = row + (size_t)dirsign * 32 * 2560;
      pre.f1 = *(const hu32x4*)(row1 + 512 + 512 * dir); pre.v1 = *(const hu32x4*)(row1 + 1536); if (FULL) pre.q1 = *(const hu32x4*)(row1); }
}
template <bool FULL>
__device__ __forceinline__ void hg_prep(LAS unsigned char* lds, const HgPre& pre, float lb, float& Bsum_out) {
    const int tid = TIDX, d = tid & 127, qt = tid >> 7;
    LAS float* tot = (LAS float*)(lds + HL_TOT); LAS float* eB = (LAS float*)(lds + HL_EB);
    { const int u = tid >> 4, seg = tid & 15;
      *(LAS hu32x4*)(lds + HL_KH + ((size_t)u * QS + seg * 8) * 2) = pre.f0; *(LAS hu32x4*)(lds + HL_KH + ((size_t)(u + 32) * QS + seg * 8) * 2) = pre.f1;
      *(LAS hu32x4*)(lds + HL_QH + ((size_t)u * QS + seg * 8) * 2) = pre.v0; *(LAS hu32x4*)(lds + HL_QH + ((size_t)(u + 32) * QS + seg * 8) * 2) = pre.v1;
      if (FULL) { *(LAS hu32x4*)(lds + HL_QT + ((size_t)u * QS + seg * 8) * 2) = pre.q0; *(LAS hu32x4*)(lds + HL_QT + ((size_t)(u + 32) * QS + seg * 8) * 2) = pre.q1; } }
    __syncthreads();
    float c[16];
    float run = 0.f;
    const float oml = 1.0f - lb;
#pragma unroll
    for (int j = 0; j < 16; ++j) {
        const int u = qt * 16 + j;
        float z = bf2f(*(const LAS bf16_t*)(lds + HL_KH + ((size_t)u * QS + d) * 2));
        z = fmaxf(z, -60.0f);
        const float f = lb + oml * __builtin_amdgcn_rcpf(1.0f + __expf(-z));
        *(LAS bf16_t*)(lds + HL_KH + ((size_t)u * QS + d) * 2) = f2bf(1.0f - f);
        run += __logf(f);
        c[j] = run;
    }
    tot[qt * 128 + d] = run;
    __syncthreads();
    const float t0 = tot[d], t1 = tot[128 + d], t2 = tot[256 + d], t3 = tot[384 + d];
    const float off = qt == 0 ? 0.f : (qt == 1 ? t0 : (qt == 2 ? t0 + t1 : t0 + t1 + t2));
    const float r = t0 + t1, B = t0 + t1 + t2 + t3;
    const float eBr = __expf(B - r), eR = __expf(r);
    if (qt == 0) eB[d] = __expf(B);
    Bsum_out = B;
#pragma unroll
    for (int jj = 0; jj < 8; ++jj) {
        unsigned pkt = 0, pvt = 0;
#pragma unroll
        for (int q2 = 0; q2 < 2; ++q2) {
            const int j = jj * 2 + q2, u = qt * 16 + j;
            const float rb = r - (off + c[j]);
            const float kh = bf2f(*(const LAS bf16_t*)(lds + HL_KH + ((size_t)u * QS + d) * 2)) * __expf(rb);
            const bf16_t vraw = *(const LAS bf16_t*)(lds + HL_QH + ((size_t)u * QS + d) * 2);
            pkt |= (unsigned)f2bf(kh * eBr) << (16 * q2); pvt |= (unsigned)vraw << (16 * q2);
            if (FULL) {
                const float zq = bf2f(*(const LAS bf16_t*)(lds + HL_QT + ((size_t)u * QS + d) * 2));
                const float q = zq * __builtin_amdgcn_rcpf(1.0f + __expf(-zq));
                const float qh = q * __expf(-rb);
                *(LAS bf16_t*)(lds + HL_QT + ((size_t)u * QS + d) * 2) = f2bf(qh * eR);
                *(LAS bf16_t*)(lds + HL_QH + ((size_t)u * QS + d) * 2) = f2bf(qh);
                *(LAS bf16_t*)(lds + HL_KH + ((size_t)u * QS + d) * 2) = f2bf(kh);
            }
        }
        *(LAS unsigned*)(lds + HL_KT + ((size_t)d * KS_ + qt * 16 + jj * 2) * 2) = pkt;
        *(LAS unsigned*)(lds + HL_VT + ((size_t)d * KS_ + qt * 16 + jj * 2) * 2) = pvt;
    }
    __syncthreads();
}
__device__ __forceinline__ void hg_state_update(LAS unsigned char* lds, hf32x16 (&S)[2], int w, int lane) {
    const int en = w & 3, r = lane & 31, hh = lane >> 5;
    const LAS float* eB = (const LAS float*)(lds + HL_EB);
#pragma unroll
    for (int i = 0; i < 2; ++i) {
        const int dm = (w >> 2) * 2 + i;
#pragma unroll
        for (int g = 0; g < 4; ++g) { const nf4 sc = *(const LAS nf4*)(eB + 32 * dm + 8 * g + 4 * hh);
            S[i][4 * g + 0] *= sc.x; S[i][4 * g + 1] *= sc.y; S[i][4 * g + 2] *= sc.z; S[i][4 * g + 3] *= sc.w; }
#pragma unroll
        for (int ks = 0; ks < 4; ++ks) {
            const hbf16x8 a = lds_frag(lds + HL_KT, 32 * dm + r, KS_, 16 * ks + 8 * hh);
            const hbf16x8 b = lds_frag(lds + HL_VT, 32 * en + r, KS_, 16 * ks + 8 * hh);
            S[i] = mfma32(a, b, S[i]);
        }
    }
}
__device__ __forceinline__ int hg_unit_base(int sc) { return sc * HSC; }
__device__ void ph_hg_pass1(const P& p, int l, LAS unsigned char* lds) {
    const bf16_t* hg = (const bf16_t*)(p.ws + OFF_HG);
    const float* lbs = (const float*)(p.ws + OFF_SMALL);
    float* ust = (float*)(p.ws + OFF_HST); float* atot = (float*)(p.ws + OFF_HAT);
    const int tid = TIDX, w = tid >> 6, lane = tid & 63;
    for (int unit = blockIdx.x; unit < HNSC * 8; unit += gridDim.x) {
        const int sc = unit >> 3, h = (unit >> 1) & 3, dir = unit & 1;
        const float lb = lbs[(size_t)(dir * NLAYER + l) * D_HG + h * 128 + (tid & 127)];
        hf32x16 S[2];
#pragma unroll
        for (int i = 0; i < 2; ++i)
#pragma unroll
            for (int k = 0; k < 16; ++k) S[i][k] = 0.f;
        float Btot = 0.f;
        const int dsg = dir ? -1 : 1, tb0 = dir ? hg_unit_base(sc) + HSC - 1 : hg_unit_base(sc);
        HgPre pre;
        hg_fetch<false>(hg, pre, tb0, dsg, h, dir);
        for (int ci = 0; ci < HNCH; ++ci) {
            float B;
            hg_prep<false>(lds, pre, lb, B);
            if (ci + 1 < HNCH) hg_fetch<false>(hg, pre, tb0 + dsg * (ci + 1) * 64, dsg, h, dir);
            Btot += B;
            hg_state_update(lds, S, w, lane);
            __syncthreads();
        }
        float* U = ust + (size_t)unit * 16384;
        int r = lane & 31, hh = lane >> 5; asm volatile("" : "+v"(r), "+v"(hh));
        const int en = w & 3;
#pragma unroll
        for (int i = 0; i < 2; ++i) { const int dm = (w >> 2) * 2 + i;
#pragma unroll
            for (int k = 0; k < 16; ++k) U[(32 * dm + (k & 3) + 8 * (k >> 2) + 4 * hh) * 128 + 32 * en + r] = S[i][k]; }
        if (tid < 128) atot[(size_t)unit * 128 + tid] = __expf(Btot);
    }
}
__device__ void ph_hg_pass2(const P& p) {
    float* ust = (float*)(p.ws + OFF_HST); const float* atot = (const float*)(p.ws + OFF_HAT);
    const int total = 5 * 8 * 16384;
    for (int idx = blockIdx.x * 512 + TIDX; idx < total; idx += gridDim.x * 512) {
        const int el = idx & 16383, hd = (idx >> 14) & 7, sq = idx >> 17;
        const int sc0 = sq == 0 ? 0 : 32 + 8 * (sq - 1), nsc = sq == 0 ? 32 : 8, dir = hd & 1, d = el >> 7;
        float carry = 0.f;
        for (int j = 0; j < nsc; ++j) {
            const int sc = dir ? sc0 + nsc - 1 - j : sc0 + j;
            const size_t unit = (size_t)sc * 8 + hd;
            const float u = ust[unit * 16384 + el], a = atot[unit * 128 + d];
            ust[unit * 16384 + el] = carry;
            carry = a * carry + u;
        }
    }
}
__device__ void ph_hg_pass3(const P& p, int l, LAS unsigned char* lds) {
    const bf16_t* hg = (const bf16_t*)(p.ws + OFF_HG);
    const float* lbs = (const float*)(p.ws + OFF_SMALL);
    const float* ust = (const float*)(p.ws + OFF_HST);
    const float* gain = PRM(p, hg_out_norm) + (size_t)l * D_HG;
    const int tid = TIDX, w = tid >> 6, lane = tid & 63, r = lane & 31, hh = lane >> 5;
    for (int unit = blockIdx.x; unit < HNSC * 4; unit += gridDim.x) {
        const int sc = unit >> 2, h = unit & 3;
        for (int dir = 0; dir < 2; ++dir) {
            const float lb = lbs[(size_t)(dir * NLAYER + l) * D_HG + h * 128 + (tid & 127)];
            const float* S0 = ust + ((size_t)sc * 8 + h * 2 + dir) * 16384;
            hf32x16 S[2];
            { const int en = w & 3;
              int r_ = r, hh_ = hh; asm volatile("" : "+v"(r_), "+v"(hh_));
              const float* S0l = S0 + (4 * hh_) * 128 + 32 * en + r_;
#pragma unroll
              for (int i = 0; i < 2; ++i) { const int dm = (w >> 2) * 2 + i;
#pragma unroll
                  for (int k = 0; k < 16; ++k) S[i][k] = S0l[(32 * dm + (k & 3) + 8 * (k >> 2)) * 128];
#pragma unroll
                  for (int g = 0; g < 4; ++g) { nu2 wv; wv.x = pack_bf2(S[i][4 * g], S[i][4 * g + 1]); wv.y = pack_bf2(S[i][4 * g + 2], S[i][4 * g + 3]);
                      *(LAS nu2*)(lds + HL_ST + ((size_t)(32 * en + r) * QS + 32 * dm + 8 * g + 4 * hh) * 2) = wv; } } }
            const int dsg = dir ? -1 : 1, tb0 = dir ? hg_unit_base(sc) + HSC - 1 : hg_unit_base(sc);
            HgPre pre;
            hg_fetch<true>(hg, pre, tb0, dsg, h, dir);
            for (int ci = 0; ci < HNCH; ++ci) {
                const int tokbase = tb0 + dsg * ci * 64;
                float Bdummy;
                hg_prep<true>(lds, pre, lb, Bdummy);
                if (ci + 1 < HNCH) hg_fetch<true>(hg, pre, tb0 + dsg * (ci + 1) * 64, dsg, h, dir);
                if (w < 4) {
                    const int tm = (w == 0 || w == 3) ? 0 : 1, sn = (w == 2 || w == 3) ? 1 : 0;
                    hf32x16 acc;
#pragma unroll
                    for (int k = 0; k < 16; ++k) acc[k] = 0.f;
                    if (w < 3) {
#pragma unroll
                        for (int ks = 0; ks < 8; ++ks) acc = mfma32(lds_frag(lds + HL_QH, 32 * tm + r, QS, 16 * ks + 8 * hh), lds_frag(lds + HL_KH, 32 * sn + r, QS, 16 * ks + 8 * hh), acc);
                    }
                    const int s_ = 32 * sn + r;
#pragma unroll
                    for (int k = 0; k < 16; ++k) { const int t_ = 32 * tm + (k & 3) + 8 * (k >> 2) + 4 * hh;
                        const float v = (w < 3 && s_ <= t_) ? acc[k] : 0.f;
                        *(LAS bf16_t*)(lds + HL_PM + ((size_t)t_ * KS_ + s_) * 2) = f2bf(v); }
                }
                __syncthreads();
                hf32x16 o;
                { const int tm = w >> 2, en = w & 3;
#pragma unroll
                  for (int k = 0; k < 16; ++k) o[k] = 0.f;
#pragma unroll
                  for (int ks = 0; ks < 4; ++ks) o = mfma32(lds_frag(lds + HL_PM, 32 * tm + r, KS_, 16 * ks + 8 * hh), lds_frag(lds + HL_VT, 32 * en + r, KS_, 16 * ks + 8 * hh), o);
#pragma unroll
                  for (int ks = 0; ks < 8; ++ks) o = mfma32(lds_frag(lds + HL_QT, 32 * tm + r, QS, 16 * ks + 8 * hh), lds_frag(lds + HL_ST, 32 * en + r, QS, 16 * ks + 8 * hh), o);
                }
                __syncthreads();
                { const int tm = w >> 2, en = w & 3; LAS float* Of = (LAS float*)(lds + HL_OF);
#pragma unroll
                  for (int k = 0; k < 16; ++k) Of[(size_t)(32 * tm + (k & 3) + 8 * (k >> 2) + 4 * hh) * OFS + 32 * en + r] = o[k]; }
                hg_state_update(lds, S, w, lane);
                { const int en = w & 3;
#pragma unroll
                  for (int i = 0; i < 2; ++i) { const int dm = (w >> 2) * 2 + i;
#pragma unroll
                      for (int g = 0; g < 4; ++g) { nu2 wv; wv.x = pack_bf2(S[i][4 * g], S[i][4 * g + 1]); wv.y = pack_bf2(S[i][4 * g + 2], S[i][4 * g + 3]);
                          *(LAS nu2*)(lds + HL_ST + ((size_t)(32 * en + r) * QS + 32 * dm + 8 * g + 4 * hh) * 2) = wv; } } }
                __syncthreads();
                { const int u = tid >> 3, e0 = (tid & 7) * 16, tok = tokbase + dsg * u;
                  const LAS float* Of = (const LAS float*)(lds + HL_OF) + (size_t)u * OFS + e0;
                  bf16_t* dst = abuf_row(p, tok) + 512 + h * 128 + e0;
                  float v[16];
#pragma unroll
                  for (int j = 0; j < 4; ++j) { const nf4 t4 = *(const LAS nf4*)(Of + 4 * j); v[4 * j] = t4.x; v[4 * j + 1] = t4.y; v[4 * j + 2] = t4.z; v[4 * j + 3] = t4.w; }
                  if (dir == 0) {
                      uint4 w0, w1;
                      w0.x = pack_bf2(v[0], v[1]); w0.y = pack_bf2(v[2], v[3]); w0.z = pack_bf2(v[4], v[5]); w0.w = pack_bf2(v[6], v[7]);
                      w1.x = pack_bf2(v[8], v[9]); w1.y = pack_bf2(v[10], v[11]); w1.z = pack_bf2(v[12], v[13]); w1.w = pack_bf2(v[14], v[15]);
                      ((uint4*)dst)[0] = w0; ((uint4*)dst)[1] = w1;
                  } else {
                      const uint4 f0 = ((const uint4*)dst)[0], f1 = ((const uint4*)dst)[1];
                      const unsigned fw[8] = {f0.x, f0.y, f0.z, f0.w, f1.x, f1.y, f1.z, f1.w};
                      float ss = 0.f;
#pragma unroll
                      for (int j = 0; j < 8; ++j) { v[2 * j] += __uint_as_float(fw[j] << 16); v[2 * j + 1] += __uint_as_float(fw[j] & 0xffff0000u); ss += v[2 * j] * v[2 * j] + v[2 * j + 1] * v[2 * j + 1]; }
                      ss += __shfl_xor(ss, 1); ss += __shfl_xor(ss, 2); ss += __shfl_xor(ss, 4);
                      const float rn = rsqrtf(ss * (1.0f / 128.0f) + 1e-6f);
                      const bf16_t* gp = hg + (size_t)tok * 2560 + 2048 + h * 128 + e0;
                      const uint4 g0 = ((const uint4*)gp)[0], g1 = ((const uint4*)gp)[1];
                      const unsigned gw[8] = {g0.x, g0.y, g0.z, g0.w, g1.x, g1.y, g1.z, g1.w};
                      unsigned ow[8];
#pragma unroll
                      for (int j = 0; j < 8; ++j) { const float ga = silu_f(__uint_as_float(gw[j] << 16)), gb = silu_f(__uint_as_float(gw[j] & 0xffff0000u));
                          ow[j] = pack_bf2(v[2 * j] * rn * gain[h * 128 + e0 + 2 * j] * ga, v[2 * j + 1] * rn * gain[h * 128 + e0 + 2 * j + 1] * gb); }
                      ((uint4*)dst)[0] = make_uint4(ow[0], ow[1], ow[2], ow[3]); ((uint4*)dst)[1] = make_uint4(ow[4], ow[5], ow[6], ow[7]);
                  }
                }
                __syncthreads();
            }
        }
    }
}
#define XB_TMO      128
#define XB_XCNT(j)  (256  + 64 * (j))
#define XB_XSUB(j)  (1280 + 64 * (j))
#define XB_XGEN(j)  (2304 + 64 * (j))
#define XB_TOP      3328
#define XB_TOPGEN   3392
#define XCD_BAR_WORDS 3456
#define XB_SPIN_CAP (1u << 18)

__device__ __forceinline__ unsigned xb_ld(unsigned* p)              { return __hip_atomic_load(p, __ATOMIC_RELAXED, __HIP_MEMORY_SCOPE_AGENT); }
__device__ __forceinline__ unsigned xb_add(unsigned* p, unsigned v) { return __hip_atomic_fetch_add(p, v, __ATOMIC_RELAXED, __HIP_MEMORY_SCOPE_AGENT); }
__device__ __forceinline__ unsigned xb_xcc_id() { return (unsigned)__builtin_amdgcn_s_getreg((3 << 11) | 20) & 0xFu; }
#define XB_SPIN(cond, bar) do { unsigned _sp = 0; while (cond) { __builtin_amdgcn_s_sleep(1); \
    if ((++_sp & 255u) == 0u) { if (xb_ld(&(bar)[XB_TMO])) break; if (_sp > XB_SPIN_CAP) { atomicAdd(&(bar)[XB_TMO], 1u); break; } } } } while (0)

struct XcdBarrier {
    unsigned* bar; unsigned x;
    volatile LAS unsigned* st;
};

__device__ __forceinline__ XcdBarrier xcd_barrier_post(unsigned* bar, volatile LAS unsigned* st) {
    XcdBarrier b; b.bar = bar; b.x = xb_xcc_id(); b.st = st;
    if (TIDX == 0) (void)xb_add(&bar[XB_XCNT(b.x)], 1u);
    return b;
}
__device__ __forceinline__ void xcd_barrier_complete(unsigned* bar, unsigned x, unsigned& nloc, unsigned& nx) {
    const unsigned G = gridDim.x * gridDim.y * gridDim.z;
    unsigned sum, cnt, mine, sp = 0u;
    for (;;) {
        sum = 0u; cnt = 0u; mine = 0u;
#pragma unroll
        for (unsigned j = 0; j < 16; ++j) { const unsigned c = xb_ld(&bar[XB_XCNT(j)]); sum += c; cnt += (c > 0u) ? 1u : 0u; mine = (j == x) ? c : mine; }
        if (sum == G) break;
        __builtin_amdgcn_s_sleep(1);
        if ((++sp & 255u) == 0u) { if (xb_ld(&bar[XB_TMO])) break; if (sp > XB_SPIN_CAP) { atomicAdd(&bar[XB_TMO], 1u); break; } }
    }
    nloc = mine > 0u ? mine : 1u; nx = cnt > 0u ? cnt : 1u;
}

__device__ __forceinline__ void xcd_barrier(const XcdBarrier& b) {
    asm volatile("s_waitcnt vmcnt(0)" ::: "memory");
    __syncthreads();
    if (TIDX == 0) {
        unsigned* bar = b.bar;
        __builtin_amdgcn_s_waitcnt(0);
        unsigned nloc = b.st[0], nx = b.st[1];
        if (nloc == 0u) { xcd_barrier_complete(bar, b.x, nloc, nx); b.st[0] = nloc; b.st[1] = nx; }
        const unsigned old = xb_add(&bar[XB_XSUB(b.x)], 1u);
        const unsigned gen = old / nloc;
        if (old + 1u == (gen + 1u) * nloc) {
            __builtin_amdgcn_fence(__ATOMIC_RELEASE, "agent");
            asm volatile("s_waitcnt vmcnt(0)" ::: "memory");
            const unsigned og = xb_add(&bar[XB_TOP], 1u);
            const unsigned tg = og / nx;
            if (og + 1u == (tg + 1u) * nx) xb_add(&bar[XB_TOPGEN], 1u);
            else XB_SPIN(xb_ld(&bar[XB_TOPGEN]) == tg, bar);
            __builtin_amdgcn_fence(__ATOMIC_ACQUIRE, "agent");
            xb_add(&bar[XB_XGEN(b.x)], 1u);
            asm volatile("s_waitcnt vmcnt(0)" ::: "memory");
        } else {
            XB_SPIN(xb_ld(&bar[XB_XGEN(b.x)]) == gen, bar);
            __builtin_amdgcn_fence(__ATOMIC_ACQUIRE, "agent");
            asm volatile("s_waitcnt vmcnt(0)" ::: "memory");
        }
    }
    __syncthreads();
}

enum { PH_SETUP, PH_CONVERT, PH_RMS_IN, PH_GEMM_IN, PH_HY_PREP, PH_FILTER, PH_HGRN, PH_HG_NORM, PH_HY_FFT, PH_HY_NORM, PH_GEMM_OUT, PH_NR0, PH_GEMM_UP, PH_GEGLU, PH_GEMM_DN, PH_NR1, PH_HG_P1, PH_HG_P2, PH_HG_P3 };
template <int PH> __device__ __forceinline__ void run_phase(const P& p_in, int l, int part, LAS unsigned char* lds) {
    P p = p_in; asm volatile("" : "+s"(p.ws), "+s"(p.out));
    p.ws = (unsigned char*)(__attribute__((address_space(1))) unsigned char*)p.ws; p.out = (float*)(__attribute__((address_space(1))) float*)p.out;
    if constexpr (PH == PH_SETUP) { ph_setup(p); ph_copy_params(p); }
    if constexpr (PH == PH_CONVERT) ph_convert_w(p, l, lds);
    if constexpr (PH == PH_RMS_IN) ph_rmsnorm_in(p, l);
    if constexpr (PH == PH_GEMM_IN) { EpiBf16Split E; E.O0 = (bf16_t*)(p.ws + OFF_HYRAW); E.ldc0 = 1536; E.O1 = (bf16_t*)(p.ws + OFF_HG); E.ldc1 = 2560; E.csplit = 1536;
        run_gemm(lds, abuf_row(p, 0), (const bf16_t*)(p.ws + OFF_W_IN), T_TOK, D_IN, DM, E); }
    if constexpr (PH == PH_HY_PREP) ph_hy_prep(p, l, lds);
    if constexpr (PH == PH_FILTER) ph_filter(p, l, lds);
    if constexpr (PH == PH_HY_FFT) ph_hy_fft(p, l, lds);
    if constexpr (PH == PH_HY_NORM) ph_hy_norm(p, l, lds);
    if constexpr (PH == PH_GEMM_OUT) { EpiBf16Split E; E.O0 = (bf16_t*)(p.ws + OFF_MIX); E.ldc0 = DM; E.O1 = E.O0; E.ldc1 = DM; E.csplit = 1 << 30;
        run_gemm(lds, abuf_row(p, 0), (const bf16_t*)(p.ws + OFF_W_OUT), T_TOK, DM, DM, E); }
    if constexpr (PH == PH_NR0) ph_norm_resid(p, l, 0);
    if constexpr (PH == PH_GEMM_UP) { EpiGeglu E; E.act = (bf16_t*)(p.ws + OFF_ACT); E.cw = PRM(p, ffn_conv_w) + (size_t)l * 3 * 8192; E.cb = PRM(p, ffn_conv_b) + (size_t)l * 8192;
        run_gemm(lds, abuf_row(p, -1), (const bf16_t*)(p.ws + OFF_W_UP), 133 * 256, 2 * DFF, DM, E); }
    if constexpr (PH == PH_GEMM_DN) { EpiBf16Split E; E.O0 = (bf16_t*)(p.ws + OFF_MIX); E.ldc0 = DM; E.O1 = E.O0; E.ldc1 = DM; E.csplit = 1 << 30;
        run_gemm(lds, (const bf16_t*)(p.ws + OFF_ACT), (const bf16_t*)(p.ws + OFF_W_DN), T_TOK, DM, DFF, E); }
    if constexpr (PH == PH_NR1) ph_norm_resid(p, l, 1);
    if constexpr (PH == PH_HG_P1) ph_hg_pass1(p, l, lds);
    if constexpr (PH == PH_HG_P2) ph_hg_pass2(p);
    if constexpr (PH == PH_HG_P3) ph_hg_pass3(p, l, lds);
}
constexpr int LDS_BYTES = 139264;
__global__ __launch_bounds__(512, 2) void mega(P p) {
    extern __shared__ __attribute__((aligned(16))) unsigned char lds_g[];
    LAS unsigned char* lds = (LAS unsigned char*)lds_g;
    cg::grid_group grid = cg::this_grid();
    volatile LAS unsigned* xst = (volatile LAS unsigned*)(lds + LDS_BYTES - 16);
    if (TIDX == 0) { xst[0] = 0u; xst[1] = 0u; }
    __syncthreads();
    const XcdBarrier xb = xcd_barrier_post((unsigned*)(p.ws + OFF_BAR), xst);
    run_phase<PH_SETUP>(p, 0, 0, lds);
    run_phase<PH_CONVERT>(p, 0, 0, lds);
    run_phase<PH_RMS_IN>(p, 0, 0, lds);
    grid.sync();
#pragma unroll 1
    for (int l = 0; l < NLAYER; ++l) {
        run_phase<PH_GEMM_IN>(p, l, 0, lds); xcd_barrier(xb);
        run_phase<PH_HY_PREP>(p, l, 0, lds); run_phase<PH_HG_P1>(p, l, 0, lds); xcd_barrier(xb);
        run_phase<PH_FILTER>(p, l, 0, lds); run_phase<PH_HG_P2>(p, l, 0, lds); xcd_barrier(xb);
        run_phase<PH_HG_P3>(p, l, 0, lds); run_phase<PH_HY_FFT>(p, l, 0, lds); xcd_barrier(xb);
        run_phase<PH_HY_NORM>(p, l, 0, lds); xcd_barrier(xb);
        run_phase<PH_GEMM_OUT>(p, l, 0, lds); xcd_barrier(xb);
        run_phase<PH_NR0>(p, l, 0, lds); xcd_barrier(xb);
        run_phase<PH_GEMM_UP>(p, l, 0, lds); xcd_barrier(xb);
        run_phase<PH_GEMM_DN>(p, l, 0, lds); xcd_barrier(xb);
        run_phase<PH_NR1>(p, l, 0, lds);
        if (l + 1 < NLAYER) { run_phase<PH_CONVERT>(p, l + 1, 0, lds); xcd_barrier(xb); }
    }
}
extern "C" void kernel_launch(void* const* d_in, const int* in_sizes, int n_in, void* d_out, int out_size, void* d_ws, size_t ws_size, hipStream_t stream) {
    if (ws_size < WS_NEED) { fprintf(stderr, "workspace too small: %zu < %zu\n", ws_size, (size_t)WS_NEED); return; }
    static int grid_blocks = 0;
    if (!grid_blocks) {
        hipFuncSetAttribute((const void*)mega, hipFuncAttributeMaxDynamicSharedMemorySize, LDS_BYTES);
        int dev = 0, cus = 0, per_cu = 0;
        hipGetDevice(&dev);
        hipDeviceGetAttribute(&cus, hipDeviceAttributeMultiprocessorCount, dev);
        hipOccupancyMaxActiveBlocksPerMultiprocessor(&per_cu, mega, 512, LDS_BYTES);
        if (per_cu > 1) per_cu = 1;
        grid_blocks = cus * per_cu;
    }
    P p{};
    for (int i = 0; i < 26; ++i) p.in[i] = (const float*)d_in[i];
    p.out = (float*)d_out; p.ws = (unsigned char*)d_ws;
    hipMemsetAsync((unsigned char*)d_ws + OFF_BAR, 0, XCD_BAR_WORDS * 4, stream);
    void* args[] = {&p};
    hipError_t e = hipLaunchCooperativeKernel((void*)mega, dim3(grid_blocks), dim3(512), args, LDS_BYTES, stream);
    if (e != hipSuccess) fprintf(stderr, "cooperative launch failed: %s (grid %d)\n", hipGetErrorString(e), grid_blocks);
}
```

```cpp
#include <hip/hip_runtime.h>
#include <hip/hip_cooperative_groups.h>
#include <cstdio>
#include <cstdint>
namespace cg = cooperative_groups;
__device__ __forceinline__ int tid_opaque() { int t = (int)threadIdx.x; asm volatile("" : "+v"(t)); return t; }
#define TIDX tid_opaque()
#define LAS __attribute__((address_space(3)))
typedef float cf2 __attribute__((ext_vector_type(2)));
typedef float nf4 __attribute__((ext_vector_type(4)));
typedef unsigned nu2 __attribute__((ext_vector_type(2)));
typedef unsigned nu4 __attribute__((ext_vector_type(4)));
namespace pg8 {
#define PG8_LAS __attribute__((address_space(3)))
typedef unsigned short bf16_t;
typedef short bf16x8 __attribute__((ext_vector_type(8)));
typedef float f32x4 __attribute__((ext_vector_type(4)));
typedef unsigned u32x4 __attribute__((ext_vector_type(4)));
constexpr int BM = 256, BK = 64, HALF = 128, HTB = HALF * BK * 2  , STAGE_BYTES = 8 * HTB, NXCD = 8, WGM = 8;

__host__ __device__ __forceinline__ int lds_byte(int r, int c) { const int st = (r >> 4) * 2 + (c >> 5), rr = r & 15, cc = c & 31, ob = rr * 64 + cc * 2; return st * 1024 + (ob ^ (((ob >> 9) & 1) << 5)); }
__host__ __device__ __forceinline__ void stage_rc(int b, int& R, int& C) { const int st = b / 1024, sb = b % 1024, swz = sb ^ (((sb >> 9) & 1) << 5); R = (st >> 1) * 16 + swz / 64; C = (st & 1) * 32 + (swz % 64) / 2; }
__host__ __device__ __forceinline__ int perm32(int rho) { const int n = rho >> 4, i = rho & 15; return 8 * (i >> 2) + 4 * n + (i & 3); }

struct Unit { int pm, pn; };
struct Gemm { const bf16_t* A; const bf16_t* Bt; int M, N, K; int ovl; };

struct StaticOrder {
    int nM, nN, nwg, G, c;
    __host__ __device__ void init(int M, int N, int G_, int c_) { nM = M / BM; nN = N / BM; nwg = nM * nN; G = G_; c = c_; }
    __host__ __device__ bool next(int i, Unit& u) const {
        const long L = (long)i * G + c; if (L >= nwg) return false;
        int wgid = (int)L; { const int q = nwg / NXCD, r = nwg % NXCD, xcd = wgid % NXCD, off = wgid / NXCD; wgid = (xcd < r ? xcd * (q + 1) : r * (q + 1) + (xcd - r) * q) + off; }
        const int nig = WGM * nN, gid = wgid / nig, fm = gid * WGM, gsz = (nM - fm) < WGM ? (nM - fm) : WGM;
        u.pm = fm + ((wgid % nig) % gsz); u.pn = (wgid % nig) / gsz; return true;
    }
    __device__ __forceinline__ void a_ready(const Unit&) const {}
    __device__ __forceinline__ void done(const Unit&) const {}
};
struct CountedOrder : StaticOrder {
    const unsigned* ready; unsigned need; unsigned* tmo;
    __device__ __forceinline__ void a_ready(const Unit& u) const {
        if (TIDX < 64) {
            const unsigned long long t0 = __builtin_amdgcn_s_memrealtime(); unsigned polls = 0;
            while ((unsigned)__builtin_amdgcn_readfirstlane(__hip_atomic_load(ready + 64 * u.pm, __ATOMIC_RELAXED, __HIP_MEMORY_SCOPE_AGENT)) < need) {
                if ((++polls & 255u) == 0u && __builtin_amdgcn_readfirstlane(__hip_atomic_load(tmo, __ATOMIC_RELAXED, __HIP_MEMORY_SCOPE_AGENT)) != 0u) break;
                if (__builtin_amdgcn_s_memrealtime() - t0 > 2000000ull) {
                    if (TIDX == 0) { unsigned expect = 0u; __hip_atomic_compare_exchange_strong(tmo + 1, &expect, 0x600u | (unsigned)(u.pm & 0xff), __ATOMIC_RELAXED, __ATOMIC_RELAXED, __HIP_MEMORY_SCOPE_AGENT); __hip_atomic_store(tmo, 1u, __ATOMIC_RELAXED, __HIP_MEMORY_SCOPE_AGENT); }
                    break; }
                __builtin_amdgcn_s_sleep(2); }
            __builtin_amdgcn_fence(__ATOMIC_ACQUIRE, "agent");
            asm volatile("s_waitcnt vmcnt(0)" ::: "memory");
        }
#if !defined(BROKEN_HOOK_NO_BARRIER)
        asm volatile("" ::: "memory"); __builtin_amdgcn_s_barrier(); asm volatile("" ::: "memory");
#endif
    }
};

__device__ __forceinline__ unsigned cvt_pk_bf16(float lo, float hi) { unsigned r; asm volatile("v_cvt_pk_bf16_f32 %0, %1, %2" : "=v"(r) : "v"(lo), "v"(hi)); return r; }
typedef float f32x2 __attribute__((ext_vector_type(2)));
__device__ __forceinline__ f32x2 gelu_pk(f32x2 v) {
    const f32x2 av = __builtin_elementwise_abs(v), d = av * 0.2316418882f + 1.0f;
    f32x2 t; t.x = __builtin_amdgcn_rcpf(d.x); t.y = __builtin_amdgcn_rcpf(d.y);
    f32x2 q = t * 0.5307027145f + (-0.7265760135f); q = q * t + 0.7107068705f; q = q * t + (-0.142248368f); q = q * t + 0.127414796f; q = q * t;
    const f32x2 s = (v * v) * (-0.72134752044f);
    f32x2 e; e.x = __builtin_amdgcn_exp2f(s.x); e.y = __builtin_amdgcn_exp2f(s.y);
    const f32x2 m = v * (q * e), r = v - m;
    f32x2 o; o.x = v.x < 0.f ? m.x : r.x; o.y = v.y < 0.f ? m.y : r.y; return o;
}

struct EpiF32 {
    static constexpr bool PERM = false, AFTER_DRAIN = false;
    float* C; int ldc; const float* bias;
    __device__ __forceinline__ void operator()(const f32x4 (&acc)[2][2][4][2], const Unit& u, int wr, int wc, int fr, int fq) const {
        const int row0 = u.pm * BM + wr * 64 + fr, col0 = u.pn * BM + wc * 32 + 4 * fq;
        f32x4 bv[2][2];
#pragma unroll
        for (int bj = 0; bj < 2; ++bj)
#pragma unroll
            for (int n = 0; n < 2; ++n) bv[bj][n] = bias ? *(const f32x4*)(bias + col0 + bj * HALF + n * 16) : (f32x4){0.f, 0.f, 0.f, 0.f};
#pragma unroll
        for (int ai = 0; ai < 2; ++ai)
#pragma unroll
            for (int m = 0; m < 4; ++m) { float* rowp = C + (size_t)(row0 + ai * HALF + m * 16) * ldc + col0;
#pragma unroll
                for (int bj = 0; bj < 2; ++bj)
#pragma unroll
                    for (int n = 0; n < 2; ++n) *(f32x4*)(rowp + bj * HALF + n * 16) = acc[ai][bj][m][n] + bv[bj][n]; }
    }
};
template <int ACT  > struct EpiBf16 {
    static constexpr bool PERM = true, AFTER_DRAIN = false;
    bf16_t* O; int ldc; const float* bias; int split_cols; size_t split_stride;
    __device__ __forceinline__ void operator()(const f32x4 (&acc)[2][2][4][2], const Unit& u, int wr, int wc, int fr, int fq) const {
        const int row0 = u.pm * BM + wr * 64 + fr; int colt = u.pn * BM; bf16_t* base = O;
        if (split_cols) { const int t = colt / split_cols; base += (size_t)t * split_stride; colt -= t * split_cols; }
        const int col0 = colt + wc * 32 + 8 * fq, bcol0 = u.pn * BM + wc * 32 + 8 * fq;
        f32x4 bv[2][2];
#pragma unroll
        for (int bj = 0; bj < 2; ++bj)
#pragma unroll
            for (int n = 0; n < 2; ++n) bv[bj][n] = bias ? *(const f32x4*)(bias + bcol0 + bj * HALF + 4 * n) : (f32x4){0.f, 0.f, 0.f, 0.f};
#pragma unroll
        for (int ai = 0; ai < 2; ++ai)
#pragma unroll
            for (int m = 0; m < 4; ++m) { bf16_t* rowp = base + (size_t)(row0 + ai * HALF + m * 16) * ldc + col0;
#pragma unroll
                for (int bj = 0; bj < 2; ++bj) { f32x4 v0 = acc[ai][bj][m][0] + bv[bj][0], v1 = acc[ai][bj][m][1] + bv[bj][1];
                    if (ACT == 1) { f32x2 a = gelu_pk((f32x2){v0[0], v0[1]}), b = gelu_pk((f32x2){v0[2], v0[3]}), c = gelu_pk((f32x2){v1[0], v1[1]}), d = gelu_pk((f32x2){v1[2], v1[3]});
                        v0 = (f32x4){a.x, a.y, b.x, b.y}; v1 = (f32x4){c.x, c.y, d.x, d.y}; }
                    if (ACT == 2) {
#pragma unroll
                        for (int j = 0; j < 4; ++j) { v0[j] = 0.5f * v0[j] * (1.0f + erff(v0[j] * 0.70710678f)); v1[j] = 0.5f * v1[j] * (1.0f + erff(v1[j] * 0.70710678f)); } }
                    u32x4 w; w.x = cvt_pk_bf16(v0[0], v0[1]); w.y = cvt_pk_bf16(v0[2], v0[3]); w.z = cvt_pk_bf16(v1[0], v1[1]); w.w = cvt_pk_bf16(v1[2], v1[3]);
                    *(u32x4*)(rowp + bj * HALF) = w; } }
    }
};
template <class Epi, class Sched, bool STAMP = false>
__device__ __forceinline__ void gemm_phase(PG8_LAS unsigned char* lds, const Gemm g, const Sched& S, const Epi& E, unsigned long long* stamps) {
    const int tid = TIDX, wid = __builtin_amdgcn_readfirstlane(tid >> 6), lane = tid & 63, wr = wid >> 2, wc = wid & 3, fr = lane & 15, fq = lane >> 4;
    const int K = g.K, nt = K / BK;
    int ts_lo = 0, ts_hi = 0, nts = 0; const unsigned long long rt_entry = STAMP ? (unsigned long long)wall_clock64() : 0ull;
#define PG8_STAMP() do { if (STAMP && wid == 0 && nts < 64) { const unsigned long long _c = (unsigned long long)clock64(); \
        ts_lo = (lane == nts) ? (int)(unsigned)_c : ts_lo; ts_hi = (lane == nts) ? (int)(unsigned)(_c >> 32) : ts_hi; ++nts; } } while (0)
    PG8_STAMP();
    unsigned voffA[2], voffB[2];
#pragma unroll
    for (int i = 0; i < 2; ++i) { int R, C; stage_rc(tid * 16 + i * 8192, R, C); const int Rb = Epi::PERM ? ((R & ~31) + perm32(R & 31)) : R;
        const int Ra = g.ovl ? R - 2 * (R >> 6) : R; voffA[i] = (unsigned)(Ra * K + C) * 2u; voffB[i] = (unsigned)(Rb * K + C) * 2u; }
    const size_t kstep = (size_t)(BK * 2);
    const size_t hstep = (size_t)HALF * K * 2;
    const size_t tstep = 2 * hstep;
    const size_t hstepA = g.ovl ? (size_t)124 * K * 2 : hstep, tstepA = g.ovl ? (size_t)248 * K * 2 : tstep;
    const unsigned ldsw = (unsigned)wid * 1024u;
    const int aoff = lds_byte(wr * 64 + fr, fq * 8), boff = lds_byte(wc * 32 + fr, fq * 8);
#define PG8_SA(b, h) (((b) * 2 + (h)) * HTB)
#define PG8_SB(b, h) ((4 + (b) * 2 + (h)) * HTB)
#define PG8_STAGE(bufoff, gbase, voff) do { _Pragma("unroll") for (int _i = 0; _i < 2; ++_i) \
        __builtin_amdgcn_global_load_lds((const unsigned*)((const char*)(gbase) + (voff)[_i]), (PG8_LAS unsigned*)(lds + (bufoff) + ldsw + _i * 8192), 16, 0, 0); } while (0)
#define PG8_LDA(dst, b, h) do { _Pragma("unroll") for (int m = 0; m < 4; ++m) _Pragma("unroll") for (int k = 0; k < 2; ++k) dst[m][k] = *(const PG8_LAS bf16x8*)(lds + PG8_SA(b, h) + aoff + m * 2048 + k * 1024); } while (0)
#define PG8_LDB(dst, b, h) do { _Pragma("unroll") for (int n = 0; n < 2; ++n) _Pragma("unroll") for (int k = 0; k < 2; ++k) dst[n][k] = *(const PG8_LAS bf16x8*)(lds + PG8_SB(b, h) + boff + n * 2048 + k * 1024); } while (0)
#define PG8_MMA(ai, bj, At, Bt) do { __builtin_amdgcn_s_setprio(1); _Pragma("unroll") for (int m = 0; m < 4; ++m) _Pragma("unroll") for (int n = 0; n < 2; ++n) _Pragma("unroll") for (int k = 0; k < 2; ++k) \
        acc[ai][bj][m][n] = __builtin_amdgcn_mfma_f32_16x16x32_bf16(Bt[n][k], At[m][k], acc[ai][bj][m][n], 0, 0, 0); __builtin_amdgcn_s_setprio(0); } while (0)
#define PG8_WAIT_V(n) asm volatile("s_waitcnt vmcnt(" #n ")" ::: "memory")
#define PG8_WAIT_L(n) asm volatile("s_waitcnt lgkmcnt(" #n ")" ::: "memory")
#define PG8_BAR __builtin_amdgcn_s_barrier()
#define PG8_SCHED __builtin_amdgcn_sched_barrier(0)
    Unit cur, nxt; int ui = 0;
    if (!S.next(0, cur)) return;
    f32x4 acc[2][2][4][2];
#pragma unroll
    for (int a = 0; a < 2; ++a)
#pragma unroll
        for (int b = 0; b < 2; ++b)
#pragma unroll
            for (int m = 0; m < 4; ++m)
#pragma unroll
                for (int n = 0; n < 2; ++n) acc[a][b][m][n] = (f32x4){0.f, 0.f, 0.f, 0.f};
    bf16x8 At[4][2], B0[2][2], B1[2][2];
    const char* cA = (const char*)g.A + (size_t)cur.pm * tstepA; const char* cB = (const char*)g.Bt + (size_t)cur.pn * tstep;
    S.a_ready(cur);
    PG8_STAGE(PG8_SB(0, 0), cB, voffB); PG8_STAGE(PG8_SA(0, 0), cA, voffA); PG8_STAGE(PG8_SB(0, 1), cB + hstep, voffB); PG8_STAGE(PG8_SA(0, 1), cA + hstepA, voffA);
    if (wr == 1) PG8_BAR;
    PG8_WAIT_V(4); PG8_BAR;
    PG8_STAGE(PG8_SB(1, 0), cB + kstep, voffB); PG8_STAGE(PG8_SA(1, 0), cA + kstep, voffA); PG8_STAGE(PG8_SB(1, 1), cB + hstep + kstep, voffB);
    PG8_WAIT_V(6); PG8_BAR;
    PG8_STAMP();
    for (;;) {
        const bool has_next = S.next(ui + 1, nxt);
        const char* nA = has_next ? (const char*)g.A + (size_t)nxt.pm * tstepA : cA; const char* nB = has_next ? (const char*)g.Bt + (size_t)nxt.pn * tstep : cB;
        for (int t = 0; t < nt; t += 2) {
            const bool last = (t == nt - 2);
            const char* a1 = cA + (size_t)(t + 1) * kstep;
            const char* a2 = last ? nA : cA + (size_t)(t + 2) * kstep; const char* b2 = last ? nB : cB + (size_t)(t + 2) * kstep;
            const char* a3 = a2 + kstep; const char* b3 = b2 + kstep;
            if (last && has_next) S.a_ready(nxt);
            PG8_LDB(B0, 0, 0); PG8_SCHED; PG8_LDA(At, 0, 0); PG8_STAGE(PG8_SA(1, 1), a1 + hstepA, voffA);
            PG8_WAIT_L(8); PG8_BAR; PG8_WAIT_L(0); PG8_MMA(0, 0, At, B0); PG8_BAR; PG8_SCHED;
            PG8_LDB(B1, 0, 1); PG8_STAGE(PG8_SB(0, 0), b2, voffB);
            PG8_BAR; PG8_WAIT_L(0); PG8_MMA(0, 1, At, B1); PG8_BAR;
            PG8_LDA(At, 0, 1); PG8_STAGE(PG8_SA(0, 0), a2, voffA);
            PG8_BAR; PG8_WAIT_L(0); PG8_MMA(1, 0, At, B0); PG8_BAR; PG8_SCHED;
            PG8_STAGE(PG8_SB(0, 1), b2 + hstep, voffB);
            PG8_WAIT_V(6); PG8_BAR; PG8_MMA(1, 1, At, B1); PG8_BAR;
            PG8_LDB(B0, 1, 0); PG8_SCHED; PG8_LDA(At, 1, 0); PG8_STAGE(PG8_SA(0, 1), a2 + hstepA, voffA);
            PG8_WAIT_L(8); PG8_BAR; PG8_WAIT_L(0); PG8_MMA(0, 0, At, B0); PG8_BAR; PG8_SCHED;
            PG8_LDB(B1, 1, 1); PG8_STAGE(PG8_SB(1, 0), b3, voffB);
            PG8_BAR; PG8_WAIT_L(0); PG8_MMA(0, 1, At, B1); PG8_BAR;
            PG8_LDA(At, 1, 1); PG8_STAGE(PG8_SA(1, 0), a3, voffA);
            PG8_BAR; PG8_WAIT_L(0); PG8_MMA(1, 0, At, B0); PG8_BAR; PG8_SCHED;
            PG8_STAGE(PG8_SB(1, 1), b3 + hstep, voffB);
            PG8_WAIT_V(6); PG8_BAR; PG8_MMA(1, 1, At, B1); PG8_BAR;
        }
        PG8_STAMP();
        if constexpr (!Epi::AFTER_DRAIN) { E(acc, cur, wr, wc, fr, fq); S.done(cur); }
        PG8_STAMP();
        if (!has_next) break;
#pragma unroll
        for (int a = 0; a < 2; ++a)
#pragma unroll
            for (int b = 0; b < 2; ++b)
#pragma unroll
                for (int m = 0; m < 4; ++m)
#pragma unroll
                    for (int n = 0; n < 2; ++n) acc[a][b][m][n] = (f32x4){0.f, 0.f, 0.f, 0.f};
        cur = nxt; cA = nA; cB = nB; ++ui;
    }
    PG8_WAIT_V(0);
    if (wr == 0) PG8_BAR;
    PG8_BAR;
    if constexpr (Epi::AFTER_DRAIN) { E.fused(acc, cur, wr, wc, fr, fq, lds, wid, lane); S.done(cur); }
    PG8_STAMP();
    if (STAMP && wid == 0) { stamps[lane] = lane < nts ? (((unsigned long long)(unsigned)ts_hi << 32) | (unsigned)ts_lo) : 0ull;
        if (lane == 62) stamps[62] = rt_entry; if (lane == 63) stamps[63] = (unsigned long long)wall_clock64(); }
#undef PG8_STAMP
#undef PG8_SA
#undef PG8_SB
#undef PG8_STAGE
#undef PG8_LDA
#undef PG8_LDB
#undef PG8_MMA
#undef PG8_WAIT_V
#undef PG8_WAIT_L
#undef PG8_BAR
#undef PG8_SCHED
}
}
typedef unsigned short bf16_t;
constexpr int T_TOK = 32768, DM = 1024, D_IN = 4096, D_HY = 512, D_HG = 512, DFF = 4096, NLAYER = 4;
constexpr int L_BIG = 16384, L_SML = 4096;
constexpr int APAD = 256;
constexpr size_t MiB = 1024ull * 1024ull;
constexpr size_t OFF_W = 0;
constexpr size_t OFF_W_IN = OFF_W, OFF_W_OUT = OFF_W + 8 * MiB, OFF_W_UP = OFF_W + 10 * MiB, OFF_W_DN = OFF_W + 26 * MiB;
constexpr size_t OFF_ABUF = 34 * MiB;
constexpr size_t OFF_R1 = 99 * MiB;
constexpr size_t OFF_HYRAW = OFF_R1;
constexpr size_t OFF_HG = OFF_R1 + 96 * MiB;
constexpr size_t OFF_KT = OFF_R1;
constexpr size_t OFF_ACT = OFF_R1;
constexpr size_t OFF_R2 = 355 * MiB;
constexpr size_t OFF_X0T = OFF_R2, OFF_ZT = OFF_R2 + 32 * MiB;
constexpr size_t OFF_MIX = OFF_R2;
constexpr size_t OFF_UPART = OFF_R2;
constexpr size_t OFF_R6 = 419 * MiB;
constexpr size_t OFF_OBUF = OFF_R6;
constexpr size_t OFF_KS = OFF_R6;
constexpr size_t OFF_SMALL = 483 * MiB;
constexpr size_t OFF_BAR = OFF_SMALL + 4 * MiB;
constexpr size_t OFF_W4T = OFF_SMALL + 8 * MiB;
constexpr size_t WS_NEED = 492 * MiB;

struct P { const float* in[26]; float* out; unsigned char* ws; };
constexpr int PB_norm_mix_pre = 0;
constexpr int PB_norm_mix_post = 4096;
constexpr int PB_norm_ffn_pre = 8192;
constexpr int PB_norm_ffn_post = 12288;
constexpr int PB_hy_conv_w = 16384;
constexpr int PB_hy_conv_b = 34816;
constexpr int PB_f_w1 = 40960;
constexpr int PB_f_b1 = 49408;
constexpr int PB_f_w2 = 49664;
constexpr int PB_f_b2 = 66048;
constexpr int PB_f_w3 = 66304;
constexpr int PB_f_b3 = 82688;
constexpr int PB_f_w4 = 82944;
constexpr int PB_f_freq = 345088;
constexpr int PB_hy_skip = 345344;
constexpr int PB_hy_out_norm = 347392;
constexpr int PB_lb_table = 349440;
constexpr int PB_hg_out_norm = 353536;
constexpr int PB_ffn_conv_w = 355584;
constexpr int PB_ffn_conv_b = 453888;
constexpr int PB_TOTAL = 486656;
constexpr size_t OFF_PB = OFF_SMALL + 512 * 1024;
#define PRM(p, NAME) ((const float*)((p).ws + OFF_PB) + PB_##NAME)

__device__ __forceinline__ float bf2f(bf16_t b) { return __uint_as_float(((unsigned)b) << 16); }
__device__ __forceinline__ bf16_t f2bf(float f) { unsigned u = __float_as_uint(f); u += 0x7FFFu + ((u >> 16) & 1u); return (bf16_t)(u >> 16); }
__device__ __forceinline__ unsigned pack_bf2(float lo, float hi) { return (unsigned)f2bf(lo) | ((unsigned)f2bf(hi) << 16); }
__device__ __forceinline__ bool seq_start(int t) { return t < L_BIG ? (t == 0) : ((t & (L_SML - 1)) == 0); }
__device__ __forceinline__ bool seq_end(int t) { return (t + 1 == T_TOK) || seq_start(t + 1); }
__device__ __forceinline__ const float* x_src_row(const P& p, int l, int t) {
    if (l > 0) return p.out + (size_t)t * DM;
    return t < L_BIG ? p.in[0] + (size_t)t * DM : p.in[1] + (size_t)(t - L_BIG) * DM;
}
__device__ __forceinline__ float silu_f(float x) { return x / (1.0f + __expf(-x)); }
__device__ __forceinline__ float wave_sum(float v) {
#pragma unroll
    for (int o = 32; o >= 1; o >>= 1) v += __shfl_xor(v, o);
    return v;
}

struct EpiBf16Split {
    static constexpr bool PERM = true, AFTER_DRAIN = false, OVL = false;
    bf16_t* O0; int ldc0; bf16_t* O1; int ldc1; int csplit;
    __device__ __forceinline__ void operator()(const pg8::f32x4 (&acc)[2][2][4][2], const pg8::Unit& u, int wr, int wc, int fr, int fq) const {
        const int row0 = u.pm * pg8::BM + wr * 64 + fr; int colt = u.pn * pg8::BM; bf16_t* base = O0; int ldc = ldc0;
        if (colt >= csplit) { base = O1; ldc = ldc1; colt -= csplit; }
        const int col0 = colt + wc * 32 + 8 * fq;
#pragma unroll
        for (int ai = 0; ai < 2; ++ai)
#pragma unroll
            for (int m = 0; m < 4; ++m) { bf16_t* rowp = base + (size_t)(row0 + ai * pg8::HALF + m * 16) * ldc + col0;
#pragma unroll
                for (int bj = 0; bj < 2; ++bj) { const pg8::f32x4 v0 = acc[ai][bj][m][0], v1 = acc[ai][bj][m][1];
                    pg8::u32x4 w; w.x = pg8::cvt_pk_bf16(v0[0], v0[1]); w.y = pg8::cvt_pk_bf16(v0[2], v0[3]); w.z = pg8::cvt_pk_bf16(v1[0], v1[1]); w.w = pg8::cvt_pk_bf16(v1[2], v1[3]);
                    *(pg8::u32x4*)(rowp + bj * pg8::HALF) = w; } }
    }
};
__device__ __forceinline__ float dpp_ror1(float v) { return __int_as_float(__builtin_amdgcn_update_dpp(0, __float_as_int(v), 0x121, 0xF, 0xF, false)); }
__device__ __forceinline__ float dpp_ror15(float v) { return __int_as_float(__builtin_amdgcn_update_dpp(0, __float_as_int(v), 0x12F, 0xF, 0xF, false)); }
__device__ __forceinline__ float gelu_tanh_e(float x) { const float y = 1.5957691216057308f * (x + 0.044715f * x * x * x); return x * __builtin_amdgcn_rcpf(1.0f + __expf(-y)); }
struct EpiGeglu {
    static constexpr bool PERM = true, AFTER_DRAIN = false, OVL = true;
    bf16_t* act; const float* cw; const float* cb;
    __device__ __forceinline__ void operator()(const pg8::f32x4 (&acc)[2][2][4][2], const pg8::Unit& u, int wr, int wc, int fr, int fq) const {
        const int j0 = u.pn * 128 + wc * 32 + 8 * fq;
        unsigned mprev = 0, mnext = 0, mst = 0;
#pragma unroll
        for (int ai = 0; ai < 2; ++ai)
#pragma unroll
            for (int m = 0; m < 4; ++m) { const int q = 16 * m + fr, tok = u.pm * 248 + 124 * ai + 62 * wr + q - 1, b = ai * 4 + m;
                const bool st = q >= 1 && q <= 62 && tok < T_TOK;
                if (st) { mst |= 1u << b; if (!seq_start(tok)) mprev |= 1u << b; if (!seq_end(tok)) mnext |= 1u << b; } }
#pragma unroll
        for (int n = 0; n < 2; ++n) {
            const int jc = j0 + 4 * n;
            const pg8::f32x4 wa0 = *(const pg8::f32x4*)(cw + jc), wa1 = *(const pg8::f32x4*)(cw + 8192 + jc), wa2 = *(const pg8::f32x4*)(cw + 16384 + jc), ba = *(const pg8::f32x4*)(cb + jc);
            const pg8::f32x4 wb0 = *(const pg8::f32x4*)(cw + 4096 + jc), wb1 = *(const pg8::f32x4*)(cw + 8192 + 4096 + jc), wb2 = *(const pg8::f32x4*)(cw + 16384 + 4096 + jc), bb = *(const pg8::f32x4*)(cb + 4096 + jc);
#pragma unroll
            for (int ai = 0; ai < 2; ++ai) {
                pg8::f32x4 pa_prev, pb_prev, na_cur, nb_cur;
#pragma unroll
                for (int i = 0; i < 4; ++i) { na_cur[i] = dpp_ror15(acc[ai][0][0][n][i]); nb_cur[i] = dpp_ror15(acc[ai][1][0][n][i]); pa_prev[i] = 0.f; pb_prev[i] = 0.f; }
#pragma unroll
                for (int m = 0; m < 4; ++m) {
                    const int b = ai * 4 + m, q = 16 * m + fr, tok = u.pm * 248 + 124 * ai + 62 * wr + q - 1;
                    const bool hp = (mprev >> b) & 1u, hn = (mnext >> b) & 1u;
                    pg8::f32x4 pa_cur, pb_cur, na_next, nb_next;
#pragma unroll
                    for (int i = 0; i < 4; ++i) { pa_cur[i] = dpp_ror1(acc[ai][0][m][n][i]); pb_cur[i] = dpp_ror1(acc[ai][1][m][n][i]);
                        na_next[i] = m < 3 ? dpp_ror15(acc[ai][0][m < 3 ? m + 1 : 3][n][i]) : 0.f; nb_next[i] = m < 3 ? dpp_ror15(acc[ai][1][m < 3 ? m + 1 : 3][n][i]) : 0.f; }
                    const pg8::f32x4 xpa = (fr == 0) ? pa_prev : pa_cur, xna = (fr == 15) ? na_next : na_cur;
                    const pg8::f32x4 xpb = (fr == 0) ? pb_prev : pb_cur, xnb = (fr == 15) ? nb_next : nb_cur;
                    const pg8::f32x4 xa = acc[ai][0][m][n], xb = acc[ai][1][m][n];
                    float o[4];
#pragma unroll
                    for (int i = 0; i < 4; ++i) {
                        const float ya = (hp ? xpa[i] * wa0[i] : 0.f) + xa[i] * wa1[i] + (hn ? xna[i] * wa2[i] : 0.f) + ba[i];
                        const float yb = (hp ? xpb[i] * wb0[i] : 0.f) + xb[i] * wb1[i] + (hn ? xnb[i] * wb2[i] : 0.f) + bb[i];
                        o[i] = gelu_tanh_e(ya) * yb;
                    }
                    if ((mst >> b) & 1u) { uint2 w; w.x = pg8::cvt_pk_bf16(o[0], o[1]); w.y = pg8::cvt_pk_bf16(o[2], o[3]); *(uint2*)(act + (size_t)tok * DFF + jc) = w; }
                    pa_prev = pa_cur; pb_prev = pb_cur; na_cur = na_next; nb_cur = nb_next;
                }
            }
        }
    }
};
template <class Epi>
__device__ __forceinline__ void run_gemm(LAS unsigned char* lds, const bf16_t* A, const bf16_t* Bt, int M, int N, int K, const Epi& E) {
    pg8::Gemm g; g.A = A; g.Bt = Bt; g.M = M; g.N = N; g.K = K; g.ovl = Epi::OVL ? 1 : 0;
    int gx = (int)gridDim.x, bx = (int)blockIdx.x; asm volatile("" : "+s"(gx), "+s"(bx));
    pg8::StaticOrder S; S.init(M, N, gx, bx);
    pg8::gemm_phase<Epi, pg8::StaticOrder, false>((PG8_LAS unsigned char*)lds, g, S, E, nullptr);
}

#define HD_INLINE __device__ __forceinline__
#define DEV_FN __device__ __forceinline__
#define LDS_F2 LAS cf2*
#define NTHR 512
#define PADI(i) ((i) + ((i) >> 5))
#define FOR_TID for (int tid = (int)TIDX, once_ = 1; once_; once_ = 0)
#define SYNC __syncthreads()
#define BREV32(x) __brev(x)
#define CIS_REV(fr, c, s) do { const float f_ = (fr); c = __builtin_amdgcn_cosf(f_); s = __builtin_amdgcn_sinf(f_); } while (0)
HD_INLINE unsigned rev4(unsigned k, int S) {
    unsigned v = BREV32(k) >> (32 - 2 * S);
    return ((v & 0xAAAAAAAAu) >> 1) | ((v & 0x55555555u) << 1);
}
HD_INLINE cf2 mkf2(float a, float b) { cf2 r; r.x = a; r.y = b; return r; }
HD_INLINE cf2 cmul(cf2 a, cf2 b) { return mkf2(a.x * b.x - a.y * b.y, a.x * b.y + a.y * b.x); }
HD_INLINE cf2 cmulc(cf2 a, cf2 b) { return mkf2(a.x * b.x + a.y * b.y, a.y * b.x - a.x * b.y); }

template <int S>
DEV_FN void fft_fwd_t(LDS_F2 X, int s0) {
    constexpr int M = 1 << (2 * S), NB = (M >> 2) / NTHR, G = NB >= 4 ? 4 : NB;
    for (int s = s0; s < S; ++s) {
        const int n = M >> (2 * s), q = n >> 2;
        const float invn = 1.0f / (float)n;
        FOR_TID {
            for (int b0 = tid; b0 < (M >> 2); b0 += G * NTHR) {
                cf2 a0[G], a1[G], a2[G], a3[G]; int bs[G]; float frv[G];
#pragma unroll
                for (int u = 0; u < G; ++u) { const int b = b0 + u * NTHR, j = b & (q - 1), base = ((b - j) << 2) + j; bs[u] = base; frv[u] = (float)j * invn;
                    a0[u] = X[PADI(base)]; a1[u] = X[PADI(base + q)]; a2[u] = X[PADI(base + 2 * q)]; a3[u] = X[PADI(base + 3 * q)]; }
#pragma unroll
                for (int u = 0; u < G; ++u) {
                    const cf2 t0 = mkf2(a0[u].x + a2[u].x, a0[u].y + a2[u].y), t1 = mkf2(a0[u].x - a2[u].x, a0[u].y - a2[u].y);
                    const cf2 t2 = mkf2(a1[u].x + a3[u].x, a1[u].y + a3[u].y);
                    const cf2 d13 = mkf2(a1[u].x - a3[u].x, a1[u].y - a3[u].y);
                    const cf2 t3 = mkf2(d13.y, -d13.x);
                    float c1, s1; CIS_REV(frv[u], c1, s1);
                    const cf2 w1 = mkf2(c1, -s1), w2 = cmul(w1, w1), w3 = cmul(w2, w1);
                    a0[u] = mkf2(t0.x + t2.x, t0.y + t2.y);
                    a1[u] = cmul(mkf2(t1.x + t3.x, t1.y + t3.y), w1);
                    a2[u] = cmul(mkf2(t0.x - t2.x, t0.y - t2.y), w2);
                    a3[u] = cmul(mkf2(t1.x - t3.x, t1.y - t3.y), w3);
                }
#pragma unroll
                for (int u = 0; u < G; ++u) { const int base = bs[u]; X[PADI(base)] = a0[u]; X[PADI(base + q)] = a1[u]; X[PADI(base + 2 * q)] = a2[u]; X[PADI(base + 3 * q)] = a3[u]; }
            }
        }
        SYNC;
    }
}
template <int S>
DEV_FN void fft_inv_t(LDS_F2 X) {
    constexpr int M = 1 << (2 * S), NB = (M >> 2) / NTHR, G = NB >= 4 ? 4 : NB;
    for (int s = S - 1; s >= 0; --s) {
        const int n = M >> (2 * s), q = n >> 2;
        const float invn = 1.0f / (float)n;
        FOR_TID {
            for (int b0 = tid; b0 < (M >> 2); b0 += G * NTHR) {
                cf2 a0[G], a1[G], a2[G], a3[G]; int bs[G]; float frv[G];
#pragma unroll
                for (int u = 0; u < G; ++u) { const int b = b0 + u * NTHR, j = b & (q - 1), base = ((b - j) << 2) + j; bs[u] = base; frv[u] = (float)j * invn;
                    a0[u] = X[PADI(base)]; a1[u] = X[PADI(base + q)]; a2[u] = X[PADI(base + 2 * q)]; a3[u] = X[PADI(base + 3 * q)]; }
#pragma unroll
                for (int u = 0; u < G; ++u) {
                    float c1, s1; CIS_REV(frv[u], c1, s1);
                    const cf2 w1 = mkf2(c1, s1), w2 = cmul(w1, w1), w3 = cmul(w2, w1);
                    const cf2 b0v = a0[u], b1 = cmul(a1[u], w1), b2 = cmul(a2[u], w2), b3 = cmul(a3[u], w3);
                    const cf2 t0 = mkf2(b0v.x + b2.x, b0v.y + b2.y), t1 = mkf2(b0v.x - b2.x, b0v.y - b2.y);
                    const cf2 t2 = mkf2(b1.x + b3.x, b1.y + b3.y);
                    const cf2 d13 = mkf2(b1.x - b3.x, b1.y - b3.y);
                    const cf2 t3 = mkf2(-d13.y, d13.x);
                    a0[u] = mkf2(t0.x + t2.x, t0.y + t2.y);
                    a1[u] = mkf2(t1.x + t3.x, t1.y + t3.y);
                    a2[u] = mkf2(t0.x - t2.x, t0.y - t2.y);
                    a3[u] = mkf2(t1.x - t3.x, t1.y - t3.y);
                }
#pragma unroll
                for (int u = 0; u < G; ++u) { const int base = bs[u]; X[PADI(base)] = a0[u]; X[PADI(base + q)] = a1[u]; X[PADI(base + 2 * q)] = a2[u]; X[PADI(base + 3 * q)] = a3[u]; }
            }
        }
        SYNC;
    }
}
DEV_FN void spec_store(LDS_F2 X, int S, cf2* Kp) {
    const int M = 1 << (2 * S);
    FOR_TID {
        for (int pp = tid; pp < (M >> 1); pp += NTHR) {
            const int p = ((pp >> 1) << 2) + (pp & 1);
            if (p == 0) {
                const cf2 c0 = X[PADI(0)]; Kp[0] = mkf2(c0.x + c0.y, c0.x - c0.y);
                const cf2 ch = X[PADI(2)]; Kp[2] = mkf2(ch.x, -ch.y);
            } else {
                const unsigned k = rev4((unsigned)p, S), pm = rev4((unsigned)(M - (int)k), S);
                const cf2 ck = X[PADI(p)], cm = X[PADI((int)pm)];
                const cf2 P = mkf2(0.5f * (ck.x + cm.x), 0.5f * (ck.y - cm.y));
                const cf2 O = mkf2(0.5f * (ck.y + cm.y), -0.5f * (ck.x - cm.x));
                float c, s; CIS_REV((float)k / (float)(2 * M), c, s);
                const cf2 Q = cmul(O, mkf2(c, -s));
                Kp[p] = mkf2(P.x + Q.x, P.y + Q.y);
                Kp[pm] = mkf2(P.x - Q.x, -(P.y - Q.y));
            }
        }
    }
    SYNC;
}
DEV_FN void spec_mul(LDS_F2 X, int S, const cf2* Kp) {
    const int M = 1 << (2 * S);
    FOR_TID {
        for (int pp = tid; pp < (M >> 1); pp += NTHR) {
            const int p = ((pp >> 1) << 2) + (pp & 1);
            if (p == 0) {
                const cf2 c0 = X[PADI(0)], k0 = Kp[0];
                const float y0 = (c0.x + c0.y) * k0.x, ym = (c0.x - c0.y) * k0.y;
                X[PADI(0)] = mkf2(0.5f * (y0 + ym), 0.5f * (y0 - ym));
                const cf2 ch = X[PADI(2)], kh = Kp[2];
                const cf2 yh = cmul(mkf2(ch.x, -ch.y), kh);
                X[PADI(2)] = mkf2(yh.x, -yh.y);
            } else {
                const unsigned k = rev4((unsigned)p, S), pm = rev4((unsigned)(M - (int)k), S);
                const cf2 ck = X[PADI(p)], cm = X[PADI((int)pm)];
                const cf2 P = mkf2(0.5f * (ck.x + cm.x), 0.5f * (ck.y - cm.y));
                const cf2 O = mkf2(0.5f * (ck.y + cm.y), -0.5f * (ck.x - cm.x));
                float c, s; CIS_REV((float)k / (float)(2 * M), c, s);
                const cf2 Wk = mkf2(c, -s);
                const cf2 Q = cmul(O, Wk);
                const cf2 xk = mkf2(P.x + Q.x, P.y + Q.y), xm = mkf2(P.x - Q.x, -(P.y - Q.y));
                const cf2 yk = cmul(xk, Kp[p]), ym = cmul(xm, Kp[pm]);
                const cf2 Ye = mkf2(0.5f * (yk.x + ym.x), 0.5f * (yk.y - ym.y));
                const cf2 Yd = mkf2(0.5f * (yk.x - ym.x), 0.5f * (yk.y + ym.y));
                const cf2 Yo = cmulc(Yd, Wk);
                X[PADI(p)] = mkf2(Ye.x - Yo.y, Ye.y + Yo.x);
                X[PADI((int)pm)] = mkf2(Ye.x + Yo.y, -Ye.y + Yo.x);
            }
        }
    }
    SYNC;
}
__device__ void ph_setup(const P& p) {
    const int gid = blockIdx.x * 512 + TIDX;
    if (gid < 2 * D_HG) {
        const int dir = gid / D_HG, c = gid % D_HG;
        float v[NLAYER], mx = -1e30f;
#pragma unroll
        for (int l = 0; l < NLAYER; ++l) { v[l] = p.in[19][(size_t)(dir * NLAYER + l) * D_HG + c]; mx = fmaxf(mx, v[l]); }
        float s = 0.f;
#pragma unroll
        for (int l = 0; l < NLAYER; ++l) { v[l] = expf(v[l] - mx); s += v[l]; }
        float* lbs = (float*)(p.ws + OFF_SMALL);
        float cum = 0.f;
#pragma unroll
        for (int l = 0; l < NLAYER; ++l) { if (l > 0) cum += v[l] / s; lbs[(size_t)(dir * NLAYER + l) * D_HG + c] = cum; }
    }
}
__device__ void ph_copy_params(const P& p) {
    float* pb = (float*)(p.ws + OFF_PB);
    const int g = blockIdx.x * 512 + TIDX, gs = gridDim.x * 512;
    for (int k = g; k < 4096; k += gs) pb[0 + k] = p.in[2][k];
    for (int k = g; k < 4096; k += gs) pb[4096 + k] = p.in[3][k];
    for (int k = g; k < 4096; k += gs) pb[8192 + k] = p.in[4][k];
    for (int k = g; k < 4096; k += gs) pb[12288 + k] = p.in[5][k];
    for (int k = g; k < 18432; k += gs) pb[16384 + k] = p.in[7][k];
    for (int k = g; k < 6144; k += gs) pb[34816 + k] = p.in[8][k];
    for (int k = g; k < 8448; k += gs) pb[40960 + k] = p.in[9][k];
    for (int k = g; k < 256; k += gs) pb[49408 + k] = p.in[10][k];
    for (int k = g; k < 16384; k += gs) pb[49664 + k] = p.in[11][k];
    for (int k = g; k < 256; k += gs) pb[66048 + k] = p.in[12][k];
    for (int k = g; k < 16384; k += gs) pb[66304 + k] = p.in[13][k];
    for (int k = g; k < 256; k += gs) pb[82688 + k] = p.in[14][k];
    for (int k = g; k < 262144; k += gs) pb[82944 + k] = p.in[15][k];
    for (int k = g; k < 256; k += gs) pb[345088 + k] = p.in[16][k];
    for (int k = g; k < 2048; k += gs) pb[345344 + k] = p.in[17][k];
    for (int k = g; k < 2048; k += gs) pb[347392 + k] = p.in[18][k];
    for (int k = g; k < 4096; k += gs) pb[349440 + k] = p.in[19][k];
    for (int k = g; k < 2048; k += gs) pb[353536 + k] = p.in[20][k];
    for (int k = g; k < 98304; k += gs) pb[355584 + k] = p.in[23][k];
    for (int k = g; k < 32768; k += gs) pb[453888 + k] = p.in[24][k];
}
__device__ void convert_one(const float* src, bf16_t* dst, int K, int N, LAS float* tile  , bool geglu_perm = false) {
    const int tiles_n = N / 64, ntiles = (K / 64) * tiles_n, tid = TIDX;
    for (int it = blockIdx.x; it < ntiles; it += gridDim.x) {
        const int k0 = (it / tiles_n) * 64, n0 = (it % tiles_n) * 64;
#pragma unroll
        for (int i = 0; i < 8; ++i) { const int r = (tid >> 6) + 8 * i, c = tid & 63; tile[r * 65 + c] = src[(size_t)(k0 + r) * N + n0 + c]; }
        __syncthreads();
#pragma unroll
        for (int i = 0; i < 8; ++i) { const int n = (tid >> 6) + 8 * i, k = tid & 63; int nr = n0 + n;
            if (geglu_perm) nr = nr < DFF ? (nr >> 7) * 256 + (nr & 127) : ((nr - DFF) >> 7) * 256 + 128 + ((nr - DFF) & 127);
            dst[(size_t)nr * K + k0 + k] = f2bf(tile[k * 65 + n]); }
        __syncthreads();
    }
}
__device__ void ph_convert_w(const P& p, int l, LAS unsigned char* lds) {
    LAS float* tile = (LAS float*)lds;
    convert_one(p.in[6] + (size_t)l * DM * D_IN, (bf16_t*)(p.ws + OFF_W_IN), DM, D_IN, tile);
    convert_one(p.in[21] + (size_t)l * DM * DM, (bf16_t*)(p.ws + OFF_W_OUT), DM, DM, tile);
    convert_one(p.in[22] + (size_t)l * DM * 2 * DFF, (bf16_t*)(p.ws + OFF_W_UP), DM, 2 * DFF, tile, true);
    convert_one(p.in[25] + (size_t)l * DFF * DM, (bf16_t*)(p.ws + OFF_W_DN), DFF, DM, tile);
    { const float* w4 = p.in[15] + (size_t)l * 64 * 1024; bf16_t* w4t = (bf16_t*)(p.ws + OFF_W4T);
      for (int idx = blockIdx.x * 512 + TIDX; idx < 65536; idx += gridDim.x * 512) { const int o = idx >> 6, f = idx & 63; w4t[idx] = f2bf(w4[f * 1024 + o]); } }
}
__device__ __forceinline__ bf16_t* abuf_row(const P& p, int t) { return (bf16_t*)(p.ws + OFF_ABUF) + (size_t)(t + APAD) * DM; }
__device__ void ph_rmsnorm_in(const P& p, int l) {
    const int lane = TIDX & 63, wv = TIDX >> 6;
    const float* gain = p.in[2] + (size_t)l * DM;
    for (int t = blockIdx.x * 8 + wv; t < T_TOK; t += gridDim.x * 8) {
        const float* xr = x_src_row(p, l, t);
        float4 v[4]; float ss = 0.f;
#pragma unroll
        for (int i = 0; i < 4; ++i) { v[i] = *(const float4*)(xr + lane * 4 + 256 * i); ss += v[i].x * v[i].x + v[i].y * v[i].y + v[i].z * v[i].z + v[i].w * v[i].w; }
        ss = wave_sum(ss);
        const float r = rsqrtf(ss * (1.0f / DM) + 1e-6f);
        bf16_t* hr = abuf_row(p, t);
#pragma unroll
        for (int i = 0; i < 4; ++i) { const float4 g = *(const float4*)(gain + lane * 4 + 256 * i);
            uint2 w; w.x = pack_bf2(v[i].x * r * g.x, v[i].y * r * g.y); w.y = pack_bf2(v[i].z * r * g.z, v[i].w * r * g.w);
            *(uint2*)(hr + lane * 4 + 256 * i) = w; }
    }
}
__device__ void ph_norm_resid(const P& p, int l, int which) {
    const int lane = TIDX & 63, wv = TIDX >> 6;
    const float* gpost = (which == 0 ? PRM(p, norm_mix_post) : PRM(p, norm_ffn_post)) + (size_t)l * DM;
    const bool has_next = (which == 0) || (l + 1 < NLAYER);
    const float* gnext = which == 0 ? PRM(p, norm_ffn_pre) + (size_t)l * DM : PRM(p, norm_mix_pre) + (size_t)(has_next ? l + 1 : l) * DM;
    const bf16_t* Y = (const bf16_t*)(p.ws + OFF_MIX);
    const int lx = which == 0 ? l : 1;
    nf4 gp[4], gn[4];
#pragma unroll
    for (int i = 0; i < 4; ++i) { gp[i] = *(const nf4*)(gpost + lane * 4 + 256 * i); gn[i] = *(const nf4*)(gnext + lane * 4 + 256 * i); }
    for (int t0 = (blockIdx.x * 8 + wv) * 2; t0 < T_TOK; t0 += gridDim.x * 16) {
        nf4 x[2][4]; nu2 yw[2][4];
#pragma unroll
        for (int rr = 0; rr < 2; ++rr) { const float* xr = x_src_row(p, lx, t0 + rr); const bf16_t* yr = Y + (size_t)(t0 + rr) * DM;
#pragma unroll
            for (int i = 0; i < 4; ++i) { x[rr][i] = *(const nf4*)(xr + lane * 4 + 256 * i); yw[rr][i] = *(const nu2*)(yr + lane * 4 + 256 * i); } }
#pragma unroll
        for (int rr = 0; rr < 2; ++rr) {
            const int t = t0 + rr;
            nf4 y[4]; float ss = 0.f;
#pragma unroll
            for (int i = 0; i < 4; ++i) { const nu2 w = yw[rr][i];
                y[i].x = __uint_as_float(w.x << 16); y[i].y = __uint_as_float(w.x & 0xffff0000u); y[i].z = __uint_as_float(w.y << 16); y[i].w = __uint_as_float(w.y & 0xffff0000u);
                ss += y[i].x * y[i].x + y[i].y * y[i].y + y[i].z * y[i].z + y[i].w * y[i].w; }
            ss = wave_sum(ss);
            const float r = rsqrtf(ss * (1.0f / DM) + 1e-6f);
            float s2 = 0.f;
#pragma unroll
            for (int i = 0; i < 4; ++i) { nf4 xv = x[rr][i];
                xv.x += y[i].x * r * gp[i].x; xv.y += y[i].y * r * gp[i].y; xv.z += y[i].z * r * gp[i].z; xv.w += y[i].w * r * gp[i].w;
                s2 += xv.x * xv.x + xv.y * xv.y + xv.z * xv.z + xv.w * xv.w;
                x[rr][i] = xv;
                *(nf4*)(p.out + (size_t)t * DM + lane * 4 + 256 * i) = xv; }
            if (has_next) {
                s2 = wave_sum(s2);
                const float r2 = rsqrtf(s2 * (1.0f / DM) + 1e-6f);
                bf16_t* hr = abuf_row(p, t);
#pragma unroll
                for (int i = 0; i < 4; ++i) { const nf4 xv = x[rr][i];
                    nu2 w; w.x = pack_bf2(xv.x * r2 * gn[i].x, xv.y * r2 * gn[i].y); w.y = pack_bf2(xv.z * r2 * gn[i].z, xv.w * r2 * gn[i].w);
                    *(nu2*)(hr + lane * 4 + 256 * i) = w; }
            }
        }
    }
}
__device__ void ph_filter(const P& p, int l, LAS unsigned char* lds) {
    LAS float* feats = (LAS float*)lds;
    LAS float* ha = feats + 16 * 36;
    LAS float* hb = ha + 16 * 64;
    LAS float* w1s = hb + 16 * 64;
    LAS float* w2s = w1s + 33 * 64;
    LAS float* w3s = w2s + 64 * 64;
    LAS bf16_t* h3b = (LAS bf16_t*)(w3s + 64 * 64);
    const int tid = TIDX;
    const float* w1 = PRM(p, f_w1) + (size_t)l * 33 * 64; const float* b1 = PRM(p, f_b1) + (size_t)l * 64;
    const float* w2 = PRM(p, f_w2) + (size_t)l * 64 * 64; const float* b2 = PRM(p, f_b2) + (size_t)l * 64;
    const float* w3 = PRM(p, f_w3) + (size_t)l * 64 * 64; const float* b3 = PRM(p, f_b3) + (size_t)l * 64;
    const float* w4 = PRM(p, f_w4) + (size_t)l * 64 * 1024; const float* fq = PRM(p, f_freq) + (size_t)l * 64;
    float* kt = (float*)(p.ws + OFF_KT);
    for (int i = tid; i < 33 * 64; i += 512) w1s[i] = w1[i];
    for (int i = tid; i < 64 * 64; i += 512) { w2s[i] = w2[i]; w3s[i] = w3[i]; }
    const int j = tid & 63;
    const float fqj = fq[j], b1j = b1[j], b2j = b2[j], b3j = b3[j];
    pg8::bf16x8 bfrag[8][2];
    { const bf16_t* w4t = (const bf16_t*)(p.ws + OFF_W4T); const int lane = tid & 63, w = tid >> 6;
#pragma unroll
      for (int nt = 0; nt < 8; ++nt)
#pragma unroll
          for (int ks = 0; ks < 2; ++ks) bfrag[nt][ks] = *(const pg8::bf16x8*)(w4t + (size_t)(128 * w + 16 * nt + (lane & 15)) * 64 + 32 * ks + 8 * (lane >> 4)); }
    __syncthreads();
    const int nitems = (L_BIG + L_SML) / 16;
    for (int it = blockIdx.x; it < nitems; it += gridDim.x) {
        const bool big = it < L_BIG / 16; const int L = big ? L_BIG : L_SML; const int pos0 = (big ? it : it - L_BIG / 16) * 16;
        float* ktc = kt + (big ? 0 : (size_t)512 * 2 * L_BIG);
        for (int idx = tid; idx < 16 * 33; idx += 512) {
            const int pp = idx / 33, f = idx % 33; const int pos = pos0 + pp;
            const float tt = (float)pos / (float)(L - 1), ang = (6.283185307179586f / (float)L) * (float)pos;
            float v;
            if (f == 0) v = tt;
            else { const int bi = (f - 1) & 15; const float band = 1e-4f + (float)bi * ((15.0f - 1e-4f) / 15.0f); v = f <= 16 ? cosf(band * ang) : -sinf(band * ang); }
            feats[pp * 36 + f] = v;
        }
        __syncthreads();
#pragma unroll
        for (int h2 = 0; h2 < 2; ++h2) { const int pp = (tid >> 6) + 8 * h2; float a = b1j;
            for (int f = 0; f < 33; ++f) a += feats[pp * 36 + f] * w1s[f * 64 + j];
            ha[pp * 64 + j] = __sinf(fqj * a); }
        __syncthreads();
#pragma unroll
        for (int h2 = 0; h2 < 2; ++h2) { const int pp = (tid >> 6) + 8 * h2; float a = b2j;
#pragma unroll 4
            for (int f4 = 0; f4 < 16; ++f4) { const nf4 hv = *(const LAS nf4*)(ha + pp * 64 + 4 * f4);
                a += hv.x * w2s[(4 * f4) * 64 + j] + hv.y * w2s[(4 * f4 + 1) * 64 + j] + hv.z * w2s[(4 * f4 + 2) * 64 + j] + hv.w * w2s[(4 * f4 + 3) * 64 + j]; }
            hb[pp * 64 + j] = __sinf(fqj * a); }
        __syncthreads();
#pragma unroll
        for (int h2 = 0; h2 < 2; ++h2) { const int pp = (tid >> 6) + 8 * h2; float a = b3j;
#pragma unroll 4
            for (int f4 = 0; f4 < 16; ++f4) { const nf4 hv = *(const LAS nf4*)(hb + pp * 64 + 4 * f4);
                a += hv.x * w3s[(4 * f4) * 64 + j] + hv.y * w3s[(4 * f4 + 1) * 64 + j] + hv.z * w3s[(4 * f4 + 2) * 64 + j] + hv.w * w3s[(4 * f4 + 3) * 64 + j]; }
            h3b[pp * 72 + j] = f2bf(__sinf(fqj * a)); }
        __syncthreads();
        {
            const int lane = tid & 63, w = tid >> 6, r16 = lane & 15, kg = lane >> 4;
            pg8::f32x4 acc[8];
#pragma unroll
            for (int nt = 0; nt < 8; ++nt) acc[nt] = (pg8::f32x4){0.f, 0.f, 0.f, 0.f};
            pg8::bf16x8 af[2];
#pragma unroll
            for (int ks = 0; ks < 2; ++ks) af[ks] = *(const LAS pg8::bf16x8*)(h3b + r16 * 72 + 32 * ks + 8 * kg);
#pragma unroll
            for (int nt = 0; nt < 8; ++nt)
#pragma unroll
                for (int ks = 0; ks < 2; ++ks) acc[nt] = __builtin_amdgcn_mfma_f32_16x16x32_bf16(af[ks], bfrag[nt][ks], acc[nt], 0, 0, 0);
            const float invl = 1.0f / (float)(L - 1);
            const float dstep = (15.350567286626972f - 3.0701134573253945f) / 511.0f;
            float tt[4];
#pragma unroll
            for (int i = 0; i < 4; ++i) tt[i] = (float)(pos0 + 4 * kg + i) * invl;
#pragma unroll
            for (int nt = 0; nt < 8; ++nt) { const int o = 128 * w + 16 * nt + r16, dir = o >> 9, c = o & 511;
                const float dl = 3.0701134573253945f + (float)c * dstep;
                nf4 v;
#pragma unroll
                for (int i = 0; i < 4; ++i) v[i] = acc[nt][i] * __expf(-tt[i] * dl);
                *(nf4*)(ktc + (size_t)(c * 2 + dir) * L + pos0 + 4 * kg) = v; }
        }
        __syncthreads();
    }
}
__device__ void ph_hy_prep(const P& p, int l, LAS unsigned char* lds) {
    constexpr int RS = 3 * 128 + 8;
    LAS bf16_t* raw = (LAS bf16_t*)lds;
    LAS bf16_t* ox = (LAS bf16_t*)(lds + 52224);
    LAS bf16_t* oz = ox + 128 * 72;
    const bf16_t* hy = (const bf16_t*)(p.ws + OFF_HYRAW);
    bf16_t* x0t = (bf16_t*)(p.ws + OFF_X0T); bf16_t* zt = (bf16_t*)(p.ws + OFF_ZT);
    const float* cw = PRM(p, hy_conv_w) + (size_t)l * 3 * 1536; const float* cb = PRM(p, hy_conv_b) + (size_t)l * 1536;
    const int tid = TIDX, nitems = (T_TOK / 64) * 4;
    for (int it = blockIdx.x; it < nitems; it += gridDim.x) {
        const int t0 = (it >> 2) * 64, c0 = (it & 3) * 128;
        for (int idx = tid; idx < 66 * 48; idx += 512) {
            const int row = idx / 48, rem = idx - row * 48, a = rem >> 4, pc = rem & 15;
            int t = t0 - 1 + row; t = t < 0 ? 0 : (t >= T_TOK ? T_TOK - 1 : t);
            *(LAS nu4*)(raw + row * RS + a * 128 + pc * 8) = *(const nu4*)(hy + (size_t)t * 1536 + a * 512 + c0 + pc * 8);
        }
        __syncthreads();
        {
            const int c = tid & 127, tq = tid >> 7;
            float wv[3][3], bv[3];
#pragma unroll
            for (int a = 0; a < 3; ++a) { bv[a] = cb[a * 512 + c0 + c];
#pragma unroll
                for (int k = 0; k < 3; ++k) wv[a][k] = cw[k * 1536 + a * 512 + c0 + c]; }
            float xm[3], xc[3];
#pragma unroll
            for (int a = 0; a < 3; ++a) { xm[a] = bf2f(raw[(tq * 16) * RS + a * 128 + c]); xc[a] = bf2f(raw[(tq * 16 + 1) * RS + a * 128 + c]); }
            unsigned px = 0, pz = 0;
#pragma unroll
            for (int j = 0; j < 16; ++j) {
                const int tt = tq * 16 + j, t = t0 + tt;
                const bool hp = !seq_start(t), hn = !seq_end(t);
                float r[3];
#pragma unroll
                for (int a = 0; a < 3; ++a) { const float xp = bf2f(raw[(tt + 2) * RS + a * 128 + c]);
                    r[a] = (hp ? xm[a] * wv[a][0] : 0.f) + xc[a] * wv[a][1] + (hn ? xp * wv[a][2] : 0.f) + bv[a];
                    xm[a] = xc[a]; xc[a] = xp; }
                const unsigned bx = f2bf(r[0]), bz = f2bf(r[1] * r[2]);
                if (j & 1) { px |= bx << 16; pz |= bz << 16;
                    *(LAS unsigned*)(ox + c * 72 + tt - 1) = px; *(LAS unsigned*)(oz + c * 72 + tt - 1) = pz; }
                else { px = bx; pz = bz; }
            }
        }
        __syncthreads();
        for (int idx = tid; idx < 128 * 16; idx += 512) {
            const int c = idx >> 4, rem = idx & 15, arr = rem >> 3, pc = rem & 7;
            const nu4 v = *(const LAS nu4*)((arr ? oz : ox) + c * 72 + pc * 8);
            *(nu4*)((arr ? zt : x0t) + (size_t)(c0 + c) * T_TOK + t0 + pc * 8) = v;
        }
        __syncthreads();
    }
}
__device__ __forceinline__ cf2 ld_f2_agent(const cf2* ptr) {
    const unsigned long long w = __hip_atomic_load((const unsigned long long*)ptr, __ATOMIC_RELAXED, __HIP_MEMORY_SCOPE_AGENT);
    return mkf2(__uint_as_float((unsigned)w), __uint_as_float((unsigned)(w >> 32)));
}
template <int S>
__device__ __forceinline__ void hy_fft_job(const P& p, int l, LAS cf2* X, cf2* Ks, int c, bool big) {
    const int tid = TIDX;
    constexpr int M = 1 << (2 * S), L = M;
    const float* kt = (const float*)(p.ws + OFF_KT);
    const bf16_t* x0t = (const bf16_t*)(p.ws + OFF_X0T); bf16_t* zt = (bf16_t*)(p.ws + OFF_ZT);
    const float* hf = kt + (big ? 0 : (size_t)512 * 2 * L_BIG) + (size_t)(c * 2) * L; const float* hb = hf + L;
#pragma unroll 4
    for (int m = tid; m < M; m += 512) {
        const int n0 = 2 * m, n1 = 2 * m + 1;
        const float a = n0 < L ? hf[n0] : (n0 == L ? 0.f : hb[2 * L - n0]);
        const float b = n1 < L ? hf[n1] : hb[2 * L - n1];
        X[PADI(m)] = mkf2(a, b);
    }
    __syncthreads();
    fft_fwd_t<S>(X, 0);
    spec_store(X, S, Ks);
    __builtin_amdgcn_fence(__ATOMIC_ACQUIRE, "agent");
    asm volatile("s_waitcnt vmcnt(0)" ::: "memory");
    __syncthreads();
    const float skip = PRM(p, hy_skip)[(size_t)l * D_HY + c];
    const int nseq = big ? 1 : 4;
    for (int sq = 0; sq < nseq; ++sq) {
        const int t0 = big ? 0 : L_BIG + sq * L_SML;
        const bf16_t* zrow = zt + (size_t)c * T_TOK + t0; const bf16_t* xrow = x0t + (size_t)c * T_TOK + t0;
#pragma unroll 4
        for (int m = tid; m < M; m += 512) {
            cf2 v = mkf2(0.f, 0.f);
            if (m < (M >> 1)) { const unsigned w = *(const unsigned*)(zrow + 2 * m); v.x = __uint_as_float(w << 16); v.y = __uint_as_float(w & 0xffff0000u); }
            X[PADI(m)] = v;
        }
        __syncthreads();
        fft_fwd_t<S>(X, 0);
        spec_mul(X, S, Ks);
        fft_inv_t<S>(X);
        const float inv = 1.0f / (float)M;
        bf16_t* orow = zt + (size_t)c * T_TOK + t0;
#pragma unroll 4
        for (int m = tid; m < (M >> 1); m += 512) {
            const cf2 d = X[PADI(m)];
            const unsigned wz = *(const unsigned*)(zrow + 2 * m), wx = *(const unsigned*)(xrow + 2 * m);
            const float z0 = __uint_as_float(wz << 16), z1 = __uint_as_float(wz & 0xffff0000u), a0 = __uint_as_float(wx << 16), a1 = __uint_as_float(wx & 0xffff0000u);
            *(unsigned*)(orow + 2 * m) = pack_bf2(a0 * (d.x * inv + skip * z0), a1 * (d.y * inv + skip * z1));
        }
        __syncthreads();
    }
}
__device__ void ph_hy_fft(const P& p, int l, LAS unsigned char* lds) {
    LAS cf2* X = (LAS cf2*)lds;
    cf2* Ks = (cf2*)(p.ws + OFF_KS) + (size_t)blockIdx.x * L_BIG;
    for (int job = blockIdx.x; job < 1024; job += gridDim.x) {
        const bool big = job < 512; const int c = job & 511;
        if (big) hy_fft_job<7>(p, l, X, Ks, c, true); else hy_fft_job<6>(p, l, X, Ks, c, false);
    }
}
__device__ void ph_hy_norm(const P& p, int l, LAS unsigned char* lds) {
    LAS bf16_t* tl = (LAS bf16_t*)lds;
    LAS float* red = (LAS float*)(lds + 9216);
    const bf16_t* yh = (const bf16_t*)(p.ws + OFF_ZT);
    const float* gain = PRM(p, hy_out_norm) + (size_t)l * D_HY;
    const int tid = TIDX, nitems = (T_TOK / 64) * 8;
    for (int it = blockIdx.x; it < nitems; it += gridDim.x) {
        const int t0 = (it >> 3) * 64, c0 = (it & 7) * 64;
        { const int cc = tid >> 3, pc = tid & 7;
          *(LAS nu4*)(tl + cc * 72 + pc * 8) = *(const nu4*)(yh + (size_t)(c0 + cc) * T_TOK + t0 + pc * 8); }
        __syncthreads();
        { const int tt = tid & 63, part = tid >> 6; float s = 0.f;
#pragma unroll
          for (int j = 0; j < 8; ++j) { const float v = bf2f(tl[(part * 8 + j) * 72 + tt]); s += v * v; }
          red[part * 64 + tt] = s; }
        __syncthreads();
        { const int tt = tid >> 3, pc = tid & 7;
          float s = 0.f;
#pragma unroll
          for (int j = 0; j < 8; ++j) s += red[j * 64 + tt];
          const float r = rsqrtf(s * (1.0f / 64.0f) + 1e-6f);
          unsigned w[4];
#pragma unroll
          for (int j = 0; j < 4; ++j) { const int ca = pc * 8 + 2 * j;
              w[j] = pack_bf2(bf2f(tl[ca * 72 + tt]) * r * gain[c0 + ca], bf2f(tl[(ca + 1) * 72 + tt]) * r * gain[c0 + ca + 1]); }
          nu4 o; o.x = w[0]; o.y = w[1]; o.z = w[2]; o.w = w[3];
          *(nu4*)(abuf_row(p, t0 + tt) + c0 + pc * 8) = o; }
        __syncthreads();
    }
}
typedef short hbf16x8 __attribute__((ext_vector_type(8)));
typedef float hf32x16 __attribute__((ext_vector_type(16)));
constexpr int HSC = 512, HNCH = HSC / 64, HNSC = T_TOK / HSC;
constexpr int QS = 136, KS_ = 72;
constexpr int HL_QH = 0, HL_KH = HL_QH + 64 * QS * 2, HL_QT = HL_KH + 64 * QS * 2, HL_KT = HL_QT + 64 * QS * 2, HL_VT = HL_KT + 128 * KS_ * 2, HL_ST = HL_VT + 128 * KS_ * 2,
              HL_PM = HL_ST + 128 * QS * 2, HL_TOT = HL_PM + 64 * KS_ * 2, HL_EB = HL_TOT + 4 * 128 * 4, HL_END = HL_EB + 128 * 4;
constexpr int HL_OF = HL_QH, OFS = 132;
static_assert(64 * OFS * 4 <= 2 * 64 * QS * 2, "O tile must fit over Qh|Kh");
constexpr size_t OFF_HST = OFF_R6 + 32 * MiB;
constexpr size_t OFF_HAT = OFF_SMALL + 64 * 1024;

__device__ __forceinline__ hf32x16 mfma32(hbf16x8 a, hbf16x8 b, hf32x16 c) { return __builtin_amdgcn_mfma_f32_32x32x16_bf16(a, b, c, 0, 0, 0); }
__device__ __forceinline__ hbf16x8 lds_frag(const LAS unsigned char* base, int row, int stride_el, int col_el) { return *(const LAS hbf16x8*)(base + ((size_t)row * stride_el + col_el) * 2); }

typedef unsigned hu32x4 __attribute__((ext_vector_type(4)));
struct HgPre { hu32x4 f0, f1, v0, v1, q0, q1; };
template <bool FULL>
__device__ __forceinline__ void hg_fetch(const bf16_t* hg, HgPre& pre, int tokbase, int dirsign, int h, int dir) {
    const int tid = TIDX;
    { const int u = tid >> 4, seg = tid & 15;
      const bf16_t* row = hg + (size_t)(tokbase + dirsign * u) * 2560 + h * 128 + seg * 8;
      pre.f0 = *(const hu32x4*)(row + 512 + 512 * dir); pre.v0 = *(const hu32x4*)(row + 1536); if (FULL) pre.q0 = *(const hu32x4*)(row);
      const bf16_t* row1 = row + (size_t)dirsign * 32 * 2560;
      pre.f1 = *(const hu32x4*)(row1 + 512 + 512 * dir); pre.v1 = *(const hu32x4*)(row1 + 1536); if (FULL) pre.q1 = *(const hu32x4*)(row1); }
}
template <bool FULL>
__device__ __forceinline__ void hg_prep(LAS unsigned char* lds, const HgPre& pre, float lb, float& Bsum_out) {
    const int tid = TIDX, d = tid & 127, qt = tid >> 7;
    LAS float* tot = (LAS float*)(lds + HL_TOT); LAS float* eB = (LAS float*)(lds + HL_EB);
    { const int u = tid >> 4, seg = tid & 15;
      *(LAS hu32x4*)(lds + HL_KH + ((size_t)u * QS + seg * 8) * 2) = pre.f0; *(LAS hu32x4*)(lds + HL_KH + ((size_t)(u + 32) * QS + seg * 8) * 2) = pre.f1;
      *(LAS hu32x4*)(lds + HL_QH + ((size_t)u * QS + seg * 8) * 2) = pre.v0; *(LAS hu32x4*)(lds + HL_QH + ((size_t)(u + 32) * QS + seg * 8) * 2) = pre.v1;
      if (FULL) { *(LAS hu32x4*)(lds + HL_QT + ((size_t)u * QS + seg * 8) * 2) = pre.q0; *(LAS hu32x4*)(lds + HL_QT + ((size_t)(u + 32) * QS + seg * 8) * 2) = pre.q1; } }
    __syncthreads();
    float c[16];
    float run = 0.f;
    const float oml = 1.0f - lb;
    float zz[16];
#pragma unroll
    for (int j = 0; j < 16; ++j) zz[j] = bf2f(*(const LAS bf16_t*)(lds + HL_KH + ((size_t)(qt * 16 + j) * QS + d) * 2));
    __builtin_amdgcn_sched_barrier(0);
#pragma unroll
    for (int j = 0; j < 16; ++j) {
        const int u = qt * 16 + j;
        const float z = fmaxf(zz[j], -60.0f);
        const float f = lb + oml * __builtin_amdgcn_rcpf(1.0f + __expf(-z));
        zz[j] = 1.0f - f;
        run += __logf(f);
        c[j] = run;
    }
    tot[qt * 128 + d] = run;
    float vv[16], qq[16];
#pragma unroll
    for (int j = 0; j < 16; ++j) { vv[j] = __uint_as_float((unsigned)(*(const LAS bf16_t*)(lds + HL_QH + ((size_t)(qt * 16 + j) * QS + d) * 2)));
        if (FULL) qq[j] = bf2f(*(const LAS bf16_t*)(lds + HL_QT + ((size_t)(qt * 16 + j) * QS + d) * 2)); }
    __syncthreads();
    const float t0 = tot[d], t1 = tot[128 + d], t2 = tot[256 + d], t3 = tot[384 + d];
    const float off = qt == 0 ? 0.f : (qt == 1 ? t0 : (qt == 2 ? t0 + t1 : t0 + t1 + t2));
    const float r = t0 + t1, B = t0 + t1 + t2 + t3;
    const float eBr = __expf(B - r), eR = __expf(r);
    if (qt == 0) eB[d] = __expf(B);
    Bsum_out = B;
#pragma unroll
    for (int jj = 0; jj < 8; ++jj) {
        unsigned pkt = 0, pvt = 0;
#pragma unroll
        for (int q2 = 0; q2 < 2; ++q2) {
            const int j = jj * 2 + q2, u = qt * 16 + j;
            const float rb = r - (off + c[j]);
            const float kh = zz[j] * __expf(rb);
            pkt |= (unsigned)f2bf(kh * eBr) << (16 * q2); pvt |= __float_as_uint(vv[j]) << (16 * q2);
            if (FULL) {
                const float zq = qq[j];
                const float q = zq * __builtin_amdgcn_rcpf(1.0f + __expf(-zq));
                const float qh = q * __expf(-rb);
                *(LAS bf16_t*)(lds + HL_QT + ((size_t)u * QS + d) * 2) = f2bf(qh * eR);
                *(LAS bf16_t*)(lds + HL_QH + ((size_t)u * QS + d) * 2) = f2bf(qh);
                *(LAS bf16_t*)(lds + HL_KH + ((size_t)u * QS + d) * 2) = f2bf(kh);
            }
        }
        *(LAS unsigned*)(lds + HL_KT + ((size_t)d * KS_ + qt * 16 + jj * 2) * 2) = pkt;
        *(LAS unsigned*)(lds + HL_VT + ((size_t)d * KS_ + qt * 16 + jj * 2) * 2) = pvt;
    }
    __syncthreads();
}
__device__ __forceinline__ void hg_state_update(LAS unsigned char* lds, hf32x16 (&S)[2], int w, int lane) {
    const int en = w & 3, r = lane & 31, hh = lane >> 5;
    const LAS float* eB = (const LAS float*)(lds + HL_EB);
#pragma unroll
    for (int i = 0; i < 2; ++i) {
        const int dm = (w >> 2) * 2 + i;
#pragma unroll
        for (int g = 0; g < 4; ++g) { const nf4 sc = *(const LAS nf4*)(eB + 32 * dm + 8 * g + 4 * hh);
            S[i][4 * g + 0] *= sc.x; S[i][4 * g + 1] *= sc.y; S[i][4 * g + 2] *= sc.z; S[i][4 * g + 3] *= sc.w; }
#pragma unroll
        for (int ks = 0; ks < 4; ++ks) {
            const hbf16x8 a = lds_frag(lds + HL_KT, 32 * dm + r, KS_, 16 * ks + 8 * hh);
            const hbf16x8 b = lds_frag(lds + HL_VT, 32 * en + r, KS_, 16 * ks + 8 * hh);
            S[i] = mfma32(a, b, S[i]);
        }
    }
}
__device__ __forceinline__ int hg_unit_base(int sc) { return sc * HSC; }
__device__ void ph_hg_pass1(const P& p, int l, LAS unsigned char* lds) {
    const bf16_t* hg = (const bf16_t*)(p.ws + OFF_HG);
    const float* lbs = (const float*)(p.ws + OFF_SMALL);
    float* ust = (float*)(p.ws + OFF_HST); float* atot = (float*)(p.ws + OFF_HAT);
    const int tid = TIDX, w = tid >> 6, lane = tid & 63;
    for (int unit = blockIdx.x; unit < HNSC * 8; unit += gridDim.x) {
        const int sc = unit >> 3, h = (unit >> 1) & 3, dir = unit & 1;
        const float lb = lbs[(size_t)(dir * NLAYER + l) * D_HG + h * 128 + (tid & 127)];
        hf32x16 S[2];
#pragma unroll
        for (int i = 0; i < 2; ++i)
#pragma unroll
            for (int k = 0; k < 16; ++k) S[i][k] = 0.f;
        float Btot = 0.f;
        const int dsg = dir ? -1 : 1, tb0 = dir ? hg_unit_base(sc) + HSC - 1 : hg_unit_base(sc);
        HgPre pre;
        hg_fetch<false>(hg, pre, tb0, dsg, h, dir);
        for (int ci = 0; ci < HNCH; ++ci) {
            float B;
            hg_prep<false>(lds, pre, lb, B);
            if (ci + 1 < HNCH) hg_fetch<false>(hg, pre, tb0 + dsg * (ci + 1) * 64, dsg, h, dir);
            Btot += B;
            hg_state_update(lds, S, w, lane);
            __syncthreads();
        }
        float* U = ust + (size_t)unit * 16384;
        int r = lane & 31, hh = lane >> 5; asm volatile("" : "+v"(r), "+v"(hh));
        const int en = w & 3;
#pragma unroll
        for (int i = 0; i < 2; ++i) { const int dm = (w >> 2) * 2 + i;
#pragma unroll
            for (int k = 0; k < 16; ++k) U[(32 * dm + (k & 3) + 8 * (k >> 2) + 4 * hh) * 128 + 32 * en + r] = S[i][k]; }
        if (tid < 128) atot[(size_t)unit * 128 + tid] = __expf(Btot);
    }
}
__device__ void ph_hg_pass2(const P& p) {
    float* ust = (float*)(p.ws + OFF_HST); const float* atot = (const float*)(p.ws + OFF_HAT);
    const int total = 5 * 8 * 16384;
    for (int idx = blockIdx.x * 512 + TIDX; idx < total; idx += gridDim.x * 512) {
        const int el = idx & 16383, hd = (idx >> 14) & 7, sq = idx >> 17;
        const int sc0 = sq == 0 ? 0 : 32 + 8 * (sq - 1), nsc = sq == 0 ? 32 : 8, dir = hd & 1, d = el >> 7;
        float carry = 0.f;
        for (int j0 = 0; j0 < nsc; j0 += 8) {
            float u[8], a[8];
#pragma unroll
            for (int jj = 0; jj < 8; ++jj) { const int j = j0 + jj, sc = dir ? sc0 + nsc - 1 - j : sc0 + j; const size_t unit = (size_t)sc * 8 + hd;
                u[jj] = ust[unit * 16384 + el]; a[jj] = atot[unit * 128 + d]; }
#pragma unroll
            for (int jj = 0; jj < 8; ++jj) { const int j = j0 + jj, sc = dir ? sc0 + nsc - 1 - j : sc0 + j; const size_t unit = (size_t)sc * 8 + hd;
                ust[unit * 16384 + el] = carry; carry = a[jj] * carry + u[jj]; }
        }
    }
}
__device__ void ph_hg_pass3(const P& p, int l, LAS unsigned char* lds) {
    const bf16_t* hg = (const bf16_t*)(p.ws + OFF_HG);
    const float* lbs = (const float*)(p.ws + OFF_SMALL);
    const float* ust = (const float*)(p.ws + OFF_HST);
    const float* gain = PRM(p, hg_out_norm) + (size_t)l * D_HG;
    const int tid = TIDX, w = tid >> 6, lane = tid & 63, r = lane & 31, hh = lane >> 5;
    for (int unit = blockIdx.x; unit < HNSC * 4; unit += gridDim.x) {
        const int sc = unit >> 2, h = unit & 3;
        for (int dir = 0; dir < 2; ++dir) {
            const float lb = lbs[(size_t)(dir * NLAYER + l) * D_HG + h * 128 + (tid & 127)];
            const float* S0 = ust + ((size_t)sc * 8 + h * 2 + dir) * 16384;
            hf32x16 S[2];
            { const int en = w & 3;
              int r_ = r, hh_ = hh; asm volatile("" : "+v"(r_), "+v"(hh_));
              const float* S0l = S0 + (4 * hh_) * 128 + 32 * en + r_;
#pragma unroll
              for (int i = 0; i < 2; ++i) { const int dm = (w >> 2) * 2 + i;
#pragma unroll
                  for (int k = 0; k < 16; ++k) S[i][k] = S0l[(32 * dm + (k & 3) + 8 * (k >> 2)) * 128];
#pragma unroll
                  for (int g = 0; g < 4; ++g) { nu2 wv; wv.x = pack_bf2(S[i][4 * g], S[i][4 * g + 1]); wv.y = pack_bf2(S[i][4 * g + 2], S[i][4 * g + 3]);
                      *(LAS nu2*)(lds + HL_ST + ((size_t)(32 * en + r) * QS + 32 * dm + 8 * g + 4 * hh) * 2) = wv; } } }
            const int dsg = dir ? -1 : 1, tb0 = dir ? hg_unit_base(sc) + HSC - 1 : hg_unit_base(sc);
            HgPre pre;
            hg_fetch<true>(hg, pre, tb0, dsg, h, dir);
            for (int ci = 0; ci < HNCH; ++ci) {
                const int tokbase = tb0 + dsg * ci * 64;
                float Bdummy;
                hg_prep<true>(lds, pre, lb, Bdummy);
                if (ci + 1 < HNCH) hg_fetch<true>(hg, pre, tb0 + dsg * (ci + 1) * 64, dsg, h, dir);
                if (w < 4) {
                    const int tm = (w == 0 || w == 3) ? 0 : 1, sn = (w == 2 || w == 3) ? 1 : 0;
                    hf32x16 acc;
#pragma unroll
                    for (int k = 0; k < 16; ++k) acc[k] = 0.f;
                    if (w < 3) {
#pragma unroll
                        for (int ks = 0; ks < 8; ++ks) acc = mfma32(lds_frag(lds + HL_QH, 32 * tm + r, QS, 16 * ks + 8 * hh), lds_frag(lds + HL_KH, 32 * sn + r, QS, 16 * ks + 8 * hh), acc);
                    }
                    const int s_ = 32 * sn + r;
#pragma unroll
                    for (int k = 0; k < 16; ++k) { const int t_ = 32 * tm + (k & 3) + 8 * (k >> 2) + 4 * hh;
                        const float v = (w < 3 && s_ <= t_) ? acc[k] : 0.f;
                        *(LAS bf16_t*)(lds + HL_PM + ((size_t)t_ * KS_ + s_) * 2) = f2bf(v); }
                }
                __syncthreads();
                hf32x16 o;
                { const int tm = w >> 2, en = w & 3;
#pragma unroll
                  for (int k = 0; k < 16; ++k) o[k] = 0.f;
#pragma unroll
                  for (int ks = 0; ks < 4; ++ks) o = mfma32(lds_frag(lds + HL_PM, 32 * tm + r, KS_, 16 * ks + 8 * hh), lds_frag(lds + HL_VT, 32 * en + r, KS_, 16 * ks + 8 * hh), o);
#pragma unroll
                  for (int ks = 0; ks < 8; ++ks) o = mfma32(lds_frag(lds + HL_QT, 32 * tm + r, QS, 16 * ks + 8 * hh), lds_frag(lds + HL_ST, 32 * en + r, QS, 16 * ks + 8 * hh), o);
                }
                __syncthreads();
                { const int tm = w >> 2, en = w & 3; LAS float* Of = (LAS float*)(lds + HL_OF);
#pragma unroll
                  for (int k = 0; k < 16; ++k) Of[(size_t)(32 * tm + (k & 3) + 8 * (k >> 2) + 4 * hh) * OFS + 32 * en + r] = o[k]; }
                hg_state_update(lds, S, w, lane);
                { const int en = w & 3;
#pragma unroll
                  for (int i = 0; i < 2; ++i) { const int dm = (w >> 2) * 2 + i;
#pragma unroll
                      for (int g = 0; g < 4; ++g) { nu2 wv; wv.x = pack_bf2(S[i][4 * g], S[i][4 * g + 1]); wv.y = pack_bf2(S[i][4 * g + 2], S[i][4 * g + 3]);
                          *(LAS nu2*)(lds + HL_ST + ((size_t)(32 * en + r) * QS + 32 * dm + 8 * g + 4 * hh) * 2) = wv; } } }
                __syncthreads();
                { const int u = tid >> 3, e0 = (tid & 7) * 16, tok = tokbase + dsg * u;
                  const LAS float* Of = (const LAS float*)(lds + HL_OF) + (size_t)u * OFS + e0;
                  bf16_t* dst = abuf_row(p, tok) + 512 + h * 128 + e0;
                  float v[16];
#pragma unroll
                  for (int j = 0; j < 4; ++j) { const nf4 t4 = *(const LAS nf4*)(Of + 4 * j); v[4 * j] = t4.x; v[4 * j + 1] = t4.y; v[4 * j + 2] = t4.z; v[4 * j + 3] = t4.w; }
                  if (dir == 0) {
                      uint4 w0, w1;
                      w0.x = pack_bf2(v[0], v[1]); w0.y = pack_bf2(v[2], v[3]); w0.z = pack_bf2(v[4], v[5]); w0.w = pack_bf2(v[6], v[7]);
                      w1.x = pack_bf2(v[8], v[9]); w1.y = pack_bf2(v[10], v[11]); w1.z = pack_bf2(v[12], v[13]); w1.w = pack_bf2(v[14], v[15]);
                      ((uint4*)dst)[0] = w0; ((uint4*)dst)[1] = w1;
                  } else {
                      const uint4 f0 = ((const uint4*)dst)[0], f1 = ((const uint4*)dst)[1];
                      const unsigned fw[8] = {f0.x, f0.y, f0.z, f0.w, f1.x, f1.y, f1.z, f1.w};
                      float ss = 0.f;
#pragma unroll
                      for (int j = 0; j < 8; ++j) { v[2 * j] += __uint_as_float(fw[j] << 16); v[2 * j + 1] += __uint_as_float(fw[j] & 0xffff0000u); ss += v[2 * j] * v[2 * j] + v[2 * j + 1] * v[2 * j + 1]; }
                      ss += __shfl_xor(ss, 1); ss += __shfl_xor(ss, 2); ss += __shfl_xor(ss, 4);
                      const float rn = rsqrtf(ss * (1.0f / 128.0f) + 1e-6f);
                      const bf16_t* gp = hg + (size_t)tok * 2560 + 2048 + h * 128 + e0;
                      const uint4 g0 = ((const uint4*)gp)[0], g1 = ((const uint4*)gp)[1];
                      const unsigned gw[8] = {g0.x, g0.y, g0.z, g0.w, g1.x, g1.y, g1.z, g1.w};
                      unsigned ow[8];
#pragma unroll
                      for (int j = 0; j < 8; ++j) { const float ga = silu_f(__uint_as_float(gw[j] << 16)), gb = silu_f(__uint_as_float(gw[j] & 0xffff0000u));
                          ow[j] = pack_bf2(v[2 * j] * rn * gain[h * 128 + e0 + 2 * j] * ga, v[2 * j + 1] * rn * gain[h * 128 + e0 + 2 * j + 1] * gb); }
                      ((uint4*)dst)[0] = make_uint4(ow[0], ow[1], ow[2], ow[3]); ((uint4*)dst)[1] = make_uint4(ow[4], ow[5], ow[6], ow[7]);
                  }
                }
                __syncthreads();
            }
        }
    }
}
#define XB_TMO      128
#define XB_XCNT(j)  (256  + 64 * (j))
#define XB_XSUB(j)  (1280 + 64 * (j))
#define XB_XGEN(j)  (2304 + 64 * (j))
#define XB_TOP      3328
#define XB_TOPGEN   3392
#define XCD_BAR_WORDS 3456
#define XB_SPIN_CAP (1u << 18)

__device__ __forceinline__ unsigned xb_ld(unsigned* p)              { return __hip_atomic_load(p, __ATOMIC_RELAXED, __HIP_MEMORY_SCOPE_AGENT); }
__device__ __forceinline__ unsigned xb_add(unsigned* p, unsigned v) { return __hip_atomic_fetch_add(p, v, __ATOMIC_RELAXED, __HIP_MEMORY_SCOPE_AGENT); }
__device__ __forceinline__ unsigned xb_xcc_id() { return (unsigned)__builtin_amdgcn_s_getreg((3 << 11) | 20) & 0xFu; }
#define XB_SPIN(cond, bar) do { unsigned _sp = 0; while (cond) { __builtin_amdgcn_s_sleep(1); \
    if ((++_sp & 255u) == 0u) { if (xb_ld(&(bar)[XB_TMO])) break; if (_sp > XB_SPIN_CAP) { atomicAdd(&(bar)[XB_TMO], 1u); break; } } } } while (0)

struct XcdBarrier {
    unsigned* bar; unsigned x;
    volatile LAS unsigned* st;
};

__device__ __forceinline__ XcdBarrier xcd_barrier_post(unsigned* bar, volatile LAS unsigned* st) {
    XcdBarrier b; b.bar = bar; b.x = xb_xcc_id(); b.st = st;
    if (TIDX == 0) (void)xb_add(&bar[XB_XCNT(b.x)], 1u);
    return b;
}
__device__ __forceinline__ void xcd_barrier_complete(unsigned* bar, unsigned x, unsigned& nloc, unsigned& nx) {
    const unsigned G = gridDim.x * gridDim.y * gridDim.z;
    unsigned sum, cnt, mine, sp = 0u;
    for (;;) {
        sum = 0u; cnt = 0u; mine = 0u;
#pragma unroll
        for (unsigned j = 0; j < 16; ++j) { const unsigned c = xb_ld(&bar[XB_XCNT(j)]); sum += c; cnt += (c > 0u) ? 1u : 0u; mine = (j == x) ? c : mine; }
        if (sum == G) break;
        __builtin_amdgcn_s_sleep(1);
        if ((++sp & 255u) == 0u) { if (xb_ld(&bar[XB_TMO])) break; if (sp > XB_SPIN_CAP) { atomicAdd(&bar[XB_TMO], 1u); break; } }
    }
    nloc = mine > 0u ? mine : 1u; nx = cnt > 0u ? cnt : 1u;
}

__device__ __forceinline__ void xcd_barrier(const XcdBarrier& b) {
    asm volatile("s_waitcnt vmcnt(0)" ::: "memory");
    __syncthreads();
    if (TIDX == 0) {
        unsigned* bar = b.bar;
        __builtin_amdgcn_s_waitcnt(0);
        unsigned nloc = b.st[0], nx = b.st[1];
        if (nloc == 0u) { xcd_barrier_complete(bar, b.x, nloc, nx); b.st[0] = nloc; b.st[1] = nx; }
        const unsigned old = xb_add(&bar[XB_XSUB(b.x)], 1u);
        const unsigned gen = old / nloc;
        if (old + 1u == (gen + 1u) * nloc) {
            __builtin_amdgcn_fence(__ATOMIC_RELEASE, "agent");
            asm volatile("s_waitcnt vmcnt(0)" ::: "memory");
            const unsigned og = xb_add(&bar[XB_TOP], 1u);
            const unsigned tg = og / nx;
            if (og + 1u == (tg + 1u) * nx) xb_add(&bar[XB_TOPGEN], 1u);
            else XB_SPIN(xb_ld(&bar[XB_TOPGEN]) == tg, bar);
            __builtin_amdgcn_fence(__ATOMIC_ACQUIRE, "agent");
            xb_add(&bar[XB_XGEN(b.x)], 1u);
            asm volatile("s_waitcnt vmcnt(0)" ::: "memory");
        } else {
            XB_SPIN(xb_ld(&bar[XB_XGEN(b.x)]) == gen, bar);
            __builtin_amdgcn_fence(__ATOMIC_ACQUIRE, "agent");
            asm volatile("s_waitcnt vmcnt(0)" ::: "memory");
        }
    }
    __syncthreads();
}

enum { PH_SETUP, PH_CONVERT, PH_RMS_IN, PH_GEMM_IN, PH_HY_PREP, PH_FILTER, PH_HGRN, PH_HG_NORM, PH_HY_FFT, PH_HY_NORM, PH_GEMM_OUT, PH_NR0, PH_GEMM_UP, PH_GEGLU, PH_GEMM_DN, PH_NR1, PH_HG_P1, PH_HG_P2, PH_HG_P3 };
template <int PH> __device__ __forceinline__ void run_phase(const P& p_in, int l, int part, LAS unsigned char* lds) {
    typedef __attribute__((address_space(1))) unsigned char* gptr_t; typedef __attribute__((address_space(1))) float* gfptr_t;
    gptr_t wsg = (gptr_t)p_in.ws; gfptr_t outg = (gfptr_t)p_in.out;
    asm volatile("" : "+s"(wsg), "+s"(outg));
    P p = p_in; p.ws = (unsigned char*)wsg; p.out = (float*)outg;
    if constexpr (PH == PH_SETUP) { ph_setup(p); ph_copy_params(p); }
    if constexpr (PH == PH_CONVERT) ph_convert_w(p, l, lds);
    if constexpr (PH == PH_RMS_IN) ph_rmsnorm_in(p, l);
    if constexpr (PH == PH_GEMM_IN) { EpiBf16Split E; E.O0 = (bf16_t*)(p.ws + OFF_HYRAW); E.ldc0 = 1536; E.O1 = (bf16_t*)(p.ws + OFF_HG); E.ldc1 = 2560; E.csplit = 1536;
        run_gemm(lds, abuf_row(p, 0), (const bf16_t*)(p.ws + OFF_W_IN), T_TOK, D_IN, DM, E); }
    if constexpr (PH == PH_HY_PREP) ph_hy_prep(p, l, lds);
    if constexpr (PH == PH_FILTER) ph_filter(p, l, lds);
    if constexpr (PH == PH_HY_FFT) ph_hy_fft(p, l, lds);
    if constexpr (PH == PH_HY_NORM) ph_hy_norm(p, l, lds);
    if constexpr (PH == PH_GEMM_OUT) { EpiBf16Split E; E.O0 = (bf16_t*)(p.ws + OFF_MIX); E.ldc0 = DM; E.O1 = E.O0; E.ldc1 = DM; E.csplit = 1 << 30;
        run_gemm(lds, abuf_row(p, 0), (const bf16_t*)(p.ws + OFF_W_OUT), T_TOK, DM, DM, E); }
    if constexpr (PH == PH_NR0) ph_norm_resid(p, l, 0);
    if constexpr (PH == PH_GEMM_UP) { EpiGeglu E; E.act = (bf16_t*)(p.ws + OFF_ACT); E.cw = PRM(p, ffn_conv_w) + (size_t)l * 3 * 8192; E.cb = PRM(p, ffn_conv_b) + (size_t)l * 8192;
        run_gemm(lds, abuf_row(p, -1), (const bf16_t*)(p.ws + OFF_W_UP), 133 * 256, 2 * DFF, DM, E); }
    if constexpr (PH == PH_GEMM_DN) { EpiBf16Split E; E.O0 = (bf16_t*)(p.ws + OFF_MIX); E.ldc0 = DM; E.O1 = E.O0; E.ldc1 = DM; E.csplit = 1 << 30;
        run_gemm(lds, (const bf16_t*)(p.ws + OFF_ACT), (const bf16_t*)(p.ws + OFF_W_DN), T_TOK, DM, DFF, E); }
    if constexpr (PH == PH_NR1) ph_norm_resid(p, l, 1);
    if constexpr (PH == PH_HG_P1) ph_hg_pass1(p, l, lds);
    if constexpr (PH == PH_HG_P2) ph_hg_pass2(p);
    if constexpr (PH == PH_HG_P3) ph_hg_pass3(p, l, lds);
}
constexpr int LDS_BYTES = 139264;
__global__ __launch_bounds__(512, 2) void mega(P p) {
    extern __shared__ __attribute__((aligned(16))) unsigned char lds_g[];
    LAS unsigned char* lds = (LAS unsigned char*)lds_g;
    cg::grid_group grid = cg::this_grid();
    volatile LAS unsigned* xst = (volatile LAS unsigned*)(lds + LDS_BYTES - 16);
    if (TIDX == 0) { xst[0] = 0u; xst[1] = 0u; }
    __syncthreads();
    const XcdBarrier xb = xcd_barrier_post((unsigned*)(p.ws + OFF_BAR), xst);
    run_phase<PH_SETUP>(p, 0, 0, lds);
    run_phase<PH_CONVERT>(p, 0, 0, lds);
    run_phase<PH_RMS_IN>(p, 0, 0, lds);
    grid.sync();
#pragma unroll 1
    for (int l = 0; l < NLAYER; ++l) {
        run_phase<PH_GEMM_IN>(p, l, 0, lds); xcd_barrier(xb);
        run_phase<PH_HY_PREP>(p, l, 0, lds); run_phase<PH_HG_P1>(p, l, 0, lds); xcd_barrier(xb);
        run_phase<PH_FILTER>(p, l, 0, lds); run_phase<PH_HG_P2>(p, l, 0, lds); xcd_barrier(xb);
        run_phase<PH_HG_P3>(p, l, 0, lds); run_phase<PH_HY_FFT>(p, l, 0, lds); xcd_barrier(xb);
        run_phase<PH_HY_NORM>(p, l, 0, lds); xcd_barrier(xb);
        run_phase<PH_GEMM_OUT>(p, l, 0, lds); xcd_barrier(xb);
        run_phase<PH_NR0>(p, l, 0, lds); xcd_barrier(xb);
        run_phase<PH_GEMM_UP>(p, l, 0, lds); xcd_barrier(xb);
        run_phase<PH_GEMM_DN>(p, l, 0, lds); xcd_barrier(xb);
        run_phase<PH_NR1>(p, l, 0, lds);
        if (l + 1 < NLAYER) { run_phase<PH_CONVERT>(p, l + 1, 0, lds); xcd_barrier(xb); }
    }
}
extern "C" void kernel_launch(void* const* d_in, const int* in_sizes, int n_in, void* d_out, int out_size, void* d_ws, size_t ws_size, hipStream_t stream) {
    if (ws_size < WS_NEED) { fprintf(stderr, "workspace too small: %zu < %zu\n", ws_size, (size_t)WS_NEED); return; }
    static int grid_blocks = 0;
    if (!grid_blocks) {
        hipFuncSetAttribute((const void*)mega, hipFuncAttributeMaxDynamicSharedMemorySize, LDS_BYTES);
        int dev = 0, cus = 0, per_cu = 0;
        hipGetDevice(&dev);
        hipDeviceGetAttribute(&cus, hipDeviceAttributeMultiprocessorCount, dev);
        hipOccupancyMaxActiveBlocksPerMultiprocessor(&per_cu, mega, 512, LDS_BYTES);
        if (per_cu > 1) per_cu = 1;
        grid_blocks = cus * per_cu;
    }
    P p{};
    for (int i = 0; i < 26; ++i) p.in[i] = (const float*)d_in[i];
    p.out = (float*)d_out; p.ws = (unsigned char*)d_ws;
    hipMemsetAsync((unsigned char*)d_ws + OFF_BAR, 0, XCD_BAR_WORDS * 4, stream);
    void* args[] = {&p};
    hipError_t e = hipLaunchCooperativeKernel((void*)mega, dim3(grid_blocks), dim3(512), args, LDS_BYTES, stream);
    if (e != hipSuccess) fprintf(stderr, "cooperative launch failed: %s (grid %d)\n", hipGetErrorString(e), grid_blocks);
}
```

```cpp
#include <hip/hip_runtime.h>
#include <hip/hip_cooperative_groups.h>
#include <cstdio>
#include <cstdint>
namespace cg = cooperative_groups;
__device__ __forceinline__ int tid_opaque() { int t = (int)threadIdx.x; asm volatile("" : "+v"(t)); return t; }
#define TIDX tid_opaque()
#define LAS __attribute__((address_space(3)))
typedef float cf2 __attribute__((ext_vector_type(2)));
typedef float nf4 __attribute__((ext_vector_type(4)));
typedef unsigned nu2 __attribute__((ext_vector_type(2)));
typedef unsigned nu4 __attribute__((ext_vector_type(4)));
namespace pg8 {
#define PG8_LAS __attribute__((address_space(3)))
typedef unsigned short bf16_t;
typedef short bf16x8 __attribute__((ext_vector_type(8)));
typedef float f32x4 __attribute__((ext_vector_type(4)));
typedef unsigned u32x4 __attribute__((ext_vector_type(4)));
constexpr int BM = 256, BK = 64, HALF = 128, HTB = HALF * BK * 2  , STAGE_BYTES = 8 * HTB, NXCD = 8, WGM = 8;

__host__ __device__ __forceinline__ int lds_byte(int r, int c) { const int st = (r >> 4) * 2 + (c >> 5), rr = r & 15, cc = c & 31, ob = rr * 64 + cc * 2; return st * 1024 + (ob ^ (((ob >> 9) & 1) << 5)); }
__host__ __device__ __forceinline__ void stage_rc(int b, int& R, int& C) { const int st = b / 1024, sb = b % 1024, swz = sb ^ (((sb >> 9) & 1) << 5); R = (st >> 1) * 16 + swz / 64; C = (st & 1) * 32 + (swz % 64) / 2; }
__host__ __device__ __forceinline__ int perm32(int rho) { const int n = rho >> 4, i = rho & 15; return 8 * (i >> 2) + 4 * n + (i & 3); }

struct Unit { int pm, pn; };
struct Gemm { const bf16_t* A; const bf16_t* Bt; int M, N, K; int ovl; };

struct StaticOrder {
    int nM, nN, nwg, G, c;
    __host__ __device__ void init(int M, int N, int G_, int c_) { nM = M / BM; nN = N / BM; nwg = nM * nN; G = G_; c = c_; }
    __host__ __device__ bool next(int i, Unit& u) const {
        const long L = (long)i * G + c; if (L >= nwg) return false;
        int wgid = (int)L; { const int q = nwg / NXCD, r = nwg % NXCD, xcd = wgid % NXCD, off = wgid / NXCD; wgid = (xcd < r ? xcd * (q + 1) : r * (q + 1) + (xcd - r) * q) + off; }
        const int nig = WGM * nN, gid = wgid / nig, fm = gid * WGM, gsz = (nM - fm) < WGM ? (nM - fm) : WGM;
        u.pm = fm + ((wgid % nig) % gsz); u.pn = (wgid % nig) / gsz; return true;
    }
    __device__ __forceinline__ void a_ready(const Unit&) const {}
    __device__ __forceinline__ void done(const Unit&) const {}
};
struct CountedOrder : StaticOrder {
    const unsigned* ready; unsigned need; unsigned* tmo;
    __device__ __forceinline__ void a_ready(const Unit& u) const {
        if (TIDX < 64) {
            const unsigned long long t0 = __builtin_amdgcn_s_memrealtime(); unsigned polls = 0;
            while ((unsigned)__builtin_amdgcn_readfirstlane(__hip_atomic_load(ready + 64 * u.pm, __ATOMIC_RELAXED, __HIP_MEMORY_SCOPE_AGENT)) < need) {
                if ((++polls & 255u) == 0u && __builtin_amdgcn_readfirstlane(__hip_atomic_load(tmo, __ATOMIC_RELAXED, __HIP_MEMORY_SCOPE_AGENT)) != 0u) break;
                if (__builtin_amdgcn_s_memrealtime() - t0 > 2000000ull) {
                    if (TIDX == 0) { unsigned expect = 0u; __hip_atomic_compare_exchange_strong(tmo + 1, &expect, 0x600u | (unsigned)(u.pm & 0xff), __ATOMIC_RELAXED, __ATOMIC_RELAXED, __HIP_MEMORY_SCOPE_AGENT); __hip_atomic_store(tmo, 1u, __ATOMIC_RELAXED, __HIP_MEMORY_SCOPE_AGENT); }
                    break; }
                __builtin_amdgcn_s_sleep(2); }
            __builtin_amdgcn_fence(__ATOMIC_ACQUIRE, "agent");
            asm volatile("s_waitcnt vmcnt(0)" ::: "memory");
        }
#if !defined(BROKEN_HOOK_NO_BARRIER)
        asm volatile("" ::: "memory"); __builtin_amdgcn_s_barrier(); asm volatile("" ::: "memory");
#endif
    }
};

__device__ __forceinline__ unsigned cvt_pk_bf16(float lo, float hi) { unsigned r; asm volatile("v_cvt_pk_bf16_f32 %0, %1, %2" : "=v"(r) : "v"(lo), "v"(hi)); return r; }
typedef float f32x2 __attribute__((ext_vector_type(2)));
__device__ __forceinline__ f32x2 gelu_pk(f32x2 v) {
    const f32x2 av = __builtin_elementwise_abs(v), d = av * 0.2316418882f + 1.0f;
    f32x2 t; t.x = __builtin_amdgcn_rcpf(d.x); t.y = __builtin_amdgcn_rcpf(d.y);
    f32x2 q = t * 0.5307027145f + (-0.7265760135f); q = q * t + 0.7107068705f; q = q * t + (-0.142248368f); q = q * t + 0.127414796f; q = q * t;
    const f32x2 s = (v * v) * (-0.72134752044f);
    f32x2 e; e.x = __builtin_amdgcn_exp2f(s.x); e.y = __builtin_amdgcn_exp2f(s.y);
    const f32x2 m = v * (q * e), r = v - m;
    f32x2 o; o.x = v.x < 0.f ? m.x : r.x; o.y = v.y < 0.f ? m.y : r.y; return o;
}

struct EpiF32 {
    static constexpr bool PERM = false, AFTER_DRAIN = false;
    float* C; int ldc; const float* bias;
    __device__ __forceinline__ void operator()(const f32x4 (&acc)[2][2][4][2], const Unit& u, int wr, int wc, int fr, int fq) const {
        const int row0 = u.pm * BM + wr * 64 + fr, col0 = u.pn * BM + wc * 32 + 4 * fq;
        f32x4 bv[2][2];
#pragma unroll
        for (int bj = 0; bj < 2; ++bj)
#pragma unroll
            for (int n = 0; n < 2; ++n) bv[bj][n] = bias ? *(const f32x4*)(bias + col0 + bj * HALF + n * 16) : (f32x4){0.f, 0.f, 0.f, 0.f};
#pragma unroll
        for (int ai = 0; ai < 2; ++ai)
#pragma unroll
            for (int m = 0; m < 4; ++m) { float* rowp = C + (size_t)(row0 + ai * HALF + m * 16) * ldc + col0;
#pragma unroll
                for (int bj = 0; bj < 2; ++bj)
#pragma unroll
                    for (int n = 0; n < 2; ++n) *(f32x4*)(rowp + bj * HALF + n * 16) = acc[ai][bj][m][n] + bv[bj][n]; }
    }
};
template <int ACT  > struct EpiBf16 {
    static constexpr bool PERM = true, AFTER_DRAIN = false;
    bf16_t* O; int ldc; const float* bias; int split_cols; size_t split_stride;
    __device__ __forceinline__ void operator()(const f32x4 (&acc)[2][2][4][2], const Unit& u, int wr, int wc, int fr, int fq) const {
        const int row0 = u.pm * BM + wr * 64 + fr; int colt = u.pn * BM; bf16_t* base = O;
        if (split_cols) { const int t = colt / split_cols; base += (size_t)t * split_stride; colt -= t * split_cols; }
        const int col0 = colt + wc * 32 + 8 * fq, bcol0 = u.pn * BM + wc * 32 + 8 * fq;
        f32x4 bv[2][2];
#pragma unroll
        for (int bj = 0; bj < 2; ++bj)
#pragma unroll
            for (int n = 0; n < 2; ++n) bv[bj][n] = bias ? *(const f32x4*)(bias + bcol0 + bj * HALF + 4 * n) : (f32x4){0.f, 0.f, 0.f, 0.f};
#pragma unroll
        for (int ai = 0; ai < 2; ++ai)
#pragma unroll
            for (int m = 0; m < 4; ++m) { bf16_t* rowp = base + (size_t)(row0 + ai * HALF + m * 16) * ldc + col0;
#pragma unroll
                for (int bj = 0; bj < 2; ++bj) { f32x4 v0 = acc[ai][bj][m][0] + bv[bj][0], v1 = acc[ai][bj][m][1] + bv[bj][1];
                    if (ACT == 1) { f32x2 a = gelu_pk((f32x2){v0[0], v0[1]}), b = gelu_pk((f32x2){v0[2], v0[3]}), c = gelu_pk((f32x2){v1[0], v1[1]}), d = gelu_pk((f32x2){v1[2], v1[3]});
                        v0 = (f32x4){a.x, a.y, b.x, b.y}; v1 = (f32x4){c.x, c.y, d.x, d.y}; }
                    if (ACT == 2) {
#pragma unroll
                        for (int j = 0; j < 4; ++j) { v0[j] = 0.5f * v0[j] * (1.0f + erff(v0[j] * 0.70710678f)); v1[j] = 0.5f * v1[j] * (1.0f + erff(v1[j] * 0.70710678f)); } }
                    u32x4 w; w.x = cvt_pk_bf16(v0[0], v0[1]); w.y = cvt_pk_bf16(v0[2], v0[3]); w.z = cvt_pk_bf16(v1[0], v1[1]); w.w = cvt_pk_bf16(v1[2], v1[3]);
                    *(u32x4*)(rowp + bj * HALF) = w; } }
    }
};
template <class Epi, class Sched, bool STAMP = false>
__device__ __forceinline__ void gemm_phase(PG8_LAS unsigned char* lds, const Gemm g, const Sched& S, const Epi& E, unsigned long long* stamps) {
    const int tid = TIDX, wid = __builtin_amdgcn_readfirstlane(tid >> 6), lane = tid & 63, wr = wid >> 2, wc = wid & 3, fr = lane & 15, fq = lane >> 4;
    const int K = g.K, nt = K / BK;
    int ts_lo = 0, ts_hi = 0, nts = 0; const unsigned long long rt_entry = STAMP ? (unsigned long long)wall_clock64() : 0ull;
#define PG8_STAMP() do { if (STAMP && wid == 0 && nts < 64) { const unsigned long long _c = (unsigned long long)clock64(); \
        ts_lo = (lane == nts) ? (int)(unsigned)_c : ts_lo; ts_hi = (lane == nts) ? (int)(unsigned)(_c >> 32) : ts_hi; ++nts; } } while (0)
    PG8_STAMP();
    unsigned voffA[2], voffB[2];
#pragma unroll
    for (int i = 0; i < 2; ++i) { int R, C; stage_rc(tid * 16 + i * 8192, R, C); const int Rb = Epi::PERM ? ((R & ~31) + perm32(R & 31)) : R;
        const int Ra = g.ovl ? R - 2 * (R >> 6) : R; voffA[i] = (unsigned)(Ra * K + C) * 2u; voffB[i] = (unsigned)(Rb * K + C) * 2u; }
    const size_t kstep = (size_t)(BK * 2);
    const size_t hstep = (size_t)HALF * K * 2;
    const size_t tstep = 2 * hstep;
    const size_t hstepA = g.ovl ? (size_t)124 * K * 2 : hstep, tstepA = g.ovl ? (size_t)248 * K * 2 : tstep;
    const unsigned ldsw = (unsigned)wid * 1024u;
    const int aoff = lds_byte(wr * 64 + fr, fq * 8), boff = lds_byte(wc * 32 + fr, fq * 8);
#define PG8_SA(b, h) (((b) * 2 + (h)) * HTB)
#define PG8_SB(b, h) ((4 + (b) * 2 + (h)) * HTB)
#define PG8_STAGE(bufoff, gbase, voff) do { _Pragma("unroll") for (int _i = 0; _i < 2; ++_i) \
        __builtin_amdgcn_global_load_lds((const unsigned*)((const char*)(gbase) + (voff)[_i]), (PG8_LAS unsigned*)(lds + (bufoff) + ldsw + _i * 8192), 16, 0, 0); } while (0)
#define PG8_LDA(dst, b, h) do { _Pragma("unroll") for (int m = 0; m < 4; ++m) _Pragma("unroll") for (int k = 0; k < 2; ++k) dst[m][k] = *(const PG8_LAS bf16x8*)(lds + PG8_SA(b, h) + aoff + m * 2048 + k * 1024); } while (0)
#define PG8_LDB(dst, b, h) do { _Pragma("unroll") for (int n = 0; n < 2; ++n) _Pragma("unroll") for (int k = 0; k < 2; ++k) dst[n][k] = *(const PG8_LAS bf16x8*)(lds + PG8_SB(b, h) + boff + n * 2048 + k * 1024); } while (0)
#define PG8_MMA(ai, bj, At, Bt) do { __builtin_amdgcn_s_setprio(1); _Pragma("unroll") for (int m = 0; m < 4; ++m) _Pragma("unroll") for (int n = 0; n < 2; ++n) _Pragma("unroll") for (int k = 0; k < 2; ++k) \
        acc[ai][bj][m][n] = __builtin_amdgcn_mfma_f32_16x16x32_bf16(Bt[n][k], At[m][k], acc[ai][bj][m][n], 0, 0, 0); __builtin_amdgcn_s_setprio(0); } while (0)
#define PG8_WAIT_V(n) asm volatile("s_waitcnt vmcnt(" #n ")" ::: "memory")
#define PG8_WAIT_L(n) asm volatile("s_waitcnt lgkmcnt(" #n ")" ::: "memory")
#define PG8_BAR __builtin_amdgcn_s_barrier()
#define PG8_SCHED __builtin_amdgcn_sched_barrier(0)
    Unit cur, nxt; int ui = 0;
    if (!S.next(0, cur)) return;
    f32x4 acc[2][2][4][2];
#pragma unroll
    for (int a = 0; a < 2; ++a)
#pragma unroll
        for (int b = 0; b < 2; ++b)
#pragma unroll
            for (int m = 0; m < 4; ++m)
#pragma unroll
                for (int n = 0; n < 2; ++n) acc[a][b][m][n] = (f32x4){0.f, 0.f, 0.f, 0.f};
    bf16x8 At[4][2], B0[2][2], B1[2][2];
    const char* cA = (const char*)g.A + (size_t)cur.pm * tstepA; const char* cB = (const char*)g.Bt + (size_t)cur.pn * tstep;
    S.a_ready(cur);
    PG8_STAGE(PG8_SB(0, 0), cB, voffB); PG8_STAGE(PG8_SA(0, 0), cA, voffA); PG8_STAGE(PG8_SB(0, 1), cB + hstep, voffB); PG8_STAGE(PG8_SA(0, 1), cA + hstepA, voffA);
    if (wr == 1) PG8_BAR;
    PG8_WAIT_V(4); PG8_BAR;
    PG8_STAGE(PG8_SB(1, 0), cB + kstep, voffB); PG8_STAGE(PG8_SA(1, 0), cA + kstep, voffA); PG8_STAGE(PG8_SB(1, 1), cB + hstep + kstep, voffB);
    PG8_WAIT_V(6); PG8_BAR;
    PG8_STAMP();
    for (;;) {
        const bool has_next = S.next(ui + 1, nxt);
        const char* nA = has_next ? (const char*)g.A + (size_t)nxt.pm * tstepA : cA; const char* nB = has_next ? (const char*)g.Bt + (size_t)nxt.pn * tstep : cB;
        for (int t = 0; t < nt; t += 2) {
            const bool last = (t == nt - 2);
            const char* a1 = cA + (size_t)(t + 1) * kstep;
            const char* a2 = last ? nA : cA + (size_t)(t + 2) * kstep; const char* b2 = last ? nB : cB + (size_t)(t + 2) * kstep;
            const char* a3 = a2 + kstep; const char* b3 = b2 + kstep;
            if (last && has_next) S.a_ready(nxt);
            PG8_LDB(B0, 0, 0); PG8_SCHED; PG8_LDA(At, 0, 0); PG8_STAGE(PG8_SA(1, 1), a1 + hstepA, voffA);
            PG8_WAIT_L(8); PG8_BAR; PG8_WAIT_L(0); PG8_MMA(0, 0, At, B0); PG8_BAR; PG8_SCHED;
            PG8_LDB(B1, 0, 1); PG8_STAGE(PG8_SB(0, 0), b2, voffB);
            PG8_BAR; PG8_WAIT_L(0); PG8_MMA(0, 1, At, B1); PG8_BAR;
            PG8_LDA(At, 0, 1); PG8_STAGE(PG8_SA(0, 0), a2, voffA);
            PG8_BAR; PG8_WAIT_L(0); PG8_MMA(1, 0, At, B0); PG8_BAR; PG8_SCHED;
            PG8_STAGE(PG8_SB(0, 1), b2 + hstep, voffB);
            PG8_WAIT_V(6); PG8_BAR; PG8_MMA(1, 1, At, B1); PG8_BAR;
            PG8_LDB(B0, 1, 0); PG8_SCHED; PG8_LDA(At, 1, 0); PG8_STAGE(PG8_SA(0, 1), a2 + hstepA, voffA);
            PG8_WAIT_L(8); PG8_BAR; PG8_WAIT_L(0); PG8_MMA(0, 0, At, B0); PG8_BAR; PG8_SCHED;
            PG8_LDB(B1, 1, 1); PG8_STAGE(PG8_SB(1, 0), b3, voffB);
            PG8_BAR; PG8_WAIT_L(0); PG8_MMA(0, 1, At, B1); PG8_BAR;
            PG8_LDA(At, 1, 1); PG8_STAGE(PG8_SA(1, 0), a3, voffA);
            PG8_BAR; PG8_WAIT_L(0); PG8_MMA(1, 0, At, B0); PG8_BAR; PG8_SCHED;
            PG8_STAGE(PG8_SB(1, 1), b3 + hstep, voffB);
            PG8_WAIT_V(6); PG8_BAR; PG8_MMA(1, 1, At, B1); PG8_BAR;
        }
        PG8_STAMP();
        if constexpr (!Epi::AFTER_DRAIN) { E(acc, cur, wr, wc, fr, fq); S.done(cur); }
        PG8_STAMP();
        if (!has_next) break;
#pragma unroll
        for (int a = 0; a < 2; ++a)
#pragma unroll
            for (int b = 0; b < 2; ++b)
#pragma unroll
                for (int m = 0; m < 4; ++m)
#pragma unroll
                    for (int n = 0; n < 2; ++n) acc[a][b][m][n] = (f32x4){0.f, 0.f, 0.f, 0.f};
        cur = nxt; cA = nA; cB = nB; ++ui;
    }
    PG8_WAIT_V(0);
    if (wr == 0) PG8_BAR;
    PG8_BAR;
    if constexpr (Epi::AFTER_DRAIN) { E.fused(acc, cur, wr, wc, fr, fq, lds, wid, lane); S.done(cur); }
    PG8_STAMP();
    if (STAMP && wid == 0) { stamps[lane] = lane < nts ? (((unsigned long long)(unsigned)ts_hi << 32) | (unsigned)ts_lo) : 0ull;
        if (lane == 62) stamps[62] = rt_entry; if (lane == 63) stamps[63] = (unsigned long long)wall_clock64(); }
#undef PG8_STAMP
#undef PG8_SA
#undef PG8_SB
#undef PG8_STAGE
#undef PG8_LDA
#undef PG8_LDB
#undef PG8_MMA
#undef PG8_WAIT_V
#undef PG8_WAIT_L
#undef PG8_BAR
#undef PG8_SCHED
}
}
typedef unsigned short bf16_t;
constexpr int T_TOK = 32768, DM = 1024, D_IN = 4096, D_HY = 512, D_HG = 512, DFF = 4096, NLAYER = 4;
constexpr int L_BIG = 16384, L_SML = 4096;
constexpr int APAD = 256;
constexpr size_t MiB = 1024ull * 1024ull;
constexpr size_t OFF_W = 0;
constexpr size_t OFF_W_IN = OFF_W, OFF_W_OUT = OFF_W + 8 * MiB, OFF_W_UP = OFF_W + 10 * MiB, OFF_W_DN = OFF_W + 26 * MiB;
constexpr size_t OFF_ABUF = 34 * MiB;
constexpr size_t OFF_R1 = 99 * MiB;
constexpr size_t OFF_HYRAW = OFF_R1;
constexpr size_t OFF_HG = OFF_R1 + 96 * MiB;
constexpr size_t OFF_KT = OFF_R1;
constexpr size_t OFF_ACT = OFF_R1;
constexpr size_t OFF_R2 = 355 * MiB;
constexpr size_t OFF_X0T = OFF_R2, OFF_ZT = OFF_R2 + 32 * MiB;
constexpr size_t OFF_MIX = OFF_R2;
constexpr size_t OFF_UPART = OFF_R2;
constexpr size_t OFF_R6 = 419 * MiB;
constexpr size_t OFF_OBUF = OFF_R6;
constexpr size_t OFF_KS = OFF_R6;
constexpr size_t OFF_SMALL = 483 * MiB;
constexpr size_t OFF_BAR = OFF_SMALL + 4 * MiB;
constexpr size_t OFF_W4T = OFF_SMALL + 8 * MiB;
constexpr size_t WS_NEED = 492 * MiB;

struct P { const float* in[26]; float* out; unsigned char* ws; };
constexpr int PB_norm_mix_pre = 0;
constexpr int PB_norm_mix_post = 4096;
constexpr int PB_norm_ffn_pre = 8192;
constexpr int PB_norm_ffn_post = 12288;
constexpr int PB_hy_conv_w = 16384;
constexpr int PB_hy_conv_b = 34816;
constexpr int PB_f_w1 = 40960;
constexpr int PB_f_b1 = 49408;
constexpr int PB_f_w2 = 49664;
constexpr int PB_f_b2 = 66048;
constexpr int PB_f_w3 = 66304;
constexpr int PB_f_b3 = 82688;
constexpr int PB_f_w4 = 82944;
constexpr int PB_f_freq = 345088;
constexpr int PB_hy_skip = 345344;
constexpr int PB_hy_out_norm = 347392;
constexpr int PB_lb_table = 349440;
constexpr int PB_hg_out_norm = 353536;
constexpr int PB_ffn_conv_w = 355584;
constexpr int PB_ffn_conv_b = 453888;
constexpr int PB_TOTAL = 486656;
constexpr size_t OFF_PB = OFF_SMALL + 512 * 1024;
#define PRM(p, NAME) ((const float*)((p).ws + OFF_PB) + PB_##NAME)

__device__ __forceinline__ float bf2f(bf16_t b) { return __uint_as_float(((unsigned)b) << 16); }
__device__ __forceinline__ bf16_t f2bf(float f) { unsigned u = __float_as_uint(f); u += 0x7FFFu + ((u >> 16) & 1u); return (bf16_t)(u >> 16); }
__device__ __forceinline__ unsigned pack_bf2(float lo, float hi) { return (unsigned)f2bf(lo) | ((unsigned)f2bf(hi) << 16); }
__device__ __forceinline__ bool seq_start(int t) { return t < L_BIG ? (t == 0) : ((t & (L_SML - 1)) == 0); }
__device__ __forceinline__ bool seq_end(int t) { return (t + 1 == T_TOK) || seq_start(t + 1); }
__device__ __forceinline__ const float* x_src_row(const P& p, int l, int t) {
    if (l > 0) return p.out + (size_t)t * DM;
    return t < L_BIG ? p.in[0] + (size_t)t * DM : p.in[1] + (size_t)(t - L_BIG) * DM;
}
__device__ __forceinline__ float silu_f(float x) { return x / (1.0f + __expf(-x)); }
__device__ __forceinline__ float wave_sum(float v) {
#pragma unroll
    for (int o = 32; o >= 1; o >>= 1) v += __shfl_xor(v, o);
    return v;
}

struct EpiBf16Split {
    static constexpr bool PERM = true, AFTER_DRAIN = false, OVL = false;
    bf16_t* O0; int ldc0; bf16_t* O1; int ldc1; int csplit;
    __device__ __forceinline__ void operator()(const pg8::f32x4 (&acc)[2][2][4][2], const pg8::Unit& u, int wr, int wc, int fr, int fq) const {
        const int row0 = u.pm * pg8::BM + wr * 64 + fr; int colt = u.pn * pg8::BM; bf16_t* base = O0; int ldc = ldc0;
        if (colt >= csplit) { base = O1; ldc = ldc1; colt -= csplit; }
        const int col0 = colt + wc * 32 + 8 * fq;
#pragma unroll
        for (int ai = 0; ai < 2; ++ai)
#pragma unroll
            for (int m = 0; m < 4; ++m) { bf16_t* rowp = base + (size_t)(row0 + ai * pg8::HALF + m * 16) * ldc + col0;
#pragma unroll
                for (int bj = 0; bj < 2; ++bj) { const pg8::f32x4 v0 = acc[ai][bj][m][0], v1 = acc[ai][bj][m][1];
                    pg8::u32x4 w; w.x = pg8::cvt_pk_bf16(v0[0], v0[1]); w.y = pg8::cvt_pk_bf16(v0[2], v0[3]); w.z = pg8::cvt_pk_bf16(v1[0], v1[1]); w.w = pg8::cvt_pk_bf16(v1[2], v1[3]);
                    *(pg8::u32x4*)(rowp + bj * pg8::HALF) = w; } }
    }
};
__device__ __forceinline__ float dpp_ror1(float v) { return __int_as_float(__builtin_amdgcn_update_dpp(0, __float_as_int(v), 0x121, 0xF, 0xF, false)); }
__device__ __forceinline__ float dpp_ror15(float v) { return __int_as_float(__builtin_amdgcn_update_dpp(0, __float_as_int(v), 0x12F, 0xF, 0xF, false)); }
__device__ __forceinline__ float gelu_tanh_e(float x) { const float y = 1.5957691216057308f * (x + 0.044715f * x * x * x); return x * __builtin_amdgcn_rcpf(1.0f + __expf(-y)); }
struct EpiGeglu {
    static constexpr bool PERM = true, AFTER_DRAIN = false, OVL = true;
    bf16_t* act; const float* cw; const float* cb;
    __device__ __forceinline__ void operator()(const pg8::f32x4 (&acc)[2][2][4][2], const pg8::Unit& u, int wr, int wc, int fr, int fq) const {
        const int j0 = u.pn * 128 + wc * 32 + 8 * fq;
        unsigned mprev = 0, mnext = 0, mst = 0;
#pragma unroll
        for (int ai = 0; ai < 2; ++ai)
#pragma unroll
            for (int m = 0; m < 4; ++m) { const int q = 16 * m + fr, tok = u.pm * 248 + 124 * ai + 62 * wr + q - 1, b = ai * 4 + m;
                const bool st = q >= 1 && q <= 62 && tok < T_TOK;
                if (st) { mst |= 1u << b; if (!seq_start(tok)) mprev |= 1u << b; if (!seq_end(tok)) mnext |= 1u << b; } }
#pragma unroll
        for (int n = 0; n < 2; ++n) {
            const int jc = j0 + 4 * n;
            const pg8::f32x4 wa0 = *(const pg8::f32x4*)(cw + jc), wa1 = *(const pg8::f32x4*)(cw + 8192 + jc), wa2 = *(const pg8::f32x4*)(cw + 16384 + jc), ba = *(const pg8::f32x4*)(cb + jc);
            const pg8::f32x4 wb0 = *(const pg8::f32x4*)(cw + 4096 + jc), wb1 = *(const pg8::f32x4*)(cw + 8192 + 4096 + jc), wb2 = *(const pg8::f32x4*)(cw + 16384 + 4096 + jc), bb = *(const pg8::f32x4*)(cb + 4096 + jc);
#pragma unroll
            for (int ai = 0; ai < 2; ++ai) {
                pg8::f32x4 pa_prev, pb_prev, na_cur, nb_cur;
#pragma unroll
                for (int i = 0; i < 4; ++i) { na_cur[i] = dpp_ror15(acc[ai][0][0][n][i]); nb_cur[i] = dpp_ror15(acc[ai][1][0][n][i]); pa_prev[i] = 0.f; pb_prev[i] = 0.f; }
#pragma unroll
                for (int m = 0; m < 4; ++m) {
                    const int b = ai * 4 + m, q = 16 * m + fr, tok = u.pm * 248 + 124 * ai + 62 * wr + q - 1;
                    const bool hp = (mprev >> b) & 1u, hn = (mnext >> b) & 1u;
                    pg8::f32x4 pa_cur, pb_cur, na_next, nb_next;
#pragma unroll
                    for (int i = 0; i < 4; ++i) { pa_cur[i] = dpp_ror1(acc[ai][0][m][n][i]); pb_cur[i] = dpp_ror1(acc[ai][1][m][n][i]);
                        na_next[i] = m < 3 ? dpp_ror15(acc[ai][0][m < 3 ? m + 1 : 3][n][i]) : 0.f; nb_next[i] = m < 3 ? dpp_ror15(acc[ai][1][m < 3 ? m + 1 : 3][n][i]) : 0.f; }
                    const pg8::f32x4 xpa = (fr == 0) ? pa_prev : pa_cur, xna = (fr == 15) ? na_next : na_cur;
                    const pg8::f32x4 xpb = (fr == 0) ? pb_prev : pb_cur, xnb = (fr == 15) ? nb_next : nb_cur;
                    const pg8::f32x4 xa = acc[ai][0][m][n], xb = acc[ai][1][m][n];
                    float o[4];
#pragma unroll
                    for (int i = 0; i < 4; ++i) {
                        const float ya = (hp ? xpa[i] * wa0[i] : 0.f) + xa[i] * wa1[i] + (hn ? xna[i] * wa2[i] : 0.f) + ba[i];
                        const float yb = (hp ? xpb[i] * wb0[i] : 0.f) + xb[i] * wb1[i] + (hn ? xnb[i] * wb2[i] : 0.f) + bb[i];
                        o[i] = gelu_tanh_e(ya) * yb;
                    }
                    if ((mst >> b) & 1u) { uint2 w; w.x = pg8::cvt_pk_bf16(o[0], o[1]); w.y = pg8::cvt_pk_bf16(o[2], o[3]); *(uint2*)(act + (size_t)tok * DFF + jc) = w; }
                    pa_prev = pa_cur; pb_prev = pb_cur; na_cur = na_next; nb_cur = nb_next;
                }
            }
        }
    }
};
template <class Epi>
__device__ __forceinline__ void run_gemm(LAS unsigned char* lds, const bf16_t* A, const bf16_t* Bt, int M, int N, int K, const Epi& E) {
    pg8::Gemm g; g.A = A; g.Bt = Bt; g.M = M; g.N = N; g.K = K; g.ovl = Epi::OVL ? 1 : 0;
    int gx = (int)gridDim.x, bx = (int)blockIdx.x; asm volatile("" : "+s"(gx), "+s"(bx));
    pg8::StaticOrder S; S.init(M, N, gx, bx);
    pg8::gemm_phase<Epi, pg8::StaticOrder, false>((PG8_LAS unsigned char*)lds, g, S, E, nullptr);
}

#define HD_INLINE __device__ __forceinline__
#define DEV_FN __device__ __forceinline__
#define LDS_F2 LAS cf2*
#define NTHR 512
#define PADI(i) ((i) + ((i) >> 5))
#define FOR_TID for (int tid = (int)TIDX, once_ = 1; once_; once_ = 0)
#define SYNC __syncthreads()
#define BREV32(x) __brev(x)
#define CIS_REV(fr, c, s) do { const float f_ = (fr); c = __builtin_amdgcn_cosf(f_); s = __builtin_amdgcn_sinf(f_); } while (0)
HD_INLINE unsigned rev4(unsigned k, int S) {
    unsigned v = BREV32(k) >> (32 - 2 * S);
    return ((v & 0xAAAAAAAAu) >> 1) | ((v & 0x55555555u) << 1);
}
HD_INLINE cf2 mkf2(float a, float b) { cf2 r; r.x = a; r.y = b; return r; }
HD_INLINE cf2 cmul(cf2 a, cf2 b) { return mkf2(a.x * b.x - a.y * b.y, a.x * b.y + a.y * b.x); }
HD_INLINE cf2 cmulc(cf2 a, cf2 b) { return mkf2(a.x * b.x + a.y * b.y, a.y * b.x - a.x * b.y); }

HD_INLINE void bf4_fwd(cf2& a0, cf2& a1, cf2& a2, cf2& a3) {
    const cf2 t0 = a0 + a2, t1 = a0 - a2, t2 = a1 + a3, d = a1 - a3; const cf2 t3 = mkf2(d.y, -d.x);
    a0 = t0 + t2; a1 = t1 + t3; a2 = t0 - t2; a3 = t1 - t3;
}
HD_INLINE void bf4_inv(cf2& b0, cf2& b1, cf2& b2, cf2& b3) {
    const cf2 t0 = b0 + b2, t1 = b0 - b2, t2 = b1 + b3, d = b1 - b3; const cf2 t3 = mkf2(-d.y, d.x);
    b0 = t0 + t2; b1 = t1 + t3; b2 = t0 - t2; b3 = t1 - t3;
}
#define W16C(k) ((k) == 0 ? 1.0f : (k) == 1 ? 0.9238795325112867f : (k) == 2 ? 0.7071067811865476f : (k) == 3 ? 0.3826834323650898f : (k) == 4 ? 0.0f : (k) == 6 ? -0.7071067811865476f :   -0.9238795325112867f)
#define W16S(k) ((k) == 0 ? 0.0f : (k) == 1 ? 0.3826834323650898f : (k) == 2 ? 0.7071067811865476f : (k) == 3 ? 0.9238795325112867f : (k) == 4 ? 1.0f : (k) == 6 ? 0.7071067811865476f :   -0.3826834323650898f)
template <int S, int NSEQ>
DEV_FN void fft_fwd2(LDS_F2 X) {
    constexpr int M = 1 << (2 * S), MP = M + (M >> 5), NG = NSEQ * (M >> 4);
#pragma unroll 1
    for (int pr = 0; pr < S / 2; ++pr) {
        const int s = 2 * pr, n = M >> (2 * s), q = n >> 2, q2 = q >> 2;
        const float invn = 1.0f / (float)n;
        FOR_TID {
#pragma unroll 2
            for (int gi = tid; gi < NG; gi += NTHR) {
                const int seq = gi / (M >> 4), g = gi - seq * (M >> 4), j2 = g & (q2 - 1), base = ((g - j2) << 4) + j2;
                LDS_F2 Xs = X + seq * MP;
                cf2 a[4][4];
#pragma unroll
                for (int r = 0; r < 4; ++r)
#pragma unroll
                    for (int r2 = 0; r2 < 4; ++r2) a[r][r2] = Xs[PADI(base + r * q + r2 * q2)];
                float c1, s1; CIS_REV((float)j2 * invn, c1, s1);
                const cf2 t1 = mkf2(c1, -s1), t2 = cmul(t1, t1), t3 = cmul(t2, t1), t4 = cmul(t2, t2), t8 = cmul(t4, t4), t12 = cmul(t8, t4);
#pragma unroll
                for (int r2 = 0; r2 < 4; ++r2) {
                    bf4_fwd(a[0][r2], a[1][r2], a[2][r2], a[3][r2]);
                    a[1][r2] = cmul(a[1][r2], cmul(t1, mkf2(W16C(r2), -W16S(r2))));
                    a[2][r2] = cmul(a[2][r2], cmul(t2, mkf2(W16C(2 * r2), -W16S(2 * r2))));
                    a[3][r2] = cmul(a[3][r2], cmul(t3, mkf2(W16C(3 * r2), -W16S(3 * r2))));
                }
#pragma unroll
                for (int r = 0; r < 4; ++r) {
                    bf4_fwd(a[r][0], a[r][1], a[r][2], a[r][3]);
                    a[r][1] = cmul(a[r][1], t4); a[r][2] = cmul(a[r][2], t8); a[r][3] = cmul(a[r][3], t12);
                }
#pragma unroll
                for (int r = 0; r < 4; ++r)
#pragma unroll
                    for (int r2 = 0; r2 < 4; ++r2) Xs[PADI(base + r * q + r2 * q2)] = a[r][r2];
            }
        }
        SYNC;
    }
    if (S & 1) {
        FOR_TID {
#pragma unroll 4
            for (int gi = tid; gi < NSEQ * (M >> 2); gi += NTHR) {
                const int seq = gi / (M >> 2), b = gi - seq * (M >> 2);
                LDS_F2 Xs = X + seq * MP;
                cf2 a0 = Xs[PADI(4 * b)], a1 = Xs[PADI(4 * b + 1)], a2 = Xs[PADI(4 * b + 2)], a3 = Xs[PADI(4 * b + 3)];
                bf4_fwd(a0, a1, a2, a3);
                Xs[PADI(4 * b)] = a0; Xs[PADI(4 * b + 1)] = a1; Xs[PADI(4 * b + 2)] = a2; Xs[PADI(4 * b + 3)] = a3;
            }
        }
        SYNC;
    }
}
template <int S, int NSEQ>
DEV_FN void fft_inv2(LDS_F2 X) {
    constexpr int M = 1 << (2 * S), MP = M + (M >> 5), NG = NSEQ * (M >> 4);
    if (S & 1) {
        FOR_TID {
#pragma unroll 4
            for (int gi = tid; gi < NSEQ * (M >> 2); gi += NTHR) {
                const int seq = gi / (M >> 2), b = gi - seq * (M >> 2);
                LDS_F2 Xs = X + seq * MP;
                cf2 a0 = Xs[PADI(4 * b)], a1 = Xs[PADI(4 * b + 1)], a2 = Xs[PADI(4 * b + 2)], a3 = Xs[PADI(4 * b + 3)];
                bf4_inv(a0, a1, a2, a3);
                Xs[PADI(4 * b)] = a0; Xs[PADI(4 * b + 1)] = a1; Xs[PADI(4 * b + 2)] = a2; Xs[PADI(4 * b + 3)] = a3;
            }
        }
        SYNC;
    }
#pragma unroll 1
    for (int pr = S / 2 - 1; pr >= 0; --pr) {
        const int s = 2 * pr, n = M >> (2 * s), q = n >> 2, q2 = q >> 2;
        const float invn = 1.0f / (float)n;
        FOR_TID {
#pragma unroll 2
            for (int gi = tid; gi < NG; gi += NTHR) {
                const int seq = gi / (M >> 4), g = gi - seq * (M >> 4), j2 = g & (q2 - 1), base = ((g - j2) << 4) + j2;
                LDS_F2 Xs = X + seq * MP;
                cf2 a[4][4];
#pragma unroll
                for (int r = 0; r < 4; ++r)
#pragma unroll
                    for (int r2 = 0; r2 < 4; ++r2) a[r][r2] = Xs[PADI(base + r * q + r2 * q2)];
                float c1, s1; CIS_REV((float)j2 * invn, c1, s1);
                const cf2 t1 = mkf2(c1, s1), t2 = cmul(t1, t1), t3 = cmul(t2, t1), t4 = cmul(t2, t2), t8 = cmul(t4, t4), t12 = cmul(t8, t4);
#pragma unroll
                for (int r = 0; r < 4; ++r) {
                    a[r][1] = cmul(a[r][1], t4); a[r][2] = cmul(a[r][2], t8); a[r][3] = cmul(a[r][3], t12);
                    bf4_inv(a[r][0], a[r][1], a[r][2], a[r][3]);
                }
#pragma unroll
                for (int r2 = 0; r2 < 4; ++r2) {
                    a[1][r2] = cmul(a[1][r2], cmul(t1, mkf2(W16C(r2), W16S(r2))));
                    a[2][r2] = cmul(a[2][r2], cmul(t2, mkf2(W16C(2 * r2), W16S(2 * r2))));
                    a[3][r2] = cmul(a[3][r2], cmul(t3, mkf2(W16C(3 * r2), W16S(3 * r2))));
                    bf4_inv(a[0][r2], a[1][r2], a[2][r2], a[3][r2]);
                }
#pragma unroll
                for (int r = 0; r < 4; ++r)
#pragma unroll
                    for (int r2 = 0; r2 < 4; ++r2) Xs[PADI(base + r * q + r2 * q2)] = a[r][r2];
            }
        }
        SYNC;
    }
}
DEV_FN void spec_store(LDS_F2 X, int S, cf2* Kp) {
    const int M = 1 << (2 * S);
    FOR_TID {
        for (int pp = tid; pp < (M >> 1); pp += NTHR) {
            const int p = ((pp >> 1) << 2) + (pp & 1);
            if (p == 0) {
                const cf2 c0 = X[PADI(0)]; Kp[0] = mkf2(c0.x + c0.y, c0.x - c0.y);
                const cf2 ch = X[PADI(2)]; Kp[2] = mkf2(ch.x, -ch.y);
            } else {
                const unsigned k = rev4((unsigned)p, S), pm = rev4((unsigned)(M - (int)k), S);
                const cf2 ck = X[PADI(p)], cm = X[PADI((int)pm)];
                const cf2 P = mkf2(0.5f * (ck.x + cm.x), 0.5f * (ck.y - cm.y));
                const cf2 O = mkf2(0.5f * (ck.y + cm.y), -0.5f * (ck.x - cm.x));
                float c, s; CIS_REV((float)k / (float)(2 * M), c, s);
                const cf2 Q = cmul(O, mkf2(c, -s));
                Kp[p] = mkf2(P.x + Q.x, P.y + Q.y);
                Kp[pm] = mkf2(P.x - Q.x, -(P.y - Q.y));
            }
        }
    }
    SYNC;
}
DEV_FN void spec_mul(LDS_F2 X0, int S, const cf2* Kp, int nseq = 1) {
    const int M = 1 << (2 * S);
    FOR_TID {
        for (int pq = tid; pq < nseq * (M >> 1); pq += NTHR) {
            const int sq_ = pq / (M >> 1), pp = pq - sq_ * (M >> 1);
            LDS_F2 X = X0 + sq_ * (M + (M >> 5));
            const int p = ((pp >> 1) << 2) + (pp & 1);
            if (p == 0) {
                const cf2 c0 = X[PADI(0)], k0 = Kp[0];
                const float y0 = (c0.x + c0.y) * k0.x, ym = (c0.x - c0.y) * k0.y;
                X[PADI(0)] = mkf2(0.5f * (y0 + ym), 0.5f * (y0 - ym));
                const cf2 ch = X[PADI(2)], kh = Kp[2];
                const cf2 yh = cmul(mkf2(ch.x, -ch.y), kh);
                X[PADI(2)] = mkf2(yh.x, -yh.y);
            } else {
                const unsigned k = rev4((unsigned)p, S), pm = rev4((unsigned)(M - (int)k), S);
                const cf2 ck = X[PADI(p)], cm = X[PADI((int)pm)];
                const cf2 P = mkf2(0.5f * (ck.x + cm.x), 0.5f * (ck.y - cm.y));
                const cf2 O = mkf2(0.5f * (ck.y + cm.y), -0.5f * (ck.x - cm.x));
                float c, s; CIS_REV((float)k / (float)(2 * M), c, s);
                const cf2 Wk = mkf2(c, -s);
                const cf2 Q = cmul(O, Wk);
                const cf2 xk = mkf2(P.x + Q.x, P.y + Q.y), xm = mkf2(P.x - Q.x, -(P.y - Q.y));
                const cf2 yk = cmul(xk, Kp[p]), ym = cmul(xm, Kp[pm]);
                const cf2 Ye = mkf2(0.5f * (yk.x + ym.x), 0.5f * (yk.y - ym.y));
                const cf2 Yd = mkf2(0.5f * (yk.x - ym.x), 0.5f * (yk.y + ym.y));
                const cf2 Yo = cmulc(Yd, Wk);
                X[PADI(p)] = mkf2(Ye.x - Yo.y, Ye.y + Yo.x);
                X[PADI((int)pm)] = mkf2(Ye.x + Yo.y, -Ye.y + Yo.x);
            }
        }
    }
    SYNC;
}
__device__ void ph_setup(const P& p) {
    const int gid = blockIdx.x * 512 + TIDX;
    if (gid < 2 * D_HG) {
        const int dir = gid / D_HG, c = gid % D_HG;
        float v[NLAYER], mx = -1e30f;
#pragma unroll
        for (int l = 0; l < NLAYER; ++l) { v[l] = p.in[19][(size_t)(dir * NLAYER + l) * D_HG + c]; mx = fmaxf(mx, v[l]); }
        float s = 0.f;
#pragma unroll
        for (int l = 0; l < NLAYER; ++l) { v[l] = expf(v[l] - mx); s += v[l]; }
        float* lbs = (float*)(p.ws + OFF_SMALL);
        float cum = 0.f;
#pragma unroll
        for (int l = 0; l < NLAYER; ++l) { if (l > 0) cum += v[l] / s; lbs[(size_t)(dir * NLAYER + l) * D_HG + c] = cum; }
    }
}
__device__ void ph_copy_params(const P& p) {
    float* pb = (float*)(p.ws + OFF_PB);
    const int g = blockIdx.x * 512 + TIDX, gs = gridDim.x * 512;
    for (int k = g; k < 4096; k += gs) pb[0 + k] = p.in[2][k];
    for (int k = g; k < 4096; k += gs) pb[4096 + k] = p.in[3][k];
    for (int k = g; k < 4096; k += gs) pb[8192 + k] = p.in[4][k];
    for (int k = g; k < 4096; k += gs) pb[12288 + k] = p.in[5][k];
    for (int k = g; k < 18432; k += gs) pb[16384 + k] = p.in[7][k];
    for (int k = g; k < 6144; k += gs) pb[34816 + k] = p.in[8][k];
    for (int k = g; k < 8448; k += gs) pb[40960 + k] = p.in[9][k];
    for (int k = g; k < 256; k += gs) pb[49408 + k] = p.in[10][k];
    for (int k = g; k < 16384; k += gs) pb[49664 + k] = p.in[11][k];
    for (int k = g; k < 256; k += gs) pb[66048 + k] = p.in[12][k];
    for (int k = g; k < 16384; k += gs) pb[66304 + k] = p.in[13][k];
    for (int k = g; k < 256; k += gs) pb[82688 + k] = p.in[14][k];
    for (int k = g; k < 262144; k += gs) pb[82944 + k] = p.in[15][k];
    for (int k = g; k < 256; k += gs) pb[345088 + k] = p.in[16][k];
    for (int k = g; k < 2048; k += gs) pb[345344 + k] = p.in[17][k];
    for (int k = g; k < 2048; k += gs) pb[347392 + k] = p.in[18][k];
    for (int k = g; k < 4096; k += gs) pb[349440 + k] = p.in[19][k];
    for (int k = g; k < 2048; k += gs) pb[353536 + k] = p.in[20][k];
    for (int k = g; k < 98304; k += gs) pb[355584 + k] = p.in[23][k];
    for (int k = g; k < 32768; k += gs) pb[453888 + k] = p.in[24][k];
}
__device__ void convert_one(const float* src, bf16_t* dst, int K, int N, LAS float* tile  , bool geglu_perm = false) {
    const int tiles_n = N / 64, ntiles = (K / 64) * tiles_n, tid = TIDX;
    for (int it = blockIdx.x; it < ntiles; it += gridDim.x) {
        const int k0 = (it / tiles_n) * 64, n0 = (it % tiles_n) * 64;
#pragma unroll
        for (int i = 0; i < 8; ++i) { const int r = (tid >> 6) + 8 * i, c = tid & 63; tile[r * 65 + c] = src[(size_t)(k0 + r) * N + n0 + c]; }
        __syncthreads();
#pragma unroll
        for (int i = 0; i < 8; ++i) { const int n = (tid >> 6) + 8 * i, k = tid & 63; int nr = n0 + n;
            if (geglu_perm) nr = nr < DFF ? (nr >> 7) * 256 + (nr & 127) : ((nr - DFF) >> 7) * 256 + 128 + ((nr - DFF) & 127);
            dst[(size_t)nr * K + k0 + k] = f2bf(tile[k * 65 + n]); }
        __syncthreads();
    }
}
__device__ void ph_convert_w(const P& p, int l, LAS unsigned char* lds) {
    LAS float* tile = (LAS float*)lds;
    convert_one(p.in[6] + (size_t)l * DM * D_IN, (bf16_t*)(p.ws + OFF_W_IN), DM, D_IN, tile);
    convert_one(p.in[21] + (size_t)l * DM * DM, (bf16_t*)(p.ws + OFF_W_OUT), DM, DM, tile);
    convert_one(p.in[22] + (size_t)l * DM * 2 * DFF, (bf16_t*)(p.ws + OFF_W_UP), DM, 2 * DFF, tile, true);
    convert_one(p.in[25] + (size_t)l * DFF * DM, (bf16_t*)(p.ws + OFF_W_DN), DFF, DM, tile);
    { const float* w4 = p.in[15] + (size_t)l * 64 * 1024; bf16_t* w4t = (bf16_t*)(p.ws + OFF_W4T);
      for (int idx = blockIdx.x * 512 + TIDX; idx < 65536; idx += gridDim.x * 512) { const int o = idx >> 6, f = idx & 63; w4t[idx] = f2bf(w4[f * 1024 + o]); } }
}
__device__ __forceinline__ bf16_t* abuf_row(const P& p, int t) { return (bf16_t*)(p.ws + OFF_ABUF) + (size_t)(t + APAD) * DM; }
__device__ void ph_rmsnorm_in(const P& p, int l) {
    const int lane = TIDX & 63, wv = TIDX >> 6;
    const float* gain = p.in[2] + (size_t)l * DM;
    for (int t = blockIdx.x * 8 + wv; t < T_TOK; t += gridDim.x * 8) {
        const float* xr = x_src_row(p, l, t);
        float4 v[4]; float ss = 0.f;
#pragma unroll
        for (int i = 0; i < 4; ++i) { v[i] = *(const float4*)(xr + lane * 4 + 256 * i); ss += v[i].x * v[i].x + v[i].y * v[i].y + v[i].z * v[i].z + v[i].w * v[i].w; }
        ss = wave_sum(ss);
        const float r = rsqrtf(ss * (1.0f / DM) + 1e-6f);
        bf16_t* hr = abuf_row(p, t);
#pragma unroll
        for (int i = 0; i < 4; ++i) { const float4 g = *(const float4*)(gain + lane * 4 + 256 * i);
            uint2 w; w.x = pack_bf2(v[i].x * r * g.x, v[i].y * r * g.y); w.y = pack_bf2(v[i].z * r * g.z, v[i].w * r * g.w);
            *(uint2*)(hr + lane * 4 + 256 * i) = w; }
    }
}
constexpr int NRR = 4;
__device__ void ph_norm_resid(const P& p, int l, int which) {
    const int lane = TIDX & 63, wv = TIDX >> 6;
    const float* gpost = (which == 0 ? PRM(p, norm_mix_post) : PRM(p, norm_ffn_post)) + (size_t)l * DM;
    const bool has_next = (which == 0) || (l + 1 < NLAYER);
    const float* gnext = which == 0 ? PRM(p, norm_ffn_pre) + (size_t)l * DM : PRM(p, norm_mix_pre) + (size_t)(has_next ? l + 1 : l) * DM;
    const bf16_t* Y = (const bf16_t*)(p.ws + OFF_MIX);
    const int lx = which == 0 ? l : 1;
    nf4 gp[4], gn[4];
#pragma unroll
    for (int i = 0; i < 4; ++i) { gp[i] = *(const nf4*)(gpost + lane * 4 + 256 * i); gn[i] = *(const nf4*)(gnext + lane * 4 + 256 * i); }
    for (int t0 = (blockIdx.x * 8 + wv) * NRR; t0 < T_TOK; t0 += gridDim.x * 8 * NRR) {
        nf4 x[NRR][4]; nu2 yw[NRR][4];
#pragma unroll
        for (int rr = 0; rr < NRR; ++rr) { const float* xr = x_src_row(p, lx, t0 + rr); const bf16_t* yr = Y + (size_t)(t0 + rr) * DM;
#pragma unroll
            for (int i = 0; i < 4; ++i) { x[rr][i] = *(const nf4*)(xr + lane * 4 + 256 * i); yw[rr][i] = *(const nu2*)(yr + lane * 4 + 256 * i); } }
#pragma unroll
        for (int rr = 0; rr < NRR; ++rr) {
            const int t = t0 + rr;
            nf4 y[4]; float ss = 0.f;
#pragma unroll
            for (int i = 0; i < 4; ++i) { const nu2 w = yw[rr][i];
                y[i].x = __uint_as_float(w.x << 16); y[i].y = __uint_as_float(w.x & 0xffff0000u); y[i].z = __uint_as_float(w.y << 16); y[i].w = __uint_as_float(w.y & 0xffff0000u);
                ss += y[i].x * y[i].x + y[i].y * y[i].y + y[i].z * y[i].z + y[i].w * y[i].w; }
            ss = wave_sum(ss);
            const float r = rsqrtf(ss * (1.0f / DM) + 1e-6f);
            float s2 = 0.f;
#pragma unroll
            for (int i = 0; i < 4; ++i) { nf4 xv = x[rr][i];
                xv.x += y[i].x * r * gp[i].x; xv.y += y[i].y * r * gp[i].y; xv.z += y[i].z * r * gp[i].z; xv.w += y[i].w * r * gp[i].w;
                s2 += xv.x * xv.x + xv.y * xv.y + xv.z * xv.z + xv.w * xv.w;
                x[rr][i] = xv;
                *(nf4*)(p.out + (size_t)t * DM + lane * 4 + 256 * i) = xv; }
            if (has_next) {
                s2 = wave_sum(s2);
                const float r2 = rsqrtf(s2 * (1.0f / DM) + 1e-6f);
                bf16_t* hr = abuf_row(p, t);
#pragma unroll
                for (int i = 0; i < 4; ++i) { const nf4 xv = x[rr][i];
                    nu2 w; w.x = pack_bf2(xv.x * r2 * gn[i].x, xv.y * r2 * gn[i].y); w.y = pack_bf2(xv.z * r2 * gn[i].z, xv.w * r2 * gn[i].w);
                    *(nu2*)(hr + lane * 4 + 256 * i) = w; }
            }
        }
    }
}
__device__ void ph_filter(const P& p, int l, LAS unsigned char* lds) {
    LAS float* feats = (LAS float*)lds;
    LAS float* ha = feats + 16 * 36;
    LAS float* hb = ha + 16 * 64;
    LAS float* w1s = hb + 16 * 64;
    LAS float* w2s = w1s + 33 * 64;
    LAS float* w3s = w2s + 64 * 64;
    LAS bf16_t* h3b = (LAS bf16_t*)(w3s + 64 * 64);
    const int tid = TIDX;
    const float* w1 = PRM(p, f_w1) + (size_t)l * 33 * 64; const float* b1 = PRM(p, f_b1) + (size_t)l * 64;
    const float* w2 = PRM(p, f_w2) + (size_t)l * 64 * 64; const float* b2 = PRM(p, f_b2) + (size_t)l * 64;
    const float* w3 = PRM(p, f_w3) + (size_t)l * 64 * 64; const float* b3 = PRM(p, f_b3) + (size_t)l * 64;
    const float* w4 = PRM(p, f_w4) + (size_t)l * 64 * 1024; const float* fq = PRM(p, f_freq) + (size_t)l * 64;
    float* kt = (float*)(p.ws + OFF_KT);
    for (int i = tid; i < 33 * 64; i += 512) w1s[i] = w1[i];
    for (int i = tid; i < 64 * 64; i += 512) { w2s[i] = w2[i]; w3s[i] = w3[i]; }
    const int j = tid & 63;
    const float fqj = fq[j], b1j = b1[j], b2j = b2[j], b3j = b3[j];
    pg8::bf16x8 bfrag[8][2];
    { const bf16_t* w4t = (const bf16_t*)(p.ws + OFF_W4T); const int lane = tid & 63, w = tid >> 6;
#pragma unroll
      for (int nt = 0; nt < 8; ++nt)
#pragma unroll
          for (int ks = 0; ks < 2; ++ks) bfrag[nt][ks] = *(const pg8::bf16x8*)(w4t + (size_t)(128 * w + 16 * nt + (lane & 15)) * 64 + 32 * ks + 8 * (lane >> 4)); }
    __syncthreads();
    const int nitems = (L_BIG + L_SML) / 16;
    for (int it = blockIdx.x; it < nitems; it += gridDim.x) {
        const bool big = it < L_BIG / 16; const int L = big ? L_BIG : L_SML; const int pos0 = (big ? it : it - L_BIG / 16) * 16;
        float* ktc = kt + (big ? 0 : (size_t)512 * 2 * L_BIG);
        for (int idx = tid; idx < 16 * 33; idx += 512) {
            const int pp = idx / 33, f = idx % 33; const int pos = pos0 + pp;
            const float tt = (float)pos / (float)(L - 1), ang = (6.283185307179586f / (float)L) * (float)pos;
            float v;
            if (f == 0) v = tt;
            else { const int bi = (f - 1) & 15; const float band = 1e-4f + (float)bi * ((15.0f - 1e-4f) / 15.0f); v = f <= 16 ? cosf(band * ang) : -sinf(band * ang); }
            feats[pp * 36 + f] = v;
        }
        __syncthreads();
#pragma unroll
        for (int h2 = 0; h2 < 2; ++h2) { const int pp = (tid >> 6) + 8 * h2; float a = b1j;
            for (int f = 0; f < 33; ++f) a += feats[pp * 36 + f] * w1s[f * 64 + j];
            ha[pp * 64 + j] = __sinf(fqj * a); }
        __syncthreads();
#pragma unroll
        for (int h2 = 0; h2 < 2; ++h2) { const int pp = (tid >> 6) + 8 * h2; float a = b2j;
#pragma unroll 4
            for (int f4 = 0; f4 < 16; ++f4) { const nf4 hv = *(const LAS nf4*)(ha + pp * 64 + 4 * f4);
                a += hv.x * w2s[(4 * f4) * 64 + j] + hv.y * w2s[(4 * f4 + 1) * 64 + j] + hv.z * w2s[(4 * f4 + 2) * 64 + j] + hv.w * w2s[(4 * f4 + 3) * 64 + j]; }
            hb[pp * 64 + j] = __sinf(fqj * a); }
        __syncthreads();
#pragma unroll
        for (int h2 = 0; h2 < 2; ++h2) { const int pp = (tid >> 6) + 8 * h2; float a = b3j;
#pragma unroll 4
            for (int f4 = 0; f4 < 16; ++f4) { const nf4 hv = *(const LAS nf4*)(hb + pp * 64 + 4 * f4);
                a += hv.x * w3s[(4 * f4) * 64 + j] + hv.y * w3s[(4 * f4 + 1) * 64 + j] + hv.z * w3s[(4 * f4 + 2) * 64 + j] + hv.w * w3s[(4 * f4 + 3) * 64 + j]; }
            h3b[pp * 72 + j] = f2bf(__sinf(fqj * a)); }
        __syncthreads();
        {
            const int lane = tid & 63, w = tid >> 6, r16 = lane & 15, kg = lane >> 4;
            pg8::f32x4 acc[8];
#pragma unroll
            for (int nt = 0; nt < 8; ++nt) acc[nt] = (pg8::f32x4){0.f, 0.f, 0.f, 0.f};
            pg8::bf16x8 af[2];
#pragma unroll
            for (int ks = 0; ks < 2; ++ks) af[ks] = *(const LAS pg8::bf16x8*)(h3b + r16 * 72 + 32 * ks + 8 * kg);
#pragma unroll
            for (int nt = 0; nt < 8; ++nt)
#pragma unroll
                for (int ks = 0; ks < 2; ++ks) acc[nt] = __builtin_amdgcn_mfma_f32_16x16x32_bf16(af[ks], bfrag[nt][ks], acc[nt], 0, 0, 0);
            const float invl = 1.0f / (float)(L - 1);
            const float dstep = (15.350567286626972f - 3.0701134573253945f) / 511.0f;
            float tt[4];
#pragma unroll
            for (int i = 0; i < 4; ++i) tt[i] = (float)(pos0 + 4 * kg + i) * invl;
#pragma unroll
            for (int nt = 0; nt < 8; ++nt) { const int o = 128 * w + 16 * nt + r16, dir = o >> 9, c = o & 511;
                const float dl = 3.0701134573253945f + (float)c * dstep;
                nf4 v;
#pragma unroll
                for (int i = 0; i < 4; ++i) v[i] = acc[nt][i] * __expf(-tt[i] * dl);
                *(nf4*)(ktc + (size_t)(c * 2 + dir) * L + pos0 + 4 * kg) = v; }
        }
        __syncthreads();
    }
}
__device__ void ph_hy_prep(const P& p, int l, LAS unsigned char* lds) {
    constexpr int RS = 3 * 128 + 8;
    LAS bf16_t* raw = (LAS bf16_t*)lds;
    LAS bf16_t* ox = (LAS bf16_t*)(lds + 52224);
    LAS bf16_t* oz = ox + 128 * 72;
    const bf16_t* hy = (const bf16_t*)(p.ws + OFF_HYRAW);
    bf16_t* x0t = (bf16_t*)(p.ws + OFF_X0T); bf16_t* zt = (bf16_t*)(p.ws + OFF_ZT);
    const float* cw = PRM(p, hy_conv_w) + (size_t)l * 3 * 1536; const float* cb = PRM(p, hy_conv_b) + (size_t)l * 1536;
    const int tid = TIDX, nitems = (T_TOK / 64) * 4;
    for (int it = blockIdx.x; it < nitems; it += gridDim.x) {
        const int t0 = (it >> 2) * 64, c0 = (it & 3) * 128;
        for (int idx = tid; idx < 66 * 48; idx += 512) {
            const int row = idx / 48, rem = idx - row * 48, a = rem >> 4, pc = rem & 15;
            int t = t0 - 1 + row; t = t < 0 ? 0 : (t >= T_TOK ? T_TOK - 1 : t);
            *(LAS nu4*)(raw + row * RS + a * 128 + pc * 8) = *(const nu4*)(hy + (size_t)t * 1536 + a * 512 + c0 + pc * 8);
        }
        __syncthreads();
        {
            const int c = tid & 127, tq = tid >> 7;
            float wv[3][3], bv[3];
#pragma unroll
            for (int a = 0; a < 3; ++a) { bv[a] = cb[a * 512 + c0 + c];
#pragma unroll
                for (int k = 0; k < 3; ++k) wv[a][k] = cw[k * 1536 + a * 512 + c0 + c]; }
            float xm[3], xc[3];
#pragma unroll
            for (int a = 0; a < 3; ++a) { xm[a] = bf2f(raw[(tq * 16) * RS + a * 128 + c]); xc[a] = bf2f(raw[(tq * 16 + 1) * RS + a * 128 + c]); }
            unsigned px = 0, pz = 0;
#pragma unroll
            for (int j = 0; j < 16; ++j) {
                const int tt = tq * 16 + j, t = t0 + tt;
                const bool hp = !seq_start(t), hn = !seq_end(t);
                float r[3];
#pragma unroll
                for (int a = 0; a < 3; ++a) { const float xp = bf2f(raw[(tt + 2) * RS + a * 128 + c]);
                    r[a] = (hp ? xm[a] * wv[a][0] : 0.f) + xc[a] * wv[a][1] + (hn ? xp * wv[a][2] : 0.f) + bv[a];
                    xm[a] = xc[a]; xc[a] = xp; }
                const unsigned bx = f2bf(r[0]), bz = f2bf(r[1] * r[2]);
                if (j & 1) { px |= bx << 16; pz |= bz << 16;
                    *(LAS unsigned*)(ox + c * 72 + tt - 1) = px; *(LAS unsigned*)(oz + c * 72 + tt - 1) = pz; }
                else { px = bx; pz = bz; }
            }
        }
        __syncthreads();
        for (int idx = tid; idx < 128 * 16; idx += 512) {
            const int c = idx >> 4, rem = idx & 15, arr = rem >> 3, pc = rem & 7;
            const nu4 v = *(const LAS nu4*)((arr ? oz : ox) + c * 72 + pc * 8);
            *(nu4*)((arr ? zt : x0t) + (size_t)(c0 + c) * T_TOK + t0 + pc * 8) = v;
        }
        __syncthreads();
    }
}
__device__ __forceinline__ cf2 ld_f2_agent(const cf2* ptr) {
    const unsigned long long w = __hip_atomic_load((const unsigned long long*)ptr, __ATOMIC_RELAXED, __HIP_MEMORY_SCOPE_AGENT);
    return mkf2(__uint_as_float((unsigned)w), __uint_as_float((unsigned)(w >> 32)));
}
template <int S, int NSEQ>
__device__ __forceinline__ void hy_fft_job(const P& p, int l, LAS cf2* X, cf2* Ks, int c, int tbase) {
    const int tid = TIDX;
    constexpr int M = 1 << (2 * S), L = M, MP = M + (M >> 5);
    const float* kt = (const float*)(p.ws + OFF_KT);
    const bf16_t* x0t = (const bf16_t*)(p.ws + OFF_X0T); bf16_t* zt = (bf16_t*)(p.ws + OFF_ZT);
    const float* hf = kt + (S == 7 ? 0 : (size_t)512 * 2 * L_BIG) + (size_t)(c * 2) * L; const float* hb = hf + L;
#pragma unroll 4
    for (int m = tid; m < M; m += 512) {
        const int n0 = 2 * m, n1 = 2 * m + 1;
        const float a = n0 < L ? hf[n0] : (n0 == L ? 0.f : hb[2 * L - n0]);
        const float b = n1 < L ? hf[n1] : hb[2 * L - n1];
        X[PADI(m)] = mkf2(a, b);
    }
    __syncthreads();
    fft_fwd2<S, 1>(X);
    spec_store(X, S, Ks);
    __builtin_amdgcn_fence(__ATOMIC_ACQUIRE, "agent");
    asm volatile("s_waitcnt vmcnt(0)" ::: "memory");
    __syncthreads();
    const float skip = PRM(p, hy_skip)[(size_t)l * D_HY + c];
    const bf16_t* zrow = zt + (size_t)c * T_TOK + tbase; const bf16_t* xrow = x0t + (size_t)c * T_TOK + tbase;
#pragma unroll 4
    for (int idx = tid; idx < NSEQ * M; idx += 512) {
        const int sq = idx / M, m = idx - sq * M;
        cf2 v = mkf2(0.f, 0.f);
        if (m < (M >> 1)) { const unsigned w = *(const unsigned*)(zrow + sq * L + 2 * m); v.x = __uint_as_float(w << 16); v.y = __uint_as_float(w & 0xffff0000u); }
        X[sq * MP + PADI(m)] = v;
    }
    __syncthreads();
    fft_fwd2<S, NSEQ>(X);
    spec_mul(X, S, Ks, NSEQ);
    fft_inv2<S, NSEQ>(X);
    const float inv = 1.0f / (float)M;
    bf16_t* orow = zt + (size_t)c * T_TOK + tbase;
#pragma unroll 4
    for (int idx = tid; idx < NSEQ * (M >> 1); idx += 512) {
        const int sq = idx / (M >> 1), m = idx - sq * (M >> 1);
        const cf2 d = X[sq * MP + PADI(m)];
        const unsigned wz = *(const unsigned*)(zrow + sq * L + 2 * m), wx = *(const unsigned*)(xrow + sq * L + 2 * m);
        const float z0 = __uint_as_float(wz << 16), z1 = __uint_as_float(wz & 0xffff0000u), a0 = __uint_as_float(wx << 16), a1 = __uint_as_float(wx & 0xffff0000u);
        *(unsigned*)(orow + sq * L + 2 * m) = pack_bf2(a0 * (d.x * inv + skip * z0), a1 * (d.y * inv + skip * z1));
    }
    __syncthreads();
}
__device__ void ph_hy_fft(const P& p, int l, LAS unsigned char* lds) {
    LAS cf2* X = (LAS cf2*)lds;
    cf2* Ks = (cf2*)(p.ws + OFF_KS) + (size_t)blockIdx.x * L_BIG;
    for (int job = blockIdx.x; job < 1024; job += gridDim.x) {
        const bool big = job < 512; const int c = job & 511;
        if (big) hy_fft_job<7, 1>(p, l, X, Ks, c, 0); else hy_fft_job<6, 4>(p, l, X, Ks, c, L_BIG);
    }
}
__device__ void ph_hy_norm(const P& p, int l, LAS unsigned char* lds) {
    LAS bf16_t* tl = (LAS bf16_t*)lds;
    LAS float* red = (LAS float*)(lds + 9216);
    const bf16_t* yh = (const bf16_t*)(p.ws + OFF_ZT);
    const float* gain = PRM(p, hy_out_norm) + (size_t)l * D_HY;
    const int tid = TIDX, nitems = (T_TOK / 64) * 8;
    for (int it = blockIdx.x; it < nitems; it += gridDim.x) {
        const int t0 = (it >> 3) * 64, c0 = (it & 7) * 64;
        { const int cc = tid >> 3, pc = tid & 7;
          *(LAS nu4*)(tl + cc * 72 + pc * 8) = *(const nu4*)(yh + (size_t)(c0 + cc) * T_TOK + t0 + pc * 8); }
        __syncthreads();
        { const int tt = tid & 63, part = tid >> 6; float s = 0.f;
#pragma unroll
          for (int j = 0; j < 8; ++j) { const float v = bf2f(tl[(part * 8 + j) * 72 + tt]); s += v * v; }
          red[part * 64 + tt] = s; }
        __syncthreads();
        { const int tt = tid >> 3, pc = tid & 7;
          float s = 0.f;
#pragma unroll
          for (int j = 0; j < 8; ++j) s += red[j * 64 + tt];
          const float r = rsqrtf(s * (1.0f / 64.0f) + 1e-6f);
          unsigned w[4];
#pragma unroll
          for (int j = 0; j < 4; ++j) { const int ca = pc * 8 + 2 * j;
              w[j] = pack_bf2(bf2f(tl[ca * 72 + tt]) * r * gain[c0 + ca], bf2f(tl[(ca + 1) * 72 + tt]) * r * gain[c0 + ca + 1]); }
          nu4 o; o.x = w[0]; o.y = w[1]; o.z = w[2]; o.w = w[3];
          *(nu4*)(abuf_row(p, t0 + tt) + c0 + pc * 8) = o; }
        __syncthreads();
    }
}
typedef short hbf16x8 __attribute__((ext_vector_type(8)));
typedef float hf32x16 __attribute__((ext_vector_type(16)));
constexpr int HSC = 512, HNCH = HSC / 64, HNSC = T_TOK / HSC;
constexpr int QS = 136, KS_ = 72;
constexpr int HL_QH = 0, HL_KH = HL_QH + 64 * QS * 2, HL_QT = HL_KH + 64 * QS * 2, HL_KT = HL_QT + 64 * QS * 2, HL_VT = HL_KT + 128 * KS_ * 2, HL_ST = HL_VT + 128 * KS_ * 2,
              HL_PM = HL_ST + 128 * QS * 2, HL_TOT = HL_PM + 64 * KS_ * 2, HL_EB = HL_TOT + 4 * 128 * 4, HL_END = HL_EB + 128 * 4;
constexpr int HL_OF = HL_QH, OFS = 132;
static_assert(64 * OFS * 4 <= 2 * 64 * QS * 2, "O tile must fit over Qh|Kh");
constexpr size_t OFF_HST = OFF_R6 + 32 * MiB;
constexpr size_t OFF_HAT = OFF_SMALL + 64 * 1024;

__device__ __forceinline__ hf32x16 mfma32(hbf16x8 a, hbf16x8 b, hf32x16 c) { return __builtin_amdgcn_mfma_f32_32x32x16_bf16(a, b, c, 0, 0, 0); }
__device__ __forceinline__ hbf16x8 lds_frag(const LAS unsigned char* base, int row, int stride_el, int col_el) { return *(const LAS hbf16x8*)(base + ((size_t)row * stride_el + col_el) * 2); }

typedef unsigned hu32x4 __attribute__((ext_vector_type(4)));
struct HgPre { hu32x4 f0, f1, v0, v1, q0, q1; };
template <bool FULL>
__device__ __forceinline__ void hg_fetch(const bf16_t* hg, HgPre& pre, int tokbase, int dirsign, int h, int dir) {
    const int tid = TIDX;
    { const int u = tid >> 4, seg = tid & 15;
      const bf16_t* row = hg + (size_t)(tokbase + dirsign * u) * 2560 + h * 128 + seg * 8;
      pre.f0 = *(const hu32x4*)(row + 512 + 512 * dir); pre.v0 = *(const hu32x4*)(row + 1536); if (FULL) pre.q0 = *(const hu32x4*)(row);
      const bf16_t* row1 = row + (size_t)dirsign * 32 * 2560;
      pre.f1 = *(const hu32x4*)(row1 + 512 + 512 * dir); pre.v1 = *(const hu32x4*)(row1 + 1536); if (FULL) pre.q1 = *(const hu32x4*)(row1); }
}
template <bool FULL>
__device__ __forceinline__ void hg_prep(LAS unsigned char* lds, const HgPre& pre, float lb, float& Bsum_out) {
    const int tid = TIDX, d = tid & 127, qt = tid >> 7;
    LAS float* tot = (LAS float*)(lds + HL_TOT); LAS float* eB = (LAS float*)(lds + HL_EB);
    { const int u = tid >> 4, seg = tid & 15;
      *(LAS hu32x4*)(lds + HL_KH + ((size_t)u * QS + seg * 8) * 2) = pre.f0; *(LAS hu32x4*)(lds + HL_KH + ((size_t)(u + 32) * QS + seg * 8) * 2) = pre.f1;
      *(LAS hu32x4*)(lds + HL_QH + ((size_t)u * QS + seg * 8) * 2) = pre.v0; *(LAS hu32x4*)(lds + HL_QH + ((size_t)(u + 32) * QS + seg * 8) * 2) = pre.v1;
      if (FULL) { *(LAS hu32x4*)(lds + HL_QT + ((size_t)u * QS + seg * 8) * 2) = pre.q0; *(LAS hu32x4*)(lds + HL_QT + ((size_t)(u + 32) * QS + seg * 8) * 2) = pre.q1; } }
    __syncthreads();
    float c[16];
    float run = 0.f;
    const float oml = 1.0f - lb;
    float zz[16];
#pragma unroll
    for (int j = 0; j < 16; ++j) zz[j] = bf2f(*(const LAS bf16_t*)(lds + HL_KH + ((size_t)(qt * 16 + j) * QS + d) * 2));
    __builtin_amdgcn_sched_barrier(0);
#pragma unroll
    for (int j = 0; j < 16; ++j) {
        const int u = qt * 16 + j;
        const float z = fmaxf(zz[j], -60.0f);
        const float f = lb + oml * __builtin_amdgcn_rcpf(1.0f + __expf(-z));
        zz[j] = 1.0f - f;
        run += __logf(f);
        c[j] = run;
    }
    tot[qt * 128 + d] = run;
    float vv[16], qq[16];
#pragma unroll
    for (int j = 0; j < 16; ++j) { vv[j] = __uint_as_float((unsigned)(*(const LAS bf16_t*)(lds + HL_QH + ((size_t)(qt * 16 + j) * QS + d) * 2)));
        if (FULL) qq[j] = bf2f(*(const LAS bf16_t*)(lds + HL_QT + ((size_t)(qt * 16 + j) * QS + d) * 2)); }
    __syncthreads();
    const float t0 = tot[d], t1 = tot[128 + d], t2 = tot[256 + d], t3 = tot[384 + d];
    const float off = qt == 0 ? 0.f : (qt == 1 ? t0 : (qt == 2 ? t0 + t1 : t0 + t1 + t2));
    const float r = t0 + t1, B = t0 + t1 + t2 + t3;
    const float eBr = __expf(B - r), eR = __expf(r);
    if (qt == 0) eB[d] = __expf(B);
    Bsum_out = B;
#pragma unroll
    for (int jj = 0; jj < 8; ++jj) {
        unsigned pkt = 0, pvt = 0;
#pragma unroll
        for (int q2 = 0; q2 < 2; ++q2) {
            const int j = jj * 2 + q2, u = qt * 16 + j;
            const float rb = r - (off + c[j]);
            const float kh = zz[j] * __expf(rb);
            pkt |= (unsigned)f2bf(kh * eBr) << (16 * q2); pvt |= __float_as_uint(vv[j]) << (16 * q2);
            if (FULL) {
                const float zq = qq[j];
                const float q = zq * __builtin_amdgcn_rcpf(1.0f + __expf(-zq));
                const float qh = q * __expf(-rb);
                *(LAS bf16_t*)(lds + HL_QT + ((size_t)u * QS + d) * 2) = f2bf(qh * eR);
                *(LAS bf16_t*)(lds + HL_QH + ((size_t)u * QS + d) * 2) = f2bf(qh);
                *(LAS bf16_t*)(lds + HL_KH + ((size_t)u * QS + d) * 2) = f2bf(kh);
            }
        }
        *(LAS unsigned*)(lds + HL_KT + ((size_t)d * KS_ + qt * 16 + jj * 2) * 2) = pkt;
        *(LAS unsigned*)(lds + HL_VT + ((size_t)d * KS_ + qt * 16 + jj * 2) * 2) = pvt;
    }
    __syncthreads();
}
__device__ __forceinline__ void hg_state_update(LAS unsigned char* lds, hf32x16 (&S)[2], int w, int lane) {
    const int en = w & 3, r = lane & 31, hh = lane >> 5;
    const LAS float* eB = (const LAS float*)(lds + HL_EB);
#pragma unroll
    for (int i = 0; i < 2; ++i) {
        const int dm = (w >> 2) * 2 + i;
#pragma unroll
        for (int g = 0; g < 4; ++g) { const nf4 sc = *(const LAS nf4*)(eB + 32 * dm + 8 * g + 4 * hh);
            S[i][4 * g + 0] *= sc.x; S[i][4 * g + 1] *= sc.y; S[i][4 * g + 2] *= sc.z; S[i][4 * g + 3] *= sc.w; }
#pragma unroll
        for (int ks = 0; ks < 4; ++ks) {
            const hbf16x8 a = lds_frag(lds + HL_KT, 32 * dm + r, KS_, 16 * ks + 8 * hh);
            const hbf16x8 b = lds_frag(lds + HL_VT, 32 * en + r, KS_, 16 * ks + 8 * hh);
            S[i] = mfma32(a, b, S[i]);
        }
    }
}
__device__ __forceinline__ int hg_unit_base(int sc) { return sc * HSC; }
__device__ void ph_hg_pass1(const P& p, int l, LAS unsigned char* lds) {
    const bf16_t* hg = (const bf16_t*)(p.ws + OFF_HG);
    const float* lbs = (const float*)(p.ws + OFF_SMALL);
    float* ust = (float*)(p.ws + OFF_HST); float* atot = (float*)(p.ws + OFF_HAT);
    const int tid = TIDX, w = tid >> 6, lane = tid & 63;
    for (int unit = blockIdx.x; unit < HNSC * 8; unit += gridDim.x) {
        const int sc = unit >> 3, h = (unit >> 1) & 3, dir = unit & 1;
        const float lb = lbs[(size_t)(dir * NLAYER + l) * D_HG + h * 128 + (tid & 127)];
        hf32x16 S[2];
#pragma unroll
        for (int i = 0; i < 2; ++i)
#pragma unroll
            for (int k = 0; k < 16; ++k) S[i][k] = 0.f;
        float Btot = 0.f;
        const int dsg = dir ? -1 : 1, tb0 = dir ? hg_unit_base(sc) + HSC - 1 : hg_unit_base(sc);
        HgPre pre;
        hg_fetch<false>(hg, pre, tb0, dsg, h, dir);
        for (int ci = 0; ci < HNCH; ++ci) {
            float B;
            hg_prep<false>(lds, pre, lb, B);
            if (ci + 1 < HNCH) hg_fetch<false>(hg, pre, tb0 + dsg * (ci + 1) * 64, dsg, h, dir);
            Btot += B;
            hg_state_update(lds, S, w, lane);
            __syncthreads();
        }
        float* U = ust + (size_t)unit * 16384;
        int r = lane & 31, hh = lane >> 5; asm volatile("" : "+v"(r), "+v"(hh));
        const int en = w & 3;
#pragma unroll
        for (int i = 0; i < 2; ++i) { const int dm = (w >> 2) * 2 + i;
#pragma unroll
            for (int k = 0; k < 16; ++k) U[(32 * dm + (k & 3) + 8 * (k >> 2) + 4 * hh) * 128 + 32 * en + r] = S[i][k]; }
        if (tid < 128) atot[(size_t)unit * 128 + tid] = __expf(Btot);
    }
}
__device__ void ph_hg_pass2(const P& p) {
    float* ust = (float*)(p.ws + OFF_HST); const float* atot = (const float*)(p.ws + OFF_HAT);
    const int total = 5 * 8 * 16384;
    for (int idx = blockIdx.x * 512 + TIDX; idx < total; idx += gridDim.x * 512) {
        const int el = idx & 16383, hd = (idx >> 14) & 7, sq = idx >> 17;
        const int sc0 = sq == 0 ? 0 : 32 + 8 * (sq - 1), nsc = sq == 0 ? 32 : 8, dir = hd & 1, d = el >> 7;
        float carry = 0.f;
        for (int j0 = 0; j0 < nsc; j0 += 8) {
            float u[8], a[8];
#pragma unroll
            for (int jj = 0; jj < 8; ++jj) { const int j = j0 + jj, sc = dir ? sc0 + nsc - 1 - j : sc0 + j; const size_t unit = (size_t)sc * 8 + hd;
                u[jj] = ust[unit * 16384 + el]; a[jj] = atot[unit * 128 + d]; }
#pragma unroll
            for (int jj = 0; jj < 8; ++jj) { const int j = j0 + jj, sc = dir ? sc0 + nsc - 1 - j : sc0 + j; const size_t unit = (size_t)sc * 8 + hd;
                ust[unit * 16384 + el] = carry; carry = a[jj] * carry + u[jj]; }
        }
    }
}
__device__ void ph_hg_pass3(const P& p, int l, LAS unsigned char* lds) {
    const bf16_t* hg = (const bf16_t*)(p.ws + OFF_HG);
    const float* lbs = (const float*)(p.ws + OFF_SMALL);
    const float* ust = (const float*)(p.ws + OFF_HST);
    const float* gain = PRM(p, hg_out_norm) + (size_t)l * D_HG;
    const int tid = TIDX, w = tid >> 6, lane = tid & 63, r = lane & 31, hh = lane >> 5;
    for (int unit = blockIdx.x; unit < HNSC * 4; unit += gridDim.x) {
        const int sc = unit >> 2, h = unit & 3;
        for (int dir = 0; dir < 2; ++dir) {
            const float lb = lbs[(size_t)(dir * NLAYER + l) * D_HG + h * 128 + (tid & 127)];
            const float* S0 = ust + ((size_t)sc * 8 + h * 2 + dir) * 16384;
            hf32x16 S[2];
            { const int en = w & 3;
              int r_ = r, hh_ = hh; asm volatile("" : "+v"(r_), "+v"(hh_));
              const float* S0l = S0 + (4 * hh_) * 128 + 32 * en + r_;
#pragma unroll
              for (int i = 0; i < 2; ++i) { const int dm = (w >> 2) * 2 + i;
#pragma unroll
                  for (int k = 0; k < 16; ++k) S[i][k] = S0l[(32 * dm + (k & 3) + 8 * (k >> 2)) * 128];
#pragma unroll
                  for (int g = 0; g < 4; ++g) { nu2 wv; wv.x = pack_bf2(S[i][4 * g], S[i][4 * g + 1]); wv.y = pack_bf2(S[i][4 * g + 2], S[i][4 * g + 3]);
                      *(LAS nu2*)(lds + HL_ST + ((size_t)(32 * en + r) * QS + 32 * dm + 8 * g + 4 * hh) * 2) = wv; } } }
            const int dsg = dir ? -1 : 1, tb0 = dir ? hg_unit_base(sc) + HSC - 1 : hg_unit_base(sc);
            HgPre pre;
            hg_fetch<true>(hg, pre, tb0, dsg, h, dir);
            for (int ci = 0; ci < HNCH; ++ci) {
                const int tokbase = tb0 + dsg * ci * 64;
                float Bdummy;
                hg_prep<true>(lds, pre, lb, Bdummy);
                if (ci + 1 < HNCH) hg_fetch<true>(hg, pre, tb0 + dsg * (ci + 1) * 64, dsg, h, dir);
                if (w < 4) {
                    const int tm = (w == 0 || w == 3) ? 0 : 1, sn = (w == 2 || w == 3) ? 1 : 0;
                    hf32x16 acc;
#pragma unroll
                    for (int k = 0; k < 16; ++k) acc[k] = 0.f;
                    if (w < 3) {
#pragma unroll
                        for (int ks = 0; ks < 8; ++ks) acc = mfma32(lds_frag(lds + HL_QH, 32 * tm + r, QS, 16 * ks + 8 * hh), lds_frag(lds + HL_KH, 32 * sn + r, QS, 16 * ks + 8 * hh), acc);
                    }
                    const int s_ = 32 * sn + r;
#pragma unroll
                    for (int k = 0; k < 16; ++k) { const int t_ = 32 * tm + (k & 3) + 8 * (k >> 2) + 4 * hh;
                        const float v = (w < 3 && s_ <= t_) ? acc[k] : 0.f;
                        *(LAS bf16_t*)(lds + HL_PM + ((size_t)t_ * KS_ + s_) * 2) = f2bf(v); }
                }
                __syncthreads();
                hf32x16 o;
                { const int tm = w >> 2, en = w & 3;
#pragma unroll
                  for (int k = 0; k < 16; ++k) o[k] = 0.f;
#pragma unroll
                  for (int ks = 0; ks < 4; ++ks) o = mfma32(lds_frag(lds + HL_PM, 32 * tm + r, KS_, 16 * ks + 8 * hh), lds_frag(lds + HL_VT, 32 * en + r, KS_, 16 * ks + 8 * hh), o);
#pragma unroll
                  for (int ks = 0; ks < 8; ++ks) o = mfma32(lds_frag(lds + HL_QT, 32 * tm + r, QS, 16 * ks + 8 * hh), lds_frag(lds + HL_ST, 32 * en + r, QS, 16 * ks + 8 * hh), o);
                }
                __syncthreads();
                { const int tm = w >> 2, en = w & 3; LAS float* Of = (LAS float*)(lds + HL_OF);
#pragma unroll
                  for (int k = 0; k < 16; ++k) Of[(size_t)(32 * tm + (k & 3) + 8 * (k >> 2) + 4 * hh) * OFS + 32 * en + r] = o[k]; }
                hg_state_update(lds, S, w, lane);
                { const int en = w & 3;
#pragma unroll
                  for (int i = 0; i < 2; ++i) { const int dm = (w >> 2) * 2 + i;
#pragma unroll
                      for (int g = 0; g < 4; ++g) { nu2 wv; wv.x = pack_bf2(S[i][4 * g], S[i][4 * g + 1]); wv.y = pack_bf2(S[i][4 * g + 2], S[i][4 * g + 3]);
                          *(LAS nu2*)(lds + HL_ST + ((size_t)(32 * en + r) * QS + 32 * dm + 8 * g + 4 * hh) * 2) = wv; } } }
                __syncthreads();
                { const int u = tid >> 3, e0 = (tid & 7) * 16, tok = tokbase + dsg * u;
                  const LAS float* Of = (const LAS float*)(lds + HL_OF) + (size_t)u * OFS + e0;
                  bf16_t* dst = abuf_row(p, tok) + 512 + h * 128 + e0;
                  float v[16];
#pragma unroll
                  for (int j = 0; j < 4; ++j) { const nf4 t4 = *(const LAS nf4*)(Of + 4 * j); v[4 * j] = t4.x; v[4 * j + 1] = t4.y; v[4 * j + 2] = t4.z; v[4 * j + 3] = t4.w; }
                  if (dir == 0) {
                      uint4 w0, w1;
                      w0.x = pack_bf2(v[0], v[1]); w0.y = pack_bf2(v[2], v[3]); w0.z = pack_bf2(v[4], v[5]); w0.w = pack_bf2(v[6], v[7]);
                      w1.x = pack_bf2(v[8], v[9]); w1.y = pack_bf2(v[10], v[11]); w1.z = pack_bf2(v[12], v[13]); w1.w = pack_bf2(v[14], v[15]);
                      ((uint4*)dst)[0] = w0; ((uint4*)dst)[1] = w1;
                  } else {
                      const uint4 f0 = ((const uint4*)dst)[0], f1 = ((const uint4*)dst)[1];
                      const unsigned fw[8] = {f0.x, f0.y, f0.z, f0.w, f1.x, f1.y, f1.z, f1.w};
                      float ss = 0.f;
#pragma unroll
                      for (int j = 0; j < 8; ++j) { v[2 * j] += __uint_as_float(fw[j] << 16); v[2 * j + 1] += __uint_as_float(fw[j] & 0xffff0000u); ss += v[2 * j] * v[2 * j] + v[2 * j + 1] * v[2 * j + 1]; }
                      ss += __shfl_xor(ss, 1); ss += __shfl_xor(ss, 2); ss += __shfl_xor(ss, 4);
                      const float rn = rsqrtf(ss * (1.0f / 128.0f) + 1e-6f);
                      const bf16_t* gp = hg + (size_t)tok * 2560 + 2048 + h * 128 + e0;
                      const uint4 g0 = ((const uint4*)gp)[0], g1 = ((const uint4*)gp)[1];
                      const unsigned gw[8] = {g0.x, g0.y, g0.z, g0.w, g1.x, g1.y, g1.z, g1.w};
                      unsigned ow[8];
#pragma unroll
                      for (int j = 0; j < 8; ++j) { const float ga = silu_f(__uint_as_float(gw[j] << 16)), gb = silu_f(__uint_as_float(gw[j] & 0xffff0000u));
                          ow[j] = pack_bf2(v[2 * j] * rn * gain[h * 128 + e0 + 2 * j] * ga, v[2 * j + 1] * rn * gain[h * 128 + e0 + 2 * j + 1] * gb); }
                      ((uint4*)dst)[0] = make_uint4(ow[0], ow[1], ow[2], ow[3]); ((uint4*)dst)[1] = make_uint4(ow[4], ow[5], ow[6], ow[7]);
                  }
                }
                __syncthreads();
            }
        }
    }
}
#define XB_TMO      128
#define XB_XCNT(j)  (256  + 64 * (j))
#define XB_XSUB(j)  (1280 + 64 * (j))
#define XB_XGEN(j)  (2304 + 64 * (j))
#define XB_TOP      3328
#define XB_TOPGEN   3392
#define XCD_BAR_WORDS 3456
#define XB_SPIN_CAP (1u << 18)

__device__ __forceinline__ unsigned xb_ld(unsigned* p)              { return __hip_atomic_load(p, __ATOMIC_RELAXED, __HIP_MEMORY_SCOPE_AGENT); }
__device__ __forceinline__ unsigned xb_add(unsigned* p, unsigned v) { return __hip_atomic_fetch_add(p, v, __ATOMIC_RELAXED, __HIP_MEMORY_SCOPE_AGENT); }
__device__ __forceinline__ unsigned xb_xcc_id() { return (unsigned)__builtin_amdgcn_s_getreg((3 << 11) | 20) & 0xFu; }
#define XB_SPIN(cond, bar) do { unsigned _sp = 0; while (cond) { __builtin_amdgcn_s_sleep(1); \
    if ((++_sp & 255u) == 0u) { if (xb_ld(&(bar)[XB_TMO])) break; if (_sp > XB_SPIN_CAP) { atomicAdd(&(bar)[XB_TMO], 1u); break; } } } } while (0)

struct XcdBarrier {
    unsigned* bar; unsigned x;
    volatile LAS unsigned* st;
};

__device__ __forceinline__ XcdBarrier xcd_barrier_post(unsigned* bar, volatile LAS unsigned* st) {
    XcdBarrier b; b.bar = bar; b.x = xb_xcc_id(); b.st = st;
    if (TIDX == 0) (void)xb_add(&bar[XB_XCNT(b.x)], 1u);
    return b;
}
__device__ __forceinline__ void xcd_barrier_complete(unsigned* bar, unsigned x, unsigned& nloc, unsigned& nx) {
    const unsigned G = gridDim.x * gridDim.y * gridDim.z;
    unsigned sum, cnt, mine, sp = 0u;
    for (;;) {
        sum = 0u; cnt = 0u; mine = 0u;
#pragma unroll
        for (unsigned j = 0; j < 16; ++j) { const unsigned c = xb_ld(&bar[XB_XCNT(j)]); sum += c; cnt += (c > 0u) ? 1u : 0u; mine = (j == x) ? c : mine; }
        if (sum == G) break;
        __builtin_amdgcn_s_sleep(1);
        if ((++sp & 255u) == 0u) { if (xb_ld(&bar[XB_TMO])) break; if (sp > XB_SPIN_CAP) { atomicAdd(&bar[XB_TMO], 1u); break; } }
    }
    nloc = mine > 0u ? mine : 1u; nx = cnt > 0u ? cnt : 1u;
}

__device__ __forceinline__ void xcd_barrier(const XcdBarrier& b) {
    asm volatile("s_waitcnt vmcnt(0)" ::: "memory");
    __syncthreads();
    if (TIDX == 0) {
        unsigned* bar = b.bar;
        __builtin_amdgcn_s_waitcnt(0);
        unsigned nloc = b.st[0], nx = b.st[1];
        if (nloc == 0u) { xcd_barrier_complete(bar, b.x, nloc, nx); b.st[0] = nloc; b.st[1] = nx; }
        const unsigned old = xb_add(&bar[XB_XSUB(b.x)], 1u);
        const unsigned gen = old / nloc;
        if (old + 1u == (gen + 1u) * nloc) {
            __builtin_amdgcn_fence(__ATOMIC_RELEASE, "agent");
            asm volatile("s_waitcnt vmcnt(0)" ::: "memory");
            const unsigned og = xb_add(&bar[XB_TOP], 1u);
            const unsigned tg = og / nx;
            if (og + 1u == (tg + 1u) * nx) xb_add(&bar[XB_TOPGEN], 1u);
            else XB_SPIN(xb_ld(&bar[XB_TOPGEN]) == tg, bar);
            __builtin_amdgcn_fence(__ATOMIC_ACQUIRE, "agent");
            xb_add(&bar[XB_XGEN(b.x)], 1u);
            asm volatile("s_waitcnt vmcnt(0)" ::: "memory");
        } else {
            XB_SPIN(xb_ld(&bar[XB_XGEN(b.x)]) == gen, bar);
            __builtin_amdgcn_fence(__ATOMIC_ACQUIRE, "agent");
            asm volatile("s_waitcnt vmcnt(0)" ::: "memory");
        }
    }
    __syncthreads();
}

enum { PH_SETUP, PH_CONVERT, PH_RMS_IN, PH_GEMM_IN, PH_HY_PREP, PH_FILTER, PH_HGRN, PH_HG_NORM, PH_HY_FFT, PH_HY_NORM, PH_GEMM_OUT, PH_NR0, PH_GEMM_UP, PH_GEGLU, PH_GEMM_DN, PH_NR1, PH_HG_P1, PH_HG_P2, PH_HG_P3 };
template <int PH> __device__ __forceinline__ void run_phase(const P& p_in, int l, int part, LAS unsigned char* lds) {
    typedef __attribute__((address_space(1))) unsigned char* gptr_t; typedef __attribute__((address_space(1))) float* gfptr_t;
    gptr_t wsg = (gptr_t)p_in.ws; gfptr_t outg = (gfptr_t)p_in.out;
    asm volatile("" : "+s"(wsg), "+s"(outg));
    P p = p_in; p.ws = (unsigned char*)wsg; p.out = (float*)outg;
    if constexpr (PH == PH_SETUP) { ph_setup(p); ph_copy_params(p); }
    if constexpr (PH == PH_CONVERT) ph_convert_w(p, l, lds);
    if constexpr (PH == PH_RMS_IN) ph_rmsnorm_in(p, l);
    if constexpr (PH == PH_GEMM_IN) { EpiBf16Split E; E.O0 = (bf16_t*)(p.ws + OFF_HYRAW); E.ldc0 = 1536; E.O1 = (bf16_t*)(p.ws + OFF_HG); E.ldc1 = 2560; E.csplit = 1536;
        run_gemm(lds, abuf_row(p, 0), (const bf16_t*)(p.ws + OFF_W_IN), T_TOK, D_IN, DM, E); }
    if constexpr (PH == PH_HY_PREP) ph_hy_prep(p, l, lds);
    if constexpr (PH == PH_FILTER) ph_filter(p, l, lds);
    if constexpr (PH == PH_HY_FFT) ph_hy_fft(p, l, lds);
    if constexpr (PH == PH_HY_NORM) ph_hy_norm(p, l, lds);
    if constexpr (PH == PH_GEMM_OUT) { EpiBf16Split E; E.O0 = (bf16_t*)(p.ws + OFF_MIX); E.ldc0 = DM; E.O1 = E.O0; E.ldc1 = DM; E.csplit = 1 << 30;
        run_gemm(lds, abuf_row(p, 0), (const bf16_t*)(p.ws + OFF_W_OUT), T_TOK, DM, DM, E); }
    if constexpr (PH == PH_NR0) ph_norm_resid(p, l, 0);
    if constexpr (PH == PH_GEMM_UP) { EpiGeglu E; E.act = (bf16_t*)(p.ws + OFF_ACT); E.cw = PRM(p, ffn_conv_w) + (size_t)l * 3 * 8192; E.cb = PRM(p, ffn_conv_b) + (size_t)l * 8192;
        run_gemm(lds, abuf_row(p, -1), (const bf16_t*)(p.ws + OFF_W_UP), 133 * 256, 2 * DFF, DM, E); }
    if constexpr (PH == PH_GEMM_DN) { EpiBf16Split E; E.O0 = (bf16_t*)(p.ws + OFF_MIX); E.ldc0 = DM; E.O1 = E.O0; E.ldc1 = DM; E.csplit = 1 << 30;
        run_gemm(lds, (const bf16_t*)(p.ws + OFF_ACT), (const bf16_t*)(p.ws + OFF_W_DN), T_TOK, DM, DFF, E); }
    if constexpr (PH == PH_NR1) ph_norm_resid(p, l, 1);
    if constexpr (PH == PH_HG_P1) ph_hg_pass1(p, l, lds);
    if constexpr (PH == PH_HG_P2) ph_hg_pass2(p);
    if constexpr (PH == PH_HG_P3) ph_hg_pass3(p, l, lds);
}
constexpr int LDS_BYTES = 139264;
__global__ __launch_bounds__(512, 2) void mega(P p) {
    extern __shared__ __attribute__((aligned(16))) unsigned char lds_g[];
    LAS unsigned char* lds = (LAS unsigned char*)lds_g;
    cg::grid_group grid = cg::this_grid();
    volatile LAS unsigned* xst = (volatile LAS unsigned*)(lds + LDS_BYTES - 16);
    if (TIDX == 0) { xst[0] = 0u; xst[1] = 0u; }
    __syncthreads();
    const XcdBarrier xb = xcd_barrier_post((unsigned*)(p.ws + OFF_BAR), xst);
    run_phase<PH_SETUP>(p, 0, 0, lds);
    run_phase<PH_CONVERT>(p, 0, 0, lds);
    run_phase<PH_RMS_IN>(p, 0, 0, lds);
    grid.sync();
#pragma unroll 1
    for (int l = 0; l < NLAYER; ++l) {
        run_phase<PH_GEMM_IN>(p, l, 0, lds); xcd_barrier(xb);
        run_phase<PH_HY_PREP>(p, l, 0, lds); run_phase<PH_HG_P1>(p, l, 0, lds); xcd_barrier(xb);
        run_phase<PH_FILTER>(p, l, 0, lds); run_phase<PH_HG_P2>(p, l, 0, lds); xcd_barrier(xb);
        run_phase<PH_HG_P3>(p, l, 0, lds); run_phase<PH_HY_FFT>(p, l, 0, lds); xcd_barrier(xb);
        run_phase<PH_HY_NORM>(p, l, 0, lds); xcd_barrier(xb);
        run_phase<PH_GEMM_OUT>(p, l, 0, lds); xcd_barrier(xb);
        run_phase<PH_NR0>(p, l, 0, lds); xcd_barrier(xb);
        run_phase<PH_GEMM_UP>(p, l, 0, lds); xcd_barrier(xb);
        run_phase<PH_GEMM_DN>(p, l, 0, lds); xcd_barrier(xb);
        run_phase<PH_NR1>(p, l, 0, lds);
        if (l + 1 < NLAYER) { run_phase<PH_CONVERT>(p, l + 1, 0, lds); xcd_barrier(xb); }
    }
}
extern "C" void kernel_launch(void* const* d_in, const int* in_sizes, int n_in, void* d_out, int out_size, void* d_ws, size_t ws_size, hipStream_t stream) {
    if (ws_size < WS_NEED) { fprintf(stderr, "workspace too small: %zu < %zu\n", ws_size, (size_t)WS_NEED); return; }
    static int grid_blocks = 0;
    if (!grid_blocks) {
        hipFuncSetAttribute((const void*)mega, hipFuncAttributeMaxDynamicSharedMemorySize, LDS_BYTES);
        int dev = 0, cus = 0, per_cu = 0;
        hipGetDevice(&dev);
        hipDeviceGetAttribute(&cus, hipDeviceAttributeMultiprocessorCount, dev);
        hipOccupancyMaxActiveBlocksPerMultiprocessor(&per_cu, mega, 512, LDS_BYTES);
        if (per_cu > 1) per_cu = 1;
        grid_blocks = cus * per_cu;
    }
    P p{};
    for (int i = 0; i < 26; ++i) p.in[i] = (const float*)d_in[i];
    p.out = (float*)d_out; p.ws = (unsigned char*)d_ws;
    hipMemsetAsync((unsigned char*)d_ws + OFF_BAR, 0, XCD_BAR_WORDS * 4, stream);
    void* args[] = {&p};
    hipError_t e = hipLaunchCooperativeKernel((void*)mega, dim3(grid_blocks), dim3(512), args, LDS_BYTES, stream);
    if (e != hipSuccess) fprintf(stderr, "cooperative launch failed: %s (grid %d)\n", hipGetErrorString(e), grid_blocks);
}
```

```cpp
#include <hip/hip_runtime.h>
#include <hip/hip_cooperative_groups.h>
#include <cstdio>
#include <cstdint>
namespace cg = cooperative_groups;
__device__ __forceinline__ int tid_opaque() { int t = (int)threadIdx.x; asm volatile("" : "+v"(t)); return t; }
#define TIDX tid_opaque()
#define LAS __attribute__((address_space(3)))
typedef float cf2 __attribute__((ext_vector_type(2)));
typedef float nf4 __attribute__((ext_vector_type(4)));
typedef unsigned nu2 __attribute__((ext_vector_type(2)));
typedef unsigned nu4 __attribute__((ext_vector_type(4)));
namespace pg8 {
#define PG8_LAS __attribute__((address_space(3)))
typedef unsigned short bf16_t;
typedef short bf16x8 __attribute__((ext_vector_type(8)));
typedef float f32x4 __attribute__((ext_vector_type(4)));
typedef unsigned u32x4 __attribute__((ext_vector_type(4)));
constexpr int BM = 256, BK = 64, HALF = 128, HTB = HALF * BK * 2  , STAGE_BYTES = 8 * HTB, NXCD = 8, WGM = 8;

__host__ __device__ __forceinline__ int lds_byte(int r, int c) { const int st = (r >> 4) * 2 + (c >> 5), rr = r & 15, cc = c & 31, ob = rr * 64 + cc * 2; return st * 1024 + (ob ^ (((ob >> 9) & 1) << 5)); }
__host__ __device__ __forceinline__ void stage_rc(int b, int& R, int& C) { const int st = b / 1024, sb = b % 1024, swz = sb ^ (((sb >> 9) & 1) << 5); R = (st >> 1) * 16 + swz / 64; C = (st & 1) * 32 + (swz % 64) / 2; }
__host__ __device__ __forceinline__ int perm32(int rho) { const int n = rho >> 4, i = rho & 15; return 8 * (i >> 2) + 4 * n + (i & 3); }

struct Unit { int pm, pn; };
struct Gemm { const bf16_t* A; const bf16_t* Bt; int M, N, K; int ovl; };

struct StaticOrder {
    int nM, nN, nwg, G, c;
    __host__ __device__ void init(int M, int N, int G_, int c_) { nM = M / BM; nN = N / BM; nwg = nM * nN; G = G_; c = c_; }
    __host__ __device__ bool next(int i, Unit& u) const {
        const long L = (long)i * G + c; if (L >= nwg) return false;
        int wgid = (int)L; { const int q = nwg / NXCD, r = nwg % NXCD, xcd = wgid % NXCD, off = wgid / NXCD; wgid = (xcd < r ? xcd * (q + 1) : r * (q + 1) + (xcd - r) * q) + off; }
        const int nig = WGM * nN, gid = wgid / nig, fm = gid * WGM, gsz = (nM - fm) < WGM ? (nM - fm) : WGM;
        u.pm = fm + ((wgid % nig) % gsz); u.pn = (wgid % nig) / gsz; return true;
    }
    __device__ __forceinline__ void a_ready(const Unit&) const {}
    __device__ __forceinline__ void done(const Unit&) const {}
};
struct CountedOrder : StaticOrder {
    const unsigned* ready; unsigned need; unsigned* tmo;
    __device__ __forceinline__ void a_ready(const Unit& u) const {
        if (TIDX < 64) {
            const unsigned long long t0 = __builtin_amdgcn_s_memrealtime(); unsigned polls = 0;
            while ((unsigned)__builtin_amdgcn_readfirstlane(__hip_atomic_load(ready + 64 * u.pm, __ATOMIC_RELAXED, __HIP_MEMORY_SCOPE_AGENT)) < need) {
                if ((++polls & 255u) == 0u && __builtin_amdgcn_readfirstlane(__hip_atomic_load(tmo, __ATOMIC_RELAXED, __HIP_MEMORY_SCOPE_AGENT)) != 0u) break;
                if (__builtin_amdgcn_s_memrealtime() - t0 > 2000000ull) {
                    if (TIDX == 0) { unsigned expect = 0u; __hip_atomic_compare_exchange_strong(tmo + 1, &expect, 0x600u | (unsigned)(u.pm & 0xff), __ATOMIC_RELAXED, __ATOMIC_RELAXED, __HIP_MEMORY_SCOPE_AGENT); __hip_atomic_store(tmo, 1u, __ATOMIC_RELAXED, __HIP_MEMORY_SCOPE_AGENT); }
                    break; }
                __builtin_amdgcn_s_sleep(2); }
            __builtin_amdgcn_fence(__ATOMIC_ACQUIRE, "agent");
            asm volatile("s_waitcnt vmcnt(0)" ::: "memory");
        }
#if !defined(BROKEN_HOOK_NO_BARRIER)
        asm volatile("" ::: "memory"); __builtin_amdgcn_s_barrier(); asm volatile("" ::: "memory");
#endif
    }
};

__device__ __forceinline__ unsigned cvt_pk_bf16(float lo, float hi) { unsigned r; asm volatile("v_cvt_pk_bf16_f32 %0, %1, %2" : "=v"(r) : "v"(lo), "v"(hi)); return r; }
typedef float f32x2 __attribute__((ext_vector_type(2)));
__device__ __forceinline__ f32x2 gelu_pk(f32x2 v) {
    const f32x2 av = __builtin_elementwise_abs(v), d = av * 0.2316418882f + 1.0f;
    f32x2 t; t.x = __builtin_amdgcn_rcpf(d.x); t.y = __builtin_amdgcn_rcpf(d.y);
    f32x2 q = t * 0.5307027145f + (-0.7265760135f); q = q * t + 0.7107068705f; q = q * t + (-0.142248368f); q = q * t + 0.127414796f; q = q * t;
    const f32x2 s = (v * v) * (-0.72134752044f);
    f32x2 e; e.x = __builtin_amdgcn_exp2f(s.x); e.y = __builtin_amdgcn_exp2f(s.y);
    const f32x2 m = v * (q * e), r = v - m;
    f32x2 o; o.x = v.x < 0.f ? m.x : r.x; o.y = v.y < 0.f ? m.y : r.y; return o;
}

struct EpiF32 {
    static constexpr bool PERM = false, AFTER_DRAIN = false;
    float* C; int ldc; const float* bias;
    __device__ __forceinline__ void operator()(const f32x4 (&acc)[2][2][4][2], const Unit& u, int wr, int wc, int fr, int fq) const {
        const int row0 = u.pm * BM + wr * 64 + fr, col0 = u.pn * BM + wc * 32 + 4 * fq;
        f32x4 bv[2][2];
#pragma unroll
        for (int bj = 0; bj < 2; ++bj)
#pragma unroll
            for (int n = 0; n < 2; ++n) bv[bj][n] = bias ? *(const f32x4*)(bias + col0 + bj * HALF + n * 16) : (f32x4){0.f, 0.f, 0.f, 0.f};
#pragma unroll
        for (int ai = 0; ai < 2; ++ai)
#pragma unroll
            for (int m = 0; m < 4; ++m) { float* rowp = C + (size_t)(row0 + ai * HALF + m * 16) * ldc + col0;
#pragma unroll
                for (int bj = 0; bj < 2; ++bj)
#pragma unroll
                    for (int n = 0; n < 2; ++n) *(f32x4*)(rowp + bj * HALF + n * 16) = acc[ai][bj][m][n] + bv[bj][n]; }
    }
};
template <int ACT  > struct EpiBf16 {
    static constexpr bool PERM = true, AFTER_DRAIN = false;
    bf16_t* O; int ldc; const float* bias; int split_cols; size_t split_stride;
    __device__ __forceinline__ void operator()(const f32x4 (&acc)[2][2][4][2], const Unit& u, int wr, int wc, int fr, int fq) const {
        const int row0 = u.pm * BM + wr * 64 + fr; int colt = u.pn * BM; bf16_t* base = O;
        if (split_cols) { const int t = colt / split_cols; base += (size_t)t * split_stride; colt -= t * split_cols; }
        const int col0 = colt + wc * 32 + 8 * fq, bcol0 = u.pn * BM + wc * 32 + 8 * fq;
        f32x4 bv[2][2];
#pragma unroll
        for (int bj = 0; bj < 2; ++bj)
#pragma unroll
            for (int n = 0; n < 2; ++n) bv[bj][n] = bias ? *(const f32x4*)(bias + bcol0 + bj * HALF + 4 * n) : (f32x4){0.f, 0.f, 0.f, 0.f};
#pragma unroll
        for (int ai = 0; ai < 2; ++ai)
#pragma unroll
            for (int m = 0; m < 4; ++m) { bf16_t* rowp = base + (size_t)(row0 + ai * HALF + m * 16) * ldc + col0;
#pragma unroll
                for (int bj = 0; bj < 2; ++bj) { f32x4 v0 = acc[ai][bj][m][0] + bv[bj][0], v1 = acc[ai][bj][m][1] + bv[bj][1];
                    if (ACT == 1) { f32x2 a = gelu_pk((f32x2){v0[0], v0[1]}), b = gelu_pk((f32x2){v0[2], v0[3]}), c = gelu_pk((f32x2){v1[0], v1[1]}), d = gelu_pk((f32x2){v1[2], v1[3]});
                        v0 = (f32x4){a.x, a.y, b.x, b.y}; v1 = (f32x4){c.x, c.y, d.x, d.y}; }
                    if (ACT == 2) {
#pragma unroll
                        for (int j = 0; j < 4; ++j) { v0[j] = 0.5f * v0[j] * (1.0f + erff(v0[j] * 0.70710678f)); v1[j] = 0.5f * v1[j] * (1.0f + erff(v1[j] * 0.70710678f)); } }
                    u32x4 w; w.x = cvt_pk_bf16(v0[0], v0[1]); w.y = cvt_pk_bf16(v0[2], v0[3]); w.z = cvt_pk_bf16(v1[0], v1[1]); w.w = cvt_pk_bf16(v1[2], v1[3]);
                    *(u32x4*)(rowp + bj * HALF) = w; } }
    }
};
template <class Epi, class Sched, bool STAMP = false>
__device__ __forceinline__ void gemm_phase(PG8_LAS unsigned char* lds, const Gemm g, const Sched& S, const Epi& E, unsigned long long* stamps) {
    const int tid = TIDX, wid = __builtin_amdgcn_readfirstlane(tid >> 6), lane = tid & 63, wr = wid >> 2, wc = wid & 3, fr = lane & 15, fq = lane >> 4;
    const int K = g.K, nt = K / BK;
    int ts_lo = 0, ts_hi = 0, nts = 0; const unsigned long long rt_entry = STAMP ? (unsigned long long)wall_clock64() : 0ull;
#define PG8_STAMP() do { if (STAMP && wid == 0 && nts < 64) { const unsigned long long _c = (unsigned long long)clock64(); \
        ts_lo = (lane == nts) ? (int)(unsigned)_c : ts_lo; ts_hi = (lane == nts) ? (int)(unsigned)(_c >> 32) : ts_hi; ++nts; } } while (0)
    PG8_STAMP();
    unsigned voffA[2], voffB[2];
#pragma unroll
    for (int i = 0; i < 2; ++i) { int R, C; stage_rc(tid * 16 + i * 8192, R, C); const int Rb = Epi::PERM ? ((R & ~31) + perm32(R & 31)) : R;
        const int Ra = g.ovl ? R - 2 * (R >> 6) : R; voffA[i] = (unsigned)(Ra * K + C) * 2u; voffB[i] = (unsigned)(Rb * K + C) * 2u; }
    const size_t kstep = (size_t)(BK * 2);
    const size_t hstep = (size_t)HALF * K * 2;
    const size_t tstep = 2 * hstep;
    const size_t hstepA = g.ovl ? (size_t)124 * K * 2 : hstep, tstepA = g.ovl ? (size_t)248 * K * 2 : tstep;
    const unsigned ldsw = (unsigned)wid * 1024u;
    const int aoff = lds_byte(wr * 64 + fr, fq * 8), boff = lds_byte(wc * 32 + fr, fq * 8);
#define PG8_SA(b, h) (((b) * 2 + (h)) * HTB)
#define PG8_SB(b, h) ((4 + (b) * 2 + (h)) * HTB)
#define PG8_STAGE(bufoff, gbase, voff) do { _Pragma("unroll") for (int _i = 0; _i < 2; ++_i) \
        __builtin_amdgcn_global_load_lds((const unsigned*)((const char*)(gbase) + (voff)[_i]), (PG8_LAS unsigned*)(lds + (bufoff) + ldsw + _i * 8192), 16, 0, 0); } while (0)
#define PG8_LDA(dst, b, h) do { _Pragma("unroll") for (int m = 0; m < 4; ++m) _Pragma("unroll") for (int k = 0; k < 2; ++k) dst[m][k] = *(const PG8_LAS bf16x8*)(lds + PG8_SA(b, h) + aoff + m * 2048 + k * 1024); } while (0)
#define PG8_LDB(dst, b, h) do { _Pragma("unroll") for (int n = 0; n < 2; ++n) _Pragma("unroll") for (int k = 0; k < 2; ++k) dst[n][k] = *(const PG8_LAS bf16x8*)(lds + PG8_SB(b, h) + boff + n * 2048 + k * 1024); } while (0)
#define PG8_MMA(ai, bj, At, Bt) do { __builtin_amdgcn_s_setprio(1); _Pragma("unroll") for (int m = 0; m < 4; ++m) _Pragma("unroll") for (int n = 0; n < 2; ++n) _Pragma("unroll") for (int k = 0; k < 2; ++k) \
        acc[ai][bj][m][n] = __builtin_amdgcn_mfma_f32_16x16x32_bf16(Bt[n][k], At[m][k], acc[ai][bj][m][n], 0, 0, 0); __builtin_amdgcn_s_setprio(0); } while (0)
#define PG8_WAIT_V(n) asm volatile("s_waitcnt vmcnt(" #n ")" ::: "memory")
#define PG8_WAIT_L(n) asm volatile("s_waitcnt lgkmcnt(" #n ")" ::: "memory")
#define PG8_BAR __builtin_amdgcn_s_barrier()
#define PG8_SCHED __builtin_amdgcn_sched_barrier(0)
    Unit cur, nxt; int ui = 0;
    if (!S.next(0, cur)) return;
    f32x4 acc[2][2][4][2];
#pragma unroll
    for (int a = 0; a < 2; ++a)
#pragma unroll
        for (int b = 0; b < 2; ++b)
#pragma unroll
            for (int m = 0; m < 4; ++m)
#pragma unroll
                for (int n = 0; n < 2; ++n) acc[a][b][m][n] = (f32x4){0.f, 0.f, 0.f, 0.f};
    bf16x8 At[4][2], B0[2][2], B1[2][2];
    const char* cA = (const char*)g.A + (size_t)cur.pm * tstepA; const char* cB = (const char*)g.Bt + (size_t)cur.pn * tstep;
    S.a_ready(cur);
    PG8_STAGE(PG8_SB(0, 0), cB, voffB); PG8_STAGE(PG8_SA(0, 0), cA, voffA); PG8_STAGE(PG8_SB(0, 1), cB + hstep, voffB); PG8_STAGE(PG8_SA(0, 1), cA + hstepA, voffA);
    if (wr == 1) PG8_BAR;
    PG8_WAIT_V(4); PG8_BAR;
    PG8_STAGE(PG8_SB(1, 0), cB + kstep, voffB); PG8_STAGE(PG8_SA(1, 0), cA + kstep, voffA); PG8_STAGE(PG8_SB(1, 1), cB + hstep + kstep, voffB);
    PG8_WAIT_V(6); PG8_BAR;
    PG8_STAMP();
    for (;;) {
        const bool has_next = S.next(ui + 1, nxt);
        const char* nA = has_next ? (const char*)g.A + (size_t)nxt.pm * tstepA : cA; const char* nB = has_next ? (const char*)g.Bt + (size_t)nxt.pn * tstep : cB;
        for (int t = 0; t < nt; t += 2) {
            const bool last = (t == nt - 2);
            const char* a1 = cA + (size_t)(t + 1) * kstep;
            const char* a2 = last ? nA : cA + (size_t)(t + 2) * kstep; const char* b2 = last ? nB : cB + (size_t)(t + 2) * kstep;
            const char* a3 = a2 + kstep; const char* b3 = b2 + kstep;
            if (last && has_next) S.a_ready(nxt);
            PG8_LDB(B0, 0, 0); PG8_SCHED; PG8_LDA(At, 0, 0); PG8_STAGE(PG8_SA(1, 1), a1 + hstepA, voffA);
            PG8_WAIT_L(8); PG8_BAR; PG8_WAIT_L(0); PG8_MMA(0, 0, At, B0); PG8_BAR; PG8_SCHED;
            PG8_LDB(B1, 0, 1); PG8_STAGE(PG8_SB(0, 0), b2, voffB);
            PG8_BAR; PG8_WAIT_L(0); PG8_MMA(0, 1, At, B1); PG8_BAR;
            PG8_LDA(At, 0, 1); PG8_STAGE(PG8_SA(0, 0), a2, voffA);
            PG8_BAR; PG8_WAIT_L(0); PG8_MMA(1, 0, At, B0); PG8_BAR; PG8_SCHED;
            PG8_STAGE(PG8_SB(0, 1), b2 + hstep, voffB);
            PG8_WAIT_V(6); PG8_BAR; PG8_MMA(1, 1, At, B1); PG8_BAR;
            PG8_LDB(B0, 1, 0); PG8_SCHED; PG8_LDA(At, 1, 0); PG8_STAGE(PG8_SA(0, 1), a2 + hstepA, voffA);
            PG8_WAIT_L(8); PG8_BAR; PG8_WAIT_L(0); PG8_MMA(0, 0, At, B0); PG8_BAR; PG8_SCHED;
            PG8_LDB(B1, 1, 1); PG8_STAGE(PG8_SB(1, 0), b3, voffB);
            PG8_BAR; PG8_WAIT_L(0); PG8_MMA(0, 1, At, B1); PG8_BAR;
            PG8_LDA(At, 1, 1); PG8_STAGE(PG8_SA(1, 0), a3, voffA);
            PG8_BAR; PG8_WAIT_L(0); PG8_MMA(1, 0, At, B0); PG8_BAR; PG8_SCHED;
            PG8_STAGE(PG8_SB(1, 1), b3 + hstep, voffB);
            PG8_WAIT_V(6); PG8_BAR; PG8_MMA(1, 1, At, B1); PG8_BAR;
        }
        PG8_STAMP();
        if constexpr (!Epi::AFTER_DRAIN) { E(acc, cur, wr, wc, fr, fq); S.done(cur); }
        PG8_STAMP();
        if (!has_next) break;
#pragma unroll
        for (int a = 0; a < 2; ++a)
#pragma unroll
            for (int b = 0; b < 2; ++b)
#pragma unroll
                for (int m = 0; m < 4; ++m)
#pragma unroll
                    for (int n = 0; n < 2; ++n) acc[a][b][m][n] = (f32x4){0.f, 0.f, 0.f, 0.f};
        cur = nxt; cA = nA; cB = nB; ++ui;
    }
    PG8_WAIT_V(0);
    if (wr == 0) PG8_BAR;
    PG8_BAR;
    if constexpr (Epi::AFTER_DRAIN) { E.fused(acc, cur, wr, wc, fr, fq, lds, wid, lane); S.done(cur); }
    PG8_STAMP();
    if (STAMP && wid == 0) { stamps[lane] = lane < nts ? (((unsigned long long)(unsigned)ts_hi << 32) | (unsigned)ts_lo) : 0ull;
        if (lane == 62) stamps[62] = rt_entry; if (lane == 63) stamps[63] = (unsigned long long)wall_clock64(); }
#undef PG8_STAMP
#undef PG8_SA
#undef PG8_SB
#undef PG8_STAGE
#undef PG8_LDA
#undef PG8_LDB
#undef PG8_MMA
#undef PG8_WAIT_V
#undef PG8_WAIT_L
#undef PG8_BAR
#undef PG8_SCHED
}
}
typedef unsigned short bf16_t;
constexpr int T_TOK = 32768, DM = 1024, D_IN = 4096, D_HY = 512, D_HG = 512, DFF = 4096, NLAYER = 4;
constexpr int L_BIG = 16384, L_SML = 4096;
constexpr int APAD = 256;
constexpr size_t MiB = 1024ull * 1024ull;
constexpr size_t OFF_W = 0;
constexpr size_t OFF_W_IN = OFF_W, OFF_W_OUT = OFF_W + 8 * MiB, OFF_W_UP = OFF_W + 10 * MiB, OFF_W_DN = OFF_W + 26 * MiB;
constexpr size_t OFF_ABUF = 34 * MiB;
constexpr size_t OFF_R1 = 99 * MiB;
constexpr size_t OFF_HYRAW = OFF_R1;
constexpr size_t OFF_HG = OFF_R1 + 96 * MiB;
constexpr size_t OFF_KT = OFF_R1;
constexpr size_t OFF_ACT = OFF_R1;
constexpr size_t OFF_R2 = 355 * MiB;
constexpr size_t OFF_X0T = OFF_R2, OFF_ZT = OFF_R2 + 32 * MiB;
constexpr size_t OFF_MIX = OFF_R2;
constexpr size_t OFF_UPART = OFF_R2;
constexpr size_t OFF_R6 = 419 * MiB;
constexpr size_t OFF_OBUF = OFF_R6;
constexpr size_t OFF_KS = OFF_R6;
constexpr size_t OFF_SMALL = 483 * MiB;
constexpr size_t OFF_BAR = OFF_SMALL + 4 * MiB;
constexpr size_t OFF_W4T = OFF_SMALL + 8 * MiB;
constexpr size_t WS_NEED = 492 * MiB;

struct P { const float* in[26]; float* out; unsigned char* ws; };
constexpr int PB_norm_mix_pre = 0;
constexpr int PB_norm_mix_post = 4096;
constexpr int PB_norm_ffn_pre = 8192;
constexpr int PB_norm_ffn_post = 12288;
constexpr int PB_hy_conv_w = 16384;
constexpr int PB_hy_conv_b = 34816;
constexpr int PB_f_w1 = 40960;
constexpr int PB_f_b1 = 49408;
constexpr int PB_f_w2 = 49664;
constexpr int PB_f_b2 = 66048;
constexpr int PB_f_w3 = 66304;
constexpr int PB_f_b3 = 82688;
constexpr int PB_f_w4 = 82944;
constexpr int PB_f_freq = 345088;
constexpr int PB_hy_skip = 345344;
constexpr int PB_hy_out_norm = 347392;
constexpr int PB_lb_table = 349440;
constexpr int PB_hg_out_norm = 353536;
constexpr int PB_ffn_conv_w = 355584;
constexpr int PB_ffn_conv_b = 453888;
constexpr int PB_TOTAL = 486656;
constexpr size_t OFF_PB = OFF_SMALL + 512 * 1024;
#define PRM(p, NAME) ((const float*)((p).ws + OFF_PB) + PB_##NAME)

__device__ __forceinline__ float bf2f(bf16_t b) { return __uint_as_float(((unsigned)b) << 16); }
__device__ __forceinline__ bf16_t f2bf(float f) { unsigned u = __float_as_uint(f); u += 0x7FFFu + ((u >> 16) & 1u); return (bf16_t)(u >> 16); }
__device__ __forceinline__ unsigned pack_bf2(float lo, float hi) { return (unsigned)f2bf(lo) | ((unsigned)f2bf(hi) << 16); }
__device__ __forceinline__ bool seq_start(int t) { return t < L_BIG ? (t == 0) : ((t & (L_SML - 1)) == 0); }
__device__ __forceinline__ bool seq_end(int t) { return (t + 1 == T_TOK) || seq_start(t + 1); }
__device__ __forceinline__ const float* x_src_row(const P& p, int l, int t) {
    if (l > 0) return p.out + (size_t)t * DM;
    return t < L_BIG ? p.in[0] + (size_t)t * DM : p.in[1] + (size_t)(t - L_BIG) * DM;
}
__device__ __forceinline__ float silu_f(float x) { return x / (1.0f + __expf(-x)); }
__device__ __forceinline__ float wave_sum(float v) {
#pragma unroll
    for (int o = 32; o >= 1; o >>= 1) v += __shfl_xor(v, o);
    return v;
}

struct EpiBf16Split {
    static constexpr bool PERM = true, AFTER_DRAIN = false, OVL = false;
    bf16_t* O0; int ldc0; bf16_t* O1; int ldc1; int csplit;
    __device__ __forceinline__ void operator()(const pg8::f32x4 (&acc)[2][2][4][2], const pg8::Unit& u, int wr, int wc, int fr, int fq) const {
        const int row0 = u.pm * pg8::BM + wr * 64 + fr; int colt = u.pn * pg8::BM; bf16_t* base = O0; int ldc = ldc0;
        if (colt >= csplit) { base = O1; ldc = ldc1; colt -= csplit; }
        const int col0 = colt + wc * 32 + 8 * fq;
#pragma unroll
        for (int ai = 0; ai < 2; ++ai)
#pragma unroll
            for (int m = 0; m < 4; ++m) { bf16_t* rowp = base + (size_t)(row0 + ai * pg8::HALF + m * 16) * ldc + col0;
#pragma unroll
                for (int bj = 0; bj < 2; ++bj) { const pg8::f32x4 v0 = acc[ai][bj][m][0], v1 = acc[ai][bj][m][1];
                    pg8::u32x4 w; w.x = pg8::cvt_pk_bf16(v0[0], v0[1]); w.y = pg8::cvt_pk_bf16(v0[2], v0[3]); w.z = pg8::cvt_pk_bf16(v1[0], v1[1]); w.w = pg8::cvt_pk_bf16(v1[2], v1[3]);
                    *(pg8::u32x4*)(rowp + bj * pg8::HALF) = w; } }
    }
};
__device__ __forceinline__ float dpp_ror1(float v) { return __int_as_float(__builtin_amdgcn_update_dpp(0, __float_as_int(v), 0x121, 0xF, 0xF, false)); }
__device__ __forceinline__ float dpp_ror15(float v) { return __int_as_float(__builtin_amdgcn_update_dpp(0, __float_as_int(v), 0x12F, 0xF, 0xF, false)); }
__device__ __forceinline__ float gelu_tanh_e(float x) { const float y = 1.5957691216057308f * (x + 0.044715f * x * x * x); return x * __builtin_amdgcn_rcpf(1.0f + __expf(-y)); }
struct EpiGeglu {
    static constexpr bool PERM = true, AFTER_DRAIN = false, OVL = true;
    bf16_t* act; const float* cw; const float* cb;
    __device__ __forceinline__ void operator()(const pg8::f32x4 (&acc)[2][2][4][2], const pg8::Unit& u, int wr, int wc, int fr, int fq) const {
        const int j0 = u.pn * 128 + wc * 32 + 8 * fq;
        unsigned mprev = 0, mnext = 0, mst = 0;
#pragma unroll
        for (int ai = 0; ai < 2; ++ai)
#pragma unroll
            for (int m = 0; m < 4; ++m) { const int q = 16 * m + fr, tok = u.pm * 248 + 124 * ai + 62 * wr + q - 1, b = ai * 4 + m;
                const bool st = q >= 1 && q <= 62 && tok < T_TOK;
                if (st) { mst |= 1u << b; if (!seq_start(tok)) mprev |= 1u << b; if (!seq_end(tok)) mnext |= 1u << b; } }
#pragma unroll
        for (int n = 0; n < 2; ++n) {
            const int jc = j0 + 4 * n;
            const pg8::f32x4 wa0 = *(const pg8::f32x4*)(cw + jc), wa1 = *(const pg8::f32x4*)(cw + 8192 + jc), wa2 = *(const pg8::f32x4*)(cw + 16384 + jc), ba = *(const pg8::f32x4*)(cb + jc);
            const pg8::f32x4 wb0 = *(const pg8::f32x4*)(cw + 4096 + jc), wb1 = *(const pg8::f32x4*)(cw + 8192 + 4096 + jc), wb2 = *(const pg8::f32x4*)(cw + 16384 + 4096 + jc), bb = *(const pg8::f32x4*)(cb + 4096 + jc);
#pragma unroll
            for (int ai = 0; ai < 2; ++ai) {
                pg8::f32x4 pa_prev, pb_prev, na_cur, nb_cur;
#pragma unroll
                for (int i = 0; i < 4; ++i) { na_cur[i] = dpp_ror15(acc[ai][0][0][n][i]); nb_cur[i] = dpp_ror15(acc[ai][1][0][n][i]); pa_prev[i] = 0.f; pb_prev[i] = 0.f; }
#pragma unroll
                for (int m = 0; m < 4; ++m) {
                    const int b = ai * 4 + m, q = 16 * m + fr, tok = u.pm * 248 + 124 * ai + 62 * wr + q - 1;
                    const bool hp = (mprev >> b) & 1u, hn = (mnext >> b) & 1u;
                    pg8::f32x4 pa_cur, pb_cur, na_next, nb_next;
#pragma unroll
                    for (int i = 0; i < 4; ++i) { pa_cur[i] = dpp_ror1(acc[ai][0][m][n][i]); pb_cur[i] = dpp_ror1(acc[ai][1][m][n][i]);
                        na_next[i] = m < 3 ? dpp_ror15(acc[ai][0][m < 3 ? m + 1 : 3][n][i]) : 0.f; nb_next[i] = m < 3 ? dpp_ror15(acc[ai][1][m < 3 ? m + 1 : 3][n][i]) : 0.f; }
                    const pg8::f32x4 xpa = (fr == 0) ? pa_prev : pa_cur, xna = (fr == 15) ? na_next : na_cur;
                    const pg8::f32x4 xpb = (fr == 0) ? pb_prev : pb_cur, xnb = (fr == 15) ? nb_next : nb_cur;
                    const pg8::f32x4 xa = acc[ai][0][m][n], xb = acc[ai][1][m][n];
                    float o[4];
#pragma unroll
                    for (int i = 0; i < 4; ++i) {
                        const float ya = (hp ? xpa[i] * wa0[i] : 0.f) + xa[i] * wa1[i] + (hn ? xna[i] * wa2[i] : 0.f) + ba[i];
                        const float yb = (hp ? xpb[i] * wb0[i] : 0.f) + xb[i] * wb1[i] + (hn ? xnb[i] * wb2[i] : 0.f) + bb[i];
                        o[i] = gelu_tanh_e(ya) * yb;
                    }
                    if ((mst >> b) & 1u) { uint2 w; w.x = pg8::cvt_pk_bf16(o[0], o[1]); w.y = pg8::cvt_pk_bf16(o[2], o[3]); *(uint2*)(act + (size_t)tok * DFF + jc) = w; }
                    pa_prev = pa_cur; pb_prev = pb_cur; na_cur = na_next; nb_cur = nb_next;
                }
            }
        }
    }
};
template <class Epi>
__device__ __forceinline__ void run_gemm(LAS unsigned char* lds, const bf16_t* A, const bf16_t* Bt, int M, int N, int K, const Epi& E) {
    pg8::Gemm g; g.A = A; g.Bt = Bt; g.M = M; g.N = N; g.K = K; g.ovl = Epi::OVL ? 1 : 0;
    int gx = (int)gridDim.x, bx = (int)blockIdx.x; asm volatile("" : "+s"(gx), "+s"(bx));
    pg8::StaticOrder S; S.init(M, N, gx, bx);
    pg8::gemm_phase<Epi, pg8::StaticOrder, false>((PG8_LAS unsigned char*)lds, g, S, E, nullptr);
}

#define HD_INLINE __device__ __forceinline__
#define DEV_FN __device__ __forceinline__
#define LDS_F2 LAS cf2*
#define NTHR 512
#define PADI(i) ((i) + ((i) >> 5))
#define FOR_TID for (int tid = (int)TIDX, once_ = 1; once_; once_ = 0)
#define SYNC __syncthreads()
#define BREV32(x) __brev(x)
#define CIS_REV(fr, c, s) do { const float f_ = (fr); c = __builtin_amdgcn_cosf(f_); s = __builtin_amdgcn_sinf(f_); } while (0)
HD_INLINE unsigned rev4(unsigned k, int S) {
    unsigned v = BREV32(k) >> (32 - 2 * S);
    return ((v & 0xAAAAAAAAu) >> 1) | ((v & 0x55555555u) << 1);
}
HD_INLINE cf2 mkf2(float a, float b) { cf2 r; r.x = a; r.y = b; return r; }
HD_INLINE cf2 cmul(cf2 a, cf2 b) { return mkf2(a.x * b.x - a.y * b.y, a.x * b.y + a.y * b.x); }
HD_INLINE cf2 cmulc(cf2 a, cf2 b) { return mkf2(a.x * b.x + a.y * b.y, a.y * b.x - a.x * b.y); }

HD_INLINE void bf4_fwd(cf2& a0, cf2& a1, cf2& a2, cf2& a3) {
    const cf2 t0 = a0 + a2, t1 = a0 - a2, t2 = a1 + a3, d = a1 - a3; const cf2 t3 = mkf2(d.y, -d.x);
    a0 = t0 + t2; a1 = t1 + t3; a2 = t0 - t2; a3 = t1 - t3;
}
HD_INLINE void bf4_inv(cf2& b0, cf2& b1, cf2& b2, cf2& b3) {
    const cf2 t0 = b0 + b2, t1 = b0 - b2, t2 = b1 + b3, d = b1 - b3; const cf2 t3 = mkf2(-d.y, d.x);
    b0 = t0 + t2; b1 = t1 + t3; b2 = t0 - t2; b3 = t1 - t3;
}
#define W16C(k) ((k) == 0 ? 1.0f : (k) == 1 ? 0.9238795325112867f : (k) == 2 ? 0.7071067811865476f : (k) == 3 ? 0.3826834323650898f : (k) == 4 ? 0.0f : (k) == 6 ? -0.7071067811865476f :   -0.9238795325112867f)
#define W16S(k) ((k) == 0 ? 0.0f : (k) == 1 ? 0.3826834323650898f : (k) == 2 ? 0.7071067811865476f : (k) == 3 ? 0.9238795325112867f : (k) == 4 ? 1.0f : (k) == 6 ? 0.7071067811865476f :   -0.3826834323650898f)
template <int S, int NSEQ, bool ZIN = false>
DEV_FN void fft_fwd2(LDS_F2 X) {
    constexpr int M = 1 << (2 * S), MP = M + (M >> 5), NG = NSEQ * (M >> 4);
#pragma unroll 1
    for (int pr = 0; pr < S / 2; ++pr) {
        const int s = 2 * pr, n = M >> (2 * s), q = n >> 2, q2 = q >> 2;
        const float invn = 1.0f / (float)n;
        FOR_TID {
#pragma unroll 2
            for (int gi = tid; gi < NG; gi += NTHR) {
                const int seq = gi / (M >> 4), g = gi - seq * (M >> 4), j2 = g & (q2 - 1), base = ((g - j2) << 4) + j2;
                LDS_F2 Xs = X + seq * MP;
                cf2 a[4][4];
#pragma unroll
                for (int r = 0; r < 4; ++r)
#pragma unroll
                    for (int r2 = 0; r2 < 4; ++r2) a[r][r2] = (ZIN && pr == 0 && r >= 2) ? mkf2(0.f, 0.f) : Xs[PADI(base + r * q + r2 * q2)];
                float c1, s1; CIS_REV((float)j2 * invn, c1, s1);
                const cf2 t1 = mkf2(c1, -s1), t2 = cmul(t1, t1), t3 = cmul(t2, t1), t4 = cmul(t2, t2), t8 = cmul(t4, t4), t12 = cmul(t8, t4);
#pragma unroll
                for (int r2 = 0; r2 < 4; ++r2) {
                    bf4_fwd(a[0][r2], a[1][r2], a[2][r2], a[3][r2]);
                    a[1][r2] = cmul(a[1][r2], cmul(t1, mkf2(W16C(r2), -W16S(r2))));
                    a[2][r2] = cmul(a[2][r2], cmul(t2, mkf2(W16C(2 * r2), -W16S(2 * r2))));
                    a[3][r2] = cmul(a[3][r2], cmul(t3, mkf2(W16C(3 * r2), -W16S(3 * r2))));
                }
#pragma unroll
                for (int r = 0; r < 4; ++r) {
                    bf4_fwd(a[r][0], a[r][1], a[r][2], a[r][3]);
                    a[r][1] = cmul(a[r][1], t4); a[r][2] = cmul(a[r][2], t8); a[r][3] = cmul(a[r][3], t12);
                }
#pragma unroll
                for (int r = 0; r < 4; ++r)
#pragma unroll
                    for (int r2 = 0; r2 < 4; ++r2) Xs[PADI(base + r * q + r2 * q2)] = a[r][r2];
            }
        }
        SYNC;
    }
    if (S & 1) {
        FOR_TID {
#pragma unroll 4
            for (int gi = tid; gi < NSEQ * (M >> 2); gi += NTHR) {
                const int seq = gi / (M >> 2), b = gi - seq * (M >> 2);
                LDS_F2 Xs = X + seq * MP;
                cf2 a0 = Xs[PADI(4 * b)], a1 = Xs[PADI(4 * b + 1)], a2 = Xs[PADI(4 * b + 2)], a3 = Xs[PADI(4 * b + 3)];
                bf4_fwd(a0, a1, a2, a3);
                Xs[PADI(4 * b)] = a0; Xs[PADI(4 * b + 1)] = a1; Xs[PADI(4 * b + 2)] = a2; Xs[PADI(4 * b + 3)] = a3;
            }
        }
        SYNC;
    }
}
template <int S, int NSEQ, bool HOUT = false>
DEV_FN void fft_inv2(LDS_F2 X) {
    constexpr int M = 1 << (2 * S), MP = M + (M >> 5), NG = NSEQ * (M >> 4);
    if (S & 1) {
        FOR_TID {
#pragma unroll 4
            for (int gi = tid; gi < NSEQ * (M >> 2); gi += NTHR) {
                const int seq = gi / (M >> 2), b = gi - seq * (M >> 2);
                LDS_F2 Xs = X + seq * MP;
                cf2 a0 = Xs[PADI(4 * b)], a1 = Xs[PADI(4 * b + 1)], a2 = Xs[PADI(4 * b + 2)], a3 = Xs[PADI(4 * b + 3)];
                bf4_inv(a0, a1, a2, a3);
                Xs[PADI(4 * b)] = a0; Xs[PADI(4 * b + 1)] = a1; Xs[PADI(4 * b + 2)] = a2; Xs[PADI(4 * b + 3)] = a3;
            }
        }
        SYNC;
    }
#pragma unroll 1
    for (int pr = S / 2 - 1; pr >= 0; --pr) {
        const int s = 2 * pr, n = M >> (2 * s), q = n >> 2, q2 = q >> 2;
        const float invn = 1.0f / (float)n;
        FOR_TID {
#pragma unroll 2
            for (int gi = tid; gi < NG; gi += NTHR) {
                const int seq = gi / (M >> 4), g = gi - seq * (M >> 4), j2 = g & (q2 - 1), base = ((g - j2) << 4) + j2;
                LDS_F2 Xs = X + seq * MP;
                cf2 a[4][4];
#pragma unroll
                for (int r = 0; r < 4; ++r)
#pragma unroll
                    for (int r2 = 0; r2 < 4; ++r2) a[r][r2] = Xs[PADI(base + r * q + r2 * q2)];
                float c1, s1; CIS_REV((float)j2 * invn, c1, s1);
                const cf2 t1 = mkf2(c1, s1), t2 = cmul(t1, t1), t3 = cmul(t2, t1), t4 = cmul(t2, t2), t8 = cmul(t4, t4), t12 = cmul(t8, t4);
#pragma unroll
                for (int r = 0; r < 4; ++r) {
                    a[r][1] = cmul(a[r][1], t4); a[r][2] = cmul(a[r][2], t8); a[r][3] = cmul(a[r][3], t12);
                    bf4_inv(a[r][0], a[r][1], a[r][2], a[r][3]);
                }
#pragma unroll
                for (int r2 = 0; r2 < 4; ++r2) {
                    a[1][r2] = cmul(a[1][r2], cmul(t1, mkf2(W16C(r2), W16S(r2))));
                    a[2][r2] = cmul(a[2][r2], cmul(t2, mkf2(W16C(2 * r2), W16S(2 * r2))));
                    a[3][r2] = cmul(a[3][r2], cmul(t3, mkf2(W16C(3 * r2), W16S(3 * r2))));
                    bf4_inv(a[0][r2], a[1][r2], a[2][r2], a[3][r2]);
                }
#pragma unroll
                for (int r = 0; r < 4; ++r)
#pragma unroll
                    for (int r2 = 0; r2 < 4; ++r2) if (!(HOUT && pr == 0 && r >= 2)) Xs[PADI(base + r * q + r2 * q2)] = a[r][r2];
            }
        }
        SYNC;
    }
}
DEV_FN void spec_store(LDS_F2 X, int S, cf2* Kp) {
    const int M = 1 << (2 * S);
    FOR_TID {
        for (int pp = tid; pp < (M >> 1); pp += NTHR) {
            const int p = ((pp >> 1) << 2) + (pp & 1);
            if (p == 0) {
                const cf2 c0 = X[PADI(0)]; Kp[0] = mkf2(c0.x + c0.y, c0.x - c0.y);
                const cf2 ch = X[PADI(2)]; Kp[2] = mkf2(ch.x, -ch.y);
            } else {
                const unsigned k = rev4((unsigned)p, S), pm = rev4((unsigned)(M - (int)k), S);
                const cf2 ck = X[PADI(p)], cm = X[PADI((int)pm)];
                const cf2 P = mkf2(0.5f * (ck.x + cm.x), 0.5f * (ck.y - cm.y));
                const cf2 O = mkf2(0.5f * (ck.y + cm.y), -0.5f * (ck.x - cm.x));
                float c, s; CIS_REV((float)k / (float)(2 * M), c, s);
                const cf2 Q = cmul(O, mkf2(c, -s));
                Kp[p] = mkf2(P.x + Q.x, P.y + Q.y);
                Kp[pm] = mkf2(P.x - Q.x, -(P.y - Q.y));
            }
        }
    }
    SYNC;
}
DEV_FN void spec_mul(LDS_F2 X0, int S, const cf2* Kp, int nseq = 1) {
    const int M = 1 << (2 * S);
    FOR_TID {
        for (int pq = tid; pq < nseq * (M >> 1); pq += NTHR) {
            const int sq_ = pq / (M >> 1), pp = pq - sq_ * (M >> 1);
            LDS_F2 X = X0 + sq_ * (M + (M >> 5));
            const int p = ((pp >> 1) << 2) + (pp & 1);
            if (p == 0) {
                const cf2 c0 = X[PADI(0)], k0 = Kp[0];
                const float y0 = (c0.x + c0.y) * k0.x, ym = (c0.x - c0.y) * k0.y;
                X[PADI(0)] = mkf2(0.5f * (y0 + ym), 0.5f * (y0 - ym));
                const cf2 ch = X[PADI(2)], kh = Kp[2];
                const cf2 yh = cmul(mkf2(ch.x, -ch.y), kh);
                X[PADI(2)] = mkf2(yh.x, -yh.y);
            } else {
                const unsigned k = rev4((unsigned)p, S), pm = rev4((unsigned)(M - (int)k), S);
                const cf2 ck = X[PADI(p)], cm = X[PADI((int)pm)];
                const cf2 P = mkf2(0.5f * (ck.x + cm.x), 0.5f * (ck.y - cm.y));
                const cf2 O = mkf2(0.5f * (ck.y + cm.y), -0.5f * (ck.x - cm.x));
                float c, s; CIS_REV((float)k / (float)(2 * M), c, s);
                const cf2 Wk = mkf2(c, -s);
                const cf2 Q = cmul(O, Wk);
                const cf2 xk = mkf2(P.x + Q.x, P.y + Q.y), xm = mkf2(P.x - Q.x, -(P.y - Q.y));
                const cf2 yk = cmul(xk, Kp[p]), ym = cmul(xm, Kp[pm]);
                const cf2 Ye = mkf2(0.5f * (yk.x + ym.x), 0.5f * (yk.y - ym.y));
                const cf2 Yd = mkf2(0.5f * (yk.x - ym.x), 0.5f * (yk.y + ym.y));
                const cf2 Yo = cmulc(Yd, Wk);
                X[PADI(p)] = mkf2(Ye.x - Yo.y, Ye.y + Yo.x);
                X[PADI((int)pm)] = mkf2(Ye.x + Yo.y, -Ye.y + Yo.x);
            }
        }
    }
    SYNC;
}
__device__ void ph_setup(const P& p) {
    const int gid = blockIdx.x * 512 + TIDX;
    if (gid < 2 * D_HG) {
        const int dir = gid / D_HG, c = gid % D_HG;
        float v[NLAYER], mx = -1e30f;
#pragma unroll
        for (int l = 0; l < NLAYER; ++l) { v[l] = p.in[19][(size_t)(dir * NLAYER + l) * D_HG + c]; mx = fmaxf(mx, v[l]); }
        float s = 0.f;
#pragma unroll
        for (int l = 0; l < NLAYER; ++l) { v[l] = expf(v[l] - mx); s += v[l]; }
        float* lbs = (float*)(p.ws + OFF_SMALL);
        float cum = 0.f;
#pragma unroll
        for (int l = 0; l < NLAYER; ++l) { if (l > 0) cum += v[l] / s; lbs[(size_t)(dir * NLAYER + l) * D_HG + c] = cum; }
    }
}
__device__ void ph_copy_params(const P& p) {
    float* pb = (float*)(p.ws + OFF_PB);
    const int g = blockIdx.x * 512 + TIDX, gs = gridDim.x * 512;
    for (int k = g; k < 4096; k += gs) pb[0 + k] = p.in[2][k];
    for (int k = g; k < 4096; k += gs) pb[4096 + k] = p.in[3][k];
    for (int k = g; k < 4096; k += gs) pb[8192 + k] = p.in[4][k];
    for (int k = g; k < 4096; k += gs) pb[12288 + k] = p.in[5][k];
    for (int k = g; k < 18432; k += gs) pb[16384 + k] = p.in[7][k];
    for (int k = g; k < 6144; k += gs) pb[34816 + k] = p.in[8][k];
    for (int k = g; k < 8448; k += gs) pb[40960 + k] = p.in[9][k];
    for (int k = g; k < 256; k += gs) pb[49408 + k] = p.in[10][k];
    for (int k = g; k < 16384; k += gs) pb[49664 + k] = p.in[11][k];
    for (int k = g; k < 256; k += gs) pb[66048 + k] = p.in[12][k];
    for (int k = g; k < 16384; k += gs) pb[66304 + k] = p.in[13][k];
    for (int k = g; k < 256; k += gs) pb[82688 + k] = p.in[14][k];
    for (int k = g; k < 262144; k += gs) pb[82944 + k] = p.in[15][k];
    for (int k = g; k < 256; k += gs) pb[345088 + k] = p.in[16][k];
    for (int k = g; k < 2048; k += gs) pb[345344 + k] = p.in[17][k];
    for (int k = g; k < 2048; k += gs) pb[347392 + k] = p.in[18][k];
    for (int k = g; k < 4096; k += gs) pb[349440 + k] = p.in[19][k];
    for (int k = g; k < 2048; k += gs) pb[353536 + k] = p.in[20][k];
    for (int k = g; k < 98304; k += gs) pb[355584 + k] = p.in[23][k];
    for (int k = g; k < 32768; k += gs) pb[453888 + k] = p.in[24][k];
}
__device__ void convert_one(const float* src, bf16_t* dst, int K, int N, LAS float* tile  , bool geglu_perm = false) {
    const int tiles_n = N / 64, ntiles = (K / 64) * tiles_n, tid = TIDX;
    for (int it = blockIdx.x; it < ntiles; it += gridDim.x) {
        const int k0 = (it / tiles_n) * 64, n0 = (it % tiles_n) * 64;
#pragma unroll
        for (int i = 0; i < 2; ++i) { const int r = (tid >> 4) + 32 * i, c4 = (tid & 15) * 4;
            const nf4 v = *(const nf4*)(src + (size_t)(k0 + r) * N + n0 + c4);
            tile[r * 65 + c4] = v.x; tile[r * 65 + c4 + 1] = v.y; tile[r * 65 + c4 + 2] = v.z; tile[r * 65 + c4 + 3] = v.w; }
        __syncthreads();
        { const int n = tid >> 3, ks = (tid & 7) * 8; int nr = n0 + n;
          if (geglu_perm) nr = nr < DFF ? (nr >> 7) * 256 + (nr & 127) : ((nr - DFF) >> 7) * 256 + 128 + ((nr - DFF) & 127);
          nu4 w;
          w.x = pack_bf2(tile[(ks + 0) * 65 + n], tile[(ks + 1) * 65 + n]); w.y = pack_bf2(tile[(ks + 2) * 65 + n], tile[(ks + 3) * 65 + n]);
          w.z = pack_bf2(tile[(ks + 4) * 65 + n], tile[(ks + 5) * 65 + n]); w.w = pack_bf2(tile[(ks + 6) * 65 + n], tile[(ks + 7) * 65 + n]);
          *(nu4*)(dst + (size_t)nr * K + k0 + ks) = w; }
        __syncthreads();
    }
}
__device__ void ph_convert_w(const P& p, int l, LAS unsigned char* lds) {
    LAS float* tile = (LAS float*)lds;
    convert_one(p.in[6] + (size_t)l * DM * D_IN, (bf16_t*)(p.ws + OFF_W_IN), DM, D_IN, tile);
    convert_one(p.in[21] + (size_t)l * DM * DM, (bf16_t*)(p.ws + OFF_W_OUT), DM, DM, tile);
    convert_one(p.in[22] + (size_t)l * DM * 2 * DFF, (bf16_t*)(p.ws + OFF_W_UP), DM, 2 * DFF, tile, true);
    convert_one(p.in[25] + (size_t)l * DFF * DM, (bf16_t*)(p.ws + OFF_W_DN), DFF, DM, tile);
    { const float* w4 = p.in[15] + (size_t)l * 64 * 1024; bf16_t* w4t = (bf16_t*)(p.ws + OFF_W4T);
      for (int idx = blockIdx.x * 512 + TIDX; idx < 65536; idx += gridDim.x * 512) { const int o = idx >> 6, f = idx & 63; w4t[idx] = f2bf(w4[f * 1024 + o]); } }
}
__device__ __forceinline__ bf16_t* abuf_row(const P& p, int t) { return (bf16_t*)(p.ws + OFF_ABUF) + (size_t)(t + APAD) * DM; }
__device__ void ph_rmsnorm_in(const P& p, int l) {
    const int lane = TIDX & 63, wv = TIDX >> 6;
    const float* gain = p.in[2] + (size_t)l * DM;
    for (int t = blockIdx.x * 8 + wv; t < T_TOK; t += gridDim.x * 8) {
        const float* xr = x_src_row(p, l, t);
        float4 v[4]; float ss = 0.f;
#pragma unroll
        for (int i = 0; i < 4; ++i) { v[i] = *(const float4*)(xr + lane * 4 + 256 * i); ss += v[i].x * v[i].x + v[i].y * v[i].y + v[i].z * v[i].z + v[i].w * v[i].w; }
        ss = wave_sum(ss);
        const float r = rsqrtf(ss * (1.0f / DM) + 1e-6f);
        bf16_t* hr = abuf_row(p, t);
#pragma unroll
        for (int i = 0; i < 4; ++i) { const float4 g = *(const float4*)(gain + lane * 4 + 256 * i);
            uint2 w; w.x = pack_bf2(v[i].x * r * g.x, v[i].y * r * g.y); w.y = pack_bf2(v[i].z * r * g.z, v[i].w * r * g.w);
            *(uint2*)(hr + lane * 4 + 256 * i) = w; }
    }
}
constexpr int NRR = 4;
__device__ void ph_norm_resid(const P& p, int l, int which) {
    const int lane = TIDX & 63, wv = TIDX >> 6;
    const float* gpost = (which == 0 ? PRM(p, norm_mix_post) : PRM(p, norm_ffn_post)) + (size_t)l * DM;
    const bool has_next = (which == 0) || (l + 1 < NLAYER);
    const float* gnext = which == 0 ? PRM(p, norm_ffn_pre) + (size_t)l * DM : PRM(p, norm_mix_pre) + (size_t)(has_next ? l + 1 : l) * DM;
    const bf16_t* Y = (const bf16_t*)(p.ws + OFF_MIX);
    const int lx = which == 0 ? l : 1;
    nf4 gp[4], gn[4];
#pragma unroll
    for (int i = 0; i < 4; ++i) { gp[i] = *(const nf4*)(gpost + lane * 4 + 256 * i); gn[i] = *(const nf4*)(gnext + lane * 4 + 256 * i); }
    for (int t0 = (blockIdx.x * 8 + wv) * NRR; t0 < T_TOK; t0 += gridDim.x * 8 * NRR) {
        nf4 x[NRR][4]; nu2 yw[NRR][4];
#pragma unroll
        for (int rr = 0; rr < NRR; ++rr) { const float* xr = x_src_row(p, lx, t0 + rr); const bf16_t* yr = Y + (size_t)(t0 + rr) * DM;
#pragma unroll
            for (int i = 0; i < 4; ++i) { x[rr][i] = *(const nf4*)(xr + lane * 4 + 256 * i); yw[rr][i] = *(const nu2*)(yr + lane * 4 + 256 * i); } }
#pragma unroll
        for (int rr = 0; rr < NRR; ++rr) {
            const int t = t0 + rr;
            nf4 y[4]; float ss = 0.f;
#pragma unroll
            for (int i = 0; i < 4; ++i) { const nu2 w = yw[rr][i];
                y[i].x = __uint_as_float(w.x << 16); y[i].y = __uint_as_float(w.x & 0xffff0000u); y[i].z = __uint_as_float(w.y << 16); y[i].w = __uint_as_float(w.y & 0xffff0000u);
                ss += y[i].x * y[i].x + y[i].y * y[i].y + y[i].z * y[i].z + y[i].w * y[i].w; }
            ss = wave_sum(ss);
            const float r = rsqrtf(ss * (1.0f / DM) + 1e-6f);
            float s2 = 0.f;
#pragma unroll
            for (int i = 0; i < 4; ++i) { nf4 xv = x[rr][i];
                xv.x += y[i].x * r * gp[i].x; xv.y += y[i].y * r * gp[i].y; xv.z += y[i].z * r * gp[i].z; xv.w += y[i].w * r * gp[i].w;
                s2 += xv.x * xv.x + xv.y * xv.y + xv.z * xv.z + xv.w * xv.w;
                x[rr][i] = xv;
                *(nf4*)(p.out + (size_t)t * DM + lane * 4 + 256 * i) = xv; }
            if (has_next) {
                s2 = wave_sum(s2);
                const float r2 = rsqrtf(s2 * (1.0f / DM) + 1e-6f);
                bf16_t* hr = abuf_row(p, t);
#pragma unroll
                for (int i = 0; i < 4; ++i) { const nf4 xv = x[rr][i];
                    nu2 w; w.x = pack_bf2(xv.x * r2 * gn[i].x, xv.y * r2 * gn[i].y); w.y = pack_bf2(xv.z * r2 * gn[i].z, xv.w * r2 * gn[i].w);
                    *(nu2*)(hr + lane * 4 + 256 * i) = w; }
            }
        }
    }
}
__device__ void ph_filter(const P& p, int l, LAS unsigned char* lds) {
    LAS float* feats = (LAS float*)lds;
    LAS float* ha = feats + 16 * 36;
    LAS float* hb = ha + 16 * 64;
    LAS float* w1s = hb + 16 * 64;
    LAS float* w2s = w1s + 33 * 64;
    LAS float* w3s = w2s + 64 * 64;
    LAS bf16_t* h3b = (LAS bf16_t*)(w3s + 64 * 64);
    const int tid = TIDX;
    const float* w1 = PRM(p, f_w1) + (size_t)l * 33 * 64; const float* b1 = PRM(p, f_b1) + (size_t)l * 64;
    const float* w2 = PRM(p, f_w2) + (size_t)l * 64 * 64; const float* b2 = PRM(p, f_b2) + (size_t)l * 64;
    const float* w3 = PRM(p, f_w3) + (size_t)l * 64 * 64; const float* b3 = PRM(p, f_b3) + (size_t)l * 64;
    const float* w4 = PRM(p, f_w4) + (size_t)l * 64 * 1024; const float* fq = PRM(p, f_freq) + (size_t)l * 64;
    float* kt = (float*)(p.ws + OFF_KT);
    for (int i = tid; i < 33 * 64; i += 512) w1s[i] = w1[i];
    for (int i = tid; i < 64 * 64; i += 512) { w2s[i] = w2[i]; w3s[i] = w3[i]; }
    const int j = tid & 63;
    const float fqj = fq[j], b1j = b1[j], b2j = b2[j], b3j = b3[j];
    pg8::bf16x8 bfrag[8][2];
    { const bf16_t* w4t = (const bf16_t*)(p.ws + OFF_W4T); const int lane = tid & 63, w = tid >> 6;
#pragma unroll
      for (int nt = 0; nt < 8; ++nt)
#pragma unroll
          for (int ks = 0; ks < 2; ++ks) bfrag[nt][ks] = *(const pg8::bf16x8*)(w4t + (size_t)(128 * w + 16 * nt + (lane & 15)) * 64 + 32 * ks + 8 * (lane >> 4)); }
    __syncthreads();
    const int nitems = (L_BIG + L_SML) / 16;
    for (int it = blockIdx.x; it < nitems; it += gridDim.x) {
        const bool big = it < L_BIG / 16; const int L = big ? L_BIG : L_SML; const int pos0 = (big ? it : it - L_BIG / 16) * 16;
        float* ktc = kt + (big ? 0 : (size_t)512 * 2 * L_BIG);
        for (int idx = tid; idx < 16 * 33; idx += 512) {
            const int pp = idx / 33, f = idx % 33; const int pos = pos0 + pp;
            const float tt = (float)pos / (float)(L - 1), ang = (6.283185307179586f / (float)L) * (float)pos;
            float v;
            if (f == 0) v = tt;
            else { const int bi = (f - 1) & 15; const float band = 1e-4f + (float)bi * ((15.0f - 1e-4f) / 15.0f); v = f <= 16 ? cosf(band * ang) : -sinf(band * ang); }
            feats[pp * 36 + f] = v;
        }
        __syncthreads();
#pragma unroll
        for (int h2 = 0; h2 < 2; ++h2) { const int pp = (tid >> 6) + 8 * h2; float a = b1j;
            for (int f = 0; f < 33; ++f) a += feats[pp * 36 + f] * w1s[f * 64 + j];
            ha[pp * 64 + j] = __sinf(fqj * a); }
        __syncthreads();
#pragma unroll
        for (int h2 = 0; h2 < 2; ++h2) { const int pp = (tid >> 6) + 8 * h2; float a = b2j;
#pragma unroll 4
            for (int f4 = 0; f4 < 16; ++f4) { const nf4 hv = *(const LAS nf4*)(ha + pp * 64 + 4 * f4);
                a += hv.x * w2s[(4 * f4) * 64 + j] + hv.y * w2s[(4 * f4 + 1) * 64 + j] + hv.z * w2s[(4 * f4 + 2) * 64 + j] + hv.w * w2s[(4 * f4 + 3) * 64 + j]; }
            hb[pp * 64 + j] = __sinf(fqj * a); }
        __syncthreads();
#pragma unroll
        for (int h2 = 0; h2 < 2; ++h2) { const int pp = (tid >> 6) + 8 * h2; float a = b3j;
#pragma unroll 4
            for (int f4 = 0; f4 < 16; ++f4) { const nf4 hv = *(const LAS nf4*)(hb + pp * 64 + 4 * f4);
                a += hv.x * w3s[(4 * f4) * 64 + j] + hv.y * w3s[(4 * f4 + 1) * 64 + j] + hv.z * w3s[(4 * f4 + 2) * 64 + j] + hv.w * w3s[(4 * f4 + 3) * 64 + j]; }
            h3b[pp * 72 + j] = f2bf(__sinf(fqj * a)); }
        __syncthreads();
        {
            const int lane = tid & 63, w = tid >> 6, r16 = lane & 15, kg = lane >> 4;
            pg8::f32x4 acc[8];
#pragma unroll
            for (int nt = 0; nt < 8; ++nt) acc[nt] = (pg8::f32x4){0.f, 0.f, 0.f, 0.f};
            pg8::bf16x8 af[2];
#pragma unroll
            for (int ks = 0; ks < 2; ++ks) af[ks] = *(const LAS pg8::bf16x8*)(h3b + r16 * 72 + 32 * ks + 8 * kg);
#pragma unroll
            for (int nt = 0; nt < 8; ++nt)
#pragma unroll
                for (int ks = 0; ks < 2; ++ks) acc[nt] = __builtin_amdgcn_mfma_f32_16x16x32_bf16(af[ks], bfrag[nt][ks], acc[nt], 0, 0, 0);
            const float invl = 1.0f / (float)(L - 1);
            const float dstep = (15.350567286626972f - 3.0701134573253945f) / 511.0f;
            float tt[4];
#pragma unroll
            for (int i = 0; i < 4; ++i) tt[i] = (float)(pos0 + 4 * kg + i) * invl;
#pragma unroll
            for (int nt = 0; nt < 8; ++nt) { const int o = 128 * w + 16 * nt + r16, dir = o >> 9, c = o & 511;
                const float dl = 3.0701134573253945f + (float)c * dstep;
                nf4 v;
#pragma unroll
                for (int i = 0; i < 4; ++i) v[i] = acc[nt][i] * __expf(-tt[i] * dl);
                *(nf4*)(ktc + (size_t)(c * 2 + dir) * L + pos0 + 4 * kg) = v; }
        }
        __syncthreads();
    }
}
__device__ void ph_hy_prep(const P& p, int l, LAS unsigned char* lds) {
    constexpr int RS = 3 * 128 + 8;
    LAS bf16_t* raw = (LAS bf16_t*)lds;
    LAS bf16_t* ox = (LAS bf16_t*)(lds + 52224);
    LAS bf16_t* oz = ox + 128 * 72;
    const bf16_t* hy = (const bf16_t*)(p.ws + OFF_HYRAW);
    bf16_t* x0t = (bf16_t*)(p.ws + OFF_X0T); bf16_t* zt = (bf16_t*)(p.ws + OFF_ZT);
    const float* cw = PRM(p, hy_conv_w) + (size_t)l * 3 * 1536; const float* cb = PRM(p, hy_conv_b) + (size_t)l * 1536;
    const int tid = TIDX, nitems = (T_TOK / 64) * 4;
    for (int it = blockIdx.x; it < nitems; it += gridDim.x) {
        const int t0 = (it >> 2) * 64, c0 = (it & 3) * 128;
        for (int idx = tid; idx < 66 * 48; idx += 512) {
            const int row = idx / 48, rem = idx - row * 48, a = rem >> 4, pc = rem & 15;
            int t = t0 - 1 + row; t = t < 0 ? 0 : (t >= T_TOK ? T_TOK - 1 : t);
            *(LAS nu4*)(raw + row * RS + a * 128 + pc * 8) = *(const nu4*)(hy + (size_t)t * 1536 + a * 512 + c0 + pc * 8);
        }
        __syncthreads();
        {
            const int c = tid & 127, tq = tid >> 7;
            float wv[3][3], bv[3];
#pragma unroll
            for (int a = 0; a < 3; ++a) { bv[a] = cb[a * 512 + c0 + c];
#pragma unroll
                for (int k = 0; k < 3; ++k) wv[a][k] = cw[k * 1536 + a * 512 + c0 + c]; }
            float xm[3], xc[3];
#pragma unroll
            for (int a = 0; a < 3; ++a) { xm[a] = bf2f(raw[(tq * 16) * RS + a * 128 + c]); xc[a] = bf2f(raw[(tq * 16 + 1) * RS + a * 128 + c]); }
            unsigned px = 0, pz = 0;
#pragma unroll
            for (int j = 0; j < 16; ++j) {
                const int tt = tq * 16 + j, t = t0 + tt;
                const bool hp = !seq_start(t), hn = !seq_end(t);
                float r[3];
#pragma unroll
                for (int a = 0; a < 3; ++a) { const float xp = bf2f(raw[(tt + 2) * RS + a * 128 + c]);
                    r[a] = (hp ? xm[a] * wv[a][0] : 0.f) + xc[a] * wv[a][1] + (hn ? xp * wv[a][2] : 0.f) + bv[a];
                    xm[a] = xc[a]; xc[a] = xp; }
                const unsigned bx = f2bf(r[0]), bz = f2bf(r[1] * r[2]);
                if (j & 1) { px |= bx << 16; pz |= bz << 16;
                    *(LAS unsigned*)(ox + c * 72 + tt - 1) = px; *(LAS unsigned*)(oz + c * 72 + tt - 1) = pz; }
                else { px = bx; pz = bz; }
            }
        }
        __syncthreads();
        for (int idx = tid; idx < 128 * 16; idx += 512) {
            const int c = idx >> 4, rem = idx & 15, arr = rem >> 3, pc = rem & 7;
            const nu4 v = *(const LAS nu4*)((arr ? oz : ox) + c * 72 + pc * 8);
            *(nu4*)((arr ? zt : x0t) + (size_t)(c0 + c) * T_TOK + t0 + pc * 8) = v;
        }
        __syncthreads();
    }
}
__device__ __forceinline__ cf2 ld_f2_agent(const cf2* ptr) {
    const unsigned long long w = __hip_atomic_load((const unsigned long long*)ptr, __ATOMIC_RELAXED, __HIP_MEMORY_SCOPE_AGENT);
    return mkf2(__uint_as_float((unsigned)w), __uint_as_float((unsigned)(w >> 32)));
}
template <int S, int NSEQ>
__device__ __forceinline__ void hy_fft_job(const P& p, int l, LAS cf2* X, cf2* Ks, int c, int tbase) {
    const int tid = TIDX;
    constexpr int M = 1 << (2 * S), L = M, MP = M + (M >> 5);
    const float* kt = (const float*)(p.ws + OFF_KT);
    const bf16_t* x0t = (const bf16_t*)(p.ws + OFF_X0T); bf16_t* zt = (bf16_t*)(p.ws + OFF_ZT);
    const float* hf = kt + (S == 7 ? 0 : (size_t)512 * 2 * L_BIG) + (size_t)(c * 2) * L; const float* hb = hf + L;
#pragma unroll 4
    for (int m = tid; m < M; m += 512) {
        const int n0 = 2 * m, n1 = 2 * m + 1;
        const float a = n0 < L ? hf[n0] : (n0 == L ? 0.f : hb[2 * L - n0]);
        const float b = n1 < L ? hf[n1] : hb[2 * L - n1];
        X[PADI(m)] = mkf2(a, b);
    }
    __syncthreads();
    fft_fwd2<S, 1>(X);
    spec_store(X, S, Ks);
    __builtin_amdgcn_fence(__ATOMIC_ACQUIRE, "agent");
    asm volatile("s_waitcnt vmcnt(0)" ::: "memory");
    __syncthreads();
    const float skip = PRM(p, hy_skip)[(size_t)l * D_HY + c];
    const bf16_t* zrow = zt + (size_t)c * T_TOK + tbase; const bf16_t* xrow = x0t + (size_t)c * T_TOK + tbase;
#pragma unroll 4
    for (int idx = tid; idx < NSEQ * (M >> 1); idx += 512) {
        const int sq = idx / (M >> 1), m = idx - sq * (M >> 1);
        const unsigned w = *(const unsigned*)(zrow + sq * L + 2 * m);
        X[sq * MP + PADI(m)] = mkf2(__uint_as_float(w << 16), __uint_as_float(w & 0xffff0000u));
    }
    __syncthreads();
    fft_fwd2<S, NSEQ, true>(X);
    spec_mul(X, S, Ks, NSEQ);
    fft_inv2<S, NSEQ, true>(X);
    const float inv = 1.0f / (float)M;
    bf16_t* orow = zt + (size_t)c * T_TOK + tbase;
#pragma unroll 4
    for (int idx = tid; idx < NSEQ * (M >> 1); idx += 512) {
        const int sq = idx / (M >> 1), m = idx - sq * (M >> 1);
        const cf2 d = X[sq * MP + PADI(m)];
        const unsigned wz = *(const unsigned*)(zrow + sq * L + 2 * m), wx = *(const unsigned*)(xrow + sq * L + 2 * m);
        const float z0 = __uint_as_float(wz << 16), z1 = __uint_as_float(wz & 0xffff0000u), a0 = __uint_as_float(wx << 16), a1 = __uint_as_float(wx & 0xffff0000u);
        *(unsigned*)(orow + sq * L + 2 * m) = pack_bf2(a0 * (d.x * inv + skip * z0), a1 * (d.y * inv + skip * z1));
    }
    __syncthreads();
}
__device__ void ph_hy_fft(const P& p, int l, LAS unsigned char* lds) {
    LAS cf2* X = (LAS cf2*)lds;
    cf2* Ks = (cf2*)(p.ws + OFF_KS) + (size_t)blockIdx.x * L_BIG;
    for (int job = blockIdx.x; job < 1024; job += gridDim.x) {
        const bool big = job < 512; const int c = job & 511;
        if (big) hy_fft_job<7, 1>(p, l, X, Ks, c, 0); else hy_fft_job<6, 4>(p, l, X, Ks, c, L_BIG);
    }
}
__device__ void ph_hy_norm(const P& p, int l, LAS unsigned char* lds) {
    LAS bf16_t* tl = (LAS bf16_t*)lds;
    LAS float* red = (LAS float*)(lds + 9216);
    const bf16_t* yh = (const bf16_t*)(p.ws + OFF_ZT);
    const float* gain = PRM(p, hy_out_norm) + (size_t)l * D_HY;
    const int tid = TIDX, nitems = (T_TOK / 64) * 8;
    for (int it = blockIdx.x; it < nitems; it += gridDim.x) {
        const int t0 = (it >> 3) * 64, c0 = (it & 7) * 64;
        { const int cc = tid >> 3, pc = tid & 7;
          *(LAS nu4*)(tl + cc * 72 + pc * 8) = *(const nu4*)(yh + (size_t)(c0 + cc) * T_TOK + t0 + pc * 8); }
        __syncthreads();
        { const int tt = tid & 63, part = tid >> 6; float s = 0.f;
#pragma unroll
          for (int j = 0; j < 8; ++j) { const float v = bf2f(tl[(part * 8 + j) * 72 + tt]); s += v * v; }
          red[part * 64 + tt] = s; }
        __syncthreads();
        { const int tt = tid >> 3, pc = tid & 7;
          float s = 0.f;
#pragma unroll
          for (int j = 0; j < 8; ++j) s += red[j * 64 + tt];
          const float r = rsqrtf(s * (1.0f / 64.0f) + 1e-6f);
          unsigned w[4];
#pragma unroll
          for (int j = 0; j < 4; ++j) { const int ca = pc * 8 + 2 * j;
              w[j] = pack_bf2(bf2f(tl[ca * 72 + tt]) * r * gain[c0 + ca], bf2f(tl[(ca + 1) * 72 + tt]) * r * gain[c0 + ca + 1]); }
          nu4 o; o.x = w[0]; o.y = w[1]; o.z = w[2]; o.w = w[3];
          *(nu4*)(abuf_row(p, t0 + tt) + c0 + pc * 8) = o; }
        __syncthreads();
    }
}
typedef short hbf16x8 __attribute__((ext_vector_type(8)));
typedef float hf32x16 __attribute__((ext_vector_type(16)));
constexpr int HSC = 512, HNCH = HSC / 64, HNSC = T_TOK / HSC;
constexpr int QS = 136, KS_ = 72;
constexpr int HL_QH = 0, HL_KH = HL_QH + 64 * QS * 2, HL_QT = HL_KH + 64 * QS * 2, HL_KT = HL_QT + 64 * QS * 2, HL_VT = HL_KT + 128 * KS_ * 2, HL_ST = HL_VT + 128 * KS_ * 2,
              HL_PM = HL_ST + 128 * QS * 2, HL_TOT = HL_PM + 64 * KS_ * 2, HL_EB = HL_TOT + 4 * 128 * 4, HL_END = HL_EB + 128 * 4;
constexpr int HL_OF = HL_QH, OFS = 132;
static_assert(64 * OFS * 4 <= 2 * 64 * QS * 2, "O tile must fit over Qh|Kh");
constexpr size_t OFF_HST = OFF_R6 + 32 * MiB;
constexpr size_t OFF_HAT = OFF_SMALL + 64 * 1024;

__device__ __forceinline__ hf32x16 mfma32(hbf16x8 a, hbf16x8 b, hf32x16 c) { return __builtin_amdgcn_mfma_f32_32x32x16_bf16(a, b, c, 0, 0, 0); }
__device__ __forceinline__ hbf16x8 lds_frag(const LAS unsigned char* base, int row, int stride_el, int col_el) { return *(const LAS hbf16x8*)(base + ((size_t)row * stride_el + col_el) * 2); }

typedef unsigned hu32x4 __attribute__((ext_vector_type(4)));
struct HgPre { hu32x4 f0, f1, v0, v1, q0, q1; };
template <bool FULL>
__device__ __forceinline__ void hg_fetch(const bf16_t* hg, HgPre& pre, int tokbase, int dirsign, int h, int dir) {
    const int tid = TIDX;
    { const int u = tid >> 4, seg = tid & 15;
      const bf16_t* row = hg + (size_t)(tokbase + dirsign * u) * 2560 + h * 128 + seg * 8;
      pre.f0 = *(const hu32x4*)(row + 512 + 512 * dir); pre.v0 = *(const hu32x4*)(row + 1536); if (FULL) pre.q0 = *(const hu32x4*)(row);
      const bf16_t* row1 = row + (size_t)dirsign * 32 * 2560;
      pre.f1 = *(const hu32x4*)(row1 + 512 + 512 * dir); pre.v1 = *(const hu32x4*)(row1 + 1536); if (FULL) pre.q1 = *(const hu32x4*)(row1); }
}
template <bool FULL>
__device__ __forceinline__ void hg_prep(LAS unsigned char* lds, const HgPre& pre, float lb, float& Bsum_out) {
    const int tid = TIDX, d = tid & 127, qt = tid >> 7;
    LAS float* tot = (LAS float*)(lds + HL_TOT); LAS float* eB = (LAS float*)(lds + HL_EB);
    { const int u = tid >> 4, seg = tid & 15;
      *(LAS hu32x4*)(lds + HL_KH + ((size_t)u * QS + seg * 8) * 2) = pre.f0; *(LAS hu32x4*)(lds + HL_KH + ((size_t)(u + 32) * QS + seg * 8) * 2) = pre.f1;
      *(LAS hu32x4*)(lds + HL_QH + ((size_t)u * QS + seg * 8) * 2) = pre.v0; *(LAS hu32x4*)(lds + HL_QH + ((size_t)(u + 32) * QS + seg * 8) * 2) = pre.v1;
      if (FULL) { *(LAS hu32x4*)(lds + HL_QT + ((size_t)u * QS + seg * 8) * 2) = pre.q0; *(LAS hu32x4*)(lds + HL_QT + ((size_t)(u + 32) * QS + seg * 8) * 2) = pre.q1; } }
    __syncthreads();
    float c[16];
    float run = 0.f;
    const float oml = 1.0f - lb;
    float zz[16];
#pragma unroll
    for (int j = 0; j < 16; ++j) zz[j] = bf2f(*(const LAS bf16_t*)(lds + HL_KH + ((size_t)(qt * 16 + j) * QS + d) * 2));
    __builtin_amdgcn_sched_barrier(0);
#pragma unroll
    for (int j = 0; j < 16; ++j) {
        const int u = qt * 16 + j;
        const float z = fmaxf(zz[j], -60.0f);
        const float f = lb + oml * __builtin_amdgcn_rcpf(1.0f + __expf(-z));
        zz[j] = 1.0f - f;
        run += __logf(f);
        c[j] = run;
    }
    tot[qt * 128 + d] = run;
    float vv[16], qq[16];
#pragma unroll
    for (int j = 0; j < 16; ++j) { vv[j] = __uint_as_float((unsigned)(*(const LAS bf16_t*)(lds + HL_QH + ((size_t)(qt * 16 + j) * QS + d) * 2)));
        if (FULL) qq[j] = bf2f(*(const LAS bf16_t*)(lds + HL_QT + ((size_t)(qt * 16 + j) * QS + d) * 2)); }
    __syncthreads();
    const float t0 = tot[d], t1 = tot[128 + d], t2 = tot[256 + d], t3 = tot[384 + d];
    const float off = qt == 0 ? 0.f : (qt == 1 ? t0 : (qt == 2 ? t0 + t1 : t0 + t1 + t2));
    const float r = t0 + t1, B = t0 + t1 + t2 + t3;
    const float eBr = __expf(B - r), eR = __expf(r);
    if (qt == 0) eB[d] = __expf(B);
    Bsum_out = B;
#pragma unroll
    for (int jj = 0; jj < 8; ++jj) {
        unsigned pkt = 0, pvt = 0;
#pragma unroll
        for (int q2 = 0; q2 < 2; ++q2) {
            const int j = jj * 2 + q2, u = qt * 16 + j;
            const float rb = r - (off + c[j]);
            const float kh = zz[j] * __expf(rb);
            pkt |= (unsigned)f2bf(kh * eBr) << (16 * q2); pvt |= __float_as_uint(vv[j]) << (16 * q2);
            if (FULL) {
                const float zq = qq[j];
                const float q = zq * __builtin_amdgcn_rcpf(1.0f + __expf(-zq));
                const float qh = q * __expf(-rb);
                *(LAS bf16_t*)(lds + HL_QT + ((size_t)u * QS + d) * 2) = f2bf(qh * eR);
                *(LAS bf16_t*)(lds + HL_QH + ((size_t)u * QS + d) * 2) = f2bf(qh);
                *(LAS bf16_t*)(lds + HL_KH + ((size_t)u * QS + d) * 2) = f2bf(kh);
            }
        }
        *(LAS unsigned*)(lds + HL_KT + ((size_t)d * KS_ + qt * 16 + jj * 2) * 2) = pkt;
        *(LAS unsigned*)(lds + HL_VT + ((size_t)d * KS_ + qt * 16 + jj * 2) * 2) = pvt;
    }
    __syncthreads();
}
__device__ __forceinline__ void hg_state_update(LAS unsigned char* lds, hf32x16 (&S)[2], int w, int lane) {
    const int en = w & 3, r = lane & 31, hh = lane >> 5;
    const LAS float* eB = (const LAS float*)(lds + HL_EB);
#pragma unroll
    for (int i = 0; i < 2; ++i) {
        const int dm = (w >> 2) * 2 + i;
#pragma unroll
        for (int g = 0; g < 4; ++g) { const nf4 sc = *(const LAS nf4*)(eB + 32 * dm + 8 * g + 4 * hh);
            S[i][4 * g + 0] *= sc.x; S[i][4 * g + 1] *= sc.y; S[i][4 * g + 2] *= sc.z; S[i][4 * g + 3] *= sc.w; }
#pragma unroll
        for (int ks = 0; ks < 4; ++ks) {
            const hbf16x8 a = lds_frag(lds + HL_KT, 32 * dm + r, KS_, 16 * ks + 8 * hh);
            const hbf16x8 b = lds_frag(lds + HL_VT, 32 * en + r, KS_, 16 * ks + 8 * hh);
            S[i] = mfma32(a, b, S[i]);
        }
    }
}
__device__ __forceinline__ int hg_unit_base(int sc) { return sc * HSC; }
__device__ void ph_hg_pass1(const P& p, int l, LAS unsigned char* lds) {
    const bf16_t* hg = (const bf16_t*)(p.ws + OFF_HG);
    const float* lbs = (const float*)(p.ws + OFF_SMALL);
    float* ust = (float*)(p.ws + OFF_HST); float* atot = (float*)(p.ws + OFF_HAT);
    const int tid = TIDX, w = tid >> 6, lane = tid & 63;
    for (int unit = blockIdx.x; unit < HNSC * 8; unit += gridDim.x) {
        const int sc = unit >> 3, h = (unit >> 1) & 3, dir = unit & 1;
        const float lb = lbs[(size_t)(dir * NLAYER + l) * D_HG + h * 128 + (tid & 127)];
        hf32x16 S[2];
#pragma unroll
        for (int i = 0; i < 2; ++i)
#pragma unroll
            for (int k = 0; k < 16; ++k) S[i][k] = 0.f;
        float Btot = 0.f;
        const int dsg = dir ? -1 : 1, tb0 = dir ? hg_unit_base(sc) + HSC - 1 : hg_unit_base(sc);
        HgPre pre;
        hg_fetch<false>(hg, pre, tb0, dsg, h, dir);
        for (int ci = 0; ci < HNCH; ++ci) {
            float B;
            hg_prep<false>(lds, pre, lb, B);
            if (ci + 1 < HNCH) hg_fetch<false>(hg, pre, tb0 + dsg * (ci + 1) * 64, dsg, h, dir);
            Btot += B;
            hg_state_update(lds, S, w, lane);
            __syncthreads();
        }
        float* U = ust + (size_t)unit * 16384;
        int r = lane & 31, hh = lane >> 5; asm volatile("" : "+v"(r), "+v"(hh));
        const int en = w & 3;
#pragma unroll
        for (int i = 0; i < 2; ++i) { const int dm = (w >> 2) * 2 + i;
#pragma unroll
            for (int k = 0; k < 16; ++k) U[(32 * dm + (k & 3) + 8 * (k >> 2) + 4 * hh) * 128 + 32 * en + r] = S[i][k]; }
        if (tid < 128) atot[(size_t)unit * 128 + tid] = __expf(Btot);
    }
}
__device__ void ph_hg_pass2(const P& p) {
    float* ust = (float*)(p.ws + OFF_HST); const float* atot = (const float*)(p.ws + OFF_HAT);
    const int total = 5 * 8 * 16384;
    for (int idx = blockIdx.x * 512 + TIDX; idx < total; idx += gridDim.x * 512) {
        const int el = idx & 16383, hd = (idx >> 14) & 7, sq = idx >> 17;
        const int sc0 = sq == 0 ? 0 : 32 + 8 * (sq - 1), nsc = sq == 0 ? 32 : 8, dir = hd & 1, d = el >> 7;
        float carry = 0.f;
        for (int j0 = 0; j0 < nsc; j0 += 8) {
            float u[8], a[8];
#pragma unroll
            for (int jj = 0; jj < 8; ++jj) { const int j = j0 + jj, sc = dir ? sc0 + nsc - 1 - j : sc0 + j; const size_t unit = (size_t)sc * 8 + hd;
                u[jj] = ust[unit * 16384 + el]; a[jj] = atot[unit * 128 + d]; }
#pragma unroll
            for (int jj = 0; jj < 8; ++jj) { const int j = j0 + jj, sc = dir ? sc0 + nsc - 1 - j : sc0 + j; const size_t unit = (size_t)sc * 8 + hd;
                ust[unit * 16384 + el] = carry; carry = a[jj] * carry + u[jj]; }
        }
    }
}
__device__ void ph_hg_pass3(const P& p, int l, LAS unsigned char* lds) {
    const bf16_t* hg = (const bf16_t*)(p.ws + OFF_HG);
    const float* lbs = (const float*)(p.ws + OFF_SMALL);
    const float* ust = (const float*)(p.ws + OFF_HST);
    const float* gain = PRM(p, hg_out_norm) + (size_t)l * D_HG;
    const int tid = TIDX, w = tid >> 6, lane = tid & 63, r = lane & 31, hh = lane >> 5;
    for (int unit = blockIdx.x; unit < HNSC * 4; unit += gridDim.x) {
        const int sc = unit >> 2, h = unit & 3;
        for (int dir = 0; dir < 2; ++dir) {
            const float lb = lbs[(size_t)(dir * NLAYER + l) * D_HG + h * 128 + (tid & 127)];
            const float* S0 = ust + ((size_t)sc * 8 + h * 2 + dir) * 16384;
            hf32x16 S[2];
            { const int en = w & 3;
              int r_ = r, hh_ = hh; asm volatile("" : "+v"(r_), "+v"(hh_));
              const float* S0l = S0 + (4 * hh_) * 128 + 32 * en + r_;
#pragma unroll
              for (int i = 0; i < 2; ++i) { const int dm = (w >> 2) * 2 + i;
#pragma unroll
                  for (int k = 0; k < 16; ++k) S[i][k] = S0l[(32 * dm + (k & 3) + 8 * (k >> 2)) * 128];
#pragma unroll
                  for (int g = 0; g < 4; ++g) { nu2 wv; wv.x = pack_bf2(S[i][4 * g], S[i][4 * g + 1]); wv.y = pack_bf2(S[i][4 * g + 2], S[i][4 * g + 3]);
                      *(LAS nu2*)(lds + HL_ST + ((size_t)(32 * en + r) * QS + 32 * dm + 8 * g + 4 * hh) * 2) = wv; } } }
            const int dsg = dir ? -1 : 1, tb0 = dir ? hg_unit_base(sc) + HSC - 1 : hg_unit_base(sc);
            HgPre pre;
            hg_fetch<true>(hg, pre, tb0, dsg, h, dir);
            for (int ci = 0; ci < HNCH; ++ci) {
                const int tokbase = tb0 + dsg * ci * 64;
                float Bdummy;
                hg_prep<true>(lds, pre, lb, Bdummy);
                if (ci + 1 < HNCH) hg_fetch<true>(hg, pre, tb0 + dsg * (ci + 1) * 64, dsg, h, dir);
                if (w < 4) {
                    const int tm = (w == 0 || w == 3) ? 0 : 1, sn = (w == 2 || w == 3) ? 1 : 0;
                    hf32x16 acc;
#pragma unroll
                    for (int k = 0; k < 16; ++k) acc[k] = 0.f;
                    if (w < 3) {
#pragma unroll
                        for (int ks = 0; ks < 8; ++ks) acc = mfma32(lds_frag(lds + HL_QH, 32 * tm + r, QS, 16 * ks + 8 * hh), lds_frag(lds + HL_KH, 32 * sn + r, QS, 16 * ks + 8 * hh), acc);
                    }
                    const int s_ = 32 * sn + r;
#pragma unroll
                    for (int k = 0; k < 16; ++k) { const int t_ = 32 * tm + (k & 3) + 8 * (k >> 2) + 4 * hh;
                        const float v = (w < 3 && s_ <= t_) ? acc[k] : 0.f;
                        *(LAS bf16_t*)(lds + HL_PM + ((size_t)t_ * KS_ + s_) * 2) = f2bf(v); }
                }
                __syncthreads();
                hf32x16 o;
                { const int tm = w >> 2, en = w & 3;
#pragma unroll
                  for (int k = 0; k < 16; ++k) o[k] = 0.f;
#pragma unroll
                  for (int ks = 0; ks < 4; ++ks) o = mfma32(lds_frag(lds + HL_PM, 32 * tm + r, KS_, 16 * ks + 8 * hh), lds_frag(lds + HL_VT, 32 * en + r, KS_, 16 * ks + 8 * hh), o);
#pragma unroll
                  for (int ks = 0; ks < 8; ++ks) o = mfma32(lds_frag(lds + HL_QT, 32 * tm + r, QS, 16 * ks + 8 * hh), lds_frag(lds + HL_ST, 32 * en + r, QS, 16 * ks + 8 * hh), o);
                }
                __syncthreads();
                { const int tm = w >> 2, en = w & 3; LAS float* Of = (LAS float*)(lds + HL_OF);
#pragma unroll
                  for (int k = 0; k < 16; ++k) Of[(size_t)(32 * tm + (k & 3) + 8 * (k >> 2) + 4 * hh) * OFS + 32 * en + r] = o[k]; }
                hg_state_update(lds, S, w, lane);
                { const int en = w & 3;
#pragma unroll
                  for (int i = 0; i < 2; ++i) { const int dm = (w >> 2) * 2 + i;
#pragma unroll
                      for (int g = 0; g < 4; ++g) { nu2 wv; wv.x = pack_bf2(S[i][4 * g], S[i][4 * g + 1]); wv.y = pack_bf2(S[i][4 * g + 2], S[i][4 * g + 3]);
                          *(LAS nu2*)(lds + HL_ST + ((size_t)(32 * en + r) * QS + 32 * dm + 8 * g + 4 * hh) * 2) = wv; } } }
                __syncthreads();
                { const int u = tid >> 3, e0 = (tid & 7) * 16, tok = tokbase + dsg * u;
                  const LAS float* Of = (const LAS float*)(lds + HL_OF) + (size_t)u * OFS + e0;
                  bf16_t* dst = abuf_row(p, tok) + 512 + h * 128 + e0;
                  float v[16];
#pragma unroll
                  for (int j = 0; j < 4; ++j) { const nf4 t4 = *(const LAS nf4*)(Of + 4 * j); v[4 * j] = t4.x; v[4 * j + 1] = t4.y; v[4 * j + 2] = t4.z; v[4 * j + 3] = t4.w; }
                  if (dir == 0) {
                      uint4 w0, w1;
                      w0.x = pack_bf2(v[0], v[1]); w0.y = pack_bf2(v[2], v[3]); w0.z = pack_bf2(v[4], v[5]); w0.w = pack_bf2(v[6], v[7]);
                      w1.x = pack_bf2(v[8], v[9]); w1.y = pack_bf2(v[10], v[11]); w1.z = pack_bf2(v[12], v[13]); w1.w = pack_bf2(v[14], v[15]);
                      ((uint4*)dst)[0] = w0; ((uint4*)dst)[1] = w1;
                  } else {
                      const uint4 f0 = ((const uint4*)dst)[0], f1 = ((const uint4*)dst)[1];
                      const unsigned fw[8] = {f0.x, f0.y, f0.z, f0.w, f1.x, f1.y, f1.z, f1.w};
                      float ss = 0.f;
#pragma unroll
                      for (int j = 0; j < 8; ++j) { v[2 * j] += __uint_as_float(fw[j] << 16); v[2 * j + 1] += __uint_as_float(fw[j] & 0xffff0000u); ss += v[2 * j] * v[2 * j] + v[2 * j + 1] * v[2 * j + 1]; }
                      ss += __shfl_xor(ss, 1); ss += __shfl_xor(ss, 2); ss += __shfl_xor(ss, 4);
                      const float rn = rsqrtf(ss * (1.0f / 128.0f) + 1e-6f);
                      const bf16_t* gp = hg + (size_t)tok * 2560 + 2048 + h * 128 + e0;
                      const uint4 g0 = ((const uint4*)gp)[0], g1 = ((const uint4*)gp)[1];
                      const unsigned gw[8] = {g0.x, g0.y, g0.z, g0.w, g1.x, g1.y, g1.z, g1.w};
                      unsigned ow[8];
#pragma unroll
                      for (int j = 0; j < 8; ++j) { const float ga = silu_f(__uint_as_float(gw[j] << 16)), gb = silu_f(__uint_as_float(gw[j] & 0xffff0000u));
                          ow[j] = pack_bf2(v[2 * j] * rn * gain[h * 128 + e0 + 2 * j] * ga, v[2 * j + 1] * rn * gain[h * 128 + e0 + 2 * j + 1] * gb); }
                      ((uint4*)dst)[0] = make_uint4(ow[0], ow[1], ow[2], ow[3]); ((uint4*)dst)[1] = make_uint4(ow[4], ow[5], ow[6], ow[7]);
                  }
                }
                __syncthreads();
            }
        }
    }
}
#define XB_TMO      128
#define XB_XCNT(j)  (256  + 64 * (j))
#define XB_XSUB(j)  (1280 + 64 * (j))
#define XB_XGEN(j)  (2304 + 64 * (j))
#define XB_TOP      3328
#define XB_TOPGEN   3392
#define XCD_BAR_WORDS 3456
#define XB_SPIN_CAP (1u << 18)

__device__ __forceinline__ unsigned xb_ld(unsigned* p)              { return __hip_atomic_load(p, __ATOMIC_RELAXED, __HIP_MEMORY_SCOPE_AGENT); }
__device__ __forceinline__ unsigned xb_add(unsigned* p, unsigned v) { return __hip_atomic_fetch_add(p, v, __ATOMIC_RELAXED, __HIP_MEMORY_SCOPE_AGENT); }
__device__ __forceinline__ unsigned xb_xcc_id() { return (unsigned)__builtin_amdgcn_s_getreg((3 << 11) | 20) & 0xFu; }
#define XB_SPIN(cond, bar) do { unsigned _sp = 0; while (cond) { __builtin_amdgcn_s_sleep(1); \
    if ((++_sp & 255u) == 0u) { if (xb_ld(&(bar)[XB_TMO])) break; if (_sp > XB_SPIN_CAP) { atomicAdd(&(bar)[XB_TMO], 1u); break; } } } } while (0)

struct XcdBarrier {
    unsigned* bar; unsigned x;
    volatile LAS unsigned* st;
};

__device__ __forceinline__ XcdBarrier xcd_barrier_post(unsigned* bar, volatile LAS unsigned* st) {
    XcdBarrier b; b.bar = bar; b.x = xb_xcc_id(); b.st = st;
    if (TIDX == 0) (void)xb_add(&bar[XB_XCNT(b.x)], 1u);
    return b;
}
__device__ __forceinline__ void xcd_barrier_complete(unsigned* bar, unsigned x, unsigned& nloc, unsigned& nx) {
    const unsigned G = gridDim.x * gridDim.y * gridDim.z;
    unsigned sum, cnt, mine, sp = 0u;
    for (;;) {
        sum = 0u; cnt = 0u; mine = 0u;
#pragma unroll
        for (unsigned j = 0; j < 16; ++j) { const unsigned c = xb_ld(&bar[XB_XCNT(j)]); sum += c; cnt += (c > 0u) ? 1u : 0u; mine = (j == x) ? c : mine; }
        if (sum == G) break;
        __builtin_amdgcn_s_sleep(1);
        if ((++sp & 255u) == 0u) { if (xb_ld(&bar[XB_TMO])) break; if (sp > XB_SPIN_CAP) { atomicAdd(&bar[XB_TMO], 1u); break; } }
    }
    nloc = mine > 0u ? mine : 1u; nx = cnt > 0u ? cnt : 1u;
}

__device__ __forceinline__ void xcd_barrier(const XcdBarrier& b) {
    asm volatile("s_waitcnt vmcnt(0)" ::: "memory");
    __syncthreads();
    if (TIDX == 0) {
        unsigned* bar = b.bar;
        __builtin_amdgcn_s_waitcnt(0);
        unsigned nloc = b.st[0], nx = b.st[1];
        if (nloc == 0u) { xcd_barrier_complete(bar, b.x, nloc, nx); b.st[0] = nloc; b.st[1] = nx; }
        const unsigned old = xb_add(&bar[XB_XSUB(b.x)], 1u);
        const unsigned gen = old / nloc;
        if (old + 1u == (gen + 1u) * nloc) {
            __builtin_amdgcn_fence(__ATOMIC_RELEASE, "agent");
            asm volatile("s_waitcnt vmcnt(0)" ::: "memory");
            const unsigned og = xb_add(&bar[XB_TOP], 1u);
            const unsigned tg = og / nx;
            if (og + 1u == (tg + 1u) * nx) xb_add(&bar[XB_TOPGEN], 1u);
            else XB_SPIN(xb_ld(&bar[XB_TOPGEN]) == tg, bar);
            __builtin_amdgcn_fence(__ATOMIC_ACQUIRE, "agent");
            xb_add(&bar[XB_XGEN(b.x)], 1u);
            asm volatile("s_waitcnt vmcnt(0)" ::: "memory");
        } else {
            XB_SPIN(xb_ld(&bar[XB_XGEN(b.x)]) == gen, bar);
            __builtin_amdgcn_fence(__ATOMIC_ACQUIRE, "agent");
            asm volatile("s_waitcnt vmcnt(0)" ::: "memory");
        }
    }
    __syncthreads();
}

enum { PH_SETUP, PH_CONVERT, PH_RMS_IN, PH_GEMM_IN, PH_HY_PREP, PH_FILTER, PH_HGRN, PH_HG_NORM, PH_HY_FFT, PH_HY_NORM, PH_GEMM_OUT, PH_NR0, PH_GEMM_UP, PH_GEGLU, PH_GEMM_DN, PH_NR1, PH_HG_P1, PH_HG_P2, PH_HG_P3 };
template <int PH> __device__ __forceinline__ void run_phase(const P& p_in, int l, int part, LAS unsigned char* lds) {
    typedef __attribute__((address_space(1))) unsigned char* gptr_t; typedef __attribute__((address_space(1))) float* gfptr_t;
    gptr_t wsg = (gptr_t)p_in.ws; gfptr_t outg = (gfptr_t)p_in.out;
    asm volatile("" : "+s"(wsg), "+s"(outg));
    P p = p_in; p.ws = (unsigned char*)wsg; p.out = (float*)outg;
    if constexpr (PH == PH_SETUP) { ph_setup(p); ph_copy_params(p); }
    if constexpr (PH == PH_CONVERT) ph_convert_w(p, l, lds);
    if constexpr (PH == PH_RMS_IN) ph_rmsnorm_in(p, l);
    if constexpr (PH == PH_GEMM_IN) { EpiBf16Split E; E.O0 = (bf16_t*)(p.ws + OFF_HYRAW); E.ldc0 = 1536; E.O1 = (bf16_t*)(p.ws + OFF_HG); E.ldc1 = 2560; E.csplit = 1536;
        run_gemm(lds, abuf_row(p, 0), (const bf16_t*)(p.ws + OFF_W_IN), T_TOK, D_IN, DM, E); }
    if constexpr (PH == PH_HY_PREP) ph_hy_prep(p, l, lds);
    if constexpr (PH == PH_FILTER) ph_filter(p, l, lds);
    if constexpr (PH == PH_HY_FFT) ph_hy_fft(p, l, lds);
    if constexpr (PH == PH_HY_NORM) ph_hy_norm(p, l, lds);
    if constexpr (PH == PH_GEMM_OUT) { EpiBf16Split E; E.O0 = (bf16_t*)(p.ws + OFF_MIX); E.ldc0 = DM; E.O1 = E.O0; E.ldc1 = DM; E.csplit = 1 << 30;
        run_gemm(lds, abuf_row(p, 0), (const bf16_t*)(p.ws + OFF_W_OUT), T_TOK, DM, DM, E); }
    if constexpr (PH == PH_NR0) ph_norm_resid(p, l, 0);
    if constexpr (PH == PH_GEMM_UP) { EpiGeglu E; E.act = (bf16_t*)(p.ws + OFF_ACT); E.cw = PRM(p, ffn_conv_w) + (size_t)l * 3 * 8192; E.cb = PRM(p, ffn_conv_b) + (size_t)l * 8192;
        run_gemm(lds, abuf_row(p, -1), (const bf16_t*)(p.ws + OFF_W_UP), 133 * 256, 2 * DFF, DM, E); }
    if constexpr (PH == PH_GEMM_DN) { EpiBf16Split E; E.O0 = (bf16_t*)(p.ws + OFF_MIX); E.ldc0 = DM; E.O1 = E.O0; E.ldc1 = DM; E.csplit = 1 << 30;
        run_gemm(lds, (const bf16_t*)(p.ws + OFF_ACT), (const bf16_t*)(p.ws + OFF_W_DN), T_TOK, DM, DFF, E); }
    if constexpr (PH == PH_NR1) ph_norm_resid(p, l, 1);
    if constexpr (PH == PH_HG_P1) ph_hg_pass1(p, l, lds);
    if constexpr (PH == PH_HG_P2) ph_hg_pass2(p);
    if constexpr (PH == PH_HG_P3) ph_hg_pass3(p, l, lds);
}
constexpr int LDS_BYTES = 139264;
__global__ __launch_bounds__(512, 2) void mega(P p) {
    extern __shared__ __attribute__((aligned(16))) unsigned char lds_g[];
    LAS unsigned char* lds = (LAS unsigned char*)lds_g;
    cg::grid_group grid = cg::this_grid();
    volatile LAS unsigned* xst = (volatile LAS unsigned*)(lds + LDS_BYTES - 16);
    if (TIDX == 0) { xst[0] = 0u; xst[1] = 0u; }
    __syncthreads();
    const XcdBarrier xb = xcd_barrier_post((unsigned*)(p.ws + OFF_BAR), xst);
    run_phase<PH_SETUP>(p, 0, 0, lds);
    run_phase<PH_CONVERT>(p, 0, 0, lds);
    run_phase<PH_RMS_IN>(p, 0, 0, lds);
    grid.sync();
#pragma unroll 1
    for (int l = 0; l < NLAYER; ++l) {
        run_phase<PH_GEMM_IN>(p, l, 0, lds); xcd_barrier(xb);
        run_phase<PH_HY_PREP>(p, l, 0, lds); run_phase<PH_HG_P1>(p, l, 0, lds); xcd_barrier(xb);
        run_phase<PH_FILTER>(p, l, 0, lds); run_phase<PH_HG_P2>(p, l, 0, lds); xcd_barrier(xb);
        run_phase<PH_HG_P3>(p, l, 0, lds); run_phase<PH_HY_FFT>(p, l, 0, lds); xcd_barrier(xb);
        run_phase<PH_HY_NORM>(p, l, 0, lds); xcd_barrier(xb);
        run_phase<PH_GEMM_OUT>(p, l, 0, lds); xcd_barrier(xb);
        run_phase<PH_NR0>(p, l, 0, lds); xcd_barrier(xb);
        run_phase<PH_GEMM_UP>(p, l, 0, lds); xcd_barrier(xb);
        run_phase<PH_GEMM_DN>(p, l, 0, lds); xcd_barrier(xb);
        run_phase<PH_NR1>(p, l, 0, lds);
        if (l + 1 < NLAYER) { run_phase<PH_CONVERT>(p, l + 1, 0, lds); xcd_barrier(xb); }
    }
}
extern "C" void kernel_launch(void* const* d_in, const int* in_sizes, int n_in, void* d_out, int out_size, void* d_ws, size_t ws_size, hipStream_t stream) {
    if (ws_size < WS_NEED) { fprintf(stderr, "workspace too small: %zu < %zu\n", ws_size, (size_t)WS_NEED); return; }
    static int grid_blocks = 0;
    if (!grid_blocks) {
        hipFuncSetAttribute((const void*)mega, hipFuncAttributeMaxDynamicSharedMemorySize, LDS_BYTES);
        int dev = 0, cus = 0, per_cu = 0;
        hipGetDevice(&dev);
        hipDeviceGetAttribute(&cus, hipDeviceAttributeMultiprocessorCount, dev);
        hipOccupancyMaxActiveBlocksPerMultiprocessor(&per_cu, mega, 512, LDS_BYTES);
        if (per_cu > 1) per_cu = 1;
        grid_blocks = cus * per_cu;
    }
    P p{};
    for (int i = 0; i < 26; ++i) p.in[i] = (const float*)d_in[i];
    p.out = (float*)d_out; p.ws = (unsigned char*)d_ws;
    hipMemsetAsync((unsigned char*)d_ws + OFF_BAR, 0, XCD_BAR_WORDS * 4, stream);
    void* args[] = {&p};
    hipError_t e = hipLaunchCooperativeKernel((void*)mega, dim3(grid_blocks), dim3(512), args, LDS_BYTES, stream);
    if (e != hipSuccess) fprintf(stderr, "cooperative launch failed: %s (grid %d)\n", hipGetErrorString(e), grid_blocks);
}
```

```cpp
#include <hip/hip_runtime.h>
#include <hip/hip_cooperative_groups.h>
#include <cstdio>
#include <cstdint>
namespace cg = cooperative_groups;
__device__ __forceinline__ int tid_opaque() { int t = (int)threadIdx.x; asm volatile("" : "+v"(t)); return t; }
#define TIDX tid_opaque()
#define LAS __attribute__((address_space(3)))
typedef float cf2 __attribute__((ext_vector_type(2)));
typedef float nf4 __attribute__((ext_vector_type(4)));
typedef unsigned nu2 __attribute__((ext_vector_type(2)));
typedef unsigned nu4 __attribute__((ext_vector_type(4)));
namespace pg8 {
#define PG8_LAS __attribute__((address_space(3)))
typedef unsigned short bf16_t;
typedef short bf16x8 __attribute__((ext_vector_type(8)));
typedef float f32x4 __attribute__((ext_vector_type(4)));
typedef unsigned u32x4 __attribute__((ext_vector_type(4)));
constexpr int BM = 256, BK = 64, HALF = 128, HTB = HALF * BK * 2  , STAGE_BYTES = 8 * HTB, NXCD = 8, WGM = 8;

__host__ __device__ __forceinline__ int lds_byte(int r, int c) { const int st = (r >> 4) * 2 + (c >> 5), rr = r & 15, cc = c & 31, ob = rr * 64 + cc * 2; return st * 1024 + (ob ^ (((ob >> 9) & 1) << 5)); }
__host__ __device__ __forceinline__ void stage_rc(int b, int& R, int& C) { const int st = b / 1024, sb = b % 1024, swz = sb ^ (((sb >> 9) & 1) << 5); R = (st >> 1) * 16 + swz / 64; C = (st & 1) * 32 + (swz % 64) / 2; }
__host__ __device__ __forceinline__ int perm32(int rho) { const int n = rho >> 4, i = rho & 15; return 8 * (i >> 2) + 4 * n + (i & 3); }

struct Unit { int pm, pn; };
struct Gemm { const bf16_t* A; const bf16_t* Bt; int M, N, K; int ovl; };

struct StaticOrder {
    int nM, nN, nwg, G, c;
    __host__ __device__ void init(int M, int N, int G_, int c_) { nM = M / BM; nN = N / BM; nwg = nM * nN; G = G_; c = c_; }
    __host__ __device__ bool next(int i, Unit& u) const {
        const long L = (long)i * G + c; if (L >= nwg) return false;
        int wgid = (int)L; { const int q = nwg / NXCD, r = nwg % NXCD, xcd = wgid % NXCD, off = wgid / NXCD; wgid = (xcd < r ? xcd * (q + 1) : r * (q + 1) + (xcd - r) * q) + off; }
        const int nig = WGM * nN, gid = wgid / nig, fm = gid * WGM, gsz = (nM - fm) < WGM ? (nM - fm) : WGM;
        u.pm = fm + ((wgid % nig) % gsz); u.pn = (wgid % nig) / gsz; return true;
    }
    __device__ __forceinline__ void a_ready(const Unit&) const {}
    __device__ __forceinline__ void done(const Unit&) const {}
};
struct CountedOrder : StaticOrder {
    const unsigned* ready; unsigned need; unsigned* tmo;
    __device__ __forceinline__ void a_ready(const Unit& u) const {
        if (TIDX < 64) {
            const unsigned long long t0 = __builtin_amdgcn_s_memrealtime(); unsigned polls = 0;
            while ((unsigned)__builtin_amdgcn_readfirstlane(__hip_atomic_load(ready + 64 * u.pm, __ATOMIC_RELAXED, __HIP_MEMORY_SCOPE_AGENT)) < need) {
                if ((++polls & 255u) == 0u && __builtin_amdgcn_readfirstlane(__hip_atomic_load(tmo, __ATOMIC_RELAXED, __HIP_MEMORY_SCOPE_AGENT)) != 0u) break;
                if (__builtin_amdgcn_s_memrealtime() - t0 > 2000000ull) {
                    if (TIDX == 0) { unsigned expect = 0u; __hip_atomic_compare_exchange_strong(tmo + 1, &expect, 0x600u | (unsigned)(u.pm & 0xff), __ATOMIC_RELAXED, __ATOMIC_RELAXED, __HIP_MEMORY_SCOPE_AGENT); __hip_atomic_store(tmo, 1u, __ATOMIC_RELAXED, __HIP_MEMORY_SCOPE_AGENT); }
                    break; }
                __builtin_amdgcn_s_sleep(2); }
            __builtin_amdgcn_fence(__ATOMIC_ACQUIRE, "agent");
            asm volatile("s_waitcnt vmcnt(0)" ::: "memory");
        }
#if !defined(BROKEN_HOOK_NO_BARRIER)
        asm volatile("" ::: "memory"); __builtin_amdgcn_s_barrier(); asm volatile("" ::: "memory");
#endif
    }
};

__device__ __forceinline__ unsigned cvt_pk_bf16(float lo, float hi) { unsigned r; asm volatile("v_cvt_pk_bf16_f32 %0, %1, %2" : "=v"(r) : "v"(lo), "v"(hi)); return r; }
typedef float f32x2 __attribute__((ext_vector_type(2)));
__device__ __forceinline__ f32x2 gelu_pk(f32x2 v) {
    const f32x2 av = __builtin_elementwise_abs(v), d = av * 0.2316418882f + 1.0f;
    f32x2 t; t.x = __builtin_amdgcn_rcpf(d.x); t.y = __builtin_amdgcn_rcpf(d.y);
    f32x2 q = t * 0.5307027145f + (-0.7265760135f); q = q * t + 0.7107068705f; q = q * t + (-0.142248368f); q = q * t + 0.127414796f; q = q * t;
    const f32x2 s = (v * v) * (-0.72134752044f);
    f32x2 e; e.x = __builtin_amdgcn_exp2f(s.x); e.y = __builtin_amdgcn_exp2f(s.y);
    const f32x2 m = v * (q * e), r = v - m;
    f32x2 o; o.x = v.x < 0.f ? m.x : r.x; o.y = v.y < 0.f ? m.y : r.y; return o;
}

struct EpiF32 {
    static constexpr bool PERM = false, AFTER_DRAIN = false;
    float* C; int ldc; const float* bias;
    __device__ __forceinline__ void operator()(const f32x4 (&acc)[2][2][4][2], const Unit& u, int wr, int wc, int fr, int fq) const {
        const int row0 = u.pm * BM + wr * 64 + fr, col0 = u.pn * BM + wc * 32 + 4 * fq;
        f32x4 bv[2][2];
#pragma unroll
        for (int bj = 0; bj < 2; ++bj)
#pragma unroll
            for (int n = 0; n < 2; ++n) bv[bj][n] = bias ? *(const f32x4*)(bias + col0 + bj * HALF + n * 16) : (f32x4){0.f, 0.f, 0.f, 0.f};
#pragma unroll
        for (int ai = 0; ai < 2; ++ai)
#pragma unroll
            for (int m = 0; m < 4; ++m) { float* rowp = C + (size_t)(row0 + ai * HALF + m * 16) * ldc + col0;
#pragma unroll
                for (int bj = 0; bj < 2; ++bj)
#pragma unroll
                    for (int n = 0; n < 2; ++n) *(f32x4*)(rowp + bj * HALF + n * 16) = acc[ai][bj][m][n] + bv[bj][n]; }
    }
};
template <int ACT  > struct EpiBf16 {
    static constexpr bool PERM = true, AFTER_DRAIN = false;
    bf16_t* O; int ldc; const float* bias; int split_cols; size_t split_stride;
    __device__ __forceinline__ void operator()(const f32x4 (&acc)[2][2][4][2], const Unit& u, int wr, int wc, int fr, int fq) const {
        const int row0 = u.pm * BM + wr * 64 + fr; int colt = u.pn * BM; bf16_t* base = O;
        if (split_cols) { const int t = colt / split_cols; base += (size_t)t * split_stride; colt -= t * split_cols; }
        const int col0 = colt + wc * 32 + 8 * fq, bcol0 = u.pn * BM + wc * 32 + 8 * fq;
        f32x4 bv[2][2];
#pragma unroll
        for (int bj = 0; bj < 2; ++bj)
#pragma unroll
            for (int n = 0; n < 2; ++n) bv[bj][n] = bias ? *(const f32x4*)(bias + bcol0 + bj * HALF + 4 * n) : (f32x4){0.f, 0.f, 0.f, 0.f};
#pragma unroll
        for (int ai = 0; ai < 2; ++ai)
#pragma unroll
            for (int m = 0; m < 4; ++m) { bf16_t* rowp = base + (size_t)(row0 + ai * HALF + m * 16) * ldc + col0;
#pragma unroll
                for (int bj = 0; bj < 2; ++bj) { f32x4 v0 = acc[ai][bj][m][0] + bv[bj][0], v1 = acc[ai][bj][m][1] + bv[bj][1];
                    if (ACT == 1) { f32x2 a = gelu_pk((f32x2){v0[0], v0[1]}), b = gelu_pk((f32x2){v0[2], v0[3]}), c = gelu_pk((f32x2){v1[0], v1[1]}), d = gelu_pk((f32x2){v1[2], v1[3]});
                        v0 = (f32x4){a.x, a.y, b.x, b.y}; v1 = (f32x4){c.x, c.y, d.x, d.y}; }
                    if (ACT == 2) {
#pragma unroll
                        for (int j = 0; j < 4; ++j) { v0[j] = 0.5f * v0[j] * (1.0f + erff(v0[j] * 0.70710678f)); v1[j] = 0.5f * v1[j] * (1.0f + erff(v1[j] * 0.70710678f)); } }
                    u32x4 w; w.x = cvt_pk_bf16(v0[0], v0[1]); w.y = cvt_pk_bf16(v0[2], v0[3]); w.z = cvt_pk_bf16(v1[0], v1[1]); w.w = cvt_pk_bf16(v1[2], v1[3]);
                    *(u32x4*)(rowp + bj * HALF) = w; } }
    }
};
template <class Epi, class Sched, bool STAMP = false>
__device__ __forceinline__ void gemm_phase(PG8_LAS unsigned char* lds, const Gemm g, const Sched& S, const Epi& E, unsigned long long* stamps) {
    const int tid = TIDX, wid = __builtin_amdgcn_readfirstlane(tid >> 6), lane = tid & 63, wr = wid >> 2, wc = wid & 3, fr = lane & 15, fq = lane >> 4;
    const int K = g.K, nt = K / BK;
    int ts_lo = 0, ts_hi = 0, nts = 0; const unsigned long long rt_entry = STAMP ? (unsigned long long)wall_clock64() : 0ull;
#define PG8_STAMP() do { if (STAMP && wid == 0 && nts < 64) { const unsigned long long _c = (unsigned long long)clock64(); \
        ts_lo = (lane == nts) ? (int)(unsigned)_c : ts_lo; ts_hi = (lane == nts) ? (int)(unsigned)(_c >> 32) : ts_hi; ++nts; } } while (0)
    PG8_STAMP();
    unsigned voffA[2], voffB[2];
#pragma unroll
    for (int i = 0; i < 2; ++i) { int R, C; stage_rc(tid * 16 + i * 8192, R, C); const int Rb = Epi::PERM ? ((R & ~31) + perm32(R & 31)) : R;
        const int Ra = g.ovl ? R - 2 * (R >> 6) : R; voffA[i] = (unsigned)(Ra * K + C) * 2u; voffB[i] = (unsigned)(Rb * K + C) * 2u; }
    const size_t kstep = (size_t)(BK * 2);
    const size_t hstep = (size_t)HALF * K * 2;
    const size_t tstep = 2 * hstep;
    const size_t hstepA = g.ovl ? (size_t)124 * K * 2 : hstep, tstepA = g.ovl ? (size_t)248 * K * 2 : tstep;
    const unsigned ldsw = (unsigned)wid * 1024u;
    const int aoff = lds_byte(wr * 64 + fr, fq * 8), boff = lds_byte(wc * 32 + fr, fq * 8);
#define PG8_SA(b, h) (((b) * 2 + (h)) * HTB)
#define PG8_SB(b, h) ((4 + (b) * 2 + (h)) * HTB)
#define PG8_STAGE(bufoff, gbase, voff) do { _Pragma("unroll") for (int _i = 0; _i < 2; ++_i) \
        __builtin_amdgcn_global_load_lds((const unsigned*)((const char*)(gbase) + (voff)[_i]), (PG8_LAS unsigned*)(lds + (bufoff) + ldsw + _i * 8192), 16, 0, 0); } while (0)
#define PG8_LDA(dst, b, h) do { _Pragma("unroll") for (int m = 0; m < 4; ++m) _Pragma("unroll") for (int k = 0; k < 2; ++k) dst[m][k] = *(const PG8_LAS bf16x8*)(lds + PG8_SA(b, h) + aoff + m * 2048 + k * 1024); } while (0)
#define PG8_LDB(dst, b, h) do { _Pragma("unroll") for (int n = 0; n < 2; ++n) _Pragma("unroll") for (int k = 0; k < 2; ++k) dst[n][k] = *(const PG8_LAS bf16x8*)(lds + PG8_SB(b, h) + boff + n * 2048 + k * 1024); } while (0)
#define PG8_MMA(ai, bj, At, Bt) do { __builtin_amdgcn_s_setprio(1); _Pragma("unroll") for (int m = 0; m < 4; ++m) _Pragma("unroll") for (int n = 0; n < 2; ++n) _Pragma("unroll") for (int k = 0; k < 2; ++k) \
        acc[ai][bj][m][n] = __builtin_amdgcn_mfma_f32_16x16x32_bf16(Bt[n][k], At[m][k], acc[ai][bj][m][n], 0, 0, 0); __builtin_amdgcn_s_setprio(0); } while (0)
#define PG8_WAIT_V(n) asm volatile("s_waitcnt vmcnt(" #n ")" ::: "memory")
#define PG8_WAIT_L(n) asm volatile("s_waitcnt lgkmcnt(" #n ")" ::: "memory")
#define PG8_BAR __builtin_amdgcn_s_barrier()
#define PG8_SCHED __builtin_amdgcn_sched_barrier(0)
    Unit cur, nxt; int ui = 0;
    if (!S.next(0, cur)) return;
    f32x4 acc[2][2][4][2];
#pragma unroll
    for (int a = 0; a < 2; ++a)
#pragma unroll
        for (int b = 0; b < 2; ++b)
#pragma unroll
            for (int m = 0; m < 4; ++m)
#pragma unroll
                for (int n = 0; n < 2; ++n) acc[a][b][m][n] = (f32x4){0.f, 0.f, 0.f, 0.f};
    bf16x8 At[4][2], B0[2][2], B1[2][2];
    const char* cA = (const char*)g.A + (size_t)cur.pm * tstepA; const char* cB = (const char*)g.Bt + (size_t)cur.pn * tstep;
    S.a_ready(cur);
    PG8_STAGE(PG8_SB(0, 0), cB, voffB); PG8_STAGE(PG8_SA(0, 0), cA, voffA); PG8_STAGE(PG8_SB(0, 1), cB + hstep, voffB); PG8_STAGE(PG8_SA(0, 1), cA + hstepA, voffA);
    if (wr == 1) PG8_BAR;
    PG8_WAIT_V(4); PG8_BAR;
    PG8_STAGE(PG8_SB(1, 0), cB + kstep, voffB); PG8_STAGE(PG8_SA(1, 0), cA + kstep, voffA); PG8_STAGE(PG8_SB(1, 1), cB + hstep + kstep, voffB);
    PG8_WAIT_V(6); PG8_BAR;
    PG8_STAMP();
    for (;;) {
        const bool has_next = S.next(ui + 1, nxt);
        const char* nA = has_next ? (const char*)g.A + (size_t)nxt.pm * tstepA : cA; const char* nB = has_next ? (const char*)g.Bt + (size_t)nxt.pn * tstep : cB;
        for (int t = 0; t < nt; t += 2) {
            const bool last = (t == nt - 2);
            const char* a1 = cA + (size_t)(t + 1) * kstep;
            const char* a2 = last ? nA : cA + (size_t)(t + 2) * kstep; const char* b2 = last ? nB : cB + (size_t)(t + 2) * kstep;
            const char* a3 = a2 + kstep; const char* b3 = b2 + kstep;
            if (last && has_next) S.a_ready(nxt);
            PG8_LDB(B0, 0, 0); PG8_SCHED; PG8_LDA(At, 0, 0); PG8_STAGE(PG8_SA(1, 1), a1 + hstepA, voffA);
            PG8_WAIT_L(8); PG8_BAR; PG8_WAIT_L(0); PG8_MMA(0, 0, At, B0); PG8_BAR; PG8_SCHED;
            PG8_LDB(B1, 0, 1); PG8_STAGE(PG8_SB(0, 0), b2, voffB);
            PG8_BAR; PG8_WAIT_L(0); PG8_MMA(0, 1, At, B1); PG8_BAR;
            PG8_LDA(At, 0, 1); PG8_STAGE(PG8_SA(0, 0), a2, voffA);
            PG8_BAR; PG8_WAIT_L(0); PG8_MMA(1, 0, At, B0); PG8_BAR; PG8_SCHED;
            PG8_STAGE(PG8_SB(0, 1), b2 + hstep, voffB);
            PG8_WAIT_V(6); PG8_BAR; PG8_MMA(1, 1, At, B1); PG8_BAR;
            PG8_LDB(B0, 1, 0); PG8_SCHED; PG8_LDA(At, 1, 0); PG8_STAGE(PG8_SA(0, 1), a2 + hstepA, voffA);
            PG8_WAIT_L(8); PG8_BAR; PG8_WAIT_L(0); PG8_MMA(0, 0, At, B0); PG8_BAR; PG8_SCHED;
            PG8_LDB(B1, 1, 1); PG8_STAGE(PG8_SB(1, 0), b3, voffB);
            PG8_BAR; PG8_WAIT_L(0); PG8_MMA(0, 1, At, B1); PG8_BAR;
            PG8_LDA(At, 1, 1); PG8_STAGE(PG8_SA(1, 0), a3, voffA);
            PG8_BAR; PG8_WAIT_L(0); PG8_MMA(1, 0, At, B0); PG8_BAR; PG8_SCHED;
            PG8_STAGE(PG8_SB(1, 1), b3 + hstep, voffB);
            PG8_WAIT_V(6); PG8_BAR; PG8_MMA(1, 1, At, B1); PG8_BAR;
        }
        PG8_STAMP();
        if constexpr (!Epi::AFTER_DRAIN) { E(acc, cur, wr, wc, fr, fq); S.done(cur); }
        PG8_STAMP();
        if (!has_next) break;
#pragma unroll
        for (int a = 0; a < 2; ++a)
#pragma unroll
            for (int b = 0; b < 2; ++b)
#pragma unroll
                for (int m = 0; m < 4; ++m)
#pragma unroll
                    for (int n = 0; n < 2; ++n) acc[a][b][m][n] = (f32x4){0.f, 0.f, 0.f, 0.f};
        cur = nxt; cA = nA; cB = nB; ++ui;
    }
    PG8_WAIT_V(0);
    if (wr == 0) PG8_BAR;
    PG8_BAR;
    if constexpr (Epi::AFTER_DRAIN) { E.fused(acc, cur, wr, wc, fr, fq, lds, wid, lane); S.done(cur); }
    PG8_STAMP();
    if (STAMP && wid == 0) { stamps[lane] = lane < nts ? (((unsigned long long)(unsigned)ts_hi << 32) | (unsigned)ts_lo) : 0ull;
        if (lane == 62) stamps[62] = rt_entry; if (lane == 63) stamps[63] = (unsigned long long)wall_clock64(); }
#undef PG8_STAMP
#undef PG8_SA
#undef PG8_SB
#undef PG8_STAGE
#undef PG8_LDA
#undef PG8_LDB
#undef PG8_MMA
#undef PG8_WAIT_V
#undef PG8_WAIT_L
#undef PG8_BAR
#undef PG8_SCHED
}
}
typedef unsigned short bf16_t;
constexpr int T_TOK = 32768, DM = 1024, D_IN = 4096, D_HY = 512, D_HG = 512, DFF = 4096, NLAYER = 4;
constexpr int L_BIG = 16384, L_SML = 4096;
constexpr int APAD = 256;
constexpr size_t MiB = 1024ull * 1024ull;
constexpr size_t OFF_W = 0;
constexpr size_t OFF_W_IN = OFF_W, OFF_W_OUT = OFF_W + 8 * MiB, OFF_W_UP = OFF_W + 10 * MiB, OFF_W_DN = OFF_W + 26 * MiB;
constexpr size_t OFF_ABUF = 34 * MiB;
constexpr size_t OFF_R1 = 99 * MiB;
constexpr size_t OFF_HYRAW = OFF_R1;
constexpr size_t OFF_HG = OFF_R1 + 96 * MiB;
constexpr size_t OFF_KT = OFF_R1;
constexpr size_t OFF_ACT = OFF_R1;
constexpr size_t OFF_R2 = 355 * MiB;
constexpr size_t OFF_X0T = OFF_R2, OFF_ZT = OFF_R2 + 32 * MiB;
constexpr size_t OFF_MIX = OFF_R2;
constexpr size_t OFF_UPART = OFF_R2;
constexpr size_t OFF_R6 = 419 * MiB;
constexpr size_t OFF_OBUF = OFF_R6;
constexpr size_t OFF_KS = OFF_R6;
constexpr size_t OFF_SMALL = 483 * MiB;
constexpr size_t OFF_BAR = OFF_SMALL + 4 * MiB;
constexpr size_t OFF_W4T = OFF_SMALL + 8 * MiB;
constexpr size_t WS_NEED = 492 * MiB;

struct P { const float* in[26]; float* out; unsigned char* ws; };
constexpr int PB_norm_mix_pre = 0;
constexpr int PB_norm_mix_post = 4096;
constexpr int PB_norm_ffn_pre = 8192;
constexpr int PB_norm_ffn_post = 12288;
constexpr int PB_hy_conv_w = 16384;
constexpr int PB_hy_conv_b = 34816;
constexpr int PB_f_w1 = 40960;
constexpr int PB_f_b1 = 49408;
constexpr int PB_f_w2 = 49664;
constexpr int PB_f_b2 = 66048;
constexpr int PB_f_w3 = 66304;
constexpr int PB_f_b3 = 82688;
constexpr int PB_f_w4 = 82944;
constexpr int PB_f_freq = 345088;
constexpr int PB_hy_skip = 345344;
constexpr int PB_hy_out_norm = 347392;
constexpr int PB_lb_table = 349440;
constexpr int PB_hg_out_norm = 353536;
constexpr int PB_ffn_conv_w = 355584;
constexpr int PB_ffn_conv_b = 453888;
constexpr int PB_TOTAL = 486656;
constexpr size_t OFF_PB = OFF_SMALL + 512 * 1024;
#define PRM(p, NAME) ((const float*)((p).ws + OFF_PB) + PB_##NAME)

__device__ __forceinline__ float bf2f(bf16_t b) { return __uint_as_float(((unsigned)b) << 16); }
__device__ __forceinline__ bf16_t f2bf(float f) { unsigned u = __float_as_uint(f); u += 0x7FFFu + ((u >> 16) & 1u); return (bf16_t)(u >> 16); }
__device__ __forceinline__ unsigned pack_bf2(float lo, float hi) { return (unsigned)f2bf(lo) | ((unsigned)f2bf(hi) << 16); }
__device__ __forceinline__ bool seq_start(int t) { return t < L_BIG ? (t == 0) : ((t & (L_SML - 1)) == 0); }
__device__ __forceinline__ bool seq_end(int t) { return (t + 1 == T_TOK) || seq_start(t + 1); }
__device__ __forceinline__ const float* x_src_row(const P& p, int l, int t) {
    if (l > 0) return p.out + (size_t)t * DM;
    return t < L_BIG ? p.in[0] + (size_t)t * DM : p.in[1] + (size_t)(t - L_BIG) * DM;
}
__device__ __forceinline__ float silu_f(float x) { return x / (1.0f + __expf(-x)); }
__device__ __forceinline__ float wave_sum(float v) {
#pragma unroll
    for (int o = 32; o >= 1; o >>= 1) v += __shfl_xor(v, o);
    return v;
}

struct EpiBf16Split {
    static constexpr bool PERM = true, AFTER_DRAIN = false, OVL = false;
    bf16_t* O0; int ldc0; bf16_t* O1; int ldc1; int csplit;
    __device__ __forceinline__ void operator()(const pg8::f32x4 (&acc)[2][2][4][2], const pg8::Unit& u, int wr, int wc, int fr, int fq) const {
        const int row0 = u.pm * pg8::BM + wr * 64 + fr; int colt = u.pn * pg8::BM; bf16_t* base = O0; int ldc = ldc0;
        if (colt >= csplit) { base = O1; ldc = ldc1; colt -= csplit; }
        const int col0 = colt + wc * 32 + 8 * fq;
#pragma unroll
        for (int ai = 0; ai < 2; ++ai)
#pragma unroll
            for (int m = 0; m < 4; ++m) { bf16_t* rowp = base + (size_t)(row0 + ai * pg8::HALF + m * 16) * ldc + col0;
#pragma unroll
                for (int bj = 0; bj < 2; ++bj) { const pg8::f32x4 v0 = acc[ai][bj][m][0], v1 = acc[ai][bj][m][1];
                    pg8::u32x4 w; w.x = pg8::cvt_pk_bf16(v0[0], v0[1]); w.y = pg8::cvt_pk_bf16(v0[2], v0[3]); w.z = pg8::cvt_pk_bf16(v1[0], v1[1]); w.w = pg8::cvt_pk_bf16(v1[2], v1[3]);
                    *(pg8::u32x4*)(rowp + bj * pg8::HALF) = w; } }
    }
};
__device__ __forceinline__ float dpp_ror1(float v) { return __int_as_float(__builtin_amdgcn_update_dpp(0, __float_as_int(v), 0x121, 0xF, 0xF, false)); }
__device__ __forceinline__ float dpp_ror15(float v) { return __int_as_float(__builtin_amdgcn_update_dpp(0, __float_as_int(v), 0x12F, 0xF, 0xF, false)); }
__device__ __forceinline__ float gelu_tanh_e(float x) { const float y = 1.5957691216057308f * (x + 0.044715f * x * x * x); return x * __builtin_amdgcn_rcpf(1.0f + __expf(-y)); }
struct EpiGeglu {
    static constexpr bool PERM = true, AFTER_DRAIN = false, OVL = true;
    bf16_t* act; const float* cw; const float* cb;
    __device__ __forceinline__ void operator()(const pg8::f32x4 (&acc)[2][2][4][2], const pg8::Unit& u, int wr, int wc, int fr, int fq) const {
        const int j0 = u.pn * 128 + wc * 32 + 8 * fq;
        unsigned mprev = 0, mnext = 0, mst = 0;
#pragma unroll
        for (int ai = 0; ai < 2; ++ai)
#pragma unroll
            for (int m = 0; m < 4; ++m) { const int q = 16 * m + fr, tok = u.pm * 248 + 124 * ai + 62 * wr + q - 1, b = ai * 4 + m;
                const bool st = q >= 1 && q <= 62 && tok < T_TOK;
                if (st) { mst |= 1u << b; if (!seq_start(tok)) mprev |= 1u << b; if (!seq_end(tok)) mnext |= 1u << b; } }
#pragma unroll
        for (int n = 0; n < 2; ++n) {
            const int jc = j0 + 4 * n;
            const pg8::f32x4 wa0 = *(const pg8::f32x4*)(cw + jc), wa1 = *(const pg8::f32x4*)(cw + 8192 + jc), wa2 = *(const pg8::f32x4*)(cw + 16384 + jc), ba = *(const pg8::f32x4*)(cb + jc);
            const pg8::f32x4 wb0 = *(const pg8::f32x4*)(cw + 4096 + jc), wb1 = *(const pg8::f32x4*)(cw + 8192 + 4096 + jc), wb2 = *(const pg8::f32x4*)(cw + 16384 + 4096 + jc), bb = *(const pg8::f32x4*)(cb + 4096 + jc);
#pragma unroll
            for (int ai = 0; ai < 2; ++ai) {
                pg8::f32x4 pa_prev, pb_prev, na_cur, nb_cur;
#pragma unroll
                for (int i = 0; i < 4; ++i) { na_cur[i] = dpp_ror15(acc[ai][0][0][n][i]); nb_cur[i] = dpp_ror15(acc[ai][1][0][n][i]); pa_prev[i] = 0.f; pb_prev[i] = 0.f; }
#pragma unroll
                for (int m = 0; m < 4; ++m) {
                    const int b = ai * 4 + m, q = 16 * m + fr, tok = u.pm * 248 + 124 * ai + 62 * wr + q - 1;
                    const bool hp = (mprev >> b) & 1u, hn = (mnext >> b) & 1u;
                    pg8::f32x4 pa_cur, pb_cur, na_next, nb_next;
#pragma unroll
                    for (int i = 0; i < 4; ++i) { pa_cur[i] = dpp_ror1(acc[ai][0][m][n][i]); pb_cur[i] = dpp_ror1(acc[ai][1][m][n][i]);
                        na_next[i] = m < 3 ? dpp_ror15(acc[ai][0][m < 3 ? m + 1 : 3][n][i]) : 0.f; nb_next[i] = m < 3 ? dpp_ror15(acc[ai][1][m < 3 ? m + 1 : 3][n][i]) : 0.f; }
                    const pg8::f32x4 xpa = (fr == 0) ? pa_prev : pa_cur, xna = (fr == 15) ? na_next : na_cur;
                    const pg8::f32x4 xpb = (fr == 0) ? pb_prev : pb_cur, xnb = (fr == 15) ? nb_next : nb_cur;
                    const pg8::f32x4 xa = acc[ai][0][m][n], xb = acc[ai][1][m][n];
                    float o[4];
#pragma unroll
                    for (int i = 0; i < 4; ++i) {
                        const float ya = (hp ? xpa[i] * wa0[i] : 0.f) + xa[i] * wa1[i] + (hn ? xna[i] * wa2[i] : 0.f) + ba[i];
                        const float yb = (hp ? xpb[i] * wb0[i] : 0.f) + xb[i] * wb1[i] + (hn ? xnb[i] * wb2[i] : 0.f) + bb[i];
                        o[i] = gelu_tanh_e(ya) * yb;
                    }
                    if ((mst >> b) & 1u) { uint2 w; w.x = pg8::cvt_pk_bf16(o[0], o[1]); w.y = pg8::cvt_pk_bf16(o[2], o[3]); *(uint2*)(act + (size_t)tok * DFF + jc) = w; }
                    pa_prev = pa_cur; pb_prev = pb_cur; na_cur = na_next; nb_cur = nb_next;
                }
            }
        }
    }
};
template <class Epi>
__device__ __forceinline__ void run_gemm(LAS unsigned char* lds, const bf16_t* A, const bf16_t* Bt, int M, int N, int K, const Epi& E) {
    pg8::Gemm g; g.A = A; g.Bt = Bt; g.M = M; g.N = N; g.K = K; g.ovl = Epi::OVL ? 1 : 0;
    int gx = (int)gridDim.x, bx = (int)blockIdx.x; asm volatile("" : "+s"(gx), "+s"(bx));
    pg8::StaticOrder S; S.init(M, N, gx, bx);
    pg8::gemm_phase<Epi, pg8::StaticOrder, false>((PG8_LAS unsigned char*)lds, g, S, E, nullptr);
}

#define HD_INLINE __device__ __forceinline__
#define DEV_FN __device__ __forceinline__
#define LDS_F2 LAS cf2*
#define NTHR 512
#define PADI(i) ((i) + ((i) >> 5))
#define FOR_TID for (int tid = (int)TIDX, once_ = 1; once_; once_ = 0)
#define SYNC __syncthreads()
#define BREV32(x) __brev(x)
#define CIS_REV(fr, c, s) do { const float f_ = (fr); c = __builtin_amdgcn_cosf(f_); s = __builtin_amdgcn_sinf(f_); } while (0)
HD_INLINE unsigned rev4(unsigned k, int S) {
    unsigned v = BREV32(k) >> (32 - 2 * S);
    return ((v & 0xAAAAAAAAu) >> 1) | ((v & 0x55555555u) << 1);
}
HD_INLINE cf2 mkf2(float a, float b) { cf2 r; r.x = a; r.y = b; return r; }
HD_INLINE cf2 cmul(cf2 a, cf2 b) { return mkf2(a.x * b.x - a.y * b.y, a.x * b.y + a.y * b.x); }
HD_INLINE cf2 cmulc(cf2 a, cf2 b) { return mkf2(a.x * b.x + a.y * b.y, a.y * b.x - a.x * b.y); }

HD_INLINE void bf4_fwd(cf2& a0, cf2& a1, cf2& a2, cf2& a3) {
    const cf2 t0 = a0 + a2, t1 = a0 - a2, t2 = a1 + a3, d = a1 - a3; const cf2 t3 = mkf2(d.y, -d.x);
    a0 = t0 + t2; a1 = t1 + t3; a2 = t0 - t2; a3 = t1 - t3;
}
HD_INLINE void bf4_inv(cf2& b0, cf2& b1, cf2& b2, cf2& b3) {
    const cf2 t0 = b0 + b2, t1 = b0 - b2, t2 = b1 + b3, d = b1 - b3; const cf2 t3 = mkf2(-d.y, d.x);
    b0 = t0 + t2; b1 = t1 + t3; b2 = t0 - t2; b3 = t1 - t3;
}
#define W16C(k) ((k) == 0 ? 1.0f : (k) == 1 ? 0.9238795325112867f : (k) == 2 ? 0.7071067811865476f : (k) == 3 ? 0.3826834323650898f : (k) == 4 ? 0.0f : (k) == 6 ? -0.7071067811865476f :   -0.9238795325112867f)
#define W16S(k) ((k) == 0 ? 0.0f : (k) == 1 ? 0.3826834323650898f : (k) == 2 ? 0.7071067811865476f : (k) == 3 ? 0.9238795325112867f : (k) == 4 ? 1.0f : (k) == 6 ? 0.7071067811865476f :   -0.3826834323650898f)
template <int S, int NSEQ, bool ZIN = false>
DEV_FN void fft_fwd2(LDS_F2 X) {
    constexpr int M = 1 << (2 * S), MP = M + (M >> 5), NG = NSEQ * (M >> 4);
#pragma unroll 1
    for (int pr = 0; pr < S / 2; ++pr) {
        const int s = 2 * pr, n = M >> (2 * s), q = n >> 2, q2 = q >> 2;
        const float invn = 1.0f / (float)n;
        FOR_TID {
#pragma unroll 2
            for (int gi = tid; gi < NG; gi += NTHR) {
                const int seq = gi / (M >> 4), g = gi - seq * (M >> 4), j2 = g & (q2 - 1), base = ((g - j2) << 4) + j2;
                LDS_F2 Xs = X + seq * MP;
                cf2 a[4][4];
#pragma unroll
                for (int r = 0; r < 4; ++r)
#pragma unroll
                    for (int r2 = 0; r2 < 4; ++r2) a[r][r2] = (ZIN && pr == 0 && r >= 2) ? mkf2(0.f, 0.f) : Xs[PADI(base + r * q + r2 * q2)];
                float c1, s1; CIS_REV((float)j2 * invn, c1, s1);
                const cf2 t1 = mkf2(c1, -s1), t2 = cmul(t1, t1), t3 = cmul(t2, t1), t4 = cmul(t2, t2), t8 = cmul(t4, t4), t12 = cmul(t8, t4);
#pragma unroll
                for (int r2 = 0; r2 < 4; ++r2) {
                    bf4_fwd(a[0][r2], a[1][r2], a[2][r2], a[3][r2]);
                    a[1][r2] = cmul(a[1][r2], cmul(t1, mkf2(W16C(r2), -W16S(r2))));
                    a[2][r2] = cmul(a[2][r2], cmul(t2, mkf2(W16C(2 * r2), -W16S(2 * r2))));
                    a[3][r2] = cmul(a[3][r2], cmul(t3, mkf2(W16C(3 * r2), -W16S(3 * r2))));
                }
#pragma unroll
                for (int r = 0; r < 4; ++r) {
                    bf4_fwd(a[r][0], a[r][1], a[r][2], a[r][3]);
                    a[r][1] = cmul(a[r][1], t4); a[r][2] = cmul(a[r][2], t8); a[r][3] = cmul(a[r][3], t12);
                }
#pragma unroll
                for (int r = 0; r < 4; ++r)
#pragma unroll
                    for (int r2 = 0; r2 < 4; ++r2) Xs[PADI(base + r * q + r2 * q2)] = a[r][r2];
            }
        }
        SYNC;
    }
    if (S & 1) {
        FOR_TID {
#pragma unroll 4
            for (int gi = tid; gi < NSEQ * (M >> 2); gi += NTHR) {
                const int seq = gi / (M >> 2), b = gi - seq * (M >> 2);
                LDS_F2 Xs = X + seq * MP;
                cf2 a0 = Xs[PADI(4 * b)], a1 = Xs[PADI(4 * b + 1)], a2 = Xs[PADI(4 * b + 2)], a3 = Xs[PADI(4 * b + 3)];
                bf4_fwd(a0, a1, a2, a3);
                Xs[PADI(4 * b)] = a0; Xs[PADI(4 * b + 1)] = a1; Xs[PADI(4 * b + 2)] = a2; Xs[PADI(4 * b + 3)] = a3;
            }
        }
        SYNC;
    }
}
template <int S, int NSEQ, bool HOUT = false>
DEV_FN void fft_inv2(LDS_F2 X) {
    constexpr int M = 1 << (2 * S), MP = M + (M >> 5), NG = NSEQ * (M >> 4);
    if (S & 1) {
        FOR_TID {
#pragma unroll 4
            for (int gi = tid; gi < NSEQ * (M >> 2); gi += NTHR) {
                const int seq = gi / (M >> 2), b = gi - seq * (M >> 2);
                LDS_F2 Xs = X + seq * MP;
                cf2 a0 = Xs[PADI(4 * b)], a1 = Xs[PADI(4 * b + 1)], a2 = Xs[PADI(4 * b + 2)], a3 = Xs[PADI(4 * b + 3)];
                bf4_inv(a0, a1, a2, a3);
                Xs[PADI(4 * b)] = a0; Xs[PADI(4 * b + 1)] = a1; Xs[PADI(4 * b + 2)] = a2; Xs[PADI(4 * b + 3)] = a3;
            }
        }
        SYNC;
    }
#pragma unroll 1
    for (int pr = S / 2 - 1; pr >= 0; --pr) {
        const int s = 2 * pr, n = M >> (2 * s), q = n >> 2, q2 = q >> 2;
        const float invn = 1.0f / (float)n;
        FOR_TID {
#pragma unroll 2
            for (int gi = tid; gi < NG; gi += NTHR) {
                const int seq = gi / (M >> 4), g = gi - seq * (M >> 4), j2 = g & (q2 - 1), base = ((g - j2) << 4) + j2;
                LDS_F2 Xs = X + seq * MP;
                cf2 a[4][4];
#pragma unroll
                for (int r = 0; r < 4; ++r)
#pragma unroll
                    for (int r2 = 0; r2 < 4; ++r2) a[r][r2] = Xs[PADI(base + r * q + r2 * q2)];
                float c1, s1; CIS_REV((float)j2 * invn, c1, s1);
                const cf2 t1 = mkf2(c1, s1), t2 = cmul(t1, t1), t3 = cmul(t2, t1), t4 = cmul(t2, t2), t8 = cmul(t4, t4), t12 = cmul(t8, t4);
#pragma unroll
                for (int r = 0; r < 4; ++r) {
                    a[r][1] = cmul(a[r][1], t4); a[r][2] = cmul(a[r][2], t8); a[r][3] = cmul(a[r][3], t12);
                    bf4_inv(a[r][0], a[r][1], a[r][2], a[r][3]);
                }
#pragma unroll
                for (int r2 = 0; r2 < 4; ++r2) {
                    a[1][r2] = cmul(a[1][r2], cmul(t1, mkf2(W16C(r2), W16S(r2))));
                    a[2][r2] = cmul(a[2][r2], cmul(t2, mkf2(W16C(2 * r2), W16S(2 * r2))));
                    a[3][r2] = cmul(a[3][r2], cmul(t3, mkf2(W16C(3 * r2), W16S(3 * r2))));
                    bf4_inv(a[0][r2], a[1][r2], a[2][r2], a[3][r2]);
                }
#pragma unroll
                for (int r = 0; r < 4; ++r)
#pragma unroll
                    for (int r2 = 0; r2 < 4; ++r2) if (!(HOUT && pr == 0 && r >= 2)) Xs[PADI(base + r * q + r2 * q2)] = a[r][r2];
            }
        }
        SYNC;
    }
}
DEV_FN void spec_store(LDS_F2 X, int S, cf2* Kp) {
    const int M = 1 << (2 * S);
    FOR_TID {
        for (int pp = tid; pp < (M >> 1); pp += NTHR) {
            const int p = ((pp >> 1) << 2) + (pp & 1);
            if (p == 0) {
                const cf2 c0 = X[PADI(0)]; Kp[0] = mkf2(c0.x + c0.y, c0.x - c0.y);
                const cf2 ch = X[PADI(2)]; Kp[2] = mkf2(ch.x, -ch.y);
            } else {
                const unsigned k = rev4((unsigned)p, S), pm = rev4((unsigned)(M - (int)k), S);
                const cf2 ck = X[PADI(p)], cm = X[PADI((int)pm)];
                const cf2 P = mkf2(0.5f * (ck.x + cm.x), 0.5f * (ck.y - cm.y));
                const cf2 O = mkf2(0.5f * (ck.y + cm.y), -0.5f * (ck.x - cm.x));
                float c, s; CIS_REV((float)k / (float)(2 * M), c, s);
                const cf2 Q = cmul(O, mkf2(c, -s));
                Kp[p] = mkf2(P.x + Q.x, P.y + Q.y);
                Kp[pm] = mkf2(P.x - Q.x, -(P.y - Q.y));
            }
        }
    }
    SYNC;
}
DEV_FN void spec_mul(LDS_F2 X0, int S, const cf2* Kp, int nseq = 1) {
    const int M = 1 << (2 * S);
    FOR_TID {
        for (int pq = tid; pq < nseq * (M >> 1); pq += NTHR) {
            const int sq_ = pq / (M >> 1), pp = pq - sq_ * (M >> 1);
            LDS_F2 X = X0 + sq_ * (M + (M >> 5));
            const int p = ((pp >> 1) << 2) + (pp & 1);
            if (p == 0) {
                const cf2 c0 = X[PADI(0)], k0 = Kp[0];
                const float y0 = (c0.x + c0.y) * k0.x, ym = (c0.x - c0.y) * k0.y;
                X[PADI(0)] = mkf2(0.5f * (y0 + ym), 0.5f * (y0 - ym));
                const cf2 ch = X[PADI(2)], kh = Kp[2];
                const cf2 yh = cmul(mkf2(ch.x, -ch.y), kh);
                X[PADI(2)] = mkf2(yh.x, -yh.y);
            } else {
                const unsigned k = rev4((unsigned)p, S), pm = rev4((unsigned)(M - (int)k), S);
                const cf2 ck = X[PADI(p)], cm = X[PADI((int)pm)];
                const cf2 P = mkf2(0.5f * (ck.x + cm.x), 0.5f * (ck.y - cm.y));
                const cf2 O = mkf2(0.5f * (ck.y + cm.y), -0.5f * (ck.x - cm.x));
                float c, s; CIS_REV((float)k / (float)(2 * M), c, s);
                const cf2 Wk = mkf2(c, -s);
                const cf2 Q = cmul(O, Wk);
                const cf2 xk = mkf2(P.x + Q.x, P.y + Q.y), xm = mkf2(P.x - Q.x, -(P.y - Q.y));
                const cf2 yk = cmul(xk, Kp[p]), ym = cmul(xm, Kp[pm]);
                const cf2 Ye = mkf2(0.5f * (yk.x + ym.x), 0.5f * (yk.y - ym.y));
                const cf2 Yd = mkf2(0.5f * (yk.x - ym.x), 0.5f * (yk.y + ym.y));
                const cf2 Yo = cmulc(Yd, Wk);
                X[PADI(p)] = mkf2(Ye.x - Yo.y, Ye.y + Yo.x);
                X[PADI((int)pm)] = mkf2(Ye.x + Yo.y, -Ye.y + Yo.x);
            }
        }
    }
    SYNC;
}
__device__ void ph_setup(const P& p) {
    const int gid = blockIdx.x * 512 + TIDX;
    if (gid < 2 * D_HG) {
        const int dir = gid / D_HG, c = gid % D_HG;
        float v[NLAYER], mx = -1e30f;
#pragma unroll
        for (int l = 0; l < NLAYER; ++l) { v[l] = p.in[19][(size_t)(dir * NLAYER + l) * D_HG + c]; mx = fmaxf(mx, v[l]); }
        float s = 0.f;
#pragma unroll
        for (int l = 0; l < NLAYER; ++l) { v[l] = expf(v[l] - mx); s += v[l]; }
        float* lbs = (float*)(p.ws + OFF_SMALL);
        float cum = 0.f;
#pragma unroll
        for (int l = 0; l < NLAYER; ++l) { if (l > 0) cum += v[l] / s; lbs[(size_t)(dir * NLAYER + l) * D_HG + c] = cum; }
    }
}
__device__ void ph_copy_params(const P& p) {
    float* pb = (float*)(p.ws + OFF_PB);
    const int g = blockIdx.x * 512 + TIDX, gs = gridDim.x * 512;
    for (int k = g; k < 4096; k += gs) pb[0 + k] = p.in[2][k];
    for (int k = g; k < 4096; k += gs) pb[4096 + k] = p.in[3][k];
    for (int k = g; k < 4096; k += gs) pb[8192 + k] = p.in[4][k];
    for (int k = g; k < 4096; k += gs) pb[12288 + k] = p.in[5][k];
    for (int k = g; k < 18432; k += gs) pb[16384 + k] = p.in[7][k];
    for (int k = g; k < 6144; k += gs) pb[34816 + k] = p.in[8][k];
    for (int k = g; k < 8448; k += gs) pb[40960 + k] = p.in[9][k];
    for (int k = g; k < 256; k += gs) pb[49408 + k] = p.in[10][k];
    for (int k = g; k < 16384; k += gs) pb[49664 + k] = p.in[11][k];
    for (int k = g; k < 256; k += gs) pb[66048 + k] = p.in[12][k];
    for (int k = g; k < 16384; k += gs) pb[66304 + k] = p.in[13][k];
    for (int k = g; k < 256; k += gs) pb[82688 + k] = p.in[14][k];
    for (int k = g; k < 262144; k += gs) pb[82944 + k] = p.in[15][k];
    for (int k = g; k < 256; k += gs) pb[345088 + k] = p.in[16][k];
    for (int k = g; k < 2048; k += gs) pb[345344 + k] = p.in[17][k];
    for (int k = g; k < 2048; k += gs) pb[347392 + k] = p.in[18][k];
    for (int k = g; k < 4096; k += gs) pb[349440 + k] = p.in[19][k];
    for (int k = g; k < 2048; k += gs) pb[353536 + k] = p.in[20][k];
    for (int k = g; k < 98304; k += gs) pb[355584 + k] = p.in[23][k];
    for (int k = g; k < 32768; k += gs) pb[453888 + k] = p.in[24][k];
}
__device__ void convert_one(const float* src, bf16_t* dst, int K, int N, LAS float* tile  , bool geglu_perm = false) {
    const int tiles_n = N / 64, ntiles = (K / 64) * tiles_n, tid = TIDX;
    for (int it = blockIdx.x; it < ntiles; it += gridDim.x) {
        const int k0 = (it / tiles_n) * 64, n0 = (it % tiles_n) * 64;
#pragma unroll
        for (int i = 0; i < 2; ++i) { const int r = (tid >> 4) + 32 * i, c4 = (tid & 15) * 4;
            const nf4 v = *(const nf4*)(src + (size_t)(k0 + r) * N + n0 + c4);
            tile[r * 65 + c4] = v.x; tile[r * 65 + c4 + 1] = v.y; tile[r * 65 + c4 + 2] = v.z; tile[r * 65 + c4 + 3] = v.w; }
        __syncthreads();
        { const int n = tid >> 3, ks = (tid & 7) * 8; int nr = n0 + n;
          if (geglu_perm) nr = nr < DFF ? (nr >> 7) * 256 + (nr & 127) : ((nr - DFF) >> 7) * 256 + 128 + ((nr - DFF) & 127);
          nu4 w;
          w.x = pack_bf2(tile[(ks + 0) * 65 + n], tile[(ks + 1) * 65 + n]); w.y = pack_bf2(tile[(ks + 2) * 65 + n], tile[(ks + 3) * 65 + n]);
          w.z = pack_bf2(tile[(ks + 4) * 65 + n], tile[(ks + 5) * 65 + n]); w.w = pack_bf2(tile[(ks + 6) * 65 + n], tile[(ks + 7) * 65 + n]);
          *(nu4*)(dst + (size_t)nr * K + k0 + ks) = w; }
        __syncthreads();
    }
}
__device__ void ph_convert_w(const P& p, int l, LAS unsigned char* lds) {
    LAS float* tile = (LAS float*)lds;
    convert_one(p.in[6] + (size_t)l * DM * D_IN, (bf16_t*)(p.ws + OFF_W_IN), DM, D_IN, tile);
    convert_one(p.in[21] + (size_t)l * DM * DM, (bf16_t*)(p.ws + OFF_W_OUT), DM, DM, tile);
    convert_one(p.in[22] + (size_t)l * DM * 2 * DFF, (bf16_t*)(p.ws + OFF_W_UP), DM, 2 * DFF, tile, true);
    convert_one(p.in[25] + (size_t)l * DFF * DM, (bf16_t*)(p.ws + OFF_W_DN), DFF, DM, tile);
    { const float* w4 = p.in[15] + (size_t)l * 64 * 1024; bf16_t* w4t = (bf16_t*)(p.ws + OFF_W4T);
      for (int idx = blockIdx.x * 512 + TIDX; idx < 65536; idx += gridDim.x * 512) { const int o = idx >> 6, f = idx & 63; w4t[idx] = f2bf(w4[f * 1024 + o]); } }
}
__device__ __forceinline__ bf16_t* abuf_row(const P& p, int t) { return (bf16_t*)(p.ws + OFF_ABUF) + (size_t)(t + APAD) * DM; }
__device__ void ph_rmsnorm_in(const P& p, int l) {
    const int lane = TIDX & 63, wv = TIDX >> 6;
    const float* gain = p.in[2] + (size_t)l * DM;
    for (int t = blockIdx.x * 8 + wv; t < T_TOK; t += gridDim.x * 8) {
        const float* xr = x_src_row(p, l, t);
        float4 v[4]; float ss = 0.f;
#pragma unroll
        for (int i = 0; i < 4; ++i) { v[i] = *(const float4*)(xr + lane * 4 + 256 * i); ss += v[i].x * v[i].x + v[i].y * v[i].y + v[i].z * v[i].z + v[i].w * v[i].w; }
        ss = wave_sum(ss);
        const float r = rsqrtf(ss * (1.0f / DM) + 1e-6f);
        bf16_t* hr = abuf_row(p, t);
#pragma unroll
        for (int i = 0; i < 4; ++i) { const float4 g = *(const float4*)(gain + lane * 4 + 256 * i);
            uint2 w; w.x = pack_bf2(v[i].x * r * g.x, v[i].y * r * g.y); w.y = pack_bf2(v[i].z * r * g.z, v[i].w * r * g.w);
            *(uint2*)(hr + lane * 4 + 256 * i) = w; }
    }
}
constexpr int NRR = 4;
__device__ __forceinline__ bf16_t* xb_buf(const P& p, bool r6) { return r6 ? (bf16_t*)(p.ws + OFF_R6) : (bf16_t*)((unsigned char*)p.out + 64 * MiB); }
__device__ void ph_norm_resid(const P& p, int l, int which) {
    const int lane = TIDX & 63, wv = TIDX >> 6;
    const float* gpost = (which == 0 ? PRM(p, norm_mix_post) : PRM(p, norm_ffn_post)) + (size_t)l * DM;
    const bool has_next = (which == 0) || (l + 1 < NLAYER);
    const float* gnext = which == 0 ? PRM(p, norm_ffn_pre) + (size_t)l * DM : PRM(p, norm_mix_pre) + (size_t)(has_next ? l + 1 : l) * DM;
    const bf16_t* Y = (const bf16_t*)(p.ws + OFF_MIX);
    const bool in_f32 = (l == 0 && which == 0), out_f32 = (l == NLAYER - 1 && which == 1);
    const bf16_t* xin = xb_buf(p, l == NLAYER - 1 && which == 1);
    bf16_t* xout = xb_buf(p, l == NLAYER - 1 && which == 0);
    nf4 gp[4], gn[4];
#pragma unroll
    for (int i = 0; i < 4; ++i) { gp[i] = *(const nf4*)(gpost + lane * 4 + 256 * i); gn[i] = *(const nf4*)(gnext + lane * 4 + 256 * i); }
    for (int t0 = (blockIdx.x * 8 + wv) * NRR; t0 < T_TOK; t0 += gridDim.x * 8 * NRR) {
        nf4 x[NRR][4]; nu2 yw[NRR][4];
#pragma unroll
        for (int rr = 0; rr < NRR; ++rr) { const bf16_t* yr = Y + (size_t)(t0 + rr) * DM;
            if (in_f32) { const float* xr = x_src_row(p, 0, t0 + rr);
#pragma unroll
                for (int i = 0; i < 4; ++i) x[rr][i] = *(const nf4*)(xr + lane * 4 + 256 * i);
            } else { const bf16_t* xr = xin + (size_t)(t0 + rr) * DM;
#pragma unroll
                for (int i = 0; i < 4; ++i) { const nu2 w = *(const nu2*)(xr + lane * 4 + 256 * i);
                    x[rr][i].x = __uint_as_float(w.x << 16); x[rr][i].y = __uint_as_float(w.x & 0xffff0000u); x[rr][i].z = __uint_as_float(w.y << 16); x[rr][i].w = __uint_as_float(w.y & 0xffff0000u); } }
#pragma unroll
            for (int i = 0; i < 4; ++i) yw[rr][i] = *(const nu2*)(yr + lane * 4 + 256 * i); }
#pragma unroll
        for (int rr = 0; rr < NRR; ++rr) {
            const int t = t0 + rr;
            nf4 y[4]; float ss = 0.f;
#pragma unroll
            for (int i = 0; i < 4; ++i) { const nu2 w = yw[rr][i];
                y[i].x = __uint_as_float(w.x << 16); y[i].y = __uint_as_float(w.x & 0xffff0000u); y[i].z = __uint_as_float(w.y << 16); y[i].w = __uint_as_float(w.y & 0xffff0000u);
                ss += y[i].x * y[i].x + y[i].y * y[i].y + y[i].z * y[i].z + y[i].w * y[i].w; }
            ss = wave_sum(ss);
            const float r = rsqrtf(ss * (1.0f / DM) + 1e-6f);
            float s2 = 0.f;
#pragma unroll
            for (int i = 0; i < 4; ++i) { nf4 xv = x[rr][i];
                xv.x += y[i].x * r * gp[i].x; xv.y += y[i].y * r * gp[i].y; xv.z += y[i].z * r * gp[i].z; xv.w += y[i].w * r * gp[i].w;
                s2 += xv.x * xv.x + xv.y * xv.y + xv.z * xv.z + xv.w * xv.w;
                x[rr][i] = xv;
                if (out_f32) *(nf4*)(p.out + (size_t)t * DM + lane * 4 + 256 * i) = xv;
                else { nu2 w; w.x = pack_bf2(xv.x, xv.y); w.y = pack_bf2(xv.z, xv.w); *(nu2*)(xout + (size_t)t * DM + lane * 4 + 256 * i) = w; } }
            if (has_next) {
                s2 = wave_sum(s2);
                const float r2 = rsqrtf(s2 * (1.0f / DM) + 1e-6f);
                bf16_t* hr = abuf_row(p, t);
#pragma unroll
                for (int i = 0; i < 4; ++i) { const nf4 xv = x[rr][i];
                    nu2 w; w.x = pack_bf2(xv.x * r2 * gn[i].x, xv.y * r2 * gn[i].y); w.y = pack_bf2(xv.z * r2 * gn[i].z, xv.w * r2 * gn[i].w);
                    *(nu2*)(hr + lane * 4 + 256 * i) = w; }
            }
        }
    }
}
__device__ void ph_filter(const P& p, int l, LAS unsigned char* lds) {
    LAS float* feats = (LAS float*)lds;
    LAS float* ha = feats + 16 * 36;
    LAS float* hb = ha + 16 * 64;
    LAS float* w1s = hb + 16 * 64;
    LAS float* w2s = w1s + 33 * 64;
    LAS float* w3s = w2s + 64 * 64;
    LAS bf16_t* h3b = (LAS bf16_t*)(w3s + 64 * 64);
    const int tid = TIDX;
    const float* w1 = PRM(p, f_w1) + (size_t)l * 33 * 64; const float* b1 = PRM(p, f_b1) + (size_t)l * 64;
    const float* w2 = PRM(p, f_w2) + (size_t)l * 64 * 64; const float* b2 = PRM(p, f_b2) + (size_t)l * 64;
    const float* w3 = PRM(p, f_w3) + (size_t)l * 64 * 64; const float* b3 = PRM(p, f_b3) + (size_t)l * 64;
    const float* w4 = PRM(p, f_w4) + (size_t)l * 64 * 1024; const float* fq = PRM(p, f_freq) + (size_t)l * 64;
    float* kt = (float*)(p.ws + OFF_KT);
    for (int i = tid; i < 33 * 64; i += 512) w1s[i] = w1[i];
    for (int i = tid; i < 64 * 64; i += 512) { w2s[i] = w2[i]; w3s[i] = w3[i]; }
    const int j = tid & 63;
    const float fqj = fq[j], b1j = b1[j], b2j = b2[j], b3j = b3[j];
    pg8::bf16x8 bfrag[8][2];
    { const bf16_t* w4t = (const bf16_t*)(p.ws + OFF_W4T); const int lane = tid & 63, w = tid >> 6;
#pragma unroll
      for (int nt = 0; nt < 8; ++nt)
#pragma unroll
          for (int ks = 0; ks < 2; ++ks) bfrag[nt][ks] = *(const pg8::bf16x8*)(w4t + (size_t)(128 * w + 16 * nt + (lane & 15)) * 64 + 32 * ks + 8 * (lane >> 4)); }
    __syncthreads();
    const int nitems = (L_BIG + L_SML) / 16;
    for (int it = blockIdx.x; it < nitems; it += gridDim.x) {
        const bool big = it < L_BIG / 16; const int L = big ? L_BIG : L_SML; const int pos0 = (big ? it : it - L_BIG / 16) * 16;
        float* ktc = kt + (big ? 0 : (size_t)512 * 2 * L_BIG);
        for (int idx = tid; idx < 16 * 33; idx += 512) {
            const int pp = idx / 33, f = idx % 33; const int pos = pos0 + pp;
            const float tt = (float)pos / (float)(L - 1), ang = (6.283185307179586f / (float)L) * (float)pos;
            float v;
            if (f == 0) v = tt;
            else { const int bi = (f - 1) & 15; const float band = 1e-4f + (float)bi * ((15.0f - 1e-4f) / 15.0f); v = f <= 16 ? cosf(band * ang) : -sinf(band * ang); }
            feats[pp * 36 + f] = v;
        }
        __syncthreads();
#pragma unroll
        for (int h2 = 0; h2 < 2; ++h2) { const int pp = (tid >> 6) + 8 * h2; float a = b1j;
            for (int f = 0; f < 33; ++f) a += feats[pp * 36 + f] * w1s[f * 64 + j];
            ha[pp * 64 + j] = __sinf(fqj * a); }
        __syncthreads();
#pragma unroll
        for (int h2 = 0; h2 < 2; ++h2) { const int pp = (tid >> 6) + 8 * h2; float a = b2j;
#pragma unroll 4
            for (int f4 = 0; f4 < 16; ++f4) { const nf4 hv = *(const LAS nf4*)(ha + pp * 64 + 4 * f4);
                a += hv.x * w2s[(4 * f4) * 64 + j] + hv.y * w2s[(4 * f4 + 1) * 64 + j] + hv.z * w2s[(4 * f4 + 2) * 64 + j] + hv.w * w2s[(4 * f4 + 3) * 64 + j]; }
            hb[pp * 64 + j] = __sinf(fqj * a); }
        __syncthreads();
#pragma unroll
        for (int h2 = 0; h2 < 2; ++h2) { const int pp = (tid >> 6) + 8 * h2; float a = b3j;
#pragma unroll 4
            for (int f4 = 0; f4 < 16; ++f4) { const nf4 hv = *(const LAS nf4*)(hb + pp * 64 + 4 * f4);
                a += hv.x * w3s[(4 * f4) * 64 + j] + hv.y * w3s[(4 * f4 + 1) * 64 + j] + hv.z * w3s[(4 * f4 + 2) * 64 + j] + hv.w * w3s[(4 * f4 + 3) * 64 + j]; }
            h3b[pp * 72 + j] = f2bf(__sinf(fqj * a)); }
        __syncthreads();
        {
            const int lane = tid & 63, w = tid >> 6, r16 = lane & 15, kg = lane >> 4;
            pg8::f32x4 acc[8];
#pragma unroll
            for (int nt = 0; nt < 8; ++nt) acc[nt] = (pg8::f32x4){0.f, 0.f, 0.f, 0.f};
            pg8::bf16x8 af[2];
#pragma unroll
            for (int ks = 0; ks < 2; ++ks) af[ks] = *(const LAS pg8::bf16x8*)(h3b + r16 * 72 + 32 * ks + 8 * kg);
#pragma unroll
            for (int nt = 0; nt < 8; ++nt)
#pragma unroll
                for (int ks = 0; ks < 2; ++ks) acc[nt] = __builtin_amdgcn_mfma_f32_16x16x32_bf16(af[ks], bfrag[nt][ks], acc[nt], 0, 0, 0);
            const float invl = 1.0f / (float)(L - 1);
            const float dstep = (15.350567286626972f - 3.0701134573253945f) / 511.0f;
            float tt[4];
#pragma unroll
            for (int i = 0; i < 4; ++i) tt[i] = (float)(pos0 + 4 * kg + i) * invl;
#pragma unroll
            for (int nt = 0; nt < 8; ++nt) { const int o = 128 * w + 16 * nt + r16, dir = o >> 9, c = o & 511;
                const float dl = 3.0701134573253945f + (float)c * dstep;
                nf4 v;
#pragma unroll
                for (int i = 0; i < 4; ++i) v[i] = acc[nt][i] * __expf(-tt[i] * dl);
                *(nf4*)(ktc + (size_t)(c * 2 + dir) * L + pos0 + 4 * kg) = v; }
        }
        __syncthreads();
    }
}
__device__ void ph_hy_prep(const P& p, int l, LAS unsigned char* lds) {
    constexpr int RS = 3 * 128 + 8;
    LAS bf16_t* raw = (LAS bf16_t*)lds;
    LAS bf16_t* ox = (LAS bf16_t*)(lds + 52224);
    LAS bf16_t* oz = ox + 128 * 72;
    const bf16_t* hy = (const bf16_t*)(p.ws + OFF_HYRAW);
    bf16_t* x0t = (bf16_t*)(p.ws + OFF_X0T); bf16_t* zt = (bf16_t*)(p.ws + OFF_ZT);
    const float* cw = PRM(p, hy_conv_w) + (size_t)l * 3 * 1536; const float* cb = PRM(p, hy_conv_b) + (size_t)l * 1536;
    const int tid = TIDX, nitems = (T_TOK / 64) * 4;
    for (int it = blockIdx.x; it < nitems; it += gridDim.x) {
        const int t0 = (it >> 2) * 64, c0 = (it & 3) * 128;
        for (int idx = tid; idx < 66 * 48; idx += 512) {
            const int row = idx / 48, rem = idx - row * 48, a = rem >> 4, pc = rem & 15;
            int t = t0 - 1 + row; t = t < 0 ? 0 : (t >= T_TOK ? T_TOK - 1 : t);
            *(LAS nu4*)(raw + row * RS + a * 128 + pc * 8) = *(const nu4*)(hy + (size_t)t * 1536 + a * 512 + c0 + pc * 8);
        }
        __syncthreads();
        {
            const int c = tid & 127, tq = tid >> 7;
            float wv[3][3], bv[3];
#pragma unroll
            for (int a = 0; a < 3; ++a) { bv[a] = cb[a * 512 + c0 + c];
#pragma unroll
                for (int k = 0; k < 3; ++k) wv[a][k] = cw[k * 1536 + a * 512 + c0 + c]; }
            float xm[3], xc[3];
#pragma unroll
            for (int a = 0; a < 3; ++a) { xm[a] = bf2f(raw[(tq * 16) * RS + a * 128 + c]); xc[a] = bf2f(raw[(tq * 16 + 1) * RS + a * 128 + c]); }
            unsigned px = 0, pz = 0;
#pragma unroll
            for (int j = 0; j < 16; ++j) {
                const int tt = tq * 16 + j, t = t0 + tt;
                const bool hp = !seq_start(t), hn = !seq_end(t);
                float r[3];
#pragma unroll
                for (int a = 0; a < 3; ++a) { const float xp = bf2f(raw[(tt + 2) * RS + a * 128 + c]);
                    r[a] = (hp ? xm[a] * wv[a][0] : 0.f) + xc[a] * wv[a][1] + (hn ? xp * wv[a][2] : 0.f) + bv[a];
                    xm[a] = xc[a]; xc[a] = xp; }
                const unsigned bx = f2bf(r[0]), bz = f2bf(r[1] * r[2]);
                if (j & 1) { px |= bx << 16; pz |= bz << 16;
                    *(LAS unsigned*)(ox + c * 72 + tt - 1) = px; *(LAS unsigned*)(oz + c * 72 + tt - 1) = pz; }
                else { px = bx; pz = bz; }
            }
        }
        __syncthreads();
        for (int idx = tid; idx < 128 * 16; idx += 512) {
            const int c = idx >> 4, rem = idx & 15, arr = rem >> 3, pc = rem & 7;
            const nu4 v = *(const LAS nu4*)((arr ? oz : ox) + c * 72 + pc * 8);
            *(nu4*)((arr ? zt : x0t) + (size_t)(c0 + c) * T_TOK + t0 + pc * 8) = v;
        }
        __syncthreads();
    }
}
__device__ __forceinline__ cf2 ld_f2_agent(const cf2* ptr) {
    const unsigned long long w = __hip_atomic_load((const unsigned long long*)ptr, __ATOMIC_RELAXED, __HIP_MEMORY_SCOPE_AGENT);
    return mkf2(__uint_as_float((unsigned)w), __uint_as_float((unsigned)(w >> 32)));
}
template <int S, int NSEQ>
__device__ __forceinline__ void hy_fft_job(const P& p, int l, LAS cf2* X, cf2* Ks, int c, int tbase) {
    const int tid = TIDX;
    constexpr int M = 1 << (2 * S), L = M, MP = M + (M >> 5);
    const float* kt = (const float*)(p.ws + OFF_KT);
    const bf16_t* x0t = (const bf16_t*)(p.ws + OFF_X0T); bf16_t* zt = (bf16_t*)(p.ws + OFF_ZT);
    const float* hf = kt + (S == 7 ? 0 : (size_t)512 * 2 * L_BIG) + (size_t)(c * 2) * L; const float* hb = hf + L;
#pragma unroll 4
    for (int m = tid; m < M; m += 512) {
        const int n0 = 2 * m, n1 = 2 * m + 1;
        const float a = n0 < L ? hf[n0] : (n0 == L ? 0.f : hb[2 * L - n0]);
        const float b = n1 < L ? hf[n1] : hb[2 * L - n1];
        X[PADI(m)] = mkf2(a, b);
    }
    __syncthreads();
    fft_fwd2<S, 1>(X);
    spec_store(X, S, Ks);
    __builtin_amdgcn_fence(__ATOMIC_ACQUIRE, "agent");
    asm volatile("s_waitcnt vmcnt(0)" ::: "memory");
    __syncthreads();
    const float skip = PRM(p, hy_skip)[(size_t)l * D_HY + c];
    const bf16_t* zrow = zt + (size_t)c * T_TOK + tbase; const bf16_t* xrow = x0t + (size_t)c * T_TOK + tbase;
#pragma unroll 4
    for (int idx = tid; idx < NSEQ * (M >> 1); idx += 512) {
        const int sq = idx / (M >> 1), m = idx - sq * (M >> 1);
        const unsigned w = *(const unsigned*)(zrow + sq * L + 2 * m);
        X[sq * MP + PADI(m)] = mkf2(__uint_as_float(w << 16), __uint_as_float(w & 0xffff0000u));
    }
    __syncthreads();
    fft_fwd2<S, NSEQ, true>(X);
    spec_mul(X, S, Ks, NSEQ);
    fft_inv2<S, NSEQ, true>(X);
    const float inv = 1.0f / (float)M;
    bf16_t* orow = zt + (size_t)c * T_TOK + tbase;
#pragma unroll 4
    for (int idx = tid; idx < NSEQ * (M >> 1); idx += 512) {
        const int sq = idx / (M >> 1), m = idx - sq * (M >> 1);
        const cf2 d = X[sq * MP + PADI(m)];
        const unsigned wz = *(const unsigned*)(zrow + sq * L + 2 * m), wx = *(const unsigned*)(xrow + sq * L + 2 * m);
        const float z0 = __uint_as_float(wz << 16), z1 = __uint_as_float(wz & 0xffff0000u), a0 = __uint_as_float(wx << 16), a1 = __uint_as_float(wx & 0xffff0000u);
        *(unsigned*)(orow + sq * L + 2 * m) = pack_bf2(a0 * (d.x * inv + skip * z0), a1 * (d.y * inv + skip * z1));
    }
    __syncthreads();
}
__device__ void ph_hy_fft(const P& p, int l, LAS unsigned char* lds) {
    LAS cf2* X = (LAS cf2*)lds;
    cf2* Ks = (cf2*)(p.ws + OFF_KS) + (size_t)blockIdx.x * L_BIG;
    for (int job = blockIdx.x; job < 1024; job += gridDim.x) {
        const bool big = job < 512; const int c = job & 511;
        if (big) hy_fft_job<7, 1>(p, l, X, Ks, c, 0); else hy_fft_job<6, 4>(p, l, X, Ks, c, L_BIG);
    }
}
__device__ void ph_hy_norm(const P& p, int l, LAS unsigned char* lds) {
    LAS bf16_t* tl = (LAS bf16_t*)lds;
    LAS float* red = (LAS float*)(lds + 9216);
    const bf16_t* yh = (const bf16_t*)(p.ws + OFF_ZT);
    const float* gain = PRM(p, hy_out_norm) + (size_t)l * D_HY;
    const int tid = TIDX, nitems = (T_TOK / 64) * 8;
    for (int it = blockIdx.x; it < nitems; it += gridDim.x) {
        const int t0 = (it >> 3) * 64, c0 = (it & 7) * 64;
        { const int cc = tid >> 3, pc = tid & 7;
          *(LAS nu4*)(tl + cc * 72 + pc * 8) = *(const nu4*)(yh + (size_t)(c0 + cc) * T_TOK + t0 + pc * 8); }
        __syncthreads();
        { const int tt = tid & 63, part = tid >> 6; float s = 0.f;
#pragma unroll
          for (int j = 0; j < 8; ++j) { const float v = bf2f(tl[(part * 8 + j) * 72 + tt]); s += v * v; }
          red[part * 64 + tt] = s; }
        __syncthreads();
        { const int tt = tid >> 3, pc = tid & 7;
          float s = 0.f;
#pragma unroll
          for (int j = 0; j < 8; ++j) s += red[j * 64 + tt];
          const float r = rsqrtf(s * (1.0f / 64.0f) + 1e-6f);
          unsigned w[4];
#pragma unroll
          for (int j = 0; j < 4; ++j) { const int ca = pc * 8 + 2 * j;
              w[j] = pack_bf2(bf2f(tl[ca * 72 + tt]) * r * gain[c0 + ca], bf2f(tl[(ca + 1) * 72 + tt]) * r * gain[c0 + ca + 1]); }
          nu4 o; o.x = w[0]; o.y = w[1]; o.z = w[2]; o.w = w[3];
          *(nu4*)(abuf_row(p, t0 + tt) + c0 + pc * 8) = o; }
        __syncthreads();
    }
}
typedef short hbf16x8 __attribute__((ext_vector_type(8)));
typedef float hf32x16 __attribute__((ext_vector_type(16)));
constexpr int HSC = 512, HNCH = HSC / 64, HNSC = T_TOK / HSC;
constexpr int QS = 136, KS_ = 72;
constexpr int HL_QH = 0, HL_KH = HL_QH + 64 * QS * 2, HL_QT = HL_KH + 64 * QS * 2, HL_KT = HL_QT + 64 * QS * 2, HL_VT = HL_KT + 128 * KS_ * 2, HL_ST = HL_VT + 128 * KS_ * 2,
              HL_PM = HL_ST + 128 * QS * 2, HL_TOT = HL_PM + 64 * KS_ * 2, HL_EB = HL_TOT + 4 * 128 * 4, HL_END = HL_EB + 128 * 4;
constexpr int HL_OF = HL_QH, OFS = 132;
static_assert(64 * OFS * 4 <= 2 * 64 * QS * 2, "O tile must fit over Qh|Kh");
constexpr size_t OFF_HST = OFF_R6 + 32 * MiB;
constexpr size_t OFF_HAT = OFF_SMALL + 64 * 1024;

__device__ __forceinline__ hf32x16 mfma32(hbf16x8 a, hbf16x8 b, hf32x16 c) { return __builtin_amdgcn_mfma_f32_32x32x16_bf16(a, b, c, 0, 0, 0); }
__device__ __forceinline__ hbf16x8 lds_frag(const LAS unsigned char* base, int row, int stride_el, int col_el) { return *(const LAS hbf16x8*)(base + ((size_t)row * stride_el + col_el) * 2); }

typedef unsigned hu32x4 __attribute__((ext_vector_type(4)));
struct HgPre { hu32x4 f0, f1, v0, v1, q0, q1; };
template <bool FULL>
__device__ __forceinline__ void hg_fetch(const bf16_t* hg, HgPre& pre, int tokbase, int dirsign, int h, int dir) {
    const int tid = TIDX;
    { const int u = tid >> 4, seg = tid & 15;
      const bf16_t* row = hg + (size_t)(tokbase + dirsign * u) * 2560 + h * 128 + seg * 8;
      pre.f0 = *(const hu32x4*)(row + 512 + 512 * dir); pre.v0 = *(const hu32x4*)(row + 1536); if (FULL) pre.q0 = *(const hu32x4*)(row);
      const bf16_t* row1 = row + (size_t)dirsign * 32 * 2560;
      pre.f1 = *(const hu32x4*)(row1 + 512 + 512 * dir); pre.v1 = *(const hu32x4*)(row1 + 1536); if (FULL) pre.q1 = *(const hu32x4*)(row1); }
}
template <bool FULL>
__device__ __forceinline__ void hg_prep(LAS unsigned char* lds, const HgPre& pre, float lb, float& Bsum_out) {
    const int tid = TIDX, d = tid & 127, qt = tid >> 7;
    LAS float* tot = (LAS float*)(lds + HL_TOT); LAS float* eB = (LAS float*)(lds + HL_EB);
    { const int u = tid >> 4, seg = tid & 15;
      *(LAS hu32x4*)(lds + HL_KH + ((size_t)u * QS + seg * 8) * 2) = pre.f0; *(LAS hu32x4*)(lds + HL_KH + ((size_t)(u + 32) * QS + seg * 8) * 2) = pre.f1;
      *(LAS hu32x4*)(lds + HL_QH + ((size_t)u * QS + seg * 8) * 2) = pre.v0; *(LAS hu32x4*)(lds + HL_QH + ((size_t)(u + 32) * QS + seg * 8) * 2) = pre.v1;
      if (FULL) { *(LAS hu32x4*)(lds + HL_QT + ((size_t)u * QS + seg * 8) * 2) = pre.q0; *(LAS hu32x4*)(lds + HL_QT + ((size_t)(u + 32) * QS + seg * 8) * 2) = pre.q1; } }
    __syncthreads();
    float c[16];
    float run = 0.f;
    const float oml = 1.0f - lb;
    float zz[16];
#pragma unroll
    for (int j = 0; j < 16; ++j) zz[j] = bf2f(*(const LAS bf16_t*)(lds + HL_KH + ((size_t)(qt * 16 + j) * QS + d) * 2));
    __builtin_amdgcn_sched_barrier(0);
#pragma unroll
    for (int j = 0; j < 16; ++j) {
        const int u = qt * 16 + j;
        const float z = fmaxf(zz[j], -60.0f);
        const float f = lb + oml * __builtin_amdgcn_rcpf(1.0f + __expf(-z));
        zz[j] = 1.0f - f;
        run += __logf(f);
        c[j] = run;
    }
    tot[qt * 128 + d] = run;
    float vv[16], qq[16];
#pragma unroll
    for (int j = 0; j < 16; ++j) { vv[j] = __uint_as_float((unsigned)(*(const LAS bf16_t*)(lds + HL_QH + ((size_t)(qt * 16 + j) * QS + d) * 2)));
        if (FULL) qq[j] = bf2f(*(const LAS bf16_t*)(lds + HL_QT + ((size_t)(qt * 16 + j) * QS + d) * 2)); }
    __syncthreads();
    const float t0 = tot[d], t1 = tot[128 + d], t2 = tot[256 + d], t3 = tot[384 + d];
    const float off = qt == 0 ? 0.f : (qt == 1 ? t0 : (qt == 2 ? t0 + t1 : t0 + t1 + t2));
    const float r = t0 + t1, B = t0 + t1 + t2 + t3;
    const float eBr = __expf(B - r), eR = __expf(r);
    if (qt == 0) eB[d] = __expf(B);
    Bsum_out = B;
#pragma unroll
    for (int jj = 0; jj < 8; ++jj) {
        unsigned pkt = 0, pvt = 0;
#pragma unroll
        for (int q2 = 0; q2 < 2; ++q2) {
            const int j = jj * 2 + q2, u = qt * 16 + j;
            const float rb = r - (off + c[j]);
            const float kh = zz[j] * __expf(rb);
            pkt |= (unsigned)f2bf(kh * eBr) << (16 * q2); pvt |= __float_as_uint(vv[j]) << (16 * q2);
            if (FULL) {
                const float zq = qq[j];
                const float q = zq * __builtin_amdgcn_rcpf(1.0f + __expf(-zq));
                const float qh = q * __expf(-rb);
                *(LAS bf16_t*)(lds + HL_QT + ((size_t)u * QS + d) * 2) = f2bf(qh * eR);
                *(LAS bf16_t*)(lds + HL_QH + ((size_t)u * QS + d) * 2) = f2bf(qh);
                *(LAS bf16_t*)(lds + HL_KH + ((size_t)u * QS + d) * 2) = f2bf(kh);
            }
        }
        *(LAS unsigned*)(lds + HL_KT + ((size_t)d * KS_ + qt * 16 + jj * 2) * 2) = pkt;
        *(LAS unsigned*)(lds + HL_VT + ((size_t)d * KS_ + qt * 16 + jj * 2) * 2) = pvt;
    }
    __syncthreads();
}
__device__ __forceinline__ void hg_state_update(LAS unsigned char* lds, hf32x16 (&S)[2], int w, int lane) {
    const int en = w & 3, r = lane & 31, hh = lane >> 5;
    const LAS float* eB = (const LAS float*)(lds + HL_EB);
#pragma unroll
    for (int i = 0; i < 2; ++i) {
        const int dm = (w >> 2) * 2 + i;
#pragma unroll
        for (int g = 0; g < 4; ++g) { const nf4 sc = *(const LAS nf4*)(eB + 32 * dm + 8 * g + 4 * hh);
            S[i][4 * g + 0] *= sc.x; S[i][4 * g + 1] *= sc.y; S[i][4 * g + 2] *= sc.z; S[i][4 * g + 3] *= sc.w; }
#pragma unroll
        for (int ks = 0; ks < 4; ++ks) {
            const hbf16x8 a = lds_frag(lds + HL_KT, 32 * dm + r, KS_, 16 * ks + 8 * hh);
            const hbf16x8 b = lds_frag(lds + HL_VT, 32 * en + r, KS_, 16 * ks + 8 * hh);
            S[i] = mfma32(a, b, S[i]);
        }
    }
}
__device__ __forceinline__ int hg_unit_base(int sc) { return sc * HSC; }
__device__ void ph_hg_pass1(const P& p, int l, LAS unsigned char* lds) {
    const bf16_t* hg = (const bf16_t*)(p.ws + OFF_HG);
    const float* lbs = (const float*)(p.ws + OFF_SMALL);
    float* ust = (float*)(p.ws + OFF_HST); float* atot = (float*)(p.ws + OFF_HAT);
    const int tid = TIDX, w = tid >> 6, lane = tid & 63;
    for (int unit = blockIdx.x; unit < HNSC * 8; unit += gridDim.x) {
        const int sc = unit >> 3, h = (unit >> 1) & 3, dir = unit & 1;
        const float lb = lbs[(size_t)(dir * NLAYER + l) * D_HG + h * 128 + (tid & 127)];
        hf32x16 S[2];
#pragma unroll
        for (int i = 0; i < 2; ++i)
#pragma unroll
            for (int k = 0; k < 16; ++k) S[i][k] = 0.f;
        float Btot = 0.f;
        const int dsg = dir ? -1 : 1, tb0 = dir ? hg_unit_base(sc) + HSC - 1 : hg_unit_base(sc);
        HgPre pre;
        hg_fetch<false>(hg, pre, tb0, dsg, h, dir);
        for (int ci = 0; ci < HNCH; ++ci) {
            float B;
            hg_prep<false>(lds, pre, lb, B);
            if (ci + 1 < HNCH) hg_fetch<false>(hg, pre, tb0 + dsg * (ci + 1) * 64, dsg, h, dir);
            Btot += B;
            hg_state_update(lds, S, w, lane);
            __syncthreads();
        }
        float* U = ust + (size_t)unit * 16384;
        int r = lane & 31, hh = lane >> 5; asm volatile("" : "+v"(r), "+v"(hh));
        const int en = w & 3;
#pragma unroll
        for (int i = 0; i < 2; ++i) { const int dm = (w >> 2) * 2 + i;
#pragma unroll
            for (int k = 0; k < 16; ++k) U[(32 * dm + (k & 3) + 8 * (k >> 2) + 4 * hh) * 128 + 32 * en + r] = S[i][k]; }
        if (tid < 128) atot[(size_t)unit * 128 + tid] = __expf(Btot);
    }
}
__device__ void ph_hg_pass2(const P& p) {
    float* ust = (float*)(p.ws + OFF_HST); const float* atot = (const float*)(p.ws + OFF_HAT);
    const int total = 5 * 8 * 16384;
    for (int idx = blockIdx.x * 512 + TIDX; idx < total; idx += gridDim.x * 512) {
        const int el = idx & 16383, hd = (idx >> 14) & 7, sq = idx >> 17;
        const int sc0 = sq == 0 ? 0 : 32 + 8 * (sq - 1), nsc = sq == 0 ? 32 : 8, dir = hd & 1, d = el >> 7;
        float carry = 0.f;
        for (int j0 = 0; j0 < nsc; j0 += 8) {
            float u[8], a[8];
#pragma unroll
            for (int jj = 0; jj < 8; ++jj) { const int j = j0 + jj, sc = dir ? sc0 + nsc - 1 - j : sc0 + j; const size_t unit = (size_t)sc * 8 + hd;
                u[jj] = ust[unit * 16384 + el]; a[jj] = atot[unit * 128 + d]; }
#pragma unroll
            for (int jj = 0; jj < 8; ++jj) { const int j = j0 + jj, sc = dir ? sc0 + nsc - 1 - j : sc0 + j; const size_t unit = (size_t)sc * 8 + hd;
                ust[unit * 16384 + el] = carry; carry = a[jj] * carry + u[jj]; }
        }
    }
}
__device__ void ph_hg_pass3(const P& p, int l, LAS unsigned char* lds) {
    const bf16_t* hg = (const bf16_t*)(p.ws + OFF_HG);
    const float* lbs = (const float*)(p.ws + OFF_SMALL);
    const float* ust = (const float*)(p.ws + OFF_HST);
    const float* gain = PRM(p, hg_out_norm) + (size_t)l * D_HG;
    const int tid = TIDX, w = tid >> 6, lane = tid & 63, r = lane & 31, hh = lane >> 5;
    for (int unit = blockIdx.x; unit < HNSC * 4; unit += gridDim.x) {
        const int sc = unit >> 2, h = unit & 3;
        for (int dir = 0; dir < 2; ++dir) {
            const float lb = lbs[(size_t)(dir * NLAYER + l) * D_HG + h * 128 + (tid & 127)];
            const float* S0 = ust + ((size_t)sc * 8 + h * 2 + dir) * 16384;
            hf32x16 S[2];
            { const int en = w & 3;
              int r_ = r, hh_ = hh; asm volatile("" : "+v"(r_), "+v"(hh_));
              const float* S0l = S0 + (4 * hh_) * 128 + 32 * en + r_;
#pragma unroll
              for (int i = 0; i < 2; ++i) { const int dm = (w >> 2) * 2 + i;
#pragma unroll
                  for (int k = 0; k < 16; ++k) S[i][k] = S0l[(32 * dm + (k & 3) + 8 * (k >> 2)) * 128];
#pragma unroll
                  for (int g = 0; g < 4; ++g) { nu2 wv; wv.x = pack_bf2(S[i][4 * g], S[i][4 * g + 1]); wv.y = pack_bf2(S[i][4 * g + 2], S[i][4 * g + 3]);
                      *(LAS nu2*)(lds + HL_ST + ((size_t)(32 * en + r) * QS + 32 * dm + 8 * g + 4 * hh) * 2) = wv; } } }
            const int dsg = dir ? -1 : 1, tb0 = dir ? hg_unit_base(sc) + HSC - 1 : hg_unit_base(sc);
            HgPre pre;
            hg_fetch<true>(hg, pre, tb0, dsg, h, dir);
            for (int ci = 0; ci < HNCH; ++ci) {
                const int tokbase = tb0 + dsg * ci * 64;
                float Bdummy;
                hg_prep<true>(lds, pre, lb, Bdummy);
                if (ci + 1 < HNCH) hg_fetch<true>(hg, pre, tb0 + dsg * (ci + 1) * 64, dsg, h, dir);
                if (w < 4) {
                    const int tm = (w == 0 || w == 3) ? 0 : 1, sn = (w == 2 || w == 3) ? 1 : 0;
                    hf32x16 acc;
#pragma unroll
                    for (int k = 0; k < 16; ++k) acc[k] = 0.f;
                    if (w < 3) {
#pragma unroll
                        for (int ks = 0; ks < 8; ++ks) acc = mfma32(lds_frag(lds + HL_QH, 32 * tm + r, QS, 16 * ks + 8 * hh), lds_frag(lds + HL_KH, 32 * sn + r, QS, 16 * ks + 8 * hh), acc);
                    }
                    const int s_ = 32 * sn + r;
#pragma unroll
                    for (int k = 0; k < 16; ++k) { const int t_ = 32 * tm + (k & 3) + 8 * (k >> 2) + 4 * hh;
                        const float v = (w < 3 && s_ <= t_) ? acc[k] : 0.f;
                        *(LAS bf16_t*)(lds + HL_PM + ((size_t)t_ * KS_ + s_) * 2) = f2bf(v); }
                }
                __syncthreads();
                hf32x16 o;
                { const int tm = w >> 2, en = w & 3;
#pragma unroll
                  for (int k = 0; k < 16; ++k) o[k] = 0.f;
#pragma unroll
                  for (int ks = 0; ks < 4; ++ks) o = mfma32(lds_frag(lds + HL_PM, 32 * tm + r, KS_, 16 * ks + 8 * hh), lds_frag(lds + HL_VT, 32 * en + r, KS_, 16 * ks + 8 * hh), o);
#pragma unroll
                  for (int ks = 0; ks < 8; ++ks) o = mfma32(lds_frag(lds + HL_QT, 32 * tm + r, QS, 16 * ks + 8 * hh), lds_frag(lds + HL_ST, 32 * en + r, QS, 16 * ks + 8 * hh), o);
                }
                __syncthreads();
                { const int tm = w >> 2, en = w & 3; LAS float* Of = (LAS float*)(lds + HL_OF);
#pragma unroll
                  for (int k = 0; k < 16; ++k) Of[(size_t)(32 * tm + (k & 3) + 8 * (k >> 2) + 4 * hh) * OFS + 32 * en + r] = o[k]; }
                hg_state_update(lds, S, w, lane);
                { const int en = w & 3;
#pragma unroll
                  for (int i = 0; i < 2; ++i) { const int dm = (w >> 2) * 2 + i;
#pragma unroll
                      for (int g = 0; g < 4; ++g) { nu2 wv; wv.x = pack_bf2(S[i][4 * g], S[i][4 * g + 1]); wv.y = pack_bf2(S[i][4 * g + 2], S[i][4 * g + 3]);
                          *(LAS nu2*)(lds + HL_ST + ((size_t)(32 * en + r) * QS + 32 * dm + 8 * g + 4 * hh) * 2) = wv; } } }
                __syncthreads();
                { const int u = tid >> 3, e0 = (tid & 7) * 16, tok = tokbase + dsg * u;
                  const LAS float* Of = (const LAS float*)(lds + HL_OF) + (size_t)u * OFS + e0;
                  bf16_t* dst = abuf_row(p, tok) + 512 + h * 128 + e0;
                  float v[16];
#pragma unroll
                  for (int j = 0; j < 4; ++j) { const nf4 t4 = *(const LAS nf4*)(Of + 4 * j); v[4 * j] = t4.x; v[4 * j + 1] = t4.y; v[4 * j + 2] = t4.z; v[4 * j + 3] = t4.w; }
                  if (dir == 0) {
                      uint4 w0, w1;
                      w0.x = pack_bf2(v[0], v[1]); w0.y = pack_bf2(v[2], v[3]); w0.z = pack_bf2(v[4], v[5]); w0.w = pack_bf2(v[6], v[7]);
                      w1.x = pack_bf2(v[8], v[9]); w1.y = pack_bf2(v[10], v[11]); w1.z = pack_bf2(v[12], v[13]); w1.w = pack_bf2(v[14], v[15]);
                      ((uint4*)dst)[0] = w0; ((uint4*)dst)[1] = w1;
                  } else {
                      const uint4 f0 = ((const uint4*)dst)[0], f1 = ((const uint4*)dst)[1];
                      const unsigned fw[8] = {f0.x, f0.y, f0.z, f0.w, f1.x, f1.y, f1.z, f1.w};
                      float ss = 0.f;
#pragma unroll
                      for (int j = 0; j < 8; ++j) { v[2 * j] += __uint_as_float(fw[j] << 16); v[2 * j + 1] += __uint_as_float(fw[j] & 0xffff0000u); ss += v[2 * j] * v[2 * j] + v[2 * j + 1] * v[2 * j + 1]; }
                      ss += __shfl_xor(ss, 1); ss += __shfl_xor(ss, 2); ss += __shfl_xor(ss, 4);
                      const float rn = rsqrtf(ss * (1.0f / 128.0f) + 1e-6f);
                      const bf16_t* gp = hg + (size_t)tok * 2560 + 2048 + h * 128 + e0;
                      const uint4 g0 = ((const uint4*)gp)[0], g1 = ((const uint4*)gp)[1];
                      const unsigned gw[8] = {g0.x, g0.y, g0.z, g0.w, g1.x, g1.y, g1.z, g1.w};
                      unsigned ow[8];
#pragma unroll
                      for (int j = 0; j < 8; ++j) { const float ga = silu_f(__uint_as_float(gw[j] << 16)), gb = silu_f(__uint_as_float(gw[j] & 0xffff0000u));
                          ow[j] = pack_bf2(v[2 * j] * rn * gain[h * 128 + e0 + 2 * j] * ga, v[2 * j + 1] * rn * gain[h * 128 + e0 + 2 * j + 1] * gb); }
                      ((uint4*)dst)[0] = make_uint4(ow[0], ow[1], ow[2], ow[3]); ((uint4*)dst)[1] = make_uint4(ow[4], ow[5], ow[6], ow[7]);
                  }
                }
                __syncthreads();
            }
        }
    }
}
#define XB_TMO      128
#define XB_XCNT(j)  (256  + 64 * (j))
#define XB_XSUB(j)  (1280 + 64 * (j))
#define XB_XGEN(j)  (2304 + 64 * (j))
#define XB_TOP      3328
#define XB_TOPGEN   3392
#define XCD_BAR_WORDS 3456
#define XB_SPIN_CAP (1u << 18)

__device__ __forceinline__ unsigned xb_ld(unsigned* p)              { return __hip_atomic_load(p, __ATOMIC_RELAXED, __HIP_MEMORY_SCOPE_AGENT); }
__device__ __forceinline__ unsigned xb_add(unsigned* p, unsigned v) { return __hip_atomic_fetch_add(p, v, __ATOMIC_RELAXED, __HIP_MEMORY_SCOPE_AGENT); }
__device__ __forceinline__ unsigned xb_xcc_id() { return (unsigned)__builtin_amdgcn_s_getreg((3 << 11) | 20) & 0xFu; }
#define XB_SPIN(cond, bar) do { unsigned _sp = 0; while (cond) { __builtin_amdgcn_s_sleep(1); \
    if ((++_sp & 255u) == 0u) { if (xb_ld(&(bar)[XB_TMO])) break; if (_sp > XB_SPIN_CAP) { atomicAdd(&(bar)[XB_TMO], 1u); break; } } } } while (0)

struct XcdBarrier {
    unsigned* bar; unsigned x;
    volatile LAS unsigned* st;
};

__device__ __forceinline__ XcdBarrier xcd_barrier_post(unsigned* bar, volatile LAS unsigned* st) {
    XcdBarrier b; b.bar = bar; b.x = xb_xcc_id(); b.st = st;
    if (TIDX == 0) (void)xb_add(&bar[XB_XCNT(b.x)], 1u);
    return b;
}
__device__ __forceinline__ void xcd_barrier_complete(unsigned* bar, unsigned x, unsigned& nloc, unsigned& nx) {
    const unsigned G = gridDim.x * gridDim.y * gridDim.z;
    unsigned sum, cnt, mine, sp = 0u;
    for (;;) {
        sum = 0u; cnt = 0u; mine = 0u;
#pragma unroll
        for (unsigned j = 0; j < 16; ++j) { const unsigned c = xb_ld(&bar[XB_XCNT(j)]); sum += c; cnt += (c > 0u) ? 1u : 0u; mine = (j == x) ? c : mine; }
        if (sum == G) break;
        __builtin_amdgcn_s_sleep(1);
        if ((++sp & 255u) == 0u) { if (xb_ld(&bar[XB_TMO])) break; if (sp > XB_SPIN_CAP) { atomicAdd(&bar[XB_TMO], 1u); break; } }
    }
    nloc = mine > 0u ? mine : 1u; nx = cnt > 0u ? cnt : 1u;
}

__device__ __forceinline__ void xcd_barrier(const XcdBarrier& b) {
    asm volatile("s_waitcnt vmcnt(0)" ::: "memory");
    __syncthreads();
    if (TIDX == 0) {
        unsigned* bar = b.bar;
        __builtin_amdgcn_s_waitcnt(0);
        unsigned nloc = b.st[0], nx = b.st[1];
        if (nloc == 0u) { xcd_barrier_complete(bar, b.x, nloc, nx); b.st[0] = nloc; b.st[1] = nx; }
        const unsigned old = xb_add(&bar[XB_XSUB(b.x)], 1u);
        const unsigned gen = old / nloc;
        if (old + 1u == (gen + 1u) * nloc) {
            __builtin_amdgcn_fence(__ATOMIC_RELEASE, "agent");
            asm volatile("s_waitcnt vmcnt(0)" ::: "memory");
            const unsigned og = xb_add(&bar[XB_TOP], 1u);
            const unsigned tg = og / nx;
            if (og + 1u == (tg + 1u) * nx) xb_add(&bar[XB_TOPGEN], 1u);
            else XB_SPIN(xb_ld(&bar[XB_TOPGEN]) == tg, bar);
            __builtin_amdgcn_fence(__ATOMIC_ACQUIRE, "agent");
            xb_add(&bar[XB_XGEN(b.x)], 1u);
            asm volatile("s_waitcnt vmcnt(0)" ::: "memory");
        } else {
            XB_SPIN(xb_ld(&bar[XB_XGEN(b.x)]) == gen, bar);
            __builtin_amdgcn_fence(__ATOMIC_ACQUIRE, "agent");
            asm volatile("s_waitcnt vmcnt(0)" ::: "memory");
        }
    }
    __syncthreads();
}

enum { PH_SETUP, PH_CONVERT, PH_RMS_IN, PH_GEMM_IN, PH_HY_PREP, PH_FILTER, PH_HGRN, PH_HG_NORM, PH_HY_FFT, PH_HY_NORM, PH_GEMM_OUT, PH_NR0, PH_GEMM_UP, PH_GEGLU, PH_GEMM_DN, PH_NR1, PH_HG_P1, PH_HG_P2, PH_HG_P3 };
template <int PH> __device__ __forceinline__ void run_phase(const P& p_in, int l, int part, LAS unsigned char* lds) {
    typedef __attribute__((address_space(1))) unsigned char* gptr_t; typedef __attribute__((address_space(1))) float* gfptr_t;
    gptr_t wsg = (gptr_t)p_in.ws; gfptr_t outg = (gfptr_t)p_in.out;
    asm volatile("" : "+s"(wsg), "+s"(outg));
    P p = p_in; p.ws = (unsigned char*)wsg; p.out = (float*)outg;
    if constexpr (PH == PH_SETUP) { ph_setup(p); ph_copy_params(p); }
    if constexpr (PH == PH_CONVERT) ph_convert_w(p, l, lds);
    if constexpr (PH == PH_RMS_IN) ph_rmsnorm_in(p, l);
    if constexpr (PH == PH_GEMM_IN) { EpiBf16Split E; E.O0 = (bf16_t*)(p.ws + OFF_HYRAW); E.ldc0 = 1536; E.O1 = (bf16_t*)(p.ws + OFF_HG); E.ldc1 = 2560; E.csplit = 1536;
        run_gemm(lds, abuf_row(p, 0), (const bf16_t*)(p.ws + OFF_W_IN), T_TOK, D_IN, DM, E); }
    if constexpr (PH == PH_HY_PREP) ph_hy_prep(p, l, lds);
    if constexpr (PH == PH_FILTER) ph_filter(p, l, lds);
    if constexpr (PH == PH_HY_FFT) ph_hy_fft(p, l, lds);
    if constexpr (PH == PH_HY_NORM) ph_hy_norm(p, l, lds);
    if constexpr (PH == PH_GEMM_OUT) { EpiBf16Split E; E.O0 = (bf16_t*)(p.ws + OFF_MIX); E.ldc0 = DM; E.O1 = E.O0; E.ldc1 = DM; E.csplit = 1 << 30;
        run_gemm(lds, abuf_row(p, 0), (const bf16_t*)(p.ws + OFF_W_OUT), T_TOK, DM, DM, E); }
    if constexpr (PH == PH_NR0) ph_norm_resid(p, l, 0);
    if constexpr (PH == PH_GEMM_UP) { EpiGeglu E; E.act = (bf16_t*)(p.ws + OFF_ACT); E.cw = PRM(p, ffn_conv_w) + (size_t)l * 3 * 8192; E.cb = PRM(p, ffn_conv_b) + (size_t)l * 8192;
        run_gemm(lds, abuf_row(p, -1), (const bf16_t*)(p.ws + OFF_W_UP), 133 * 256, 2 * DFF, DM, E); }
    if constexpr (PH == PH_GEMM_DN) { EpiBf16Split E; E.O0 = (bf16_t*)(p.ws + OFF_MIX); E.ldc0 = DM; E.O1 = E.O0; E.ldc1 = DM; E.csplit = 1 << 30;
        run_gemm(lds, (const bf16_t*)(p.ws + OFF_ACT), (const bf16_t*)(p.ws + OFF_W_DN), T_TOK, DM, DFF, E); }
    if constexpr (PH == PH_NR1) ph_norm_resid(p, l, 1);
    if constexpr (PH == PH_HG_P1) ph_hg_pass1(p, l, lds);
    if constexpr (PH == PH_HG_P2) ph_hg_pass2(p);
    if constexpr (PH == PH_HG_P3) ph_hg_pass3(p, l, lds);
}
constexpr int LDS_BYTES = 139264;
__global__ __launch_bounds__(512, 2) void mega(P p) {
    extern __shared__ __attribute__((aligned(16))) unsigned char lds_g[];
    LAS unsigned char* lds = (LAS unsigned char*)lds_g;
    cg::grid_group grid = cg::this_grid();
    volatile LAS unsigned* xst = (volatile LAS unsigned*)(lds + LDS_BYTES - 16);
    if (TIDX == 0) { xst[0] = 0u; xst[1] = 0u; }
    __syncthreads();
    const XcdBarrier xb = xcd_barrier_post((unsigned*)(p.ws + OFF_BAR), xst);
    run_phase<PH_SETUP>(p, 0, 0, lds);
    run_phase<PH_CONVERT>(p, 0, 0, lds);
    run_phase<PH_RMS_IN>(p, 0, 0, lds);
    grid.sync();
#pragma unroll 1
    for (int l = 0; l < NLAYER; ++l) {
        run_phase<PH_GEMM_IN>(p, l, 0, lds); xcd_barrier(xb);
        run_phase<PH_HY_PREP>(p, l, 0, lds); run_phase<PH_HG_P1>(p, l, 0, lds); xcd_barrier(xb);
        run_phase<PH_FILTER>(p, l, 0, lds); run_phase<PH_HG_P2>(p, l, 0, lds); xcd_barrier(xb);
        run_phase<PH_HG_P3>(p, l, 0, lds); run_phase<PH_HY_FFT>(p, l, 0, lds); xcd_barrier(xb);
        run_phase<PH_HY_NORM>(p, l, 0, lds); xcd_barrier(xb);
        run_phase<PH_GEMM_OUT>(p, l, 0, lds); xcd_barrier(xb);
        run_phase<PH_NR0>(p, l, 0, lds); xcd_barrier(xb);
        run_phase<PH_GEMM_UP>(p, l, 0, lds); xcd_barrier(xb);
        run_phase<PH_GEMM_DN>(p, l, 0, lds); xcd_barrier(xb);
        run_phase<PH_NR1>(p, l, 0, lds);
        if (l + 1 < NLAYER) { run_phase<PH_CONVERT>(p, l + 1, 0, lds); xcd_barrier(xb); }
    }
}
extern "C" void kernel_launch(void* const* d_in, const int* in_sizes, int n_in, void* d_out, int out_size, void* d_ws, size_t ws_size, hipStream_t stream) {
    if (ws_size < WS_NEED) { fprintf(stderr, "workspace too small: %zu < %zu\n", ws_size, (size_t)WS_NEED); return; }
    static int grid_blocks = 0;
    if (!grid_blocks) {
        hipFuncSetAttribute((const void*)mega, hipFuncAttributeMaxDynamicSharedMemorySize, LDS_BYTES);
        int dev = 0, cus = 0, per_cu = 0;
        hipGetDevice(&dev);
        hipDeviceGetAttribute(&cus, hipDeviceAttributeMultiprocessorCount, dev);
        hipOccupancyMaxActiveBlocksPerMultiprocessor(&per_cu, mega, 512, LDS_BYTES);
        if (per_cu > 1) per_cu = 1;
        grid_blocks = cus * per_cu;
    }
    P p{};
    for (int i = 0; i < 26; ++i) p.in[i] = (const float*)d_in[i];
    p.out = (float*)d_out; p.ws = (unsigned char*)d_ws;
    hipMemsetAsync((unsigned char*)d_ws + OFF_BAR, 0, XCD_BAR_WORDS * 4, stream);
    void* args[] = {&p};
    hipError_t e = hipLaunchCooperativeKernel((void*)mega, dim3(grid_blocks), dim3(512), args, LDS_BYTES, stream);
    if (e != hipSuccess) fprintf(stderr, "cooperative launch failed: %s (grid %d)\n", hipGetErrorString(e), grid_blocks);
}
```

```cpp
#include <hip/hip_runtime.h>
#include <hip/hip_cooperative_groups.h>
#include <cstdio>
#include <cstdint>
namespace cg = cooperative_groups;
__device__ __forceinline__ int tid_opaque() { int t = (int)threadIdx.x; asm volatile("" : "+v"(t)); return t; }
#define TIDX tid_opaque()
#define LAS __attribute__((address_space(3)))
typedef float cf2 __attribute__((ext_vector_type(2)));
typedef float nf4 __attribute__((ext_vector_type(4)));
typedef unsigned nu2 __attribute__((ext_vector_type(2)));
typedef unsigned nu4 __attribute__((ext_vector_type(4)));
namespace pg8 {
#define PG8_LAS __attribute__((address_space(3)))
typedef unsigned short bf16_t;
typedef short bf16x8 __attribute__((ext_vector_type(8)));
typedef float f32x4 __attribute__((ext_vector_type(4)));
typedef unsigned u32x4 __attribute__((ext_vector_type(4)));
constexpr int BM = 256, BK = 64, HALF = 128, HTB = HALF * BK * 2  , STAGE_BYTES = 8 * HTB, NXCD = 8, WGM = 8;

__host__ __device__ __forceinline__ int lds_byte(int r, int c) { const int st = (r >> 4) * 2 + (c >> 5), rr = r & 15, cc = c & 31, ob = rr * 64 + cc * 2; return st * 1024 + (ob ^ (((ob >> 9) & 1) << 5)); }
__host__ __device__ __forceinline__ void stage_rc(int b, int& R, int& C) { const int st = b / 1024, sb = b % 1024, swz = sb ^ (((sb >> 9) & 1) << 5); R = (st >> 1) * 16 + swz / 64; C = (st & 1) * 32 + (swz % 64) / 2; }
__host__ __device__ __forceinline__ int perm32(int rho) { const int n = rho >> 4, i = rho & 15; return 8 * (i >> 2) + 4 * n + (i & 3); }

struct Unit { int pm, pn; };
struct Gemm { const bf16_t* A; const bf16_t* Bt; int M, N, K; int ovl; };

struct StaticOrder {
    int nM, nN, nwg, G, c;
    __host__ __device__ void init(int M, int N, int G_, int c_) { nM = M / BM; nN = N / BM; nwg = nM * nN; G = G_; c = c_; }
    __host__ __device__ bool next(int i, Unit& u) const {
        const long L = (long)i * G + c; if (L >= nwg) return false;
        int wgid = (int)L; { const int q = nwg / NXCD, r = nwg % NXCD, xcd = wgid % NXCD, off = wgid / NXCD; wgid = (xcd < r ? xcd * (q + 1) : r * (q + 1) + (xcd - r) * q) + off; }
        const int nig = WGM * nN, gid = wgid / nig, fm = gid * WGM, gsz = (nM - fm) < WGM ? (nM - fm) : WGM;
        u.pm = fm + ((wgid % nig) % gsz); u.pn = (wgid % nig) / gsz; return true;
    }
    __device__ __forceinline__ void a_ready(const Unit&) const {}
    __device__ __forceinline__ void done(const Unit&) const {}
};
struct CountedOrder : StaticOrder {
    const unsigned* ready; unsigned need; unsigned* tmo;
    __device__ __forceinline__ void a_ready(const Unit& u) const {
        if (TIDX < 64) {
            const unsigned long long t0 = __builtin_amdgcn_s_memrealtime(); unsigned polls = 0;
            while ((unsigned)__builtin_amdgcn_readfirstlane(__hip_atomic_load(ready + 64 * u.pm, __ATOMIC_RELAXED, __HIP_MEMORY_SCOPE_AGENT)) < need) {
                if ((++polls & 255u) == 0u && __builtin_amdgcn_readfirstlane(__hip_atomic_load(tmo, __ATOMIC_RELAXED, __HIP_MEMORY_SCOPE_AGENT)) != 0u) break;
                if (__builtin_amdgcn_s_memrealtime() - t0 > 2000000ull) {
                    if (TIDX == 0) { unsigned expect = 0u; __hip_atomic_compare_exchange_strong(tmo + 1, &expect, 0x600u | (unsigned)(u.pm & 0xff), __ATOMIC_RELAXED, __ATOMIC_RELAXED, __HIP_MEMORY_SCOPE_AGENT); __hip_atomic_store(tmo, 1u, __ATOMIC_RELAXED, __HIP_MEMORY_SCOPE_AGENT); }
                    break; }
                __builtin_amdgcn_s_sleep(2); }
            __builtin_amdgcn_fence(__ATOMIC_ACQUIRE, "agent");
            asm volatile("s_waitcnt vmcnt(0)" ::: "memory");
        }
#if !defined(BROKEN_HOOK_NO_BARRIER)
        asm volatile("" ::: "memory"); __builtin_amdgcn_s_barrier(); asm volatile("" ::: "memory");
#endif
    }
};

__device__ __forceinline__ unsigned cvt_pk_bf16(float lo, float hi) { unsigned r; asm volatile("v_cvt_pk_bf16_f32 %0, %1, %2" : "=v"(r) : "v"(lo), "v"(hi)); return r; }
typedef float f32x2 __attribute__((ext_vector_type(2)));
__device__ __forceinline__ f32x2 gelu_pk(f32x2 v) {
    const f32x2 av = __builtin_elementwise_abs(v), d = av * 0.2316418882f + 1.0f;
    f32x2 t; t.x = __builtin_amdgcn_rcpf(d.x); t.y = __builtin_amdgcn_rcpf(d.y);
    f32x2 q = t * 0.5307027145f + (-0.7265760135f); q = q * t + 0.7107068705f; q = q * t + (-0.142248368f); q = q * t + 0.127414796f; q = q * t;
    const f32x2 s = (v * v) * (-0.72134752044f);
    f32x2 e; e.x = __builtin_amdgcn_exp2f(s.x); e.y = __builtin_amdgcn_exp2f(s.y);
    const f32x2 m = v * (q * e), r = v - m;
    f32x2 o; o.x = v.x < 0.f ? m.x : r.x; o.y = v.y < 0.f ? m.y : r.y; return o;
}

struct EpiF32 {
    static constexpr bool PERM = false, AFTER_DRAIN = false;
    float* C; int ldc; const float* bias;
    __device__ __forceinline__ void operator()(const f32x4 (&acc)[2][2][4][2], const Unit& u, int wr, int wc, int fr, int fq) const {
        const int row0 = u.pm * BM + wr * 64 + fr, col0 = u.pn * BM + wc * 32 + 4 * fq;
        f32x4 bv[2][2];
#pragma unroll
        for (int bj = 0; bj < 2; ++bj)
#pragma unroll
            for (int n = 0; n < 2; ++n) bv[bj][n] = bias ? *(const f32x4*)(bias + col0 + bj * HALF + n * 16) : (f32x4){0.f, 0.f, 0.f, 0.f};
#pragma unroll
        for (int ai = 0; ai < 2; ++ai)
#pragma unroll
            for (int m = 0; m < 4; ++m) { float* rowp = C + (size_t)(row0 + ai * HALF + m * 16) * ldc + col0;
#pragma unroll
                for (int bj = 0; bj < 2; ++bj)
#pragma unroll
                    for (int n = 0; n < 2; ++n) *(f32x4*)(rowp + bj * HALF + n * 16) = acc[ai][bj][m][n] + bv[bj][n]; }
    }
};
template <int ACT  > struct EpiBf16 {
    static constexpr bool PERM = true, AFTER_DRAIN = false;
    bf16_t* O; int ldc; const float* bias; int split_cols; size_t split_stride;
    __device__ __forceinline__ void operator()(const f32x4 (&acc)[2][2][4][2], const Unit& u, int wr, int wc, int fr, int fq) const {
        const int row0 = u.pm * BM + wr * 64 + fr; int colt = u.pn * BM; bf16_t* base = O;
        if (split_cols) { const int t = colt / split_cols; base += (size_t)t * split_stride; colt -= t * split_cols; }
        const int col0 = colt + wc * 32 + 8 * fq, bcol0 = u.pn * BM + wc * 32 + 8 * fq;
        f32x4 bv[2][2];
#pragma unroll
        for (int bj = 0; bj < 2; ++bj)
#pragma unroll
            for (int n = 0; n < 2; ++n) bv[bj][n] = bias ? *(const f32x4*)(bias + bcol0 + bj * HALF + 4 * n) : (f32x4){0.f, 0.f, 0.f, 0.f};
#pragma unroll
        for (int ai = 0; ai < 2; ++ai)
#pragma unroll
            for (int m = 0; m < 4; ++m) { bf16_t* rowp = base + (size_t)(row0 + ai * HALF + m * 16) * ldc + col0;
#pragma unroll
                for (int bj = 0; bj < 2; ++bj) { f32x4 v0 = acc[ai][bj][m][0] + bv[bj][0], v1 = acc[ai][bj][m][1] + bv[bj][1];
                    if (ACT == 1) { f32x2 a = gelu_pk((f32x2){v0[0], v0[1]}), b = gelu_pk((f32x2){v0[2], v0[3]}), c = gelu_pk((f32x2){v1[0], v1[1]}), d = gelu_pk((f32x2){v1[2], v1[3]});
                        v0 = (f32x4){a.x, a.y, b.x, b.y}; v1 = (f32x4){c.x, c.y, d.x, d.y}; }
                    if (ACT == 2) {
#pragma unroll
                        for (int j = 0; j < 4; ++j) { v0[j] = 0.5f * v0[j] * (1.0f + erff(v0[j] * 0.70710678f)); v1[j] = 0.5f * v1[j] * (1.0f + erff(v1[j] * 0.70710678f)); } }
                    u32x4 w; w.x = cvt_pk_bf16(v0[0], v0[1]); w.y = cvt_pk_bf16(v0[2], v0[3]); w.z = cvt_pk_bf16(v1[0], v1[1]); w.w = cvt_pk_bf16(v1[2], v1[3]);
                    *(u32x4*)(rowp + bj * HALF) = w; } }
    }
};
template <class Epi, class Sched, bool STAMP = false>
__device__ __forceinline__ void gemm_phase(PG8_LAS unsigned char* lds, const Gemm g, const Sched& S, const Epi& E, unsigned long long* stamps) {
    const int tid = TIDX, wid = __builtin_amdgcn_readfirstlane(tid >> 6), lane = tid & 63, wr = wid >> 2, wc = wid & 3, fr = lane & 15, fq = lane >> 4;
    const int K = g.K, nt = K / BK;
    int ts_lo = 0, ts_hi = 0, nts = 0; const unsigned long long rt_entry = STAMP ? (unsigned long long)wall_clock64() : 0ull;
#define PG8_STAMP() do { if (STAMP && wid == 0 && nts < 64) { const unsigned long long _c = (unsigned long long)clock64(); \
        ts_lo = (lane == nts) ? (int)(unsigned)_c : ts_lo; ts_hi = (lane == nts) ? (int)(unsigned)(_c >> 32) : ts_hi; ++nts; } } while (0)
    PG8_STAMP();
    unsigned voffA[2], voffB[2];
#pragma unroll
    for (int i = 0; i < 2; ++i) { int R, C; stage_rc(tid * 16 + i * 8192, R, C); const int Rb = Epi::PERM ? ((R & ~31) + perm32(R & 31)) : R;
        const int Ra = g.ovl ? R - 2 * (R >> 6) : R; voffA[i] = (unsigned)(Ra * K + C) * 2u; voffB[i] = (unsigned)(Rb * K + C) * 2u; }
    const size_t kstep = (size_t)(BK * 2);
    const size_t hstep = (size_t)HALF * K * 2;
    const size_t tstep = 2 * hstep;
    const size_t hstepA = g.ovl ? (size_t)124 * K * 2 : hstep, tstepA = g.ovl ? (size_t)248 * K * 2 : tstep;
    const unsigned ldsw = (unsigned)wid * 1024u;
    const int aoff = lds_byte(wr * 64 + fr, fq * 8), boff = lds_byte(wc * 32 + fr, fq * 8);
#define PG8_SA(b, h) (((b) * 2 + (h)) * HTB)
#define PG8_SB(b, h) ((4 + (b) * 2 + (h)) * HTB)
#define PG8_STAGE(bufoff, gbase, voff) do { _Pragma("unroll") for (int _i = 0; _i < 2; ++_i) \
        __builtin_amdgcn_global_load_lds((const unsigned*)((const char*)(gbase) + (voff)[_i]), (PG8_LAS unsigned*)(lds + (bufoff) + ldsw + _i * 8192), 16, 0, 0); } while (0)
#define PG8_LDA(dst, b, h) do { _Pragma("unroll") for (int m = 0; m < 4; ++m) _Pragma("unroll") for (int k = 0; k < 2; ++k) dst[m][k] = *(const PG8_LAS bf16x8*)(lds + PG8_SA(b, h) + aoff + m * 2048 + k * 1024); } while (0)
#define PG8_LDB(dst, b, h) do { _Pragma("unroll") for (int n = 0; n < 2; ++n) _Pragma("unroll") for (int k = 0; k < 2; ++k) dst[n][k] = *(const PG8_LAS bf16x8*)(lds + PG8_SB(b, h) + boff + n * 2048 + k * 1024); } while (0)
#define PG8_MMA(ai, bj, At, Bt) do { __builtin_amdgcn_s_setprio(1); _Pragma("unroll") for (int m = 0; m < 4; ++m) _Pragma("unroll") for (int n = 0; n < 2; ++n) _Pragma("unroll") for (int k = 0; k < 2; ++k) \
        acc[ai][bj][m][n] = __builtin_amdgcn_mfma_f32_16x16x32_bf16(Bt[n][k], At[m][k], acc[ai][bj][m][n], 0, 0, 0); __builtin_amdgcn_s_setprio(0); } while (0)
#define PG8_WAIT_V(n) asm volatile("s_waitcnt vmcnt(" #n ")" ::: "memory")
#define PG8_WAIT_L(n) asm volatile("s_waitcnt lgkmcnt(" #n ")" ::: "memory")
#define PG8_BAR __builtin_amdgcn_s_barrier()
#define PG8_SCHED __builtin_amdgcn_sched_barrier(0)
    Unit cur, nxt; int ui = 0;
    if (!S.next(0, cur)) return;
    f32x4 acc[2][2][4][2];
#pragma unroll
    for (int a = 0; a < 2; ++a)
#pragma unroll
        for (int b = 0; b < 2; ++b)
#pragma unroll
            for (int m = 0; m < 4; ++m)
#pragma unroll
                for (int n = 0; n < 2; ++n) acc[a][b][m][n] = (f32x4){0.f, 0.f, 0.f, 0.f};
    bf16x8 At[4][2], B0[2][2], B1[2][2];
    const char* cA = (const char*)g.A + (size_t)cur.pm * tstepA; const char* cB = (const char*)g.Bt + (size_t)cur.pn * tstep;
    S.a_ready(cur);
    PG8_STAGE(PG8_SB(0, 0), cB, voffB); PG8_STAGE(PG8_SA(0, 0), cA, voffA); PG8_STAGE(PG8_SB(0, 1), cB + hstep, voffB); PG8_STAGE(PG8_SA(0, 1), cA + hstepA, voffA);
    if (wr == 1) PG8_BAR;
    PG8_WAIT_V(4); PG8_BAR;
    PG8_STAGE(PG8_SB(1, 0), cB + kstep, voffB); PG8_STAGE(PG8_SA(1, 0), cA + kstep, voffA); PG8_STAGE(PG8_SB(1, 1), cB + hstep + kstep, voffB);
    PG8_WAIT_V(6); PG8_BAR;
    PG8_STAMP();
    for (;;) {
        const bool has_next = S.next(ui + 1, nxt);
        const char* nA = has_next ? (const char*)g.A + (size_t)nxt.pm * tstepA : cA; const char* nB = has_next ? (const char*)g.Bt + (size_t)nxt.pn * tstep : cB;
        for (int t = 0; t < nt; t += 2) {
            const bool last = (t == nt - 2);
            const char* a1 = cA + (size_t)(t + 1) * kstep;
            const char* a2 = last ? nA : cA + (size_t)(t + 2) * kstep; const char* b2 = last ? nB : cB + (size_t)(t + 2) * kstep;
            const char* a3 = a2 + kstep; const char* b3 = b2 + kstep;
            if (last && has_next) S.a_ready(nxt);
            PG8_LDB(B0, 0, 0); PG8_SCHED; PG8_LDA(At, 0, 0); PG8_STAGE(PG8_SA(1, 1), a1 + hstepA, voffA);
            PG8_WAIT_L(8); PG8_BAR; PG8_WAIT_L(0); PG8_MMA(0, 0, At, B0); PG8_BAR; PG8_SCHED;
            PG8_LDB(B1, 0, 1); PG8_STAGE(PG8_SB(0, 0), b2, voffB);
            PG8_BAR; PG8_WAIT_L(0); PG8_MMA(0, 1, At, B1); PG8_BAR;
            PG8_LDA(At, 0, 1); PG8_STAGE(PG8_SA(0, 0), a2, voffA);
            PG8_BAR; PG8_WAIT_L(0); PG8_MMA(1, 0, At, B0); PG8_BAR; PG8_SCHED;
            PG8_STAGE(PG8_SB(0, 1), b2 + hstep, voffB);
            PG8_WAIT_V(6); PG8_BAR; PG8_MMA(1, 1, At, B1); PG8_BAR;
            PG8_LDB(B0, 1, 0); PG8_SCHED; PG8_LDA(At, 1, 0); PG8_STAGE(PG8_SA(0, 1), a2 + hstepA, voffA);
            PG8_WAIT_L(8); PG8_BAR; PG8_WAIT_L(0); PG8_MMA(0, 0, At, B0); PG8_BAR; PG8_SCHED;
            PG8_LDB(B1, 1, 1); PG8_STAGE(PG8_SB(1, 0), b3, voffB);
            PG8_BAR; PG8_WAIT_L(0); PG8_MMA(0, 1, At, B1); PG8_BAR;
            PG8_LDA(At, 1, 1); PG8_STAGE(PG8_SA(1, 0), a3, voffA);
            PG8_BAR; PG8_WAIT_L(0); PG8_MMA(1, 0, At, B0); PG8_BAR; PG8_SCHED;
            PG8_STAGE(PG8_SB(1, 1), b3 + hstep, voffB);
            PG8_WAIT_V(6); PG8_BAR; PG8_MMA(1, 1, At, B1); PG8_BAR;
        }
        PG8_STAMP();
        if constexpr (!Epi::AFTER_DRAIN) { E(acc, cur, wr, wc, fr, fq); S.done(cur); }
        PG8_STAMP();
        if (!has_next) break;
#pragma unroll
        for (int a = 0; a < 2; ++a)
#pragma unroll
            for (int b = 0; b < 2; ++b)
#pragma unroll
                for (int m = 0; m < 4; ++m)
#pragma unroll
                    for (int n = 0; n < 2; ++n) acc[a][b][m][n] = (f32x4){0.f, 0.f, 0.f, 0.f};
        cur = nxt; cA = nA; cB = nB; ++ui;
    }
    PG8_WAIT_V(0);
    if (wr == 0) PG8_BAR;
    PG8_BAR;
    if constexpr (Epi::AFTER_DRAIN) { E.fused(acc, cur, wr, wc, fr, fq, lds, wid, lane); S.done(cur); }
    PG8_STAMP();
    if (STAMP && wid == 0) { stamps[lane] = lane < nts ? (((unsigned long long)(unsigned)ts_hi << 32) | (unsigned)ts_lo) : 0ull;
        if (lane == 62) stamps[62] = rt_entry; if (lane == 63) stamps[63] = (unsigned long long)wall_clock64(); }
#undef PG8_STAMP
#undef PG8_SA
#undef PG8_SB
#undef PG8_STAGE
#undef PG8_LDA
#undef PG8_LDB
#undef PG8_MMA
#undef PG8_WAIT_V
#undef PG8_WAIT_L
#undef PG8_BAR
#undef PG8_SCHED
}
}
typedef unsigned short bf16_t;
constexpr int T_TOK = 32768, DM = 1024, D_IN = 4096, D_HY = 512, D_HG = 512, DFF = 4096, NLAYER = 4;
constexpr int L_BIG = 16384, L_SML = 4096;
constexpr int APAD = 256;
constexpr size_t MiB = 1024ull * 1024ull;
constexpr size_t OFF_W = 0;
constexpr size_t OFF_W_IN = OFF_W, OFF_W_OUT = OFF_W + 8 * MiB, OFF_W_UP = OFF_W + 10 * MiB, OFF_W_DN = OFF_W + 26 * MiB;
constexpr size_t OFF_ABUF = 34 * MiB;
constexpr size_t OFF_R1 = 99 * MiB;
constexpr size_t OFF_HYRAW = OFF_R1;
constexpr size_t OFF_HG = OFF_R1 + 96 * MiB;
constexpr size_t OFF_KT = OFF_R1;
constexpr size_t OFF_ACT = OFF_R1;
constexpr size_t OFF_R2 = 355 * MiB;
constexpr size_t OFF_X0T = OFF_R2, OFF_ZT = OFF_R2 + 32 * MiB;
constexpr size_t OFF_MIX = OFF_R2;
constexpr size_t OFF_UPART = OFF_R2;
constexpr size_t OFF_R6 = 419 * MiB;
constexpr size_t OFF_OBUF = OFF_R6;
constexpr size_t OFF_KS = OFF_R6;
constexpr size_t OFF_SMALL = 483 * MiB;
constexpr size_t OFF_BAR = OFF_SMALL + 4 * MiB;
constexpr size_t OFF_W4T = OFF_SMALL + 8 * MiB;
constexpr size_t WS_NEED = 492 * MiB;

struct P { const float* in[26]; float* out; unsigned char* ws; };
constexpr int PB_norm_mix_pre = 0;
constexpr int PB_norm_mix_post = 4096;
constexpr int PB_norm_ffn_pre = 8192;
constexpr int PB_norm_ffn_post = 12288;
constexpr int PB_hy_conv_w = 16384;
constexpr int PB_hy_conv_b = 34816;
constexpr int PB_f_w1 = 40960;
constexpr int PB_f_b1 = 49408;
constexpr int PB_f_w2 = 49664;
constexpr int PB_f_b2 = 66048;
constexpr int PB_f_w3 = 66304;
constexpr int PB_f_b3 = 82688;
constexpr int PB_f_w4 = 82944;
constexpr int PB_f_freq = 345088;
constexpr int PB_hy_skip = 345344;
constexpr int PB_hy_out_norm = 347392;
constexpr int PB_lb_table = 349440;
constexpr int PB_hg_out_norm = 353536;
constexpr int PB_ffn_conv_w = 355584;
constexpr int PB_ffn_conv_b = 453888;
constexpr int PB_TOTAL = 486656;
constexpr size_t OFF_PB = OFF_SMALL + 512 * 1024;
#define PRM(p, NAME) ((const float*)((p).ws + OFF_PB) + PB_##NAME)

__device__ __forceinline__ float bf2f(bf16_t b) { return __uint_as_float(((unsigned)b) << 16); }
__device__ __forceinline__ bf16_t f2bf(float f) { unsigned u = __float_as_uint(f); u += 0x7FFFu + ((u >> 16) & 1u); return (bf16_t)(u >> 16); }
__device__ __forceinline__ unsigned pack_bf2(float lo, float hi) { return (unsigned)f2bf(lo) | ((unsigned)f2bf(hi) << 16); }
__device__ __forceinline__ bool seq_start(int t) { return t < L_BIG ? (t == 0) : ((t & (L_SML - 1)) == 0); }
__device__ __forceinline__ bool seq_end(int t) { return (t + 1 == T_TOK) || seq_start(t + 1); }
__device__ __forceinline__ const float* x_src_row(const P& p, int l, int t) {
    if (l > 0) return p.out + (size_t)t * DM;
    return t < L_BIG ? p.in[0] + (size_t)t * DM : p.in[1] + (size_t)(t - L_BIG) * DM;
}
__device__ __forceinline__ float silu_f(float x) { return x / (1.0f + __expf(-x)); }
__device__ __forceinline__ float wave_sum(float v) {
#pragma unroll
    for (int o = 32; o >= 1; o >>= 1) v += __shfl_xor(v, o);
    return v;
}

struct EpiBf16Split {
    static constexpr bool PERM = true, AFTER_DRAIN = false, OVL = false;
    bf16_t* O0; int ldc0; bf16_t* O1; int ldc1; int csplit;
    __device__ __forceinline__ void operator()(const pg8::f32x4 (&acc)[2][2][4][2], const pg8::Unit& u, int wr, int wc, int fr, int fq) const {
        const int row0 = u.pm * pg8::BM + wr * 64 + fr; int colt = u.pn * pg8::BM; bf16_t* base = O0; int ldc = ldc0;
        if (colt >= csplit) { base = O1; ldc = ldc1; colt -= csplit; }
        const int col0 = colt + wc * 32 + 8 * fq;
#pragma unroll
        for (int ai = 0; ai < 2; ++ai)
#pragma unroll
            for (int m = 0; m < 4; ++m) { bf16_t* rowp = base + (size_t)(row0 + ai * pg8::HALF + m * 16) * ldc + col0;
#pragma unroll
                for (int bj = 0; bj < 2; ++bj) { const pg8::f32x4 v0 = acc[ai][bj][m][0], v1 = acc[ai][bj][m][1];
                    pg8::u32x4 w; w.x = pg8::cvt_pk_bf16(v0[0], v0[1]); w.y = pg8::cvt_pk_bf16(v0[2], v0[3]); w.z = pg8::cvt_pk_bf16(v1[0], v1[1]); w.w = pg8::cvt_pk_bf16(v1[2], v1[3]);
                    *(pg8::u32x4*)(rowp + bj * pg8::HALF) = w; } }
    }
};
__device__ __forceinline__ float dpp_ror1(float v) { return __int_as_float(__builtin_amdgcn_update_dpp(0, __float_as_int(v), 0x121, 0xF, 0xF, false)); }
__device__ __forceinline__ float dpp_ror15(float v) { return __int_as_float(__builtin_amdgcn_update_dpp(0, __float_as_int(v), 0x12F, 0xF, 0xF, false)); }
__device__ __forceinline__ float gelu_tanh_e(float x) { const float y = 1.5957691216057308f * (x + 0.044715f * x * x * x); return x * __builtin_amdgcn_rcpf(1.0f + __expf(-y)); }
struct EpiGeglu {
    static constexpr bool PERM = true, AFTER_DRAIN = false, OVL = true;
    bf16_t* act; const float* cw; const float* cb;
    template <bool MASK> __device__ __forceinline__ void run(const pg8::f32x4 (&acc)[2][2][4][2], const pg8::Unit& u, int wr, int wc, int fr, int fq, unsigned mprev, unsigned mnext, unsigned mst) const {
        const int j0 = u.pn * 128 + wc * 32 + 8 * fq;
#pragma unroll
        for (int n = 0; n < 2; ++n) {
            const int jc = j0 + 4 * n;
            const pg8::f32x4 wa0 = *(const pg8::f32x4*)(cw + jc), wa1 = *(const pg8::f32x4*)(cw + 8192 + jc), wa2 = *(const pg8::f32x4*)(cw + 16384 + jc), ba = *(const pg8::f32x4*)(cb + jc);
            const pg8::f32x4 wb0 = *(const pg8::f32x4*)(cw + 4096 + jc), wb1 = *(const pg8::f32x4*)(cw + 8192 + 4096 + jc), wb2 = *(const pg8::f32x4*)(cw + 16384 + 4096 + jc), bb = *(const pg8::f32x4*)(cb + 4096 + jc);
#pragma unroll
            for (int ai = 0; ai < 2; ++ai) {
                pg8::f32x4 pa_prev, pb_prev, na_cur, nb_cur;
#pragma unroll
                for (int i = 0; i < 4; ++i) { na_cur[i] = dpp_ror15(acc[ai][0][0][n][i]); nb_cur[i] = dpp_ror15(acc[ai][1][0][n][i]); pa_prev[i] = 0.f; pb_prev[i] = 0.f; }
#pragma unroll
                for (int m = 0; m < 4; ++m) {
                    const int b = ai * 4 + m, q = 16 * m + fr, tok = u.pm * 248 + 124 * ai + 62 * wr + q - 1;
                    const bool hp = (mprev >> b) & 1u, hn = (mnext >> b) & 1u;
                    pg8::f32x4 pa_cur, pb_cur, na_next, nb_next;
#pragma unroll
                    for (int i = 0; i < 4; ++i) { pa_cur[i] = dpp_ror1(acc[ai][0][m][n][i]); pb_cur[i] = dpp_ror1(acc[ai][1][m][n][i]);
                        na_next[i] = m < 3 ? dpp_ror15(acc[ai][0][m < 3 ? m + 1 : 3][n][i]) : 0.f; nb_next[i] = m < 3 ? dpp_ror15(acc[ai][1][m < 3 ? m + 1 : 3][n][i]) : 0.f; }
                    const pg8::f32x4 xpa = (fr == 0) ? pa_prev : pa_cur, xna = (fr == 15) ? na_next : na_cur;
                    const pg8::f32x4 xpb = (fr == 0) ? pb_prev : pb_cur, xnb = (fr == 15) ? nb_next : nb_cur;
                    const pg8::f32x4 xa = acc[ai][0][m][n], xb = acc[ai][1][m][n];
                    float o[4];
#pragma unroll
                    for (int i = 0; i < 4; ++i) {
                        const float w0a = (!MASK || hp) ? wa0[i] : 0.f, w2a = (!MASK || hn) ? wa2[i] : 0.f, w0b = (!MASK || hp) ? wb0[i] : 0.f, w2b = (!MASK || hn) ? wb2[i] : 0.f;
                        const float ya = __builtin_fmaf(xpa[i], w0a, __builtin_fmaf(xa[i], wa1[i], __builtin_fmaf(xna[i], w2a, ba[i])));
                        const float yb = __builtin_fmaf(xpb[i], w0b, __builtin_fmaf(xb[i], wb1[i], __builtin_fmaf(xnb[i], w2b, bb[i])));
                        const float e = __builtin_amdgcn_exp2f(ya * __builtin_fmaf(ya * ya, -0.10294324f, -2.3022082f));
                        o[i] = ya * yb * __builtin_amdgcn_rcpf(1.0f + e);
                    }
                    if (MASK ? ((mst >> b) & 1u) != 0u : (q >= 1 && q <= 62)) { uint2 w; w.x = pg8::cvt_pk_bf16(o[0], o[1]); w.y = pg8::cvt_pk_bf16(o[2], o[3]); *(uint2*)(act + (size_t)tok * DFF + jc) = w; }
                    pa_prev = pa_cur; pb_prev = pb_cur; na_cur = na_next; nb_cur = nb_next;
                }
            }
        }
    }
    __device__ __forceinline__ void operator()(const pg8::f32x4 (&acc)[2][2][4][2], const pg8::Unit& u, int wr, int wc, int fr, int fq) const {
        const int j0 = u.pn * 128 + wc * 32 + 8 * fq;
        unsigned mprev = 0, mnext = 0, mst = 0;
#pragma unroll
        for (int ai = 0; ai < 2; ++ai)
#pragma unroll
            for (int m = 0; m < 4; ++m) { const int q = 16 * m + fr, tok = u.pm * 248 + 124 * ai + 62 * wr + q - 1, b = ai * 4 + m;
                const bool st = q >= 1 && q <= 62 && tok < T_TOK;
                if (st) { mst |= 1u << b; if (!seq_start(tok)) mprev |= 1u << b; if (!seq_end(tok)) mnext |= 1u << b; } }
        run<true>(acc, u, wr, wc, fr, fq, mprev, mnext, mst);
    }
};
template <class Epi>
__device__ __forceinline__ void run_gemm(LAS unsigned char* lds, const bf16_t* A, const bf16_t* Bt, int M, int N, int K, const Epi& E) {
    pg8::Gemm g; g.A = A; g.Bt = Bt; g.M = M; g.N = N; g.K = K; g.ovl = Epi::OVL ? 1 : 0;
    int gx = (int)gridDim.x, bx = (int)blockIdx.x; asm volatile("" : "+s"(gx), "+s"(bx));
    pg8::StaticOrder S; S.init(M, N, gx, bx);
    pg8::gemm_phase<Epi, pg8::StaticOrder, false>((PG8_LAS unsigned char*)lds, g, S, E, nullptr);
}

#define HD_INLINE __device__ __forceinline__
#define DEV_FN __device__ __forceinline__
#define LDS_F2 LAS cf2*
#define NTHR 512
#define PADI(i) ((i) + ((i) >> 5))
#define FOR_TID for (int tid = (int)TIDX, once_ = 1; once_; once_ = 0)
#define SYNC __syncthreads()
#define BREV32(x) __brev(x)
#define CIS_REV(fr, c, s) do { const float f_ = (fr); c = __builtin_amdgcn_cosf(f_); s = __builtin_amdgcn_sinf(f_); } while (0)
HD_INLINE unsigned rev4(unsigned k, int S) {
    unsigned v = BREV32(k) >> (32 - 2 * S);
    return ((v & 0xAAAAAAAAu) >> 1) | ((v & 0x55555555u) << 1);
}
HD_INLINE cf2 mkf2(float a, float b) { cf2 r; r.x = a; r.y = b; return r; }
HD_INLINE cf2 cmul(cf2 a, cf2 b) { return mkf2(a.x * b.x - a.y * b.y, a.x * b.y + a.y * b.x); }
HD_INLINE cf2 cmulc(cf2 a, cf2 b) { return mkf2(a.x * b.x + a.y * b.y, a.y * b.x - a.x * b.y); }

HD_INLINE void bf4_fwd(cf2& a0, cf2& a1, cf2& a2, cf2& a3) {
    const cf2 t0 = a0 + a2, t1 = a0 - a2, t2 = a1 + a3, d = a1 - a3; const cf2 t3 = mkf2(d.y, -d.x);
    a0 = t0 + t2; a1 = t1 + t3; a2 = t0 - t2; a3 = t1 - t3;
}
HD_INLINE void bf4_inv(cf2& b0, cf2& b1, cf2& b2, cf2& b3) {
    const cf2 t0 = b0 + b2, t1 = b0 - b2, t2 = b1 + b3, d = b1 - b3; const cf2 t3 = mkf2(-d.y, d.x);
    b0 = t0 + t2; b1 = t1 + t3; b2 = t0 - t2; b3 = t1 - t3;
}
#define W16C(k) ((k) == 0 ? 1.0f : (k) == 1 ? 0.9238795325112867f : (k) == 2 ? 0.7071067811865476f : (k) == 3 ? 0.3826834323650898f : (k) == 4 ? 0.0f : (k) == 6 ? -0.7071067811865476f :   -0.9238795325112867f)
#define W16S(k) ((k) == 0 ? 0.0f : (k) == 1 ? 0.3826834323650898f : (k) == 2 ? 0.7071067811865476f : (k) == 3 ? 0.9238795325112867f : (k) == 4 ? 1.0f : (k) == 6 ? 0.7071067811865476f :   -0.3826834323650898f)
template <int S, int NSEQ, bool ZIN = false>
DEV_FN void fft_fwd2(LDS_F2 X) {
    constexpr int M = 1 << (2 * S), MP = M + (M >> 5), NG = NSEQ * (M >> 4);
#pragma unroll 1
    for (int pr = 0; pr < S / 2; ++pr) {
        const int s = 2 * pr, n = M >> (2 * s), q = n >> 2, q2 = q >> 2;
        const float invn = 1.0f / (float)n;
        FOR_TID {
#pragma unroll 2
            for (int gi = tid; gi < NG; gi += NTHR) {
                const int seq = gi / (M >> 4), g = gi - seq * (M >> 4), j2 = g & (q2 - 1), base = ((g - j2) << 4) + j2;
                LDS_F2 Xs = X + seq * MP;
                cf2 a[4][4];
#pragma unroll
                for (int r = 0; r < 4; ++r)
#pragma unroll
                    for (int r2 = 0; r2 < 4; ++r2) a[r][r2] = (ZIN && pr == 0 && r >= 2) ? mkf2(0.f, 0.f) : Xs[PADI(base + r * q + r2 * q2)];
                float c1, s1; CIS_REV((float)j2 * invn, c1, s1);
                const cf2 t1 = mkf2(c1, -s1), t2 = cmul(t1, t1), t3 = cmul(t2, t1), t4 = cmul(t2, t2), t8 = cmul(t4, t4), t12 = cmul(t8, t4);
#pragma unroll
                for (int r2 = 0; r2 < 4; ++r2) {
                    bf4_fwd(a[0][r2], a[1][r2], a[2][r2], a[3][r2]);
                    a[1][r2] = cmul(a[1][r2], cmul(t1, mkf2(W16C(r2), -W16S(r2))));
                    a[2][r2] = cmul(a[2][r2], cmul(t2, mkf2(W16C(2 * r2), -W16S(2 * r2))));
                    a[3][r2] = cmul(a[3][r2], cmul(t3, mkf2(W16C(3 * r2), -W16S(3 * r2))));
                }
#pragma unroll
                for (int r = 0; r < 4; ++r) {
                    bf4_fwd(a[r][0], a[r][1], a[r][2], a[r][3]);
                    a[r][1] = cmul(a[r][1], t4); a[r][2] = cmul(a[r][2], t8); a[r][3] = cmul(a[r][3], t12);
                }
#pragma unroll
                for (int r = 0; r < 4; ++r)
#pragma unroll
                    for (int r2 = 0; r2 < 4; ++r2) Xs[PADI(base + r * q + r2 * q2)] = a[r][r2];
            }
        }
        SYNC;
    }
    if (S & 1) {
        FOR_TID {
#pragma unroll 4
            for (int gi = tid; gi < NSEQ * (M >> 2); gi += NTHR) {
                const int seq = gi / (M >> 2), b = gi - seq * (M >> 2);
                LDS_F2 Xs = X + seq * MP;
                cf2 a0 = Xs[PADI(4 * b)], a1 = Xs[PADI(4 * b + 1)], a2 = Xs[PADI(4 * b + 2)], a3 = Xs[PADI(4 * b + 3)];
                bf4_fwd(a0, a1, a2, a3);
                Xs[PADI(4 * b)] = a0; Xs[PADI(4 * b + 1)] = a1; Xs[PADI(4 * b + 2)] = a2; Xs[PADI(4 * b + 3)] = a3;
            }
        }
        SYNC;
    }
}
template <int S, int NSEQ, bool HOUT = false>
DEV_FN void fft_inv2(LDS_F2 X) {
    constexpr int M = 1 << (2 * S), MP = M + (M >> 5), NG = NSEQ * (M >> 4);
    if (S & 1) {
        FOR_TID {
#pragma unroll 4
            for (int gi = tid; gi < NSEQ * (M >> 2); gi += NTHR) {
                const int seq = gi / (M >> 2), b = gi - seq * (M >> 2);
                LDS_F2 Xs = X + seq * MP;
                cf2 a0 = Xs[PADI(4 * b)], a1 = Xs[PADI(4 * b + 1)], a2 = Xs[PADI(4 * b + 2)], a3 = Xs[PADI(4 * b + 3)];
                bf4_inv(a0, a1, a2, a3);
                Xs[PADI(4 * b)] = a0; Xs[PADI(4 * b + 1)] = a1; Xs[PADI(4 * b + 2)] = a2; Xs[PADI(4 * b + 3)] = a3;
            }
        }
        SYNC;
    }
#pragma unroll 1
    for (int pr = S / 2 - 1; pr >= 0; --pr) {
        const int s = 2 * pr, n = M >> (2 * s), q = n >> 2, q2 = q >> 2;
        const float invn = 1.0f / (float)n;
        FOR_TID {
#pragma unroll 2
            for (int gi = tid; gi < NG; gi += NTHR) {
                const int seq = gi / (M >> 4), g = gi - seq * (M >> 4), j2 = g & (q2 - 1), base = ((g - j2) << 4) + j2;
                LDS_F2 Xs = X + seq * MP;
                cf2 a[4][4];
#pragma unroll
                for (int r = 0; r < 4; ++r)
#pragma unroll
                    for (int r2 = 0; r2 < 4; ++r2) a[r][r2] = Xs[PADI(base + r * q + r2 * q2)];
                float c1, s1; CIS_REV((float)j2 * invn, c1, s1);
                const cf2 t1 = mkf2(c1, s1), t2 = cmul(t1, t1), t3 = cmul(t2, t1), t4 = cmul(t2, t2), t8 = cmul(t4, t4), t12 = cmul(t8, t4);
#pragma unroll
                for (int r = 0; r < 4; ++r) {
                    a[r][1] = cmul(a[r][1], t4); a[r][2] = cmul(a[r][2], t8); a[r][3] = cmul(a[r][3], t12);
                    bf4_inv(a[r][0], a[r][1], a[r][2], a[r][3]);
                }
#pragma unroll
                for (int r2 = 0; r2 < 4; ++r2) {
                    a[1][r2] = cmul(a[1][r2], cmul(t1, mkf2(W16C(r2), W16S(r2))));
                    a[2][r2] = cmul(a[2][r2], cmul(t2, mkf2(W16C(2 * r2), W16S(2 * r2))));
                    a[3][r2] = cmul(a[3][r2], cmul(t3, mkf2(W16C(3 * r2), W16S(3 * r2))));
                    bf4_inv(a[0][r2], a[1][r2], a[2][r2], a[3][r2]);
                }
#pragma unroll
                for (int r = 0; r < 4; ++r)
#pragma unroll
                    for (int r2 = 0; r2 < 4; ++r2) if (!(HOUT && pr == 0 && r >= 2)) Xs[PADI(base + r * q + r2 * q2)] = a[r][r2];
            }
        }
        SYNC;
    }
}
DEV_FN void spec_store(LDS_F2 X, int S, cf2* Kp) {
    const int M = 1 << (2 * S);
    FOR_TID {
        for (int pp = tid; pp < (M >> 1); pp += NTHR) {
            const int p = ((pp >> 1) << 2) + (pp & 1);
            if (p == 0) {
                const cf2 c0 = X[PADI(0)]; Kp[0] = mkf2(c0.x + c0.y, c0.x - c0.y);
                const cf2 ch = X[PADI(2)]; Kp[2] = mkf2(ch.x, -ch.y);
            } else {
                const unsigned k = rev4((unsigned)p, S), pm = rev4((unsigned)(M - (int)k), S);
                const cf2 ck = X[PADI(p)], cm = X[PADI((int)pm)];
                const cf2 P = mkf2(0.5f * (ck.x + cm.x), 0.5f * (ck.y - cm.y));
                const cf2 O = mkf2(0.5f * (ck.y + cm.y), -0.5f * (ck.x - cm.x));
                float c, s; CIS_REV((float)k / (float)(2 * M), c, s);
                const cf2 Q = cmul(O, mkf2(c, -s));
                Kp[p] = mkf2(P.x + Q.x, P.y + Q.y);
                Kp[pm] = mkf2(P.x - Q.x, -(P.y - Q.y));
            }
        }
    }
    SYNC;
}
DEV_FN void spec_mul(LDS_F2 X0, int S, const cf2* Kp, int nseq = 1) {
    const int M = 1 << (2 * S);
    FOR_TID {
        for (int pq = tid; pq < nseq * (M >> 1); pq += NTHR) {
            const int sq_ = pq / (M >> 1), pp = pq - sq_ * (M >> 1);
            LDS_F2 X = X0 + sq_ * (M + (M >> 5));
            const int p = ((pp >> 1) << 2) + (pp & 1);
            if (p == 0) {
                const cf2 c0 = X[PADI(0)], k0 = Kp[0];
                const float y0 = (c0.x + c0.y) * k0.x, ym = (c0.x - c0.y) * k0.y;
                X[PADI(0)] = mkf2(0.5f * (y0 + ym), 0.5f * (y0 - ym));
                const cf2 ch = X[PADI(2)], kh = Kp[2];
                const cf2 yh = cmul(mkf2(ch.x, -ch.y), kh);
                X[PADI(2)] = mkf2(yh.x, -yh.y);
            } else {
                const unsigned k = rev4((unsigned)p, S), pm = rev4((unsigned)(M - (int)k), S);
                const cf2 ck = X[PADI(p)], cm = X[PADI((int)pm)];
                const cf2 P = mkf2(0.5f * (ck.x + cm.x), 0.5f * (ck.y - cm.y));
                const cf2 O = mkf2(0.5f * (ck.y + cm.y), -0.5f * (ck.x - cm.x));
                float c, s; CIS_REV((float)k / (float)(2 * M), c, s);
                const cf2 Wk = mkf2(c, -s);
                const cf2 Q = cmul(O, Wk);
                const cf2 xk = mkf2(P.x + Q.x, P.y + Q.y), xm = mkf2(P.x - Q.x, -(P.y - Q.y));
                const cf2 yk = cmul(xk, Kp[p]), ym = cmul(xm, Kp[pm]);
                const cf2 Ye = mkf2(0.5f * (yk.x + ym.x), 0.5f * (yk.y - ym.y));
                const cf2 Yd = mkf2(0.5f * (yk.x - ym.x), 0.5f * (yk.y + ym.y));
                const cf2 Yo = cmulc(Yd, Wk);
                X[PADI(p)] = mkf2(Ye.x - Yo.y, Ye.y + Yo.x);
                X[PADI((int)pm)] = mkf2(Ye.x + Yo.y, -Ye.y + Yo.x);
            }
        }
    }
    SYNC;
}
__device__ void ph_setup(const P& p) {
    const int gid = blockIdx.x * 512 + TIDX;
    if (gid < 2 * D_HG) {
        const int dir = gid / D_HG, c = gid % D_HG;
        float v[NLAYER], mx = -1e30f;
#pragma unroll
        for (int l = 0; l < NLAYER; ++l) { v[l] = p.in[19][(size_t)(dir * NLAYER + l) * D_HG + c]; mx = fmaxf(mx, v[l]); }
        float s = 0.f;
#pragma unroll
        for (int l = 0; l < NLAYER; ++l) { v[l] = expf(v[l] - mx); s += v[l]; }
        float* lbs = (float*)(p.ws + OFF_SMALL);
        float cum = 0.f;
#pragma unroll
        for (int l = 0; l < NLAYER; ++l) { if (l > 0) cum += v[l] / s; lbs[(size_t)(dir * NLAYER + l) * D_HG + c] = cum; }
    }
}
__device__ void ph_copy_params(const P& p) {
    float* pb = (float*)(p.ws + OFF_PB);
    const int g = blockIdx.x * 512 + TIDX, gs = gridDim.x * 512;
    for (int k = g; k < 4096; k += gs) pb[0 + k] = p.in[2][k];
    for (int k = g; k < 4096; k += gs) pb[4096 + k] = p.in[3][k];
    for (int k = g; k < 4096; k += gs) pb[8192 + k] = p.in[4][k];
    for (int k = g; k < 4096; k += gs) pb[12288 + k] = p.in[5][k];
    for (int k = g; k < 18432; k += gs) pb[16384 + k] = p.in[7][k];
    for (int k = g; k < 6144; k += gs) pb[34816 + k] = p.in[8][k];
    for (int k = g; k < 8448; k += gs) pb[40960 + k] = p.in[9][k];
    for (int k = g; k < 256; k += gs) pb[49408 + k] = p.in[10][k];
    for (int k = g; k < 16384; k += gs) pb[49664 + k] = p.in[11][k];
    for (int k = g; k < 256; k += gs) pb[66048 + k] = p.in[12][k];
    for (int k = g; k < 16384; k += gs) pb[66304 + k] = p.in[13][k];
    for (int k = g; k < 256; k += gs) pb[82688 + k] = p.in[14][k];
    for (int k = g; k < 262144; k += gs) pb[82944 + k] = p.in[15][k];
    for (int k = g; k < 256; k += gs) pb[345088 + k] = p.in[16][k];
    for (int k = g; k < 2048; k += gs) pb[345344 + k] = p.in[17][k];
    for (int k = g; k < 2048; k += gs) pb[347392 + k] = p.in[18][k];
    for (int k = g; k < 4096; k += gs) pb[349440 + k] = p.in[19][k];
    for (int k = g; k < 2048; k += gs) pb[353536 + k] = p.in[20][k];
    for (int k = g; k < 98304; k += gs) pb[355584 + k] = p.in[23][k];
    for (int k = g; k < 32768; k += gs) pb[453888 + k] = p.in[24][k];
}
__device__ void convert_one(const float* src, bf16_t* dst, int K, int N, LAS float* tile  , bool geglu_perm = false) {
    const int tiles_n = N / 64, ntiles = (K / 64) * tiles_n, tid = TIDX;
    for (int it = blockIdx.x; it < ntiles; it += gridDim.x) {
        const int k0 = (it / tiles_n) * 64, n0 = (it % tiles_n) * 64;
#pragma unroll
        for (int i = 0; i < 2; ++i) { const int r = (tid >> 4) + 32 * i, c4 = (tid & 15) * 4;
            const nf4 v = *(const nf4*)(src + (size_t)(k0 + r) * N + n0 + c4);
            tile[r * 65 + c4] = v.x; tile[r * 65 + c4 + 1] = v.y; tile[r * 65 + c4 + 2] = v.z; tile[r * 65 + c4 + 3] = v.w; }
        __syncthreads();
        { const int n = tid >> 3, ks = (tid & 7) * 8; int nr = n0 + n;
          if (geglu_perm) nr = nr < DFF ? (nr >> 7) * 256 + (nr & 127) : ((nr - DFF) >> 7) * 256 + 128 + ((nr - DFF) & 127);
          nu4 w;
          w.x = pack_bf2(tile[(ks + 0) * 65 + n], tile[(ks + 1) * 65 + n]); w.y = pack_bf2(tile[(ks + 2) * 65 + n], tile[(ks + 3) * 65 + n]);
          w.z = pack_bf2(tile[(ks + 4) * 65 + n], tile[(ks + 5) * 65 + n]); w.w = pack_bf2(tile[(ks + 6) * 65 + n], tile[(ks + 7) * 65 + n]);
          *(nu4*)(dst + (size_t)nr * K + k0 + ks) = w; }
        __syncthreads();
    }
}
__device__ void ph_convert_w(const P& p, int l, LAS unsigned char* lds) {
    LAS float* tile = (LAS float*)lds;
    convert_one(p.in[6] + (size_t)l * DM * D_IN, (bf16_t*)(p.ws + OFF_W_IN), DM, D_IN, tile);
    convert_one(p.in[21] + (size_t)l * DM * DM, (bf16_t*)(p.ws + OFF_W_OUT), DM, DM, tile);
    convert_one(p.in[22] + (size_t)l * DM * 2 * DFF, (bf16_t*)(p.ws + OFF_W_UP), DM, 2 * DFF, tile, true);
    convert_one(p.in[25] + (size_t)l * DFF * DM, (bf16_t*)(p.ws + OFF_W_DN), DFF, DM, tile);
    { const float* w4 = p.in[15] + (size_t)l * 64 * 1024; bf16_t* w4t = (bf16_t*)(p.ws + OFF_W4T);
      for (int idx = blockIdx.x * 512 + TIDX; idx < 65536; idx += gridDim.x * 512) { const int o = idx >> 6, f = idx & 63; w4t[idx] = f2bf(w4[f * 1024 + o]); } }
}
__device__ __forceinline__ bf16_t* abuf_row(const P& p, int t) { return (bf16_t*)(p.ws + OFF_ABUF) + (size_t)(t + APAD) * DM; }
__device__ void ph_rmsnorm_in(const P& p, int l) {
    const int lane = TIDX & 63, wv = TIDX >> 6;
    const float* gain = p.in[2] + (size_t)l * DM;
    for (int t = blockIdx.x * 8 + wv; t < T_TOK; t += gridDim.x * 8) {
        const float* xr = x_src_row(p, l, t);
        float4 v[4]; float ss = 0.f;
#pragma unroll
        for (int i = 0; i < 4; ++i) { v[i] = *(const float4*)(xr + lane * 4 + 256 * i); ss += v[i].x * v[i].x + v[i].y * v[i].y + v[i].z * v[i].z + v[i].w * v[i].w; }
        ss = wave_sum(ss);
        const float r = rsqrtf(ss * (1.0f / DM) + 1e-6f);
        bf16_t* hr = abuf_row(p, t);
#pragma unroll
        for (int i = 0; i < 4; ++i) { const float4 g = *(const float4*)(gain + lane * 4 + 256 * i);
            uint2 w; w.x = pack_bf2(v[i].x * r * g.x, v[i].y * r * g.y); w.y = pack_bf2(v[i].z * r * g.z, v[i].w * r * g.w);
            *(uint2*)(hr + lane * 4 + 256 * i) = w; }
    }
}
constexpr int NRR = 4;
__device__ __forceinline__ bf16_t* xb_buf(const P& p, bool r6) { return r6 ? (bf16_t*)(p.ws + OFF_R6) : (bf16_t*)((unsigned char*)p.out + 64 * MiB); }
__device__ void ph_norm_resid(const P& p, int l, int which) {
    const int lane = TIDX & 63, wv = TIDX >> 6;
    const float* gpost = (which == 0 ? PRM(p, norm_mix_post) : PRM(p, norm_ffn_post)) + (size_t)l * DM;
    const bool has_next = (which == 0) || (l + 1 < NLAYER);
    const float* gnext = which == 0 ? PRM(p, norm_ffn_pre) + (size_t)l * DM : PRM(p, norm_mix_pre) + (size_t)(has_next ? l + 1 : l) * DM;
    const bf16_t* Y = (const bf16_t*)(p.ws + OFF_MIX);
    const bool in_f32 = (l == 0 && which == 0), out_f32 = (l == NLAYER - 1 && which == 1);
    const bf16_t* xin = xb_buf(p, l == NLAYER - 1 && which == 1);
    bf16_t* xout = xb_buf(p, l == NLAYER - 1 && which == 0);
    nf4 gp[4], gn[4];
#pragma unroll
    for (int i = 0; i < 4; ++i) { gp[i] = *(const nf4*)(gpost + lane * 4 + 256 * i); gn[i] = *(const nf4*)(gnext + lane * 4 + 256 * i); }
    for (int t0 = (blockIdx.x * 8 + wv) * NRR; t0 < T_TOK; t0 += gridDim.x * 8 * NRR) {
        nf4 x[NRR][4]; nu2 yw[NRR][4];
#pragma unroll
        for (int rr = 0; rr < NRR; ++rr) { const bf16_t* yr = Y + (size_t)(t0 + rr) * DM;
            if (in_f32) { const float* xr = x_src_row(p, 0, t0 + rr);
#pragma unroll
                for (int i = 0; i < 4; ++i) x[rr][i] = *(const nf4*)(xr + lane * 4 + 256 * i);
            } else { const bf16_t* xr = xin + (size_t)(t0 + rr) * DM;
#pragma unroll
                for (int i = 0; i < 4; ++i) { const nu2 w = *(const nu2*)(xr + lane * 4 + 256 * i);
                    x[rr][i].x = __uint_as_float(w.x << 16); x[rr][i].y = __uint_as_float(w.x & 0xffff0000u); x[rr][i].z = __uint_as_float(w.y << 16); x[rr][i].w = __uint_as_float(w.y & 0xffff0000u); } }
#pragma unroll
            for (int i = 0; i < 4; ++i) yw[rr][i] = *(const nu2*)(yr + lane * 4 + 256 * i); }
#pragma unroll
        for (int rr = 0; rr < NRR; ++rr) {
            const int t = t0 + rr;
            nf4 y[4]; float ss = 0.f;
#pragma unroll
            for (int i = 0; i < 4; ++i) { const nu2 w = yw[rr][i];
                y[i].x = __uint_as_float(w.x << 16); y[i].y = __uint_as_float(w.x & 0xffff0000u); y[i].z = __uint_as_float(w.y << 16); y[i].w = __uint_as_float(w.y & 0xffff0000u);
                ss += y[i].x * y[i].x + y[i].y * y[i].y + y[i].z * y[i].z + y[i].w * y[i].w; }
            ss = wave_sum(ss);
            const float r = rsqrtf(ss * (1.0f / DM) + 1e-6f);
            float s2 = 0.f;
#pragma unroll
            for (int i = 0; i < 4; ++i) { nf4 xv = x[rr][i];
                xv.x += y[i].x * r * gp[i].x; xv.y += y[i].y * r * gp[i].y; xv.z += y[i].z * r * gp[i].z; xv.w += y[i].w * r * gp[i].w;
                s2 += xv.x * xv.x + xv.y * xv.y + xv.z * xv.z + xv.w * xv.w;
                x[rr][i] = xv;
                if (out_f32) *(nf4*)(p.out + (size_t)t * DM + lane * 4 + 256 * i) = xv;
                else { nu2 w; w.x = pack_bf2(xv.x, xv.y); w.y = pack_bf2(xv.z, xv.w); *(nu2*)(xout + (size_t)t * DM + lane * 4 + 256 * i) = w; } }
            if (has_next) {
                s2 = wave_sum(s2);
                const float r2 = rsqrtf(s2 * (1.0f / DM) + 1e-6f);
                bf16_t* hr = abuf_row(p, t);
#pragma unroll
                for (int i = 0; i < 4; ++i) { const nf4 xv = x[rr][i];
                    nu2 w; w.x = pack_bf2(xv.x * r2 * gn[i].x, xv.y * r2 * gn[i].y); w.y = pack_bf2(xv.z * r2 * gn[i].z, xv.w * r2 * gn[i].w);
                    *(nu2*)(hr + lane * 4 + 256 * i) = w; }
            }
        }
    }
}
__device__ void ph_filter(const P& p, int l, LAS unsigned char* lds) {
    LAS float* feats = (LAS float*)lds;
    LAS float* ha = feats + 16 * 36;
    LAS float* hb = ha + 16 * 64;
    LAS float* w1s = hb + 16 * 64;
    LAS float* w2s = w1s + 33 * 64;
    LAS float* w3s = w2s + 64 * 64;
    LAS bf16_t* h3b = (LAS bf16_t*)(w3s + 64 * 64);
    const int tid = TIDX;
    const float* w1 = PRM(p, f_w1) + (size_t)l * 33 * 64; const float* b1 = PRM(p, f_b1) + (size_t)l * 64;
    const float* w2 = PRM(p, f_w2) + (size_t)l * 64 * 64; const float* b2 = PRM(p, f_b2) + (size_t)l * 64;
    const float* w3 = PRM(p, f_w3) + (size_t)l * 64 * 64; const float* b3 = PRM(p, f_b3) + (size_t)l * 64;
    const float* w4 = PRM(p, f_w4) + (size_t)l * 64 * 1024; const float* fq = PRM(p, f_freq) + (size_t)l * 64;
    float* kt = (float*)(p.ws + OFF_KT);
    for (int i = tid; i < 33 * 64; i += 512) w1s[i] = w1[i];
    for (int i = tid; i < 64 * 64; i += 512) { w2s[i] = w2[i]; w3s[i] = w3[i]; }
    const int j = tid & 63;
    const float fqj = fq[j], b1j = b1[j], b2j = b2[j], b3j = b3[j];
    pg8::bf16x8 bfrag[8][2];
    { const bf16_t* w4t = (const bf16_t*)(p.ws + OFF_W4T); const int lane = tid & 63, w = tid >> 6;
#pragma unroll
      for (int nt = 0; nt < 8; ++nt)
#pragma unroll
          for (int ks = 0; ks < 2; ++ks) bfrag[nt][ks] = *(const pg8::bf16x8*)(w4t + (size_t)(128 * w + 16 * nt + (lane & 15)) * 64 + 32 * ks + 8 * (lane >> 4)); }
    __syncthreads();
    const int nitems = (L_BIG + L_SML) / 16;
    for (int it = blockIdx.x; it < nitems; it += gridDim.x) {
        const bool big = it < L_BIG / 16; const int L = big ? L_BIG : L_SML; const int pos0 = (big ? it : it - L_BIG / 16) * 16;
        float* ktc = kt + (big ? 0 : (size_t)512 * 2 * L_BIG);
        for (int idx = tid; idx < 16 * 33; idx += 512) {
            const int pp = idx / 33, f = idx % 33; const int pos = pos0 + pp;
            const float tt = (float)pos / (float)(L - 1), ang = (6.283185307179586f / (float)L) * (float)pos;
            float v;
            if (f == 0) v = tt;
            else { const int bi = (f - 1) & 15; const float band = 1e-4f + (float)bi * ((15.0f - 1e-4f) / 15.0f); v = f <= 16 ? cosf(band * ang) : -sinf(band * ang); }
            feats[pp * 36 + f] = v;
        }
        __syncthreads();
#pragma unroll
        for (int h2 = 0; h2 < 2; ++h2) { const int pp = (tid >> 6) + 8 * h2; float a = b1j;
            for (int f = 0; f < 33; ++f) a += feats[pp * 36 + f] * w1s[f * 64 + j];
            ha[pp * 64 + j] = __sinf(fqj * a); }
        __syncthreads();
#pragma unroll
        for (int h2 = 0; h2 < 2; ++h2) { const int pp = (tid >> 6) + 8 * h2; float a = b2j;
#pragma unroll 4
            for (int f4 = 0; f4 < 16; ++f4) { const nf4 hv = *(const LAS nf4*)(ha + pp * 64 + 4 * f4);
                a += hv.x * w2s[(4 * f4) * 64 + j] + hv.y * w2s[(4 * f4 + 1) * 64 + j] + hv.z * w2s[(4 * f4 + 2) * 64 + j] + hv.w * w2s[(4 * f4 + 3) * 64 + j]; }
            hb[pp * 64 + j] = __sinf(fqj * a); }
        __syncthreads();
#pragma unroll
        for (int h2 = 0; h2 < 2; ++h2) { const int pp = (tid >> 6) + 8 * h2; float a = b3j;
#pragma unroll 4
            for (int f4 = 0; f4 < 16; ++f4) { const nf4 hv = *(const LAS nf4*)(hb + pp * 64 + 4 * f4);
                a += hv.x * w3s[(4 * f4) * 64 + j] + hv.y * w3s[(4 * f4 + 1) * 64 + j] + hv.z * w3s[(4 * f4 + 2) * 64 + j] + hv.w * w3s[(4 * f4 + 3) * 64 + j]; }
            h3b[pp * 72 + j] = f2bf(__sinf(fqj * a)); }
        __syncthreads();
        {
            const int lane = tid & 63, w = tid >> 6, r16 = lane & 15, kg = lane >> 4;
            pg8::f32x4 acc[8];
#pragma unroll
            for (int nt = 0; nt < 8; ++nt) acc[nt] = (pg8::f32x4){0.f, 0.f, 0.f, 0.f};
            pg8::bf16x8 af[2];
#pragma unroll
            for (int ks = 0; ks < 2; ++ks) af[ks] = *(const LAS pg8::bf16x8*)(h3b + r16 * 72 + 32 * ks + 8 * kg);
#pragma unroll
            for (int nt = 0; nt < 8; ++nt)
#pragma unroll
                for (int ks = 0; ks < 2; ++ks) acc[nt] = __builtin_amdgcn_mfma_f32_16x16x32_bf16(af[ks], bfrag[nt][ks], acc[nt], 0, 0, 0);
            const float invl = 1.0f / (float)(L - 1);
            const float dstep = (15.350567286626972f - 3.0701134573253945f) / 511.0f;
            float tt[4];
#pragma unroll
            for (int i = 0; i < 4; ++i) tt[i] = (float)(pos0 + 4 * kg + i) * invl;
#pragma unroll
            for (int nt = 0; nt < 8; ++nt) { const int o = 128 * w + 16 * nt + r16, dir = o >> 9, c = o & 511;
                const float dl = 3.0701134573253945f + (float)c * dstep;
                nf4 v;
#pragma unroll
                for (int i = 0; i < 4; ++i) v[i] = acc[nt][i] * __expf(-tt[i] * dl);
                *(nf4*)(ktc + (size_t)(c * 2 + dir) * L + pos0 + 4 * kg) = v; }
        }
        __syncthreads();
    }
}
__device__ void ph_hy_prep(const P& p, int l, LAS unsigned char* lds) {
    constexpr int RS = 3 * 128 + 8;
    LAS bf16_t* raw = (LAS bf16_t*)lds;
    LAS bf16_t* ox = (LAS bf16_t*)(lds + 52224);
    LAS bf16_t* oz = ox + 128 * 72;
    const bf16_t* hy = (const bf16_t*)(p.ws + OFF_HYRAW);
    bf16_t* x0t = (bf16_t*)(p.ws + OFF_X0T); bf16_t* zt = (bf16_t*)(p.ws + OFF_ZT);
    const float* cw = PRM(p, hy_conv_w) + (size_t)l * 3 * 1536; const float* cb = PRM(p, hy_conv_b) + (size_t)l * 1536;
    const int tid = TIDX, nitems = (T_TOK / 64) * 4;
    for (int it = blockIdx.x; it < nitems; it += gridDim.x) {
        const int t0 = (it >> 2) * 64, c0 = (it & 3) * 128;
        for (int idx = tid; idx < 66 * 48; idx += 512) {
            const int row = idx / 48, rem = idx - row * 48, a = rem >> 4, pc = rem & 15;
            int t = t0 - 1 + row; t = t < 0 ? 0 : (t >= T_TOK ? T_TOK - 1 : t);
            *(LAS nu4*)(raw + row * RS + a * 128 + pc * 8) = *(const nu4*)(hy + (size_t)t * 1536 + a * 512 + c0 + pc * 8);
        }
        __syncthreads();
        {
            const int c = tid & 127, tq = tid >> 7;
            float wv[3][3], bv[3];
#pragma unroll
            for (int a = 0; a < 3; ++a) { bv[a] = cb[a * 512 + c0 + c];
#pragma unroll
                for (int k = 0; k < 3; ++k) wv[a][k] = cw[k * 1536 + a * 512 + c0 + c]; }
            float xm[3], xc[3];
#pragma unroll
            for (int a = 0; a < 3; ++a) { xm[a] = bf2f(raw[(tq * 16) * RS + a * 128 + c]); xc[a] = bf2f(raw[(tq * 16 + 1) * RS + a * 128 + c]); }
            unsigned px = 0, pz = 0;
#pragma unroll
            for (int j = 0; j < 16; ++j) {
                const int tt = tq * 16 + j, t = t0 + tt;
                const bool hp = !seq_start(t), hn = !seq_end(t);
                float r[3];
#pragma unroll
                for (int a = 0; a < 3; ++a) { const float xp = bf2f(raw[(tt + 2) * RS + a * 128 + c]);
                    r[a] = (hp ? xm[a] * wv[a][0] : 0.f) + xc[a] * wv[a][1] + (hn ? xp * wv[a][2] : 0.f) + bv[a];
                    xm[a] = xc[a]; xc[a] = xp; }
                const unsigned bx = f2bf(r[0]), bz = f2bf(r[1] * r[2]);
                if (j & 1) { px |= bx << 16; pz |= bz << 16;
                    *(LAS unsigned*)(ox + c * 72 + tt - 1) = px; *(LAS unsigned*)(oz + c * 72 + tt - 1) = pz; }
                else { px = bx; pz = bz; }
            }
        }
        __syncthreads();
        for (int idx = tid; idx < 128 * 16; idx += 512) {
            const int c = idx >> 4, rem = idx & 15, arr = rem >> 3, pc = rem & 7;
            const nu4 v = *(const LAS nu4*)((arr ? oz : ox) + c * 72 + pc * 8);
            *(nu4*)((arr ? zt : x0t) + (size_t)(c0 + c) * T_TOK + t0 + pc * 8) = v;
        }
        __syncthreads();
    }
}
__device__ __forceinline__ cf2 ld_f2_agent(const cf2* ptr) {
    const unsigned long long w = __hip_atomic_load((const unsigned long long*)ptr, __ATOMIC_RELAXED, __HIP_MEMORY_SCOPE_AGENT);
    return mkf2(__uint_as_float((unsigned)w), __uint_as_float((unsigned)(w >> 32)));
}
template <int S, int NSEQ>
__device__ __forceinline__ void hy_fft_job(const P& p, int l, LAS cf2* X, cf2* Ks, int c, int tbase) {
    const int tid = TIDX;
    constexpr int M = 1 << (2 * S), L = M, MP = M + (M >> 5);
    const float* kt = (const float*)(p.ws + OFF_KT);
    const bf16_t* x0t = (const bf16_t*)(p.ws + OFF_X0T); bf16_t* zt = (bf16_t*)(p.ws + OFF_ZT);
    const float* hf = kt + (S == 7 ? 0 : (size_t)512 * 2 * L_BIG) + (size_t)(c * 2) * L; const float* hb = hf + L;
#pragma unroll 4
    for (int m = tid; m < M; m += 512) {
        const int n0 = 2 * m, n1 = 2 * m + 1;
        const float a = n0 < L ? hf[n0] : (n0 == L ? 0.f : hb[2 * L - n0]);
        const float b = n1 < L ? hf[n1] : hb[2 * L - n1];
        X[PADI(m)] = mkf2(a, b);
    }
    __syncthreads();
    fft_fwd2<S, 1>(X);
    spec_store(X, S, Ks);
    __builtin_amdgcn_fence(__ATOMIC_ACQUIRE, "agent");
    asm volatile("s_waitcnt vmcnt(0)" ::: "memory");
    __syncthreads();
    const float skip = PRM(p, hy_skip)[(size_t)l * D_HY + c];
    const bf16_t* zrow = zt + (size_t)c * T_TOK + tbase; const bf16_t* xrow = x0t + (size_t)c * T_TOK + tbase;
#pragma unroll 4
    for (int idx = tid; idx < NSEQ * (M >> 1); idx += 512) {
        const int sq = idx / (M >> 1), m = idx - sq * (M >> 1);
        const unsigned w = *(const unsigned*)(zrow + sq * L + 2 * m);
        X[sq * MP + PADI(m)] = mkf2(__uint_as_float(w << 16), __uint_as_float(w & 0xffff0000u));
    }
    __syncthreads();
    fft_fwd2<S, NSEQ, true>(X);
    spec_mul(X, S, Ks, NSEQ);
    fft_inv2<S, NSEQ, true>(X);
    const float inv = 1.0f / (float)M;
    bf16_t* orow = zt + (size_t)c * T_TOK + tbase;
#pragma unroll 4
    for (int idx = tid; idx < NSEQ * (M >> 1); idx += 512) {
        const int sq = idx / (M >> 1), m = idx - sq * (M >> 1);
        const cf2 d = X[sq * MP + PADI(m)];
        const unsigned wz = *(const unsigned*)(zrow + sq * L + 2 * m), wx = *(const unsigned*)(xrow + sq * L + 2 * m);
        const float z0 = __uint_as_float(wz << 16), z1 = __uint_as_float(wz & 0xffff0000u), a0 = __uint_as_float(wx << 16), a1 = __uint_as_float(wx & 0xffff0000u);
        *(unsigned*)(orow + sq * L + 2 * m) = pack_bf2(a0 * (d.x * inv + skip * z0), a1 * (d.y * inv + skip * z1));
    }
    __syncthreads();
}
__device__ void ph_hy_fft(const P& p, int l, LAS unsigned char* lds) {
    LAS cf2* X = (LAS cf2*)lds;
    cf2* Ks = (cf2*)(p.ws + OFF_KS) + (size_t)blockIdx.x * L_BIG;
    for (int job = blockIdx.x; job < 1024; job += gridDim.x) {
        const bool big = job < 512; const int c = job & 511;
        if (big) hy_fft_job<7, 1>(p, l, X, Ks, c, 0); else hy_fft_job<6, 4>(p, l, X, Ks, c, L_BIG);
    }
}
__device__ void ph_hy_norm(const P& p, int l, LAS unsigned char* lds) {
    LAS bf16_t* tl = (LAS bf16_t*)lds;
    LAS float* red = (LAS float*)(lds + 9216);
    const bf16_t* yh = (const bf16_t*)(p.ws + OFF_ZT);
    const float* gain = PRM(p, hy_out_norm) + (size_t)l * D_HY;
    const int tid = TIDX, nitems = (T_TOK / 64) * 8;
    for (int it = blockIdx.x; it < nitems; it += gridDim.x) {
        const int t0 = (it >> 3) * 64, c0 = (it & 7) * 64;
        { const int cc = tid >> 3, pc = tid & 7;
          *(LAS nu4*)(tl + cc * 72 + pc * 8) = *(const nu4*)(yh + (size_t)(c0 + cc) * T_TOK + t0 + pc * 8); }
        __syncthreads();
        { const int tt = tid & 63, part = tid >> 6; float s = 0.f;
#pragma unroll
          for (int j = 0; j < 8; ++j) { const float v = bf2f(tl[(part * 8 + j) * 72 + tt]); s += v * v; }
          red[part * 64 + tt] = s; }
        __syncthreads();
        { const int tt = tid >> 3, pc = tid & 7;
          float s = 0.f;
#pragma unroll
          for (int j = 0; j < 8; ++j) s += red[j * 64 + tt];
          const float r = rsqrtf(s * (1.0f / 64.0f) + 1e-6f);
          unsigned w[4];
#pragma unroll
          for (int j = 0; j < 4; ++j) { const int ca = pc * 8 + 2 * j;
              w[j] = pack_bf2(bf2f(tl[ca * 72 + tt]) * r * gain[c0 + ca], bf2f(tl[(ca + 1) * 72 + tt]) * r * gain[c0 + ca + 1]); }
          nu4 o; o.x = w[0]; o.y = w[1]; o.z = w[2]; o.w = w[3];
          *(nu4*)(abuf_row(p, t0 + tt) + c0 + pc * 8) = o; }
        __syncthreads();
    }
}
typedef short hbf16x8 __attribute__((ext_vector_type(8)));
typedef float hf32x16 __attribute__((ext_vector_type(16)));
constexpr int HSC = 512, HNCH = HSC / 64, HNSC = T_TOK / HSC;
constexpr int QS = 136, KS_ = 72;
constexpr int HL_QH = 0, HL_KH = HL_QH + 64 * QS * 2, HL_QT = HL_KH + 64 * QS * 2, HL_KT = HL_QT + 64 * QS * 2, HL_VT = HL_KT + 128 * KS_ * 2, HL_ST = HL_VT + 128 * KS_ * 2,
              HL_PM = HL_ST + 128 * QS * 2, HL_TOT = HL_PM + 64 * KS_ * 2, HL_EB = HL_TOT + 4 * 128 * 4, HL_END = HL_EB + 128 * 4;
constexpr int HL_OF = HL_QH, OFS = 132;
static_assert(64 * OFS * 4 <= 2 * 64 * QS * 2, "O tile must fit over Qh|Kh");
constexpr size_t OFF_HST = OFF_R6 + 32 * MiB;
constexpr size_t OFF_HAT = OFF_SMALL + 64 * 1024;

__device__ __forceinline__ hf32x16 mfma32(hbf16x8 a, hbf16x8 b, hf32x16 c) { return __builtin_amdgcn_mfma_f32_32x32x16_bf16(a, b, c, 0, 0, 0); }
__device__ __forceinline__ hbf16x8 lds_frag(const LAS unsigned char* base, int row, int stride_el, int col_el) { return *(const LAS hbf16x8*)(base + ((size_t)row * stride_el + col_el) * 2); }

typedef unsigned hu32x4 __attribute__((ext_vector_type(4)));
struct HgPre { hu32x4 f0, f1, v0, v1, q0, q1; };
template <bool FULL>
__device__ __forceinline__ void hg_fetch(const bf16_t* hg, HgPre& pre, int tokbase, int dirsign, int h, int dir) {
    const int tid = TIDX;
    { const int u = tid >> 4, seg = tid & 15;
      const bf16_t* row = hg + (size_t)(tokbase + dirsign * u) * 2560 + h * 128 + seg * 8;
      pre.f0 = *(const hu32x4*)(row + 512 + 512 * dir); pre.v0 = *(const hu32x4*)(row + 1536); if (FULL) pre.q0 = *(const hu32x4*)(row);
      const bf16_t* row1 = row + (size_t)dirsign * 32 * 2560;
      pre.f1 = *(const hu32x4*)(row1 + 512 + 512 * dir); pre.v1 = *(const hu32x4*)(row1 + 1536); if (FULL) pre.q1 = *(const hu32x4*)(row1); }
}
template <bool FULL>
__device__ __forceinline__ void hg_prep(LAS unsigned char* lds, const HgPre& pre, float lb, float& Bsum_out) {
    const int tid = TIDX, d = tid & 127, qt = tid >> 7;
    LAS float* tot = (LAS float*)(lds + HL_TOT); LAS float* eB = (LAS float*)(lds + HL_EB);
    { const int u = tid >> 4, seg = tid & 15;
      *(LAS hu32x4*)(lds + HL_KH + ((size_t)u * QS + seg * 8) * 2) = pre.f0; *(LAS hu32x4*)(lds + HL_KH + ((size_t)(u + 32) * QS + seg * 8) * 2) = pre.f1;
      *(LAS hu32x4*)(lds + HL_QH + ((size_t)u * QS + seg * 8) * 2) = pre.v0; *(LAS hu32x4*)(lds + HL_QH + ((size_t)(u + 32) * QS + seg * 8) * 2) = pre.v1;
      if (FULL) { *(LAS hu32x4*)(lds + HL_QT + ((size_t)u * QS + seg * 8) * 2) = pre.q0; *(LAS hu32x4*)(lds + HL_QT + ((size_t)(u + 32) * QS + seg * 8) * 2) = pre.q1; } }
    __syncthreads();
    float c[16];
    float run = 0.f;
    const float oml = 1.0f - lb;
    float zz[16];
#pragma unroll
    for (int j = 0; j < 16; ++j) zz[j] = bf2f(*(const LAS bf16_t*)(lds + HL_KH + ((size_t)(qt * 16 + j) * QS + d) * 2));
    __builtin_amdgcn_sched_barrier(0);
#pragma unroll
    for (int j = 0; j < 16; ++j) {
        const int u = qt * 16 + j;
        const float z = fmaxf(zz[j], -60.0f);
        const float f = lb + oml * __builtin_amdgcn_rcpf(1.0f + __expf(-z));
        zz[j] = 1.0f - f;
        run += __logf(f);
        c[j] = run;
    }
    tot[qt * 128 + d] = run;
    float vv[16], qq[16];
#pragma unroll
    for (int j = 0; j < 16; ++j) { vv[j] = __uint_as_float((unsigned)(*(const LAS bf16_t*)(lds + HL_QH + ((size_t)(qt * 16 + j) * QS + d) * 2)));
        if (FULL) qq[j] = bf2f(*(const LAS bf16_t*)(lds + HL_QT + ((size_t)(qt * 16 + j) * QS + d) * 2)); }
    __syncthreads();
    const float t0 = tot[d], t1 = tot[128 + d], t2 = tot[256 + d], t3 = tot[384 + d];
    const float off = qt == 0 ? 0.f : (qt == 1 ? t0 : (qt == 2 ? t0 + t1 : t0 + t1 + t2));
    const float r = t0 + t1, B = t0 + t1 + t2 + t3;
    const float eBr = __expf(B - r), eR = __expf(r);
    if (qt == 0) eB[d] = __expf(B);
    Bsum_out = B;
#pragma unroll
    for (int jj = 0; jj < 8; ++jj) {
        unsigned pkt = 0, pvt = 0;
#pragma unroll
        for (int q2 = 0; q2 < 2; ++q2) {
            const int j = jj * 2 + q2, u = qt * 16 + j;
            const float rb = r - (off + c[j]);
            const float kh = zz[j] * __expf(rb);
            pkt |= (unsigned)f2bf(kh * eBr) << (16 * q2); pvt |= __float_as_uint(vv[j]) << (16 * q2);
            if (FULL) {
                const float zq = qq[j];
                const float q = zq * __builtin_amdgcn_rcpf(1.0f + __expf(-zq));
                const float qh = q * __expf(-rb);
                *(LAS bf16_t*)(lds + HL_QT + ((size_t)u * QS + d) * 2) = f2bf(qh * eR);
                *(LAS bf16_t*)(lds + HL_QH + ((size_t)u * QS + d) * 2) = f2bf(qh);
                *(LAS bf16_t*)(lds + HL_KH + ((size_t)u * QS + d) * 2) = f2bf(kh);
            }
        }
        *(LAS unsigned*)(lds + HL_KT + ((size_t)d * KS_ + qt * 16 + jj * 2) * 2) = pkt;
        *(LAS unsigned*)(lds + HL_VT + ((size_t)d * KS_ + qt * 16 + jj * 2) * 2) = pvt;
    }
    __syncthreads();
}
__device__ __forceinline__ void hg_state_update(LAS unsigned char* lds, hf32x16 (&S)[2], int w, int lane) {
    const int en = w & 3, r = lane & 31, hh = lane >> 5;
    const LAS float* eB = (const LAS float*)(lds + HL_EB);
#pragma unroll
    for (int i = 0; i < 2; ++i) {
        const int dm = (w >> 2) * 2 + i;
#pragma unroll
        for (int g = 0; g < 4; ++g) { const nf4 sc = *(const LAS nf4*)(eB + 32 * dm + 8 * g + 4 * hh);
            S[i][4 * g + 0] *= sc.x; S[i][4 * g + 1] *= sc.y; S[i][4 * g + 2] *= sc.z; S[i][4 * g + 3] *= sc.w; }
#pragma unroll
        for (int ks = 0; ks < 4; ++ks) {
            const hbf16x8 a = lds_frag(lds + HL_KT, 32 * dm + r, KS_, 16 * ks + 8 * hh);
            const hbf16x8 b = lds_frag(lds + HL_VT, 32 * en + r, KS_, 16 * ks + 8 * hh);
            S[i] = mfma32(a, b, S[i]);
        }
    }
}
__device__ __forceinline__ int hg_unit_base(int sc) { return sc * HSC; }
__device__ void ph_hg_pass1(const P& p, int l, LAS unsigned char* lds) {
    const bf16_t* hg = (const bf16_t*)(p.ws + OFF_HG);
    const float* lbs = (const float*)(p.ws + OFF_SMALL);
    float* ust = (float*)(p.ws + OFF_HST); float* atot = (float*)(p.ws + OFF_HAT);
    const int tid = TIDX, w = tid >> 6, lane = tid & 63;
    for (int unit = blockIdx.x; unit < HNSC * 8; unit += gridDim.x) {
        const int sc = unit >> 3, h = (unit >> 1) & 3, dir = unit & 1;
        const float lb = lbs[(size_t)(dir * NLAYER + l) * D_HG + h * 128 + (tid & 127)];
        hf32x16 S[2];
#pragma unroll
        for (int i = 0; i < 2; ++i)
#pragma unroll
            for (int k = 0; k < 16; ++k) S[i][k] = 0.f;
        float Btot = 0.f;
        const int dsg = dir ? -1 : 1, tb0 = dir ? hg_unit_base(sc) + HSC - 1 : hg_unit_base(sc);
        HgPre pre;
        hg_fetch<false>(hg, pre, tb0, dsg, h, dir);
        for (int ci = 0; ci < HNCH; ++ci) {
            float B;
            hg_prep<false>(lds, pre, lb, B);
            if (ci + 1 < HNCH) hg_fetch<false>(hg, pre, tb0 + dsg * (ci + 1) * 64, dsg, h, dir);
            Btot += B;
            hg_state_update(lds, S, w, lane);
            __syncthreads();
        }
        float* U = ust + (size_t)unit * 16384;
        int r = lane & 31, hh = lane >> 5; asm volatile("" : "+v"(r), "+v"(hh));
        const int en = w & 3;
#pragma unroll
        for (int i = 0; i < 2; ++i) { const int dm = (w >> 2) * 2 + i;
#pragma unroll
            for (int k = 0; k < 16; ++k) U[(32 * dm + (k & 3) + 8 * (k >> 2) + 4 * hh) * 128 + 32 * en + r] = S[i][k]; }
        if (tid < 128) atot[(size_t)unit * 128 + tid] = __expf(Btot);
    }
}
__device__ void ph_hg_pass2(const P& p) {
    float* ust = (float*)(p.ws + OFF_HST); const float* atot = (const float*)(p.ws + OFF_HAT);
    const int total = 5 * 8 * 16384;
    for (int idx = blockIdx.x * 512 + TIDX; idx < total; idx += gridDim.x * 512) {
        const int el = idx & 16383, hd = (idx >> 14) & 7, sq = idx >> 17;
        const int sc0 = sq == 0 ? 0 : 32 + 8 * (sq - 1), nsc = sq == 0 ? 32 : 8, dir = hd & 1, d = el >> 7;
        float carry = 0.f;
        for (int j0 = 0; j0 < nsc; j0 += 8) {
            float u[8], a[8];
#pragma unroll
            for (int jj = 0; jj < 8; ++jj) { const int j = j0 + jj, sc = dir ? sc0 + nsc - 1 - j : sc0 + j; const size_t unit = (size_t)sc * 8 + hd;
                u[jj] = ust[unit * 16384 + el]; a[jj] = atot[unit * 128 + d]; }
#pragma unroll
            for (int jj = 0; jj < 8; ++jj) { const int j = j0 + jj, sc = dir ? sc0 + nsc - 1 - j : sc0 + j; const size_t unit = (size_t)sc * 8 + hd;
                ust[unit * 16384 + el] = carry; carry = a[jj] * carry + u[jj]; }
        }
    }
}
__device__ void ph_hg_pass3(const P& p, int l, LAS unsigned char* lds) {
    const bf16_t* hg = (const bf16_t*)(p.ws + OFF_HG);
    const float* lbs = (const float*)(p.ws + OFF_SMALL);
    const float* ust = (const float*)(p.ws + OFF_HST);
    const float* gain = PRM(p, hg_out_norm) + (size_t)l * D_HG;
    const int tid = TIDX, w = tid >> 6, lane = tid & 63, r = lane & 31, hh = lane >> 5;
    for (int unit = blockIdx.x; unit < HNSC * 4; unit += gridDim.x) {
        const int sc = unit >> 2, h = unit & 3;
        for (int dir = 0; dir < 2; ++dir) {
            const float lb = lbs[(size_t)(dir * NLAYER + l) * D_HG + h * 128 + (tid & 127)];
            const float* S0 = ust + ((size_t)sc * 8 + h * 2 + dir) * 16384;
            hf32x16 S[2];
            { const int en = w & 3;
              int r_ = r, hh_ = hh; asm volatile("" : "+v"(r_), "+v"(hh_));
              const float* S0l = S0 + (4 * hh_) * 128 + 32 * en + r_;
#pragma unroll
              for (int i = 0; i < 2; ++i) { const int dm = (w >> 2) * 2 + i;
#pragma unroll
                  for (int k = 0; k < 16; ++k) S[i][k] = S0l[(32 * dm + (k & 3) + 8 * (k >> 2)) * 128];
#pragma unroll
                  for (int g = 0; g < 4; ++g) { nu2 wv; wv.x = pack_bf2(S[i][4 * g], S[i][4 * g + 1]); wv.y = pack_bf2(S[i][4 * g + 2], S[i][4 * g + 3]);
                      *(LAS nu2*)(lds + HL_ST + ((size_t)(32 * en + r) * QS + 32 * dm + 8 * g + 4 * hh) * 2) = wv; } } }
            const int dsg = dir ? -1 : 1, tb0 = dir ? hg_unit_base(sc) + HSC - 1 : hg_unit_base(sc);
            HgPre pre;
            hg_fetch<true>(hg, pre, tb0, dsg, h, dir);
            for (int ci = 0; ci < HNCH; ++ci) {
                const int tokbase = tb0 + dsg * ci * 64;
                float Bdummy;
                hg_prep<true>(lds, pre, lb, Bdummy);
                if (ci + 1 < HNCH) hg_fetch<true>(hg, pre, tb0 + dsg * (ci + 1) * 64, dsg, h, dir);
                if (w < 4) {
                    const int tm = (w == 0 || w == 3) ? 0 : 1, sn = (w == 2 || w == 3) ? 1 : 0;
                    hf32x16 acc;
#pragma unroll
                    for (int k = 0; k < 16; ++k) acc[k] = 0.f;
                    if (w < 3) {
#pragma unroll
                        for (int ks = 0; ks < 8; ++ks) acc = mfma32(lds_frag(lds + HL_QH, 32 * tm + r, QS, 16 * ks + 8 * hh), lds_frag(lds + HL_KH, 32 * sn + r, QS, 16 * ks + 8 * hh), acc);
                    }
                    const int s_ = 32 * sn + r;
#pragma unroll
                    for (int k = 0; k < 16; ++k) { const int t_ = 32 * tm + (k & 3) + 8 * (k >> 2) + 4 * hh;
                        const float v = (w < 3 && s_ <= t_) ? acc[k] : 0.f;
                        *(LAS bf16_t*)(lds + HL_PM + ((size_t)t_ * KS_ + s_) * 2) = f2bf(v); }
                }
                __syncthreads();
                hf32x16 o;
                { const int tm = w >> 2, en = w & 3;
#pragma unroll
                  for (int k = 0; k < 16; ++k) o[k] = 0.f;
#pragma unroll
                  for (int ks = 0; ks < 4; ++ks) o = mfma32(lds_frag(lds + HL_PM, 32 * tm + r, KS_, 16 * ks + 8 * hh), lds_frag(lds + HL_VT, 32 * en + r, KS_, 16 * ks + 8 * hh), o);
#pragma unroll
                  for (int ks = 0; ks < 8; ++ks) o = mfma32(lds_frag(lds + HL_QT, 32 * tm + r, QS, 16 * ks + 8 * hh), lds_frag(lds + HL_ST, 32 * en + r, QS, 16 * ks + 8 * hh), o);
                }
                __syncthreads();
                { const int tm = w >> 2, en = w & 3; LAS float* Of = (LAS float*)(lds + HL_OF);
#pragma unroll
                  for (int k = 0; k < 16; ++k) Of[(size_t)(32 * tm + (k & 3) + 8 * (k >> 2) + 4 * hh) * OFS + 32 * en + r] = o[k]; }
                hg_state_update(lds, S, w, lane);
                { const int en = w & 3;
#pragma unroll
                  for (int i = 0; i < 2; ++i) { const int dm = (w >> 2) * 2 + i;
#pragma unroll
                      for (int g = 0; g < 4; ++g) { nu2 wv; wv.x = pack_bf2(S[i][4 * g], S[i][4 * g + 1]); wv.y = pack_bf2(S[i][4 * g + 2], S[i][4 * g + 3]);
                          *(LAS nu2*)(lds + HL_ST + ((size_t)(32 * en + r) * QS + 32 * dm + 8 * g + 4 * hh) * 2) = wv; } } }
                __syncthreads();
                { const int u = tid >> 3, e0 = (tid & 7) * 16, tok = tokbase + dsg * u;
                  const LAS float* Of = (const LAS float*)(lds + HL_OF) + (size_t)u * OFS + e0;
                  bf16_t* dst = abuf_row(p, tok) + 512 + h * 128 + e0;
                  float v[16];
#pragma unroll
                  for (int j = 0; j < 4; ++j) { const nf4 t4 = *(const LAS nf4*)(Of + 4 * j); v[4 * j] = t4.x; v[4 * j + 1] = t4.y; v[4 * j + 2] = t4.z; v[4 * j + 3] = t4.w; }
                  if (dir == 0) {
                      uint4 w0, w1;
                      w0.x = pack_bf2(v[0], v[1]); w0.y = pack_bf2(v[2], v[3]); w0.z = pack_bf2(v[4], v[5]); w0.w = pack_bf2(v[6], v[7]);
                      w1.x = pack_bf2(v[8], v[9]); w1.y = pack_bf2(v[10], v[11]); w1.z = pack_bf2(v[12], v[13]); w1.w = pack_bf2(v[14], v[15]);
                      ((uint4*)dst)[0] = w0; ((uint4*)dst)[1] = w1;
                  } else {
                      const uint4 f0 = ((const uint4*)dst)[0], f1 = ((const uint4*)dst)[1];
                      const unsigned fw[8] = {f0.x, f0.y, f0.z, f0.w, f1.x, f1.y, f1.z, f1.w};
                      float ss = 0.f;
#pragma unroll
                      for (int j = 0; j < 8; ++j) { v[2 * j] += __uint_as_float(fw[j] << 16); v[2 * j + 1] += __uint_as_float(fw[j] & 0xffff0000u); ss += v[2 * j] * v[2 * j] + v[2 * j + 1] * v[2 * j + 1]; }
                      ss += __shfl_xor(ss, 1); ss += __shfl_xor(ss, 2); ss += __shfl_xor(ss, 4);
                      const float rn = rsqrtf(ss * (1.0f / 128.0f) + 1e-6f);
                      const bf16_t* gp = hg + (size_t)tok * 2560 + 2048 + h * 128 + e0;
                      const uint4 g0 = ((const uint4*)gp)[0], g1 = ((const uint4*)gp)[1];
                      const unsigned gw[8] = {g0.x, g0.y, g0.z, g0.w, g1.x, g1.y, g1.z, g1.w};
                      unsigned ow[8];
#pragma unroll
                      for (int j = 0; j < 8; ++j) { const float ga = silu_f(__uint_as_float(gw[j] << 16)), gb = silu_f(__uint_as_float(gw[j] & 0xffff0000u));
                          ow[j] = pack_bf2(v[2 * j] * rn * gain[h * 128 + e0 + 2 * j] * ga, v[2 * j + 1] * rn * gain[h * 128 + e0 + 2 * j + 1] * gb); }
                      ((uint4*)dst)[0] = make_uint4(ow[0], ow[1], ow[2], ow[3]); ((uint4*)dst)[1] = make_uint4(ow[4], ow[5], ow[6], ow[7]);
                  }
                }
                __syncthreads();
            }
        }
    }
}
#define XB_TMO      128
#define XB_XCNT(j)  (256  + 64 * (j))
#define XB_XSUB(j)  (1280 + 64 * (j))
#define XB_XGEN(j)  (2304 + 64 * (j))
#define XB_TOP      3328
#define XB_TOPGEN   3392
#define XCD_BAR_WORDS 3456
#define XB_SPIN_CAP (1u << 18)

__device__ __forceinline__ unsigned xb_ld(unsigned* p)              { return __hip_atomic_load(p, __ATOMIC_RELAXED, __HIP_MEMORY_SCOPE_AGENT); }
__device__ __forceinline__ unsigned xb_add(unsigned* p, unsigned v) { return __hip_atomic_fetch_add(p, v, __ATOMIC_RELAXED, __HIP_MEMORY_SCOPE_AGENT); }
__device__ __forceinline__ unsigned xb_xcc_id() { return (unsigned)__builtin_amdgcn_s_getreg((3 << 11) | 20) & 0xFu; }
#define XB_SPIN(cond, bar) do { unsigned _sp = 0; while (cond) { __builtin_amdgcn_s_sleep(1); \
    if ((++_sp & 255u) == 0u) { if (xb_ld(&(bar)[XB_TMO])) break; if (_sp > XB_SPIN_CAP) { atomicAdd(&(bar)[XB_TMO], 1u); break; } } } } while (0)

struct XcdBarrier {
    unsigned* bar; unsigned x;
    volatile LAS unsigned* st;
};

__device__ __forceinline__ XcdBarrier xcd_barrier_post(unsigned* bar, volatile LAS unsigned* st) {
    XcdBarrier b; b.bar = bar; b.x = xb_xcc_id(); b.st = st;
    if (TIDX == 0) (void)xb_add(&bar[XB_XCNT(b.x)], 1u);
    return b;
}
__device__ __forceinline__ void xcd_barrier_complete(unsigned* bar, unsigned x, unsigned& nloc, unsigned& nx) {
    const unsigned G = gridDim.x * gridDim.y * gridDim.z;
    unsigned sum, cnt, mine, sp = 0u;
    for (;;) {
        sum = 0u; cnt = 0u; mine = 0u;
#pragma unroll
        for (unsigned j = 0; j < 16; ++j) { const unsigned c = xb_ld(&bar[XB_XCNT(j)]); sum += c; cnt += (c > 0u) ? 1u : 0u; mine = (j == x) ? c : mine; }
        if (sum == G) break;
        __builtin_amdgcn_s_sleep(1);
        if ((++sp & 255u) == 0u) { if (xb_ld(&bar[XB_TMO])) break; if (sp > XB_SPIN_CAP) { atomicAdd(&bar[XB_TMO], 1u); break; } }
    }
    nloc = mine > 0u ? mine : 1u; nx = cnt > 0u ? cnt : 1u;
}

__device__ __forceinline__ void xcd_barrier(const XcdBarrier& b) {
    asm volatile("s_waitcnt vmcnt(0)" ::: "memory");
    __syncthreads();
    if (TIDX == 0) {
        unsigned* bar = b.bar;
        __builtin_amdgcn_s_waitcnt(0);
        unsigned nloc = b.st[0], nx = b.st[1];
        if (nloc == 0u) { xcd_barrier_complete(bar, b.x, nloc, nx); b.st[0] = nloc; b.st[1] = nx; }
        const unsigned old = xb_add(&bar[XB_XSUB(b.x)], 1u);
        const unsigned gen = old / nloc;
        if (old + 1u == (gen + 1u) * nloc) {
            __builtin_amdgcn_fence(__ATOMIC_RELEASE, "agent");
            asm volatile("s_waitcnt vmcnt(0)" ::: "memory");
            const unsigned og = xb_add(&bar[XB_TOP], 1u);
            const unsigned tg = og / nx;
            if (og + 1u == (tg + 1u) * nx) xb_add(&bar[XB_TOPGEN], 1u);
            else XB_SPIN(xb_ld(&bar[XB_TOPGEN]) == tg, bar);
            __builtin_amdgcn_fence(__ATOMIC_ACQUIRE, "agent");
            xb_add(&bar[XB_XGEN(b.x)], 1u);
            asm volatile("s_waitcnt vmcnt(0)" ::: "memory");
        } else {
            XB_SPIN(xb_ld(&bar[XB_XGEN(b.x)]) == gen, bar);
            __builtin_amdgcn_fence(__ATOMIC_ACQUIRE, "agent");
            asm volatile("s_waitcnt vmcnt(0)" ::: "memory");
        }
    }
    __syncthreads();
}

enum { PH_SETUP, PH_CONVERT, PH_RMS_IN, PH_GEMM_IN, PH_HY_PREP, PH_FILTER, PH_HGRN, PH_HG_NORM, PH_HY_FFT, PH_HY_NORM, PH_GEMM_OUT, PH_NR0, PH_GEMM_UP, PH_GEGLU, PH_GEMM_DN, PH_NR1, PH_HG_P1, PH_HG_P2, PH_HG_P3 };
template <int PH> __device__ __forceinline__ void run_phase(const P& p_in, int l, int part, LAS unsigned char* lds) {
    typedef __attribute__((address_space(1))) unsigned char* gptr_t; typedef __attribute__((address_space(1))) float* gfptr_t;
    gptr_t wsg = (gptr_t)p_in.ws; gfptr_t outg = (gfptr_t)p_in.out;
    asm volatile("" : "+s"(wsg), "+s"(outg));
    P p = p_in; p.ws = (unsigned char*)wsg; p.out = (float*)outg;
    if constexpr (PH == PH_SETUP) { ph_setup(p); ph_copy_params(p); }
    if constexpr (PH == PH_CONVERT) ph_convert_w(p, l, lds);
    if constexpr (PH == PH_RMS_IN) ph_rmsnorm_in(p, l);
    if constexpr (PH == PH_GEMM_IN) { EpiBf16Split E; E.O0 = (bf16_t*)(p.ws + OFF_HYRAW); E.ldc0 = 1536; E.O1 = (bf16_t*)(p.ws + OFF_HG); E.ldc1 = 2560; E.csplit = 1536;
        run_gemm(lds, abuf_row(p, 0), (const bf16_t*)(p.ws + OFF_W_IN), T_TOK, D_IN, DM, E); }
    if constexpr (PH == PH_HY_PREP) ph_hy_prep(p, l, lds);
    if constexpr (PH == PH_FILTER) ph_filter(p, l, lds);
    if constexpr (PH == PH_HY_FFT) ph_hy_fft(p, l, lds);
    if constexpr (PH == PH_HY_NORM) ph_hy_norm(p, l, lds);
    if constexpr (PH == PH_GEMM_OUT) { EpiBf16Split E; E.O0 = (bf16_t*)(p.ws + OFF_MIX); E.ldc0 = DM; E.O1 = E.O0; E.ldc1 = DM; E.csplit = 1 << 30;
        run_gemm(lds, abuf_row(p, 0), (const bf16_t*)(p.ws + OFF_W_OUT), T_TOK, DM, DM, E); }
    if constexpr (PH == PH_NR0) ph_norm_resid(p, l, 0);
    if constexpr (PH == PH_GEMM_UP) { EpiGeglu E; E.act = (bf16_t*)(p.ws + OFF_ACT); E.cw = PRM(p, ffn_conv_w) + (size_t)l * 3 * 8192; E.cb = PRM(p, ffn_conv_b) + (size_t)l * 8192;
        run_gemm(lds, abuf_row(p, -1), (const bf16_t*)(p.ws + OFF_W_UP), 133 * 256, 2 * DFF, DM, E); }
    if constexpr (PH == PH_GEMM_DN) { EpiBf16Split E; E.O0 = (bf16_t*)(p.ws + OFF_MIX); E.ldc0 = DM; E.O1 = E.O0; E.ldc1 = DM; E.csplit = 1 << 30;
        run_gemm(lds, (const bf16_t*)(p.ws + OFF_ACT), (const bf16_t*)(p.ws + OFF_W_DN), T_TOK, DM, DFF, E); }
    if constexpr (PH == PH_NR1) ph_norm_resid(p, l, 1);
    if constexpr (PH == PH_HG_P1) ph_hg_pass1(p, l, lds);
    if constexpr (PH == PH_HG_P2) ph_hg_pass2(p);
    if constexpr (PH == PH_HG_P3) ph_hg_pass3(p, l, lds);
}
constexpr int LDS_BYTES = 139264;
__global__ __launch_bounds__(512, 2) void mega(P p) {
    extern __shared__ __attribute__((aligned(16))) unsigned char lds_g[];
    LAS unsigned char* lds = (LAS unsigned char*)lds_g;
    cg::grid_group grid = cg::this_grid();
    volatile LAS unsigned* xst = (volatile LAS unsigned*)(lds + LDS_BYTES - 16);
    if (TIDX == 0) { xst[0] = 0u; xst[1] = 0u; }
    __syncthreads();
    const XcdBarrier xb = xcd_barrier_post((unsigned*)(p.ws + OFF_BAR), xst);
    run_phase<PH_SETUP>(p, 0, 0, lds);
    run_phase<PH_CONVERT>(p, 0, 0, lds);
    run_phase<PH_RMS_IN>(p, 0, 0, lds);
    grid.sync();
#pragma unroll 1
    for (int l = 0; l < NLAYER; ++l) {
        run_phase<PH_GEMM_IN>(p, l, 0, lds); xcd_barrier(xb);
        run_phase<PH_HY_PREP>(p, l, 0, lds); run_phase<PH_HG_P1>(p, l, 0, lds); xcd_barrier(xb);
        run_phase<PH_FILTER>(p, l, 0, lds); run_phase<PH_HG_P2>(p, l, 0, lds); xcd_barrier(xb);
        run_phase<PH_HG_P3>(p, l, 0, lds); run_phase<PH_HY_FFT>(p, l, 0, lds); xcd_barrier(xb);
        run_phase<PH_HY_NORM>(p, l, 0, lds); xcd_barrier(xb);
        run_phase<PH_GEMM_OUT>(p, l, 0, lds); xcd_barrier(xb);
        run_phase<PH_NR0>(p, l, 0, lds); xcd_barrier(xb);
        run_phase<PH_GEMM_UP>(p, l, 0, lds); xcd_barrier(xb);
        run_phase<PH_GEMM_DN>(p, l, 0, lds); xcd_barrier(xb);
        run_phase<PH_NR1>(p, l, 0, lds);
        if (l + 1 < NLAYER) { run_phase<PH_CONVERT>(p, l + 1, 0, lds); xcd_barrier(xb); }
    }
}
extern "C" void kernel_launch(void* const* d_in, const int* in_sizes, int n_in, void* d_out, int out_size, void* d_ws, size_t ws_size, hipStream_t stream) {
    if (ws_size < WS_NEED) { fprintf(stderr, "workspace too small: %zu < %zu\n", ws_size, (size_t)WS_NEED); return; }
    static int grid_blocks = 0;
    if (!grid_blocks) {
        hipFuncSetAttribute((const void*)mega, hipFuncAttributeMaxDynamicSharedMemorySize, LDS_BYTES);
        int dev = 0, cus = 0, per_cu = 0;
        hipGetDevice(&dev);
        hipDeviceGetAttribute(&cus, hipDeviceAttributeMultiprocessorCount, dev);
        hipOccupancyMaxActiveBlocksPerMultiprocessor(&per_cu, mega, 512, LDS_BYTES);
        if (per_cu > 1) per_cu = 1;
        grid_blocks = cus * per_cu;
    }
    P p{};
    for (int i = 0; i < 26; ++i) p.in[i] = (const float*)d_in[i];
    p.out = (float*)d_out; p.ws = (unsigned char*)d_ws;
    hipMemsetAsync((unsigned char*)d_ws + OFF_BAR, 0, XCD_BAR_WORDS * 4, stream);
    void* args[] = {&p};
    hipError_t e = hipLaunchCooperativeKernel((void*)mega, dim3(grid_blocks), dim3(512), args, LDS_BYTES, stream);
    if (e != hipSuccess) fprintf(stderr, "cooperative launch failed: %s (grid %d)\n", hipGetErrorString(e), grid_blocks);
}
```

```cpp
#include <hip/hip_runtime.h>
#include <hip/hip_cooperative_groups.h>
#include <cstdio>
#include <cstdint>
namespace cg = cooperative_groups;
__device__ __forceinline__ int tid_opaque() { int t = (int)threadIdx.x; asm volatile("" : "+v"(t)); return t; }
#define TIDX tid_opaque()
#define LAS __attribute__((address_space(3)))
typedef float cf2 __attribute__((ext_vector_type(2)));
typedef float nf4 __attribute__((ext_vector_type(4)));
typedef unsigned nu2 __attribute__((ext_vector_type(2)));
typedef unsigned nu4 __attribute__((ext_vector_type(4)));
#define LBAR() do { asm volatile("s_waitcnt lgkmcnt(0)" ::: "memory"); __builtin_amdgcn_s_barrier(); asm volatile("" ::: "memory"); } while (0)
namespace pg8 {
#define PG8_LAS __attribute__((address_space(3)))
typedef unsigned short bf16_t;
typedef short bf16x8 __attribute__((ext_vector_type(8)));
typedef float f32x4 __attribute__((ext_vector_type(4)));
typedef unsigned u32x4 __attribute__((ext_vector_type(4)));
constexpr int BM = 256, BK = 64, HALF = 128, HTB = HALF * BK * 2  , STAGE_BYTES = 8 * HTB, NXCD = 8, WGM = 8;

__host__ __device__ __forceinline__ int lds_byte(int r, int c) { const int st = (r >> 4) * 2 + (c >> 5), rr = r & 15, cc = c & 31, ob = rr * 64 + cc * 2; return st * 1024 + (ob ^ (((ob >> 9) & 1) << 5)); }
__host__ __device__ __forceinline__ void stage_rc(int b, int& R, int& C) { const int st = b / 1024, sb = b % 1024, swz = sb ^ (((sb >> 9) & 1) << 5); R = (st >> 1) * 16 + swz / 64; C = (st & 1) * 32 + (swz % 64) / 2; }
__host__ __device__ __forceinline__ int perm32(int rho) { const int n = rho >> 4, i = rho & 15; return 8 * (i >> 2) + 4 * n + (i & 3); }

struct Unit { int pm, pn; };
struct Gemm { const bf16_t* A; const bf16_t* Bt; int M, N, K; int ovl; };

struct StaticOrder {
    int nM, nN, nwg, G, c; int rev = 0;
    __host__ __device__ void init(int M, int N, int G_, int c_) { nM = M / BM; nN = N / BM; nwg = nM * nN; G = G_; c = c_; }
    __host__ __device__ bool next(int i, Unit& u) const {
        const long L = (long)i * G + c; if (L >= nwg) return false;
        int wgid = (int)L; { const int q = nwg / NXCD, r = nwg % NXCD, xcd = wgid % NXCD, off = wgid / NXCD; wgid = (xcd < r ? xcd * (q + 1) : r * (q + 1) + (xcd - r) * q) + off; }
        const int nig = WGM * nN, gid = wgid / nig, fm = gid * WGM, gsz = (nM - fm) < WGM ? (nM - fm) : WGM;
        u.pm = fm + ((wgid % nig) % gsz); u.pn = (wgid % nig) / gsz; if (rev) u.pm = nM - 1 - u.pm; return true;
    }
    __device__ __forceinline__ void a_ready(const Unit&) const {}
    __device__ __forceinline__ void done(const Unit&) const {}
};
struct CountedOrder : StaticOrder {
    const unsigned* ready; unsigned need; unsigned* tmo;
    __device__ __forceinline__ void a_ready(const Unit& u) const {
        if (TIDX < 64) {
            const unsigned long long t0 = __builtin_amdgcn_s_memrealtime(); unsigned polls = 0;
            while ((unsigned)__builtin_amdgcn_readfirstlane(__hip_atomic_load(ready + 64 * u.pm, __ATOMIC_RELAXED, __HIP_MEMORY_SCOPE_AGENT)) < need) {
                if ((++polls & 255u) == 0u && __builtin_amdgcn_readfirstlane(__hip_atomic_load(tmo, __ATOMIC_RELAXED, __HIP_MEMORY_SCOPE_AGENT)) != 0u) break;
                if (__builtin_amdgcn_s_memrealtime() - t0 > 2000000ull) {
                    if (TIDX == 0) { unsigned expect = 0u; __hip_atomic_compare_exchange_strong(tmo + 1, &expect, 0x600u | (unsigned)(u.pm & 0xff), __ATOMIC_RELAXED, __ATOMIC_RELAXED, __HIP_MEMORY_SCOPE_AGENT); __hip_atomic_store(tmo, 1u, __ATOMIC_RELAXED, __HIP_MEMORY_SCOPE_AGENT); }
                    break; }
                __builtin_amdgcn_s_sleep(2); }
            __builtin_amdgcn_fence(__ATOMIC_ACQUIRE, "agent");
            asm volatile("s_waitcnt vmcnt(0)" ::: "memory");
        }
#if !defined(BROKEN_HOOK_NO_BARRIER)
        asm volatile("" ::: "memory"); __builtin_amdgcn_s_barrier(); asm volatile("" ::: "memory");
#endif
    }
};

__device__ __forceinline__ unsigned cvt_pk_bf16(float lo, float hi) { unsigned r; asm volatile("v_cvt_pk_bf16_f32 %0, %1, %2" : "=v"(r) : "v"(lo), "v"(hi)); return r; }
typedef float f32x2 __attribute__((ext_vector_type(2)));
__device__ __forceinline__ f32x2 gelu_pk(f32x2 v) {
    const f32x2 av = __builtin_elementwise_abs(v), d = av * 0.2316418882f + 1.0f;
    f32x2 t; t.x = __builtin_amdgcn_rcpf(d.x); t.y = __builtin_amdgcn_rcpf(d.y);
    f32x2 q = t * 0.5307027145f + (-0.7265760135f); q = q * t + 0.7107068705f; q = q * t + (-0.142248368f); q = q * t + 0.127414796f; q = q * t;
    const f32x2 s = (v * v) * (-0.72134752044f);
    f32x2 e; e.x = __builtin_amdgcn_exp2f(s.x); e.y = __builtin_amdgcn_exp2f(s.y);
    const f32x2 m = v * (q * e), r = v - m;
    f32x2 o; o.x = v.x < 0.f ? m.x : r.x; o.y = v.y < 0.f ? m.y : r.y; return o;
}

struct EpiF32 {
    static constexpr bool PERM = false, AFTER_DRAIN = false;
    float* C; int ldc; const float* bias;
    __device__ __forceinline__ void operator()(const f32x4 (&acc)[2][2][4][2], const Unit& u, int wr, int wc, int fr, int fq) const {
        const int row0 = u.pm * BM + wr * 64 + fr, col0 = u.pn * BM + wc * 32 + 4 * fq;
        f32x4 bv[2][2];
#pragma unroll
        for (int bj = 0; bj < 2; ++bj)
#pragma unroll
            for (int n = 0; n < 2; ++n) bv[bj][n] = bias ? *(const f32x4*)(bias + col0 + bj * HALF + n * 16) : (f32x4){0.f, 0.f, 0.f, 0.f};
#pragma unroll
        for (int ai = 0; ai < 2; ++ai)
#pragma unroll
            for (int m = 0; m < 4; ++m) { float* rowp = C + (size_t)(row0 + ai * HALF + m * 16) * ldc + col0;
#pragma unroll
                for (int bj = 0; bj < 2; ++bj)
#pragma unroll
                    for (int n = 0; n < 2; ++n) *(f32x4*)(rowp + bj * HALF + n * 16) = acc[ai][bj][m][n] + bv[bj][n]; }
    }
};
template <int ACT  > struct EpiBf16 {
    static constexpr bool PERM = true, AFTER_DRAIN = false;
    bf16_t* O; int ldc; const float* bias; int split_cols; size_t split_stride;
    __device__ __forceinline__ void operator()(const f32x4 (&acc)[2][2][4][2], const Unit& u, int wr, int wc, int fr, int fq) const {
        const int row0 = u.pm * BM + wr * 64 + fr; int colt = u.pn * BM; bf16_t* base = O;
        if (split_cols) { const int t = colt / split_cols; base += (size_t)t * split_stride; colt -= t * split_cols; }
        const int col0 = colt + wc * 32 + 8 * fq, bcol0 = u.pn * BM + wc * 32 + 8 * fq;
        f32x4 bv[2][2];
#pragma unroll
        for (int bj = 0; bj < 2; ++bj)
#pragma unroll
            for (int n = 0; n < 2; ++n) bv[bj][n] = bias ? *(const f32x4*)(bias + bcol0 + bj * HALF + 4 * n) : (f32x4){0.f, 0.f, 0.f, 0.f};
#pragma unroll
        for (int ai = 0; ai < 2; ++ai)
#pragma unroll
            for (int m = 0; m < 4; ++m) { bf16_t* rowp = base + (size_t)(row0 + ai * HALF + m * 16) * ldc + col0;
#pragma unroll
                for (int bj = 0; bj < 2; ++bj) { f32x4 v0 = acc[ai][bj][m][0] + bv[bj][0], v1 = acc[ai][bj][m][1] + bv[bj][1];
                    if (ACT == 1) { f32x2 a = gelu_pk((f32x2){v0[0], v0[1]}), b = gelu_pk((f32x2){v0[2], v0[3]}), c = gelu_pk((f32x2){v1[0], v1[1]}), d = gelu_pk((f32x2){v1[2], v1[3]});
                        v0 = (f32x4){a.x, a.y, b.x, b.y}; v1 = (f32x4){c.x, c.y, d.x, d.y}; }
                    if (ACT == 2) {
#pragma unroll
                        for (int j = 0; j < 4; ++j) { v0[j] = 0.5f * v0[j] * (1.0f + erff(v0[j] * 0.70710678f)); v1[j] = 0.5f * v1[j] * (1.0f + erff(v1[j] * 0.70710678f)); } }
                    u32x4 w; w.x = cvt_pk_bf16(v0[0], v0[1]); w.y = cvt_pk_bf16(v0[2], v0[3]); w.z = cvt_pk_bf16(v1[0], v1[1]); w.w = cvt_pk_bf16(v1[2], v1[3]);
                    *(u32x4*)(rowp + bj * HALF) = w; } }
    }
};
template <class Epi, class Sched, bool STAMP = false>
__device__ __forceinline__ void gemm_phase(PG8_LAS unsigned char* lds, const Gemm g, const Sched& S, const Epi& E, unsigned long long* stamps) {
    const int tid = TIDX, wid = __builtin_amdgcn_readfirstlane(tid >> 6), lane = tid & 63, wr = wid >> 2, wc = wid & 3, fr = lane & 15, fq = lane >> 4;
    const int K = g.K, nt = K / BK;
    int ts_lo = 0, ts_hi = 0, nts = 0; const unsigned long long rt_entry = STAMP ? (unsigned long long)wall_clock64() : 0ull;
#define PG8_STAMP() do { if (STAMP && wid == 0 && nts < 64) { const unsigned long long _c = (unsigned long long)clock64(); \
        ts_lo = (lane == nts) ? (int)(unsigned)_c : ts_lo; ts_hi = (lane == nts) ? (int)(unsigned)(_c >> 32) : ts_hi; ++nts; } } while (0)
    PG8_STAMP();
    unsigned voffA[2], voffB[2];
#pragma unroll
    for (int i = 0; i < 2; ++i) { int R, C; stage_rc(tid * 16 + i * 8192, R, C); const int Rb = Epi::PERM ? ((R & ~31) + perm32(R & 31)) : R;
        const int Ra = g.ovl ? R - 2 * (R >> 6) : R; voffA[i] = (unsigned)(Ra * K + C) * 2u; voffB[i] = (unsigned)(Rb * K + C) * 2u; }
    const size_t kstep = (size_t)(BK * 2);
    const size_t hstep = (size_t)HALF * K * 2;
    const size_t tstep = 2 * hstep;
    const size_t hstepA = g.ovl ? (size_t)124 * K * 2 : hstep, tstepA = g.ovl ? (size_t)248 * K * 2 : tstep;
    const unsigned ldsw = (unsigned)wid * 1024u;
    const int aoff = lds_byte(wr * 64 + fr, fq * 8), boff = lds_byte(wc * 32 + fr, fq * 8);
#define PG8_SA(b, h) (((b) * 2 + (h)) * HTB)
#define PG8_SB(b, h) ((4 + (b) * 2 + (h)) * HTB)
#define PG8_STAGE(bufoff, gbase, voff) do { _Pragma("unroll") for (int _i = 0; _i < 2; ++_i) \
        __builtin_amdgcn_global_load_lds((const unsigned*)((const char*)(gbase) + (voff)[_i]), (PG8_LAS unsigned*)(lds + (bufoff) + ldsw + _i * 8192), 16, 0, 0); } while (0)
#define PG8_LDA(dst, b, h) do { _Pragma("unroll") for (int m = 0; m < 4; ++m) _Pragma("unroll") for (int k = 0; k < 2; ++k) dst[m][k] = *(const PG8_LAS bf16x8*)(lds + PG8_SA(b, h) + aoff + m * 2048 + k * 1024); } while (0)
#define PG8_LDB(dst, b, h) do { _Pragma("unroll") for (int n = 0; n < 2; ++n) _Pragma("unroll") for (int k = 0; k < 2; ++k) dst[n][k] = *(const PG8_LAS bf16x8*)(lds + PG8_SB(b, h) + boff + n * 2048 + k * 1024); } while (0)
#define PG8_MMA(ai, bj, At, Bt) do { __builtin_amdgcn_s_setprio(1); _Pragma("unroll") for (int m = 0; m < 4; ++m) _Pragma("unroll") for (int n = 0; n < 2; ++n) _Pragma("unroll") for (int k = 0; k < 2; ++k) \
        acc[ai][bj][m][n] = __builtin_amdgcn_mfma_f32_16x16x32_bf16(Bt[n][k], At[m][k], acc[ai][bj][m][n], 0, 0, 0); __builtin_amdgcn_s_setprio(0); } while (0)
#define PG8_WAIT_V(n) asm volatile("s_waitcnt vmcnt(" #n ")" ::: "memory")
#define PG8_WAIT_L(n) asm volatile("s_waitcnt lgkmcnt(" #n ")" ::: "memory")
#define PG8_BAR __builtin_amdgcn_s_barrier()
#define PG8_SCHED __builtin_amdgcn_sched_barrier(0)
    Unit cur, nxt; int ui = 0;
    if (!S.next(0, cur)) return;
    f32x4 acc[2][2][4][2];
#pragma unroll
    for (int a = 0; a < 2; ++a)
#pragma unroll
        for (int b = 0; b < 2; ++b)
#pragma unroll
            for (int m = 0; m < 4; ++m)
#pragma unroll
                for (int n = 0; n < 2; ++n) acc[a][b][m][n] = (f32x4){0.f, 0.f, 0.f, 0.f};
    bf16x8 At[4][2], B0[2][2], B1[2][2];
    const char* cA = (const char*)g.A + (size_t)cur.pm * tstepA; const char* cB = (const char*)g.Bt + (size_t)cur.pn * tstep;
    S.a_ready(cur);
    PG8_STAGE(PG8_SB(0, 0), cB, voffB); PG8_STAGE(PG8_SA(0, 0), cA, voffA); PG8_STAGE(PG8_SB(0, 1), cB + hstep, voffB); PG8_STAGE(PG8_SA(0, 1), cA + hstepA, voffA);
    if (wr == 1) PG8_BAR;
    PG8_WAIT_V(4); PG8_BAR;
    PG8_STAGE(PG8_SB(1, 0), cB + kstep, voffB); PG8_STAGE(PG8_SA(1, 0), cA + kstep, voffA); PG8_STAGE(PG8_SB(1, 1), cB + hstep + kstep, voffB);
    PG8_WAIT_V(6); PG8_BAR;
    PG8_STAMP();
    for (;;) {
        const bool has_next = S.next(ui + 1, nxt);
        const char* nA = has_next ? (const char*)g.A + (size_t)nxt.pm * tstepA : cA; const char* nB = has_next ? (const char*)g.Bt + (size_t)nxt.pn * tstep : cB;
        for (int t = 0; t < nt; t += 2) {
            const bool last = (t == nt - 2);
            const char* a1 = cA + (size_t)(t + 1) * kstep;
            const char* a2 = last ? nA : cA + (size_t)(t + 2) * kstep; const char* b2 = last ? nB : cB + (size_t)(t + 2) * kstep;
            const char* a3 = a2 + kstep; const char* b3 = b2 + kstep;
            if (last && has_next) S.a_ready(nxt);
            PG8_LDB(B0, 0, 0); PG8_SCHED; PG8_LDA(At, 0, 0); PG8_STAGE(PG8_SA(1, 1), a1 + hstepA, voffA);
            PG8_WAIT_L(8); PG8_BAR; PG8_WAIT_L(0); PG8_MMA(0, 0, At, B0); PG8_BAR; PG8_SCHED;
            PG8_LDB(B1, 0, 1); PG8_STAGE(PG8_SB(0, 0), b2, voffB);
            PG8_BAR; PG8_WAIT_L(0); PG8_MMA(0, 1, At, B1); PG8_BAR;
            PG8_LDA(At, 0, 1); PG8_STAGE(PG8_SA(0, 0), a2, voffA);
            PG8_BAR; PG8_WAIT_L(0); PG8_MMA(1, 0, At, B0); PG8_BAR; PG8_SCHED;
            PG8_STAGE(PG8_SB(0, 1), b2 + hstep, voffB);
            PG8_WAIT_V(6); PG8_BAR; PG8_MMA(1, 1, At, B1); PG8_BAR;
            PG8_LDB(B0, 1, 0); PG8_SCHED; PG8_LDA(At, 1, 0); PG8_STAGE(PG8_SA(0, 1), a2 + hstepA, voffA);
            PG8_WAIT_L(8); PG8_BAR; PG8_WAIT_L(0); PG8_MMA(0, 0, At, B0); PG8_BAR; PG8_SCHED;
            PG8_LDB(B1, 1, 1); PG8_STAGE(PG8_SB(1, 0), b3, voffB);
            PG8_BAR; PG8_WAIT_L(0); PG8_MMA(0, 1, At, B1); PG8_BAR;
            PG8_LDA(At, 1, 1); PG8_STAGE(PG8_SA(1, 0), a3, voffA);
            PG8_BAR; PG8_WAIT_L(0); PG8_MMA(1, 0, At, B0); PG8_BAR; PG8_SCHED;
            PG8_STAGE(PG8_SB(1, 1), b3 + hstep, voffB);
            PG8_WAIT_V(6); PG8_BAR; PG8_MMA(1, 1, At, B1); PG8_BAR;
        }
        PG8_STAMP();
        if constexpr (!Epi::AFTER_DRAIN) { E(acc, cur, wr, wc, fr, fq); S.done(cur); }
        PG8_STAMP();
        if (!has_next) break;
#pragma unroll
        for (int a = 0; a < 2; ++a)
#pragma unroll
            for (int b = 0; b < 2; ++b)
#pragma unroll
                for (int m = 0; m < 4; ++m)
#pragma unroll
                    for (int n = 0; n < 2; ++n) acc[a][b][m][n] = (f32x4){0.f, 0.f, 0.f, 0.f};
        cur = nxt; cA = nA; cB = nB; ++ui;
    }
    PG8_WAIT_V(0);
    if (wr == 0) PG8_BAR;
    PG8_BAR;
    if constexpr (Epi::AFTER_DRAIN) { E.fused(acc, cur, wr, wc, fr, fq, lds, wid, lane); S.done(cur); }
    PG8_STAMP();
    if (STAMP && wid == 0) { stamps[lane] = lane < nts ? (((unsigned long long)(unsigned)ts_hi << 32) | (unsigned)ts_lo) : 0ull;
        if (lane == 62) stamps[62] = rt_entry; if (lane == 63) stamps[63] = (unsigned long long)wall_clock64(); }
#undef PG8_STAMP
#undef PG8_SA
#undef PG8_SB
#undef PG8_STAGE
#undef PG8_LDA
#undef PG8_LDB
#undef PG8_MMA
#undef PG8_WAIT_V
#undef PG8_WAIT_L
#undef PG8_BAR
#undef PG8_SCHED
}
}
typedef unsigned short bf16_t;
constexpr int T_TOK = 32768, DM = 1024, D_IN = 4096, D_HY = 512, D_HG = 512, DFF = 4096, NLAYER = 4;
constexpr int L_BIG = 16384, L_SML = 4096;
constexpr int APAD = 256;
constexpr size_t MiB = 1024ull * 1024ull;
constexpr size_t OFF_W = 0;
constexpr size_t OFF_W_IN = OFF_W, OFF_W_OUT = OFF_W + 8 * MiB, OFF_W_UP = OFF_W + 10 * MiB, OFF_W_DN = OFF_W + 26 * MiB;
constexpr size_t OFF_ABUF = 34 * MiB;
constexpr size_t OFF_R1 = 99 * MiB;
constexpr size_t OFF_HYRAW = OFF_R1;
constexpr size_t OFF_HG = OFF_R1 + 96 * MiB;
constexpr size_t OFF_KT = OFF_R1;
constexpr size_t OFF_ACT = OFF_R1;
constexpr size_t OFF_R2 = 355 * MiB;
constexpr size_t OFF_X0T = OFF_R2, OFF_ZT = OFF_R2 + 32 * MiB;
constexpr size_t OFF_MIX = OFF_R2;
constexpr size_t OFF_UPART = OFF_R2;
constexpr size_t OFF_R6 = 419 * MiB;
constexpr size_t OFF_OBUF = OFF_R6;
constexpr size_t OFF_KS = OFF_R6;
constexpr size_t OFF_SMALL = 483 * MiB;
constexpr size_t OFF_BAR = OFF_SMALL + 4 * MiB;
constexpr size_t OFF_W4T = OFF_SMALL + 8 * MiB;
constexpr size_t WS_NEED = 502 * MiB;

struct P { const float* in[26]; float* out; unsigned char* ws; };
constexpr int PB_norm_mix_pre = 0;
constexpr int PB_norm_mix_post = 4096;
constexpr int PB_norm_ffn_pre = 8192;
constexpr int PB_norm_ffn_post = 12288;
constexpr int PB_hy_conv_w = 16384;
constexpr int PB_hy_conv_b = 34816;
constexpr int PB_f_w1 = 40960;
constexpr int PB_f_b1 = 49408;
constexpr int PB_f_w2 = 49664;
constexpr int PB_f_b2 = 66048;
constexpr int PB_f_w3 = 66304;
constexpr int PB_f_b3 = 82688;
constexpr int PB_f_w4 = 82944;
constexpr int PB_f_freq = 345088;
constexpr int PB_hy_skip = 345344;
constexpr int PB_hy_out_norm = 347392;
constexpr int PB_lb_table = 349440;
constexpr int PB_hg_out_norm = 353536;
constexpr int PB_ffn_conv_w = 355584;
constexpr int PB_ffn_conv_b = 453888;
constexpr int PB_TOTAL = 486656;
constexpr size_t OFF_PB = OFF_SMALL + 512 * 1024;
#define PRM(p, NAME) ((const float*)((p).ws + OFF_PB) + PB_##NAME)

__device__ __forceinline__ float bf2f(bf16_t b) { return __uint_as_float(((unsigned)b) << 16); }
__device__ __forceinline__ bf16_t f2bf(float f) { unsigned u = __float_as_uint(f); u += 0x7FFFu + ((u >> 16) & 1u); return (bf16_t)(u >> 16); }
__device__ __forceinline__ unsigned pack_bf2(float lo, float hi) { return (unsigned)f2bf(lo) | ((unsigned)f2bf(hi) << 16); }
__device__ __forceinline__ unsigned pack_bf2_hw(float lo, float hi) { unsigned r; asm("v_cvt_pk_bf16_f32 %0, %1, %2" : "=v"(r) : "v"(lo), "v"(hi)); return r; }
__device__ __forceinline__ bool seq_start(int t) { return t < L_BIG ? (t == 0) : ((t & (L_SML - 1)) == 0); }
__device__ __forceinline__ bool seq_end(int t) { return (t + 1 == T_TOK) || seq_start(t + 1); }
__device__ __forceinline__ const float* x_src_row(const P& p, int l, int t) {
    if (l > 0) return p.out + (size_t)t * DM;
    return t < L_BIG ? p.in[0] + (size_t)t * DM : p.in[1] + (size_t)(t - L_BIG) * DM;
}
__device__ __forceinline__ float silu_f(float x) { return x / (1.0f + __expf(-x)); }
__device__ __forceinline__ float wave_sum(float v) {
#pragma unroll
    for (int o = 32; o >= 1; o >>= 1) v += __shfl_xor(v, o);
    return v;
}

struct EpiBf16Split {
    static constexpr bool PERM = true, AFTER_DRAIN = false, OVL = false;
    bf16_t* O0; int ldc0; bf16_t* O1; int ldc1; int csplit;
    int silu_lo0, silu_hi0, silu_lo1, silu_hi1;
    __device__ __forceinline__ void operator()(const pg8::f32x4 (&acc)[2][2][4][2], const pg8::Unit& u, int wr, int wc, int fr, int fq) const {
        const int row0 = u.pm * pg8::BM + wr * 64 + fr; int colt = u.pn * pg8::BM; bf16_t* base = O0; int ldc = ldc0;
        const bool act = (colt >= silu_lo0 && colt < silu_hi0) || (colt >= silu_lo1 && colt < silu_hi1);
        if (colt >= csplit) { base = O1; ldc = ldc1; colt -= csplit; }
        const int col0 = colt + wc * 32 + 8 * fq;
#pragma unroll
        for (int ai = 0; ai < 2; ++ai)
#pragma unroll
            for (int m = 0; m < 4; ++m) { bf16_t* rowp = base + (size_t)(row0 + ai * pg8::HALF + m * 16) * ldc + col0;
#pragma unroll
                for (int bj = 0; bj < 2; ++bj) { pg8::f32x4 v0 = acc[ai][bj][m][0], v1 = acc[ai][bj][m][1];
                    if (act) {
#pragma unroll
                        for (int i = 0; i < 4; ++i) { v0[i] = v0[i] * __builtin_amdgcn_rcpf(1.0f + __builtin_amdgcn_exp2f(-1.4426950408889634f * v0[i])); v1[i] = v1[i] * __builtin_amdgcn_rcpf(1.0f + __builtin_amdgcn_exp2f(-1.4426950408889634f * v1[i])); } }
                    pg8::u32x4 w; w.x = pg8::cvt_pk_bf16(v0[0], v0[1]); w.y = pg8::cvt_pk_bf16(v0[2], v0[3]); w.z = pg8::cvt_pk_bf16(v1[0], v1[1]); w.w = pg8::cvt_pk_bf16(v1[2], v1[3]);
                    *(pg8::u32x4*)(rowp + bj * pg8::HALF) = w; } }
    }
};
__device__ __forceinline__ float dpp_ror1(float v) { return __int_as_float(__builtin_amdgcn_mov_dpp(__float_as_int(v), 0x121, 0xF, 0xF, true)); }
__device__ __forceinline__ float dpp_ror15(float v) { return __int_as_float(__builtin_amdgcn_mov_dpp(__float_as_int(v), 0x12F, 0xF, 0xF, true)); }
__device__ __forceinline__ float gelu_tanh_e(float x) { const float y = 1.5957691216057308f * (x + 0.044715f * x * x * x); return x * __builtin_amdgcn_rcpf(1.0f + __expf(-y)); }
struct EpiGeglu {
    static constexpr bool PERM = true, AFTER_DRAIN = false, OVL = true;
    bf16_t* act; const float* cw; const float* cb;
    template <bool MASK> __device__ __forceinline__ void run(const pg8::f32x4 (&acc)[2][2][4][2], const pg8::Unit& u, int wr, int wc, int fr, int fq, unsigned mprev, unsigned mnext, unsigned mst) const {
        const int j0 = u.pn * 128 + wc * 32 + 8 * fq;
#pragma unroll
        for (int n = 0; n < 2; ++n) {
            const int jc = j0 + 4 * n;
            const pg8::f32x4 wa0 = *(const pg8::f32x4*)(cw + jc), wa1 = *(const pg8::f32x4*)(cw + 8192 + jc), wa2 = *(const pg8::f32x4*)(cw + 16384 + jc), ba = *(const pg8::f32x4*)(cb + jc);
            const pg8::f32x4 wb0 = *(const pg8::f32x4*)(cw + 4096 + jc), wb1 = *(const pg8::f32x4*)(cw + 8192 + 4096 + jc), wb2 = *(const pg8::f32x4*)(cw + 16384 + 4096 + jc), bb = *(const pg8::f32x4*)(cb + 4096 + jc);
#pragma unroll
            for (int ai = 0; ai < 2; ++ai) {
                pg8::f32x4 pa_prev, pb_prev, na_cur, nb_cur;
#pragma unroll
                for (int i = 0; i < 4; ++i) { na_cur[i] = dpp_ror15(acc[ai][0][0][n][i]); nb_cur[i] = dpp_ror15(acc[ai][1][0][n][i]); pa_prev[i] = 0.f; pb_prev[i] = 0.f; }
#pragma unroll
                for (int m = 0; m < 4; ++m) {
                    const int b = ai * 4 + m, q = 16 * m + fr, tok = u.pm * 248 + 124 * ai + 62 * wr + q - 1;
                    const bool hp = (mprev >> b) & 1u, hn = (mnext >> b) & 1u;
                    pg8::f32x4 pa_cur, pb_cur, na_next, nb_next;
#pragma unroll
                    for (int i = 0; i < 4; ++i) { pa_cur[i] = dpp_ror1(acc[ai][0][m][n][i]); pb_cur[i] = dpp_ror1(acc[ai][1][m][n][i]);
                        na_next[i] = m < 3 ? dpp_ror15(acc[ai][0][m < 3 ? m + 1 : 3][n][i]) : 0.f; nb_next[i] = m < 3 ? dpp_ror15(acc[ai][1][m < 3 ? m + 1 : 3][n][i]) : 0.f; }
                    const pg8::f32x4 xpa = (fr == 0) ? pa_prev : pa_cur, xna = (fr == 15) ? na_next : na_cur;
                    const pg8::f32x4 xpb = (fr == 0) ? pb_prev : pb_cur, xnb = (fr == 15) ? nb_next : nb_cur;
                    const pg8::f32x4 xa = acc[ai][0][m][n], xb = acc[ai][1][m][n];
                    float o[4];
#pragma unroll
                    for (int h2 = 0; h2 < 2; ++h2) {
                        typedef float f2v __attribute__((ext_vector_type(2)));
                        const f2v zero2 = (f2v){0.f, 0.f};
                        const f2v w0a = (!MASK || hp) ? (h2 ? wa0.zw : wa0.xy) : zero2, w2a = (!MASK || hn) ? (h2 ? wa2.zw : wa2.xy) : zero2;
                        const f2v w0b = (!MASK || hp) ? (h2 ? wb0.zw : wb0.xy) : zero2, w2b = (!MASK || hn) ? (h2 ? wb2.zw : wb2.xy) : zero2;
                        const f2v ya = __builtin_elementwise_fma(h2 ? xpa.zw : xpa.xy, w0a, __builtin_elementwise_fma(h2 ? xa.zw : xa.xy, h2 ? wa1.zw : wa1.xy, __builtin_elementwise_fma(h2 ? xna.zw : xna.xy, w2a, h2 ? ba.zw : ba.xy)));
                        const f2v yb = __builtin_elementwise_fma(h2 ? xpb.zw : xpb.xy, w0b, __builtin_elementwise_fma(h2 ? xb.zw : xb.xy, h2 ? wb1.zw : wb1.xy, __builtin_elementwise_fma(h2 ? xnb.zw : xnb.xy, w2b, h2 ? bb.zw : bb.xy)));
                        const f2v pz = ya * __builtin_elementwise_fma(ya * ya, (f2v){-0.10294324f, -0.10294324f}, (f2v){-2.3022082f, -2.3022082f});
                        f2v rc; rc.x = __builtin_amdgcn_rcpf(1.0f + __builtin_amdgcn_exp2f(pz.x)); rc.y = __builtin_amdgcn_rcpf(1.0f + __builtin_amdgcn_exp2f(pz.y));
                        const f2v o2 = ya * yb * rc;
                        o[2 * h2] = o2.x; o[2 * h2 + 1] = o2.y;
                    }
                    if (MASK ? ((mst >> b) & 1u) != 0u : (q >= 1 && q <= 62)) { uint2 w; w.x = pg8::cvt_pk_bf16(o[0], o[1]); w.y = pg8::cvt_pk_bf16(o[2], o[3]); *(uint2*)(act + (size_t)tok * DFF + jc) = w; }
                    pa_prev = pa_cur; pb_prev = pb_cur; na_cur = na_next; nb_cur = nb_next;
                }
            }
        }
    }
    __device__ __forceinline__ void operator()(const pg8::f32x4 (&acc)[2][2][4][2], const pg8::Unit& u, int wr, int wc, int fr, int fq) const {
        const int j0 = u.pn * 128 + wc * 32 + 8 * fq;
        unsigned mprev = 0, mnext = 0, mst = 0;
#pragma unroll
        for (int ai = 0; ai < 2; ++ai)
#pragma unroll
            for (int m = 0; m < 4; ++m) { const int q = 16 * m + fr, tok = u.pm * 248 + 124 * ai + 62 * wr + q - 1, b = ai * 4 + m;
                const bool st = q >= 1 && q <= 62 && tok < T_TOK;
                if (st) { mst |= 1u << b; if (!seq_start(tok)) mprev |= 1u << b; if (!seq_end(tok)) mnext |= 1u << b; } }
        run<true>(acc, u, wr, wc, fr, fq, mprev, mnext, mst);
    }
};
template <class Epi>
__device__ __forceinline__ void run_gemm(LAS unsigned char* lds, const bf16_t* A, const bf16_t* Bt, int M, int N, int K, const Epi& E, int rev = 0) {
    pg8::Gemm g; g.A = A; g.Bt = Bt; g.M = M; g.N = N; g.K = K; g.ovl = Epi::OVL ? 1 : 0;
    int gx = (int)gridDim.x, bx = (int)blockIdx.x; asm volatile("" : "+s"(gx), "+s"(bx));
    pg8::StaticOrder S; S.init(M, N, gx, bx); S.rev = rev;
    pg8::gemm_phase<Epi, pg8::StaticOrder, false>((PG8_LAS unsigned char*)lds, g, S, E, nullptr);
}

#define HD_INLINE __device__ __forceinline__
#define DEV_FN __device__ __forceinline__
#define LDS_F2 LAS cf2*
#define FFT_ASM_CMUL 1
#define NTHR 512
#define PADI(i) ((i) + ((i) >> 5))
#define FOR_TID for (int tid = (int)TIDX, once_ = 1; once_; once_ = 0)
#define SYNC __syncthreads()
#define BREV32(x) __brev(x)
#define CIS_REV(fr, c, s) do { const float f_ = (fr); c = __builtin_amdgcn_cosf(f_); s = __builtin_amdgcn_sinf(f_); } while (0)
HD_INLINE unsigned rev4(unsigned k, int S) {
    unsigned v = BREV32(k) >> (32 - 2 * S);
    return ((v & 0xAAAAAAAAu) >> 1) | ((v & 0x55555555u) << 1);
}
HD_INLINE cf2 mkf2(float a, float b) { cf2 r; r.x = a; r.y = b; return r; }
#ifdef FFT_ASM_CMUL
HD_INLINE cf2 cmul(cf2 a, cf2 b) {
    cf2 t, d;
    asm("v_pk_mul_f32 %0, %1, %2 op_sel:[0,0] op_sel_hi:[0,1]" : "=v"(t) : "v"(a), "v"(b));
    asm("v_pk_fma_f32 %0, %1, %2, %3 op_sel:[1,1,0] op_sel_hi:[1,0,1] neg_lo:[1,0,0]" : "=v"(d) : "v"(a), "v"(b), "v"(t));
    return d;
}
HD_INLINE cf2 cmul_g(cf2 a, cf2 b) {
    cf2 t, d;
    asm("s_nop 1\n\tv_pk_mul_f32 %0, %1, %2 op_sel:[0,0] op_sel_hi:[0,1]" : "=v"(t) : "v"(a), "v"(b));
    asm("v_pk_fma_f32 %0, %1, %2, %3 op_sel:[1,1,0] op_sel_hi:[1,0,1] neg_lo:[1,0,0]" : "=v"(d) : "v"(a), "v"(b), "v"(t));
    return d;
}
HD_INLINE cf2 cmulc_g(cf2 a, cf2 b) {
    cf2 t, d;
    asm("s_nop 1\n\tv_pk_mul_f32 %0, %1, %2 op_sel:[0,0] op_sel_hi:[0,1] neg_hi:[0,1]" : "=v"(t) : "v"(a), "v"(b));
    asm("v_pk_fma_f32 %0, %1, %2, %3 op_sel:[1,1,0] op_sel_hi:[1,0,1]" : "=v"(d) : "v"(a), "v"(b), "v"(t));
    return d;
}
#define cmulc cmulc_g
#else
HD_INLINE cf2 cmul(cf2 a, cf2 b) { return mkf2(a.x * b.x - a.y * b.y, a.x * b.y + a.y * b.x); }
HD_INLINE cf2 cmulc(cf2 a, cf2 b) { return mkf2(a.x * b.x + a.y * b.y, a.y * b.x - a.x * b.y); }
#define cmul_g cmul
#endif

HD_INLINE void bf4_fwd(cf2& a0, cf2& a1, cf2& a2, cf2& a3) {
    const cf2 t0 = a0 + a2, t1 = a0 - a2, t2 = a1 + a3, d = a1 - a3; const cf2 t3 = mkf2(d.y, -d.x);
    a0 = t0 + t2; a1 = t1 + t3; a2 = t0 - t2; a3 = t1 - t3;
}
HD_INLINE void bf4_inv(cf2& b0, cf2& b1, cf2& b2, cf2& b3) {
    const cf2 t0 = b0 + b2, t1 = b0 - b2, t2 = b1 + b3, d = b1 - b3; const cf2 t3 = mkf2(-d.y, d.x);
    b0 = t0 + t2; b1 = t1 + t3; b2 = t0 - t2; b3 = t1 - t3;
}
#define W16C(k) ((k) == 0 ? 1.0f : (k) == 1 ? 0.9238795325112867f : (k) == 2 ? 0.7071067811865476f : (k) == 3 ? 0.3826834323650898f : (k) == 4 ? 0.0f : (k) == 6 ? -0.7071067811865476f :   -0.9238795325112867f)
#define W16S(k) ((k) == 0 ? 0.0f : (k) == 1 ? 0.3826834323650898f : (k) == 2 ? 0.7071067811865476f : (k) == 3 ? 0.9238795325112867f : (k) == 4 ? 1.0f : (k) == 6 ? 0.7071067811865476f :   -0.3826834323650898f)
template <int S, int NSEQ, bool ZIN = false>
DEV_FN void fft_fwd2(LDS_F2 X) {
    constexpr int M = 1 << (2 * S), MP = M + (M >> 5), NG = NSEQ * (M >> 4);
#pragma unroll 1
    for (int pr = 0; pr < S / 2; ++pr) {
        const int s = 2 * pr, n = M >> (2 * s), q = n >> 2, q2 = q >> 2;
        const bool lin = (q2 & 31) == 0; const int sq = q + (q >> 5), sq2 = q2 + (q2 >> 5);
        const float invn = 1.0f / (float)n;
        FOR_TID {
#pragma unroll 2
            for (int gi = tid; gi < NG; gi += NTHR) {
                const int seq = gi / (M >> 4), g = gi - seq * (M >> 4), j2 = g & (q2 - 1), base = ((g - j2) << 4) + j2;
                LDS_F2 Xs = X + seq * MP;
                cf2 a[4][4];
                const int pb = lin ? PADI(base) : base;
#define FIDX(r, r2) (lin ? pb + (r) * sq + (r2) * sq2 : PADI(base + (r) * q + (r2) * q2))
#pragma unroll
                for (int r = 0; r < 4; ++r)
#pragma unroll
                    for (int r2 = 0; r2 < 4; ++r2) a[r][r2] = (ZIN && pr == 0 && r >= 2) ? mkf2(0.f, 0.f) : Xs[FIDX(r, r2)];
                float c1, s1; CIS_REV((float)j2 * invn, c1, s1);
                const cf2 t1 = mkf2(c1, -s1), t2 = cmul_g(t1, t1), t3 = cmul_g(t2, t1), t4 = cmul(t2, t2), t8 = cmul(t4, t4), t12 = cmul(t8, t4);
#pragma unroll
                for (int r2 = 0; r2 < 4; ++r2) {
                    bf4_fwd(a[0][r2], a[1][r2], a[2][r2], a[3][r2]);
                    a[1][r2] = r2 == 0 ? cmul_g(a[1][r2], t1) : cmul(a[1][r2], cmul_g(t1, mkf2(W16C(r2), -W16S(r2))));
                    a[2][r2] = cmul(a[2][r2], r2 == 0 ? t2 : cmul(t2, mkf2(W16C(2 * r2), -W16S(2 * r2))));
                    a[3][r2] = cmul(a[3][r2], r2 == 0 ? t3 : cmul(t3, mkf2(W16C(3 * r2), -W16S(3 * r2))));
                }
#pragma unroll
                for (int r = 0; r < 4; ++r) {
                    bf4_fwd(a[r][0], a[r][1], a[r][2], a[r][3]);
                    a[r][1] = cmul(a[r][1], t4); a[r][2] = cmul(a[r][2], t8); a[r][3] = cmul(a[r][3], t12);
                }
#pragma unroll
                for (int r = 0; r < 4; ++r)
#pragma unroll
                    for (int r2 = 0; r2 < 4; ++r2) Xs[FIDX(r, r2)] = a[r][r2];
            }
        }
        SYNC;
    }
    if (S & 1) {
        FOR_TID {
#pragma unroll 4
            for (int gi = tid; gi < NSEQ * (M >> 2); gi += NTHR) {
                const int seq = gi / (M >> 2), b = gi - seq * (M >> 2);
                LDS_F2 Xs = X + seq * MP;
                const int p4 = PADI(4 * b);
                cf2 a0 = Xs[p4], a1 = Xs[p4 + 1], a2 = Xs[p4 + 2], a3 = Xs[p4 + 3];
                bf4_fwd(a0, a1, a2, a3);
                Xs[p4] = a0; Xs[p4 + 1] = a1; Xs[p4 + 2] = a2; Xs[p4 + 3] = a3;
            }
        }
        SYNC;
    }
}
template <int S, int NSEQ, bool HOUT = false>
DEV_FN void fft_inv2(LDS_F2 X) {
    constexpr int M = 1 << (2 * S), MP = M + (M >> 5), NG = NSEQ * (M >> 4);
    if (S & 1) {
        FOR_TID {
#pragma unroll 4
            for (int gi = tid; gi < NSEQ * (M >> 2); gi += NTHR) {
                const int seq = gi / (M >> 2), b = gi - seq * (M >> 2);
                LDS_F2 Xs = X + seq * MP;
                const int p4 = PADI(4 * b);
                cf2 a0 = Xs[p4], a1 = Xs[p4 + 1], a2 = Xs[p4 + 2], a3 = Xs[p4 + 3];
                bf4_inv(a0, a1, a2, a3);
                Xs[p4] = a0; Xs[p4 + 1] = a1; Xs[p4 + 2] = a2; Xs[p4 + 3] = a3;
            }
        }
        SYNC;
    }
#pragma unroll 1
    for (int pr = S / 2 - 1; pr >= 0; --pr) {
        const int s = 2 * pr, n = M >> (2 * s), q = n >> 2, q2 = q >> 2;
        const bool lin = (q2 & 31) == 0; const int sq = q + (q >> 5), sq2 = q2 + (q2 >> 5);
        const float invn = 1.0f / (float)n;
        FOR_TID {
#pragma unroll 2
            for (int gi = tid; gi < NG; gi += NTHR) {
                const int seq = gi / (M >> 4), g = gi - seq * (M >> 4), j2 = g & (q2 - 1), base = ((g - j2) << 4) + j2;
                LDS_F2 Xs = X + seq * MP;
                cf2 a[4][4];
                const int pb = lin ? PADI(base) : base;
#pragma unroll
                for (int r = 0; r < 4; ++r)
#pragma unroll
                    for (int r2 = 0; r2 < 4; ++r2) a[r][r2] = Xs[FIDX(r, r2)];
                float c1, s1; CIS_REV((float)j2 * invn, c1, s1);
                const cf2 t1 = mkf2(c1, s1), t2 = cmul_g(t1, t1), t3 = cmul_g(t2, t1), t4 = cmul(t2, t2), t8 = cmul(t4, t4), t12 = cmul(t8, t4);
#pragma unroll
                for (int r = 0; r < 4; ++r) {
                    a[r][1] = cmul(a[r][1], t4); a[r][2] = cmul(a[r][2], t8); a[r][3] = cmul(a[r][3], t12);
                    bf4_inv(a[r][0], a[r][1], a[r][2], a[r][3]);
                }
#pragma unroll
                for (int r2 = 0; r2 < 4; ++r2) {
                    a[1][r2] = r2 == 0 ? cmul_g(a[1][r2], t1) : cmul(a[1][r2], cmul_g(t1, mkf2(W16C(r2), W16S(r2))));
                    a[2][r2] = cmul(a[2][r2], r2 == 0 ? t2 : cmul(t2, mkf2(W16C(2 * r2), W16S(2 * r2))));
                    a[3][r2] = cmul(a[3][r2], r2 == 0 ? t3 : cmul(t3, mkf2(W16C(3 * r2), W16S(3 * r2))));
                    bf4_inv(a[0][r2], a[1][r2], a[2][r2], a[3][r2]);
                }
#pragma unroll
                for (int r = 0; r < 4; ++r)
#pragma unroll
                    for (int r2 = 0; r2 < 4; ++r2) if (!(HOUT && pr == 0 && r >= 2)) Xs[FIDX(r, r2)] = a[r][r2];
            }
        }
        SYNC;
    }
}
DEV_FN void spec_store(LDS_F2 X, int S, cf2* Kp) {
    const int M = 1 << (2 * S);
    FOR_TID {
        for (int pp = tid; pp < (M >> 1); pp += NTHR) {
            const int p = ((pp >> 1) << 2) + (pp & 1);
            if (p == 0) {
                const cf2 c0 = X[PADI(0)]; Kp[0] = mkf2(c0.x + c0.y, c0.x - c0.y);
                const cf2 ch = X[PADI(2)]; Kp[2] = mkf2(ch.x, -ch.y);
            } else {
                const unsigned k = rev4((unsigned)p, S), pm = rev4((unsigned)(M - (int)k), S);
                const cf2 ck = X[PADI(p)], cm = X[PADI((int)pm)];
                const cf2 P = mkf2(0.5f * (ck.x + cm.x), 0.5f * (ck.y - cm.y));
                const cf2 O = mkf2(0.5f * (ck.y + cm.y), -0.5f * (ck.x - cm.x));
                float c, s; CIS_REV((float)k / (float)(2 * M), c, s);
                const cf2 Q = cmul_g(O, mkf2(c, -s));
                Kp[p] = mkf2(P.x + Q.x, P.y + Q.y);
                Kp[pm] = mkf2(P.x - Q.x, -(P.y - Q.y));
            }
        }
    }
    SYNC;
}
DEV_FN void spec_mul(LDS_F2 X0, int S, const cf2* Kp, int nseq = 1) {
    const int M = 1 << (2 * S);
    constexpr int G = 4;
    FOR_TID {
        if (tid < nseq) {
            LDS_F2 X = X0 + tid * (M + (M >> 5));
            const cf2 c0 = X[PADI(0)], k0 = Kp[0];
            const float y0 = (c0.x + c0.y) * k0.x, ym = (c0.x - c0.y) * k0.y;
            X[PADI(0)] = mkf2(0.5f * (y0 + ym), 0.5f * (y0 - ym));
            const cf2 ch = X[PADI(2)], kh = Kp[2];
            const cf2 yh = cmul(mkf2(ch.x, -ch.y), kh);
            X[PADI(2)] = mkf2(yh.x, -yh.y);
        }
        for (int pq0 = tid; pq0 < nseq * (M >> 1); pq0 += G * NTHR) {
            cf2 ck[G], cm[G], kk[G], km[G]; int ip[G], im[G], sqo[G]; float fk[G]; bool sp[G];
#pragma unroll
            for (int u = 0; u < G; ++u) {
                const int pq = pq0 + u * NTHR, sq_ = pq / (M >> 1), pp = pq - sq_ * (M >> 1);
                sp[u] = (pp == 0);
                const int p = sp[u] ? 1 : ((pp >> 1) << 2) + (pp & 1);
                const unsigned k = rev4((unsigned)p, S), pm = rev4((unsigned)(M - (int)k), S);
                ip[u] = p; im[u] = (int)pm; sqo[u] = sq_ * (M + (M >> 5)); fk[u] = (float)k / (float)(2 * M);
                ck[u] = X0[sqo[u] + PADI(p)]; cm[u] = X0[sqo[u] + PADI((int)pm)]; kk[u] = Kp[p]; km[u] = Kp[pm];
            }
#pragma unroll
            for (int u = 0; u < G; ++u) {
                const cf2 P = mkf2(0.5f * (ck[u].x + cm[u].x), 0.5f * (ck[u].y - cm[u].y));
                const cf2 O = mkf2(0.5f * (ck[u].y + cm[u].y), -0.5f * (ck[u].x - cm[u].x));
                float c, s; CIS_REV(fk[u], c, s);
                const cf2 Wk = mkf2(c, -s);
                const cf2 Q = cmul_g(O, Wk);
                const cf2 xk = mkf2(P.x + Q.x, P.y + Q.y), xm = mkf2(P.x - Q.x, -(P.y - Q.y));
                const cf2 yk = cmul(xk, kk[u]), ym = cmul(xm, km[u]);
                const cf2 Ye = mkf2(0.5f * (yk.x + ym.x), 0.5f * (yk.y - ym.y));
                const cf2 Yd = mkf2(0.5f * (yk.x - ym.x), 0.5f * (yk.y + ym.y));
                const cf2 Yo = cmulc(Yd, Wk);
                ck[u] = mkf2(Ye.x - Yo.y, Ye.y + Yo.x); cm[u] = mkf2(Ye.x + Yo.y, -Ye.y + Yo.x);
            }
#pragma unroll
            for (int u = 0; u < G; ++u) if (!sp[u]) { X0[sqo[u] + PADI(ip[u])] = ck[u]; X0[sqo[u] + PADI(im[u])] = cm[u]; }
        }
    }
    SYNC;
}
__device__ void ph_setup(const P& p) {
    const int gid = blockIdx.x * 512 + TIDX;
    if (gid < 2 * D_HG) {
        const int dir = gid / D_HG, c = gid % D_HG;
        float v[NLAYER], mx = -1e30f;
#pragma unroll
        for (int l = 0; l < NLAYER; ++l) { v[l] = p.in[19][(size_t)(dir * NLAYER + l) * D_HG + c]; mx = fmaxf(mx, v[l]); }
        float s = 0.f;
#pragma unroll
        for (int l = 0; l < NLAYER; ++l) { v[l] = expf(v[l] - mx); s += v[l]; }
        float* lbs = (float*)(p.ws + OFF_SMALL);
        float cum = 0.f;
#pragma unroll
        for (int l = 0; l < NLAYER; ++l) { if (l > 0) cum += v[l] / s; lbs[(size_t)(dir * NLAYER + l) * D_HG + c] = cum; }
    }
}
__device__ void ph_copy_params(const P& p) {
    float* pb = (float*)(p.ws + OFF_PB);
    const int g = blockIdx.x * 512 + TIDX, gs = gridDim.x * 512;
    for (int k = g; k < 4096; k += gs) pb[0 + k] = p.in[2][k];
    for (int k = g; k < 4096; k += gs) pb[4096 + k] = p.in[3][k];
    for (int k = g; k < 4096; k += gs) pb[8192 + k] = p.in[4][k];
    for (int k = g; k < 4096; k += gs) pb[12288 + k] = p.in[5][k];
    for (int k = g; k < 18432; k += gs) pb[16384 + k] = p.in[7][k];
    for (int k = g; k < 6144; k += gs) pb[34816 + k] = p.in[8][k];
    for (int k = g; k < 8448; k += gs) pb[40960 + k] = p.in[9][k];
    for (int k = g; k < 256; k += gs) pb[49408 + k] = p.in[10][k];
    for (int k = g; k < 16384; k += gs) pb[49664 + k] = p.in[11][k];
    for (int k = g; k < 256; k += gs) pb[66048 + k] = p.in[12][k];
    for (int k = g; k < 16384; k += gs) pb[66304 + k] = p.in[13][k];
    for (int k = g; k < 256; k += gs) pb[82688 + k] = p.in[14][k];
    for (int k = g; k < 262144; k += gs) pb[82944 + k] = p.in[15][k];
    for (int k = g; k < 256; k += gs) pb[345088 + k] = p.in[16][k];
    for (int k = g; k < 2048; k += gs) pb[345344 + k] = p.in[17][k];
    for (int k = g; k < 2048; k += gs) pb[347392 + k] = p.in[18][k];
    for (int k = g; k < 4096; k += gs) pb[349440 + k] = p.in[19][k];
    for (int k = g; k < 2048; k += gs) pb[353536 + k] = p.in[20][k];
    for (int k = g; k < 98304; k += gs) pb[355584 + k] = p.in[23][k];
    for (int k = g; k < 32768; k += gs) pb[453888 + k] = p.in[24][k];
}
__device__ void convert_one(const float* src, bf16_t* dst, int K, int N, LAS float* tile  , bool geglu_perm = false) {
    const int tiles_n = N / 64, ntiles = (K / 64) * tiles_n, tid = TIDX;
    const int r0 = tid >> 4, c4 = (tid & 15) * 4;
    nf4 nx0 = (nf4){0.f, 0.f, 0.f, 0.f}, nx1 = nx0;
    { const int it = blockIdx.x; if (it < ntiles) { const int k0 = (it / tiles_n) * 64, n0 = (it % tiles_n) * 64;
        nx0 = *(const nf4*)(src + (size_t)(k0 + r0) * N + n0 + c4); nx1 = *(const nf4*)(src + (size_t)(k0 + r0 + 32) * N + n0 + c4); } }
    for (int it = blockIdx.x; it < ntiles; it += gridDim.x) {
        const int k0 = (it / tiles_n) * 64, n0 = (it % tiles_n) * 64;
        tile[r0 * 65 + c4] = nx0.x; tile[r0 * 65 + c4 + 1] = nx0.y; tile[r0 * 65 + c4 + 2] = nx0.z; tile[r0 * 65 + c4 + 3] = nx0.w;
        tile[(r0 + 32) * 65 + c4] = nx1.x; tile[(r0 + 32) * 65 + c4 + 1] = nx1.y; tile[(r0 + 32) * 65 + c4 + 2] = nx1.z; tile[(r0 + 32) * 65 + c4 + 3] = nx1.w;
        { const int it2 = it + (int)gridDim.x; if (it2 < ntiles) { const int k2 = (it2 / tiles_n) * 64, n2 = (it2 % tiles_n) * 64;
            nx0 = *(const nf4*)(src + (size_t)(k2 + r0) * N + n2 + c4); nx1 = *(const nf4*)(src + (size_t)(k2 + r0 + 32) * N + n2 + c4); } }
        LBAR();
        { const int n = tid >> 3, ks = (tid & 7) * 8; int nr = n0 + n;
          if (geglu_perm) nr = nr < DFF ? (nr >> 7) * 256 + (nr & 127) : ((nr - DFF) >> 7) * 256 + 128 + ((nr - DFF) & 127);
          nu4 w;
          w.x = pack_bf2(tile[(ks + 0) * 65 + n], tile[(ks + 1) * 65 + n]); w.y = pack_bf2(tile[(ks + 2) * 65 + n], tile[(ks + 3) * 65 + n]);
          w.z = pack_bf2(tile[(ks + 4) * 65 + n], tile[(ks + 5) * 65 + n]); w.w = pack_bf2(tile[(ks + 6) * 65 + n], tile[(ks + 7) * 65 + n]);
          *(nu4*)(dst + (size_t)nr * K + k0 + ks) = w; }
        LBAR();
    }
}
__device__ void ph_convert_w(const P& p, int l, LAS unsigned char* lds) {
    LAS float* tile = (LAS float*)lds;
    convert_one(p.in[6] + (size_t)l * DM * D_IN, (bf16_t*)(p.ws + OFF_W_IN), DM, D_IN, tile);
    convert_one(p.in[21] + (size_t)l * DM * DM, (bf16_t*)(p.ws + OFF_W_OUT), DM, DM, tile);
    convert_one(p.in[22] + (size_t)l * DM * 2 * DFF, (bf16_t*)(p.ws + OFF_W_UP), DM, 2 * DFF, tile, true);
    convert_one(p.in[25] + (size_t)l * DFF * DM, (bf16_t*)(p.ws + OFF_W_DN), DFF, DM, tile);
    { const float* w4 = p.in[15] + (size_t)l * 64 * 1024; bf16_t* w4t = (bf16_t*)(p.ws + OFF_W4T);
      for (int idx = blockIdx.x * 512 + TIDX; idx < 65536; idx += gridDim.x * 512) { const int o = idx >> 6, f = idx & 63; w4t[idx] = f2bf(w4[f * 1024 + o]); } }
}
__device__ __forceinline__ bf16_t* abuf_row(const P& p, int t) { return (bf16_t*)(p.ws + OFF_ABUF) + (size_t)(t + APAD) * DM; }
__device__ void ph_rmsnorm_in(const P& p, int l) {
    const int lane = TIDX & 63, wv = TIDX >> 6;
    const float* gain = p.in[2] + (size_t)l * DM;
    for (int t = blockIdx.x * 8 + wv; t < T_TOK; t += gridDim.x * 8) {
        const float* xr = x_src_row(p, l, t);
        float4 v[4]; float ss = 0.f;
#pragma unroll
        for (int i = 0; i < 4; ++i) { v[i] = *(const float4*)(xr + lane * 4 + 256 * i); ss += v[i].x * v[i].x + v[i].y * v[i].y + v[i].z * v[i].z + v[i].w * v[i].w; }
        ss = wave_sum(ss);
        const float r = rsqrtf(ss * (1.0f / DM) + 1e-6f);
        bf16_t* hr = abuf_row(p, t);
#pragma unroll
        for (int i = 0; i < 4; ++i) { const float4 g = *(const float4*)(gain + lane * 4 + 256 * i);
            uint2 w; w.x = pack_bf2(v[i].x * r * g.x, v[i].y * r * g.y); w.y = pack_bf2(v[i].z * r * g.z, v[i].w * r * g.w);
            *(uint2*)(hr + lane * 4 + 256 * i) = w; }
    }
}
constexpr int NRR = 4;
__device__ __forceinline__ bf16_t* xb_buf(const P& p, bool r6) { return r6 ? (bf16_t*)(p.ws + OFF_R6) : (bf16_t*)((unsigned char*)p.out + 64 * MiB); }
__device__ void ph_norm_resid(const P& p, int l, int which) {
    const int lane = TIDX & 63, wv = TIDX >> 6;
    const float* gpost = (which == 0 ? PRM(p, norm_mix_post) : PRM(p, norm_ffn_post)) + (size_t)l * DM;
    const bool has_next = (which == 0) || (l + 1 < NLAYER);
    const float* gnext = which == 0 ? PRM(p, norm_ffn_pre) + (size_t)l * DM : PRM(p, norm_mix_pre) + (size_t)(has_next ? l + 1 : l) * DM;
    const bf16_t* Y = (const bf16_t*)(p.ws + OFF_MIX);
    const bool in_f32 = (l == 0 && which == 0), out_f32 = (l == NLAYER - 1 && which == 1);
    const bf16_t* xin = xb_buf(p, l == NLAYER - 1 && which == 1);
    bf16_t* xout = xb_buf(p, l == NLAYER - 1 && which == 0);
    nf4 gp[4], gn[4];
#pragma unroll
    for (int i = 0; i < 4; ++i) { gp[i] = *(const nf4*)(gpost + lane * 4 + 256 * i); gn[i] = *(const nf4*)(gnext + lane * 4 + 256 * i); }
    for (int t0 = (blockIdx.x * 8 + wv) * NRR; t0 < T_TOK; t0 += gridDim.x * 8 * NRR) {
        nf4 x[NRR][4]; nu2 yw[NRR][4];
#pragma unroll
        for (int rr = 0; rr < NRR; ++rr) { const bf16_t* yr = Y + (size_t)(t0 + rr) * DM;
            if (in_f32) { const float* xr = x_src_row(p, 0, t0 + rr);
#pragma unroll
                for (int i = 0; i < 4; ++i) x[rr][i] = *(const nf4*)(xr + lane * 4 + 256 * i);
            } else { const bf16_t* xr = xin + (size_t)(t0 + rr) * DM;
#pragma unroll
                for (int i = 0; i < 4; ++i) { const nu2 w = *(const nu2*)(xr + lane * 4 + 256 * i);
                    x[rr][i].x = __uint_as_float(w.x << 16); x[rr][i].y = __uint_as_float(w.x & 0xffff0000u); x[rr][i].z = __uint_as_float(w.y << 16); x[rr][i].w = __uint_as_float(w.y & 0xffff0000u); } }
#pragma unroll
            for (int i = 0; i < 4; ++i) yw[rr][i] = *(const nu2*)(yr + lane * 4 + 256 * i); }
#pragma unroll
        for (int rr = 0; rr < NRR; ++rr) {
            const int t = t0 + rr;
            nf4 y[4]; float ss = 0.f;
#pragma unroll
            for (int i = 0; i < 4; ++i) { const nu2 w = yw[rr][i];
                y[i].x = __uint_as_float(w.x << 16); y[i].y = __uint_as_float(w.x & 0xffff0000u); y[i].z = __uint_as_float(w.y << 16); y[i].w = __uint_as_float(w.y & 0xffff0000u);
                ss += y[i].x * y[i].x + y[i].y * y[i].y + y[i].z * y[i].z + y[i].w * y[i].w; }
            ss = wave_sum(ss);
            const float r = rsqrtf(ss * (1.0f / DM) + 1e-6f);
            float s2 = 0.f;
#pragma unroll
            for (int i = 0; i < 4; ++i) { nf4 xv = x[rr][i];
                xv.x += y[i].x * r * gp[i].x; xv.y += y[i].y * r * gp[i].y; xv.z += y[i].z * r * gp[i].z; xv.w += y[i].w * r * gp[i].w;
                s2 += xv.x * xv.x + xv.y * xv.y + xv.z * xv.z + xv.w * xv.w;
                x[rr][i] = xv;
                if (out_f32) *(nf4*)(p.out + (size_t)t * DM + lane * 4 + 256 * i) = xv;
                else { nu2 w; w.x = pack_bf2(xv.x, xv.y); w.y = pack_bf2(xv.z, xv.w); *(nu2*)(xout + (size_t)t * DM + lane * 4 + 256 * i) = w; } }
            if (has_next) {
                s2 = wave_sum(s2);
                const float r2 = rsqrtf(s2 * (1.0f / DM) + 1e-6f);
                bf16_t* hr = abuf_row(p, t);
#pragma unroll
                for (int i = 0; i < 4; ++i) { const nf4 xv = x[rr][i];
                    nu2 w; w.x = pack_bf2(xv.x * r2 * gn[i].x, xv.y * r2 * gn[i].y); w.y = pack_bf2(xv.z * r2 * gn[i].z, xv.w * r2 * gn[i].w);
                    *(nu2*)(hr + lane * 4 + 256 * i) = w; }
            }
        }
    }
}
__device__ void ph_filter(const P& p, int l, LAS unsigned char* lds) {
    LAS float* feats = (LAS float*)lds;
    LAS float* ha = feats + 16 * 36;
    LAS float* hb = ha + 16 * 64;
    LAS float* w1s = hb + 16 * 64;
    LAS float* w2s = w1s + 33 * 64;
    LAS float* w3s = w2s + 64 * 64;
    LAS bf16_t* h3b = (LAS bf16_t*)(w3s + 64 * 64);
    const int tid = TIDX;
    const float* w1 = PRM(p, f_w1) + (size_t)l * 33 * 64; const float* b1 = PRM(p, f_b1) + (size_t)l * 64;
    const float* w2 = PRM(p, f_w2) + (size_t)l * 64 * 64; const float* b2 = PRM(p, f_b2) + (size_t)l * 64;
    const float* w3 = PRM(p, f_w3) + (size_t)l * 64 * 64; const float* b3 = PRM(p, f_b3) + (size_t)l * 64;
    const float* w4 = PRM(p, f_w4) + (size_t)l * 64 * 1024; const float* fq = PRM(p, f_freq) + (size_t)l * 64;
    float* kt = (float*)(p.ws + OFF_KT);
    for (int i = tid; i < 33 * 64; i += 512) w1s[i] = w1[i];
    for (int i = tid; i < 64 * 64; i += 512) { w2s[i] = w2[i]; w3s[i] = w3[i]; }
    const int j = tid & 63;
    const float fqj = fq[j], b1j = b1[j], b2j = b2[j], b3j = b3[j];
    pg8::bf16x8 bfrag[8][2];
    { const bf16_t* w4t = (const bf16_t*)(p.ws + OFF_W4T); const int lane = tid & 63, w = tid >> 6;
#pragma unroll
      for (int nt = 0; nt < 8; ++nt)
#pragma unroll
          for (int ks = 0; ks < 2; ++ks) bfrag[nt][ks] = *(const pg8::bf16x8*)(w4t + (size_t)(128 * w + 16 * nt + (lane & 15)) * 64 + 32 * ks + 8 * (lane >> 4)); }
    __syncthreads();
    const int nitems = (L_BIG + L_SML) / 16;
    for (int it = blockIdx.x; it < nitems; it += gridDim.x) {
        const bool big = it < L_BIG / 16; const int L = big ? L_BIG : L_SML; const int pos0 = (big ? it : it - L_BIG / 16) * 16;
        float* ktc = kt + (big ? 0 : (size_t)512 * 2 * L_BIG);
        for (int idx = tid; idx < 16 * 33; idx += 512) {
            const int pp = idx / 33, f = idx % 33; const int pos = pos0 + pp;
            const float tt = (float)pos / (float)(L - 1), ang = (6.283185307179586f / (float)L) * (float)pos;
            float v;
            if (f == 0) v = tt;
            else { const int bi = (f - 1) & 15; const float band = 1e-4f + (float)bi * ((15.0f - 1e-4f) / 15.0f); v = f <= 16 ? cosf(band * ang) : -sinf(band * ang); }
            feats[pp * 36 + f] = v;
        }
        __syncthreads();
#pragma unroll
        for (int h2 = 0; h2 < 2; ++h2) { const int pp = (tid >> 6) + 8 * h2; float a = b1j;
            for (int f = 0; f < 33; ++f) a += feats[pp * 36 + f] * w1s[f * 64 + j];
            ha[pp * 64 + j] = __sinf(fqj * a); }
        __syncthreads();
#pragma unroll
        for (int h2 = 0; h2 < 2; ++h2) { const int pp = (tid >> 6) + 8 * h2; float a = b2j;
#pragma unroll 4
            for (int f4 = 0; f4 < 16; ++f4) { const nf4 hv = *(const LAS nf4*)(ha + pp * 64 + 4 * f4);
                a += hv.x * w2s[(4 * f4) * 64 + j] + hv.y * w2s[(4 * f4 + 1) * 64 + j] + hv.z * w2s[(4 * f4 + 2) * 64 + j] + hv.w * w2s[(4 * f4 + 3) * 64 + j]; }
            hb[pp * 64 + j] = __sinf(fqj * a); }
        __syncthreads();
#pragma unroll
        for (int h2 = 0; h2 < 2; ++h2) { const int pp = (tid >> 6) + 8 * h2; float a = b3j;
#pragma unroll 4
            for (int f4 = 0; f4 < 16; ++f4) { const nf4 hv = *(const LAS nf4*)(hb + pp * 64 + 4 * f4);
                a += hv.x * w3s[(4 * f4) * 64 + j] + hv.y * w3s[(4 * f4 + 1) * 64 + j] + hv.z * w3s[(4 * f4 + 2) * 64 + j] + hv.w * w3s[(4 * f4 + 3) * 64 + j]; }
            h3b[pp * 72 + j] = f2bf(__sinf(fqj * a)); }
        __syncthreads();
        {
            const int lane = tid & 63, w = tid >> 6, r16 = lane & 15, kg = lane >> 4;
            pg8::f32x4 acc[8];
#pragma unroll
            for (int nt = 0; nt < 8; ++nt) acc[nt] = (pg8::f32x4){0.f, 0.f, 0.f, 0.f};
            pg8::bf16x8 af[2];
#pragma unroll
            for (int ks = 0; ks < 2; ++ks) af[ks] = *(const LAS pg8::bf16x8*)(h3b + r16 * 72 + 32 * ks + 8 * kg);
#pragma unroll
            for (int nt = 0; nt < 8; ++nt)
#pragma unroll
                for (int ks = 0; ks < 2; ++ks) acc[nt] = __builtin_amdgcn_mfma_f32_16x16x32_bf16(af[ks], bfrag[nt][ks], acc[nt], 0, 0, 0);
            const float invl = 1.0f / (float)(L - 1);
            const float dstep = (15.350567286626972f - 3.0701134573253945f) / 511.0f;
            float tt[4];
#pragma unroll
            for (int i = 0; i < 4; ++i) tt[i] = (float)(pos0 + 4 * kg + i) * invl;
#pragma unroll
            for (int nt = 0; nt < 8; ++nt) { const int o = 128 * w + 16 * nt + r16, dir = o >> 9, c = o & 511;
                const float dl = 3.0701134573253945f + (float)c * dstep;
                nf4 v;
#pragma unroll
                for (int i = 0; i < 4; ++i) v[i] = acc[nt][i] * __expf(-tt[i] * dl);
                *(nf4*)(ktc + (size_t)(c * 2 + dir) * L + pos0 + 4 * kg) = v; }
        }
        __syncthreads();
    }
}
__device__ void ph_hy_prep(const P& p, int l, LAS unsigned char* lds) {
    constexpr int RS = 3 * 128 + 8;
    LAS bf16_t* raw = (LAS bf16_t*)lds;
    LAS bf16_t* ox = (LAS bf16_t*)(lds + 52224);
    LAS bf16_t* oz = ox + 128 * 72;
    const bf16_t* hy = (const bf16_t*)(p.ws + OFF_HYRAW);
    bf16_t* x0t = (bf16_t*)(p.ws + OFF_X0T); bf16_t* zt = (bf16_t*)(p.ws + OFF_ZT);
    const float* cw = PRM(p, hy_conv_w) + (size_t)l * 3 * 1536; const float* cb = PRM(p, hy_conv_b) + (size_t)l * 1536;
    const int tid = TIDX, nitems = (T_TOK / 64) * 4;
    for (int it = blockIdx.x; it < nitems; it += gridDim.x) {
        const int t0 = (it >> 2) * 64, c0 = (it & 3) * 128;
        for (int idx = tid; idx < 66 * 48; idx += 512) {
            const int row = idx / 48, rem = idx - row * 48, a = rem >> 4, pc = rem & 15;
            int t = t0 - 1 + row; t = t < 0 ? 0 : (t >= T_TOK ? T_TOK - 1 : t);
            *(LAS nu4*)(raw + row * RS + a * 128 + pc * 8) = *(const nu4*)(hy + (size_t)t * 1536 + a * 512 + c0 + pc * 8);
        }
        __syncthreads();
        {
            const int c = tid & 127, tq = tid >> 7;
            float wv[3][3], bv[3];
#pragma unroll
            for (int a = 0; a < 3; ++a) { bv[a] = cb[a * 512 + c0 + c];
#pragma unroll
                for (int k = 0; k < 3; ++k) wv[a][k] = cw[k * 1536 + a * 512 + c0 + c]; }
            float xm[3], xc[3];
#pragma unroll
            for (int a = 0; a < 3; ++a) { xm[a] = bf2f(raw[(tq * 16) * RS + a * 128 + c]); xc[a] = bf2f(raw[(tq * 16 + 1) * RS + a * 128 + c]); }
            unsigned px = 0, pz = 0;
#pragma unroll
            for (int j = 0; j < 16; ++j) {
                const int tt = tq * 16 + j, t = t0 + tt;
                const bool hp = !seq_start(t), hn = !seq_end(t);
                float r[3];
#pragma unroll
                for (int a = 0; a < 3; ++a) { const float xp = bf2f(raw[(tt + 2) * RS + a * 128 + c]);
                    r[a] = (hp ? xm[a] * wv[a][0] : 0.f) + xc[a] * wv[a][1] + (hn ? xp * wv[a][2] : 0.f) + bv[a];
                    xm[a] = xc[a]; xc[a] = xp; }
                const unsigned bx = f2bf(r[0]), bz = f2bf(r[1] * r[2]);
                if (j & 1) { px |= bx << 16; pz |= bz << 16;
                    *(LAS unsigned*)(ox + c * 72 + tt - 1) = px; *(LAS unsigned*)(oz + c * 72 + tt - 1) = pz; }
                else { px = bx; pz = bz; }
            }
        }
        __syncthreads();
        for (int idx = tid; idx < 128 * 16; idx += 512) {
            const int c = idx >> 4, rem = idx & 15, arr = rem >> 3, pc = rem & 7;
            const nu4 v = *(const LAS nu4*)((arr ? oz : ox) + c * 72 + pc * 8);
            *(nu4*)((arr ? zt : x0t) + (size_t)(c0 + c) * T_TOK + t0 + pc * 8) = v;
        }
        __syncthreads();
    }
}
__device__ __forceinline__ cf2 ld_f2_agent(const cf2* ptr) {
    const unsigned long long w = __hip_atomic_load((const unsigned long long*)ptr, __ATOMIC_RELAXED, __HIP_MEMORY_SCOPE_AGENT);
    return mkf2(__uint_as_float((unsigned)w), __uint_as_float((unsigned)(w >> 32)));
}
template <int S, int NSEQ>
__device__ __forceinline__ void hy_fft_job(const P& p, int l, LAS cf2* X, cf2* Ks, int c, int tbase) {
    const int tid = TIDX;
    constexpr int M = 1 << (2 * S), L = M, MP = M + (M >> 5);
    const float* kt = (const float*)(p.ws + OFF_KT);
    const bf16_t* x0t = (const bf16_t*)(p.ws + OFF_X0T); bf16_t* zt = (bf16_t*)(p.ws + OFF_ZT);
    const float* hf = kt + (S == 7 ? 0 : (size_t)512 * 2 * L_BIG) + (size_t)(c * 2) * L; const float* hb = hf + L;
#pragma unroll 4
    for (int m = tid; m < M; m += 512) {
        const int n0 = 2 * m, n1 = 2 * m + 1;
        const float a = n0 < L ? hf[n0] : (n0 == L ? 0.f : hb[2 * L - n0]);
        const float b = n1 < L ? hf[n1] : hb[2 * L - n1];
        X[PADI(m)] = mkf2(a, b);
    }
    __syncthreads();
    fft_fwd2<S, 1>(X);
    spec_store(X, S, Ks);
    __builtin_amdgcn_fence(__ATOMIC_ACQUIRE, "agent");
    asm volatile("s_waitcnt vmcnt(0)" ::: "memory");
    __syncthreads();
    const float skip = PRM(p, hy_skip)[(size_t)l * D_HY + c];
    const bf16_t* zrow = zt + (size_t)c * T_TOK + tbase; const bf16_t* xrow = x0t + (size_t)c * T_TOK + tbase;
#pragma unroll 4
    for (int idx = tid; idx < NSEQ * (M >> 1); idx += 512) {
        const int sq = idx / (M >> 1), m = idx - sq * (M >> 1);
        const unsigned w = *(const unsigned*)(zrow + sq * L + 2 * m);
        X[sq * MP + PADI(m)] = mkf2(__uint_as_float(w << 16), __uint_as_float(w & 0xffff0000u));
    }
    __syncthreads();
    fft_fwd2<S, NSEQ, true>(X);
    spec_mul(X, S, Ks, NSEQ);
    fft_inv2<S, NSEQ, true>(X);
    const float inv = 1.0f / (float)M;
    bf16_t* orow = zt + (size_t)c * T_TOK + tbase;
#pragma unroll 4
    for (int idx = tid; idx < NSEQ * (M >> 1); idx += 512) {
        const int sq = idx / (M >> 1), m = idx - sq * (M >> 1);
        const cf2 d = X[sq * MP + PADI(m)];
        const unsigned wz = *(const unsigned*)(zrow + sq * L + 2 * m), wx = *(const unsigned*)(xrow + sq * L + 2 * m);
        const float z0 = __uint_as_float(wz << 16), z1 = __uint_as_float(wz & 0xffff0000u), a0 = __uint_as_float(wx << 16), a1 = __uint_as_float(wx & 0xffff0000u);
        *(unsigned*)(orow + sq * L + 2 * m) = pack_bf2(a0 * (d.x * inv + skip * z0), a1 * (d.y * inv + skip * z1));
    }
    __syncthreads();
}
__device__ void ph_hy_fft(const P& p, int l, LAS unsigned char* lds) {
    LAS cf2* X = (LAS cf2*)lds;
    cf2* Ks = (cf2*)(p.ws + OFF_KS) + (size_t)blockIdx.x * L_BIG;
    for (int job = blockIdx.x; job < 1024; job += gridDim.x) {
        const bool big = job < 512; const int c = job & 511;
        if (big) hy_fft_job<7, 1>(p, l, X, Ks, c, 0); else hy_fft_job<6, 4>(p, l, X, Ks, c, L_BIG);
    }
}
__device__ void ph_hy_norm(const P& p, int l, LAS unsigned char* lds) {
    LAS bf16_t* tl = (LAS bf16_t*)lds;
    LAS float* red = (LAS float*)(lds + 9216);
    const bf16_t* yh = (const bf16_t*)(p.ws + OFF_ZT);
    const float* gain = PRM(p, hy_out_norm) + (size_t)l * D_HY;
    const int tid = TIDX, nitems = (T_TOK / 64) * 8;
    const int cc = tid >> 3, pc = tid & 7;
    nu4 nxt = (nu4){0u, 0u, 0u, 0u};
    { const int it = blockIdx.x; if (it < nitems) nxt = *(const nu4*)(yh + (size_t)((it & 7) * 64 + cc) * T_TOK + (it >> 3) * 64 + pc * 8); }
    for (int it = blockIdx.x; it < nitems; it += gridDim.x) {
        const int t0 = (it >> 3) * 64, c0 = (it & 7) * 64;
        *(LAS nu4*)(tl + cc * 72 + pc * 8) = nxt;
        { const int it2 = it + (int)gridDim.x; if (it2 < nitems) nxt = *(const nu4*)(yh + (size_t)((it2 & 7) * 64 + cc) * T_TOK + (it2 >> 3) * 64 + pc * 8); }
        LBAR();
        { const int tt = tid & 63, part = tid >> 6; float s = 0.f;
#pragma unroll
          for (int j = 0; j < 8; ++j) { const float v = bf2f(tl[(part * 8 + j) * 72 + tt]); s += v * v; }
          red[part * 64 + tt] = s; }
        LBAR();
        { const int tt = tid >> 3;
          float s = 0.f;
#pragma unroll
          for (int j = 0; j < 8; ++j) s += red[j * 64 + tt];
          const float r = rsqrtf(s * (1.0f / 64.0f) + 1e-6f);
          unsigned w[4];
#pragma unroll
          for (int j = 0; j < 4; ++j) { const int ca = pc * 8 + 2 * j;
              w[j] = pack_bf2(bf2f(tl[ca * 72 + tt]) * r * gain[c0 + ca], bf2f(tl[(ca + 1) * 72 + tt]) * r * gain[c0 + ca + 1]); }
          nu4 o; o.x = w[0]; o.y = w[1]; o.z = w[2]; o.w = w[3];
          *(nu4*)(abuf_row(p, t0 + tt) + c0 + pc * 8) = o; }
        LBAR();
    }
}
typedef short hbf16x8 __attribute__((ext_vector_type(8)));
typedef float hf32x16 __attribute__((ext_vector_type(16)));
constexpr int HSC = 512, HNCH = HSC / 64, HNSC = T_TOK / HSC;
constexpr int QS = 136, KS_ = 72;
constexpr int HL_QH = 0, HL_KH = HL_QH + 64 * QS * 2, HL_QT = HL_KH + 64 * QS * 2, HL_KT = HL_QT + 64 * QS * 2, HL_VT = HL_KT + 128 * KS_ * 2, HL_ST = HL_VT + 128 * KS_ * 2,
              HL_PM = HL_ST + 128 * QS * 2, HL_TOT = HL_PM + 64 * KS_ * 2, HL_EB = HL_TOT + 4 * 128 * 4, HL_END = HL_EB + 128 * 4;
constexpr int HL_OF = HL_QH, OFS = 132;
static_assert(64 * OFS * 4 <= 2 * 64 * QS * 2, "O tile must fit over Qh|Kh");
constexpr size_t OFF_HST = OFF_R6 + 32 * MiB;
constexpr size_t OFF_HAT = OFF_SMALL + 64 * 1024;

__device__ __forceinline__ hf32x16 mfma32(hbf16x8 a, hbf16x8 b, hf32x16 c) { return __builtin_amdgcn_mfma_f32_32x32x16_bf16(a, b, c, 0, 0, 0); }
__device__ __forceinline__ hbf16x8 lds_frag(const LAS unsigned char* base, int row, int stride_el, int col_el) { return *(const LAS hbf16x8*)(base + ((size_t)row * stride_el + col_el) * 2); }

typedef unsigned hu32x4 __attribute__((ext_vector_type(4)));
struct HgPre { hu32x4 f0, f1, v0, v1, q0, q1; };
template <bool FULL>
__device__ __forceinline__ void hg_fetch(const bf16_t* hg, HgPre& pre, int tokbase, int dirsign, int h, int dir) {
    const int tid = TIDX;
    { const int u = tid >> 4, seg = tid & 15;
      const bf16_t* row = hg + (size_t)(tokbase + dirsign * u) * 2560 + h * 128 + seg * 8;
      pre.f0 = *(const hu32x4*)(row + 512 + 512 * dir); pre.v0 = *(const hu32x4*)(row + 1536); if (FULL) pre.q0 = *(const hu32x4*)(row);
      const bf16_t* row1 = row + (size_t)dirsign * 32 * 2560;
      pre.f1 = *(const hu32x4*)(row1 + 512 + 512 * dir); pre.v1 = *(const hu32x4*)(row1 + 1536); if (FULL) pre.q1 = *(const hu32x4*)(row1); }
}
template <bool FULL>
__device__ __forceinline__ void hg_prep(LAS unsigned char* lds, const HgPre& pre, float lb, float& Bsum_out) {
    const int tid = TIDX, d = tid & 127, qt = tid >> 7;
    LAS float* tot = (LAS float*)(lds + HL_TOT); LAS float* eB = (LAS float*)(lds + HL_EB);
    { const int u = tid >> 4, seg = tid & 15;
      *(LAS hu32x4*)(lds + HL_KH + ((size_t)u * QS + seg * 8) * 2) = pre.f0; *(LAS hu32x4*)(lds + HL_KH + ((size_t)(u + 32) * QS + seg * 8) * 2) = pre.f1;
      *(LAS hu32x4*)(lds + HL_QH + ((size_t)u * QS + seg * 8) * 2) = pre.v0; *(LAS hu32x4*)(lds + HL_QH + ((size_t)(u + 32) * QS + seg * 8) * 2) = pre.v1;
      if (FULL) { *(LAS hu32x4*)(lds + HL_QT + ((size_t)u * QS + seg * 8) * 2) = pre.q0; *(LAS hu32x4*)(lds + HL_QT + ((size_t)(u + 32) * QS + seg * 8) * 2) = pre.q1; } }
    LBAR();
    float c[16];
    float run = 0.f;
    const float oml = 1.0f - lb;
    float zz[16];
#pragma unroll
    for (int j = 0; j < 16; ++j) zz[j] = bf2f(*(const LAS bf16_t*)(lds + HL_KH + ((size_t)(qt * 16 + j) * QS + d) * 2));
    __builtin_amdgcn_sched_barrier(0);
#pragma unroll
    for (int j = 0; j < 16; ++j) {
        const int u = qt * 16 + j;
        const float z = fmaxf(zz[j], -60.0f);
        const float f = lb + oml * __builtin_amdgcn_rcpf(1.0f + __expf(-z));
        zz[j] = 1.0f - f;
        run += __builtin_amdgcn_logf(f);
        c[j] = run;
    }
    tot[qt * 128 + d] = run;
    float vv[16], qq[16];
#pragma unroll
    for (int j = 0; j < 16; ++j) { vv[j] = __uint_as_float((unsigned)(*(const LAS bf16_t*)(lds + HL_QH + ((size_t)(qt * 16 + j) * QS + d) * 2)));
        if (FULL) qq[j] = bf2f(*(const LAS bf16_t*)(lds + HL_QT + ((size_t)(qt * 16 + j) * QS + d) * 2)); }
    LBAR();
    const float t0 = tot[d], t1 = tot[128 + d], t2 = tot[256 + d], t3 = tot[384 + d];
    const float off = qt == 0 ? 0.f : (qt == 1 ? t0 : (qt == 2 ? t0 + t1 : t0 + t1 + t2));
    const float r = t0 + t1, B = t0 + t1 + t2 + t3;
    const float eBr = __builtin_amdgcn_exp2f(B - r), eR = __builtin_amdgcn_exp2f(r);
    if (qt == 0) eB[d] = __builtin_amdgcn_exp2f(B);
    Bsum_out = B;
#pragma unroll
    for (int jj = 0; jj < 8; ++jj) {
        const int j0 = jj * 2, u0 = qt * 16 + j0;
        const float rb0 = r - (off + c[j0]), rb1 = r - (off + c[j0 + 1]);
        const float kh0 = zz[j0] * __builtin_amdgcn_exp2f(rb0), kh1 = zz[j0 + 1] * __builtin_amdgcn_exp2f(rb1);
        const unsigned pkt = pack_bf2_hw(kh0 * eBr, kh1 * eBr);
        const unsigned pvt = __float_as_uint(vv[j0]) | (__float_as_uint(vv[j0 + 1]) << 16);
        if (FULL) {
            const float zq0 = qq[j0], zq1 = qq[j0 + 1];
            const float qh0 = zq0 * __builtin_amdgcn_rcpf(1.0f + __expf(-zq0)) * __builtin_amdgcn_exp2f(-rb0), qh1 = zq1 * __builtin_amdgcn_rcpf(1.0f + __expf(-zq1)) * __builtin_amdgcn_exp2f(-rb1);
            const unsigned pq0 = pack_bf2_hw(qh0 * eR, qh0), pq1 = pack_bf2_hw(qh1 * eR, qh1), pk = pack_bf2_hw(kh0, kh1);
            *(LAS bf16_t*)(lds + HL_QT + ((size_t)u0 * QS + d) * 2) = (bf16_t)pq0;        *(LAS bf16_t*)(lds + HL_QH + ((size_t)u0 * QS + d) * 2) = (bf16_t)(pq0 >> 16);
            *(LAS bf16_t*)(lds + HL_QT + ((size_t)(u0 + 1) * QS + d) * 2) = (bf16_t)pq1;  *(LAS bf16_t*)(lds + HL_QH + ((size_t)(u0 + 1) * QS + d) * 2) = (bf16_t)(pq1 >> 16);
            *(LAS bf16_t*)(lds + HL_KH + ((size_t)u0 * QS + d) * 2) = (bf16_t)pk;         *(LAS bf16_t*)(lds + HL_KH + ((size_t)(u0 + 1) * QS + d) * 2) = (bf16_t)(pk >> 16);
        }
        *(LAS unsigned*)(lds + HL_KT + ((size_t)d * KS_ + qt * 16 + j0) * 2) = pkt;
        *(LAS unsigned*)(lds + HL_VT + ((size_t)d * KS_ + qt * 16 + j0) * 2) = pvt;
    }
    LBAR();
}
__device__ __forceinline__ void hg_state_update(LAS unsigned char* lds, hf32x16 (&S)[2], int w, int lane) {
    const int en = w & 3, r = lane & 31, hh = lane >> 5;
    const LAS float* eB = (const LAS float*)(lds + HL_EB);
#pragma unroll
    for (int i = 0; i < 2; ++i) {
        const int dm = (w >> 2) * 2 + i;
#pragma unroll
        for (int g = 0; g < 4; ++g) { const nf4 sc = *(const LAS nf4*)(eB + 32 * dm + 8 * g + 4 * hh);
            S[i][4 * g + 0] *= sc.x; S[i][4 * g + 1] *= sc.y; S[i][4 * g + 2] *= sc.z; S[i][4 * g + 3] *= sc.w; }
#pragma unroll
        for (int ks = 0; ks < 4; ++ks) {
            const hbf16x8 a = lds_frag(lds + HL_KT, 32 * dm + r, KS_, 16 * ks + 8 * hh);
            const hbf16x8 b = lds_frag(lds + HL_VT, 32 * en + r, KS_, 16 * ks + 8 * hh);
            S[i] = mfma32(a, b, S[i]);
        }
    }
}
__device__ __forceinline__ int hg_unit_base(int sc) { return sc * HSC; }
__device__ void ph_hg_pass1(const P& p, int l, LAS unsigned char* lds) {
    const bf16_t* hg = (const bf16_t*)(p.ws + OFF_HG);
    const float* lbs = (const float*)(p.ws + OFF_SMALL);
    float* ust = (float*)(p.ws + OFF_HST); float* atot = (float*)(p.ws + OFF_HAT);
    const int tid = TIDX, w = tid >> 6, lane = tid & 63;
    for (int unit = blockIdx.x; unit < HNSC * 8; unit += gridDim.x) {
        const int sc = unit >> 3, h = (unit >> 1) & 3, dir = unit & 1;
        const float lb = lbs[(size_t)(dir * NLAYER + l) * D_HG + h * 128 + (tid & 127)];
        hf32x16 S[2];
#pragma unroll
        for (int i = 0; i < 2; ++i)
#pragma unroll
            for (int k = 0; k < 16; ++k) S[i][k] = 0.f;
        float Btot = 0.f;
        const int dsg = dir ? -1 : 1, tb0 = dir ? hg_unit_base(sc) + HSC - 1 : hg_unit_base(sc);
        HgPre pre;
        hg_fetch<false>(hg, pre, tb0, dsg, h, dir);
        for (int ci = 0; ci < HNCH; ++ci) {
            float B;
            hg_prep<false>(lds, pre, lb, B);
            if (ci + 1 < HNCH) hg_fetch<false>(hg, pre, tb0 + dsg * (ci + 1) * 64, dsg, h, dir);
            Btot += B;
            hg_state_update(lds, S, w, lane);
            LBAR();
        }
        float* U = ust + (size_t)unit * 16384;
        int r = lane & 31, hh = lane >> 5; asm volatile("" : "+v"(r), "+v"(hh));
        const int en = w & 3;
#pragma unroll
        for (int i = 0; i < 2; ++i) { const int dm = (w >> 2) * 2 + i;
#pragma unroll
            for (int k = 0; k < 16; ++k) U[(32 * dm + (k & 3) + 8 * (k >> 2) + 4 * hh) * 128 + 32 * en + r] = S[i][k]; }
        if (tid < 128) atot[(size_t)unit * 128 + tid] = __builtin_amdgcn_exp2f(Btot);
    }
}
__device__ void ph_hg_pass2(const P& p) {
    float* ust = (float*)(p.ws + OFF_HST); const float* atot = (const float*)(p.ws + OFF_HAT);
    const int total = 5 * 8 * 16384;
    for (int idx = blockIdx.x * 512 + TIDX; idx < total; idx += gridDim.x * 512) {
        const int el = idx & 16383, hd = (idx >> 14) & 7, sq = idx >> 17;
        const int sc0 = sq == 0 ? 0 : 32 + 8 * (sq - 1), nsc = sq == 0 ? 32 : 8, dir = hd & 1, d = el >> 7;
        float carry = 0.f;
        for (int j0 = 0; j0 < nsc; j0 += 8) {
            float u[8], a[8];
#pragma unroll
            for (int jj = 0; jj < 8; ++jj) { const int j = j0 + jj, sc = dir ? sc0 + nsc - 1 - j : sc0 + j; const size_t unit = (size_t)sc * 8 + hd;
                u[jj] = ust[unit * 16384 + el]; a[jj] = atot[unit * 128 + d]; }
#pragma unroll
            for (int jj = 0; jj < 8; ++jj) { const int j = j0 + jj, sc = dir ? sc0 + nsc - 1 - j : sc0 + j; const size_t unit = (size_t)sc * 8 + hd;
                ust[unit * 16384 + el] = carry; carry = a[jj] * carry + u[jj]; }
        }
    }
}
__device__ void ph_hg_pass3(const P& p, int l, LAS unsigned char* lds) {
    const bf16_t* hg = (const bf16_t*)(p.ws + OFF_HG);
    const float* lbs = (const float*)(p.ws + OFF_SMALL);
    const float* ust = (const float*)(p.ws + OFF_HST);
    const float* gain = PRM(p, hg_out_norm) + (size_t)l * D_HG;
    const int tid = TIDX, w = tid >> 6, lane = tid & 63, r = lane & 31, hh = lane >> 5;
    for (int unit = blockIdx.x; unit < HNSC * 4; unit += gridDim.x) {
        const int sc = unit >> 2, h = unit & 3;
        for (int dir = 0; dir < 2; ++dir) {
            __syncthreads();
            const float lb = lbs[(size_t)(dir * NLAYER + l) * D_HG + h * 128 + (tid & 127)];
            const float* S0 = ust + ((size_t)sc * 8 + h * 2 + dir) * 16384;
            hf32x16 S[2];
            { const int en = w & 3;
              int r_ = r, hh_ = hh; asm volatile("" : "+v"(r_), "+v"(hh_));
              const float* S0l = S0 + (4 * hh_) * 128 + 32 * en + r_;
#pragma unroll
              for (int i = 0; i < 2; ++i) { const int dm = (w >> 2) * 2 + i;
#pragma unroll
                  for (int k = 0; k < 16; ++k) S[i][k] = S0l[(32 * dm + (k & 3) + 8 * (k >> 2)) * 128];
#pragma unroll
                  for (int g = 0; g < 4; ++g) { nu2 wv; wv.x = pack_bf2(S[i][4 * g], S[i][4 * g + 1]); wv.y = pack_bf2(S[i][4 * g + 2], S[i][4 * g + 3]);
                      *(LAS nu2*)(lds + HL_ST + ((size_t)(32 * en + r) * QS + 32 * dm + 8 * g + 4 * hh) * 2) = wv; } } }
            const int dsg = dir ? -1 : 1, tb0 = dir ? hg_unit_base(sc) + HSC - 1 : hg_unit_base(sc);
            HgPre pre;
            hg_fetch<true>(hg, pre, tb0, dsg, h, dir);
            for (int ci = 0; ci < HNCH; ++ci) {
                const int tokbase = tb0 + dsg * ci * 64;
                float Bdummy;
                hg_prep<true>(lds, pre, lb, Bdummy);
                if (ci + 1 < HNCH) hg_fetch<true>(hg, pre, tb0 + dsg * (ci + 1) * 64, dsg, h, dir);
                if (w < 4) {
                    const int tm = (w == 0 || w == 3) ? 0 : 1, sn = (w == 2 || w == 3) ? 1 : 0;
                    hf32x16 acc;
#pragma unroll
                    for (int k = 0; k < 16; ++k) acc[k] = 0.f;
                    if (w < 3) {
#pragma unroll
                        for (int ks = 0; ks < 8; ++ks) acc = mfma32(lds_frag(lds + HL_QH, 32 * tm + r, QS, 16 * ks + 8 * hh), lds_frag(lds + HL_KH, 32 * sn + r, QS, 16 * ks + 8 * hh), acc);
                    }
                    const int s_ = 32 * sn + r;
#pragma unroll
                    for (int k = 0; k < 16; ++k) { const int t_ = 32 * tm + (k & 3) + 8 * (k >> 2) + 4 * hh;
                        const float v = (w < 3 && s_ <= t_) ? acc[k] : 0.f;
                        *(LAS bf16_t*)(lds + HL_PM + ((size_t)t_ * KS_ + s_) * 2) = f2bf(v); }
                }
                LBAR();
                hf32x16 o;
                { const int tm = w >> 2, en = w & 3;
#pragma unroll
                  for (int k = 0; k < 16; ++k) o[k] = 0.f;
#pragma unroll
                  for (int ks = 0; ks < 4; ++ks) o = mfma32(lds_frag(lds + HL_PM, 32 * tm + r, KS_, 16 * ks + 8 * hh), lds_frag(lds + HL_VT, 32 * en + r, KS_, 16 * ks + 8 * hh), o);
#pragma unroll
                  for (int ks = 0; ks < 8; ++ks) o = mfma32(lds_frag(lds + HL_QT, 32 * tm + r, QS, 16 * ks + 8 * hh), lds_frag(lds + HL_ST, 32 * en + r, QS, 16 * ks + 8 * hh), o);
                }
                LBAR();
                { const int tm = w >> 2, en = w & 3; LAS float* Of = (LAS float*)(lds + HL_OF);
#pragma unroll
                  for (int k = 0; k < 16; ++k) Of[(size_t)(32 * tm + (k & 3) + 8 * (k >> 2) + 4 * hh) * OFS + 32 * en + r] = o[k]; }
                hg_state_update(lds, S, w, lane);
                { const int en = w & 3;
#pragma unroll
                  for (int i = 0; i < 2; ++i) { const int dm = (w >> 2) * 2 + i;
#pragma unroll
                      for (int g = 0; g < 4; ++g) { nu2 wv; wv.x = pack_bf2(S[i][4 * g], S[i][4 * g + 1]); wv.y = pack_bf2(S[i][4 * g + 2], S[i][4 * g + 3]);
                          *(LAS nu2*)(lds + HL_ST + ((size_t)(32 * en + r) * QS + 32 * dm + 8 * g + 4 * hh) * 2) = wv; } } }
                LBAR();
                { const int u = tid >> 3, e0 = (tid & 7) * 16, tok = tokbase + dsg * u;
                  const LAS float* Of = (const LAS float*)(lds + HL_OF) + (size_t)u * OFS + e0;
                  bf16_t* dst = abuf_row(p, tok) + 512 + h * 128 + e0;
                  float v[16];
#pragma unroll
                  for (int j = 0; j < 4; ++j) { const nf4 t4 = *(const LAS nf4*)(Of + 4 * j); v[4 * j] = t4.x; v[4 * j + 1] = t4.y; v[4 * j + 2] = t4.z; v[4 * j + 3] = t4.w; }
                  if (dir == 0) {
                      uint4 w0, w1;
                      w0.x = pack_bf2(v[0], v[1]); w0.y = pack_bf2(v[2], v[3]); w0.z = pack_bf2(v[4], v[5]); w0.w = pack_bf2(v[6], v[7]);
                      w1.x = pack_bf2(v[8], v[9]); w1.y = pack_bf2(v[10], v[11]); w1.z = pack_bf2(v[12], v[13]); w1.w = pack_bf2(v[14], v[15]);
                      ((uint4*)dst)[0] = w0; ((uint4*)dst)[1] = w1;
                  } else {
                      const uint4 f0 = ((const uint4*)dst)[0], f1 = ((const uint4*)dst)[1];
                      const unsigned fw[8] = {f0.x, f0.y, f0.z, f0.w, f1.x, f1.y, f1.z, f1.w};
                      float ss = 0.f;
#pragma unroll
                      for (int j = 0; j < 8; ++j) { v[2 * j] += __uint_as_float(fw[j] << 16); v[2 * j + 1] += __uint_as_float(fw[j] & 0xffff0000u); ss += v[2 * j] * v[2 * j] + v[2 * j + 1] * v[2 * j + 1]; }
                      ss += __shfl_xor(ss, 1); ss += __shfl_xor(ss, 2); ss += __shfl_xor(ss, 4);
                      const float rn = rsqrtf(ss * (1.0f / 128.0f) + 1e-6f);
                      const bf16_t* gp = hg + (size_t)tok * 2560 + 2048 + h * 128 + e0;
                      const uint4 g0 = ((const uint4*)gp)[0], g1 = ((const uint4*)gp)[1];
                      const unsigned gw[8] = {g0.x, g0.y, g0.z, g0.w, g1.x, g1.y, g1.z, g1.w};
                      unsigned ow[8];
#pragma unroll
                      for (int j = 0; j < 8; ++j) { const float ga = silu_f(__uint_as_float(gw[j] << 16)), gb = silu_f(__uint_as_float(gw[j] & 0xffff0000u));
                          ow[j] = pack_bf2_hw(v[2 * j] * rn * gain[h * 128 + e0 + 2 * j] * ga, v[2 * j + 1] * rn * gain[h * 128 + e0 + 2 * j + 1] * gb); }
                      ((uint4*)dst)[0] = make_uint4(ow[0], ow[1], ow[2], ow[3]); ((uint4*)dst)[1] = make_uint4(ow[4], ow[5], ow[6], ow[7]);
                  }
                }
                LBAR();
            }
        }
    }
}
#define XB_TMO      128
#define XB_XCNT(j)  (256  + 64 * (j))
#define XB_XSUB(j)  (1280 + 64 * (j))
#define XB_XGEN(j)  (2304 + 64 * (j))
#define XB_TOP      3328
#define XB_TOPGEN   3392
#define XCD_BAR_WORDS 3456
#define XB_SPIN_CAP (1u << 18)

__device__ __forceinline__ unsigned xb_ld(unsigned* p)              { return __hip_atomic_load(p, __ATOMIC_RELAXED, __HIP_MEMORY_SCOPE_AGENT); }
__device__ __forceinline__ unsigned xb_add(unsigned* p, unsigned v) { return __hip_atomic_fetch_add(p, v, __ATOMIC_RELAXED, __HIP_MEMORY_SCOPE_AGENT); }
__device__ __forceinline__ unsigned xb_xcc_id() { return (unsigned)__builtin_amdgcn_s_getreg((3 << 11) | 20) & 0xFu; }
#define XB_SPIN(cond, bar) do { unsigned _sp = 0; while (cond) { __builtin_amdgcn_s_sleep(1); \
    if ((++_sp & 255u) == 0u) { if (xb_ld(&(bar)[XB_TMO])) break; if (_sp > XB_SPIN_CAP) { atomicAdd(&(bar)[XB_TMO], 1u); break; } } } } while (0)

struct XcdBarrier {
    unsigned* bar; unsigned x;
    volatile LAS unsigned* st;
};

__device__ __forceinline__ XcdBarrier xcd_barrier_post(unsigned* bar, volatile LAS unsigned* st) {
    XcdBarrier b; b.bar = bar; b.x = xb_xcc_id(); b.st = st;
    if (TIDX == 0) (void)xb_add(&bar[XB_XCNT(b.x)], 1u);
    return b;
}
__device__ __forceinline__ void xcd_barrier_complete(unsigned* bar, unsigned x, unsigned& nloc, unsigned& nx) {
    const unsigned G = gridDim.x * gridDim.y * gridDim.z;
    unsigned sum, cnt, mine, sp = 0u;
    for (;;) {
        sum = 0u; cnt = 0u; mine = 0u;
#pragma unroll
        for (unsigned j = 0; j < 16; ++j) { const unsigned c = xb_ld(&bar[XB_XCNT(j)]); sum += c; cnt += (c > 0u) ? 1u : 0u; mine = (j == x) ? c : mine; }
        if (sum == G) break;
        __builtin_amdgcn_s_sleep(1);
        if ((++sp & 255u) == 0u) { if (xb_ld(&bar[XB_TMO])) break; if (sp > XB_SPIN_CAP) { atomicAdd(&bar[XB_TMO], 1u); break; } }
    }
    nloc = mine > 0u ? mine : 1u; nx = cnt > 0u ? cnt : 1u;
}

__device__ __forceinline__ void xcd_barrier(const XcdBarrier& b) {
    asm volatile("s_waitcnt vmcnt(0)" ::: "memory");
    __syncthreads();
    if (TIDX == 0) {
        unsigned* bar = b.bar;
        __builtin_amdgcn_s_waitcnt(0);
        unsigned nloc = b.st[0], nx = b.st[1];
        if (nloc == 0u) { xcd_barrier_complete(bar, b.x, nloc, nx); b.st[0] = nloc; b.st[1] = nx; }
        const unsigned old = xb_add(&bar[XB_XSUB(b.x)], 1u);
        const unsigned gen = old / nloc;
        if (old + 1u == (gen + 1u) * nloc) {
            __builtin_amdgcn_fence(__ATOMIC_RELEASE, "agent");
            asm volatile("s_waitcnt vmcnt(0)" ::: "memory");
            const unsigned og = xb_add(&bar[XB_TOP], 1u);
            const unsigned tg = og / nx;
            if (og + 1u == (tg + 1u) * nx) xb_add(&bar[XB_TOPGEN], 1u);
            else XB_SPIN(xb_ld(&bar[XB_TOPGEN]) == tg, bar);
            __builtin_amdgcn_fence(__ATOMIC_ACQUIRE, "agent");
            xb_add(&bar[XB_XGEN(b.x)], 1u);
            asm volatile("s_waitcnt vmcnt(0)" ::: "memory");
        } else {
            XB_SPIN(xb_ld(&bar[XB_XGEN(b.x)]) == gen, bar);
            __builtin_amdgcn_fence(__ATOMIC_ACQUIRE, "agent");
            asm volatile("s_waitcnt vmcnt(0)" ::: "memory");
        }
    }
    __syncthreads();
}

enum { PH_SETUP, PH_CONVERT, PH_RMS_IN, PH_GEMM_IN, PH_HY_PREP, PH_FILTER, PH_HGRN, PH_HG_NORM, PH_HY_FFT, PH_HY_NORM, PH_GEMM_OUT, PH_NR0, PH_GEMM_UP, PH_GEGLU, PH_GEMM_DN, PH_NR1, PH_HG_P1, PH_HG_P2, PH_HG_P3 };
template <int PH> __device__ __forceinline__ void run_phase(const P& p_in, int l, int part, LAS unsigned char* lds) {
    typedef __attribute__((address_space(1))) unsigned char* gptr_t; typedef __attribute__((address_space(1))) float* gfptr_t;
    gptr_t wsg = (gptr_t)p_in.ws; gfptr_t outg = (gfptr_t)p_in.out;
    asm volatile("" : "+s"(wsg), "+s"(outg));
    P p = p_in; p.ws = (unsigned char*)wsg; p.out = (float*)outg;
    if constexpr (PH == PH_SETUP) { ph_setup(p); ph_copy_params(p); }
    if constexpr (PH == PH_CONVERT) ph_convert_w(p, l, lds);
    if constexpr (PH == PH_RMS_IN) ph_rmsnorm_in(p, l);
    if constexpr (PH == PH_GEMM_IN) { EpiBf16Split E; E.O0 = (bf16_t*)(p.ws + OFF_HYRAW); E.ldc0 = 1536; E.O1 = (bf16_t*)(p.ws + OFF_HG); E.ldc1 = 2560; E.csplit = 1536; E.silu_lo0 = E.silu_hi0 = E.silu_lo1 = E.silu_hi1 = 0;
        run_gemm(lds, abuf_row(p, 0), (const bf16_t*)(p.ws + OFF_W_IN), T_TOK, D_IN, DM, E); }
    if constexpr (PH == PH_HY_PREP) ph_hy_prep(p, l, lds);
    if constexpr (PH == PH_FILTER) ph_filter(p, l, lds);
    if constexpr (PH == PH_HY_FFT) ph_hy_fft(p, l, lds);
    if constexpr (PH == PH_HY_NORM) ph_hy_norm(p, l, lds);
    if constexpr (PH == PH_GEMM_OUT) { EpiBf16Split E; E.O0 = (bf16_t*)(p.ws + OFF_MIX); E.ldc0 = DM; E.O1 = E.O0; E.ldc1 = DM; E.csplit = 1 << 30; E.silu_lo0 = E.silu_hi0 = E.silu_lo1 = E.silu_hi1 = 0;
        run_gemm(lds, abuf_row(p, 0), (const bf16_t*)(p.ws + OFF_W_OUT), T_TOK, DM, DM, E); }
    if constexpr (PH == PH_NR0) ph_norm_resid(p, l, 0);
    if constexpr (PH == PH_GEMM_UP) { EpiGeglu E; E.act = (bf16_t*)(p.ws + OFF_ACT); E.cw = PRM(p, ffn_conv_w) + (size_t)l * 3 * 8192; E.cb = PRM(p, ffn_conv_b) + (size_t)l * 8192;
        run_gemm(lds, abuf_row(p, -1), (const bf16_t*)(p.ws + OFF_W_UP), 133 * 256, 2 * DFF, DM, E); }
    if constexpr (PH == PH_GEMM_DN) { EpiBf16Split E; E.O0 = (bf16_t*)(p.ws + OFF_MIX); E.ldc0 = DM; E.O1 = E.O0; E.ldc1 = DM; E.csplit = 1 << 30; E.silu_lo0 = E.silu_hi0 = E.silu_lo1 = E.silu_hi1 = 0;
        run_gemm(lds, (const bf16_t*)(p.ws + OFF_ACT), (const bf16_t*)(p.ws + OFF_W_DN), T_TOK, DM, DFF, E, 1); }
    if constexpr (PH == PH_NR1) ph_norm_resid(p, l, 1);
    if constexpr (PH == PH_HG_P1) ph_hg_pass1(p, l, lds);
    if constexpr (PH == PH_HG_P2) ph_hg_pass2(p);
    if constexpr (PH == PH_HG_P3) ph_hg_pass3(p, l, lds);
}
constexpr int LDS_BYTES = 139264;
__global__ __launch_bounds__(512, 2) void mega(P p) {
    extern __shared__ __attribute__((aligned(16))) unsigned char lds_g[];
    LAS unsigned char* lds = (LAS unsigned char*)lds_g;
    cg::grid_group grid = cg::this_grid();
    volatile LAS unsigned* xst = (volatile LAS unsigned*)(lds + LDS_BYTES - 16);
    if (TIDX == 0) { xst[0] = 0u; xst[1] = 0u; }
    __syncthreads();
    const XcdBarrier xb = xcd_barrier_post((unsigned*)(p.ws + OFF_BAR), xst);
    run_phase<PH_SETUP>(p, 0, 0, lds);
    run_phase<PH_CONVERT>(p, 0, 0, lds);
    run_phase<PH_RMS_IN>(p, 0, 0, lds);
    grid.sync();
#pragma unroll 1
    for (int l = 0; l < NLAYER; ++l) {
        run_phase<PH_GEMM_IN>(p, l, 0, lds); xcd_barrier(xb);
        run_phase<PH_HY_PREP>(p, l, 0, lds); run_phase<PH_HG_P1>(p, l, 0, lds); xcd_barrier(xb);
        run_phase<PH_FILTER>(p, l, 0, lds); run_phase<PH_HG_P2>(p, l, 0, lds); xcd_barrier(xb);
        run_phase<PH_HG_P3>(p, l, 0, lds); run_phase<PH_HY_FFT>(p, l, 0, lds); xcd_barrier(xb);
        run_phase<PH_HY_NORM>(p, l, 0, lds); xcd_barrier(xb);
        run_phase<PH_GEMM_OUT>(p, l, 0, lds); xcd_barrier(xb);
        run_phase<PH_NR0>(p, l, 0, lds); xcd_barrier(xb);
        run_phase<PH_GEMM_UP>(p, l, 0, lds); xcd_barrier(xb);
        run_phase<PH_GEMM_DN>(p, l, 0, lds); xcd_barrier(xb);
        run_phase<PH_NR1>(p, l, 0, lds);
        if (l + 1 < NLAYER) { run_phase<PH_CONVERT>(p, l + 1, 0, lds); xcd_barrier(xb); }
    }
}
extern "C" void kernel_launch(void* const* d_in, const int* in_sizes, int n_in, void* d_out, int out_size, void* d_ws, size_t ws_size, hipStream_t stream) {
    if (ws_size < WS_NEED) { fprintf(stderr, "workspace too small: %zu < %zu\n", ws_size, (size_t)WS_NEED); return; }
    static int grid_blocks = 0;
    if (!grid_blocks) {
        hipFuncSetAttribute((const void*)mega, hipFuncAttributeMaxDynamicSharedMemorySize, LDS_BYTES);
        int dev = 0, cus = 0, per_cu = 0;
        hipGetDevice(&dev);
        hipDeviceGetAttribute(&cus, hipDeviceAttributeMultiprocessorCount, dev);
        hipOccupancyMaxActiveBlocksPerMultiprocessor(&per_cu, mega, 512, LDS_BYTES);
        if (per_cu > 1) per_cu = 1;
        grid_blocks = cus * per_cu;
    }
    P p{};
    for (int i = 0; i < 26; ++i) p.in[i] = (const float*)d_in[i];
    p.out = (float*)d_out; p.ws = (unsigned char*)d_ws;
    hipMemsetAsync((unsigned char*)d_ws + OFF_BAR, 0, XCD_BAR_WORDS * 4, stream);
    void* args[] = {&p};
    hipError_t e = hipLaunchCooperativeKernel((void*)mega, dim3(grid_blocks), dim3(512), args, LDS_BYTES, stream);
    if (e != hipSuccess) fprintf(stderr, "cooperative launch failed: %s (grid %d)\n", hipGetErrorString(e), grid_blocks);
}
```

```cpp
#include <hip/hip_runtime.h>
#include <hip/hip_cooperative_groups.h>
#include <cstdio>
#include <cstdint>
namespace cg = cooperative_groups;
__device__ __forceinline__ int tid_opaque() { int t = (int)threadIdx.x; asm volatile("" : "+v"(t)); return t; }
#define TIDX tid_opaque()
#define LAS __attribute__((address_space(3)))
typedef float cf2 __attribute__((ext_vector_type(2)));
typedef float nf4 __attribute__((ext_vector_type(4)));
typedef unsigned nu2 __attribute__((ext_vector_type(2)));
typedef unsigned nu4 __attribute__((ext_vector_type(4)));
#define LBAR() do { asm volatile("s_waitcnt lgkmcnt(0)" ::: "memory"); __builtin_amdgcn_s_barrier(); asm volatile("" ::: "memory"); } while (0)
namespace pg8 {
#define PG8_LAS __attribute__((address_space(3)))
typedef unsigned short bf16_t;
typedef short bf16x8 __attribute__((ext_vector_type(8)));
typedef float f32x4 __attribute__((ext_vector_type(4)));
typedef unsigned u32x4 __attribute__((ext_vector_type(4)));
constexpr int BM = 256, BK = 64, HALF = 128, HTB = HALF * BK * 2  , STAGE_BYTES = 8 * HTB, NXCD = 8, WGM = 8;

__host__ __device__ __forceinline__ int lds_byte(int r, int c) { const int st = (r >> 4) * 2 + (c >> 5), rr = r & 15, cc = c & 31, ob = rr * 64 + cc * 2; return st * 1024 + (ob ^ (((ob >> 9) & 1) << 5)); }
__host__ __device__ __forceinline__ void stage_rc(int b, int& R, int& C) { const int st = b / 1024, sb = b % 1024, swz = sb ^ (((sb >> 9) & 1) << 5); R = (st >> 1) * 16 + swz / 64; C = (st & 1) * 32 + (swz % 64) / 2; }
__host__ __device__ __forceinline__ int perm32(int rho) { const int n = rho >> 4, i = rho & 15; return 8 * (i >> 2) + 4 * n + (i & 3); }

struct Unit { int pm, pn; };
struct Gemm { const bf16_t* A; const bf16_t* Bt; int M, N, K; int ovl; };

struct StaticOrder {
    int nM, nN, nwg, G, c; int rev = 0;
    __host__ __device__ void init(int M, int N, int G_, int c_) { nM = M / BM; nN = N / BM; nwg = nM * nN; G = G_; c = c_; }
    __host__ __device__ bool next(int i, Unit& u) const {
        const long L = (long)i * G + c; if (L >= nwg) return false;
        int wgid = (int)L; { const int q = nwg / NXCD, r = nwg % NXCD, xcd = wgid % NXCD, off = wgid / NXCD; wgid = (xcd < r ? xcd * (q + 1) : r * (q + 1) + (xcd - r) * q) + off; }
        const int nig = WGM * nN, gid = wgid / nig, fm = gid * WGM, gsz = (nM - fm) < WGM ? (nM - fm) : WGM;
        u.pm = fm + ((wgid % nig) % gsz); u.pn = (wgid % nig) / gsz; if (rev) u.pm = nM - 1 - u.pm; return true;
    }
    __device__ __forceinline__ void a_ready(const Unit&) const {}
    __device__ __forceinline__ void done(const Unit&) const {}
};
struct CountedOrder : StaticOrder {
    const unsigned* ready; unsigned need; unsigned* tmo;
    __device__ __forceinline__ void a_ready(const Unit& u) const {
        if (TIDX < 64) {
            const unsigned long long t0 = __builtin_amdgcn_s_memrealtime(); unsigned polls = 0;
            while ((unsigned)__builtin_amdgcn_readfirstlane(__hip_atomic_load(ready + 64 * u.pm, __ATOMIC_RELAXED, __HIP_MEMORY_SCOPE_AGENT)) < need) {
                if ((++polls & 255u) == 0u && __builtin_amdgcn_readfirstlane(__hip_atomic_load(tmo, __ATOMIC_RELAXED, __HIP_MEMORY_SCOPE_AGENT)) != 0u) break;
                if (__builtin_amdgcn_s_memrealtime() - t0 > 2000000ull) {
                    if (TIDX == 0) { unsigned expect = 0u; __hip_atomic_compare_exchange_strong(tmo + 1, &expect, 0x600u | (unsigned)(u.pm & 0xff), __ATOMIC_RELAXED, __ATOMIC_RELAXED, __HIP_MEMORY_SCOPE_AGENT); __hip_atomic_store(tmo, 1u, __ATOMIC_RELAXED, __HIP_MEMORY_SCOPE_AGENT); }
                    break; }
                __builtin_amdgcn_s_sleep(2); }
            __builtin_amdgcn_fence(__ATOMIC_ACQUIRE, "agent");
            asm volatile("s_waitcnt vmcnt(0)" ::: "memory");
        }
#if !defined(BROKEN_HOOK_NO_BARRIER)
        asm volatile("" ::: "memory"); __builtin_amdgcn_s_barrier(); asm volatile("" ::: "memory");
#endif
    }
};

__device__ __forceinline__ unsigned cvt_pk_bf16(float lo, float hi) { unsigned r; asm volatile("v_cvt_pk_bf16_f32 %0, %1, %2" : "=v"(r) : "v"(lo), "v"(hi)); return r; }
typedef float f32x2 __attribute__((ext_vector_type(2)));
__device__ __forceinline__ f32x2 gelu_pk(f32x2 v) {
    const f32x2 av = __builtin_elementwise_abs(v), d = av * 0.2316418882f + 1.0f;
    f32x2 t; t.x = __builtin_amdgcn_rcpf(d.x); t.y = __builtin_amdgcn_rcpf(d.y);
    f32x2 q = t * 0.5307027145f + (-0.7265760135f); q = q * t + 0.7107068705f; q = q * t + (-0.142248368f); q = q * t + 0.127414796f; q = q * t;
    const f32x2 s = (v * v) * (-0.72134752044f);
    f32x2 e; e.x = __builtin_amdgcn_exp2f(s.x); e.y = __builtin_amdgcn_exp2f(s.y);
    const f32x2 m = v * (q * e), r = v - m;
    f32x2 o; o.x = v.x < 0.f ? m.x : r.x; o.y = v.y < 0.f ? m.y : r.y; return o;
}

struct EpiF32 {
    static constexpr bool PERM = false, AFTER_DRAIN = false;
    float* C; int ldc; const float* bias;
    __device__ __forceinline__ void operator()(const f32x4 (&acc)[2][2][4][2], const Unit& u, int wr, int wc, int fr, int fq) const {
        const int row0 = u.pm * BM + wr * 64 + fr, col0 = u.pn * BM + wc * 32 + 4 * fq;
        f32x4 bv[2][2];
#pragma unroll
        for (int bj = 0; bj < 2; ++bj)
#pragma unroll
            for (int n = 0; n < 2; ++n) bv[bj][n] = bias ? *(const f32x4*)(bias + col0 + bj * HALF + n * 16) : (f32x4){0.f, 0.f, 0.f, 0.f};
#pragma unroll
        for (int ai = 0; ai < 2; ++ai)
#pragma unroll
            for (int m = 0; m < 4; ++m) { float* rowp = C + (size_t)(row0 + ai * HALF + m * 16) * ldc + col0;
#pragma unroll
                for (int bj = 0; bj < 2; ++bj)
#pragma unroll
                    for (int n = 0; n < 2; ++n) *(f32x4*)(rowp + bj * HALF + n * 16) = acc[ai][bj][m][n] + bv[bj][n]; }
    }
};
template <int ACT  > struct EpiBf16 {
    static constexpr bool PERM = true, AFTER_DRAIN = false;
    bf16_t* O; int ldc; const float* bias; int split_cols; size_t split_stride;
    __device__ __forceinline__ void operator()(const f32x4 (&acc)[2][2][4][2], const Unit& u, int wr, int wc, int fr, int fq) const {
        const int row0 = u.pm * BM + wr * 64 + fr; int colt = u.pn * BM; bf16_t* base = O;
        if (split_cols) { const int t = colt / split_cols; base += (size_t)t * split_stride; colt -= t * split_cols; }
        const int col0 = colt + wc * 32 + 8 * fq, bcol0 = u.pn * BM + wc * 32 + 8 * fq;
        f32x4 bv[2][2];
#pragma unroll
        for (int bj = 0; bj < 2; ++bj)
#pragma unroll
            for (int n = 0; n < 2; ++n) bv[bj][n] = bias ? *(const f32x4*)(bias + bcol0 + bj * HALF + 4 * n) : (f32x4){0.f, 0.f, 0.f, 0.f};
#pragma unroll
        for (int ai = 0; ai < 2; ++ai)
#pragma unroll
            for (int m = 0; m < 4; ++m) { bf16_t* rowp = base + (size_t)(row0 + ai * HALF + m * 16) * ldc + col0;
#pragma unroll
                for (int bj = 0; bj < 2; ++bj) { f32x4 v0 = acc[ai][bj][m][0] + bv[bj][0], v1 = acc[ai][bj][m][1] + bv[bj][1];
                    if (ACT == 1) { f32x2 a = gelu_pk((f32x2){v0[0], v0[1]}), b = gelu_pk((f32x2){v0[2], v0[3]}), c = gelu_pk((f32x2){v1[0], v1[1]}), d = gelu_pk((f32x2){v1[2], v1[3]});
                        v0 = (f32x4){a.x, a.y, b.x, b.y}; v1 = (f32x4){c.x, c.y, d.x, d.y}; }
                    if (ACT == 2) {
#pragma unroll
                        for (int j = 0; j < 4; ++j) { v0[j] = 0.5f * v0[j] * (1.0f + erff(v0[j] * 0.70710678f)); v1[j] = 0.5f * v1[j] * (1.0f + erff(v1[j] * 0.70710678f)); } }
                    u32x4 w; w.x = cvt_pk_bf16(v0[0], v0[1]); w.y = cvt_pk_bf16(v0[2], v0[3]); w.z = cvt_pk_bf16(v1[0], v1[1]); w.w = cvt_pk_bf16(v1[2], v1[3]);
                    *(u32x4*)(rowp + bj * HALF) = w; } }
    }
};
template <class Epi, class Sched, bool STAMP = false>
__device__ __forceinline__ void gemm_phase(PG8_LAS unsigned char* lds, const Gemm g, const Sched& S, const Epi& E, unsigned long long* stamps) {
    const int tid = TIDX, wid = __builtin_amdgcn_readfirstlane(tid >> 6), lane = tid & 63, wr = wid >> 2, wc = wid & 3, fr = lane & 15, fq = lane >> 4;
    const int K = g.K, nt = K / BK;
    int ts_lo = 0, ts_hi = 0, nts = 0; const unsigned long long rt_entry = STAMP ? (unsigned long long)wall_clock64() : 0ull;
#define PG8_STAMP() do { if (STAMP && wid == 0 && nts < 64) { const unsigned long long _c = (unsigned long long)clock64(); \
        ts_lo = (lane == nts) ? (int)(unsigned)_c : ts_lo; ts_hi = (lane == nts) ? (int)(unsigned)(_c >> 32) : ts_hi; ++nts; } } while (0)
    PG8_STAMP();
    unsigned voffA[2], voffB[2];
#pragma unroll
    for (int i = 0; i < 2; ++i) { int R, C; stage_rc(tid * 16 + i * 8192, R, C); const int Rb = Epi::PERM ? ((R & ~31) + perm32(R & 31)) : R;
        const int Ra = g.ovl ? R - 2 * (R >> 6) : R; voffA[i] = (unsigned)(Ra * K + C) * 2u; voffB[i] = (unsigned)(Rb * K + C) * 2u; }
    const size_t kstep = (size_t)(BK * 2);
    const size_t hstep = (size_t)HALF * K * 2;
    const size_t tstep = 2 * hstep;
    const size_t hstepA = g.ovl ? (size_t)124 * K * 2 : hstep, tstepA = g.ovl ? (size_t)248 * K * 2 : tstep;
    const unsigned ldsw = (unsigned)wid * 1024u;
    const int aoff = lds_byte(wr * 64 + fr, fq * 8), boff = lds_byte(wc * 32 + fr, fq * 8);
#define PG8_SA(b, h) (((b) * 2 + (h)) * HTB)
#define PG8_SB(b, h) ((4 + (b) * 2 + (h)) * HTB)
#define PG8_STAGE(bufoff, gbase, voff) do { _Pragma("unroll") for (int _i = 0; _i < 2; ++_i) \
        __builtin_amdgcn_global_load_lds((const unsigned*)((const char*)(gbase) + (voff)[_i]), (PG8_LAS unsigned*)(lds + (bufoff) + ldsw + _i * 8192), 16, 0, 0); } while (0)
#define PG8_LDA(dst, b, h) do { _Pragma("unroll") for (int m = 0; m < 4; ++m) _Pragma("unroll") for (int k = 0; k < 2; ++k) dst[m][k] = *(const PG8_LAS bf16x8*)(lds + PG8_SA(b, h) + aoff + m * 2048 + k * 1024); } while (0)
#define PG8_LDB(dst, b, h) do { _Pragma("unroll") for (int n = 0; n < 2; ++n) _Pragma("unroll") for (int k = 0; k < 2; ++k) dst[n][k] = *(const PG8_LAS bf16x8*)(lds + PG8_SB(b, h) + boff + n * 2048 + k * 1024); } while (0)
#define PG8_MMA(ai, bj, At, Bt) do { __builtin_amdgcn_s_setprio(1); _Pragma("unroll") for (int m = 0; m < 4; ++m) _Pragma("unroll") for (int n = 0; n < 2; ++n) _Pragma("unroll") for (int k = 0; k < 2; ++k) \
        acc[ai][bj][m][n] = __builtin_amdgcn_mfma_f32_16x16x32_bf16(Bt[n][k], At[m][k], acc[ai][bj][m][n], 0, 0, 0); __builtin_amdgcn_s_setprio(0); } while (0)
#define PG8_WAIT_V(n) asm volatile("s_waitcnt vmcnt(" #n ")" ::: "memory")
#define PG8_WAIT_L(n) asm volatile("s_waitcnt lgkmcnt(" #n ")" ::: "memory")
#define PG8_BAR __builtin_amdgcn_s_barrier()
#define PG8_SCHED __builtin_amdgcn_sched_barrier(0)
    Unit cur, nxt; int ui = 0;
    if (!S.next(0, cur)) return;
    f32x4 acc[2][2][4][2];
#pragma unroll
    for (int a = 0; a < 2; ++a)
#pragma unroll
        for (int b = 0; b < 2; ++b)
#pragma unroll
            for (int m = 0; m < 4; ++m)
#pragma unroll
                for (int n = 0; n < 2; ++n) acc[a][b][m][n] = (f32x4){0.f, 0.f, 0.f, 0.f};
    bf16x8 At[4][2], B0[2][2], B1[2][2];
    const char* cA = (const char*)g.A + (size_t)cur.pm * tstepA; const char* cB = (const char*)g.Bt + (size_t)cur.pn * tstep;
    S.a_ready(cur);
    PG8_STAGE(PG8_SB(0, 0), cB, voffB); PG8_STAGE(PG8_SA(0, 0), cA, voffA); PG8_STAGE(PG8_SB(0, 1), cB + hstep, voffB); PG8_STAGE(PG8_SA(0, 1), cA + hstepA, voffA);
    if (wr == 1) PG8_BAR;
    PG8_WAIT_V(4); PG8_BAR;
    PG8_STAGE(PG8_SB(1, 0), cB + kstep, voffB); PG8_STAGE(PG8_SA(1, 0), cA + kstep, voffA); PG8_STAGE(PG8_SB(1, 1), cB + hstep + kstep, voffB);
    PG8_WAIT_V(6); PG8_BAR;
    PG8_STAMP();
    for (;;) {
        const bool has_next = S.next(ui + 1, nxt);
        const char* nA = has_next ? (const char*)g.A + (size_t)nxt.pm * tstepA : cA; const char* nB = has_next ? (const char*)g.Bt + (size_t)nxt.pn * tstep : cB;
        for (int t = 0; t < nt; t += 2) {
            const bool last = (t == nt - 2);
            const char* a1 = cA + (size_t)(t + 1) * kstep;
            const char* a2 = last ? nA : cA + (size_t)(t + 2) * kstep; const char* b2 = last ? nB : cB + (size_t)(t + 2) * kstep;
            const char* a3 = a2 + kstep; const char* b3 = b2 + kstep;
            if (last && has_next) S.a_ready(nxt);
            PG8_LDB(B0, 0, 0); PG8_SCHED; PG8_LDA(At, 0, 0); PG8_STAGE(PG8_SA(1, 1), a1 + hstepA, voffA);
            PG8_WAIT_L(8); PG8_BAR; PG8_WAIT_L(0); PG8_MMA(0, 0, At, B0); PG8_BAR; PG8_SCHED;
            PG8_LDB(B1, 0, 1); PG8_STAGE(PG8_SB(0, 0), b2, voffB);
            PG8_BAR; PG8_WAIT_L(0); PG8_MMA(0, 1, At, B1); PG8_BAR;
            PG8_LDA(At, 0, 1); PG8_STAGE(PG8_SA(0, 0), a2, voffA);
            PG8_BAR; PG8_WAIT_L(0); PG8_MMA(1, 0, At, B0); PG8_BAR; PG8_SCHED;
            PG8_STAGE(PG8_SB(0, 1), b2 + hstep, voffB);
            PG8_WAIT_V(6); PG8_BAR; PG8_MMA(1, 1, At, B1); PG8_BAR;
            PG8_LDB(B0, 1, 0); PG8_SCHED; PG8_LDA(At, 1, 0); PG8_STAGE(PG8_SA(0, 1), a2 + hstepA, voffA);
            PG8_WAIT_L(8); PG8_BAR; PG8_WAIT_L(0); PG8_MMA(0, 0, At, B0); PG8_BAR; PG8_SCHED;
            PG8_LDB(B1, 1, 1); PG8_STAGE(PG8_SB(1, 0), b3, voffB);
            PG8_BAR; PG8_WAIT_L(0); PG8_MMA(0, 1, At, B1); PG8_BAR;
            PG8_LDA(At, 1, 1); PG8_STAGE(PG8_SA(1, 0), a3, voffA);
            PG8_BAR; PG8_WAIT_L(0); PG8_MMA(1, 0, At, B0); PG8_BAR; PG8_SCHED;
            PG8_STAGE(PG8_SB(1, 1), b3 + hstep, voffB);
            PG8_WAIT_V(6); PG8_BAR; PG8_MMA(1, 1, At, B1); PG8_BAR;
        }
        PG8_STAMP();
        if constexpr (!Epi::AFTER_DRAIN) { E(acc, cur, wr, wc, fr, fq); S.done(cur); }
        PG8_STAMP();
        if (!has_next) break;
#pragma unroll
        for (int a = 0; a < 2; ++a)
#pragma unroll
            for (int b = 0; b < 2; ++b)
#pragma unroll
                for (int m = 0; m < 4; ++m)
#pragma unroll
                    for (int n = 0; n < 2; ++n) acc[a][b][m][n] = (f32x4){0.f, 0.f, 0.f, 0.f};
        cur = nxt; cA = nA; cB = nB; ++ui;
    }
    PG8_WAIT_V(0);
    if (wr == 0) PG8_BAR;
    PG8_BAR;
    if constexpr (Epi::AFTER_DRAIN) { E.fused(acc, cur, wr, wc, fr, fq, lds, wid, lane); S.done(cur); }
    PG8_STAMP();
    if (STAMP && wid == 0) { stamps[lane] = lane < nts ? (((unsigned long long)(unsigned)ts_hi << 32) | (unsigned)ts_lo) : 0ull;
        if (lane == 62) stamps[62] = rt_entry; if (lane == 63) stamps[63] = (unsigned long long)wall_clock64(); }
#undef PG8_STAMP
#undef PG8_SA
#undef PG8_SB
#undef PG8_STAGE
#undef PG8_LDA
#undef PG8_LDB
#undef PG8_MMA
#undef PG8_WAIT_V
#undef PG8_WAIT_L
#undef PG8_BAR
#undef PG8_SCHED
}
}
typedef unsigned short bf16_t;
constexpr int T_TOK = 32768, DM = 1024, D_IN = 4096, D_HY = 512, D_HG = 512, DFF = 4096, NLAYER = 4;
constexpr int L_BIG = 16384, L_SML = 4096;
constexpr int APAD = 256;
constexpr size_t MiB = 1024ull * 1024ull;
constexpr size_t OFF_W = 0;
constexpr size_t OFF_W_IN = OFF_W, OFF_W_OUT = OFF_W + 8 * MiB, OFF_W_UP = OFF_W + 10 * MiB, OFF_W_DN = OFF_W + 26 * MiB;
constexpr size_t OFF_ABUF = 34 * MiB;
constexpr size_t OFF_R1 = 99 * MiB;
constexpr size_t OFF_HYRAW = OFF_R1;
constexpr size_t OFF_HG = OFF_R1 + 96 * MiB;
constexpr size_t OFF_KT = OFF_R1;
constexpr size_t OFF_ACT = OFF_R1;
constexpr size_t OFF_R2 = 355 * MiB;
constexpr size_t OFF_X0T = OFF_R2, OFF_ZT = OFF_R2 + 32 * MiB;
constexpr size_t OFF_MIX = OFF_R2;
constexpr size_t OFF_UPART = OFF_R2;
constexpr size_t OFF_R6 = 419 * MiB;
constexpr size_t OFF_OBUF = OFF_R6;
constexpr size_t OFF_KS = OFF_R6;
constexpr size_t OFF_SMALL = 483 * MiB;
constexpr size_t OFF_BAR = OFF_SMALL + 4 * MiB;
constexpr size_t OFF_W4T = OFF_SMALL + 8 * MiB;
constexpr size_t WS_NEED = 502 * MiB;

struct P { const float* in[26]; float* out; unsigned char* ws; };
constexpr int PB_norm_mix_pre = 0;
constexpr int PB_norm_mix_post = 4096;
constexpr int PB_norm_ffn_pre = 8192;
constexpr int PB_norm_ffn_post = 12288;
constexpr int PB_hy_conv_w = 16384;
constexpr int PB_hy_conv_b = 34816;
constexpr int PB_f_w1 = 40960;
constexpr int PB_f_b1 = 49408;
constexpr int PB_f_w2 = 49664;
constexpr int PB_f_b2 = 66048;
constexpr int PB_f_w3 = 66304;
constexpr int PB_f_b3 = 82688;
constexpr int PB_f_w4 = 82944;
constexpr int PB_f_freq = 345088;
constexpr int PB_hy_skip = 345344;
constexpr int PB_hy_out_norm = 347392;
constexpr int PB_lb_table = 349440;
constexpr int PB_hg_out_norm = 353536;
constexpr int PB_ffn_conv_w = 355584;
constexpr int PB_ffn_conv_b = 453888;
constexpr int PB_TOTAL = 486656;
constexpr size_t OFF_PB = OFF_SMALL + 512 * 1024;
#define PRM(p, NAME) ((const float*)((p).ws + OFF_PB) + PB_##NAME)

__device__ __forceinline__ float bf2f(bf16_t b) { return __uint_as_float(((unsigned)b) << 16); }
typedef __bf16 nbf2v __attribute__((ext_vector_type(2)));
typedef float nf2v __attribute__((ext_vector_type(2)));
__device__ __forceinline__ bf16_t f2bf(float f) { const __bf16 b = (__bf16)f; return __builtin_bit_cast(unsigned short, b); }
__device__ __forceinline__ unsigned pack_bf2(float lo, float hi) { nf2v v; v.x = lo; v.y = hi; return __builtin_bit_cast(unsigned, __builtin_convertvector(v, nbf2v)); }
__device__ __forceinline__ unsigned pack_bf2_hw(float lo, float hi) { return pack_bf2(lo, hi); }
__device__ __forceinline__ bool seq_start(int t) { return t < L_BIG ? (t == 0) : ((t & (L_SML - 1)) == 0); }
__device__ __forceinline__ bool seq_end(int t) { return (t + 1 == T_TOK) || seq_start(t + 1); }
__device__ __forceinline__ const float* x_src_row(const P& p, int l, int t) {
    if (l > 0) return p.out + (size_t)t * DM;
    return t < L_BIG ? p.in[0] + (size_t)t * DM : p.in[1] + (size_t)(t - L_BIG) * DM;
}
__device__ __forceinline__ float silu_f(float x) { return x / (1.0f + __expf(-x)); }
__device__ __forceinline__ float wave_sum(float v) {
#pragma unroll
    for (int o = 32; o >= 1; o >>= 1) v += __shfl_xor(v, o);
    return v;
}

struct EpiBf16Split {
    static constexpr bool PERM = true, AFTER_DRAIN = false, OVL = false;
    bf16_t* O0; int ldc0; bf16_t* O1; int ldc1; int csplit;
    int silu_lo0, silu_hi0, silu_lo1, silu_hi1;
    __device__ __forceinline__ void operator()(const pg8::f32x4 (&acc)[2][2][4][2], const pg8::Unit& u, int wr, int wc, int fr, int fq) const {
        const int row0 = u.pm * pg8::BM + wr * 64 + fr; int colt = u.pn * pg8::BM; bf16_t* base = O0; int ldc = ldc0;
        const bool act = (colt >= silu_lo0 && colt < silu_hi0) || (colt >= silu_lo1 && colt < silu_hi1);
        if (colt >= csplit) { base = O1; ldc = ldc1; colt -= csplit; }
        const int col0 = colt + wc * 32 + 8 * fq;
#pragma unroll
        for (int ai = 0; ai < 2; ++ai)
#pragma unroll
            for (int m = 0; m < 4; ++m) { bf16_t* rowp = base + (size_t)(row0 + ai * pg8::HALF + m * 16) * ldc + col0;
#pragma unroll
                for (int bj = 0; bj < 2; ++bj) { pg8::f32x4 v0 = acc[ai][bj][m][0], v1 = acc[ai][bj][m][1];
                    if (act) {
#pragma unroll
                        for (int i = 0; i < 4; ++i) { v0[i] = v0[i] * __builtin_amdgcn_rcpf(1.0f + __builtin_amdgcn_exp2f(-1.4426950408889634f * v0[i])); v1[i] = v1[i] * __builtin_amdgcn_rcpf(1.0f + __builtin_amdgcn_exp2f(-1.4426950408889634f * v1[i])); } }
                    pg8::u32x4 w; w.x = pg8::cvt_pk_bf16(v0[0], v0[1]); w.y = pg8::cvt_pk_bf16(v0[2], v0[3]); w.z = pg8::cvt_pk_bf16(v1[0], v1[1]); w.w = pg8::cvt_pk_bf16(v1[2], v1[3]);
                    *(pg8::u32x4*)(rowp + bj * pg8::HALF) = w; } }
    }
};
__device__ __forceinline__ float dpp_ror1(float v) { return __int_as_float(__builtin_amdgcn_mov_dpp(__float_as_int(v), 0x121, 0xF, 0xF, true)); }
__device__ __forceinline__ float dpp_ror15(float v) { return __int_as_float(__builtin_amdgcn_mov_dpp(__float_as_int(v), 0x12F, 0xF, 0xF, true)); }
__device__ __forceinline__ float gelu_tanh_e(float x) { const float y = 1.5957691216057308f * (x + 0.044715f * x * x * x); return x * __builtin_amdgcn_rcpf(1.0f + __expf(-y)); }
struct EpiGeglu {
    static constexpr bool PERM = true, AFTER_DRAIN = false, OVL = true;
    bf16_t* act; const float* cw; const float* cb;
    template <bool MASK> __device__ __forceinline__ void run(const pg8::f32x4 (&acc)[2][2][4][2], const pg8::Unit& u, int wr, int wc, int fr, int fq, unsigned mprev, unsigned mnext, unsigned mst) const {
        const int j0 = u.pn * 128 + wc * 32 + 8 * fq;
#pragma unroll
        for (int n = 0; n < 2; ++n) {
            const int jc = j0 + 4 * n;
            const pg8::f32x4 wa0 = *(const pg8::f32x4*)(cw + jc), wa1 = *(const pg8::f32x4*)(cw + 8192 + jc), wa2 = *(const pg8::f32x4*)(cw + 16384 + jc), ba = *(const pg8::f32x4*)(cb + jc);
            const pg8::f32x4 wb0 = *(const pg8::f32x4*)(cw + 4096 + jc), wb1 = *(const pg8::f32x4*)(cw + 8192 + 4096 + jc), wb2 = *(const pg8::f32x4*)(cw + 16384 + 4096 + jc), bb = *(const pg8::f32x4*)(cb + 4096 + jc);
#pragma unroll
            for (int ai = 0; ai < 2; ++ai) {
                pg8::f32x4 pa_prev, pb_prev, na_cur, nb_cur;
#pragma unroll
                for (int i = 0; i < 4; ++i) { na_cur[i] = dpp_ror15(acc[ai][0][0][n][i]); nb_cur[i] = dpp_ror15(acc[ai][1][0][n][i]); pa_prev[i] = 0.f; pb_prev[i] = 0.f; }
#pragma unroll
                for (int m = 0; m < 4; ++m) {
                    const int b = ai * 4 + m, q = 16 * m + fr, tok = u.pm * 248 + 124 * ai + 62 * wr + q - 1;
                    const bool hp = (mprev >> b) & 1u, hn = (mnext >> b) & 1u;
                    pg8::f32x4 pa_cur, pb_cur, na_next, nb_next;
#pragma unroll
                    for (int i = 0; i < 4; ++i) { pa_cur[i] = dpp_ror1(acc[ai][0][m][n][i]); pb_cur[i] = dpp_ror1(acc[ai][1][m][n][i]);
                        na_next[i] = m < 3 ? dpp_ror15(acc[ai][0][m < 3 ? m + 1 : 3][n][i]) : 0.f; nb_next[i] = m < 3 ? dpp_ror15(acc[ai][1][m < 3 ? m + 1 : 3][n][i]) : 0.f; }
                    const pg8::f32x4 xpa = (fr == 0) ? pa_prev : pa_cur, xna = (fr == 15) ? na_next : na_cur;
                    const pg8::f32x4 xpb = (fr == 0) ? pb_prev : pb_cur, xnb = (fr == 15) ? nb_next : nb_cur;
                    const pg8::f32x4 xa = acc[ai][0][m][n], xb = acc[ai][1][m][n];
                    float o[4];
#pragma unroll
                    for (int h2 = 0; h2 < 2; ++h2) {
                        typedef float f2v __attribute__((ext_vector_type(2)));
                        const f2v zero2 = (f2v){0.f, 0.f};
                        const f2v w0a = (!MASK || hp) ? (h2 ? wa0.zw : wa0.xy) : zero2, w2a = (!MASK || hn) ? (h2 ? wa2.zw : wa2.xy) : zero2;
                        const f2v w0b = (!MASK || hp) ? (h2 ? wb0.zw : wb0.xy) : zero2, w2b = (!MASK || hn) ? (h2 ? wb2.zw : wb2.xy) : zero2;
                        const f2v ya = __builtin_elementwise_fma(h2 ? xpa.zw : xpa.xy, w0a, __builtin_elementwise_fma(h2 ? xa.zw : xa.xy, h2 ? wa1.zw : wa1.xy, __builtin_elementwise_fma(h2 ? xna.zw : xna.xy, w2a, h2 ? ba.zw : ba.xy)));
                        const f2v yb = __builtin_elementwise_fma(h2 ? xpb.zw : xpb.xy, w0b, __builtin_elementwise_fma(h2 ? xb.zw : xb.xy, h2 ? wb1.zw : wb1.xy, __builtin_elementwise_fma(h2 ? xnb.zw : xnb.xy, w2b, h2 ? bb.zw : bb.xy)));
                        const f2v pz = ya * __builtin_elementwise_fma(ya * ya, (f2v){-0.10294324f, -0.10294324f}, (f2v){-2.3022082f, -2.3022082f});
                        f2v rc; rc.x = __builtin_amdgcn_rcpf(1.0f + __builtin_amdgcn_exp2f(pz.x)); rc.y = __builtin_amdgcn_rcpf(1.0f + __builtin_amdgcn_exp2f(pz.y));
                        const f2v o2 = ya * yb * rc;
                        o[2 * h2] = o2.x; o[2 * h2 + 1] = o2.y;
                    }
                    if (MASK ? ((mst >> b) & 1u) != 0u : (q >= 1 && q <= 62)) { uint2 w; w.x = pg8::cvt_pk_bf16(o[0], o[1]); w.y = pg8::cvt_pk_bf16(o[2], o[3]); *(uint2*)(act + (size_t)tok * DFF + jc) = w; }
                    pa_prev = pa_cur; pb_prev = pb_cur; na_cur = na_next; nb_cur = nb_next;
                }
            }
        }
    }
    __device__ __forceinline__ void operator()(const pg8::f32x4 (&acc)[2][2][4][2], const pg8::Unit& u, int wr, int wc, int fr, int fq) const {
        const int j0 = u.pn * 128 + wc * 32 + 8 * fq;
        unsigned mprev = 0, mnext = 0, mst = 0;
#pragma unroll
        for (int ai = 0; ai < 2; ++ai)
#pragma unroll
            for (int m = 0; m < 4; ++m) { const int q = 16 * m + fr, tok = u.pm * 248 + 124 * ai + 62 * wr + q - 1, b = ai * 4 + m;
                const bool st = q >= 1 && q <= 62 && tok < T_TOK;
                if (st) { mst |= 1u << b; if (!seq_start(tok)) mprev |= 1u << b; if (!seq_end(tok)) mnext |= 1u << b; } }
        run<true>(acc, u, wr, wc, fr, fq, mprev, mnext, mst);
    }
};
template <class Epi>
__device__ __forceinline__ void run_gemm(LAS unsigned char* lds, const bf16_t* A, const bf16_t* Bt, int M, int N, int K, const Epi& E, int rev = 0) {
    pg8::Gemm g; g.A = A; g.Bt = Bt; g.M = M; g.N = N; g.K = K; g.ovl = Epi::OVL ? 1 : 0;
    int gx = (int)gridDim.x, bx = (int)blockIdx.x; asm volatile("" : "+s"(gx), "+s"(bx));
    pg8::StaticOrder S; S.init(M, N, gx, bx); S.rev = rev;
    pg8::gemm_phase<Epi, pg8::StaticOrder, false>((PG8_LAS unsigned char*)lds, g, S, E, nullptr);
}

#define HD_INLINE __device__ __forceinline__
#define DEV_FN __device__ __forceinline__
#define LDS_F2 LAS cf2*
#define FFT_ASM_CMUL 1
#define NTHR 512
#define PADI(i) ((i) + ((i) >> 5))
#define FOR_TID for (int tid = (int)TIDX, once_ = 1; once_; once_ = 0)
#define SYNC __syncthreads()
#define BREV32(x) __brev(x)
#define CIS_REV(fr, c, s) do { const float f_ = (fr); c = __builtin_amdgcn_cosf(f_); s = __builtin_amdgcn_sinf(f_); } while (0)
HD_INLINE unsigned rev4(unsigned k, int S) {
    unsigned v = BREV32(k) >> (32 - 2 * S);
    return ((v & 0xAAAAAAAAu) >> 1) | ((v & 0x55555555u) << 1);
}
HD_INLINE cf2 mkf2(float a, float b) { cf2 r; r.x = a; r.y = b; return r; }
#ifdef FFT_ASM_CMUL
HD_INLINE cf2 cmul(cf2 a, cf2 b) {
    cf2 t, d;
    asm("v_pk_mul_f32 %0, %1, %2 op_sel:[0,0] op_sel_hi:[0,1]" : "=v"(t) : "v"(a), "v"(b));
    asm("v_pk_fma_f32 %0, %1, %2, %3 op_sel:[1,1,0] op_sel_hi:[1,0,1] neg_lo:[1,0,0]" : "=v"(d) : "v"(a), "v"(b), "v"(t));
    return d;
}
HD_INLINE cf2 cmul_g(cf2 a, cf2 b) {
    cf2 t, d;
    asm("s_nop 1\n\tv_pk_mul_f32 %0, %1, %2 op_sel:[0,0] op_sel_hi:[0,1]" : "=v"(t) : "v"(a), "v"(b));
    asm("v_pk_fma_f32 %0, %1, %2, %3 op_sel:[1,1,0] op_sel_hi:[1,0,1] neg_lo:[1,0,0]" : "=v"(d) : "v"(a), "v"(b), "v"(t));
    return d;
}
HD_INLINE cf2 cmulc_g(cf2 a, cf2 b) {
    cf2 t, d;
    asm("s_nop 1\n\tv_pk_mul_f32 %0, %1, %2 op_sel:[0,0] op_sel_hi:[0,1] neg_hi:[0,1]" : "=v"(t) : "v"(a), "v"(b));
    asm("v_pk_fma_f32 %0, %1, %2, %3 op_sel:[1,1,0] op_sel_hi:[1,0,1]" : "=v"(d) : "v"(a), "v"(b), "v"(t));
    return d;
}
#define cmulc cmulc_g
#else
HD_INLINE cf2 cmul(cf2 a, cf2 b) { return mkf2(a.x * b.x - a.y * b.y, a.x * b.y + a.y * b.x); }
HD_INLINE cf2 cmulc(cf2 a, cf2 b) { return mkf2(a.x * b.x + a.y * b.y, a.y * b.x - a.x * b.y); }
#define cmul_g cmul
#endif

HD_INLINE void bf4_fwd(cf2& a0, cf2& a1, cf2& a2, cf2& a3) {
    const cf2 t0 = a0 + a2, t1 = a0 - a2, t2 = a1 + a3, d = a1 - a3; const cf2 t3 = mkf2(d.y, -d.x);
    a0 = t0 + t2; a1 = t1 + t3; a2 = t0 - t2; a3 = t1 - t3;
}
HD_INLINE void bf4_inv(cf2& b0, cf2& b1, cf2& b2, cf2& b3) {
    const cf2 t0 = b0 + b2, t1 = b0 - b2, t2 = b1 + b3, d = b1 - b3; const cf2 t3 = mkf2(-d.y, d.x);
    b0 = t0 + t2; b1 = t1 + t3; b2 = t0 - t2; b3 = t1 - t3;
}
#define W16C(k) ((k) == 0 ? 1.0f : (k) == 1 ? 0.9238795325112867f : (k) == 2 ? 0.7071067811865476f : (k) == 3 ? 0.3826834323650898f : (k) == 4 ? 0.0f : (k) == 6 ? -0.7071067811865476f :   -0.9238795325112867f)
#define W16S(k) ((k) == 0 ? 0.0f : (k) == 1 ? 0.3826834323650898f : (k) == 2 ? 0.7071067811865476f : (k) == 3 ? 0.9238795325112867f : (k) == 4 ? 1.0f : (k) == 6 ? 0.7071067811865476f :   -0.3826834323650898f)
template <int S, int NSEQ, bool ZIN = false>
DEV_FN void fft_fwd2(LDS_F2 X) {
    constexpr int M = 1 << (2 * S), MP = M + (M >> 5), NG = NSEQ * (M >> 4);
#pragma unroll 1
    for (int pr = 0; pr < S / 2; ++pr) {
        const int s = 2 * pr, n = M >> (2 * s), q = n >> 2, q2 = q >> 2;
        const bool lin = (q2 & 31) == 0; const int sq = q + (q >> 5), sq2 = q2 + (q2 >> 5);
        const float invn = 1.0f / (float)n;
        FOR_TID {
#pragma unroll 2
            for (int gi = tid; gi < NG; gi += NTHR) {
                const int seq = gi / (M >> 4), g = gi - seq * (M >> 4), j2 = g & (q2 - 1), base = ((g - j2) << 4) + j2;
                LDS_F2 Xs = X + seq * MP;
                cf2 a[4][4];
                const int pb = lin ? PADI(base) : base;
#define FIDX(r, r2) (lin ? pb + (r) * sq + (r2) * sq2 : PADI(base + (r) * q + (r2) * q2))
#pragma unroll
                for (int r = 0; r < 4; ++r)
#pragma unroll
                    for (int r2 = 0; r2 < 4; ++r2) a[r][r2] = (ZIN && pr == 0 && r >= 2) ? mkf2(0.f, 0.f) : Xs[FIDX(r, r2)];
                float c1, s1; CIS_REV((float)j2 * invn, c1, s1);
                const cf2 t1 = mkf2(c1, -s1), t2 = cmul_g(t1, t1), t3 = cmul_g(t2, t1), t4 = cmul(t2, t2), t8 = cmul(t4, t4), t12 = cmul(t8, t4);
#pragma unroll
                for (int r2 = 0; r2 < 4; ++r2) {
                    bf4_fwd(a[0][r2], a[1][r2], a[2][r2], a[3][r2]);
                    a[1][r2] = r2 == 0 ? cmul_g(a[1][r2], t1) : cmul(a[1][r2], cmul_g(t1, mkf2(W16C(r2), -W16S(r2))));
                    a[2][r2] = cmul(a[2][r2], r2 == 0 ? t2 : cmul(t2, mkf2(W16C(2 * r2), -W16S(2 * r2))));
                    a[3][r2] = cmul(a[3][r2], r2 == 0 ? t3 : cmul(t3, mkf2(W16C(3 * r2), -W16S(3 * r2))));
                }
#pragma unroll
                for (int r = 0; r < 4; ++r) {
                    bf4_fwd(a[r][0], a[r][1], a[r][2], a[r][3]);
                    a[r][1] = cmul(a[r][1], t4); a[r][2] = cmul(a[r][2], t8); a[r][3] = cmul(a[r][3], t12);
                }
#pragma unroll
                for (int r = 0; r < 4; ++r)
#pragma unroll
                    for (int r2 = 0; r2 < 4; ++r2) Xs[FIDX(r, r2)] = a[r][r2];
            }
        }
        SYNC;
    }
    if (S & 1) {
        FOR_TID {
#pragma unroll 4
            for (int gi = tid; gi < NSEQ * (M >> 2); gi += NTHR) {
                const int seq = gi / (M >> 2), b = gi - seq * (M >> 2);
                LDS_F2 Xs = X + seq * MP;
                const int p4 = PADI(4 * b);
                cf2 a0 = Xs[p4], a1 = Xs[p4 + 1], a2 = Xs[p4 + 2], a3 = Xs[p4 + 3];
                bf4_fwd(a0, a1, a2, a3);
                Xs[p4] = a0; Xs[p4 + 1] = a1; Xs[p4 + 2] = a2; Xs[p4 + 3] = a3;
            }
        }
        SYNC;
    }
}
template <int S, int NSEQ, bool HOUT = false>
DEV_FN void fft_inv2(LDS_F2 X) {
    constexpr int M = 1 << (2 * S), MP = M + (M >> 5), NG = NSEQ * (M >> 4);
    if (S & 1) {
        FOR_TID {
#pragma unroll 4
            for (int gi = tid; gi < NSEQ * (M >> 2); gi += NTHR) {
                const int seq = gi / (M >> 2), b = gi - seq * (M >> 2);
                LDS_F2 Xs = X + seq * MP;
                const int p4 = PADI(4 * b);
                cf2 a0 = Xs[p4], a1 = Xs[p4 + 1], a2 = Xs[p4 + 2], a3 = Xs[p4 + 3];
                bf4_inv(a0, a1, a2, a3);
                Xs[p4] = a0; Xs[p4 + 1] = a1; Xs[p4 + 2] = a2; Xs[p4 + 3] = a3;
            }
        }
        SYNC;
    }
#pragma unroll 1
    for (int pr = S / 2 - 1; pr >= 0; --pr) {
        const int s = 2 * pr, n = M >> (2 * s), q = n >> 2, q2 = q >> 2;
        const bool lin = (q2 & 31) == 0; const int sq = q + (q >> 5), sq2 = q2 + (q2 >> 5);
        const float invn = 1.0f / (float)n;
        FOR_TID {
#pragma unroll 2
            for (int gi = tid; gi < NG; gi += NTHR) {
                const int seq = gi / (M >> 4), g = gi - seq * (M >> 4), j2 = g & (q2 - 1), base = ((g - j2) << 4) + j2;
                LDS_F2 Xs = X + seq * MP;
                cf2 a[4][4];
                const int pb = lin ? PADI(base) : base;
#pragma unroll
                for (int r = 0; r < 4; ++r)
#pragma unroll
                    for (int r2 = 0; r2 < 4; ++r2) a[r][r2] = Xs[FIDX(r, r2)];
                float c1, s1; CIS_REV((float)j2 * invn, c1, s1);
                const cf2 t1 = mkf2(c1, s1), t2 = cmul_g(t1, t1), t3 = cmul_g(t2, t1), t4 = cmul(t2, t2), t8 = cmul(t4, t4), t12 = cmul(t8, t4);
#pragma unroll
                for (int r = 0; r < 4; ++r) {
                    a[r][1] = cmul(a[r][1], t4); a[r][2] = cmul(a[r][2], t8); a[r][3] = cmul(a[r][3], t12);
                    bf4_inv(a[r][0], a[r][1], a[r][2], a[r][3]);
                }
#pragma unroll
                for (int r2 = 0; r2 < 4; ++r2) {
                    a[1][r2] = r2 == 0 ? cmul_g(a[1][r2], t1) : cmul(a[1][r2], cmul_g(t1, mkf2(W16C(r2), W16S(r2))));
                    a[2][r2] = cmul(a[2][r2], r2 == 0 ? t2 : cmul(t2, mkf2(W16C(2 * r2), W16S(2 * r2))));
                    a[3][r2] = cmul(a[3][r2], r2 == 0 ? t3 : cmul(t3, mkf2(W16C(3 * r2), W16S(3 * r2))));
                    bf4_inv(a[0][r2], a[1][r2], a[2][r2], a[3][r2]);
                }
#pragma unroll
                for (int r = 0; r < 4; ++r)
#pragma unroll
                    for (int r2 = 0; r2 < 4; ++r2) if (!(HOUT && pr == 0 && r >= 2)) Xs[FIDX(r, r2)] = a[r][r2];
            }
        }
        SYNC;
    }
}
DEV_FN void spec_store(LDS_F2 X, int S, cf2* Kp) {
    const int M = 1 << (2 * S);
    FOR_TID {
        for (int pp = tid; pp < (M >> 1); pp += NTHR) {
            const int p = ((pp >> 1) << 2) + (pp & 1);
            if (p == 0) {
                const cf2 c0 = X[PADI(0)]; Kp[0] = mkf2(c0.x + c0.y, c0.x - c0.y);
                const cf2 ch = X[PADI(2)]; Kp[2] = mkf2(ch.x, -ch.y);
            } else {
                const unsigned k = rev4((unsigned)p, S), pm = rev4((unsigned)(M - (int)k), S);
                const cf2 ck = X[PADI(p)], cm = X[PADI((int)pm)];
                const cf2 P = mkf2(0.5f * (ck.x + cm.x), 0.5f * (ck.y - cm.y));
                const cf2 O = mkf2(0.5f * (ck.y + cm.y), -0.5f * (ck.x - cm.x));
                float c, s; CIS_REV((float)k / (float)(2 * M), c, s);
                const cf2 Q = cmul_g(O, mkf2(c, -s));
                Kp[p] = mkf2(P.x + Q.x, P.y + Q.y);
                Kp[pm] = mkf2(P.x - Q.x, -(P.y - Q.y));
            }
        }
    }
    SYNC;
}
DEV_FN void spec_mul(LDS_F2 X0, int S, const cf2* Kp, int nseq = 1) {
    const int M = 1 << (2 * S);
    constexpr int G = 4;
    FOR_TID {
        if (tid < nseq) {
            LDS_F2 X = X0 + tid * (M + (M >> 5));
            const cf2 c0 = X[PADI(0)], k0 = Kp[0];
            const float y0 = (c0.x + c0.y) * k0.x, ym = (c0.x - c0.y) * k0.y;
            X[PADI(0)] = mkf2(0.5f * (y0 + ym), 0.5f * (y0 - ym));
            const cf2 ch = X[PADI(2)], kh = Kp[2];
            const cf2 yh = cmul(mkf2(ch.x, -ch.y), kh);
            X[PADI(2)] = mkf2(yh.x, -yh.y);
        }
        for (int pq0 = tid; pq0 < nseq * (M >> 1); pq0 += G * NTHR) {
            cf2 ck[G], cm[G], kk[G], km[G]; int ip[G], im[G], sqo[G]; float fk[G]; bool sp[G];
#pragma unroll
            for (int u = 0; u < G; ++u) {
                const int pq = pq0 + u * NTHR, sq_ = pq / (M >> 1), pp = pq - sq_ * (M >> 1);
                sp[u] = (pp == 0);
                const int p = sp[u] ? 1 : ((pp >> 1) << 2) + (pp & 1);
                const unsigned k = rev4((unsigned)p, S), pm = rev4((unsigned)(M - (int)k), S);
                ip[u] = p; im[u] = (int)pm; sqo[u] = sq_ * (M + (M >> 5)); fk[u] = (float)k / (float)(2 * M);
                ck[u] = X0[sqo[u] + PADI(p)]; cm[u] = X0[sqo[u] + PADI((int)pm)]; kk[u] = Kp[p]; km[u] = Kp[pm];
            }
#pragma unroll
            for (int u = 0; u < G; ++u) {
                const cf2 P = mkf2(0.5f * (ck[u].x + cm[u].x), 0.5f * (ck[u].y - cm[u].y));
                const cf2 O = mkf2(0.5f * (ck[u].y + cm[u].y), -0.5f * (ck[u].x - cm[u].x));
                float c, s; CIS_REV(fk[u], c, s);
                const cf2 Wk = mkf2(c, -s);
                const cf2 Q = cmul_g(O, Wk);
                const cf2 xk = mkf2(P.x + Q.x, P.y + Q.y), xm = mkf2(P.x - Q.x, -(P.y - Q.y));
                const cf2 yk = cmul(xk, kk[u]), ym = cmul(xm, km[u]);
                const cf2 Ye = mkf2(0.5f * (yk.x + ym.x), 0.5f * (yk.y - ym.y));
                const cf2 Yd = mkf2(0.5f * (yk.x - ym.x), 0.5f * (yk.y + ym.y));
                const cf2 Yo = cmulc(Yd, Wk);
                ck[u] = mkf2(Ye.x - Yo.y, Ye.y + Yo.x); cm[u] = mkf2(Ye.x + Yo.y, -Ye.y + Yo.x);
            }
#pragma unroll
            for (int u = 0; u < G; ++u) if (!sp[u]) { X0[sqo[u] + PADI(ip[u])] = ck[u]; X0[sqo[u] + PADI(im[u])] = cm[u]; }
        }
    }
    SYNC;
}
__device__ void ph_setup(const P& p) {
    const int gid = blockIdx.x * 512 + TIDX;
    if (gid < 2 * D_HG) {
        const int dir = gid / D_HG, c = gid % D_HG;
        float v[NLAYER], mx = -1e30f;
#pragma unroll
        for (int l = 0; l < NLAYER; ++l) { v[l] = p.in[19][(size_t)(dir * NLAYER + l) * D_HG + c]; mx = fmaxf(mx, v[l]); }
        float s = 0.f;
#pragma unroll
        for (int l = 0; l < NLAYER; ++l) { v[l] = expf(v[l] - mx); s += v[l]; }
        float* lbs = (float*)(p.ws + OFF_SMALL);
        float cum = 0.f;
#pragma unroll
        for (int l = 0; l < NLAYER; ++l) { if (l > 0) cum += v[l] / s; lbs[(size_t)(dir * NLAYER + l) * D_HG + c] = cum; }
    }
}
__device__ void ph_copy_params(const P& p) {
    float* pb = (float*)(p.ws + OFF_PB);
    const int g = blockIdx.x * 512 + TIDX, gs = gridDim.x * 512;
    for (int k = g; k < 4096; k += gs) pb[0 + k] = p.in[2][k];
    for (int k = g; k < 4096; k += gs) pb[4096 + k] = p.in[3][k];
    for (int k = g; k < 4096; k += gs) pb[8192 + k] = p.in[4][k];
    for (int k = g; k < 4096; k += gs) pb[12288 + k] = p.in[5][k];
    for (int k = g; k < 18432; k += gs) pb[16384 + k] = p.in[7][k];
    for (int k = g; k < 6144; k += gs) pb[34816 + k] = p.in[8][k];
    for (int k = g; k < 8448; k += gs) pb[40960 + k] = p.in[9][k];
    for (int k = g; k < 256; k += gs) pb[49408 + k] = p.in[10][k];
    for (int k = g; k < 16384; k += gs) pb[49664 + k] = p.in[11][k];
    for (int k = g; k < 256; k += gs) pb[66048 + k] = p.in[12][k];
    for (int k = g; k < 16384; k += gs) pb[66304 + k] = p.in[13][k];
    for (int k = g; k < 256; k += gs) pb[82688 + k] = p.in[14][k];
    for (int k = g; k < 262144; k += gs) pb[82944 + k] = p.in[15][k];
    for (int k = g; k < 256; k += gs) pb[345088 + k] = p.in[16][k];
    for (int k = g; k < 2048; k += gs) pb[345344 + k] = p.in[17][k];
    for (int k = g; k < 2048; k += gs) pb[347392 + k] = p.in[18][k];
    for (int k = g; k < 4096; k += gs) pb[349440 + k] = p.in[19][k];
    for (int k = g; k < 2048; k += gs) pb[353536 + k] = p.in[20][k];
    for (int k = g; k < 98304; k += gs) pb[355584 + k] = p.in[23][k];
    for (int k = g; k < 32768; k += gs) pb[453888 + k] = p.in[24][k];
}
__device__ void convert_one(const float* src, bf16_t* dst, int K, int N, LAS float* tile  , bool geglu_perm = false) {
    const int tiles_n = N / 64, ntiles = (K / 64) * tiles_n, tid = TIDX;
    const int r0 = tid >> 4, c4 = (tid & 15) * 4;
    nf4 nx0 = (nf4){0.f, 0.f, 0.f, 0.f}, nx1 = nx0;
    { const int it = blockIdx.x; if (it < ntiles) { const int k0 = (it / tiles_n) * 64, n0 = (it % tiles_n) * 64;
        nx0 = *(const nf4*)(src + (size_t)(k0 + r0) * N + n0 + c4); nx1 = *(const nf4*)(src + (size_t)(k0 + r0 + 32) * N + n0 + c4); } }
    for (int it = blockIdx.x; it < ntiles; it += gridDim.x) {
        const int k0 = (it / tiles_n) * 64, n0 = (it % tiles_n) * 64;
        tile[r0 * 65 + c4] = nx0.x; tile[r0 * 65 + c4 + 1] = nx0.y; tile[r0 * 65 + c4 + 2] = nx0.z; tile[r0 * 65 + c4 + 3] = nx0.w;
        tile[(r0 + 32) * 65 + c4] = nx1.x; tile[(r0 + 32) * 65 + c4 + 1] = nx1.y; tile[(r0 + 32) * 65 + c4 + 2] = nx1.z; tile[(r0 + 32) * 65 + c4 + 3] = nx1.w;
        { const int it2 = it + (int)gridDim.x; if (it2 < ntiles) { const int k2 = (it2 / tiles_n) * 64, n2 = (it2 % tiles_n) * 64;
            nx0 = *(const nf4*)(src + (size_t)(k2 + r0) * N + n2 + c4); nx1 = *(const nf4*)(src + (size_t)(k2 + r0 + 32) * N + n2 + c4); } }
        LBAR();
        { const int n = tid >> 3, ks = (tid & 7) * 8; int nr = n0 + n;
          if (geglu_perm) nr = nr < DFF ? (nr >> 7) * 256 + (nr & 127) : ((nr - DFF) >> 7) * 256 + 128 + ((nr - DFF) & 127);
          nu4 w;
          w.x = pack_bf2(tile[(ks + 0) * 65 + n], tile[(ks + 1) * 65 + n]); w.y = pack_bf2(tile[(ks + 2) * 65 + n], tile[(ks + 3) * 65 + n]);
          w.z = pack_bf2(tile[(ks + 4) * 65 + n], tile[(ks + 5) * 65 + n]); w.w = pack_bf2(tile[(ks + 6) * 65 + n], tile[(ks + 7) * 65 + n]);
          *(nu4*)(dst + (size_t)nr * K + k0 + ks) = w; }
        LBAR();
    }
}
__device__ void ph_convert_w(const P& p, int l, LAS unsigned char* lds) {
    LAS float* tile = (LAS float*)lds;
    convert_one(p.in[6] + (size_t)l * DM * D_IN, (bf16_t*)(p.ws + OFF_W_IN), DM, D_IN, tile);
    convert_one(p.in[21] + (size_t)l * DM * DM, (bf16_t*)(p.ws + OFF_W_OUT), DM, DM, tile);
    convert_one(p.in[22] + (size_t)l * DM * 2 * DFF, (bf16_t*)(p.ws + OFF_W_UP), DM, 2 * DFF, tile, true);
    convert_one(p.in[25] + (size_t)l * DFF * DM, (bf16_t*)(p.ws + OFF_W_DN), DFF, DM, tile);
    { const float* w4 = p.in[15] + (size_t)l * 64 * 1024; bf16_t* w4t = (bf16_t*)(p.ws + OFF_W4T);
      for (int idx = blockIdx.x * 512 + TIDX; idx < 65536; idx += gridDim.x * 512) { const int o = idx >> 6, f = idx & 63; w4t[idx] = f2bf(w4[f * 1024 + o]); } }
}
__device__ __forceinline__ bf16_t* abuf_row(const P& p, int t) { return (bf16_t*)(p.ws + OFF_ABUF) + (size_t)(t + APAD) * DM; }
__device__ void ph_rmsnorm_in(const P& p, int l) {
    const int lane = TIDX & 63, wv = TIDX >> 6;
    const float* gain = p.in[2] + (size_t)l * DM;
    for (int t = blockIdx.x * 8 + wv; t < T_TOK; t += gridDim.x * 8) {
        const float* xr = x_src_row(p, l, t);
        float4 v[4]; float ss = 0.f;
#pragma unroll
        for (int i = 0; i < 4; ++i) { v[i] = *(const float4*)(xr + lane * 4 + 256 * i); ss += v[i].x * v[i].x + v[i].y * v[i].y + v[i].z * v[i].z + v[i].w * v[i].w; }
        ss = wave_sum(ss);
        const float r = rsqrtf(ss * (1.0f / DM) + 1e-6f);
        bf16_t* hr = abuf_row(p, t);
#pragma unroll
        for (int i = 0; i < 4; ++i) { const float4 g = *(const float4*)(gain + lane * 4 + 256 * i);
            uint2 w; w.x = pack_bf2(v[i].x * r * g.x, v[i].y * r * g.y); w.y = pack_bf2(v[i].z * r * g.z, v[i].w * r * g.w);
            *(uint2*)(hr + lane * 4 + 256 * i) = w; }
    }
}
constexpr int NRR = 4;
__device__ __forceinline__ bf16_t* xb_buf(const P& p, bool r6) { return r6 ? (bf16_t*)(p.ws + OFF_R6) : (bf16_t*)((unsigned char*)p.out + 64 * MiB); }
__device__ void ph_norm_resid(const P& p, int l, int which) {
    const int lane = TIDX & 63, wv = TIDX >> 6;
    const float* gpost = (which == 0 ? PRM(p, norm_mix_post) : PRM(p, norm_ffn_post)) + (size_t)l * DM;
    const bool has_next = (which == 0) || (l + 1 < NLAYER);
    const float* gnext = which == 0 ? PRM(p, norm_ffn_pre) + (size_t)l * DM : PRM(p, norm_mix_pre) + (size_t)(has_next ? l + 1 : l) * DM;
    const bf16_t* Y = (const bf16_t*)(p.ws + OFF_MIX);
    const bool in_f32 = (l == 0 && which == 0), out_f32 = (l == NLAYER - 1 && which == 1);
    const bf16_t* xin = xb_buf(p, l == NLAYER - 1 && which == 1);
    bf16_t* xout = xb_buf(p, l == NLAYER - 1 && which == 0);
    nf4 gp[4], gn[4];
#pragma unroll
    for (int i = 0; i < 4; ++i) { gp[i] = *(const nf4*)(gpost + lane * 4 + 256 * i); gn[i] = *(const nf4*)(gnext + lane * 4 + 256 * i); }
    for (int t0 = (blockIdx.x * 8 + wv) * NRR; t0 < T_TOK; t0 += gridDim.x * 8 * NRR) {
        nf4 x[NRR][4]; nu2 yw[NRR][4];
#pragma unroll
        for (int rr = 0; rr < NRR; ++rr) { const bf16_t* yr = Y + (size_t)(t0 + rr) * DM;
            if (in_f32) { const float* xr = x_src_row(p, 0, t0 + rr);
#pragma unroll
                for (int i = 0; i < 4; ++i) x[rr][i] = *(const nf4*)(xr + lane * 4 + 256 * i);
            } else { const bf16_t* xr = xin + (size_t)(t0 + rr) * DM;
#pragma unroll
                for (int i = 0; i < 4; ++i) { const nu2 w = *(const nu2*)(xr + lane * 4 + 256 * i);
                    x[rr][i].x = __uint_as_float(w.x << 16); x[rr][i].y = __uint_as_float(w.x & 0xffff0000u); x[rr][i].z = __uint_as_float(w.y << 16); x[rr][i].w = __uint_as_float(w.y & 0xffff0000u); } }
#pragma unroll
            for (int i = 0; i < 4; ++i) yw[rr][i] = *(const nu2*)(yr + lane * 4 + 256 * i); }
#pragma unroll
        for (int rr = 0; rr < NRR; ++rr) {
            const int t = t0 + rr;
            nf4 y[4]; float ss = 0.f;
#pragma unroll
            for (int i = 0; i < 4; ++i) { const nu2 w = yw[rr][i];
                y[i].x = __uint_as_float(w.x << 16); y[i].y = __uint_as_float(w.x & 0xffff0000u); y[i].z = __uint_as_float(w.y << 16); y[i].w = __uint_as_float(w.y & 0xffff0000u);
                ss += y[i].x * y[i].x + y[i].y * y[i].y + y[i].z * y[i].z + y[i].w * y[i].w; }
            ss = wave_sum(ss);
            const float r = rsqrtf(ss * (1.0f / DM) + 1e-6f);
            float s2 = 0.f;
#pragma unroll
            for (int i = 0; i < 4; ++i) { nf4 xv = x[rr][i];
                xv.x += y[i].x * r * gp[i].x; xv.y += y[i].y * r * gp[i].y; xv.z += y[i].z * r * gp[i].z; xv.w += y[i].w * r * gp[i].w;
                s2 += xv.x * xv.x + xv.y * xv.y + xv.z * xv.z + xv.w * xv.w;
                x[rr][i] = xv;
                if (out_f32) *(nf4*)(p.out + (size_t)t * DM + lane * 4 + 256 * i) = xv;
                else { nu2 w; w.x = pack_bf2(xv.x, xv.y); w.y = pack_bf2(xv.z, xv.w); *(nu2*)(xout + (size_t)t * DM + lane * 4 + 256 * i) = w; } }
            if (has_next) {
                s2 = wave_sum(s2);
                const float r2 = rsqrtf(s2 * (1.0f / DM) + 1e-6f);
                bf16_t* hr = abuf_row(p, t);
#pragma unroll
                for (int i = 0; i < 4; ++i) { const nf4 xv = x[rr][i];
                    nu2 w; w.x = pack_bf2(xv.x * r2 * gn[i].x, xv.y * r2 * gn[i].y); w.y = pack_bf2(xv.z * r2 * gn[i].z, xv.w * r2 * gn[i].w);
                    *(nu2*)(hr + lane * 4 + 256 * i) = w; }
            }
        }
    }
}
__device__ void ph_filter(const P& p, int l, LAS unsigned char* lds) {
    LAS float* feats = (LAS float*)lds;
    LAS float* ha = feats + 16 * 36;
    LAS float* hb = ha + 16 * 64;
    LAS float* w1s = hb + 16 * 64;
    LAS float* w2s = w1s + 33 * 64;
    LAS float* w3s = w2s + 64 * 64;
    LAS bf16_t* h3b = (LAS bf16_t*)(w3s + 64 * 64);
    const int tid = TIDX;
    const float* w1 = PRM(p, f_w1) + (size_t)l * 33 * 64; const float* b1 = PRM(p, f_b1) + (size_t)l * 64;
    const float* w2 = PRM(p, f_w2) + (size_t)l * 64 * 64; const float* b2 = PRM(p, f_b2) + (size_t)l * 64;
    const float* w3 = PRM(p, f_w3) + (size_t)l * 64 * 64; const float* b3 = PRM(p, f_b3) + (size_t)l * 64;
    const float* w4 = PRM(p, f_w4) + (size_t)l * 64 * 1024; const float* fq = PRM(p, f_freq) + (size_t)l * 64;
    float* kt = (float*)(p.ws + OFF_KT);
    for (int i = tid; i < 33 * 64; i += 512) w1s[i] = w1[i];
    for (int i = tid; i < 64 * 64; i += 512) { w2s[i] = w2[i]; w3s[i] = w3[i]; }
    const int j = tid & 63;
    const float fqj = fq[j], b1j = b1[j], b2j = b2[j], b3j = b3[j];
    pg8::bf16x8 bfrag[8][2];
    { const bf16_t* w4t = (const bf16_t*)(p.ws + OFF_W4T); const int lane = tid & 63, w = tid >> 6;
#pragma unroll
      for (int nt = 0; nt < 8; ++nt)
#pragma unroll
          for (int ks = 0; ks < 2; ++ks) bfrag[nt][ks] = *(const pg8::bf16x8*)(w4t + (size_t)(128 * w + 16 * nt + (lane & 15)) * 64 + 32 * ks + 8 * (lane >> 4)); }
    __syncthreads();
    const int nitems = (L_BIG + L_SML) / 16;
    for (int it = blockIdx.x; it < nitems; it += gridDim.x) {
        const bool big = it < L_BIG / 16; const int L = big ? L_BIG : L_SML; const int pos0 = (big ? it : it - L_BIG / 16) * 16;
        float* ktc = kt + (big ? 0 : (size_t)512 * 2 * L_BIG);
        for (int idx = tid; idx < 16 * 33; idx += 512) {
            const int pp = idx / 33, f = idx % 33; const int pos = pos0 + pp;
            const float tt = (float)pos / (float)(L - 1), ang = (6.283185307179586f / (float)L) * (float)pos;
            float v;
            if (f == 0) v = tt;
            else { const int bi = (f - 1) & 15; const float band = 1e-4f + (float)bi * ((15.0f - 1e-4f) / 15.0f); v = f <= 16 ? cosf(band * ang) : -sinf(band * ang); }
            feats[pp * 36 + f] = v;
        }
        __syncthreads();
#pragma unroll
        for (int h2 = 0; h2 < 2; ++h2) { const int pp = (tid >> 6) + 8 * h2; float a = b1j;
            for (int f = 0; f < 33; ++f) a += feats[pp * 36 + f] * w1s[f * 64 + j];
            ha[pp * 64 + j] = __sinf(fqj * a); }
        __syncthreads();
#pragma unroll
        for (int h2 = 0; h2 < 2; ++h2) { const int pp = (tid >> 6) + 8 * h2; float a = b2j;
#pragma unroll 4
            for (int f4 = 0; f4 < 16; ++f4) { const nf4 hv = *(const LAS nf4*)(ha + pp * 64 + 4 * f4);
                a += hv.x * w2s[(4 * f4) * 64 + j] + hv.y * w2s[(4 * f4 + 1) * 64 + j] + hv.z * w2s[(4 * f4 + 2) * 64 + j] + hv.w * w2s[(4 * f4 + 3) * 64 + j]; }
            hb[pp * 64 + j] = __sinf(fqj * a); }
        __syncthreads();
#pragma unroll
        for (int h2 = 0; h2 < 2; ++h2) { const int pp = (tid >> 6) + 8 * h2; float a = b3j;
#pragma unroll 4
            for (int f4 = 0; f4 < 16; ++f4) { const nf4 hv = *(const LAS nf4*)(hb + pp * 64 + 4 * f4);
                a += hv.x * w3s[(4 * f4) * 64 + j] + hv.y * w3s[(4 * f4 + 1) * 64 + j] + hv.z * w3s[(4 * f4 + 2) * 64 + j] + hv.w * w3s[(4 * f4 + 3) * 64 + j]; }
            h3b[pp * 72 + j] = f2bf(__sinf(fqj * a)); }
        __syncthreads();
        {
            const int lane = tid & 63, w = tid >> 6, r16 = lane & 15, kg = lane >> 4;
            pg8::f32x4 acc[8];
#pragma unroll
            for (int nt = 0; nt < 8; ++nt) acc[nt] = (pg8::f32x4){0.f, 0.f, 0.f, 0.f};
            pg8::bf16x8 af[2];
#pragma unroll
            for (int ks = 0; ks < 2; ++ks) af[ks] = *(const LAS pg8::bf16x8*)(h3b + r16 * 72 + 32 * ks + 8 * kg);
#pragma unroll
            for (int nt = 0; nt < 8; ++nt)
#pragma unroll
                for (int ks = 0; ks < 2; ++ks) acc[nt] = __builtin_amdgcn_mfma_f32_16x16x32_bf16(af[ks], bfrag[nt][ks], acc[nt], 0, 0, 0);
            const float invl = 1.0f / (float)(L - 1);
            const float dstep = (15.350567286626972f - 3.0701134573253945f) / 511.0f;
            float tt[4];
#pragma unroll
            for (int i = 0; i < 4; ++i) tt[i] = (float)(pos0 + 4 * kg + i) * invl;
#pragma unroll
            for (int nt = 0; nt < 8; ++nt) { const int o = 128 * w + 16 * nt + r16, dir = o >> 9, c = o & 511;
                const float dl = 3.0701134573253945f + (float)c * dstep;
                nf4 v;
#pragma unroll
                for (int i = 0; i < 4; ++i) v[i] = acc[nt][i] * __expf(-tt[i] * dl);
                *(nf4*)(ktc + (size_t)(c * 2 + dir) * L + pos0 + 4 * kg) = v; }
        }
        __syncthreads();
    }
}
__device__ void ph_hy_prep(const P& p, int l, LAS unsigned char* lds) {
    constexpr int RS = 3 * 128 + 8;
    LAS bf16_t* raw = (LAS bf16_t*)lds;
    LAS bf16_t* ox = (LAS bf16_t*)(lds + 52224);
    LAS bf16_t* oz = ox + 128 * 72;
    const bf16_t* hy = (const bf16_t*)(p.ws + OFF_HYRAW);
    bf16_t* x0t = (bf16_t*)(p.ws + OFF_X0T); bf16_t* zt = (bf16_t*)(p.ws + OFF_ZT);
    const float* cw = PRM(p, hy_conv_w) + (size_t)l * 3 * 1536; const float* cb = PRM(p, hy_conv_b) + (size_t)l * 1536;
    const int tid = TIDX, nitems = (T_TOK / 64) * 4;
    for (int it = blockIdx.x; it < nitems; it += gridDim.x) {
        const int t0 = (it >> 2) * 64, c0 = (it & 3) * 128;
        for (int idx = tid; idx < 66 * 48; idx += 512) {
            const int row = idx / 48, rem = idx - row * 48, a = rem >> 4, pc = rem & 15;
            int t = t0 - 1 + row; t = t < 0 ? 0 : (t >= T_TOK ? T_TOK - 1 : t);
            *(LAS nu4*)(raw + row * RS + a * 128 + pc * 8) = *(const nu4*)(hy + (size_t)t * 1536 + a * 512 + c0 + pc * 8);
        }
        __syncthreads();
        {
            const int c = tid & 127, tq = tid >> 7;
            float wv[3][3], bv[3];
#pragma unroll
            for (int a = 0; a < 3; ++a) { bv[a] = cb[a * 512 + c0 + c];
#pragma unroll
                for (int k = 0; k < 3; ++k) wv[a][k] = cw[k * 1536 + a * 512 + c0 + c]; }
            float xm[3], xc[3];
#pragma unroll
            for (int a = 0; a < 3; ++a) { xm[a] = bf2f(raw[(tq * 16) * RS + a * 128 + c]); xc[a] = bf2f(raw[(tq * 16 + 1) * RS + a * 128 + c]); }
            unsigned px = 0, pz = 0;
#pragma unroll
            for (int j = 0; j < 16; ++j) {
                const int tt = tq * 16 + j, t = t0 + tt;
                const bool hp = !seq_start(t), hn = !seq_end(t);
                float r[3];
#pragma unroll
                for (int a = 0; a < 3; ++a) { const float xp = bf2f(raw[(tt + 2) * RS + a * 128 + c]);
                    r[a] = (hp ? xm[a] * wv[a][0] : 0.f) + xc[a] * wv[a][1] + (hn ? xp * wv[a][2] : 0.f) + bv[a];
                    xm[a] = xc[a]; xc[a] = xp; }
                const unsigned bx = f2bf(r[0]), bz = f2bf(r[1] * r[2]);
                if (j & 1) { px |= bx << 16; pz |= bz << 16;
                    *(LAS unsigned*)(ox + c * 72 + tt - 1) = px; *(LAS unsigned*)(oz + c * 72 + tt - 1) = pz; }
                else { px = bx; pz = bz; }
            }
        }
        __syncthreads();
        for (int idx = tid; idx < 128 * 16; idx += 512) {
            const int c = idx >> 4, rem = idx & 15, arr = rem >> 3, pc = rem & 7;
            const nu4 v = *(const LAS nu4*)((arr ? oz : ox) + c * 72 + pc * 8);
            *(nu4*)((arr ? zt : x0t) + (size_t)(c0 + c) * T_TOK + t0 + pc * 8) = v;
        }
        __syncthreads();
    }
}
__device__ __forceinline__ cf2 ld_f2_agent(const cf2* ptr) {
    const unsigned long long w = __hip_atomic_load((const unsigned long long*)ptr, __ATOMIC_RELAXED, __HIP_MEMORY_SCOPE_AGENT);
    return mkf2(__uint_as_float((unsigned)w), __uint_as_float((unsigned)(w >> 32)));
}
template <int S, int NSEQ>
__device__ __forceinline__ void hy_fft_job(const P& p, int l, LAS cf2* X, cf2* Ks, int c, int tbase) {
    const int tid = TIDX;
    constexpr int M = 1 << (2 * S), L = M, MP = M + (M >> 5);
    const float* kt = (const float*)(p.ws + OFF_KT);
    const bf16_t* x0t = (const bf16_t*)(p.ws + OFF_X0T); bf16_t* zt = (bf16_t*)(p.ws + OFF_ZT);
    const float* hf = kt + (S == 7 ? 0 : (size_t)512 * 2 * L_BIG) + (size_t)(c * 2) * L; const float* hb = hf + L;
#pragma unroll 4
    for (int m = tid; m < M; m += 512) {
        const int n0 = 2 * m, n1 = 2 * m + 1;
        const float a = n0 < L ? hf[n0] : (n0 == L ? 0.f : hb[2 * L - n0]);
        const float b = n1 < L ? hf[n1] : hb[2 * L - n1];
        X[PADI(m)] = mkf2(a, b);
    }
    __syncthreads();
    fft_fwd2<S, 1>(X);
    spec_store(X, S, Ks);
    __builtin_amdgcn_fence(__ATOMIC_ACQUIRE, "agent");
    asm volatile("s_waitcnt vmcnt(0)" ::: "memory");
    __syncthreads();
    const float skip = PRM(p, hy_skip)[(size_t)l * D_HY + c];
    const bf16_t* zrow = zt + (size_t)c * T_TOK + tbase; const bf16_t* xrow = x0t + (size_t)c * T_TOK + tbase;
#pragma unroll 4
    for (int idx = tid; idx < NSEQ * (M >> 1); idx += 512) {
        const int sq = idx / (M >> 1), m = idx - sq * (M >> 1);
        const unsigned w = *(const unsigned*)(zrow + sq * L + 2 * m);
        X[sq * MP + PADI(m)] = mkf2(__uint_as_float(w << 16), __uint_as_float(w & 0xffff0000u));
    }
    __syncthreads();
    fft_fwd2<S, NSEQ, true>(X);
    spec_mul(X, S, Ks, NSEQ);
    fft_inv2<S, NSEQ, true>(X);
    const float inv = 1.0f / (float)M;
    bf16_t* orow = zt + (size_t)c * T_TOK + tbase;
#pragma unroll 4
    for (int idx = tid; idx < NSEQ * (M >> 1); idx += 512) {
        const int sq = idx / (M >> 1), m = idx - sq * (M >> 1);
        const cf2 d = X[sq * MP + PADI(m)];
        const unsigned wz = *(const unsigned*)(zrow + sq * L + 2 * m), wx = *(const unsigned*)(xrow + sq * L + 2 * m);
        const float z0 = __uint_as_float(wz << 16), z1 = __uint_as_float(wz & 0xffff0000u), a0 = __uint_as_float(wx << 16), a1 = __uint_as_float(wx & 0xffff0000u);
        *(unsigned*)(orow + sq * L + 2 * m) = pack_bf2(a0 * (d.x * inv + skip * z0), a1 * (d.y * inv + skip * z1));
    }
    __syncthreads();
}
__device__ void ph_hy_fft(const P& p, int l, LAS unsigned char* lds) {
    LAS cf2* X = (LAS cf2*)lds;
    cf2* Ks = (cf2*)(p.ws + OFF_KS) + (size_t)blockIdx.x * L_BIG;
    for (int job = blockIdx.x; job < 1024; job += gridDim.x) {
        const bool big = job < 512; const int c = job & 511;
        if (big) hy_fft_job<7, 1>(p, l, X, Ks, c, 0); else hy_fft_job<6, 4>(p, l, X, Ks, c, L_BIG);
    }
}
__device__ void ph_hy_norm(const P& p, int l, LAS unsigned char* lds) {
    LAS bf16_t* tl = (LAS bf16_t*)lds;
    LAS float* red = (LAS float*)(lds + 9216);
    const bf16_t* yh = (const bf16_t*)(p.ws + OFF_ZT);
    const float* gain = PRM(p, hy_out_norm) + (size_t)l * D_HY;
    const int tid = TIDX, nitems = (T_TOK / 64) * 8;
    const int cc = tid >> 3, pc = tid & 7;
    nu4 nxt = (nu4){0u, 0u, 0u, 0u};
    { const int it = blockIdx.x; if (it < nitems) nxt = *(const nu4*)(yh + (size_t)((it & 7) * 64 + cc) * T_TOK + (it >> 3) * 64 + pc * 8); }
    for (int it = blockIdx.x; it < nitems; it += gridDim.x) {
        const int t0 = (it >> 3) * 64, c0 = (it & 7) * 64;
        *(LAS nu4*)(tl + cc * 72 + pc * 8) = nxt;
        { const int it2 = it + (int)gridDim.x; if (it2 < nitems) nxt = *(const nu4*)(yh + (size_t)((it2 & 7) * 64 + cc) * T_TOK + (it2 >> 3) * 64 + pc * 8); }
        LBAR();
        { const int tt = tid & 63, part = tid >> 6; float s = 0.f;
#pragma unroll
          for (int j = 0; j < 8; ++j) { const float v = bf2f(tl[(part * 8 + j) * 72 + tt]); s += v * v; }
          red[part * 64 + tt] = s; }
        LBAR();
        { const int tt = tid >> 3;
          float s = 0.f;
#pragma unroll
          for (int j = 0; j < 8; ++j) s += red[j * 64 + tt];
          const float r = rsqrtf(s * (1.0f / 64.0f) + 1e-6f);
          unsigned w[4];
#pragma unroll
          for (int j = 0; j < 4; ++j) { const int ca = pc * 8 + 2 * j;
              w[j] = pack_bf2(bf2f(tl[ca * 72 + tt]) * r * gain[c0 + ca], bf2f(tl[(ca + 1) * 72 + tt]) * r * gain[c0 + ca + 1]); }
          nu4 o; o.x = w[0]; o.y = w[1]; o.z = w[2]; o.w = w[3];
          *(nu4*)(abuf_row(p, t0 + tt) + c0 + pc * 8) = o; }
        LBAR();
    }
}
typedef short hbf16x8 __attribute__((ext_vector_type(8)));
typedef float hf32x16 __attribute__((ext_vector_type(16)));
constexpr int HSC = 512, HNCH = HSC / 64, HNSC = T_TOK / HSC;
constexpr int QS = 136, KS_ = 72;
constexpr int HL_QH = 0, HL_KH = HL_QH + 64 * QS * 2, HL_QT = HL_KH + 64 * QS * 2, HL_KT = HL_QT + 64 * QS * 2, HL_VT = HL_KT + 128 * KS_ * 2, HL_ST = HL_VT + 128 * KS_ * 2,
              HL_PM = HL_ST + 128 * QS * 2, HL_TOT = HL_PM + 64 * KS_ * 2, HL_EB = HL_TOT + 4 * 128 * 4, HL_END = HL_EB + 128 * 4;
constexpr int HL_OF = HL_QH, OFS = 132;
static_assert(64 * OFS * 4 <= 2 * 64 * QS * 2, "O tile must fit over Qh|Kh");
constexpr size_t OFF_HST = OFF_R6 + 32 * MiB;
constexpr size_t OFF_HAT = OFF_SMALL + 64 * 1024;

__device__ __forceinline__ hf32x16 mfma32(hbf16x8 a, hbf16x8 b, hf32x16 c) { return __builtin_amdgcn_mfma_f32_32x32x16_bf16(a, b, c, 0, 0, 0); }
__device__ __forceinline__ hbf16x8 lds_frag(const LAS unsigned char* base, int row, int stride_el, int col_el) { return *(const LAS hbf16x8*)(base + ((size_t)row * stride_el + col_el) * 2); }

typedef unsigned hu32x4 __attribute__((ext_vector_type(4)));
struct HgPre { hu32x4 f0, f1, v0, v1, q0, q1; };
template <bool FULL>
__device__ __forceinline__ void hg_fetch(const bf16_t* hg, HgPre& pre, int tokbase, int dirsign, int h, int dir) {
    const int tid = TIDX;
    { const int u = tid >> 4, seg = tid & 15;
      const bf16_t* row = hg + (size_t)(tokbase + dirsign * u) * 2560 + h * 128 + seg * 8;
      pre.f0 = *(const hu32x4*)(row + 512 + 512 * dir); pre.v0 = *(const hu32x4*)(row + 1536); if (FULL) pre.q0 = *(const hu32x4*)(row);
      const bf16_t* row1 = row + (size_t)dirsign * 32 * 2560;
      pre.f1 = *(const hu32x4*)(row1 + 512 + 512 * dir); pre.v1 = *(const hu32x4*)(row1 + 1536); if (FULL) pre.q1 = *(const hu32x4*)(row1); }
}
template <bool FULL>
__device__ __forceinline__ void hg_prep(LAS unsigned char* lds, const HgPre& pre, float lb, float& Bsum_out) {
    const int tid = TIDX, d = tid & 127, qt = tid >> 7;
    LAS float* tot = (LAS float*)(lds + HL_TOT); LAS float* eB = (LAS float*)(lds + HL_EB);
    { const int u = tid >> 4, seg = tid & 15;
      *(LAS hu32x4*)(lds + HL_KH + ((size_t)u * QS + seg * 8) * 2) = pre.f0; *(LAS hu32x4*)(lds + HL_KH + ((size_t)(u + 32) * QS + seg * 8) * 2) = pre.f1;
      *(LAS hu32x4*)(lds + HL_QH + ((size_t)u * QS + seg * 8) * 2) = pre.v0; *(LAS hu32x4*)(lds + HL_QH + ((size_t)(u + 32) * QS + seg * 8) * 2) = pre.v1;
      if (FULL) { *(LAS hu32x4*)(lds + HL_QT + ((size_t)u * QS + seg * 8) * 2) = pre.q0; *(LAS hu32x4*)(lds + HL_QT + ((size_t)(u + 32) * QS + seg * 8) * 2) = pre.q1; } }
    LBAR();
    float c[16];
    float run = 0.f;
    const float oml = 1.0f - lb;
    float zz[16];
#pragma unroll
    for (int j = 0; j < 16; ++j) zz[j] = bf2f(*(const LAS bf16_t*)(lds + HL_KH + ((size_t)(qt * 16 + j) * QS + d) * 2));
    __builtin_amdgcn_sched_barrier(0);
#pragma unroll
    for (int j = 0; j < 16; ++j) {
        const int u = qt * 16 + j;
        const float z = fmaxf(zz[j], -60.0f);
        const float f = lb + oml * __builtin_amdgcn_rcpf(1.0f + __expf(-z));
        zz[j] = 1.0f - f;
        run += __builtin_amdgcn_logf(f);
        c[j] = run;
    }
    tot[qt * 128 + d] = run;
    float vv[16], qq[16];
#pragma unroll
    for (int j = 0; j < 16; ++j) { vv[j] = __uint_as_float((unsigned)(*(const LAS bf16_t*)(lds + HL_QH + ((size_t)(qt * 16 + j) * QS + d) * 2)));
        if (FULL) qq[j] = bf2f(*(const LAS bf16_t*)(lds + HL_QT + ((size_t)(qt * 16 + j) * QS + d) * 2)); }
    LBAR();
    const float t0 = tot[d], t1 = tot[128 + d], t2 = tot[256 + d], t3 = tot[384 + d];
    const float off = qt == 0 ? 0.f : (qt == 1 ? t0 : (qt == 2 ? t0 + t1 : t0 + t1 + t2));
    const float r = t0 + t1, B = t0 + t1 + t2 + t3;
    const float eBr = __builtin_amdgcn_exp2f(B - r), eR = __builtin_amdgcn_exp2f(r);
    if (qt == 0) eB[d] = __builtin_amdgcn_exp2f(B);
    Bsum_out = B;
#pragma unroll
    for (int jj = 0; jj < 8; ++jj) {
        const int j0 = jj * 2, u0 = qt * 16 + j0;
        const float rb0 = r - (off + c[j0]), rb1 = r - (off + c[j0 + 1]);
        const float kh0 = zz[j0] * __builtin_amdgcn_exp2f(rb0), kh1 = zz[j0 + 1] * __builtin_amdgcn_exp2f(rb1);
        const unsigned pkt = pack_bf2_hw(kh0 * eBr, kh1 * eBr);
        const unsigned pvt = __float_as_uint(vv[j0]) | (__float_as_uint(vv[j0 + 1]) << 16);
        if (FULL) {
            const float zq0 = qq[j0], zq1 = qq[j0 + 1];
            const float qh0 = zq0 * __builtin_amdgcn_rcpf(1.0f + __expf(-zq0)) * __builtin_amdgcn_exp2f(-rb0), qh1 = zq1 * __builtin_amdgcn_rcpf(1.0f + __expf(-zq1)) * __builtin_amdgcn_exp2f(-rb1);
            const unsigned pq0 = pack_bf2_hw(qh0 * eR, qh0), pq1 = pack_bf2_hw(qh1 * eR, qh1), pk = pack_bf2_hw(kh0, kh1);
            *(LAS bf16_t*)(lds + HL_QT + ((size_t)u0 * QS + d) * 2) = (bf16_t)pq0;        *(LAS bf16_t*)(lds + HL_QH + ((size_t)u0 * QS + d) * 2) = (bf16_t)(pq0 >> 16);
            *(LAS bf16_t*)(lds + HL_QT + ((size_t)(u0 + 1) * QS + d) * 2) = (bf16_t)pq1;  *(LAS bf16_t*)(lds + HL_QH + ((size_t)(u0 + 1) * QS + d) * 2) = (bf16_t)(pq1 >> 16);
            *(LAS bf16_t*)(lds + HL_KH + ((size_t)u0 * QS + d) * 2) = (bf16_t)pk;         *(LAS bf16_t*)(lds + HL_KH + ((size_t)(u0 + 1) * QS + d) * 2) = (bf16_t)(pk >> 16);
        }
        *(LAS unsigned*)(lds + HL_KT + ((size_t)d * KS_ + qt * 16 + j0) * 2) = pkt;
        *(LAS unsigned*)(lds + HL_VT + ((size_t)d * KS_ + qt * 16 + j0) * 2) = pvt;
    }
    LBAR();
}
__device__ __forceinline__ void hg_state_update(LAS unsigned char* lds, hf32x16 (&S)[2], int w, int lane) {
    const int en = w & 3, r = lane & 31, hh = lane >> 5;
    const LAS float* eB = (const LAS float*)(lds + HL_EB);
#pragma unroll
    for (int i = 0; i < 2; ++i) {
        const int dm = (w >> 2) * 2 + i;
#pragma unroll
        for (int g = 0; g < 4; ++g) { const nf4 sc = *(const LAS nf4*)(eB + 32 * dm + 8 * g + 4 * hh);
            S[i][4 * g + 0] *= sc.x; S[i][4 * g + 1] *= sc.y; S[i][4 * g + 2] *= sc.z; S[i][4 * g + 3] *= sc.w; }
#pragma unroll
        for (int ks = 0; ks < 4; ++ks) {
            const hbf16x8 a = lds_frag(lds + HL_KT, 32 * dm + r, KS_, 16 * ks + 8 * hh);
            const hbf16x8 b = lds_frag(lds + HL_VT, 32 * en + r, KS_, 16 * ks + 8 * hh);
            S[i] = mfma32(a, b, S[i]);
        }
    }
}
__device__ __forceinline__ int hg_unit_base(int sc) { return sc * HSC; }
__device__ void ph_hg_pass1(const P& p, int l, LAS unsigned char* lds) {
    const bf16_t* hg = (const bf16_t*)(p.ws + OFF_HG);
    const float* lbs = (const float*)(p.ws + OFF_SMALL);
    float* ust = (float*)(p.ws + OFF_HST); float* atot = (float*)(p.ws + OFF_HAT);
    const int tid = TIDX, w = tid >> 6, lane = tid & 63;
    for (int unit = blockIdx.x; unit < HNSC * 8; unit += gridDim.x) {
        const int sc = unit >> 3, h = (unit >> 1) & 3, dir = unit & 1;
        const float lb = lbs[(size_t)(dir * NLAYER + l) * D_HG + h * 128 + (tid & 127)];
        hf32x16 S[2];
#pragma unroll
        for (int i = 0; i < 2; ++i)
#pragma unroll
            for (int k = 0; k < 16; ++k) S[i][k] = 0.f;
        float Btot = 0.f;
        const int dsg = dir ? -1 : 1, tb0 = dir ? hg_unit_base(sc) + HSC - 1 : hg_unit_base(sc);
        HgPre pre;
        hg_fetch<false>(hg, pre, tb0, dsg, h, dir);
        for (int ci = 0; ci < HNCH; ++ci) {
            float B;
            hg_prep<false>(lds, pre, lb, B);
            if (ci + 1 < HNCH) hg_fetch<false>(hg, pre, tb0 + dsg * (ci + 1) * 64, dsg, h, dir);
            Btot += B;
            hg_state_update(lds, S, w, lane);
            LBAR();
        }
        float* U = ust + (size_t)unit * 16384;
        int r = lane & 31, hh = lane >> 5; asm volatile("" : "+v"(r), "+v"(hh));
        const int en = w & 3;
#pragma unroll
        for (int i = 0; i < 2; ++i) { const int dm = (w >> 2) * 2 + i;
#pragma unroll
            for (int k = 0; k < 16; ++k) U[(32 * dm + (k & 3) + 8 * (k >> 2) + 4 * hh) * 128 + 32 * en + r] = S[i][k]; }
        if (tid < 128) atot[(size_t)unit * 128 + tid] = __builtin_amdgcn_exp2f(Btot);
    }
}
__device__ void ph_hg_pass2(const P& p) {
    float* ust = (float*)(p.ws + OFF_HST); const float* atot = (const float*)(p.ws + OFF_HAT);
    const int total = 5 * 8 * 16384;
    for (int idx = blockIdx.x * 512 + TIDX; idx < total; idx += gridDim.x * 512) {
        const int el = idx & 16383, hd = (idx >> 14) & 7, sq = idx >> 17;
        const int sc0 = sq == 0 ? 0 : 32 + 8 * (sq - 1), nsc = sq == 0 ? 32 : 8, dir = hd & 1, d = el >> 7;
        float carry = 0.f;
        for (int j0 = 0; j0 < nsc; j0 += 8) {
            float u[8], a[8];
#pragma unroll
            for (int jj = 0; jj < 8; ++jj) { const int j = j0 + jj, sc = dir ? sc0 + nsc - 1 - j : sc0 + j; const size_t unit = (size_t)sc * 8 + hd;
                u[jj] = ust[unit * 16384 + el]; a[jj] = atot[unit * 128 + d]; }
#pragma unroll
            for (int jj = 0; jj < 8; ++jj) { const int j = j0 + jj, sc = dir ? sc0 + nsc - 1 - j : sc0 + j; const size_t unit = (size_t)sc * 8 + hd;
                ust[unit * 16384 + el] = carry; carry = a[jj] * carry + u[jj]; }
        }
    }
}
__device__ void ph_hg_pass3(const P& p, int l, LAS unsigned char* lds) {
    const bf16_t* hg = (const bf16_t*)(p.ws + OFF_HG);
    const float* lbs = (const float*)(p.ws + OFF_SMALL);
    const float* ust = (const float*)(p.ws + OFF_HST);
    const float* gain = PRM(p, hg_out_norm) + (size_t)l * D_HG;
    const int tid = TIDX, w = tid >> 6, lane = tid & 63, r = lane & 31, hh = lane >> 5;
    for (int unit = blockIdx.x; unit < HNSC * 4; unit += gridDim.x) {
        const int sc = unit >> 2, h = unit & 3;
        for (int dir = 0; dir < 2; ++dir) {
            __syncthreads();
            const float lb = lbs[(size_t)(dir * NLAYER + l) * D_HG + h * 128 + (tid & 127)];
            const float* S0 = ust + ((size_t)sc * 8 + h * 2 + dir) * 16384;
            hf32x16 S[2];
            { const int en = w & 3;
              int r_ = r, hh_ = hh; asm volatile("" : "+v"(r_), "+v"(hh_));
              const float* S0l = S0 + (4 * hh_) * 128 + 32 * en + r_;
#pragma unroll
              for (int i = 0; i < 2; ++i) { const int dm = (w >> 2) * 2 + i;
#pragma unroll
                  for (int k = 0; k < 16; ++k) S[i][k] = S0l[(32 * dm + (k & 3) + 8 * (k >> 2)) * 128];
#pragma unroll
                  for (int g = 0; g < 4; ++g) { nu2 wv; wv.x = pack_bf2(S[i][4 * g], S[i][4 * g + 1]); wv.y = pack_bf2(S[i][4 * g + 2], S[i][4 * g + 3]);
                      *(LAS nu2*)(lds + HL_ST + ((size_t)(32 * en + r) * QS + 32 * dm + 8 * g + 4 * hh) * 2) = wv; } } }
            const int dsg = dir ? -1 : 1, tb0 = dir ? hg_unit_base(sc) + HSC - 1 : hg_unit_base(sc);
            HgPre pre;
            hg_fetch<true>(hg, pre, tb0, dsg, h, dir);
            for (int ci = 0; ci < HNCH; ++ci) {
                const int tokbase = tb0 + dsg * ci * 64;
                float Bdummy;
                hg_prep<true>(lds, pre, lb, Bdummy);
                if (ci + 1 < HNCH) hg_fetch<true>(hg, pre, tb0 + dsg * (ci + 1) * 64, dsg, h, dir);
                if (w < 4) {
                    const int tm = (w == 0 || w == 3) ? 0 : 1, sn = (w == 2 || w == 3) ? 1 : 0;
                    hf32x16 acc;
#pragma unroll
                    for (int k = 0; k < 16; ++k) acc[k] = 0.f;
                    if (w < 3) {
#pragma unroll
                        for (int ks = 0; ks < 8; ++ks) acc = mfma32(lds_frag(lds + HL_QH, 32 * tm + r, QS, 16 * ks + 8 * hh), lds_frag(lds + HL_KH, 32 * sn + r, QS, 16 * ks + 8 * hh), acc);
                    }
                    const int s_ = 32 * sn + r;
#pragma unroll
                    for (int k = 0; k < 16; ++k) { const int t_ = 32 * tm + (k & 3) + 8 * (k >> 2) + 4 * hh;
                        const float v = (w < 3 && s_ <= t_) ? acc[k] : 0.f;
                        *(LAS bf16_t*)(lds + HL_PM + ((size_t)t_ * KS_ + s_) * 2) = f2bf(v); }
                }
                LBAR();
                hf32x16 o;
                { const int tm = w >> 2, en = w & 3;
#pragma unroll
                  for (int k = 0; k < 16; ++k) o[k] = 0.f;
#pragma unroll
                  for (int ks = 0; ks < 4; ++ks) o = mfma32(lds_frag(lds + HL_PM, 32 * tm + r, KS_, 16 * ks + 8 * hh), lds_frag(lds + HL_VT, 32 * en + r, KS_, 16 * ks + 8 * hh), o);
#pragma unroll
                  for (int ks = 0; ks < 8; ++ks) o = mfma32(lds_frag(lds + HL_QT, 32 * tm + r, QS, 16 * ks + 8 * hh), lds_frag(lds + HL_ST, 32 * en + r, QS, 16 * ks + 8 * hh), o);
                }
                LBAR();
                { const int tm = w >> 2, en = w & 3; LAS float* Of = (LAS float*)(lds + HL_OF);
#pragma unroll
                  for (int k = 0; k < 16; ++k) Of[(size_t)(32 * tm + (k & 3) + 8 * (k >> 2) + 4 * hh) * OFS + 32 * en + r] = o[k]; }
                hg_state_update(lds, S, w, lane);
                { const int en = w & 3;
#pragma unroll
                  for (int i = 0; i < 2; ++i) { const int dm = (w >> 2) * 2 + i;
#pragma unroll
                      for (int g = 0; g < 4; ++g) { nu2 wv; wv.x = pack_bf2(S[i][4 * g], S[i][4 * g + 1]); wv.y = pack_bf2(S[i][4 * g + 2], S[i][4 * g + 3]);
                          *(LAS nu2*)(lds + HL_ST + ((size_t)(32 * en + r) * QS + 32 * dm + 8 * g + 4 * hh) * 2) = wv; } } }
                LBAR();
                { const int u = tid >> 3, e0 = (tid & 7) * 16, tok = tokbase + dsg * u;
                  const LAS float* Of = (const LAS float*)(lds + HL_OF) + (size_t)u * OFS + e0;
                  bf16_t* dst = abuf_row(p, tok) + 512 + h * 128 + e0;
                  float v[16];
#pragma unroll
                  for (int j = 0; j < 4; ++j) { const nf4 t4 = *(const LAS nf4*)(Of + 4 * j); v[4 * j] = t4.x; v[4 * j + 1] = t4.y; v[4 * j + 2] = t4.z; v[4 * j + 3] = t4.w; }
                  if (dir == 0) {
                      uint4 w0, w1;
                      w0.x = pack_bf2(v[0], v[1]); w0.y = pack_bf2(v[2], v[3]); w0.z = pack_bf2(v[4], v[5]); w0.w = pack_bf2(v[6], v[7]);
                      w1.x = pack_bf2(v[8], v[9]); w1.y = pack_bf2(v[10], v[11]); w1.z = pack_bf2(v[12], v[13]); w1.w = pack_bf2(v[14], v[15]);
                      ((uint4*)dst)[0] = w0; ((uint4*)dst)[1] = w1;
                  } else {
                      const uint4 f0 = ((const uint4*)dst)[0], f1 = ((const uint4*)dst)[1];
                      const unsigned fw[8] = {f0.x, f0.y, f0.z, f0.w, f1.x, f1.y, f1.z, f1.w};
                      float ss = 0.f;
#pragma unroll
                      for (int j = 0; j < 8; ++j) { v[2 * j] += __uint_as_float(fw[j] << 16); v[2 * j + 1] += __uint_as_float(fw[j] & 0xffff0000u); ss += v[2 * j] * v[2 * j] + v[2 * j + 1] * v[2 * j + 1]; }
                      ss += __shfl_xor(ss, 1); ss += __shfl_xor(ss, 2); ss += __shfl_xor(ss, 4);
                      const float rn = rsqrtf(ss * (1.0f / 128.0f) + 1e-6f);
                      const bf16_t* gp = hg + (size_t)tok * 2560 + 2048 + h * 128 + e0;
                      const uint4 g0 = ((const uint4*)gp)[0], g1 = ((const uint4*)gp)[1];
                      const unsigned gw[8] = {g0.x, g0.y, g0.z, g0.w, g1.x, g1.y, g1.z, g1.w};
                      unsigned ow[8];
#pragma unroll
                      for (int j = 0; j < 8; ++j) { const float ga = silu_f(__uint_as_float(gw[j] << 16)), gb = silu_f(__uint_as_float(gw[j] & 0xffff0000u));
                          ow[j] = pack_bf2_hw(v[2 * j] * rn * gain[h * 128 + e0 + 2 * j] * ga, v[2 * j + 1] * rn * gain[h * 128 + e0 + 2 * j + 1] * gb); }
                      ((uint4*)dst)[0] = make_uint4(ow[0], ow[1], ow[2], ow[3]); ((uint4*)dst)[1] = make_uint4(ow[4], ow[5], ow[6], ow[7]);
                  }
                }
                LBAR();
            }
        }
    }
}
#define XB_TMO      128
#define XB_XCNT(j)  (256  + 64 * (j))
#define XB_XSUB(j)  (1280 + 64 * (j))
#define XB_XGEN(j)  (2304 + 64 * (j))
#define XB_TOP      3328
#define XB_TOPGEN   3392
#define XCD_BAR_WORDS 3456
#define XB_SPIN_CAP (1u << 18)

__device__ __forceinline__ unsigned xb_ld(unsigned* p)              { return __hip_atomic_load(p, __ATOMIC_RELAXED, __HIP_MEMORY_SCOPE_AGENT); }
__device__ __forceinline__ unsigned xb_add(unsigned* p, unsigned v) { return __hip_atomic_fetch_add(p, v, __ATOMIC_RELAXED, __HIP_MEMORY_SCOPE_AGENT); }
__device__ __forceinline__ unsigned xb_xcc_id() { return (unsigned)__builtin_amdgcn_s_getreg((3 << 11) | 20) & 0xFu; }
#define XB_SPIN(cond, bar) do { unsigned _sp = 0; while (cond) { __builtin_amdgcn_s_sleep(1); \
    if ((++_sp & 255u) == 0u) { if (xb_ld(&(bar)[XB_TMO])) break; if (_sp > XB_SPIN_CAP) { atomicAdd(&(bar)[XB_TMO], 1u); break; } } } } while (0)

struct XcdBarrier {
    unsigned* bar; unsigned x;
    volatile LAS unsigned* st;
};

__device__ __forceinline__ XcdBarrier xcd_barrier_post(unsigned* bar, volatile LAS unsigned* st) {
    XcdBarrier b; b.bar = bar; b.x = xb_xcc_id(); b.st = st;
    if (TIDX == 0) (void)xb_add(&bar[XB_XCNT(b.x)], 1u);
    return b;
}
__device__ __forceinline__ void xcd_barrier_complete(unsigned* bar, unsigned x, unsigned& nloc, unsigned& nx) {
    const unsigned G = gridDim.x * gridDim.y * gridDim.z;
    unsigned sum, cnt, mine, sp = 0u;
    for (;;) {
        sum = 0u; cnt = 0u; mine = 0u;
#pragma unroll
        for (unsigned j = 0; j < 16; ++j) { const unsigned c = xb_ld(&bar[XB_XCNT(j)]); sum += c; cnt += (c > 0u) ? 1u : 0u; mine = (j == x) ? c : mine; }
        if (sum == G) break;
        __builtin_amdgcn_s_sleep(1);
        if ((++sp & 255u) == 0u) { if (xb_ld(&bar[XB_TMO])) break; if (sp > XB_SPIN_CAP) { atomicAdd(&bar[XB_TMO], 1u); break; } }
    }
    nloc = mine > 0u ? mine : 1u; nx = cnt > 0u ? cnt : 1u;
}

__device__ __forceinline__ void xcd_barrier(const XcdBarrier& b) {
    asm volatile("s_waitcnt vmcnt(0)" ::: "memory");
    __syncthreads();
    if (TIDX == 0) {
        unsigned* bar = b.bar;
        __builtin_amdgcn_s_waitcnt(0);
        unsigned nloc = b.st[0], nx = b.st[1];
        if (nloc == 0u) { xcd_barrier_complete(bar, b.x, nloc, nx); b.st[0] = nloc; b.st[1] = nx; }
        const unsigned old = xb_add(&bar[XB_XSUB(b.x)], 1u);
        const unsigned gen = old / nloc;
        if (old + 1u == (gen + 1u) * nloc) {
            __builtin_amdgcn_fence(__ATOMIC_RELEASE, "agent");
            asm volatile("s_waitcnt vmcnt(0)" ::: "memory");
            const unsigned og = xb_add(&bar[XB_TOP], 1u);
            const unsigned tg = og / nx;
            if (og + 1u == (tg + 1u) * nx) xb_add(&bar[XB_TOPGEN], 1u);
            else XB_SPIN(xb_ld(&bar[XB_TOPGEN]) == tg, bar);
            __builtin_amdgcn_fence(__ATOMIC_ACQUIRE, "agent");
            xb_add(&bar[XB_XGEN(b.x)], 1u);
            asm volatile("s_waitcnt vmcnt(0)" ::: "memory");
        } else {
            XB_SPIN(xb_ld(&bar[XB_XGEN(b.x)]) == gen, bar);
            __builtin_amdgcn_fence(__ATOMIC_ACQUIRE, "agent");
            asm volatile("s_waitcnt vmcnt(0)" ::: "memory");
        }
    }
    __syncthreads();
}

enum { PH_SETUP, PH_CONVERT, PH_RMS_IN, PH_GEMM_IN, PH_HY_PREP, PH_FILTER, PH_HGRN, PH_HG_NORM, PH_HY_FFT, PH_HY_NORM, PH_GEMM_OUT, PH_NR0, PH_GEMM_UP, PH_GEGLU, PH_GEMM_DN, PH_NR1, PH_HG_P1, PH_HG_P2, PH_HG_P3 };
template <int PH> __device__ __forceinline__ void run_phase(const P& p_in, int l, int part, LAS unsigned char* lds) {
    typedef __attribute__((address_space(1))) unsigned char* gptr_t; typedef __attribute__((address_space(1))) float* gfptr_t;
    gptr_t wsg = (gptr_t)p_in.ws; gfptr_t outg = (gfptr_t)p_in.out;
    asm volatile("" : "+s"(wsg), "+s"(outg));
    P p = p_in; p.ws = (unsigned char*)wsg; p.out = (float*)outg;
    if constexpr (PH == PH_SETUP) { ph_setup(p); ph_copy_params(p); }
    if constexpr (PH == PH_CONVERT) ph_convert_w(p, l, lds);
    if constexpr (PH == PH_RMS_IN) ph_rmsnorm_in(p, l);
    if constexpr (PH == PH_GEMM_IN) { EpiBf16Split E; E.O0 = (bf16_t*)(p.ws + OFF_HYRAW); E.ldc0 = 1536; E.O1 = (bf16_t*)(p.ws + OFF_HG); E.ldc1 = 2560; E.csplit = 1536; E.silu_lo0 = E.silu_hi0 = E.silu_lo1 = E.silu_hi1 = 0;
        run_gemm(lds, abuf_row(p, 0), (const bf16_t*)(p.ws + OFF_W_IN), T_TOK, D_IN, DM, E); }
    if constexpr (PH == PH_HY_PREP) ph_hy_prep(p, l, lds);
    if constexpr (PH == PH_FILTER) ph_filter(p, l, lds);
    if constexpr (PH == PH_HY_FFT) ph_hy_fft(p, l, lds);
    if constexpr (PH == PH_HY_NORM) ph_hy_norm(p, l, lds);
    if constexpr (PH == PH_GEMM_OUT) { EpiBf16Split E; E.O0 = (bf16_t*)(p.ws + OFF_MIX); E.ldc0 = DM; E.O1 = E.O0; E.ldc1 = DM; E.csplit = 1 << 30; E.silu_lo0 = E.silu_hi0 = E.silu_lo1 = E.silu_hi1 = 0;
        run_gemm(lds, abuf_row(p, 0), (const bf16_t*)(p.ws + OFF_W_OUT), T_TOK, DM, DM, E); }
    if constexpr (PH == PH_NR0) ph_norm_resid(p, l, 0);
    if constexpr (PH == PH_GEMM_UP) { EpiGeglu E; E.act = (bf16_t*)(p.ws + OFF_ACT); E.cw = PRM(p, ffn_conv_w) + (size_t)l * 3 * 8192; E.cb = PRM(p, ffn_conv_b) + (size_t)l * 8192;
        run_gemm(lds, abuf_row(p, -1), (const bf16_t*)(p.ws + OFF_W_UP), 133 * 256, 2 * DFF, DM, E); }
    if constexpr (PH == PH_GEMM_DN) { EpiBf16Split E; E.O0 = (bf16_t*)(p.ws + OFF_MIX); E.ldc0 = DM; E.O1 = E.O0; E.ldc1 = DM; E.csplit = 1 << 30; E.silu_lo0 = E.silu_hi0 = E.silu_lo1 = E.silu_hi1 = 0;
        run_gemm(lds, (const bf16_t*)(p.ws + OFF_ACT), (const bf16_t*)(p.ws + OFF_W_DN), T_TOK, DM, DFF, E, 1); }
    if constexpr (PH == PH_NR1) ph_norm_resid(p, l, 1);
    if constexpr (PH == PH_HG_P1) ph_hg_pass1(p, l, lds);
    if constexpr (PH == PH_HG_P2) ph_hg_pass2(p);
    if constexpr (PH == PH_HG_P3) ph_hg_pass3(p, l, lds);
}
constexpr int LDS_BYTES = 139264;
__global__ __launch_bounds__(512, 2) void mega(P p) {
    extern __shared__ __attribute__((aligned(16))) unsigned char lds_g[];
    LAS unsigned char* lds = (LAS unsigned char*)lds_g;
    cg::grid_group grid = cg::this_grid();
    volatile LAS unsigned* xst = (volatile LAS unsigned*)(lds + LDS_BYTES - 16);
    if (TIDX == 0) { xst[0] = 0u; xst[1] = 0u; }
    __syncthreads();
    const XcdBarrier xb = xcd_barrier_post((unsigned*)(p.ws + OFF_BAR), xst);
    run_phase<PH_SETUP>(p, 0, 0, lds);
    run_phase<PH_CONVERT>(p, 0, 0, lds);
    run_phase<PH_RMS_IN>(p, 0, 0, lds);
    grid.sync();
#pragma unroll 1
    for (int l = 0; l < NLAYER; ++l) {
        run_phase<PH_GEMM_IN>(p, l, 0, lds); xcd_barrier(xb);
        run_phase<PH_HY_PREP>(p, l, 0, lds); run_phase<PH_HG_P1>(p, l, 0, lds); xcd_barrier(xb);
        run_phase<PH_FILTER>(p, l, 0, lds); run_phase<PH_HG_P2>(p, l, 0, lds); xcd_barrier(xb);
        run_phase<PH_HG_P3>(p, l, 0, lds); run_phase<PH_HY_FFT>(p, l, 0, lds); xcd_barrier(xb);
        run_phase<PH_HY_NORM>(p, l, 0, lds); xcd_barrier(xb);
        run_phase<PH_GEMM_OUT>(p, l, 0, lds); xcd_barrier(xb);
        run_phase<PH_NR0>(p, l, 0, lds); xcd_barrier(xb);
        run_phase<PH_GEMM_UP>(p, l, 0, lds); xcd_barrier(xb);
        run_phase<PH_GEMM_DN>(p, l, 0, lds); xcd_barrier(xb);
        run_phase<PH_NR1>(p, l, 0, lds);
        if (l + 1 < NLAYER) { run_phase<PH_CONVERT>(p, l + 1, 0, lds); xcd_barrier(xb); }
    }
}
extern "C" void kernel_launch(void* const* d_in, const int* in_sizes, int n_in, void* d_out, int out_size, void* d_ws, size_t ws_size, hipStream_t stream) {
    if (ws_size < WS_NEED) { fprintf(stderr, "workspace too small: %zu < %zu\n", ws_size, (size_t)WS_NEED); return; }
    static int grid_blocks = 0;
    if (!grid_blocks) {
        hipFuncSetAttribute((const void*)mega, hipFuncAttributeMaxDynamicSharedMemorySize, LDS_BYTES);
        int dev = 0, cus = 0, per_cu = 0;
        hipGetDevice(&dev);
        hipDeviceGetAttribute(&cus, hipDeviceAttributeMultiprocessorCount, dev);
        hipOccupancyMaxActiveBlocksPerMultiprocessor(&per_cu, mega, 512, LDS_BYTES);
        if (per_cu > 1) per_cu = 1;
        grid_blocks = cus * per_cu;
    }
    P p{};
    for (int i = 0; i < 26; ++i) p.in[i] = (const float*)d_in[i];
    p.out = (float*)d_out; p.ws = (unsigned char*)d_ws;
    hipMemsetAsync((unsigned char*)d_ws + OFF_BAR, 0, XCD_BAR_WORDS * 4, stream);
    void* args[] = {&p};
    hipError_t e = hipLaunchCooperativeKernel((void*)mega, dim3(grid_blocks), dim3(512), args, LDS_BYTES, stream);
    if (e != hipSuccess) fprintf(stderr, "cooperative launch failed: %s (grid %d)\n", hipGetErrorString(e), grid_blocks);
}
```

```cpp
#include <hip/hip_runtime.h>
#include <hip/hip_cooperative_groups.h>
#include <cstdio>
#include <cstdint>
namespace cg = cooperative_groups;
__device__ __forceinline__ int tid_opaque() { int t = (int)threadIdx.x; asm volatile("" : "+v"(t)); return t; }
#define TIDX tid_opaque()
#define LAS __attribute__((address_space(3)))
typedef float cf2 __attribute__((ext_vector_type(2)));
typedef float nf4 __attribute__((ext_vector_type(4)));
typedef unsigned nu2 __attribute__((ext_vector_type(2)));
typedef unsigned nu4 __attribute__((ext_vector_type(4)));
#define LBAR() do { asm volatile("s_waitcnt lgkmcnt(0)" ::: "memory"); __builtin_amdgcn_s_barrier(); asm volatile("" ::: "memory"); } while (0)
namespace pg8 {
#define PG8_LAS __attribute__((address_space(3)))
typedef unsigned short bf16_t;
typedef short bf16x8 __attribute__((ext_vector_type(8)));
typedef float f32x4 __attribute__((ext_vector_type(4)));
typedef unsigned u32x4 __attribute__((ext_vector_type(4)));
constexpr int BM = 256, BK = 64, HALF = 128, HTB = HALF * BK * 2  , STAGE_BYTES = 8 * HTB, NXCD = 8, WGM = 8;

__host__ __device__ __forceinline__ int lds_byte(int r, int c) { const int st = (r >> 4) * 2 + (c >> 5), rr = r & 15, cc = c & 31, ob = rr * 64 + cc * 2; return st * 1024 + (ob ^ (((ob >> 9) & 1) << 5)); }
__host__ __device__ __forceinline__ void stage_rc(int b, int& R, int& C) { const int st = b / 1024, sb = b % 1024, swz = sb ^ (((sb >> 9) & 1) << 5); R = (st >> 1) * 16 + swz / 64; C = (st & 1) * 32 + (swz % 64) / 2; }
__host__ __device__ __forceinline__ int perm32(int rho) { const int n = rho >> 4, i = rho & 15; return 8 * (i >> 2) + 4 * n + (i & 3); }

struct Unit { int pm, pn; };
struct Gemm { const bf16_t* A; const bf16_t* Bt; int M, N, K; int ovl; };

struct StaticOrder {
    int nM, nN, nwg, G, c; int rev = 0;
    __host__ __device__ void init(int M, int N, int G_, int c_) { nM = M / BM; nN = N / BM; nwg = nM * nN; G = G_; c = c_; }
    __host__ __device__ bool next(int i, Unit& u) const {
        const long L = (long)i * G + c; if (L >= nwg) return false;
        int wgid = (int)L; { const int q = nwg / NXCD, r = nwg % NXCD, xcd = wgid % NXCD, off = wgid / NXCD; wgid = (xcd < r ? xcd * (q + 1) : r * (q + 1) + (xcd - r) * q) + off; }
        const int nig = WGM * nN, gid = wgid / nig, fm = gid * WGM, gsz = (nM - fm) < WGM ? (nM - fm) : WGM;
        u.pm = fm + ((wgid % nig) % gsz); u.pn = (wgid % nig) / gsz; if (rev) u.pm = nM - 1 - u.pm; return true;
    }
    __device__ __forceinline__ void a_ready(const Unit&) const {}
    __device__ __forceinline__ void done(const Unit&) const {}
};
struct CountedOrder : StaticOrder {
    const unsigned* ready; unsigned need; unsigned* tmo;
    __device__ __forceinline__ void a_ready(const Unit& u) const {
        if (TIDX < 64) {
            const unsigned long long t0 = __builtin_amdgcn_s_memrealtime(); unsigned polls = 0;
            while ((unsigned)__builtin_amdgcn_readfirstlane(__hip_atomic_load(ready + 64 * u.pm, __ATOMIC_RELAXED, __HIP_MEMORY_SCOPE_AGENT)) < need) {
                if ((++polls & 255u) == 0u && __builtin_amdgcn_readfirstlane(__hip_atomic_load(tmo, __ATOMIC_RELAXED, __HIP_MEMORY_SCOPE_AGENT)) != 0u) break;
                if (__builtin_amdgcn_s_memrealtime() - t0 > 2000000ull) {
                    if (TIDX == 0) { unsigned expect = 0u; __hip_atomic_compare_exchange_strong(tmo + 1, &expect, 0x600u | (unsigned)(u.pm & 0xff), __ATOMIC_RELAXED, __ATOMIC_RELAXED, __HIP_MEMORY_SCOPE_AGENT); __hip_atomic_store(tmo, 1u, __ATOMIC_RELAXED, __HIP_MEMORY_SCOPE_AGENT); }
                    break; }
                __builtin_amdgcn_s_sleep(2); }
            __builtin_amdgcn_fence(__ATOMIC_ACQUIRE, "agent");
            asm volatile("s_waitcnt vmcnt(0)" ::: "memory");
        }
#if !defined(BROKEN_HOOK_NO_BARRIER)
        asm volatile("" ::: "memory"); __builtin_amdgcn_s_barrier(); asm volatile("" ::: "memory");
#endif
    }
};

__device__ __forceinline__ unsigned cvt_pk_bf16(float lo, float hi) { unsigned r; asm volatile("v_cvt_pk_bf16_f32 %0, %1, %2" : "=v"(r) : "v"(lo), "v"(hi)); return r; }
typedef float f32x2 __attribute__((ext_vector_type(2)));
__device__ __forceinline__ f32x2 gelu_pk(f32x2 v) {
    const f32x2 av = __builtin_elementwise_abs(v), d = av * 0.2316418882f + 1.0f;
    f32x2 t; t.x = __builtin_amdgcn_rcpf(d.x); t.y = __builtin_amdgcn_rcpf(d.y);
    f32x2 q = t * 0.5307027145f + (-0.7265760135f); q = q * t + 0.7107068705f; q = q * t + (-0.142248368f); q = q * t + 0.127414796f; q = q * t;
    const f32x2 s = (v * v) * (-0.72134752044f);
    f32x2 e; e.x = __builtin_amdgcn_exp2f(s.x); e.y = __builtin_amdgcn_exp2f(s.y);
    const f32x2 m = v * (q * e), r = v - m;
    f32x2 o; o.x = v.x < 0.f ? m.x : r.x; o.y = v.y < 0.f ? m.y : r.y; return o;
}

struct EpiF32 {
    static constexpr bool PERM = false, AFTER_DRAIN = false;
    float* C; int ldc; const float* bias;
    __device__ __forceinline__ void operator()(const f32x4 (&acc)[2][2][4][2], const Unit& u, int wr, int wc, int fr, int fq) const {
        const int row0 = u.pm * BM + wr * 64 + fr, col0 = u.pn * BM + wc * 32 + 4 * fq;
        f32x4 bv[2][2];
#pragma unroll
        for (int bj = 0; bj < 2; ++bj)
#pragma unroll
            for (int n = 0; n < 2; ++n) bv[bj][n] = bias ? *(const f32x4*)(bias + col0 + bj * HALF + n * 16) : (f32x4){0.f, 0.f, 0.f, 0.f};
#pragma unroll
        for (int ai = 0; ai < 2; ++ai)
#pragma unroll
            for (int m = 0; m < 4; ++m) { float* rowp = C + (size_t)(row0 + ai * HALF + m * 16) * ldc + col0;
#pragma unroll
                for (int bj = 0; bj < 2; ++bj)
#pragma unroll
                    for (int n = 0; n < 2; ++n) *(f32x4*)(rowp + bj * HALF + n * 16) = acc[ai][bj][m][n] + bv[bj][n]; }
    }
};
template <int ACT  > struct EpiBf16 {
    static constexpr bool PERM = true, AFTER_DRAIN = false;
    bf16_t* O; int ldc; const float* bias; int split_cols; size_t split_stride;
    __device__ __forceinline__ void operator()(const f32x4 (&acc)[2][2][4][2], const Unit& u, int wr, int wc, int fr, int fq) const {
        const int row0 = u.pm * BM + wr * 64 + fr; int colt = u.pn * BM; bf16_t* base = O;
        if (split_cols) { const int t = colt / split_cols; base += (size_t)t * split_stride; colt -= t * split_cols; }
        const int col0 = colt + wc * 32 + 8 * fq, bcol0 = u.pn * BM + wc * 32 + 8 * fq;
        f32x4 bv[2][2];
#pragma unroll
        for (int bj = 0; bj < 2; ++bj)
#pragma unroll
            for (int n = 0; n < 2; ++n) bv[bj][n] = bias ? *(const f32x4*)(bias + bcol0 + bj * HALF + 4 * n) : (f32x4){0.f, 0.f, 0.f, 0.f};
#pragma unroll
        for (int ai = 0; ai < 2; ++ai)
#pragma unroll
            for (int m = 0; m < 4; ++m) { bf16_t* rowp = base + (size_t)(row0 + ai * HALF + m * 16) * ldc + col0;
#pragma unroll
                for (int bj = 0; bj < 2; ++bj) { f32x4 v0 = acc[ai][bj][m][0] + bv[bj][0], v1 = acc[ai][bj][m][1] + bv[bj][1];
                    if (ACT == 1) { f32x2 a = gelu_pk((f32x2){v0[0], v0[1]}), b = gelu_pk((f32x2){v0[2], v0[3]}), c = gelu_pk((f32x2){v1[0], v1[1]}), d = gelu_pk((f32x2){v1[2], v1[3]});
                        v0 = (f32x4){a.x, a.y, b.x, b.y}; v1 = (f32x4){c.x, c.y, d.x, d.y}; }
                    if (ACT == 2) {
#pragma unroll
                        for (int j = 0; j < 4; ++j) { v0[j] = 0.5f * v0[j] * (1.0f + erff(v0[j] * 0.70710678f)); v1[j] = 0.5f * v1[j] * (1.0f + erff(v1[j] * 0.70710678f)); } }
                    u32x4 w; w.x = cvt_pk_bf16(v0[0], v0[1]); w.y = cvt_pk_bf16(v0[2], v0[3]); w.z = cvt_pk_bf16(v1[0], v1[1]); w.w = cvt_pk_bf16(v1[2], v1[3]);
                    *(u32x4*)(rowp + bj * HALF) = w; } }
    }
};
template <class Epi, class Sched, bool STAMP = false>
__device__ __forceinline__ void gemm_phase(PG8_LAS unsigned char* lds, const Gemm g, const Sched& S, const Epi& E, unsigned long long* stamps) {
    const int tid = TIDX, wid = __builtin_amdgcn_readfirstlane(tid >> 6), lane = tid & 63, wr = wid >> 2, wc = wid & 3, fr = lane & 15, fq = lane >> 4;
    const int K = g.K, nt = K / BK;
    int ts_lo = 0, ts_hi = 0, nts = 0; const unsigned long long rt_entry = STAMP ? (unsigned long long)wall_clock64() : 0ull;
#define PG8_STAMP() do { if (STAMP && wid == 0 && nts < 64) { const unsigned long long _c = (unsigned long long)clock64(); \
        ts_lo = (lane == nts) ? (int)(unsigned)_c : ts_lo; ts_hi = (lane == nts) ? (int)(unsigned)(_c >> 32) : ts_hi; ++nts; } } while (0)
    PG8_STAMP();
    unsigned voffA[2], voffB[2];
#pragma unroll
    for (int i = 0; i < 2; ++i) { int R, C; stage_rc(tid * 16 + i * 8192, R, C); const int Rb = Epi::PERM ? ((R & ~31) + perm32(R & 31)) : R;
        const int Ra = g.ovl ? R - 2 * (R >> 6) : R; voffA[i] = (unsigned)(Ra * K + C) * 2u; voffB[i] = (unsigned)(Rb * K + C) * 2u; }
    const size_t kstep = (size_t)(BK * 2);
    const size_t hstep = (size_t)HALF * K * 2;
    const size_t tstep = 2 * hstep;
    const size_t hstepA = g.ovl ? (size_t)124 * K * 2 : hstep, tstepA = g.ovl ? (size_t)248 * K * 2 : tstep;
    const unsigned ldsw = (unsigned)wid * 1024u;
    const int aoff = lds_byte(wr * 64 + fr, fq * 8), boff = lds_byte(wc * 32 + fr, fq * 8);
#define PG8_SA(b, h) (((b) * 2 + (h)) * HTB)
#define PG8_SB(b, h) ((4 + (b) * 2 + (h)) * HTB)
#define PG8_STAGE(bufoff, gbase, voff) do { _Pragma("unroll") for (int _i = 0; _i < 2; ++_i) \
        __builtin_amdgcn_global_load_lds((const unsigned*)((const char*)(gbase) + (voff)[_i]), (PG8_LAS unsigned*)(lds + (bufoff) + ldsw + _i * 8192), 16, 0, 0); } while (0)
#define PG8_LDA(dst, b, h) do { _Pragma("unroll") for (int m = 0; m < 4; ++m) _Pragma("unroll") for (int k = 0; k < 2; ++k) dst[m][k] = *(const PG8_LAS bf16x8*)(lds + PG8_SA(b, h) + aoff + m * 2048 + k * 1024); } while (0)
#define PG8_LDB(dst, b, h) do { _Pragma("unroll") for (int n = 0; n < 2; ++n) _Pragma("unroll") for (int k = 0; k < 2; ++k) dst[n][k] = *(const PG8_LAS bf16x8*)(lds + PG8_SB(b, h) + boff + n * 2048 + k * 1024); } while (0)
#define PG8_MMA(ai, bj, At, Bt) do { __builtin_amdgcn_s_setprio(1); _Pragma("unroll") for (int m = 0; m < 4; ++m) _Pragma("unroll") for (int n = 0; n < 2; ++n) _Pragma("unroll") for (int k = 0; k < 2; ++k) \
        acc[ai][bj][m][n] = __builtin_amdgcn_mfma_f32_16x16x32_bf16(Bt[n][k], At[m][k], acc[ai][bj][m][n], 0, 0, 0); __builtin_amdgcn_s_setprio(0); } while (0)
#define PG8_WAIT_V(n) asm volatile("s_waitcnt vmcnt(" #n ")" ::: "memory")
#define PG8_WAIT_L(n) asm volatile("s_waitcnt lgkmcnt(" #n ")" ::: "memory")
#define PG8_BAR __builtin_amdgcn_s_barrier()
#define PG8_SCHED __builtin_amdgcn_sched_barrier(0)
    Unit cur, nxt; int ui = 0;
    if (!S.next(0, cur)) return;
    f32x4 acc[2][2][4][2];
#pragma unroll
    for (int a = 0; a < 2; ++a)
#pragma unroll
        for (int b = 0; b < 2; ++b)
#pragma unroll
            for (int m = 0; m < 4; ++m)
#pragma unroll
                for (int n = 0; n < 2; ++n) acc[a][b][m][n] = (f32x4){0.f, 0.f, 0.f, 0.f};
    bf16x8 At[4][2], B0[2][2], B1[2][2];
    const char* cA = (const char*)g.A + (size_t)cur.pm * tstepA; const char* cB = (const char*)g.Bt + (size_t)cur.pn * tstep;
    S.a_ready(cur);
    PG8_STAGE(PG8_SB(0, 0), cB, voffB); PG8_STAGE(PG8_SA(0, 0), cA, voffA); PG8_STAGE(PG8_SB(0, 1), cB + hstep, voffB); PG8_STAGE(PG8_SA(0, 1), cA + hstepA, voffA);
    if (wr == 1) PG8_BAR;
    PG8_WAIT_V(4); PG8_BAR;
    PG8_STAGE(PG8_SB(1, 0), cB + kstep, voffB); PG8_STAGE(PG8_SA(1, 0), cA + kstep, voffA); PG8_STAGE(PG8_SB(1, 1), cB + hstep + kstep, voffB);
    PG8_WAIT_V(6); PG8_BAR;
    PG8_STAMP();
    for (;;) {
        const bool has_next = S.next(ui + 1, nxt);
        const char* nA = has_next ? (const char*)g.A + (size_t)nxt.pm * tstepA : cA; const char* nB = has_next ? (const char*)g.Bt + (size_t)nxt.pn * tstep : cB;
        for (int t = 0; t < nt; t += 2) {
            const bool last = (t == nt - 2);
            const char* a1 = cA + (size_t)(t + 1) * kstep;
            const char* a2 = last ? nA : cA + (size_t)(t + 2) * kstep; const char* b2 = last ? nB : cB + (size_t)(t + 2) * kstep;
            const char* a3 = a2 + kstep; const char* b3 = b2 + kstep;
            if (last && has_next) S.a_ready(nxt);
            PG8_LDB(B0, 0, 0); PG8_SCHED; PG8_LDA(At, 0, 0); PG8_STAGE(PG8_SA(1, 1), a1 + hstepA, voffA);
            PG8_WAIT_L(8); PG8_BAR; PG8_WAIT_L(0); PG8_MMA(0, 0, At, B0); PG8_BAR; PG8_SCHED;
            PG8_LDB(B1, 0, 1); PG8_STAGE(PG8_SB(0, 0), b2, voffB);
            PG8_BAR; PG8_WAIT_L(0); PG8_MMA(0, 1, At, B1); PG8_BAR;
            PG8_LDA(At, 0, 1); PG8_STAGE(PG8_SA(0, 0), a2, voffA);
            PG8_BAR; PG8_WAIT_L(0); PG8_MMA(1, 0, At, B0); PG8_BAR; PG8_SCHED;
            PG8_STAGE(PG8_SB(0, 1), b2 + hstep, voffB);
            PG8_WAIT_V(6); PG8_BAR; PG8_MMA(1, 1, At, B1); PG8_BAR;
            PG8_LDB(B0, 1, 0); PG8_SCHED; PG8_LDA(At, 1, 0); PG8_STAGE(PG8_SA(0, 1), a2 + hstepA, voffA);
            PG8_WAIT_L(8); PG8_BAR; PG8_WAIT_L(0); PG8_MMA(0, 0, At, B0); PG8_BAR; PG8_SCHED;
            PG8_LDB(B1, 1, 1); PG8_STAGE(PG8_SB(1, 0), b3, voffB);
            PG8_BAR; PG8_WAIT_L(0); PG8_MMA(0, 1, At, B1); PG8_BAR;
            PG8_LDA(At, 1, 1); PG8_STAGE(PG8_SA(1, 0), a3, voffA);
            PG8_BAR; PG8_WAIT_L(0); PG8_MMA(1, 0, At, B0); PG8_BAR; PG8_SCHED;
            PG8_STAGE(PG8_SB(1, 1), b3 + hstep, voffB);
            PG8_WAIT_V(6); PG8_BAR; PG8_MMA(1, 1, At, B1); PG8_BAR;
        }
        PG8_STAMP();
        if constexpr (!Epi::AFTER_DRAIN) { E(acc, cur, wr, wc, fr, fq); S.done(cur); }
        PG8_STAMP();
        if (!has_next) break;
#pragma unroll
        for (int a = 0; a < 2; ++a)
#pragma unroll
            for (int b = 0; b < 2; ++b)
#pragma unroll
                for (int m = 0; m < 4; ++m)
#pragma unroll
                    for (int n = 0; n < 2; ++n) acc[a][b][m][n] = (f32x4){0.f, 0.f, 0.f, 0.f};
        cur = nxt; cA = nA; cB = nB; ++ui;
    }
    PG8_WAIT_V(0);
    if (wr == 0) PG8_BAR;
    PG8_BAR;
    if constexpr (Epi::AFTER_DRAIN) { E.fused(acc, cur, wr, wc, fr, fq, lds, wid, lane); S.done(cur); }
    PG8_STAMP();
    if (STAMP && wid == 0) { stamps[lane] = lane < nts ? (((unsigned long long)(unsigned)ts_hi << 32) | (unsigned)ts_lo) : 0ull;
        if (lane == 62) stamps[62] = rt_entry; if (lane == 63) stamps[63] = (unsigned long long)wall_clock64(); }
#undef PG8_STAMP
#undef PG8_SA
#undef PG8_SB
#undef PG8_STAGE
#undef PG8_LDA
#undef PG8_LDB
#undef PG8_MMA
#undef PG8_WAIT_V
#undef PG8_WAIT_L
#undef PG8_BAR
#undef PG8_SCHED
}
}
typedef unsigned short bf16_t;
constexpr int T_TOK = 32768, DM = 1024, D_IN = 4096, D_HY = 512, D_HG = 512, DFF = 4096, NLAYER = 4;
constexpr int L_BIG = 16384, L_SML = 4096;
constexpr int APAD = 256;
constexpr size_t MiB = 1024ull * 1024ull;
constexpr size_t OFF_W = 0;
constexpr size_t OFF_W_IN = OFF_W, OFF_W_OUT = OFF_W + 8 * MiB, OFF_W_UP = OFF_W + 10 * MiB, OFF_W_DN = OFF_W + 26 * MiB;
constexpr size_t OFF_ABUF = 34 * MiB;
constexpr size_t OFF_R1 = 99 * MiB;
constexpr size_t OFF_HYRAW = OFF_R1;
constexpr size_t OFF_HG = OFF_R1 + 96 * MiB;
constexpr size_t OFF_KT = OFF_R1;
constexpr size_t OFF_ACT = OFF_R1;
constexpr size_t OFF_R2 = 355 * MiB;
constexpr size_t OFF_X0T = OFF_R2, OFF_ZT = OFF_R2 + 32 * MiB;
constexpr size_t OFF_MIX = OFF_R2;
constexpr size_t OFF_UPART = OFF_R2;
constexpr size_t OFF_R6 = 419 * MiB;
constexpr size_t OFF_OBUF = OFF_R6;
constexpr size_t OFF_KS = OFF_R6;
constexpr size_t OFF_SMALL = 483 * MiB;
constexpr size_t OFF_BAR = OFF_SMALL + 4 * MiB;
constexpr size_t OFF_W4T = OFF_SMALL + 8 * MiB;
constexpr size_t WS_NEED = 502 * MiB;

struct P { const float* in[26]; float* out; unsigned char* ws; };
constexpr int PB_norm_mix_pre = 0;
constexpr int PB_norm_mix_post = 4096;
constexpr int PB_norm_ffn_pre = 8192;
constexpr int PB_norm_ffn_post = 12288;
constexpr int PB_hy_conv_w = 16384;
constexpr int PB_hy_conv_b = 34816;
constexpr int PB_f_w1 = 40960;
constexpr int PB_f_b1 = 49408;
constexpr int PB_f_w2 = 49664;
constexpr int PB_f_b2 = 66048;
constexpr int PB_f_w3 = 66304;
constexpr int PB_f_b3 = 82688;
constexpr int PB_f_w4 = 82944;
constexpr int PB_f_freq = 345088;
constexpr int PB_hy_skip = 345344;
constexpr int PB_hy_out_norm = 347392;
constexpr int PB_lb_table = 349440;
constexpr int PB_hg_out_norm = 353536;
constexpr int PB_ffn_conv_w = 355584;
constexpr int PB_ffn_conv_b = 453888;
constexpr int PB_TOTAL = 486656;
constexpr size_t OFF_PB = OFF_SMALL + 512 * 1024;
#define PRM(p, NAME) ((const float*)((p).ws + OFF_PB) + PB_##NAME)

__device__ __forceinline__ float bf2f(bf16_t b) { return __uint_as_float(((unsigned)b) << 16); }
typedef __bf16 nbf2v __attribute__((ext_vector_type(2)));
typedef float nf2v __attribute__((ext_vector_type(2)));
__device__ __forceinline__ bf16_t f2bf(float f) { const __bf16 b = (__bf16)f; return __builtin_bit_cast(unsigned short, b); }
__device__ __forceinline__ unsigned pack_bf2(float lo, float hi) { nf2v v; v.x = lo; v.y = hi; return __builtin_bit_cast(unsigned, __builtin_convertvector(v, nbf2v)); }
__device__ __forceinline__ unsigned pack_bf2_hw(float lo, float hi) { return pack_bf2(lo, hi); }
__device__ __forceinline__ bool seq_start(int t) { return t < L_BIG ? (t == 0) : ((t & (L_SML - 1)) == 0); }
__device__ __forceinline__ bool seq_end(int t) { return (t + 1 == T_TOK) || seq_start(t + 1); }
__device__ __forceinline__ const float* x_src_row(const P& p, int l, int t) {
    if (l > 0) return p.out + (size_t)t * DM;
    return t < L_BIG ? p.in[0] + (size_t)t * DM : p.in[1] + (size_t)(t - L_BIG) * DM;
}
__device__ __forceinline__ float silu_f(float x) { return x * __builtin_amdgcn_rcpf(1.0f + __expf(-x)); }
__device__ __forceinline__ float wave_sum(float v) {
#pragma unroll
    for (int o = 32; o >= 1; o >>= 1) v += __shfl_xor(v, o);
    return v;
}

struct EpiBf16Split {
    static constexpr bool PERM = true, AFTER_DRAIN = false, OVL = false;
    bf16_t* O0; int ldc0; bf16_t* O1; int ldc1; int csplit;
    int silu_lo0, silu_hi0, silu_lo1, silu_hi1;
    __device__ __forceinline__ void operator()(const pg8::f32x4 (&acc)[2][2][4][2], const pg8::Unit& u, int wr, int wc, int fr, int fq) const {
        const int row0 = u.pm * pg8::BM + wr * 64 + fr; int colt = u.pn * pg8::BM; bf16_t* base = O0; int ldc = ldc0;
        const bool act = (colt >= silu_lo0 && colt < silu_hi0) || (colt >= silu_lo1 && colt < silu_hi1);
        if (colt >= csplit) { base = O1; ldc = ldc1; colt -= csplit; }
        const int col0 = colt + wc * 32 + 8 * fq;
#pragma unroll
        for (int ai = 0; ai < 2; ++ai)
#pragma unroll
            for (int m = 0; m < 4; ++m) { bf16_t* rowp = base + (size_t)(row0 + ai * pg8::HALF + m * 16) * ldc + col0;
#pragma unroll
                for (int bj = 0; bj < 2; ++bj) { pg8::f32x4 v0 = acc[ai][bj][m][0], v1 = acc[ai][bj][m][1];
                    if (act) {
#pragma unroll
                        for (int i = 0; i < 4; ++i) { v0[i] = v0[i] * __builtin_amdgcn_rcpf(1.0f + __builtin_amdgcn_exp2f(-1.4426950408889634f * v0[i])); v1[i] = v1[i] * __builtin_amdgcn_rcpf(1.0f + __builtin_amdgcn_exp2f(-1.4426950408889634f * v1[i])); } }
                    pg8::u32x4 w; w.x = pg8::cvt_pk_bf16(v0[0], v0[1]); w.y = pg8::cvt_pk_bf16(v0[2], v0[3]); w.z = pg8::cvt_pk_bf16(v1[0], v1[1]); w.w = pg8::cvt_pk_bf16(v1[2], v1[3]);
                    *(pg8::u32x4*)(rowp + bj * pg8::HALF) = w; } }
    }
};
__device__ __forceinline__ float dpp_ror1(float v) { return __int_as_float(__builtin_amdgcn_mov_dpp(__float_as_int(v), 0x121, 0xF, 0xF, true)); }
__device__ __forceinline__ float dpp_ror15(float v) { return __int_as_float(__builtin_amdgcn_mov_dpp(__float_as_int(v), 0x12F, 0xF, 0xF, true)); }
__device__ __forceinline__ float gelu_tanh_e(float x) { const float y = 1.5957691216057308f * (x + 0.044715f * x * x * x); return x * __builtin_amdgcn_rcpf(1.0f + __expf(-y)); }
struct EpiGeglu {
    static constexpr bool PERM = true, AFTER_DRAIN = false, OVL = true;
    bf16_t* act; const float* cw; const float* cb;
    template <bool MASK> __device__ __forceinline__ void run(const pg8::f32x4 (&acc)[2][2][4][2], const pg8::Unit& u, int wr, int wc, int fr, int fq, unsigned mprev, unsigned mnext, unsigned mst) const {
        const int j0 = u.pn * 128 + wc * 32 + 8 * fq;
#pragma unroll
        for (int n = 0; n < 2; ++n) {
            const int jc = j0 + 4 * n;
            const pg8::f32x4 wa0 = *(const pg8::f32x4*)(cw + jc), wa1 = *(const pg8::f32x4*)(cw + 8192 + jc), wa2 = *(const pg8::f32x4*)(cw + 16384 + jc), ba = *(const pg8::f32x4*)(cb + jc);
            const pg8::f32x4 wb0 = *(const pg8::f32x4*)(cw + 4096 + jc), wb1 = *(const pg8::f32x4*)(cw + 8192 + 4096 + jc), wb2 = *(const pg8::f32x4*)(cw + 16384 + 4096 + jc), bb = *(const pg8::f32x4*)(cb + 4096 + jc);
#pragma unroll
            for (int ai = 0; ai < 2; ++ai) {
                pg8::f32x4 pa_prev, pb_prev, na_cur, nb_cur;
#pragma unroll
                for (int i = 0; i < 4; ++i) { na_cur[i] = dpp_ror15(acc[ai][0][0][n][i]); nb_cur[i] = dpp_ror15(acc[ai][1][0][n][i]); pa_prev[i] = 0.f; pb_prev[i] = 0.f; }
#pragma unroll
                for (int m = 0; m < 4; ++m) {
                    const int b = ai * 4 + m, q = 16 * m + fr, tok = u.pm * 248 + 124 * ai + 62 * wr + q - 1;
                    const bool hp = (mprev >> b) & 1u, hn = (mnext >> b) & 1u;
                    pg8::f32x4 pa_cur, pb_cur, na_next, nb_next;
#pragma unroll
                    for (int i = 0; i < 4; ++i) { pa_cur[i] = dpp_ror1(acc[ai][0][m][n][i]); pb_cur[i] = dpp_ror1(acc[ai][1][m][n][i]);
                        na_next[i] = m < 3 ? dpp_ror15(acc[ai][0][m < 3 ? m + 1 : 3][n][i]) : 0.f; nb_next[i] = m < 3 ? dpp_ror15(acc[ai][1][m < 3 ? m + 1 : 3][n][i]) : 0.f; }
                    const pg8::f32x4 xpa = (fr == 0) ? pa_prev : pa_cur, xna = (fr == 15) ? na_next : na_cur;
                    const pg8::f32x4 xpb = (fr == 0) ? pb_prev : pb_cur, xnb = (fr == 15) ? nb_next : nb_cur;
                    const pg8::f32x4 xa = acc[ai][0][m][n], xb = acc[ai][1][m][n];
                    float o[4];
#pragma unroll
                    for (int h2 = 0; h2 < 2; ++h2) {
                        typedef float f2v __attribute__((ext_vector_type(2)));
                        const f2v zero2 = (f2v){0.f, 0.f};
                        const f2v w0a = (!MASK || hp) ? (h2 ? wa0.zw : wa0.xy) : zero2, w2a = (!MASK || hn) ? (h2 ? wa2.zw : wa2.xy) : zero2;
                        const f2v w0b = (!MASK || hp) ? (h2 ? wb0.zw : wb0.xy) : zero2, w2b = (!MASK || hn) ? (h2 ? wb2.zw : wb2.xy) : zero2;
                        const f2v ya = __builtin_elementwise_fma(h2 ? xpa.zw : xpa.xy, w0a, __builtin_elementwise_fma(h2 ? xa.zw : xa.xy, h2 ? wa1.zw : wa1.xy, __builtin_elementwise_fma(h2 ? xna.zw : xna.xy, w2a, h2 ? ba.zw : ba.xy)));
                        const f2v yb = __builtin_elementwise_fma(h2 ? xpb.zw : xpb.xy, w0b, __builtin_elementwise_fma(h2 ? xb.zw : xb.xy, h2 ? wb1.zw : wb1.xy, __builtin_elementwise_fma(h2 ? xnb.zw : xnb.xy, w2b, h2 ? bb.zw : bb.xy)));
                        const f2v pz = ya * __builtin_elementwise_fma(ya * ya, (f2v){-0.10294324f, -0.10294324f}, (f2v){-2.3022082f, -2.3022082f});
                        f2v rc; rc.x = __builtin_amdgcn_rcpf(1.0f + __builtin_amdgcn_exp2f(pz.x)); rc.y = __builtin_amdgcn_rcpf(1.0f + __builtin_amdgcn_exp2f(pz.y));
                        const f2v o2 = ya * yb * rc;
                        o[2 * h2] = o2.x; o[2 * h2 + 1] = o2.y;
                    }
                    if (MASK ? ((mst >> b) & 1u) != 0u : (q >= 1 && q <= 62)) { uint2 w; w.x = pg8::cvt_pk_bf16(o[0], o[1]); w.y = pg8::cvt_pk_bf16(o[2], o[3]); *(uint2*)(act + (size_t)tok * DFF + jc) = w; }
                    pa_prev = pa_cur; pb_prev = pb_cur; na_cur = na_next; nb_cur = nb_next;
                }
            }
        }
    }
    __device__ __forceinline__ void operator()(const pg8::f32x4 (&acc)[2][2][4][2], const pg8::Unit& u, int wr, int wc, int fr, int fq) const {
        const int j0 = u.pn * 128 + wc * 32 + 8 * fq;
        unsigned mprev = 0, mnext = 0, mst = 0;
#pragma unroll
        for (int ai = 0; ai < 2; ++ai)
#pragma unroll
            for (int m = 0; m < 4; ++m) { const int q = 16 * m + fr, tok = u.pm * 248 + 124 * ai + 62 * wr + q - 1, b = ai * 4 + m;
                const bool st = q >= 1 && q <= 62 && tok < T_TOK;
                if (st) { mst |= 1u << b; if (!seq_start(tok)) mprev |= 1u << b; if (!seq_end(tok)) mnext |= 1u << b; } }
        run<true>(acc, u, wr, wc, fr, fq, mprev, mnext, mst);
    }
};
template <class Epi>
__device__ __forceinline__ void run_gemm(LAS unsigned char* lds, const bf16_t* A, const bf16_t* Bt, int M, int N, int K, const Epi& E, int rev = 0) {
    pg8::Gemm g; g.A = A; g.Bt = Bt; g.M = M; g.N = N; g.K = K; g.ovl = Epi::OVL ? 1 : 0;
    int gx = (int)gridDim.x, bx = (int)blockIdx.x; asm volatile("" : "+s"(gx), "+s"(bx));
    pg8::StaticOrder S; S.init(M, N, gx, bx); S.rev = rev;
    pg8::gemm_phase<Epi, pg8::StaticOrder, false>((PG8_LAS unsigned char*)lds, g, S, E, nullptr);
}

#define HD_INLINE __device__ __forceinline__
#define DEV_FN __device__ __forceinline__
#define LDS_F2 LAS cf2*
#define FFT_ASM_CMUL 1
#define NTHR 512
#define PADI(i) ((i) + ((i) >> 5))
#define FOR_TID for (int tid = (int)TIDX, once_ = 1; once_; once_ = 0)
#define SYNC __syncthreads()
#define BREV32(x) __brev(x)
#define CIS_REV(fr, c, s) do { const float f_ = (fr); c = __builtin_amdgcn_cosf(f_); s = __builtin_amdgcn_sinf(f_); } while (0)
HD_INLINE unsigned rev4(unsigned k, int S) {
    unsigned v = BREV32(k) >> (32 - 2 * S);
    return ((v & 0xAAAAAAAAu) >> 1) | ((v & 0x55555555u) << 1);
}
HD_INLINE cf2 mkf2(float a, float b) { cf2 r; r.x = a; r.y = b; return r; }
#ifdef FFT_ASM_CMUL
HD_INLINE cf2 cmul(cf2 a, cf2 b) {
    cf2 t, d;
    asm("v_pk_mul_f32 %0, %1, %2 op_sel:[0,0] op_sel_hi:[0,1]" : "=v"(t) : "v"(a), "v"(b));
    asm("v_pk_fma_f32 %0, %1, %2, %3 op_sel:[1,1,0] op_sel_hi:[1,0,1] neg_lo:[1,0,0]" : "=v"(d) : "v"(a), "v"(b), "v"(t));
    return d;
}
HD_INLINE cf2 cmul_g(cf2 a, cf2 b) {
    cf2 t, d;
    asm("s_nop 1\n\tv_pk_mul_f32 %0, %1, %2 op_sel:[0,0] op_sel_hi:[0,1]" : "=v"(t) : "v"(a), "v"(b));
    asm("v_pk_fma_f32 %0, %1, %2, %3 op_sel:[1,1,0] op_sel_hi:[1,0,1] neg_lo:[1,0,0]" : "=v"(d) : "v"(a), "v"(b), "v"(t));
    return d;
}
HD_INLINE cf2 cmulc_g(cf2 a, cf2 b) {
    cf2 t, d;
    asm("s_nop 1\n\tv_pk_mul_f32 %0, %1, %2 op_sel:[0,0] op_sel_hi:[0,1] neg_hi:[0,1]" : "=v"(t) : "v"(a), "v"(b));
    asm("v_pk_fma_f32 %0, %1, %2, %3 op_sel:[1,1,0] op_sel_hi:[1,0,1]" : "=v"(d) : "v"(a), "v"(b), "v"(t));
    return d;
}
#define cmulc cmulc_g
#else
HD_INLINE cf2 cmul(cf2 a, cf2 b) { return mkf2(a.x * b.x - a.y * b.y, a.x * b.y + a.y * b.x); }
HD_INLINE cf2 cmulc(cf2 a, cf2 b) { return mkf2(a.x * b.x + a.y * b.y, a.y * b.x - a.x * b.y); }
#define cmul_g cmul
#endif

HD_INLINE void bf4_fwd(cf2& a0, cf2& a1, cf2& a2, cf2& a3) {
    const cf2 t0 = a0 + a2, t1 = a0 - a2, t2 = a1 + a3, d = a1 - a3; const cf2 t3 = mkf2(d.y, -d.x);
    a0 = t0 + t2; a1 = t1 + t3; a2 = t0 - t2; a3 = t1 - t3;
}
HD_INLINE void bf4_inv(cf2& b0, cf2& b1, cf2& b2, cf2& b3) {
    const cf2 t0 = b0 + b2, t1 = b0 - b2, t2 = b1 + b3, d = b1 - b3; const cf2 t3 = mkf2(-d.y, d.x);
    b0 = t0 + t2; b1 = t1 + t3; b2 = t0 - t2; b3 = t1 - t3;
}
#define W16C(k) ((k) == 0 ? 1.0f : (k) == 1 ? 0.9238795325112867f : (k) == 2 ? 0.7071067811865476f : (k) == 3 ? 0.3826834323650898f : (k) == 4 ? 0.0f : (k) == 6 ? -0.7071067811865476f :   -0.9238795325112867f)
#define W16S(k) ((k) == 0 ? 0.0f : (k) == 1 ? 0.3826834323650898f : (k) == 2 ? 0.7071067811865476f : (k) == 3 ? 0.9238795325112867f : (k) == 4 ? 1.0f : (k) == 6 ? 0.7071067811865476f :   -0.3826834323650898f)
template <int S, int NSEQ, bool ZIN = false>
DEV_FN void fft_fwd2(LDS_F2 X) {
    constexpr int M = 1 << (2 * S), MP = M + (M >> 5), NG = NSEQ * (M >> 4);
#pragma unroll 1
    for (int pr = 0; pr < S / 2; ++pr) {
        const int s = 2 * pr, n = M >> (2 * s), q = n >> 2, q2 = q >> 2;
        const bool lin = (q2 & 31) == 0; const int sq = q + (q >> 5), sq2 = q2 + (q2 >> 5);
        const float invn = 1.0f / (float)n;
        FOR_TID {
#pragma unroll 2
            for (int gi = tid; gi < NG; gi += NTHR) {
                const int seq = (int)((unsigned)gi / (unsigned)(M >> 4)), g = gi - seq * (M >> 4), j2 = g & (q2 - 1), base = ((g - j2) << 4) + j2;
                LDS_F2 Xs = X + seq * MP;
                cf2 a[4][4];
                const int pb = lin ? PADI(base) : base;
#define FIDX(r, r2) (lin ? pb + (r) * sq + (r2) * sq2 : PADI(base + (r) * q + (r2) * q2))
#pragma unroll
                for (int r = 0; r < 4; ++r)
#pragma unroll
                    for (int r2 = 0; r2 < 4; ++r2) a[r][r2] = (ZIN && pr == 0 && r >= 2) ? mkf2(0.f, 0.f) : Xs[FIDX(r, r2)];
                float c1, s1; CIS_REV((float)j2 * invn, c1, s1);
                const cf2 t1 = mkf2(c1, -s1), t2 = cmul_g(t1, t1), t3 = cmul_g(t2, t1), t4 = cmul(t2, t2), t8 = cmul(t4, t4), t12 = cmul(t8, t4);
#pragma unroll
                for (int r2 = 0; r2 < 4; ++r2) {
                    bf4_fwd(a[0][r2], a[1][r2], a[2][r2], a[3][r2]);
                    a[1][r2] = r2 == 0 ? cmul_g(a[1][r2], t1) : cmul(a[1][r2], cmul_g(t1, mkf2(W16C(r2), -W16S(r2))));
                    a[2][r2] = cmul(a[2][r2], r2 == 0 ? t2 : cmul(t2, mkf2(W16C(2 * r2), -W16S(2 * r2))));
                    a[3][r2] = cmul(a[3][r2], r2 == 0 ? t3 : cmul(t3, mkf2(W16C(3 * r2), -W16S(3 * r2))));
                }
#pragma unroll
                for (int r = 0; r < 4; ++r) {
                    bf4_fwd(a[r][0], a[r][1], a[r][2], a[r][3]);
                    a[r][1] = cmul(a[r][1], t4); a[r][2] = cmul(a[r][2], t8); a[r][3] = cmul(a[r][3], t12);
                }
#pragma unroll
                for (int r = 0; r < 4; ++r)
#pragma unroll
                    for (int r2 = 0; r2 < 4; ++r2) Xs[FIDX(r, r2)] = a[r][r2];
            }
        }
        SYNC;
    }
    if (S & 1) {
        FOR_TID {
#pragma unroll 4
            for (int gi = tid; gi < NSEQ * (M >> 2); gi += NTHR) {
                const int seq = (int)((unsigned)gi / (unsigned)(M >> 2)), b = gi - seq * (M >> 2);
                LDS_F2 Xs = X + seq * MP;
                const int p4 = PADI(4 * b);
                cf2 a0 = Xs[p4], a1 = Xs[p4 + 1], a2 = Xs[p4 + 2], a3 = Xs[p4 + 3];
                bf4_fwd(a0, a1, a2, a3);
                Xs[p4] = a0; Xs[p4 + 1] = a1; Xs[p4 + 2] = a2; Xs[p4 + 3] = a3;
            }
        }
        SYNC;
    }
}
template <int S, int NSEQ, bool HOUT = false>
DEV_FN void fft_inv2(LDS_F2 X) {
    constexpr int M = 1 << (2 * S), MP = M + (M >> 5), NG = NSEQ * (M >> 4);
    if (S & 1) {
        FOR_TID {
#pragma unroll 4
            for (int gi = tid; gi < NSEQ * (M >> 2); gi += NTHR) {
                const int seq = (int)((unsigned)gi / (unsigned)(M >> 2)), b = gi - seq * (M >> 2);
                LDS_F2 Xs = X + seq * MP;
                const int p4 = PADI(4 * b);
                cf2 a0 = Xs[p4], a1 = Xs[p4 + 1], a2 = Xs[p4 + 2], a3 = Xs[p4 + 3];
                bf4_inv(a0, a1, a2, a3);
                Xs[p4] = a0; Xs[p4 + 1] = a1; Xs[p4 + 2] = a2; Xs[p4 + 3] = a3;
            }
        }
        SYNC;
    }
#pragma unroll 1
    for (int pr = S / 2 - 1; pr >= 0; --pr) {
        const int s = 2 * pr, n = M >> (2 * s), q = n >> 2, q2 = q >> 2;
        const bool lin = (q2 & 31) == 0; const int sq = q + (q >> 5), sq2 = q2 + (q2 >> 5);
        const float invn = 1.0f / (float)n;
        FOR_TID {
#pragma unroll 2
            for (int gi = tid; gi < NG; gi += NTHR) {
                const int seq = (int)((unsigned)gi / (unsigned)(M >> 4)), g = gi - seq * (M >> 4), j2 = g & (q2 - 1), base = ((g - j2) << 4) + j2;
                LDS_F2 Xs = X + seq * MP;
                cf2 a[4][4];
                const int pb = lin ? PADI(base) : base;
#pragma unroll
                for (int r = 0; r < 4; ++r)
#pragma unroll
                    for (int r2 = 0; r2 < 4; ++r2) a[r][r2] = Xs[FIDX(r, r2)];
                float c1, s1; CIS_REV((float)j2 * invn, c1, s1);
                const cf2 t1 = mkf2(c1, s1), t2 = cmul_g(t1, t1), t3 = cmul_g(t2, t1), t4 = cmul(t2, t2), t8 = cmul(t4, t4), t12 = cmul(t8, t4);
#pragma unroll
                for (int r = 0; r < 4; ++r) {
                    a[r][1] = cmul(a[r][1], t4); a[r][2] = cmul(a[r][2], t8); a[r][3] = cmul(a[r][3], t12);
                    bf4_inv(a[r][0], a[r][1], a[r][2], a[r][3]);
                }
#pragma unroll
                for (int r2 = 0; r2 < 4; ++r2) {
                    a[1][r2] = r2 == 0 ? cmul_g(a[1][r2], t1) : cmul(a[1][r2], cmul_g(t1, mkf2(W16C(r2), W16S(r2))));
                    a[2][r2] = cmul(a[2][r2], r2 == 0 ? t2 : cmul(t2, mkf2(W16C(2 * r2), W16S(2 * r2))));
                    a[3][r2] = cmul(a[3][r2], r2 == 0 ? t3 : cmul(t3, mkf2(W16C(3 * r2), W16S(3 * r2))));
                    bf4_inv(a[0][r2], a[1][r2], a[2][r2], a[3][r2]);
                }
#pragma unroll
                for (int r = 0; r < 4; ++r)
#pragma unroll
                    for (int r2 = 0; r2 < 4; ++r2) if (!(HOUT && pr == 0 && r >= 2)) Xs[FIDX(r, r2)] = a[r][r2];
            }
        }
        SYNC;
    }
}
DEV_FN void spec_store(LDS_F2 X, int S, cf2* Kp) {
    const int M = 1 << (2 * S);
    FOR_TID {
        for (int pp = tid; pp < (M >> 1); pp += NTHR) {
            const int p = ((pp >> 1) << 2) + (pp & 1);
            if (p == 0) {
                const cf2 c0 = X[PADI(0)]; Kp[0] = mkf2(c0.x + c0.y, c0.x - c0.y);
                const cf2 ch = X[PADI(2)]; Kp[2] = mkf2(ch.x, -ch.y);
            } else {
                const unsigned k = rev4((unsigned)p, S), pm = rev4((unsigned)(M - (int)k), S);
                const cf2 ck = X[PADI(p)], cm = X[PADI((int)pm)];
                const cf2 P = mkf2(0.5f * (ck.x + cm.x), 0.5f * (ck.y - cm.y));
                const cf2 O = mkf2(0.5f * (ck.y + cm.y), -0.5f * (ck.x - cm.x));
                float c, s; CIS_REV((float)k / (float)(2 * M), c, s);
                const cf2 Q = cmul_g(O, mkf2(c, -s));
                Kp[p] = mkf2(P.x + Q.x, P.y + Q.y);
                Kp[pm] = mkf2(P.x - Q.x, -(P.y - Q.y));
            }
        }
    }
    SYNC;
}
DEV_FN void spec_mul(LDS_F2 X0, int S, const cf2* Kp, int nseq = 1) {
    const int M = 1 << (2 * S);
    constexpr int G = 4;
    FOR_TID {
        if (tid < nseq) {
            LDS_F2 X = X0 + tid * (M + (M >> 5));
            const cf2 c0 = X[PADI(0)], k0 = Kp[0];
            const float y0 = (c0.x + c0.y) * k0.x, ym = (c0.x - c0.y) * k0.y;
            X[PADI(0)] = mkf2(0.5f * (y0 + ym), 0.5f * (y0 - ym));
            const cf2 ch = X[PADI(2)], kh = Kp[2];
            const cf2 yh = cmul(mkf2(ch.x, -ch.y), kh);
            X[PADI(2)] = mkf2(yh.x, -yh.y);
        }
        for (int pq0 = tid; pq0 < nseq * (M >> 1); pq0 += G * NTHR) {
            cf2 ck[G], cm[G], kk[G], km[G]; int ip[G], im[G], sqo[G]; float fk[G]; bool sp[G];
#pragma unroll
            for (int u = 0; u < G; ++u) {
                const int pq = pq0 + u * NTHR, sq_ = (int)((unsigned)pq / (unsigned)(M >> 1)), pp = pq - sq_ * (M >> 1);
                sp[u] = (pp == 0);
                const int p = sp[u] ? 1 : ((pp >> 1) << 2) + (pp & 1);
                const unsigned k = rev4((unsigned)p, S), pm = rev4((unsigned)(M - (int)k), S);
                ip[u] = p; im[u] = (int)pm; sqo[u] = sq_ * (M + (M >> 5)); fk[u] = (float)k / (float)(2 * M);
                ck[u] = X0[sqo[u] + PADI(p)]; cm[u] = X0[sqo[u] + PADI((int)pm)]; kk[u] = Kp[p]; km[u] = Kp[pm];
            }
#pragma unroll
            for (int u = 0; u < G; ++u) {
                const cf2 P = mkf2(0.5f * (ck[u].x + cm[u].x), 0.5f * (ck[u].y - cm[u].y));
                const cf2 O = mkf2(0.5f * (ck[u].y + cm[u].y), -0.5f * (ck[u].x - cm[u].x));
                float c, s; CIS_REV(fk[u], c, s);
                const cf2 Wk = mkf2(c, -s);
                const cf2 Q = cmul_g(O, Wk);
                const cf2 xk = mkf2(P.x + Q.x, P.y + Q.y), xm = mkf2(P.x - Q.x, -(P.y - Q.y));
                const cf2 yk = cmul(xk, kk[u]), ym = cmul(xm, km[u]);
                const cf2 Ye = mkf2(0.5f * (yk.x + ym.x), 0.5f * (yk.y - ym.y));
                const cf2 Yd = mkf2(0.5f * (yk.x - ym.x), 0.5f * (yk.y + ym.y));
                const cf2 Yo = cmulc(Yd, Wk);
                ck[u] = mkf2(Ye.x - Yo.y, Ye.y + Yo.x); cm[u] = mkf2(Ye.x + Yo.y, -Ye.y + Yo.x);
            }
#pragma unroll
            for (int u = 0; u < G; ++u) if (!sp[u]) { X0[sqo[u] + PADI(ip[u])] = ck[u]; X0[sqo[u] + PADI(im[u])] = cm[u]; }
        }
    }
    SYNC;
}
__device__ void ph_setup(const P& p) {
    const int gid = blockIdx.x * 512 + TIDX;
    if (gid < 2 * D_HG) {
        const int dir = gid / D_HG, c = gid % D_HG;
        float v[NLAYER], mx = -1e30f;
#pragma unroll
        for (int l = 0; l < NLAYER; ++l) { v[l] = p.in[19][(size_t)(dir * NLAYER + l) * D_HG + c]; mx = fmaxf(mx, v[l]); }
        float s = 0.f;
#pragma unroll
        for (int l = 0; l < NLAYER; ++l) { v[l] = expf(v[l] - mx); s += v[l]; }
        float* lbs = (float*)(p.ws + OFF_SMALL);
        float cum = 0.f;
#pragma unroll
        for (int l = 0; l < NLAYER; ++l) { if (l > 0) cum += v[l] / s; lbs[(size_t)(dir * NLAYER + l) * D_HG + c] = cum; }
    }
}
__device__ void ph_copy_params(const P& p) {
    float* pb = (float*)(p.ws + OFF_PB);
    const int g = blockIdx.x * 512 + TIDX, gs = gridDim.x * 512;
    for (int k = g; k < 4096; k += gs) pb[0 + k] = p.in[2][k];
    for (int k = g; k < 4096; k += gs) pb[4096 + k] = p.in[3][k];
    for (int k = g; k < 4096; k += gs) pb[8192 + k] = p.in[4][k];
    for (int k = g; k < 4096; k += gs) pb[12288 + k] = p.in[5][k];
    for (int k = g; k < 18432; k += gs) pb[16384 + k] = p.in[7][k];
    for (int k = g; k < 6144; k += gs) pb[34816 + k] = p.in[8][k];
    for (int k = g; k < 8448; k += gs) pb[40960 + k] = p.in[9][k];
    for (int k = g; k < 256; k += gs) pb[49408 + k] = p.in[10][k];
    for (int k = g; k < 16384; k += gs) pb[49664 + k] = p.in[11][k];
    for (int k = g; k < 256; k += gs) pb[66048 + k] = p.in[12][k];
    for (int k = g; k < 16384; k += gs) pb[66304 + k] = p.in[13][k];
    for (int k = g; k < 256; k += gs) pb[82688 + k] = p.in[14][k];
    for (int k = g; k < 262144; k += gs) pb[82944 + k] = p.in[15][k];
    for (int k = g; k < 256; k += gs) pb[345088 + k] = p.in[16][k];
    for (int k = g; k < 2048; k += gs) pb[345344 + k] = p.in[17][k];
    for (int k = g; k < 2048; k += gs) pb[347392 + k] = p.in[18][k];
    for (int k = g; k < 4096; k += gs) pb[349440 + k] = p.in[19][k];
    for (int k = g; k < 2048; k += gs) pb[353536 + k] = p.in[20][k];
    for (int k = g; k < 98304; k += gs) pb[355584 + k] = p.in[23][k];
    for (int k = g; k < 32768; k += gs) pb[453888 + k] = p.in[24][k];
}
__device__ void convert_one(const float* src, bf16_t* dst, int K, int N, LAS float* tile  , bool geglu_perm = false) {
    const int tiles_n = N / 64, ntiles = (K / 64) * tiles_n, tid = TIDX;
    const int r0 = tid >> 4, c4 = (tid & 15) * 4;
    nf4 nx0 = (nf4){0.f, 0.f, 0.f, 0.f}, nx1 = nx0;
    { const int it = blockIdx.x; if (it < ntiles) { const int k0 = (it / tiles_n) * 64, n0 = (it % tiles_n) * 64;
        nx0 = *(const nf4*)(src + (size_t)(k0 + r0) * N + n0 + c4); nx1 = *(const nf4*)(src + (size_t)(k0 + r0 + 32) * N + n0 + c4); } }
    for (int it = blockIdx.x; it < ntiles; it += gridDim.x) {
        const int k0 = (it / tiles_n) * 64, n0 = (it % tiles_n) * 64;
        tile[r0 * 65 + c4] = nx0.x; tile[r0 * 65 + c4 + 1] = nx0.y; tile[r0 * 65 + c4 + 2] = nx0.z; tile[r0 * 65 + c4 + 3] = nx0.w;
        tile[(r0 + 32) * 65 + c4] = nx1.x; tile[(r0 + 32) * 65 + c4 + 1] = nx1.y; tile[(r0 + 32) * 65 + c4 + 2] = nx1.z; tile[(r0 + 32) * 65 + c4 + 3] = nx1.w;
        { const int it2 = it + (int)gridDim.x; if (it2 < ntiles) { const int k2 = (it2 / tiles_n) * 64, n2 = (it2 % tiles_n) * 64;
            nx0 = *(const nf4*)(src + (size_t)(k2 + r0) * N + n2 + c4); nx1 = *(const nf4*)(src + (size_t)(k2 + r0 + 32) * N + n2 + c4); } }
        LBAR();
        { const int n = tid >> 3, ks = (tid & 7) * 8; int nr = n0 + n;
          if (geglu_perm) nr = nr < DFF ? (nr >> 7) * 256 + (nr & 127) : ((nr - DFF) >> 7) * 256 + 128 + ((nr - DFF) & 127);
          nu4 w;
          w.x = pack_bf2(tile[(ks + 0) * 65 + n], tile[(ks + 1) * 65 + n]); w.y = pack_bf2(tile[(ks + 2) * 65 + n], tile[(ks + 3) * 65 + n]);
          w.z = pack_bf2(tile[(ks + 4) * 65 + n], tile[(ks + 5) * 65 + n]); w.w = pack_bf2(tile[(ks + 6) * 65 + n], tile[(ks + 7) * 65 + n]);
          *(nu4*)(dst + (size_t)nr * K + k0 + ks) = w; }
        LBAR();
    }
}
__device__ void ph_convert_w(const P& p, int l, LAS unsigned char* lds) {
    LAS float* tile = (LAS float*)lds;
    convert_one(p.in[6] + (size_t)l * DM * D_IN, (bf16_t*)(p.ws + OFF_W_IN), DM, D_IN, tile);
    convert_one(p.in[21] + (size_t)l * DM * DM, (bf16_t*)(p.ws + OFF_W_OUT), DM, DM, tile);
    convert_one(p.in[22] + (size_t)l * DM * 2 * DFF, (bf16_t*)(p.ws + OFF_W_UP), DM, 2 * DFF, tile, true);
    convert_one(p.in[25] + (size_t)l * DFF * DM, (bf16_t*)(p.ws + OFF_W_DN), DFF, DM, tile);
    { const float* w4 = p.in[15] + (size_t)l * 64 * 1024; bf16_t* w4t = (bf16_t*)(p.ws + OFF_W4T);
      for (int idx = blockIdx.x * 512 + TIDX; idx < 65536; idx += gridDim.x * 512) { const int o = idx >> 6, f = idx & 63; w4t[idx] = f2bf(w4[f * 1024 + o]); } }
}
__device__ __forceinline__ bf16_t* abuf_row(const P& p, int t) { return (bf16_t*)(p.ws + OFF_ABUF) + (size_t)(t + APAD) * DM; }
__device__ void ph_rmsnorm_in(const P& p, int l) {
    const int lane = TIDX & 63, wv = TIDX >> 6;
    const float* gain = p.in[2] + (size_t)l * DM;
    for (int t = blockIdx.x * 8 + wv; t < T_TOK; t += gridDim.x * 8) {
        const float* xr = x_src_row(p, l, t);
        float4 v[4]; float ss = 0.f;
#pragma unroll
        for (int i = 0; i < 4; ++i) { v[i] = *(const float4*)(xr + lane * 4 + 256 * i); ss += v[i].x * v[i].x + v[i].y * v[i].y + v[i].z * v[i].z + v[i].w * v[i].w; }
        ss = wave_sum(ss);
        const float r = rsqrtf(ss * (1.0f / DM) + 1e-6f);
        bf16_t* hr = abuf_row(p, t);
#pragma unroll
        for (int i = 0; i < 4; ++i) { const float4 g = *(const float4*)(gain + lane * 4 + 256 * i);
            uint2 w; w.x = pack_bf2(v[i].x * r * g.x, v[i].y * r * g.y); w.y = pack_bf2(v[i].z * r * g.z, v[i].w * r * g.w);
            *(uint2*)(hr + lane * 4 + 256 * i) = w; }
    }
}
constexpr int NRR = 4;
__device__ __forceinline__ bf16_t* xb_buf(const P& p, bool r6) { return r6 ? (bf16_t*)(p.ws + OFF_R6) : (bf16_t*)((unsigned char*)p.out + 64 * MiB); }
__device__ void ph_norm_resid(const P& p, int l, int which) {
    const int lane = TIDX & 63, wv = TIDX >> 6;
    const float* gpost = (which == 0 ? PRM(p, norm_mix_post) : PRM(p, norm_ffn_post)) + (size_t)l * DM;
    const bool has_next = (which == 0) || (l + 1 < NLAYER);
    const float* gnext = which == 0 ? PRM(p, norm_ffn_pre) + (size_t)l * DM : PRM(p, norm_mix_pre) + (size_t)(has_next ? l + 1 : l) * DM;
    const bf16_t* Y = (const bf16_t*)(p.ws + OFF_MIX);
    const bool in_f32 = (l == 0 && which == 0), out_f32 = (l == NLAYER - 1 && which == 1);
    const bf16_t* xin = xb_buf(p, l == NLAYER - 1 && which == 1);
    bf16_t* xout = xb_buf(p, l == NLAYER - 1 && which == 0);
    nf4 gp[4], gn[4];
#pragma unroll
    for (int i = 0; i < 4; ++i) { gp[i] = *(const nf4*)(gpost + lane * 4 + 256 * i); gn[i] = *(const nf4*)(gnext + lane * 4 + 256 * i); }
    for (int t0 = (blockIdx.x * 8 + wv) * NRR; t0 < T_TOK; t0 += gridDim.x * 8 * NRR) {
        nf4 x[NRR][4]; nu2 yw[NRR][4];
#pragma unroll
        for (int rr = 0; rr < NRR; ++rr) { const bf16_t* yr = Y + (size_t)(t0 + rr) * DM;
            if (in_f32) { const float* xr = x_src_row(p, 0, t0 + rr);
#pragma unroll
                for (int i = 0; i < 4; ++i) x[rr][i] = *(const nf4*)(xr + lane * 4 + 256 * i);
            } else { const bf16_t* xr = xin + (size_t)(t0 + rr) * DM;
#pragma unroll
                for (int i = 0; i < 4; ++i) { const nu2 w = *(const nu2*)(xr + lane * 4 + 256 * i);
                    x[rr][i].x = __uint_as_float(w.x << 16); x[rr][i].y = __uint_as_float(w.x & 0xffff0000u); x[rr][i].z = __uint_as_float(w.y << 16); x[rr][i].w = __uint_as_float(w.y & 0xffff0000u); } }
#pragma unroll
            for (int i = 0; i < 4; ++i) yw[rr][i] = *(const nu2*)(yr + lane * 4 + 256 * i); }
#pragma unroll
        for (int rr = 0; rr < NRR; ++rr) {
            const int t = t0 + rr;
            nf4 y[4]; float ss = 0.f;
#pragma unroll
            for (int i = 0; i < 4; ++i) { const nu2 w = yw[rr][i];
                y[i].x = __uint_as_float(w.x << 16); y[i].y = __uint_as_float(w.x & 0xffff0000u); y[i].z = __uint_as_float(w.y << 16); y[i].w = __uint_as_float(w.y & 0xffff0000u);
                ss += y[i].x * y[i].x + y[i].y * y[i].y + y[i].z * y[i].z + y[i].w * y[i].w; }
            ss = wave_sum(ss);
            const float r = rsqrtf(ss * (1.0f / DM) + 1e-6f);
            float s2 = 0.f;
#pragma unroll
            for (int i = 0; i < 4; ++i) { nf4 xv = x[rr][i];
                xv.x += y[i].x * r * gp[i].x; xv.y += y[i].y * r * gp[i].y; xv.z += y[i].z * r * gp[i].z; xv.w += y[i].w * r * gp[i].w;
                s2 += xv.x * xv.x + xv.y * xv.y + xv.z * xv.z + xv.w * xv.w;
                x[rr][i] = xv;
                if (out_f32) *(nf4*)(p.out + (size_t)t * DM + lane * 4 + 256 * i) = xv;
                else { nu2 w; w.x = pack_bf2(xv.x, xv.y); w.y = pack_bf2(xv.z, xv.w); *(nu2*)(xout + (size_t)t * DM + lane * 4 + 256 * i) = w; } }
            if (has_next) {
                s2 = wave_sum(s2);
                const float r2 = rsqrtf(s2 * (1.0f / DM) + 1e-6f);
                bf16_t* hr = abuf_row(p, t);
#pragma unroll
                for (int i = 0; i < 4; ++i) { const nf4 xv = x[rr][i];
                    nu2 w; w.x = pack_bf2(xv.x * r2 * gn[i].x, xv.y * r2 * gn[i].y); w.y = pack_bf2(xv.z * r2 * gn[i].z, xv.w * r2 * gn[i].w);
                    *(nu2*)(hr + lane * 4 + 256 * i) = w; }
            }
        }
    }
}
__device__ void ph_filter(const P& p, int l, LAS unsigned char* lds) {
    LAS float* feats = (LAS float*)lds;
    LAS float* ha = feats + 16 * 36;
    LAS float* hb = ha + 16 * 64;
    LAS float* w1s = hb + 16 * 64;
    LAS float* w2s = w1s + 33 * 64;
    LAS float* w3s = w2s + 64 * 64;
    LAS bf16_t* h3b = (LAS bf16_t*)(w3s + 64 * 64);
    const int tid = TIDX;
    const float* w1 = PRM(p, f_w1) + (size_t)l * 33 * 64; const float* b1 = PRM(p, f_b1) + (size_t)l * 64;
    const float* w2 = PRM(p, f_w2) + (size_t)l * 64 * 64; const float* b2 = PRM(p, f_b2) + (size_t)l * 64;
    const float* w3 = PRM(p, f_w3) + (size_t)l * 64 * 64; const float* b3 = PRM(p, f_b3) + (size_t)l * 64;
    const float* w4 = PRM(p, f_w4) + (size_t)l * 64 * 1024; const float* fq = PRM(p, f_freq) + (size_t)l * 64;
    float* kt = (float*)(p.ws + OFF_KT);
    for (int i = tid; i < 33 * 64; i += 512) w1s[i] = w1[i];
    for (int i = tid; i < 64 * 64; i += 512) { w2s[i] = w2[i]; w3s[i] = w3[i]; }
    const int j = tid & 63;
    const float fqj = fq[j], b1j = b1[j], b2j = b2[j], b3j = b3[j];
    pg8::bf16x8 bfrag[8][2];
    { const bf16_t* w4t = (const bf16_t*)(p.ws + OFF_W4T); const int lane = tid & 63, w = tid >> 6;
#pragma unroll
      for (int nt = 0; nt < 8; ++nt)
#pragma unroll
          for (int ks = 0; ks < 2; ++ks) bfrag[nt][ks] = *(const pg8::bf16x8*)(w4t + (size_t)(128 * w + 16 * nt + (lane & 15)) * 64 + 32 * ks + 8 * (lane >> 4)); }
    __syncthreads();
    const int nitems = (L_BIG + L_SML) / 16;
    for (int it = blockIdx.x; it < nitems; it += gridDim.x) {
        const bool big = it < L_BIG / 16; const int L = big ? L_BIG : L_SML; const int pos0 = (big ? it : it - L_BIG / 16) * 16;
        float* ktc = kt + (big ? 0 : (size_t)512 * 2 * L_BIG);
        for (int idx = tid; idx < 16 * 33; idx += 512) {
            const int pp = idx / 33, f = idx % 33; const int pos = pos0 + pp;
            const float tt = (float)pos / (float)(L - 1), ang = (6.283185307179586f / (float)L) * (float)pos;
            float v;
            if (f == 0) v = tt;
            else { const int bi = (f - 1) & 15; const float band = 1e-4f + (float)bi * ((15.0f - 1e-4f) / 15.0f); v = f <= 16 ? cosf(band * ang) : -sinf(band * ang); }
            feats[pp * 36 + f] = v;
        }
        __syncthreads();
#pragma unroll
        for (int h2 = 0; h2 < 2; ++h2) { const int pp = (tid >> 6) + 8 * h2; float a = b1j;
            for (int f = 0; f < 33; ++f) a += feats[pp * 36 + f] * w1s[f * 64 + j];
            ha[pp * 64 + j] = __sinf(fqj * a); }
        __syncthreads();
#pragma unroll
        for (int h2 = 0; h2 < 2; ++h2) { const int pp = (tid >> 6) + 8 * h2; float a = b2j;
#pragma unroll 4
            for (int f4 = 0; f4 < 16; ++f4) { const nf4 hv = *(const LAS nf4*)(ha + pp * 64 + 4 * f4);
                a += hv.x * w2s[(4 * f4) * 64 + j] + hv.y * w2s[(4 * f4 + 1) * 64 + j] + hv.z * w2s[(4 * f4 + 2) * 64 + j] + hv.w * w2s[(4 * f4 + 3) * 64 + j]; }
            hb[pp * 64 + j] = __sinf(fqj * a); }
        __syncthreads();
#pragma unroll
        for (int h2 = 0; h2 < 2; ++h2) { const int pp = (tid >> 6) + 8 * h2; float a = b3j;
#pragma unroll 4
            for (int f4 = 0; f4 < 16; ++f4) { const nf4 hv = *(const LAS nf4*)(hb + pp * 64 + 4 * f4);
                a += hv.x * w3s[(4 * f4) * 64 + j] + hv.y * w3s[(4 * f4 + 1) * 64 + j] + hv.z * w3s[(4 * f4 + 2) * 64 + j] + hv.w * w3s[(4 * f4 + 3) * 64 + j]; }
            h3b[pp * 72 + j] = f2bf(__sinf(fqj * a)); }
        __syncthreads();
        {
            const int lane = tid & 63, w = tid >> 6, r16 = lane & 15, kg = lane >> 4;
            pg8::f32x4 acc[8];
#pragma unroll
            for (int nt = 0; nt < 8; ++nt) acc[nt] = (pg8::f32x4){0.f, 0.f, 0.f, 0.f};
            pg8::bf16x8 af[2];
#pragma unroll
            for (int ks = 0; ks < 2; ++ks) af[ks] = *(const LAS pg8::bf16x8*)(h3b + r16 * 72 + 32 * ks + 8 * kg);
#pragma unroll
            for (int nt = 0; nt < 8; ++nt)
#pragma unroll
                for (int ks = 0; ks < 2; ++ks) acc[nt] = __builtin_amdgcn_mfma_f32_16x16x32_bf16(af[ks], bfrag[nt][ks], acc[nt], 0, 0, 0);
            const float invl = 1.0f / (float)(L - 1);
            const float dstep = (15.350567286626972f - 3.0701134573253945f) / 511.0f;
            float tt[4];
#pragma unroll
            for (int i = 0; i < 4; ++i) tt[i] = (float)(pos0 + 4 * kg + i) * invl;
#pragma unroll
            for (int nt = 0; nt < 8; ++nt) { const int o = 128 * w + 16 * nt + r16, dir = o >> 9, c = o & 511;
                const float dl = 3.0701134573253945f + (float)c * dstep;
                nf4 v;
#pragma unroll
                for (int i = 0; i < 4; ++i) v[i] = acc[nt][i] * __expf(-tt[i] * dl);
                *(nf4*)(ktc + (size_t)(c * 2 + dir) * L + pos0 + 4 * kg) = v; }
        }
        __syncthreads();
    }
}
__device__ void ph_hy_prep(const P& p, int l, LAS unsigned char* lds) {
    constexpr int RS = 3 * 128 + 8;
    LAS bf16_t* raw = (LAS bf16_t*)lds;
    LAS bf16_t* ox = (LAS bf16_t*)(lds + 52224);
    LAS bf16_t* oz = ox + 128 * 72;
    const bf16_t* hy = (const bf16_t*)(p.ws + OFF_HYRAW);
    bf16_t* x0t = (bf16_t*)(p.ws + OFF_X0T); bf16_t* zt = (bf16_t*)(p.ws + OFF_ZT);
    const float* cw = PRM(p, hy_conv_w) + (size_t)l * 3 * 1536; const float* cb = PRM(p, hy_conv_b) + (size_t)l * 1536;
    const int tid = TIDX, nitems = (T_TOK / 64) * 4;
    for (int it = blockIdx.x; it < nitems; it += gridDim.x) {
        const int t0 = (it >> 2) * 64, c0 = (it & 3) * 128;
        for (int idx = tid; idx < 66 * 48; idx += 512) {
            const int row = idx / 48, rem = idx - row * 48, a = rem >> 4, pc = rem & 15;
            int t = t0 - 1 + row; t = t < 0 ? 0 : (t >= T_TOK ? T_TOK - 1 : t);
            *(LAS nu4*)(raw + row * RS + a * 128 + pc * 8) = *(const nu4*)(hy + (size_t)t * 1536 + a * 512 + c0 + pc * 8);
        }
        __syncthreads();
        {
            const int c = tid & 127, tq = tid >> 7;
            float wv[3][3], bv[3];
#pragma unroll
            for (int a = 0; a < 3; ++a) { bv[a] = cb[a * 512 + c0 + c];
#pragma unroll
                for (int k = 0; k < 3; ++k) wv[a][k] = cw[k * 1536 + a * 512 + c0 + c]; }
            float xm[3], xc[3];
#pragma unroll
            for (int a = 0; a < 3; ++a) { xm[a] = bf2f(raw[(tq * 16) * RS + a * 128 + c]); xc[a] = bf2f(raw[(tq * 16 + 1) * RS + a * 128 + c]); }
            unsigned px = 0, pz = 0;
#pragma unroll
            for (int j = 0; j < 16; ++j) {
                const int tt = tq * 16 + j, t = t0 + tt;
                const bool hp = !seq_start(t), hn = !seq_end(t);
                float r[3];
#pragma unroll
                for (int a = 0; a < 3; ++a) { const float xp = bf2f(raw[(tt + 2) * RS + a * 128 + c]);
                    r[a] = (hp ? xm[a] * wv[a][0] : 0.f) + xc[a] * wv[a][1] + (hn ? xp * wv[a][2] : 0.f) + bv[a];
                    xm[a] = xc[a]; xc[a] = xp; }
                const unsigned bx = f2bf(r[0]), bz = f2bf(r[1] * r[2]);
                if (j & 1) { px |= bx << 16; pz |= bz << 16;
                    *(LAS unsigned*)(ox + c * 72 + tt - 1) = px; *(LAS unsigned*)(oz + c * 72 + tt - 1) = pz; }
                else { px = bx; pz = bz; }
            }
        }
        __syncthreads();
        for (int idx = tid; idx < 128 * 16; idx += 512) {
            const int c = idx >> 4, rem = idx & 15, arr = rem >> 3, pc = rem & 7;
            const nu4 v = *(const LAS nu4*)((arr ? oz : ox) + c * 72 + pc * 8);
            *(nu4*)((arr ? zt : x0t) + (size_t)(c0 + c) * T_TOK + t0 + pc * 8) = v;
        }
        __syncthreads();
    }
}
__device__ __forceinline__ cf2 ld_f2_agent(const cf2* ptr) {
    const unsigned long long w = __hip_atomic_load((const unsigned long long*)ptr, __ATOMIC_RELAXED, __HIP_MEMORY_SCOPE_AGENT);
    return mkf2(__uint_as_float((unsigned)w), __uint_as_float((unsigned)(w >> 32)));
}
template <int S, int NSEQ>
__device__ __forceinline__ void hy_fft_job(const P& p, int l, LAS cf2* X, cf2* Ks, int c, int tbase) {
    const int tid = TIDX;
    constexpr int M = 1 << (2 * S), L = M, MP = M + (M >> 5);
    const float* kt = (const float*)(p.ws + OFF_KT);
    const bf16_t* x0t = (const bf16_t*)(p.ws + OFF_X0T); bf16_t* zt = (bf16_t*)(p.ws + OFF_ZT);
    const float* hf = kt + (S == 7 ? 0 : (size_t)512 * 2 * L_BIG) + (size_t)(c * 2) * L; const float* hb = hf + L;
#pragma unroll 4
    for (int m = tid; m < M; m += 512) {
        const int n0 = 2 * m, n1 = 2 * m + 1;
        const float a = n0 < L ? hf[n0] : (n0 == L ? 0.f : hb[2 * L - n0]);
        const float b = n1 < L ? hf[n1] : hb[2 * L - n1];
        X[PADI(m)] = mkf2(a, b);
    }
    __syncthreads();
    fft_fwd2<S, 1>(X);
    spec_store(X, S, Ks);
    __builtin_amdgcn_fence(__ATOMIC_ACQUIRE, "agent");
    asm volatile("s_waitcnt vmcnt(0)" ::: "memory");
    __syncthreads();
    const float skip = PRM(p, hy_skip)[(size_t)l * D_HY + c];
    const bf16_t* zrow = zt + (size_t)c * T_TOK + tbase; const bf16_t* xrow = x0t + (size_t)c * T_TOK + tbase;
#pragma unroll 4
    for (int idx = tid; idx < NSEQ * (M >> 1); idx += 512) {
        const int sq = (int)((unsigned)idx / (unsigned)(M >> 1)), m = idx - sq * (M >> 1);
        const unsigned w = *(const unsigned*)(zrow + sq * L + 2 * m);
        X[sq * MP + PADI(m)] = mkf2(__uint_as_float(w << 16), __uint_as_float(w & 0xffff0000u));
    }
    __syncthreads();
    fft_fwd2<S, NSEQ, true>(X);
    spec_mul(X, S, Ks, NSEQ);
    fft_inv2<S, NSEQ, true>(X);
    const float inv = 1.0f / (float)M;
    bf16_t* orow = zt + (size_t)c * T_TOK + tbase;
#pragma unroll 4
    for (int idx = tid; idx < NSEQ * (M >> 1); idx += 512) {
        const int sq = (int)((unsigned)idx / (unsigned)(M >> 1)), m = idx - sq * (M >> 1);
        const cf2 d = X[sq * MP + PADI(m)];
        const unsigned wz = *(const unsigned*)(zrow + sq * L + 2 * m), wx = *(const unsigned*)(xrow + sq * L + 2 * m);
        const float z0 = __uint_as_float(wz << 16), z1 = __uint_as_float(wz & 0xffff0000u), a0 = __uint_as_float(wx << 16), a1 = __uint_as_float(wx & 0xffff0000u);
        *(unsigned*)(orow + sq * L + 2 * m) = pack_bf2(a0 * (d.x * inv + skip * z0), a1 * (d.y * inv + skip * z1));
    }
    __syncthreads();
}
__device__ void ph_hy_fft(const P& p, int l, LAS unsigned char* lds) {
    LAS cf2* X = (LAS cf2*)lds;
    cf2* Ks = (cf2*)(p.ws + OFF_KS) + (size_t)blockIdx.x * L_BIG;
    for (int job = blockIdx.x; job < 1024; job += gridDim.x) {
        const bool big = job < 512; const int c = job & 511;
        if (big) hy_fft_job<7, 1>(p, l, X, Ks, c, 0); else hy_fft_job<6, 4>(p, l, X, Ks, c, L_BIG);
    }
}
__device__ void ph_hy_norm(const P& p, int l, LAS unsigned char* lds) {
    LAS bf16_t* tl = (LAS bf16_t*)lds;
    LAS float* red = (LAS float*)(lds + 9216);
    const bf16_t* yh = (const bf16_t*)(p.ws + OFF_ZT);
    const float* gain = PRM(p, hy_out_norm) + (size_t)l * D_HY;
    const int tid = TIDX, nitems = (T_TOK / 64) * 8;
    const int cc = tid >> 3, pc = tid & 7;
    nu4 nxt = (nu4){0u, 0u, 0u, 0u};
    { const int it = blockIdx.x; if (it < nitems) nxt = *(const nu4*)(yh + (size_t)((it & 7) * 64 + cc) * T_TOK + (it >> 3) * 64 + pc * 8); }
    for (int it = blockIdx.x; it < nitems; it += gridDim.x) {
        const int t0 = (it >> 3) * 64, c0 = (it & 7) * 64;
        *(LAS nu4*)(tl + cc * 72 + pc * 8) = nxt;
        { const int it2 = it + (int)gridDim.x; if (it2 < nitems) nxt = *(const nu4*)(yh + (size_t)((it2 & 7) * 64 + cc) * T_TOK + (it2 >> 3) * 64 + pc * 8); }
        LBAR();
        { const int tt = tid & 63, part = tid >> 6; float s = 0.f;
#pragma unroll
          for (int j = 0; j < 8; ++j) { const float v = bf2f(tl[(part * 8 + j) * 72 + tt]); s += v * v; }
          red[part * 64 + tt] = s; }
        LBAR();
        { const int tt = tid >> 3;
          float s = 0.f;
#pragma unroll
          for (int j = 0; j < 8; ++j) s += red[j * 64 + tt];
          const float r = rsqrtf(s * (1.0f / 64.0f) + 1e-6f);
          unsigned w[4];
#pragma unroll
          for (int j = 0; j < 4; ++j) { const int ca = pc * 8 + 2 * j;
              w[j] = pack_bf2(bf2f(tl[ca * 72 + tt]) * r * gain[c0 + ca], bf2f(tl[(ca + 1) * 72 + tt]) * r * gain[c0 + ca + 1]); }
          nu4 o; o.x = w[0]; o.y = w[1]; o.z = w[2]; o.w = w[3];
          *(nu4*)(abuf_row(p, t0 + tt) + c0 + pc * 8) = o; }
        LBAR();
    }
}
typedef short hbf16x8 __attribute__((ext_vector_type(8)));
typedef float hf32x16 __attribute__((ext_vector_type(16)));
constexpr int HSC = 512, HNCH = HSC / 64, HNSC = T_TOK / HSC;
constexpr int QS = 136, KS_ = 72;
constexpr int HL_QH = 0, HL_KH = HL_QH + 64 * QS * 2, HL_QT = HL_KH + 64 * QS * 2, HL_KT = HL_QT + 64 * QS * 2, HL_VT = HL_KT + 128 * KS_ * 2, HL_ST = HL_VT + 128 * KS_ * 2,
              HL_PM = HL_ST + 128 * QS * 2, HL_TOT = HL_PM + 64 * KS_ * 2, HL_EB = HL_TOT + 4 * 128 * 4, HL_END = HL_EB + 128 * 4;
constexpr int HL_OF = HL_QH, OFS = 132;
static_assert(64 * OFS * 4 <= 2 * 64 * QS * 2, "O tile must fit over Qh|Kh");
constexpr size_t OFF_HST = OFF_R6 + 32 * MiB;
constexpr size_t OFF_HAT = OFF_SMALL + 64 * 1024;

__device__ __forceinline__ hf32x16 mfma32(hbf16x8 a, hbf16x8 b, hf32x16 c) { return __builtin_amdgcn_mfma_f32_32x32x16_bf16(a, b, c, 0, 0, 0); }
__device__ __forceinline__ hbf16x8 lds_frag(const LAS unsigned char* base, int row, int stride_el, int col_el) { return *(const LAS hbf16x8*)(base + ((size_t)row * stride_el + col_el) * 2); }

typedef unsigned hu32x4 __attribute__((ext_vector_type(4)));
struct HgPre { hu32x4 f0, f1, v0, v1, q0, q1; };
template <bool FULL>
__device__ __forceinline__ void hg_fetch(const bf16_t* hg, HgPre& pre, int tokbase, int dirsign, int h, int dir) {
    const int tid = TIDX;
    { const int u = tid >> 4, seg = tid & 15;
      const bf16_t* row = hg + (size_t)(tokbase + dirsign * u) * 2560 + h * 128 + seg * 8;
      pre.f0 = *(const hu32x4*)(row + 512 + 512 * dir); pre.v0 = *(const hu32x4*)(row + 1536); if (FULL) pre.q0 = *(const hu32x4*)(row);
      const bf16_t* row1 = row + (size_t)dirsign * 32 * 2560;
      pre.f1 = *(const hu32x4*)(row1 + 512 + 512 * dir); pre.v1 = *(const hu32x4*)(row1 + 1536); if (FULL) pre.q1 = *(const hu32x4*)(row1); }
}
template <bool FULL>
__device__ __forceinline__ void hg_prep(LAS unsigned char* lds, const HgPre& pre, float lb, float& Bsum_out) {
    const int tid = TIDX, d = tid & 127, qt = tid >> 7;
    LAS float* tot = (LAS float*)(lds + HL_TOT); LAS float* eB = (LAS float*)(lds + HL_EB);
    { const int u = tid >> 4, seg = tid & 15;
      *(LAS hu32x4*)(lds + HL_KH + ((size_t)u * QS + seg * 8) * 2) = pre.f0; *(LAS hu32x4*)(lds + HL_KH + ((size_t)(u + 32) * QS + seg * 8) * 2) = pre.f1;
      *(LAS hu32x4*)(lds + HL_QH + ((size_t)u * QS + seg * 8) * 2) = pre.v0; *(LAS hu32x4*)(lds + HL_QH + ((size_t)(u + 32) * QS + seg * 8) * 2) = pre.v1;
      if (FULL) { *(LAS hu32x4*)(lds + HL_QT + ((size_t)u * QS + seg * 8) * 2) = pre.q0; *(LAS hu32x4*)(lds + HL_QT + ((size_t)(u + 32) * QS + seg * 8) * 2) = pre.q1; } }
    LBAR();
    float c[16];
    float run = 0.f;
    const float oml = 1.0f - lb;
    float zz[16];
#pragma unroll
    for (int j = 0; j < 16; ++j) zz[j] = bf2f(*(const LAS bf16_t*)(lds + HL_KH + ((size_t)(qt * 16 + j) * QS + d) * 2));
    __builtin_amdgcn_sched_barrier(0);
#pragma unroll
    for (int j = 0; j < 16; ++j) {
        const int u = qt * 16 + j;
        const float z = fmaxf(zz[j], -60.0f);
        const float f = lb + oml * __builtin_amdgcn_rcpf(1.0f + __expf(-z));
        zz[j] = 1.0f - f;
        run += __builtin_amdgcn_logf(f);
        c[j] = run;
    }
    tot[qt * 128 + d] = run;
    float vv[16], qq[16];
#pragma unroll
    for (int j = 0; j < 16; ++j) { vv[j] = __uint_as_float((unsigned)(*(const LAS bf16_t*)(lds + HL_QH + ((size_t)(qt * 16 + j) * QS + d) * 2)));
        if (FULL) qq[j] = bf2f(*(const LAS bf16_t*)(lds + HL_QT + ((size_t)(qt * 16 + j) * QS + d) * 2)); }
    LBAR();
    const float t0 = tot[d], t1 = tot[128 + d], t2 = tot[256 + d], t3 = tot[384 + d];
    const float off = qt == 0 ? 0.f : (qt == 1 ? t0 : (qt == 2 ? t0 + t1 : t0 + t1 + t2));
    const float r = t0 + t1, B = t0 + t1 + t2 + t3;
    const float eBr = __builtin_amdgcn_exp2f(B - r), eR = __builtin_amdgcn_exp2f(r);
    if (qt == 0) eB[d] = __builtin_amdgcn_exp2f(B);
    Bsum_out = B;
#pragma unroll
    for (int jj = 0; jj < 8; ++jj) {
        const int j0 = jj * 2, u0 = qt * 16 + j0;
        const float rb0 = r - (off + c[j0]), rb1 = r - (off + c[j0 + 1]);
        const float kh0 = zz[j0] * __builtin_amdgcn_exp2f(rb0), kh1 = zz[j0 + 1] * __builtin_amdgcn_exp2f(rb1);
        const unsigned pkt = pack_bf2_hw(kh0 * eBr, kh1 * eBr);
        const unsigned pvt = __float_as_uint(vv[j0]) | (__float_as_uint(vv[j0 + 1]) << 16);
        if (FULL) {
            const float zq0 = qq[j0], zq1 = qq[j0 + 1];
            const float qh0 = zq0 * __builtin_amdgcn_rcpf(1.0f + __expf(-zq0)) * __builtin_amdgcn_exp2f(-rb0), qh1 = zq1 * __builtin_amdgcn_rcpf(1.0f + __expf(-zq1)) * __builtin_amdgcn_exp2f(-rb1);
            const unsigned pq0 = pack_bf2_hw(qh0 * eR, qh0), pq1 = pack_bf2_hw(qh1 * eR, qh1), pk = pack_bf2_hw(kh0, kh1);
            *(LAS bf16_t*)(lds + HL_QT + ((size_t)u0 * QS + d) * 2) = (bf16_t)pq0;        *(LAS bf16_t*)(lds + HL_QH + ((size_t)u0 * QS + d) * 2) = (bf16_t)(pq0 >> 16);
            *(LAS bf16_t*)(lds + HL_QT + ((size_t)(u0 + 1) * QS + d) * 2) = (bf16_t)pq1;  *(LAS bf16_t*)(lds + HL_QH + ((size_t)(u0 + 1) * QS + d) * 2) = (bf16_t)(pq1 >> 16);
            *(LAS bf16_t*)(lds + HL_KH + ((size_t)u0 * QS + d) * 2) = (bf16_t)pk;         *(LAS bf16_t*)(lds + HL_KH + ((size_t)(u0 + 1) * QS + d) * 2) = (bf16_t)(pk >> 16);
        }
        *(LAS unsigned*)(lds + HL_KT + ((size_t)d * KS_ + qt * 16 + j0) * 2) = pkt;
        *(LAS unsigned*)(lds + HL_VT + ((size_t)d * KS_ + qt * 16 + j0) * 2) = pvt;
    }
    LBAR();
}
__device__ __forceinline__ void hg_state_update(LAS unsigned char* lds, hf32x16 (&S)[2], int w, int lane) {
    const int en = w & 3, r = lane & 31, hh = lane >> 5;
    const LAS float* eB = (const LAS float*)(lds + HL_EB);
#pragma unroll
    for (int i = 0; i < 2; ++i) {
        const int dm = (w >> 2) * 2 + i;
#pragma unroll
        for (int g = 0; g < 4; ++g) { const nf4 sc = *(const LAS nf4*)(eB + 32 * dm + 8 * g + 4 * hh);
            S[i][4 * g + 0] *= sc.x; S[i][4 * g + 1] *= sc.y; S[i][4 * g + 2] *= sc.z; S[i][4 * g + 3] *= sc.w; }
#pragma unroll
        for (int ks = 0; ks < 4; ++ks) {
            const hbf16x8 a = lds_frag(lds + HL_KT, 32 * dm + r, KS_, 16 * ks + 8 * hh);
            const hbf16x8 b = lds_frag(lds + HL_VT, 32 * en + r, KS_, 16 * ks + 8 * hh);
            S[i] = mfma32(a, b, S[i]);
        }
    }
}
__device__ __forceinline__ int hg_unit_base(int sc) { return sc * HSC; }
__device__ void ph_hg_pass1(const P& p, int l, LAS unsigned char* lds) {
    const bf16_t* hg = (const bf16_t*)(p.ws + OFF_HG);
    const float* lbs = (const float*)(p.ws + OFF_SMALL);
    float* ust = (float*)(p.ws + OFF_HST); float* atot = (float*)(p.ws + OFF_HAT);
    const int tid = TIDX, w = tid >> 6, lane = tid & 63;
    for (int unit = blockIdx.x; unit < HNSC * 8; unit += gridDim.x) {
        const int sc = unit >> 3, h = (unit >> 1) & 3, dir = unit & 1;
        const float lb = lbs[(size_t)(dir * NLAYER + l) * D_HG + h * 128 + (tid & 127)];
        hf32x16 S[2];
#pragma unroll
        for (int i = 0; i < 2; ++i)
#pragma unroll
            for (int k = 0; k < 16; ++k) S[i][k] = 0.f;
        float Btot = 0.f;
        const int dsg = dir ? -1 : 1, tb0 = dir ? hg_unit_base(sc) + HSC - 1 : hg_unit_base(sc);
        HgPre pre;
        hg_fetch<false>(hg, pre, tb0, dsg, h, dir);
        for (int ci = 0; ci < HNCH; ++ci) {
            float B;
            hg_prep<false>(lds, pre, lb, B);
            if (ci + 1 < HNCH) hg_fetch<false>(hg, pre, tb0 + dsg * (ci + 1) * 64, dsg, h, dir);
            Btot += B;
            hg_state_update(lds, S, w, lane);
            LBAR();
        }
        float* U = ust + (size_t)unit * 16384;
        int r = lane & 31, hh = lane >> 5; asm volatile("" : "+v"(r), "+v"(hh));
        const int en = w & 3;
#pragma unroll
        for (int i = 0; i < 2; ++i) { const int dm = (w >> 2) * 2 + i;
#pragma unroll
            for (int k = 0; k < 16; ++k) U[(32 * dm + (k & 3) + 8 * (k >> 2) + 4 * hh) * 128 + 32 * en + r] = S[i][k]; }
        if (tid < 128) atot[(size_t)unit * 128 + tid] = __builtin_amdgcn_exp2f(Btot);
    }
}
__device__ void ph_hg_pass2(const P& p) {
    float* ust = (float*)(p.ws + OFF_HST); const float* atot = (const float*)(p.ws + OFF_HAT);
    const int total = 5 * 8 * 16384;
    for (int idx = blockIdx.x * 512 + TIDX; idx < total; idx += gridDim.x * 512) {
        const int el = idx & 16383, hd = (idx >> 14) & 7, sq = idx >> 17;
        const int sc0 = sq == 0 ? 0 : 32 + 8 * (sq - 1), nsc = sq == 0 ? 32 : 8, dir = hd & 1, d = el >> 7;
        float carry = 0.f;
        for (int j0 = 0; j0 < nsc; j0 += 8) {
            float u[8], a[8];
#pragma unroll
            for (int jj = 0; jj < 8; ++jj) { const int j = j0 + jj, sc = dir ? sc0 + nsc - 1 - j : sc0 + j; const size_t unit = (size_t)sc * 8 + hd;
                u[jj] = ust[unit * 16384 + el]; a[jj] = atot[unit * 128 + d]; }
#pragma unroll
            for (int jj = 0; jj < 8; ++jj) { const int j = j0 + jj, sc = dir ? sc0 + nsc - 1 - j : sc0 + j; const size_t unit = (size_t)sc * 8 + hd;
                ust[unit * 16384 + el] = carry; carry = a[jj] * carry + u[jj]; }
        }
    }
}
__device__ void ph_hg_pass3(const P& p, int l, LAS unsigned char* lds) {
    const bf16_t* hg = (const bf16_t*)(p.ws + OFF_HG);
    const float* lbs = (const float*)(p.ws + OFF_SMALL);
    const float* ust = (const float*)(p.ws + OFF_HST);
    const float* gain = PRM(p, hg_out_norm) + (size_t)l * D_HG;
    const int tid = TIDX, w = tid >> 6, lane = tid & 63, r = lane & 31, hh = lane >> 5;
    for (int unit = blockIdx.x; unit < HNSC * 4; unit += gridDim.x) {
        const int sc = unit >> 2, h = unit & 3;
        for (int dir = 0; dir < 2; ++dir) {
            __syncthreads();
            const float lb = lbs[(size_t)(dir * NLAYER + l) * D_HG + h * 128 + (tid & 127)];
            const float* S0 = ust + ((size_t)sc * 8 + h * 2 + dir) * 16384;
            hf32x16 S[2];
            { const int en = w & 3;
              int r_ = r, hh_ = hh; asm volatile("" : "+v"(r_), "+v"(hh_));
              const float* S0l = S0 + (4 * hh_) * 128 + 32 * en + r_;
#pragma unroll
              for (int i = 0; i < 2; ++i) { const int dm = (w >> 2) * 2 + i;
#pragma unroll
                  for (int k = 0; k < 16; ++k) S[i][k] = S0l[(32 * dm + (k & 3) + 8 * (k >> 2)) * 128];
#pragma unroll
                  for (int g = 0; g < 4; ++g) { nu2 wv; wv.x = pack_bf2(S[i][4 * g], S[i][4 * g + 1]); wv.y = pack_bf2(S[i][4 * g + 2], S[i][4 * g + 3]);
                      *(LAS nu2*)(lds + HL_ST + ((size_t)(32 * en + r) * QS + 32 * dm + 8 * g + 4 * hh) * 2) = wv; } } }
            const int dsg = dir ? -1 : 1, tb0 = dir ? hg_unit_base(sc) + HSC - 1 : hg_unit_base(sc);
            HgPre pre;
            hg_fetch<true>(hg, pre, tb0, dsg, h, dir);
            for (int ci = 0; ci < HNCH; ++ci) {
                const int tokbase = tb0 + dsg * ci * 64;
                float Bdummy;
                hg_prep<true>(lds, pre, lb, Bdummy);
                if (ci + 1 < HNCH) hg_fetch<true>(hg, pre, tb0 + dsg * (ci + 1) * 64, dsg, h, dir);
                if (w < 4) {
                    const int tm = (w == 0 || w == 3) ? 0 : 1, sn = (w == 2 || w == 3) ? 1 : 0;
                    hf32x16 acc;
#pragma unroll
                    for (int k = 0; k < 16; ++k) acc[k] = 0.f;
                    if (w < 3) {
#pragma unroll
                        for (int ks = 0; ks < 8; ++ks) acc = mfma32(lds_frag(lds + HL_QH, 32 * tm + r, QS, 16 * ks + 8 * hh), lds_frag(lds + HL_KH, 32 * sn + r, QS, 16 * ks + 8 * hh), acc);
                    }
                    const int s_ = 32 * sn + r;
#pragma unroll
                    for (int k = 0; k < 16; ++k) { const int t_ = 32 * tm + (k & 3) + 8 * (k >> 2) + 4 * hh;
                        const float v = (w < 3 && s_ <= t_) ? acc[k] : 0.f;
                        *(LAS bf16_t*)(lds + HL_PM + ((size_t)t_ * KS_ + s_) * 2) = f2bf(v); }
                }
                LBAR();
                hf32x16 o;
                { const int tm = w >> 2, en = w & 3;
#pragma unroll
                  for (int k = 0; k < 16; ++k) o[k] = 0.f;
#pragma unroll
                  for (int ks = 0; ks < 4; ++ks) o = mfma32(lds_frag(lds + HL_PM, 32 * tm + r, KS_, 16 * ks + 8 * hh), lds_frag(lds + HL_VT, 32 * en + r, KS_, 16 * ks + 8 * hh), o);
#pragma unroll
                  for (int ks = 0; ks < 8; ++ks) o = mfma32(lds_frag(lds + HL_QT, 32 * tm + r, QS, 16 * ks + 8 * hh), lds_frag(lds + HL_ST, 32 * en + r, QS, 16 * ks + 8 * hh), o);
                }
                LBAR();
                { const int tm = w >> 2, en = w & 3; LAS float* Of = (LAS float*)(lds + HL_OF);
#pragma unroll
                  for (int k = 0; k < 16; ++k) Of[(size_t)(32 * tm + (k & 3) + 8 * (k >> 2) + 4 * hh) * OFS + 32 * en + r] = o[k]; }
                hg_state_update(lds, S, w, lane);
                { const int en = w & 3;
#pragma unroll
                  for (int i = 0; i < 2; ++i) { const int dm = (w >> 2) * 2 + i;
#pragma unroll
                      for (int g = 0; g < 4; ++g) { nu2 wv; wv.x = pack_bf2(S[i][4 * g], S[i][4 * g + 1]); wv.y = pack_bf2(S[i][4 * g + 2], S[i][4 * g + 3]);
                          *(LAS nu2*)(lds + HL_ST + ((size_t)(32 * en + r) * QS + 32 * dm + 8 * g + 4 * hh) * 2) = wv; } } }
                LBAR();
                { const int u = tid >> 3, e0 = (tid & 7) * 16, tok = tokbase + dsg * u;
                  const LAS float* Of = (const LAS float*)(lds + HL_OF) + (size_t)u * OFS + e0;
                  bf16_t* dst = abuf_row(p, tok) + 512 + h * 128 + e0;
                  float v[16];
#pragma unroll
                  for (int j = 0; j < 4; ++j) { const nf4 t4 = *(const LAS nf4*)(Of + 4 * j); v[4 * j] = t4.x; v[4 * j + 1] = t4.y; v[4 * j + 2] = t4.z; v[4 * j + 3] = t4.w; }
                  if (dir == 0) {
                      uint4 w0, w1;
                      w0.x = pack_bf2(v[0], v[1]); w0.y = pack_bf2(v[2], v[3]); w0.z = pack_bf2(v[4], v[5]); w0.w = pack_bf2(v[6], v[7]);
                      w1.x = pack_bf2(v[8], v[9]); w1.y = pack_bf2(v[10], v[11]); w1.z = pack_bf2(v[12], v[13]); w1.w = pack_bf2(v[14], v[15]);
                      ((uint4*)dst)[0] = w0; ((uint4*)dst)[1] = w1;
                  } else {
                      const uint4 f0 = ((const uint4*)dst)[0], f1 = ((const uint4*)dst)[1];
                      const unsigned fw[8] = {f0.x, f0.y, f0.z, f0.w, f1.x, f1.y, f1.z, f1.w};
                      float ss = 0.f;
#pragma unroll
                      for (int j = 0; j < 8; ++j) { v[2 * j] += __uint_as_float(fw[j] << 16); v[2 * j + 1] += __uint_as_float(fw[j] & 0xffff0000u); ss += v[2 * j] * v[2 * j] + v[2 * j + 1] * v[2 * j + 1]; }
                      ss += __shfl_xor(ss, 1); ss += __shfl_xor(ss, 2); ss += __shfl_xor(ss, 4);
                      const float rn = rsqrtf(ss * (1.0f / 128.0f) + 1e-6f);
                      const bf16_t* gp = hg + (size_t)tok * 2560 + 2048 + h * 128 + e0;
                      const uint4 g0 = ((const uint4*)gp)[0], g1 = ((const uint4*)gp)[1];
                      const unsigned gw[8] = {g0.x, g0.y, g0.z, g0.w, g1.x, g1.y, g1.z, g1.w};
                      unsigned ow[8];
#pragma unroll
                      for (int j = 0; j < 8; ++j) { const float ga = silu_f(__uint_as_float(gw[j] << 16)), gb = silu_f(__uint_as_float(gw[j] & 0xffff0000u));
                          ow[j] = pack_bf2_hw(v[2 * j] * rn * gain[h * 128 + e0 + 2 * j] * ga, v[2 * j + 1] * rn * gain[h * 128 + e0 + 2 * j + 1] * gb); }
                      ((uint4*)dst)[0] = make_uint4(ow[0], ow[1], ow[2], ow[3]); ((uint4*)dst)[1] = make_uint4(ow[4], ow[5], ow[6], ow[7]);
                  }
                }
                LBAR();
            }
        }
    }
}
#define XB_TMO      128
#define XB_XCNT(j)  (256  + 64 * (j))
#define XB_XSUB(j)  (1280 + 64 * (j))
#define XB_XGEN(j)  (2304 + 64 * (j))
#define XB_TOP      3328
#define XB_TOPGEN   3392
#define XCD_BAR_WORDS 3456
#define XB_SPIN_CAP (1u << 18)

__device__ __forceinline__ unsigned xb_ld(unsigned* p)              { return __hip_atomic_load(p, __ATOMIC_RELAXED, __HIP_MEMORY_SCOPE_AGENT); }
__device__ __forceinline__ unsigned xb_add(unsigned* p, unsigned v) { return __hip_atomic_fetch_add(p, v, __ATOMIC_RELAXED, __HIP_MEMORY_SCOPE_AGENT); }
__device__ __forceinline__ unsigned xb_xcc_id() { return (unsigned)__builtin_amdgcn_s_getreg((3 << 11) | 20) & 0xFu; }
#define XB_SPIN(cond, bar) do { unsigned _sp = 0; while (cond) { __builtin_amdgcn_s_sleep(1); \
    if ((++_sp & 255u) == 0u) { if (xb_ld(&(bar)[XB_TMO])) break; if (_sp > XB_SPIN_CAP) { atomicAdd(&(bar)[XB_TMO], 1u); break; } } } } while (0)

struct XcdBarrier {
    unsigned* bar; unsigned x;
    volatile LAS unsigned* st;
};

__device__ __forceinline__ XcdBarrier xcd_barrier_post(unsigned* bar, volatile LAS unsigned* st) {
    XcdBarrier b; b.bar = bar; b.x = xb_xcc_id(); b.st = st;
    if (TIDX == 0) (void)xb_add(&bar[XB_XCNT(b.x)], 1u);
    return b;
}
__device__ __forceinline__ void xcd_barrier_complete(unsigned* bar, unsigned x, unsigned& nloc, unsigned& nx) {
    const unsigned G = gridDim.x * gridDim.y * gridDim.z;
    unsigned sum, cnt, mine, sp = 0u;
    for (;;) {
        sum = 0u; cnt = 0u; mine = 0u;
#pragma unroll
        for (unsigned j = 0; j < 16; ++j) { const unsigned c = xb_ld(&bar[XB_XCNT(j)]); sum += c; cnt += (c > 0u) ? 1u : 0u; mine = (j == x) ? c : mine; }
        if (sum == G) break;
        __builtin_amdgcn_s_sleep(1);
        if ((++sp & 255u) == 0u) { if (xb_ld(&bar[XB_TMO])) break; if (sp > XB_SPIN_CAP) { atomicAdd(&bar[XB_TMO], 1u); break; } }
    }
    nloc = mine > 0u ? mine : 1u; nx = cnt > 0u ? cnt : 1u;
}

__device__ __forceinline__ void xcd_barrier(const XcdBarrier& b) {
    asm volatile("s_waitcnt vmcnt(0)" ::: "memory");
    __syncthreads();
    if (TIDX == 0) {
        unsigned* bar = b.bar;
        __builtin_amdgcn_s_waitcnt(0);
        unsigned nloc = b.st[0], nx = b.st[1];
        if (nloc == 0u) { xcd_barrier_complete(bar, b.x, nloc, nx); b.st[0] = nloc; b.st[1] = nx; }
        const unsigned old = xb_add(&bar[XB_XSUB(b.x)], 1u);
        const unsigned gen = old / nloc;
        if (old + 1u == (gen + 1u) * nloc) {
            __builtin_amdgcn_fence(__ATOMIC_RELEASE, "agent");
            asm volatile("s_waitcnt vmcnt(0)" ::: "memory");
            const unsigned og = xb_add(&bar[XB_TOP], 1u);
            const unsigned tg = og / nx;
            if (og + 1u == (tg + 1u) * nx) xb_add(&bar[XB_TOPGEN], 1u);
            else XB_SPIN(xb_ld(&bar[XB_TOPGEN]) == tg, bar);
            __builtin_amdgcn_fence(__ATOMIC_ACQUIRE, "agent");
            xb_add(&bar[XB_XGEN(b.x)], 1u);
            asm volatile("s_waitcnt vmcnt(0)" ::: "memory");
        } else {
            XB_SPIN(xb_ld(&bar[XB_XGEN(b.x)]) == gen, bar);
            __builtin_amdgcn_fence(__ATOMIC_ACQUIRE, "agent");
            asm volatile("s_waitcnt vmcnt(0)" ::: "memory");
        }
    }
    __syncthreads();
}

enum { PH_SETUP, PH_CONVERT, PH_RMS_IN, PH_GEMM_IN, PH_HY_PREP, PH_FILTER, PH_HGRN, PH_HG_NORM, PH_HY_FFT, PH_HY_NORM, PH_GEMM_OUT, PH_NR0, PH_GEMM_UP, PH_GEGLU, PH_GEMM_DN, PH_NR1, PH_HG_P1, PH_HG_P2, PH_HG_P3 };
template <int PH> __device__ __forceinline__ void run_phase(const P& p_in, int l, int part, LAS unsigned char* lds) {
    typedef __attribute__((address_space(1))) unsigned char* gptr_t; typedef __attribute__((address_space(1))) float* gfptr_t;
    gptr_t wsg = (gptr_t)p_in.ws; gfptr_t outg = (gfptr_t)p_in.out;
    asm volatile("" : "+s"(wsg), "+s"(outg));
    P p = p_in; p.ws = (unsigned char*)wsg; p.out = (float*)outg;
    if constexpr (PH == PH_SETUP) { ph_setup(p); ph_copy_params(p); }
    if constexpr (PH == PH_CONVERT) ph_convert_w(p, l, lds);
    if constexpr (PH == PH_RMS_IN) ph_rmsnorm_in(p, l);
    if constexpr (PH == PH_GEMM_IN) { EpiBf16Split E; E.O0 = (bf16_t*)(p.ws + OFF_HYRAW); E.ldc0 = 1536; E.O1 = (bf16_t*)(p.ws + OFF_HG); E.ldc1 = 2560; E.csplit = 1536; E.silu_lo0 = E.silu_hi0 = E.silu_lo1 = E.silu_hi1 = 0;
        run_gemm(lds, abuf_row(p, 0), (const bf16_t*)(p.ws + OFF_W_IN), T_TOK, D_IN, DM, E); }
    if constexpr (PH == PH_HY_PREP) ph_hy_prep(p, l, lds);
    if constexpr (PH == PH_FILTER) ph_filter(p, l, lds);
    if constexpr (PH == PH_HY_FFT) ph_hy_fft(p, l, lds);
    if constexpr (PH == PH_HY_NORM) ph_hy_norm(p, l, lds);
    if constexpr (PH == PH_GEMM_OUT) { EpiBf16Split E; E.O0 = (bf16_t*)(p.ws + OFF_MIX); E.ldc0 = DM; E.O1 = E.O0; E.ldc1 = DM; E.csplit = 1 << 30; E.silu_lo0 = E.silu_hi0 = E.silu_lo1 = E.silu_hi1 = 0;
        run_gemm(lds, abuf_row(p, 0), (const bf16_t*)(p.ws + OFF_W_OUT), T_TOK, DM, DM, E); }
    if constexpr (PH == PH_NR0) ph_norm_resid(p, l, 0);
    if constexpr (PH == PH_GEMM_UP) { EpiGeglu E; E.act = (bf16_t*)(p.ws + OFF_ACT); E.cw = PRM(p, ffn_conv_w) + (size_t)l * 3 * 8192; E.cb = PRM(p, ffn_conv_b) + (size_t)l * 8192;
        run_gemm(lds, abuf_row(p, -1), (const bf16_t*)(p.ws + OFF_W_UP), 133 * 256, 2 * DFF, DM, E); }
    if constexpr (PH == PH_GEMM_DN) { EpiBf16Split E; E.O0 = (bf16_t*)(p.ws + OFF_MIX); E.ldc0 = DM; E.O1 = E.O0; E.ldc1 = DM; E.csplit = 1 << 30; E.silu_lo0 = E.silu_hi0 = E.silu_lo1 = E.silu_hi1 = 0;
        run_gemm(lds, (const bf16_t*)(p.ws + OFF_ACT), (const bf16_t*)(p.ws + OFF_W_DN), T_TOK, DM, DFF, E, 1); }
    if constexpr (PH == PH_NR1) ph_norm_resid(p, l, 1);
    if constexpr (PH == PH_HG_P1) ph_hg_pass1(p, l, lds);
    if constexpr (PH == PH_HG_P2) ph_hg_pass2(p);
    if constexpr (PH == PH_HG_P3) ph_hg_pass3(p, l, lds);
}
constexpr int LDS_BYTES = 139264;
__global__ __launch_bounds__(512, 2) void mega(P p) {
    extern __shared__ __attribute__((aligned(16))) unsigned char lds_g[];
    LAS unsigned char* lds = (LAS unsigned char*)lds_g;
    cg::grid_group grid = cg::this_grid();
    volatile LAS unsigned* xst = (volatile LAS unsigned*)(lds + LDS_BYTES - 16);
    if (TIDX == 0) { xst[0] = 0u; xst[1] = 0u; }
    __syncthreads();
    const XcdBarrier xb = xcd_barrier_post((unsigned*)(p.ws + OFF_BAR), xst);
    run_phase<PH_SETUP>(p, 0, 0, lds);
    run_phase<PH_CONVERT>(p, 0, 0, lds);
    run_phase<PH_RMS_IN>(p, 0, 0, lds);
    grid.sync();
#pragma unroll 1
    for (int l = 0; l < NLAYER; ++l) {
        run_phase<PH_GEMM_IN>(p, l, 0, lds); xcd_barrier(xb);
        run_phase<PH_HY_PREP>(p, l, 0, lds); run_phase<PH_HG_P1>(p, l, 0, lds); xcd_barrier(xb);
        run_phase<PH_FILTER>(p, l, 0, lds); run_phase<PH_HG_P2>(p, l, 0, lds); xcd_barrier(xb);
        run_phase<PH_HG_P3>(p, l, 0, lds); run_phase<PH_HY_FFT>(p, l, 0, lds); xcd_barrier(xb);
        run_phase<PH_HY_NORM>(p, l, 0, lds); xcd_barrier(xb);
        run_phase<PH_GEMM_OUT>(p, l, 0, lds); xcd_barrier(xb);
        run_phase<PH_NR0>(p, l, 0, lds); xcd_barrier(xb);
        run_phase<PH_GEMM_UP>(p, l, 0, lds); xcd_barrier(xb);
        run_phase<PH_GEMM_DN>(p, l, 0, lds); xcd_barrier(xb);
        run_phase<PH_NR1>(p, l, 0, lds);
        if (l + 1 < NLAYER) { run_phase<PH_CONVERT>(p, l + 1, 0, lds); xcd_barrier(xb); }
    }
}
extern "C" void kernel_launch(void* const* d_in, const int* in_sizes, int n_in, void* d_out, int out_size, void* d_ws, size_t ws_size, hipStream_t stream) {
    if (ws_size < WS_NEED) { fprintf(stderr, "workspace too small: %zu < %zu\n", ws_size, (size_t)WS_NEED); return; }
    static int grid_blocks = 0;
    if (!grid_blocks) {
        hipFuncSetAttribute((const void*)mega, hipFuncAttributeMaxDynamicSharedMemorySize, LDS_BYTES);
        int dev = 0, cus = 0, per_cu = 0;
        hipGetDevice(&dev);
        hipDeviceGetAttribute(&cus, hipDeviceAttributeMultiprocessorCount, dev);
        hipOccupancyMaxActiveBlocksPerMultiprocessor(&per_cu, mega, 512, LDS_BYTES);
        if (per_cu > 1) per_cu = 1;
        grid_blocks = cus * per_cu;
    }
    P p{};
    for (int i = 0; i < 26; ++i) p.in[i] = (const float*)d_in[i];
    p.out = (float*)d_out; p.ws = (unsigned char*)d_ws;
    hipMemsetAsync((unsigned char*)d_ws + OFF_BAR, 0, XCD_BAR_WORDS * 4, stream);
    void* args[] = {&p};
    hipError_t e = hipLaunchCooperativeKernel((void*)mega, dim3(grid_blocks), dim3(512), args, LDS_BYTES, stream);
    if (e != hipSuccess) fprintf(stderr, "cooperative launch failed: %s (grid %d)\n", hipGetErrorString(e), grid_blocks);
}
```
